# Optimizing an MI355X kernel written in HIP

```python
import math
import jax, jax.numpy as jnp
from jax import lax
import numpy as np

D_MODEL = 1024
BATCH = 32
SEQ = 256
DEPTH = 2
DEC_BATCH = 8
DEC_SEQ = 4096
PAST_LEN = 512

GRID_W = 64
POS_BASE = 10000.0
N_DIR = 2
N_HEADS = 4
HEAD_DK = D_MODEL // (2 * N_HEADS)
HEAD_DV = D_MODEL // N_HEADS
DK = N_HEADS * HEAD_DK
DV = N_HEADS * HEAD_DV
GATE_RANK = 16
GATE_TAU = 16.0
CHUNK = 64
S5_WIDTH = D_MODEL // 2
S5_GROUP = 16
S5_GROUPS = S5_WIDTH // S5_GROUP
S5_STATE = 64
D_FF = 4 * D_MODEL
N_MOD = 6
EPS = 1e-6
SPLITS = (DK, DK, DV, DV, N_DIR * GATE_RANK, S5_WIDTH, D_MODEL, D_MODEL)
SPLIT_IDX = tuple(int(i) for i in np.cumsum(SPLITS)[:-1])
D_IN = int(sum(SPLITS))

kernel_name = "hybrid_gla_s5_diffusion_step"


def rms_norm(x, g):
    x32 = x.astype(jnp.float32)
    y = x32 * lax.rsqrt(jnp.mean(jnp.square(x32), -1, keepdims=True) + EPS) * g.astype(jnp.float32)
    return y.astype(x.dtype)


def grid_pos_embed(n_tokens, dim):
    rows = n_tokens // GRID_W
    r = jnp.repeat(jnp.arange(rows, dtype=jnp.float32), GRID_W)
    col = jnp.tile(jnp.arange(GRID_W, dtype=jnp.float32), rows)
    quarter = dim // 4
    omega = 1.0 / (POS_BASE ** (jnp.arange(quarter, dtype=jnp.float32) / quarter))
    ar = r[:, None] * omega
    ac = col[:, None] * omega
    return jnp.concatenate([jnp.sin(ar), jnp.cos(ar), jnp.sin(ac), jnp.cos(ac)], axis=-1)


def gla_scan(q, k, v, log_a, s0):
    B, T, H, _ = q.shape
    dv = v.shape[-1]
    n = T // CHUNK

    def blocks(a):
        return a.reshape(B, n, CHUNK, H, a.shape[-1]).transpose(1, 0, 3, 2, 4)

    qb, kb, vb, gb = blocks(q), blocks(k), blocks(v), blocks(log_a)
    cum = jnp.cumsum(gb, axis=3)
    total = cum[:, :, :, -1:, :]
    q_dec = qb * jnp.exp(cum)
    k_in = kb * jnp.exp(-cum)
    k_out = kb * jnp.exp(total - cum)
    mask = jnp.tril(jnp.ones((CHUNK, CHUNK), dtype=bool))
    scores = jnp.where(mask, jnp.einsum('nbhid,nbhjd->nbhij', q_dec, k_in), 0.0)
    o_intra = jnp.einsum('nbhij,nbhjv->nbhiv', scores, vb)

    def step(s, inp):
        qd, ko, vv, tot = inp
        o = jnp.einsum('bhid,bhdv->bhiv', qd, s)
        s = jnp.exp(tot[:, :, 0, :])[..., None] * s + jnp.einsum('bhjd,bhjv->bhdv', ko, vv)
        return s, o

    s_final, o_inter = lax.scan(step, s0, (q_dec, k_out, vb, total))
    o = (o_intra + o_inter).transpose(1, 0, 3, 2, 4).reshape(B, T, H, dv)
    return o, s_final


def gla_mixer(q, k, v, r, glr, w_gate_up, b_gate, norm_g, s0):
    B, T, _ = q.shape
    dtype = q.dtype
    f32 = jnp.float32
    qh = q.astype(f32).reshape(B, T, N_HEADS, HEAD_DK) * (HEAD_DK ** -0.5)
    kh = k.astype(f32).reshape(B, T, N_HEADS, HEAD_DK)
    vh = v.astype(f32).reshape(B, T, N_HEADS, HEAD_DV)
    z = jnp.einsum('btnr,nrk->btnk', glr.astype(f32).reshape(B, T, N_DIR, GATE_RANK),
                   w_gate_up.astype(f32)) + b_gate.astype(f32)
    log_a = (jax.nn.log_sigmoid(z) / GATE_TAU).reshape(B, T, N_DIR, N_HEADS, HEAD_DK)
    s0 = s0.astype(f32)
    o_f, s_f = gla_scan(qh, kh, vh, log_a[:, :, 0], s0[:, 0])
    flip = lambda a: jnp.flip(a, axis=1)
    o_b, s_b = gla_scan(flip(qh), flip(kh), flip(vh), flip(log_a[:, :, 1]), s0[:, 1])
    o = o_f + flip(o_b)
    o = o * lax.rsqrt(jnp.mean(jnp.square(o), -1, keepdims=True) + EPS) * norm_g.astype(f32)
    o = o.reshape(B, T, DV) * jax.nn.silu(r.astype(f32))
    return o.astype(dtype), jnp.stack([s_f, s_b], axis=1)


def _linear_recurrence(earlier, later):
    a_e, b_e = earlier
    a_l, b_l = later
    return a_l * a_e, a_l * b_e + b_l


def s5_direction(u, lam_re, lam_im, log_step, b_re, b_im, c_re, c_im, s0_re, s0_im):
    T = u.shape[1]
    lam = lax.complex(lam_re, lam_im)
    lam_bar = jnp.exp(lam * jnp.exp(log_step)[:, None])
    b_bar = ((lam_bar - 1.0) / lam)[..., None] * lax.complex(b_re, b_im)
    bu = jnp.einsum('btgn,gpn->tbgp', u.astype(jnp.complex64), b_bar)
    bu = bu.at[0].add(lam_bar * lax.complex(s0_re, s0_im))
    a = jnp.broadcast_to(lam_bar, (T, 1) + lam_bar.shape)
    _, s = lax.associative_scan(_linear_recurrence, (a, bu), axis=0)
    y = jnp.einsum('tbgp,gnp->btgn', s, lax.complex(c_re, c_im)).real
    return y, s[-1].real, s[-1].imag


def s5_mixer(u, s5_params, d, w_glu, b_glu, s0_re, s0_im):
    B, T, _ = u.shape
    f32 = jnp.float32
    u32 = u.astype(f32)
    ug = u32.reshape(B, T, S5_GROUPS, S5_GROUP)
    prm = [p_.astype(f32) for p_ in s5_params]
    s0_re = s0_re.astype(f32)
    s0_im = s0_im.astype(f32)
    y_f, f_re, f_im = s5_direction(ug, *[p_[0] for p_ in prm], s0_re[:, 0], s0_im[:, 0])
    y_b, b_re, b_im = s5_direction(jnp.flip(ug, 1), *[p_[1] for p_ in prm], s0_re[:, 1], s0_im[:, 1])
    y = (y_f + jnp.flip(y_b, 1)).reshape(B, T, S5_WIDTH) + d.astype(f32) * u32
    y = jax.nn.gelu(y)
    y = y * jax.nn.sigmoid(y @ w_glu.astype(f32) + b_glu.astype(f32))
    return y.astype(u.dtype), jnp.stack([f_re, b_re], axis=1), jnp.stack([f_im, b_im], axis=1)


def trunk_layer(x, mod, gla_s0, s5_s0_re, s5_s0_im, p):
    shift1, scale1, gate1, shift2, scale2, gate2 = jnp.split(mod[:, None, :], N_MOD, axis=-1)
    h = rms_norm(x, p["norm1_g"]) * (1 + scale1) + shift1
    q, k, v, r, glr, u, ga, gb = jnp.split(h @ p["w_in"], SPLIT_IDX, axis=-1)
    o_gla, gla_state = gla_mixer(q, k, v, r, glr, p["w_gate_up"], p["b_gate"], p["gla_norm_g"], gla_s0)
    o_s5, s5_re, s5_im = s5_mixer(u, p["s5"], p["s5_d"], p["w_glu"], p["b_glu"], s5_s0_re, s5_s0_im)
    merged = (jax.nn.sigmoid(ga) * (o_gla @ p["w_proj_gla"])
              + jax.nn.sigmoid(gb) * (o_s5 @ p["w_proj_s5"]))
    x = x + gate1 * (merged @ p["w_out"])
    h2 = rms_norm(x, p["norm2_g"]) * (1 + scale2) + shift2
    x = x + gate2 * (jnp.square(jax.nn.relu(h2 @ p["w_ff1"])) @ p["w_ff2"])
    return x, gla_state, s5_re, s5_im


def setup_inputs(seed: int = 0) -> dict:
    key = jax.random.key(seed)
    ks = iter(jax.random.split(key, 40))
    f32 = jnp.float32

    def nrm(shape, scale):
        return scale * jax.random.normal(next(ks), shape, f32)

    n_idx = jnp.arange(S5_STATE, dtype=f32)
    s5_shape = (DEPTH, N_DIR, S5_GROUPS, S5_STATE)
    return {
        "x_prompt": nrm((BATCH, SEQ, D_MODEL), 1.0),
        "x_sample": nrm((DEC_BATCH, DEC_SEQ, D_MODEL), 1.0),
        "c": nrm((DEC_BATCH, D_MODEL), 1.0),
        "cache_gla_state": nrm((DEC_BATCH, DEPTH, N_DIR, N_HEADS, HEAD_DK, HEAD_DV), 1.0),
        "state_s5_re": nrm((DEC_BATCH, DEPTH, N_DIR, S5_GROUPS, S5_STATE), 0.5),
        "state_s5_im": nrm((DEC_BATCH, DEPTH, N_DIR, S5_GROUPS, S5_STATE), 0.5),
        "c_ctx": nrm((D_MODEL,), 1.0),
        "w_mod": nrm((DEPTH, D_MODEL, N_MOD * D_MODEL), 0.5 * D_MODEL ** -0.5),
        "b_mod": nrm((DEPTH, N_MOD * D_MODEL), 0.02),
        "norm1_g": 1.0 + nrm((DEPTH, D_MODEL), 0.02),
        "w_in": nrm((DEPTH, D_MODEL, D_IN), D_MODEL ** -0.5),
        "w_gate_up": nrm((DEPTH, N_DIR, GATE_RANK, DK), GATE_RANK ** -0.5),
        "b_gate": nrm((DEPTH, N_DIR, DK), 0.1),
        "gla_norm_g": 1.0 + nrm((DEPTH, HEAD_DV), 0.02),
        "w_proj_gla": nrm((DEPTH, DV, D_MODEL), DV ** -0.5),
        "s5_lam_re": -0.5 + nrm(s5_shape, 0.01),
        "s5_lam_im": math.pi * n_idx + nrm(s5_shape, 0.01),
        "s5_log_step": jax.random.uniform(next(ks), (DEPTH, N_DIR, S5_GROUPS), f32,
                                          math.log(1e-3), math.log(1e-1)),
        "s5_b_re": nrm((DEPTH, N_DIR, S5_GROUPS, S5_STATE, S5_GROUP), (2 * S5_GROUP) ** -0.5),
        "s5_b_im": nrm((DEPTH, N_DIR, S5_GROUPS, S5_STATE, S5_GROUP), (2 * S5_GROUP) ** -0.5),
        "s5_c_re": nrm((DEPTH, N_DIR, S5_GROUPS, S5_GROUP, S5_STATE), S5_STATE ** -0.5),
        "s5_c_im": nrm((DEPTH, N_DIR, S5_GROUPS, S5_GROUP, S5_STATE), S5_STATE ** -0.5),
        "s5_d": nrm((DEPTH, S5_WIDTH), 0.5),
        "w_glu": nrm((DEPTH, S5_WIDTH, S5_WIDTH), S5_WIDTH ** -0.5),
        "b_glu": nrm((DEPTH, S5_WIDTH), 0.02),
        "w_proj_s5": nrm((DEPTH, S5_WIDTH, D_MODEL), S5_WIDTH ** -0.5),
        "w_out": nrm((DEPTH, D_MODEL, D_MODEL), D_MODEL ** -0.5),
        "norm2_g": 1.0 + nrm((DEPTH, D_MODEL), 0.02),
        "w_ff1": nrm((DEPTH, D_MODEL, D_FF), D_MODEL ** -0.5),
        "w_ff2": nrm((DEPTH, D_FF, D_MODEL), D_FF ** -0.5),
        "final_g": 1.0 + nrm((D_MODEL,), 0.02),
    }


def reference(x_prompt, x_sample, c, cache_gla_state, state_s5_re, state_s5_im, c_ctx,
              w_mod, b_mod, norm1_g, w_in, w_gate_up, b_gate, gla_norm_g, w_proj_gla,
              s5_lam_re, s5_lam_im, s5_log_step, s5_b_re, s5_b_im, s5_c_re, s5_c_im, s5_d,
              w_glu, b_glu, w_proj_s5, w_out, norm2_g, w_ff1, w_ff2, final_g):
    layers = [dict(norm1_g=norm1_g[l], w_in=w_in[l], w_gate_up=w_gate_up[l], b_gate=b_gate[l],
                   gla_norm_g=gla_norm_g[l], w_proj_gla=w_proj_gla[l],
                   s5=(s5_lam_re[l], s5_lam_im[l], s5_log_step[l], s5_b_re[l], s5_b_im[l],
                       s5_c_re[l], s5_c_im[l]),
                   s5_d=s5_d[l], w_glu=w_glu[l], b_glu=b_glu[l], w_proj_s5=w_proj_s5[l],
                   w_out=w_out[l], norm2_g=norm2_g[l], w_ff1=w_ff1[l], w_ff2=w_ff2[l])
              for l in range(DEPTH)]

    nb = x_prompt.shape[0]
    gla0 = jnp.zeros((nb, N_DIR, N_HEADS, HEAD_DK, HEAD_DV), jnp.float32)
    s50 = jnp.zeros((nb, N_DIR, S5_GROUPS, S5_STATE), jnp.float32)
    xc = x_prompt
    gla_list, s5_re_list, s5_im_list = [], [], []
    for l in range(DEPTH):
        mod_ctx = (jax.nn.silu(c_ctx) @ w_mod[l] + b_mod[l])[None]
        xc, g_st, s_re, s_im = trunk_layer(xc, mod_ctx, gla0, s50, s50, layers[l])
        gla_list.append(g_st)
        s5_re_list.append(s_re)
        s5_im_list.append(s_im)
    y_prompt = rms_norm(xc, final_g)
    new_gla_state = jnp.stack(gla_list, axis=1)
    new_s5_re = jnp.stack(s5_re_list, axis=1)
    new_s5_im = jnp.stack(s5_im_list, axis=1)

    xs = x_sample + grid_pos_embed(x_sample.shape[1], D_MODEL).astype(x_sample.dtype)
    for l in range(DEPTH):
        mod = jax.nn.silu(c) @ w_mod[l] + b_mod[l]
        xs, _, _, _ = trunk_layer(xs, mod, cache_gla_state[:, l], state_s5_re[:, l],
                                  state_s5_im[:, l], layers[l])
    y_sample = rms_norm(xs, final_g)

    return (y_prompt, y_sample, new_gla_state, new_s5_re, new_s5_im)
```

```cpp
#include <hip/hip_runtime.h>
#include <hip/hip_cooperative_groups.h>
#include <cstdio>
namespace cg = cooperative_groups;

#ifndef MULTI_LAUNCH
#define MULTI_LAUNCH 0
#endif

#ifndef PHASE_SEL
#define PHASE_SEL -1
#endif
#define EN(q) (PHASE_SEL < 0 || PHASE_SEL == (q))
#define LAS __attribute__((address_space(3)))
typedef unsigned short bf16_t;
typedef short bf16x8 __attribute__((ext_vector_type(8)));
typedef float f32x4 __attribute__((ext_vector_type(4)));
typedef unsigned u32x4 __attribute__((ext_vector_type(4)));
typedef unsigned u32x2 __attribute__((ext_vector_type(2)));

constexpr int NTHR = 512;
constexpr int TOK = 40960, TOKP = 8192;
constexpr int LDS_BYTES = 147456;
constexpr int NPHASE = 35;
constexpr int PPL = 17;

constexpr size_t MiB = (size_t)1 << 20;
constexpr size_t WS_MOD = 0;
constexpr size_t WS_GLR = 1 * MiB;
constexpr size_t WS_TOTF = 7 * MiB;
constexpr size_t WS_TOTB = 9 * MiB;
constexpr size_t WS_W = 16 * MiB;
constexpr size_t W_A = 0;
constexpr size_t W_B = W_A + (size_t)2816 * 1024 * 2;
constexpr size_t W_PG = W_B + (size_t)3072 * 1024 * 2;
constexpr size_t W_GLU = W_PG + (size_t)1024 * 1024 * 2;
constexpr size_t W_PS = W_GLU + (size_t)512 * 512 * 2;
constexpr size_t W_OUT = W_PS + (size_t)1024 * 512 * 2;
constexpr size_t W_1 = W_OUT + (size_t)1024 * 1024 * 2;
constexpr size_t W_2 = W_1 + (size_t)4096 * 1024 * 2;
constexpr size_t WS_R2 = 50 * MiB;
constexpr size_t WS_R3 = 130 * MiB;
constexpr size_t WS_R4 = 210 * MiB;
constexpr size_t WS_R5 = 290 * MiB;
constexpr size_t WS_E = 350 * MiB;
constexpr size_t WS_R6 = 390 * MiB;
constexpr size_t WS_R1 = 430 * MiB;
constexpr size_t WS_EMAT = 454 * MiB;
constexpr size_t WS_HID = 130 * MiB;
constexpr size_t WS_END = 510 * MiB;

struct P { const float* in[31]; float* out; unsigned char* ws; int ph_lo, ph_hi; };

__device__ __forceinline__ int tid_() { int t = threadIdx.x; asm volatile("" : "+v"(t)); return t; }
__device__ __forceinline__ int bid_() { int b = blockIdx.x; asm volatile("" : "+s"(b)); return b; }
__device__ __forceinline__ int lnd(int k) { asm volatile("" : "+s"(k)); return k; }
__device__ __forceinline__ unsigned pk_bf16(float lo, float hi) { unsigned r; asm("v_cvt_pk_bf16_f32 %0, %1, %2" : "=v"(r) : "v"(lo), "v"(hi)); return r; }
__device__ __forceinline__ float bf2f(bf16_t b) { return __uint_as_float(((unsigned)b) << 16); }
__device__ __forceinline__ float bflo(unsigned w) { return __uint_as_float(w << 16); }
__device__ __forceinline__ float bfhi(unsigned w) { return __uint_as_float(w & 0xffff0000u); }
__device__ __forceinline__ bf16_t f2bf(float f) { return (bf16_t)(pk_bf16(f, 0.f) & 0xffffu); }
__device__ __forceinline__ float sigmoidf_(float x) { return 1.0f / (1.0f + __expf(-x)); }
__device__ __forceinline__ void store4bf(bf16_t* ptr, f32x4 v) { u32x2 w; w.x = pk_bf16(v[0], v[1]); w.y = pk_bf16(v[2], v[3]); *(u32x2*)ptr = w; }
__device__ __forceinline__ f32x4 load4bf(const bf16_t* ptr) { u32x2 w = *(const u32x2*)ptr; return (f32x4){bflo(w.x), bfhi(w.x), bflo(w.y), bfhi(w.y)}; }
__device__ __forceinline__ int mod_index(int tok) { return tok < TOKP ? 0 : (tok >> 12) - 1; }
__device__ __forceinline__ float wave_sum(float v) {
#pragma unroll
    for (int o = 32; o >= 1; o >>= 1) v += __shfl_xor(v, o);
    return v;
}

namespace pg8 {
constexpr int BM = 256, BK = 64, HALF = 128, HTB = HALF * BK * 2, STAGE_BYTES = 8 * HTB, NXCD = 8, WGM = 8;
__device__ __forceinline__ int lds_byte(int r, int c) { const int st = (r >> 4) * 2 + (c >> 5), rr = r & 15, cc = c & 31, ob = rr * 64 + cc * 2; return st * 1024 + (ob ^ (((ob >> 9) & 1) << 5)); }
__device__ __forceinline__ void stage_rc(int b, int& R, int& C) { const int st = b / 1024, sb = b % 1024, swz = sb ^ (((sb >> 9) & 1) << 5); R = (st >> 1) * 16 + swz / 64; C = (st & 1) * 32 + (swz % 64) / 2; }

struct Unit { int pm, pn, z; };
struct Gemm { const bf16_t* A; const bf16_t* Bt; int M, N, K, lda; size_t sA, sB; int nz; };
struct Order {
    int nM, nN, nwg, G, c, nz;
    __device__ void init(int M, int N, int nz_, int G_, int c_) { nM = M / BM; nN = N / BM; nwg = nM * nN; G = G_; c = c_; nz = nz_; }
    __device__ bool next(int i, Unit& u) const {
        const long L = (long)i * G + c; if (L >= (long)nwg * nz) return false;
        if (nz == 1) {
            int wgid = (int)L; { const int q = nwg / NXCD, r = nwg % NXCD, xcd = wgid % NXCD, off = wgid / NXCD; wgid = (xcd < r ? xcd * (q + 1) : r * (q + 1) + (xcd - r) * q) + off; }
            const int nig = WGM * nN, gid = wgid / nig, fm = gid * WGM, gsz = (nM - fm) < WGM ? (nM - fm) : WGM;
            u.pm = fm + ((wgid % nig) % gsz); u.pn = (wgid % nig) / gsz; u.z = 0;
        } else {
            const int z = (int)(L / nwg), r = (int)(L % nwg); u.z = z; u.pm = r % nM; u.pn = r / nM;
        }
        return true;
    }
};

template <class Epi>
__device__ __forceinline__ void gemm_phase(LAS unsigned char* lds, const Gemm g, const Order& S, const Epi& E) {
    const int tid = tid_(), wid = __builtin_amdgcn_readfirstlane(tid >> 6), lane = tid & 63, wr = wid >> 2, wc = wid & 3, fr = lane & 15, fq = lane >> 4;
    const int K = g.K, nt = K / BK;
    unsigned voffA[2], voffB[2];
#pragma unroll
    for (int i = 0; i < 2; ++i) { int R, C; stage_rc(tid * 16 + i * 8192, R, C); voffA[i] = (unsigned)(R * g.lda + C) * 2u; voffB[i] = (unsigned)(R * K + C) * 2u; }
    const size_t kstep = (size_t)(BK * 2);
    const size_t hstepA = (size_t)HALF * g.lda * 2, hstepB = (size_t)HALF * K * 2;
    const unsigned ldsw = (unsigned)wid * 1024u;
    const int aoff = lds_byte(wr * 64 + fr, fq * 8), boff = lds_byte(wc * 32 + fr, fq * 8);
#define PG8_SA(b, h) (((b) * 2 + (h)) * HTB)
#define PG8_SB(b, h) ((4 + (b) * 2 + (h)) * HTB)
#define PG8_STAGE(bufoff, gbase, voff) do { _Pragma("unroll") for (int _i = 0; _i < 2; ++_i) \
        __builtin_amdgcn_global_load_lds((const unsigned*)((const char*)(gbase) + (voff)[_i]), (LAS unsigned*)(lds + (bufoff) + ldsw + _i * 8192), 16, 0, 0); } while (0)
#define PG8_LDA(dst, b, h) do { _Pragma("unroll") for (int m = 0; m < 4; ++m) _Pragma("unroll") for (int k = 0; k < 2; ++k) dst[m][k] = *(const LAS bf16x8*)(lds + PG8_SA(b, h) + aoff + m * 2048 + k * 1024); } while (0)
#define PG8_LDB(dst, b, h) do { _Pragma("unroll") for (int n = 0; n < 2; ++n) _Pragma("unroll") for (int k = 0; k < 2; ++k) dst[n][k] = *(const LAS bf16x8*)(lds + PG8_SB(b, h) + boff + n * 2048 + k * 1024); } while (0)
#define PG8_MMA(ai, bj, At, Bt) do { __builtin_amdgcn_s_setprio(1); _Pragma("unroll") for (int m = 0; m < 4; ++m) _Pragma("unroll") for (int n = 0; n < 2; ++n) _Pragma("unroll") for (int k = 0; k < 2; ++k) \
        acc[ai][bj][m][n] = __builtin_amdgcn_mfma_f32_16x16x32_bf16(Bt[n][k], At[m][k], acc[ai][bj][m][n], 0, 0, 0); __builtin_amdgcn_s_setprio(0); } while (0)
#define PG8_WAIT_V(n) asm volatile("s_waitcnt vmcnt(" #n ")" ::: "memory")
#define PG8_WAIT_L(n) asm volatile("s_waitcnt lgkmcnt(" #n ")" ::: "memory")
#define PG8_BAR __builtin_amdgcn_s_barrier()
#define PG8_SCHED __builtin_amdgcn_sched_barrier(0)
    Unit cur, nxt; int ui = 0;
    if (!S.next(0, cur)) return;
    f32x4 acc[2][2][4][2];
#pragma unroll
    for (int a = 0; a < 2; ++a)
#pragma unroll
        for (int b = 0; b < 2; ++b)
#pragma unroll
            for (int m = 0; m < 4; ++m)
#pragma unroll
                for (int n = 0; n < 2; ++n) acc[a][b][m][n] = (f32x4){0.f, 0.f, 0.f, 0.f};
    bf16x8 At[4][2], B0[2][2], B1[2][2];
    const char* cA = (const char*)g.A + ((size_t)cur.z * g.sA + (size_t)cur.pm * BM * g.lda) * 2;
    const char* cB = (const char*)g.Bt + ((size_t)cur.z * g.sB + (size_t)cur.pn * BM * K) * 2;
    PG8_STAGE(PG8_SB(0, 0), cB, voffB); PG8_STAGE(PG8_SA(0, 0), cA, voffA); PG8_STAGE(PG8_SB(0, 1), cB + hstepB, voffB); PG8_STAGE(PG8_SA(0, 1), cA + hstepA, voffA);
    if (wr == 1) PG8_BAR;
    PG8_WAIT_V(4); PG8_BAR;
    PG8_STAGE(PG8_SB(1, 0), cB + kstep, voffB); PG8_STAGE(PG8_SA(1, 0), cA + kstep, voffA); PG8_STAGE(PG8_SB(1, 1), cB + hstepB + kstep, voffB);
    PG8_WAIT_V(6); PG8_BAR;
    for (;;) {
        const bool has_next = S.next(ui + 1, nxt);
        const char* nA = has_next ? (const char*)g.A + ((size_t)nxt.z * g.sA + (size_t)nxt.pm * BM * g.lda) * 2 : cA;
        const char* nB = has_next ? (const char*)g.Bt + ((size_t)nxt.z * g.sB + (size_t)nxt.pn * BM * K) * 2 : cB;
        for (int t = 0; t < nt; t += 2) {
            const bool last = (t == nt - 2);
            const char* a1 = cA + (size_t)(t + 1) * kstep;
            const char* a2 = last ? nA : cA + (size_t)(t + 2) * kstep; const char* b2 = last ? nB : cB + (size_t)(t + 2) * kstep;
            const char* a3 = a2 + kstep; const char* b3 = b2 + kstep;
            PG8_LDB(B0, 0, 0); PG8_SCHED; PG8_LDA(At, 0, 0); PG8_STAGE(PG8_SA(1, 1), a1 + hstepA, voffA);
            PG8_WAIT_L(8); PG8_BAR; PG8_WAIT_L(0); PG8_MMA(0, 0, At, B0); PG8_BAR; PG8_SCHED;
            PG8_LDB(B1, 0, 1); PG8_STAGE(PG8_SB(0, 0), b2, voffB);
            PG8_BAR; PG8_WAIT_L(0); PG8_MMA(0, 1, At, B1); PG8_BAR;
            PG8_LDA(At, 0, 1); PG8_STAGE(PG8_SA(0, 0), a2, voffA);
            PG8_BAR; PG8_WAIT_L(0); PG8_MMA(1, 0, At, B0); PG8_BAR; PG8_SCHED;
            PG8_STAGE(PG8_SB(0, 1), b2 + hstepB, voffB);
            PG8_WAIT_V(6); PG8_BAR; PG8_MMA(1, 1, At, B1); PG8_BAR;
            PG8_LDB(B0, 1, 0); PG8_SCHED; PG8_LDA(At, 1, 0); PG8_STAGE(PG8_SA(0, 1), a2 + hstepA, voffA);
            PG8_WAIT_L(8); PG8_BAR; PG8_WAIT_L(0); PG8_MMA(0, 0, At, B0); PG8_BAR; PG8_SCHED;
            PG8_LDB(B1, 1, 1); PG8_STAGE(PG8_SB(1, 0), b3, voffB);
            PG8_BAR; PG8_WAIT_L(0); PG8_MMA(0, 1, At, B1); PG8_BAR;
            PG8_LDA(At, 1, 1); PG8_STAGE(PG8_SA(1, 0), a3, voffA);
            PG8_BAR; PG8_WAIT_L(0); PG8_MMA(1, 0, At, B0); PG8_BAR; PG8_SCHED;
            PG8_STAGE(PG8_SB(1, 1), b3 + hstepB, voffB);
            PG8_WAIT_V(6); PG8_BAR; PG8_MMA(1, 1, At, B1); PG8_BAR;
        }
        {
            const int row0 = cur.pm * BM + wr * 64 + fr, col0 = cur.pn * BM + wc * 32 + 4 * fq;
#pragma unroll
            for (int ai = 0; ai < 2; ++ai)
#pragma unroll
                for (int m = 0; m < 4; ++m)
#pragma unroll
                    for (int bj = 0; bj < 2; ++bj)
#pragma unroll
                        for (int n = 0; n < 2; ++n) E(cur.z, row0 + ai * HALF + m * 16, col0 + bj * HALF + n * 16, acc[ai][bj][m][n]);
        }
        if (!has_next) break;
#pragma unroll
        for (int a = 0; a < 2; ++a)
#pragma unroll
            for (int b = 0; b < 2; ++b)
#pragma unroll
                for (int m = 0; m < 4; ++m)
#pragma unroll
                    for (int n = 0; n < 2; ++n) acc[a][b][m][n] = (f32x4){0.f, 0.f, 0.f, 0.f};
        cur = nxt; cA = nA; cB = nB; ++ui;
    }
    PG8_WAIT_V(0);
    if (wr == 0) PG8_BAR;
    PG8_BAR;
#undef PG8_SA
#undef PG8_SB
#undef PG8_STAGE
#undef PG8_LDA
#undef PG8_LDB
#undef PG8_MMA
#undef PG8_WAIT_V
#undef PG8_WAIT_L
#undef PG8_BAR
#undef PG8_SCHED
}
}

struct EpiPartA {
    bf16_t* Q; bf16_t* Kk; bf16_t* V; bf16_t* UG; float* GLR;
    __device__ __forceinline__ void operator()(int, int row, int col, f32x4 v) const {
        if (col < 512) store4bf(Q + (size_t)row * 512 + col, v);
        else if (col < 1024) store4bf(Kk + (size_t)row * 512 + (col - 512), v);
        else if (col < 2048) store4bf(V + (size_t)row * 1024 + (col - 1024), v);
        else if (col < 2304) { const int c = col - 2048; if (c < 32) *(f32x4*)(GLR + (size_t)row * 32 + c) = v; }
        else { const int c = col - 2304, g = c >> 4, n = c & 15, chunk = row >> 5, j = row & 31; store4bf(UG + ((size_t)(g * 1280 + chunk) * 768 + j * 16 + n), v); }
    }
};
struct EpiE { float* E; __device__ __forceinline__ void operator()(int z, int row, int col, f32x4 v) const { *(f32x4*)(E + ((size_t)(z * 1280 + row) * 256 + col)) = v; } };
struct EpiY {
    bf16_t* YB;
    __device__ __forceinline__ void operator()(int z, int row, int col, f32x4 v) const {
        const int tok = row * 32 + (col >> 4), ch = z * 16 + (col & 15);
        f32x4 o;
#pragma unroll
        for (int e = 0; e < 4; ++e) { const float x = v[e]; o[e] = x * sigmoidf_(1.5957691216f * (x + 0.044715f * x * x * x)); }
        store4bf(YB + (size_t)tok * 512 + ch, o);
    }
};
struct EpiGLU {
    const bf16_t* YB; bf16_t* OS5; const float* bglu;
    __device__ __forceinline__ void operator()(int, int row, int col, f32x4 v) const {
        const f32x4 b = *(const f32x4*)(bglu + col); const f32x4 y = load4bf(YB + (size_t)row * 512 + col); f32x4 o;
#pragma unroll
        for (int e = 0; e < 4; ++e) o[e] = y[e] * sigmoidf_(v[e] + b[e]);
        store4bf(OS5 + (size_t)row * 512 + col, o);
    }
};
struct EpiPartB {
    bf16_t* R; bf16_t* GA; bf16_t* GB;
    __device__ __forceinline__ void operator()(int, int row, int col, f32x4 v) const {
        f32x4 s;
#pragma unroll
        for (int e = 0; e < 4; ++e) s[e] = sigmoidf_(v[e]);
        if (col < 1024) { store4bf(R + (size_t)row * 1024 + col, v * s); }
        else if (col < 2048) store4bf(GA + (size_t)row * 1024 + (col - 1024), s);
        else store4bf(GB + (size_t)row * 1024 + (col - 2048), s);
    }
};
struct EpiProj1 { const bf16_t* GA; bf16_t* T1;
    __device__ __forceinline__ void operator()(int, int row, int col, f32x4 v) const { const size_t o = (size_t)row * 1024 + col; store4bf(T1 + o, load4bf(GA + o) * v); } };
struct EpiProj2 { const bf16_t* GB; bf16_t* T1;
    __device__ __forceinline__ void operator()(int, int row, int col, f32x4 v) const { const size_t o = (size_t)row * 1024 + col; store4bf(T1 + o, load4bf(T1 + o) + load4bf(GB + o) * v); } };
struct EpiRes { float* X; const float* gate;
    __device__ __forceinline__ void operator()(int, int row, int col, f32x4 v) const {
        const f32x4 gt = *(const f32x4*)(gate + (size_t)mod_index(row) * 6144 + col); float* xp = X + (size_t)row * 1024 + col;
        *(f32x4*)xp = *(const f32x4*)xp + gt * v; } };
struct EpiFF1 { bf16_t* H;
    __device__ __forceinline__ void operator()(int, int row, int col, f32x4 v) const {
        f32x4 o;
#pragma unroll
        for (int e = 0; e < 4; ++e) { const float r = fmaxf(v[e], 0.f); o[e] = r * r; }
        store4bf(H + (size_t)row * 4096 + col, o); } };

struct ConvJob { const float* src; int ld, K, c0, nvalid, ndst; bf16_t* dst; float scale; };
__device__ __forceinline__ bool conv_job(const P& p, int l, int j, ConvJob& J) {
    bf16_t* W = (bf16_t*)(p.ws + WS_W);
    const float* win = p.in[lnd(10)] + (size_t)l * 1024 * 5664;
    J.scale = 1.0f;
    switch (j) {
        case 0: J = {win, 5664, 1024, 0, 512, 512, W + W_A / 2, 0.08838834764831845f}; break;
        case 1: J = {win, 5664, 1024, 512, 512, 512, W + W_A / 2 + (size_t)512 * 1024, 1.f}; break;
        case 2: J = {win, 5664, 1024, 1024, 1024, 1024, W + W_A / 2 + (size_t)1024 * 1024, 1.f}; break;
        case 3: J = {win, 5664, 1024, 3072, 32, 256, W + W_A / 2 + (size_t)2048 * 1024, 1.f}; break;
        case 4: J = {win, 5664, 1024, 3104, 512, 512, W + W_A / 2 + (size_t)2304 * 1024, 1.f}; break;
        case 5: J = {win, 5664, 1024, 2048, 1024, 1024, W + W_B / 2, 1.f}; break;
        case 6: J = {win, 5664, 1024, 3616, 1024, 1024, W + W_B / 2 + (size_t)1024 * 1024, 1.f}; break;
        case 7: J = {win, 5664, 1024, 4640, 1024, 1024, W + W_B / 2 + (size_t)2048 * 1024, 1.f}; break;
        case 8: J = {p.in[lnd(14)] + (size_t)l * 1024 * 1024, 1024, 1024, 0, 1024, 1024, W + W_PG / 2, 1.f}; break;
        case 9: J = {p.in[lnd(23)] + (size_t)l * 512 * 512, 512, 512, 0, 512, 512, W + W_GLU / 2, 1.f}; break;
        case 10: J = {p.in[lnd(25)] + (size_t)l * 512 * 1024, 1024, 512, 0, 1024, 1024, W + W_PS / 2, 1.f}; break;
        case 11: J = {p.in[lnd(26)] + (size_t)l * 1024 * 1024, 1024, 1024, 0, 1024, 1024, W + W_OUT / 2, 1.f}; break;
        case 12: J = {p.in[lnd(28)] + (size_t)l * 1024 * 4096, 4096, 1024, 0, 4096, 4096, W + W_1 / 2, 1.f}; break;
        case 13: J = {p.in[lnd(29)] + (size_t)l * 4096 * 1024, 1024, 4096, 0, 1024, 1024, W + W_2 / 2, 1.f}; break;
        default: return false;
    }
    return true;
}
constexpr int CONV_TILES = 4224;
__device__ __forceinline__ void conv_tile(const P& p, int l, int tile, LAS float* sT) {
    const int tid = tid_();
    ConvJob J; int j = 0, rem = tile;
    for (; j < 14; ++j) { conv_job(p, l, j, J); const int nt = (J.ndst / 64) * (J.K / 64); if (rem < nt) break; rem -= nt; }
    const int kts = J.K / 64, ntile = rem / kts, ktile = rem % kts, n0 = ntile * 64, k0 = ktile * 64;
    {
        const int kk = tid >> 4, c4 = (tid & 15) * 4;
#pragma unroll
        for (int i = 0; i < 2; ++i) {
            const int k = kk + 32 * i; f32x4 v = (f32x4){0.f, 0.f, 0.f, 0.f};
            if (n0 + c4 < J.nvalid) v = *(const f32x4*)(J.src + (size_t)(k0 + k) * J.ld + J.c0 + n0 + c4);
#pragma unroll
            for (int e = 0; e < 4; ++e) sT[(c4 + e) * 65 + k] = v[e] * J.scale;
        }
    }
    __syncthreads();
    {
        const int n = tid >> 3, ks = (tid & 7) * 8; u32x4 w;
        const LAS float* s = sT + n * 65 + ks;
        w.x = pk_bf16(s[0], s[1]); w.y = pk_bf16(s[2], s[3]); w.z = pk_bf16(s[4], s[5]); w.w = pk_bf16(s[6], s[7]);
        *(u32x4*)(J.dst + (size_t)(n0 + n) * J.K + k0 + ks) = w;
    }
}

__device__ __forceinline__ void mod_task(const P& p, int m, LAS float* sm) {
    const int tid = tid_(), l = m / 192, colbase = (m % 192) * 32, cl = tid & 31, ks = tid >> 5;
    LAS float* SC = sm; LAS float* RED = sm + 9216;
    for (int i = tid; i < 9216; i += NTHR) { const int j = i >> 10, k = i & 1023; const float c = (j == 0) ? p.in[lnd(6)][k] : p.in[lnd(2)][(j - 1) * 1024 + k]; SC[i] = c * sigmoidf_(c); }
    __syncthreads();
    float acc[9];
#pragma unroll
    for (int j = 0; j < 9; ++j) acc[j] = 0.f;
    const float* w = p.in[lnd(7)] + (size_t)l * 1024 * 6144 + colbase + cl;
    for (int kk = 0; kk < 64; ++kk) { const int k = ks * 64 + kk; const float wv = w[(size_t)k * 6144];
#pragma unroll
        for (int j = 0; j < 9; ++j) acc[j] += SC[j * 1024 + k] * wv; }
#pragma unroll
    for (int j = 0; j < 9; ++j) RED[(ks * 9 + j) * 32 + cl] = acc[j];
    __syncthreads();
    if (tid < 288) { const int j = tid >> 5, c = tid & 31; float s = 0.f;
#pragma unroll
        for (int q = 0; q < 16; ++q) s += RED[(q * 9 + j) * 32 + c];
        float* mod = (float*)(p.ws + WS_MOD);
        mod[((size_t)l * 9 + j) * 6144 + colbase + c] = s + p.in[lnd(8)][(size_t)l * 6144 + colbase + c]; }
}

__device__ __forceinline__ void s5_mats(const P& p, int l, int g, LAS float* sm) {
    const int tid = tid_();
    LAS float* KF = sm; LAS float* KB = sm + 8192; LAS float* LT = sm + 16384; LAS float* CC = sm + 20608; LAS float* BB = sm + 22656;
    bf16_t* MC = (bf16_t*)(p.ws + WS_R1) + (size_t)g * 512 * 768;
    bf16_t* EM = (bf16_t*)(p.ws + WS_EMAT) + (size_t)g * 256 * 512;
    for (int d = 0; d < 2; ++d) {
        const int pg = (l * 2 + d) * 32 + g;
        const float* lamr = p.in[lnd(15)] + (size_t)pg * 64; const float* lami = p.in[lnd(16)] + (size_t)pg * 64;
        const float dt = expf(p.in[lnd(17)][pg]);
        const float* bre = p.in[lnd(18)] + (size_t)pg * 1024; const float* bim = p.in[lnd(19)] + (size_t)pg * 1024;
        const float* cre = p.in[lnd(20)] + (size_t)pg * 1024; const float* cim = p.in[lnd(21)] + (size_t)pg * 1024;
        for (int i = tid; i < 33 * 64; i += NTHR) { const int tau = i >> 6, pp = i & 63; const float a = expf(lamr[pp] * dt * (float)tau); float s, c; sincosf(lami[pp] * dt * (float)tau, &s, &c); LT[2 * i] = a * c; LT[2 * i + 1] = a * s; }
        for (int i = tid; i < 1024; i += NTHR) { CC[2 * i] = cre[i]; CC[2 * i + 1] = cim[i]; }
        for (int i = tid; i < 1024; i += NTHR) {
            const int pp = i >> 4; const float lr = lamr[pp], li = lami[pp]; float s, c; sincosf(li * dt, &s, &c);
            const float em1 = expm1f(lr * dt); float sh, ch; sincosf(0.5f * li * dt, &sh, &ch);
            const float nr = em1 * c - 2.f * sh * sh, ni = (em1 + 1.f) * s;
            const float inv = 1.f / (lr * lr + li * li);
            const float qr = (nr * lr + ni * li) * inv, qi = (ni * lr - nr * li) * inv;
            const float br = bre[i], bi = bim[i];
            BB[2 * i] = qr * br - qi * bi; BB[2 * i + 1] = qr * bi + qi * br;
        }
        __syncthreads();
        {
            const int tau = tid >> 4, n = tid & 15; float acc[16];
#pragma unroll
            for (int m = 0; m < 16; ++m) acc[m] = 0.f;
            for (int pp = 0; pp < 64; ++pp) {
                const float cr = CC[2 * (n * 64 + pp)], ci = CC[2 * (n * 64 + pp) + 1], lr = LT[2 * (tau * 64 + pp)], li = LT[2 * (tau * 64 + pp) + 1];
                const float xr = cr * lr - ci * li, xi = cr * li + ci * lr;
#pragma unroll
                for (int m = 0; m < 16; ++m) acc[m] += xr * BB[2 * (pp * 16 + m)] - xi * BB[2 * (pp * 16 + m) + 1];
            }
            LAS float* Kd = d ? KB : KF;
#pragma unroll
            for (int m = 0; m < 16; ++m) Kd[(tau * 16 + n) * 16 + m] = acc[m];
        }
        {
            const int pp = tid >> 3, cseg = tid & 7;
#pragma unroll 1
            for (int jj = 0; jj < 4; ++jj) {
                const int j = cseg * 4 + jj, e = d == 0 ? 31 - j : j; const float lr = LT[2 * (e * 64 + pp)], li = LT[2 * (e * 64 + pp) + 1];
                float re[16], im[16];
#pragma unroll
                for (int m = 0; m < 16; ++m) { const float br = BB[2 * (pp * 16 + m)], bi = BB[2 * (pp * 16 + m) + 1]; re[m] = lr * br - li * bi; im[m] = lr * bi + li * br; }
                bf16_t* er = EM + (size_t)(d * 128 + pp) * 512 + j * 16; bf16_t* ei = EM + (size_t)(d * 128 + 64 + pp) * 512 + j * 16;
#pragma unroll
                for (int h = 0; h < 2; ++h) {
                    u32x4 w; w.x = pk_bf16(re[8 * h], re[8 * h + 1]); w.y = pk_bf16(re[8 * h + 2], re[8 * h + 3]); w.z = pk_bf16(re[8 * h + 4], re[8 * h + 5]); w.w = pk_bf16(re[8 * h + 6], re[8 * h + 7]); *(u32x4*)(er + 8 * h) = w;
                    u32x4 x; x.x = pk_bf16(im[8 * h], im[8 * h + 1]); x.y = pk_bf16(im[8 * h + 2], im[8 * h + 3]); x.z = pk_bf16(im[8 * h + 4], im[8 * h + 5]); x.w = pk_bf16(im[8 * h + 6], im[8 * h + 7]); *(u32x4*)(ei + 8 * h) = x;
                }
            }
        }
        {
            const int t = tid >> 4, n = tid & 15, f = d == 0 ? t + 1 : 32 - t;
            bf16_t* mr = MC + (size_t)tid * 768 + 512 + d * 128;
#pragma unroll 1
            for (int p8 = 0; p8 < 8; ++p8) {
                float re[8], im[8];
#pragma unroll
                for (int q = 0; q < 8; ++q) { const int pp = p8 * 8 + q; const float cr = CC[2 * (n * 64 + pp)], ci = CC[2 * (n * 64 + pp) + 1], lr = LT[2 * (f * 64 + pp)], li = LT[2 * (f * 64 + pp) + 1];
                    re[q] = cr * lr - ci * li; im[q] = -(cr * li + ci * lr); }
                u32x4 w; w.x = pk_bf16(re[0], re[1]); w.y = pk_bf16(re[2], re[3]); w.z = pk_bf16(re[4], re[5]); w.w = pk_bf16(re[6], re[7]); *(u32x4*)(mr + p8 * 8) = w;
                u32x4 x; x.x = pk_bf16(im[0], im[1]); x.y = pk_bf16(im[2], im[3]); x.z = pk_bf16(im[4], im[5]); x.w = pk_bf16(im[6], im[7]); *(u32x4*)(mr + 64 + p8 * 8) = x;
            }
        }
        __syncthreads();
    }
    {
        const int t = tid >> 4, n = tid & 15; const float dsk = p.in[lnd(22)][(size_t)l * 512 + g * 16 + n];
        bf16_t* mr = MC + (size_t)tid * 768;
#pragma unroll 1
        for (int j = 0; j < 32; ++j) {
            float v[16];
#pragma unroll
            for (int m = 0; m < 16; ++m) v[m] = 0.f;
            if (j <= t) { const LAS float* k = KF + ((t - j) * 16 + n) * 16;
#pragma unroll
                for (int m = 0; m < 16; ++m) v[m] += k[m]; }
            if (j >= t) { const LAS float* k = KB + ((j - t) * 16 + n) * 16;
#pragma unroll
                for (int m = 0; m < 16; ++m) v[m] += k[m]; }
            if (j == t) {
#pragma unroll
                for (int m = 0; m < 16; ++m) v[m] += (m == n) ? dsk : 0.f; }
            u32x4 w; w.x = pk_bf16(v[0], v[1]); w.y = pk_bf16(v[2], v[3]); w.z = pk_bf16(v[4], v[5]); w.w = pk_bf16(v[6], v[7]); *(u32x4*)(mr + j * 16) = w;
            u32x4 x; x.x = pk_bf16(v[8], v[9]); x.y = pk_bf16(v[10], v[11]); x.z = pk_bf16(v[12], v[13]); x.w = pk_bf16(v[14], v[15]); *(u32x4*)(mr + j * 16 + 8) = x;
        }
    }
}

__device__ __forceinline__ void phase_prep(const P& p, int l, LAS unsigned char* lds) {
    LAS float* sm = (LAS float*)lds;
    const int nmod = (l == 0) ? 384 : 0, total = 32 + nmod + CONV_TILES;
    for (int task = bid_(); task < total; task += gridDim.x) {
        if (task < 32) s5_mats(p, l, task, sm);
        else if (task < 32 + nmod) mod_task(p, task - 32, sm);
        else conv_tile(p, l, task - 32 - nmod, sm);
        __syncthreads();
    }
}

__device__ __forceinline__ void norm_row_write(const f32x4 (&x)[4], const float* g, const float* mod, int shoff, int scoff, bf16_t* hrow, int lane) {
    float ss = 0.f;
#pragma unroll
    for (int i = 0; i < 4; ++i) ss += x[i][0] * x[i][0] + x[i][1] * x[i][1] + x[i][2] * x[i][2] + x[i][3] * x[i][3];
    ss = wave_sum(ss);
    const float rstd = rsqrtf(ss * (1.0f / 1024.0f) + 1e-6f);
#pragma unroll
    for (int i = 0; i < 4; ++i) { const int d = i * 256 + lane * 4; const f32x4 gg = *(const f32x4*)(g + d), sc = *(const f32x4*)(mod + scoff + d), sh = *(const f32x4*)(mod + shoff + d);
        f32x4 h;
#pragma unroll
        for (int e = 0; e < 4; ++e) h[e] = x[i][e] * rstd * gg[e] * (1.f + sc[e]) + sh[e];
        store4bf(hrow + d, h); }
}
__device__ __forceinline__ void phase_norm(const P& p, int l, int which) {
    const int lane = tid_() & 63, gw = bid_() * 8 + (tid_() >> 6), nw = gridDim.x * 8;
    const float* g = (which == 1 ? p.in[lnd(9)] : p.in[lnd(27)]) + (size_t)l * 1024;
    const float* modl = (const float*)(p.ws + WS_MOD) + (size_t)l * 9 * 6144;
    const int shoff = which == 1 ? 0 : 3072, scoff = which == 1 ? 1024 : 4096;
    bf16_t* H = (bf16_t*)(p.ws + WS_R2); float* X = p.out;
    if (which == 1 && l == 0) {
        for (int item = gw; item < 4096 + 8192; item += nw) {
            if (item < 4096) {
                const int n = item; const float rr = (float)(n >> 6), cc = (float)(n & 63); f32x4 pe[4];
#pragma unroll
                for (int e = 0; e < 4; ++e) { const float om = expf(-(float)(lane * 4 + e) * (9.210340371976184f / 256.0f)); float s, c; sincosf(rr * om, &s, &c); pe[0][e] = s; pe[1][e] = c; sincosf(cc * om, &s, &c); pe[2][e] = s; pe[3][e] = c; }
                for (int b = 0; b < 8; ++b) { const int row = TOKP + b * 4096 + n; const float* src = p.in[lnd(1)] + ((size_t)b * 4096 + n) * 1024; f32x4 x[4];
#pragma unroll
                    for (int i = 0; i < 4; ++i) { x[i] = *(const f32x4*)(src + i * 256 + lane * 4) + pe[i]; *(f32x4*)(X + (size_t)row * 1024 + i * 256 + lane * 4) = x[i]; }
                    norm_row_write(x, g, modl + (size_t)(1 + b) * 6144, shoff, scoff, H + (size_t)row * 1024, lane); }
            } else { const int row = item - 4096; const float* src = p.in[lnd(0)] + (size_t)row * 1024; f32x4 x[4];
#pragma unroll
                for (int i = 0; i < 4; ++i) { x[i] = *(const f32x4*)(src + i * 256 + lane * 4); *(f32x4*)(X + (size_t)row * 1024 + i * 256 + lane * 4) = x[i]; }
                norm_row_write(x, g, modl, shoff, scoff, H + (size_t)row * 1024, lane); }
        }
    } else {
        for (int row = gw; row < TOK; row += nw) { f32x4 x[4];
#pragma unroll
            for (int i = 0; i < 4; ++i) x[i] = *(const f32x4*)(X + (size_t)row * 1024 + i * 256 + lane * 4);
            norm_row_write(x, g, modl + (size_t)mod_index(row) * 6144, shoff, scoff, H + (size_t)row * 1024, lane); }
    }
}
__device__ __forceinline__ void phase_final(const P& p) {
    const int lane = tid_() & 63, gw = bid_() * 8 + (tid_() >> 6), nw = gridDim.x * 8; float* X = p.out; const float* g = p.in[lnd(30)];
    for (int row = gw; row < TOK; row += nw) { f32x4 x[4]; float ss = 0.f;
#pragma unroll
        for (int i = 0; i < 4; ++i) { x[i] = *(const f32x4*)(X + (size_t)row * 1024 + i * 256 + lane * 4); ss += x[i][0] * x[i][0] + x[i][1] * x[i][1] + x[i][2] * x[i][2] + x[i][3] * x[i][3]; }
        ss = wave_sum(ss); const float rstd = rsqrtf(ss * (1.0f / 1024.0f) + 1e-6f);
#pragma unroll
        for (int i = 0; i < 4; ++i) { const f32x4 gg = *(const f32x4*)(g + i * 256 + lane * 4); *(f32x4*)(X + (size_t)row * 1024 + i * 256 + lane * 4) = x[i] * rstd * gg; } }
}

__device__ __forceinline__ void phase_s5scan(const P& p, int l) {
    const float* E = (const float*)(p.ws + WS_E); bf16_t* UG = (bf16_t*)(p.ws + WS_R5);
    float* ore = p.out + (size_t)TOK * 1024 + 16777216; float* oim = ore + 262144;
    for (int task = bid_(); task < 320; task += gridDim.x) {
        const int idx = task * NTHR + tid_(), pp = idx & 63, d = (idx >> 6) & 1, g = (idx >> 7) & 31, s = 39 - (idx >> 12);
        const int nch = s < 32 ? 8 : 128, cbase = s < 32 ? s * 8 : 256 + (s - 32) * 128;
        const int pg = (l * 2 + d) * 32 + g; const float dt = expf(p.in[lnd(17)][pg]);
        const float a = expf(p.in[lnd(15)][(size_t)pg * 64 + pp] * dt * 32.f); float sn, cs; sincosf(p.in[lnd(16)][(size_t)pg * 64 + pp] * dt * 32.f, &sn, &cs);
        const float ar = a * cs, ai = a * sn;
        float sr = 0.f, si = 0.f;
        if (s >= 32) { const size_t o = ((((size_t)(s - 32) * 2 + l) * 2 + d) * 32 + g) * 64 + pp; sr = p.in[lnd(4)][o]; si = p.in[lnd(5)][o]; }
        const float* Eb = E + ((size_t)(g * 1280 + cbase) * 256 + d * 128 + pp);
        bf16_t* Ub = UG + ((size_t)(g * 1280 + cbase) * 768 + 512 + d * 128 + pp);
        for (int c0 = 0; c0 < nch; c0 += 8) {
            float er[8], ei[8];
#pragma unroll
            for (int k = 0; k < 8; ++k) { const int c = d == 0 ? c0 + k : nch - 1 - (c0 + k); er[k] = Eb[(size_t)c * 256]; ei[k] = Eb[(size_t)c * 256 + 64]; }
#pragma unroll
            for (int k = 0; k < 8; ++k) { const int c = d == 0 ? c0 + k : nch - 1 - (c0 + k);
                Ub[(size_t)c * 768] = f2bf(sr); Ub[(size_t)c * 768 + 64] = f2bf(si);
                const float nr = ar * sr - ai * si + er[k], ni = ar * si + ai * sr + ei[k]; sr = nr; si = ni; }
        }
        if (s < 32) { const size_t o = ((((size_t)s * 2 + l) * 2 + d) * 32 + g) * 64 + pp; ore[o] = sr; oim[o] = si; }
    }
}

__device__ __forceinline__ void phase_glapre(const P& p, int l, LAS unsigned char* lds) {
    const int tid = tid_(), d = tid & 127, tq = tid >> 7;
    LAS float* sG = (LAS float*)lds; LAS float* sT4 = sG + 2048;
    bf16_t* Q = (bf16_t*)(p.ws + WS_R3); bf16_t* Kk = Q + (size_t)TOK * 512;
    bf16_t* QB = (bf16_t*)(p.ws + WS_R5); bf16_t* KB = QB + (size_t)TOK * 512;
    const float* GLR = (const float*)(p.ws + WS_GLR);
    for (int task = bid_(); task < 2560; task += gridDim.x) {
        const int c64 = task >> 2, h = task & 3, tb = c64 * 64;
        { const int row = tid >> 3, c4 = (tid & 7) * 4; *(LAS f32x4*)(sG + row * 32 + c4) = *(const f32x4*)(GLR + (size_t)(tb + row) * 32 + c4); }
        float qv[16], kv[16];
#pragma unroll
        for (int i = 0; i < 16; ++i) { const size_t o = (size_t)(tb + tq * 16 + i) * 512 + h * 128 + d; qv[i] = bf2f(Q[o]); kv[i] = bf2f(Kk[o]); }
        __syncthreads();
#pragma unroll 1
        for (int dir = 0; dir < 2; ++dir) {
            float w[16];
#pragma unroll
            for (int r = 0; r < 16; ++r) w[r] = p.in[lnd(11)][((size_t)(l * 2 + dir) * 16 + r) * 512 + h * 128 + d];
            const float bg = p.in[lnd(12)][(size_t)(l * 2 + dir) * 512 + h * 128 + d];
            float cum[16];
#pragma unroll
            for (int i = 0; i < 16; ++i) { const LAS float* gr = sG + (tq * 16 + i) * 32 + dir * 16; float z = bg;
#pragma unroll
                for (int r = 0; r < 16; ++r) z += gr[r] * w[r];
                cum[i] = (fminf(z, 0.f) - __logf(1.0f + __expf(-fabsf(z)))) * 0.0625f; }
            if (dir == 0) {
#pragma unroll
                for (int i = 1; i < 16; ++i) cum[i] += cum[i - 1];
            } else {
#pragma unroll
                for (int i = 14; i >= 0; --i) cum[i] += cum[i + 1];
            }
            sT4[tq * 128 + d] = dir == 0 ? cum[15] : cum[0];
            __syncthreads();
            float off = 0.f, total = 0.f;
#pragma unroll
            for (int q = 0; q < 4; ++q) { const float v = sT4[q * 128 + d]; total += v; if (dir == 0 ? (q < tq) : (q > tq)) off += v; }
            bf16_t* QD = dir == 0 ? Q : QB; bf16_t* KI = dir == 0 ? Kk : KB;
#pragma unroll
            for (int i = 0; i < 16; ++i) { const float cm = cum[i] + off; const size_t o = (size_t)(tb + tq * 16 + i) * 512 + h * 128 + d;
                QD[o] = f2bf(qv[i] * __expf(cm)); KI[o] = f2bf(kv[i] * __expf(-cm)); }
            if (tq == 0) ((float*)(p.ws + (dir == 0 ? WS_TOTF : WS_TOTB)))[(size_t)c64 * 512 + h * 128 + d] = total;
            __syncthreads();
        }
    }
}

constexpr int GLA_GRP = 71168;
__device__ __forceinline__ void phase_gla(const P& p, int l, LAS unsigned char* lds) {
    const int tid = tid_(), grp = tid >> 8, gt = tid & 255, wv = (tid >> 6) & 3, lane = tid & 63, fr = lane & 15, fq = lane >> 4;
    LAS unsigned char* gl = lds + grp * GLA_GRP;
    LAS bf16_t* sQ = (LAS bf16_t*)gl; LAS bf16_t* sK = (LAS bf16_t*)(gl + 17408); LAS bf16_t* sV = (LAS bf16_t*)(gl + 34816);
    LAS bf16_t* sP = (LAS bf16_t*)(gl + 44032); LAS bf16_t* sS = (LAS bf16_t*)(gl + 53248); LAS float* sTot = (LAS float*)(gl + 70656);
    const bf16_t* QD = grp == 0 ? (const bf16_t*)(p.ws + WS_R3) : (const bf16_t*)(p.ws + WS_R5);
    const bf16_t* KI = QD + (size_t)TOK * 512;
    const bf16_t* V = (const bf16_t*)(p.ws + WS_R4);
    const float* TOT = (const float*)(p.ws + (grp == 0 ? WS_TOTF : WS_TOTB));
    bf16_t* O = (bf16_t*)(p.ws + WS_R1);
    float* OST = p.out + (size_t)TOK * 1024;
    const int G = gridDim.x, b = bid_();
    const bool custom = (G == 256);
    const int ntask_mine = custom ? (b < 128 ? 1 : 4) : ((640 - b + G - 1) / G);
    for (int ti = 0; ti < ntask_mine; ++ti) {
        const int task = custom ? (b < 128 ? b : b + 128 * ti) : b + G * ti;
        if (task >= 640) break;
        const bool sample = task < 128;
        const int t2 = sample ? task : task - 128, sb = t2 >> 4, h = (t2 >> 2) & 3, vs = t2 & 3;
        const int base = sample ? TOKP + sb * 4096 : sb * 256, nch = sample ? 64 : 4;
        f32x4 accS[4][2];
#pragma unroll
        for (int vt = 0; vt < 4; ++vt)
#pragma unroll
            for (int dt = 0; dt < 2; ++dt) {
                f32x4 a = (f32x4){0.f, 0.f, 0.f, 0.f};
                if (sample) { const int dd = 16 * (2 * wv + dt) + fr; const float* cp = p.in[lnd(3)] + (((((size_t)sb * 2 + l) * 2 + grp) * 4 + h) * 128 + dd) * 256 + vs * 64 + 16 * vt + 4 * fq; a = *(const f32x4*)cp; }
                accS[vt][dt] = a;
#pragma unroll
                for (int e = 0; e < 4; ++e) sS[(16 * vt + 4 * fq + e) * 136 + 16 * (2 * wv + dt) + fr] = f2bf(a[e]);
            }
        u32x4 rq[4], rk[4], rv[2]; float rt = 0.f;
#define GLA_LOAD(ci) do { const int tb_ = base + (ci) * 64; \
        _Pragma("unroll") for (int i = 0; i < 4; ++i) { const int idx = gt + 256 * i, row = idx >> 4, c16 = idx & 15; const size_t o = (size_t)(tb_ + row) * 512 + h * 128 + c16 * 8; rq[i] = *(const u32x4*)(QD + o); rk[i] = *(const u32x4*)(KI + o); } \
        _Pragma("unroll") for (int i = 0; i < 2; ++i) { const int idx = gt + 256 * i, row = idx >> 3, c8 = idx & 7; rv[i] = *(const u32x4*)(V + (size_t)(tb_ + row) * 1024 + h * 256 + vs * 64 + c8 * 8); } \
        if (gt < 128) rt = TOT[(size_t)(tb_ >> 6) * 512 + h * 128 + gt]; } while (0)
#define GLA_STORE() do { \
        _Pragma("unroll") for (int i = 0; i < 4; ++i) { const int idx = gt + 256 * i, row = idx >> 4, c16 = idx & 15; *(LAS u32x4*)(sQ + row * 136 + c16 * 8) = rq[i]; *(LAS u32x4*)(sK + row * 136 + c16 * 8) = rk[i]; } \
        _Pragma("unroll") for (int i = 0; i < 2; ++i) { const int idx = gt + 256 * i, row = idx >> 3, c8 = idx & 7; *(LAS u32x4*)(sV + row * 72 + c8 * 8) = rv[i]; } \
        if (gt < 128) sTot[gt] = rt; } while (0)
        GLA_LOAD(grp == 0 ? 0 : nch - 1);
        GLA_STORE();
        __syncthreads();
        for (int s = 0; s < nch; ++s) {
            const int ci = grp == 0 ? s : nch - 1 - s, tb = base + ci * 64;
            const bool second = (s >= (nch >> 1));
            if (s + 1 < nch) GLA_LOAD(grp == 0 ? s + 1 : nch - 2 - s);
#pragma unroll
            for (int jt = 0; jt < 4; ++jt) {
                f32x4 acc = (f32x4){0.f, 0.f, 0.f, 0.f};
                const bool skip = grp == 0 ? (jt > wv) : (jt < wv);
                if (!skip) {
#pragma unroll
                    for (int ks = 0; ks < 4; ++ks) { const bf16x8 a = *(const LAS bf16x8*)(sQ + (16 * wv + fr) * 136 + 32 * ks + 8 * fq); const bf16x8 bb = *(const LAS bf16x8*)(sK + (16 * jt + fr) * 136 + 32 * ks + 8 * fq);
                        acc = __builtin_amdgcn_mfma_f32_16x16x32_bf16(a, bb, acc, 0, 0, 0); }
                }
#pragma unroll
                for (int e = 0; e < 4; ++e) { const int i = 16 * wv + 4 * fq + e, j = 16 * jt + fr; const bool keep = grp == 0 ? (j <= i) : (j >= i); sP[i * 72 + j] = f2bf(keep ? acc[e] : 0.f); }
            }
            __syncthreads();
            bf16x8 vf[4][2];
#pragma unroll
            for (int vt = 0; vt < 4; ++vt)
#pragma unroll
                for (int ks = 0; ks < 2; ++ks)
#pragma unroll
                    for (int e = 0; e < 8; ++e) vf[vt][ks][e] = (short)sV[(32 * ks + 8 * fq + e) * 72 + 16 * vt + fr];
#pragma unroll
            for (int it = 0; it < 4; ++it) {
                f32x4 acc = (f32x4){0.f, 0.f, 0.f, 0.f};
#pragma unroll
                for (int ks = 0; ks < 2; ++ks) { const bf16x8 a = *(const LAS bf16x8*)(sP + (16 * it + fr) * 72 + 32 * ks + 8 * fq);
                    bf16x8 bsel = vf[0][ks];
                    if (wv == 1) bsel = vf[1][ks]; else if (wv == 2) bsel = vf[2][ks]; else if (wv == 3) bsel = vf[3][ks];
                    acc = __builtin_amdgcn_mfma_f32_16x16x32_bf16(a, bsel, acc, 0, 0, 0); }
#pragma unroll
                for (int ks = 0; ks < 4; ++ks) { const bf16x8 a = *(const LAS bf16x8*)(sQ + (16 * it + fr) * 136 + 32 * ks + 8 * fq); const bf16x8 bb = *(const LAS bf16x8*)(sS + (16 * wv + fr) * 136 + 32 * ks + 8 * fq);
                    acc = __builtin_amdgcn_mfma_f32_16x16x32_bf16(a, bb, acc, 0, 0, 0); }
#pragma unroll
                for (int e = 0; e < 4; ++e) { bf16_t* op = O + (size_t)(tb + 16 * it + 4 * fq + e) * 1024 + h * 256 + vs * 64 + 16 * wv + fr; float val = acc[e]; if (second) val += bf2f(*op); *op = f2bf(val); }
            }
#pragma unroll
            for (int dt = 0; dt < 2; ++dt) {
                bf16x8 kf[2];
#pragma unroll
                for (int ks = 0; ks < 2; ++ks)
#pragma unroll
                    for (int e = 0; e < 8; ++e) kf[ks][e] = (short)sK[(32 * ks + 8 * fq + e) * 136 + 16 * (2 * wv + dt) + fr];
                const float sc = __expf(sTot[16 * (2 * wv + dt) + fr]);
#pragma unroll
                for (int vt = 0; vt < 4; ++vt) {
#pragma unroll
                    for (int ks = 0; ks < 2; ++ks) accS[vt][dt] = __builtin_amdgcn_mfma_f32_16x16x32_bf16(vf[vt][ks], kf[ks], accS[vt][dt], 0, 0, 0);
                    accS[vt][dt] = accS[vt][dt] * sc;
                }
            }
            __syncthreads();
#pragma unroll
            for (int vt = 0; vt < 4; ++vt)
#pragma unroll
                for (int dt = 0; dt < 2; ++dt)
#pragma unroll
                    for (int e = 0; e < 4; ++e) sS[(16 * vt + 4 * fq + e) * 136 + 16 * (2 * wv + dt) + fr] = f2bf(accS[vt][dt][e]);
            if (s + 1 < nch) GLA_STORE();
            __syncthreads();
        }
        if (!sample) {
#pragma unroll
            for (int vt = 0; vt < 4; ++vt)
#pragma unroll
                for (int dt = 0; dt < 2; ++dt) { const int dd = 16 * (2 * wv + dt) + fr; float* op = OST + (((((size_t)sb * 2 + l) * 2 + grp) * 4 + h) * 128 + dd) * 256 + vs * 64 + 16 * vt + 4 * fq; *(f32x4*)op = accS[vt][dt]; }
        }
    }
#undef GLA_LOAD
#undef GLA_STORE
}

__device__ __forceinline__ void phase_glapost(const P& p, int l) {
    const int lane = tid_() & 63, gw = bid_() * 8 + (tid_() >> 6), nw = gridDim.x * 8;
    bf16_t* O = (bf16_t*)(p.ws + WS_R1); const bf16_t* R = (const bf16_t*)(p.ws + WS_R3);
    const float* gn = p.in[lnd(13)] + (size_t)l * 256 + (lane & 15) * 16;
    for (int row = gw; row < TOK; row += nw) {
        const size_t o = (size_t)row * 1024 + lane * 16; float x[16], r[16];
#pragma unroll
        for (int hh = 0; hh < 2; ++hh) { const u32x4 a = *(const u32x4*)(O + o + 8 * hh), c = *(const u32x4*)(R + o + 8 * hh);
            x[8 * hh + 0] = bflo(a.x); x[8 * hh + 1] = bfhi(a.x); x[8 * hh + 2] = bflo(a.y); x[8 * hh + 3] = bfhi(a.y); x[8 * hh + 4] = bflo(a.z); x[8 * hh + 5] = bfhi(a.z); x[8 * hh + 6] = bflo(a.w); x[8 * hh + 7] = bfhi(a.w);
            r[8 * hh + 0] = bflo(c.x); r[8 * hh + 1] = bfhi(c.x); r[8 * hh + 2] = bflo(c.y); r[8 * hh + 3] = bfhi(c.y); r[8 * hh + 4] = bflo(c.z); r[8 * hh + 5] = bfhi(c.z); r[8 * hh + 6] = bflo(c.w); r[8 * hh + 7] = bfhi(c.w); }
        float ss = 0.f;
#pragma unroll
        for (int e = 0; e < 16; ++e) ss += x[e] * x[e];
        ss += __shfl_xor(ss, 1); ss += __shfl_xor(ss, 2); ss += __shfl_xor(ss, 4); ss += __shfl_xor(ss, 8);
        const float rstd = rsqrtf(ss * (1.0f / 256.0f) + 1e-6f);
        float y[16];
#pragma unroll
        for (int e = 0; e < 16; ++e) y[e] = x[e] * rstd * gn[e] * r[e];
#pragma unroll
        for (int hh = 0; hh < 2; ++hh) { u32x4 w; w.x = pk_bf16(y[8 * hh], y[8 * hh + 1]); w.y = pk_bf16(y[8 * hh + 2], y[8 * hh + 3]); w.z = pk_bf16(y[8 * hh + 4], y[8 * hh + 5]); w.w = pk_bf16(y[8 * hh + 6], y[8 * hh + 7]); *(u32x4*)(O + o + 8 * hh) = w; }
    }
}

__device__ __forceinline__ void run_phase(const P& p, int ph, LAS unsigned char* lds) {
    if (ph == 2 * PPL) { if (EN(34)) phase_final(p); return; }
    const int l = ph / PPL, q = ph % PPL;
    unsigned char* ws = p.ws; bf16_t* W = (bf16_t*)(ws + WS_W);
    const int G = gridDim.x, c = bid_();
    pg8::Order S;
    switch (q) {
        case 0: if (EN(0)) phase_prep(p, l, lds); break;
        case 1: if (EN(1)) phase_norm(p, l, 1); break;
        case 2: if (EN(2)) { pg8::Gemm g{(const bf16_t*)(ws + WS_R2), W + W_A / 2, TOK, 2816, 1024, 1024, 0, 0, 1}; S.init(TOK, 2816, 1, G, c);
            EpiPartA E{(bf16_t*)(ws + WS_R3), (bf16_t*)(ws + WS_R3) + (size_t)TOK * 512, (bf16_t*)(ws + WS_R4), (bf16_t*)(ws + WS_R5), (float*)(ws + WS_GLR)};
            pg8::gemm_phase(lds, g, S, E); } break;
        case 3: if (EN(3)) { pg8::Gemm g{(const bf16_t*)(ws + WS_R5), (const bf16_t*)(ws + WS_EMAT), 1280, 256, 512, 768, (size_t)1280 * 768, (size_t)256 * 512, 32}; S.init(1280, 256, 32, G, c);
            EpiE E{(float*)(ws + WS_E)}; pg8::gemm_phase(lds, g, S, E); } break;
        case 4: if (EN(4)) phase_s5scan(p, l); break;
        case 5: if (EN(5)) { pg8::Gemm g{(const bf16_t*)(ws + WS_R5), (const bf16_t*)(ws + WS_R1), 1280, 512, 768, 768, (size_t)1280 * 768, (size_t)512 * 768, 32}; S.init(1280, 512, 32, G, c);
            EpiY E{(bf16_t*)(ws + WS_E)}; pg8::gemm_phase(lds, g, S, E); } break;
        case 6: if (EN(6)) { pg8::Gemm g{(const bf16_t*)(ws + WS_E), W + W_GLU / 2, TOK, 512, 512, 512, 0, 0, 1}; S.init(TOK, 512, 1, G, c);
            EpiGLU E{(const bf16_t*)(ws + WS_E), (bf16_t*)(ws + WS_R6), p.in[lnd(24)] + (size_t)l * 512}; pg8::gemm_phase(lds, g, S, E); } break;
        case 7: if (EN(7)) phase_glapre(p, l, lds); break;
        case 8: if (EN(8)) phase_gla(p, l, lds); break;
        case 9: if (EN(9)) { pg8::Gemm g{(const bf16_t*)(ws + WS_R2), W + W_B / 2, TOK, 3072, 1024, 1024, 0, 0, 1}; S.init(TOK, 3072, 1, G, c);
            EpiPartB E{(bf16_t*)(ws + WS_R3), (bf16_t*)(ws + WS_R4), (bf16_t*)(ws + WS_R5)}; pg8::gemm_phase(lds, g, S, E); } break;
        case 10: if (EN(10)) phase_glapost(p, l); break;
        case 11: if (EN(11)) { pg8::Gemm g{(const bf16_t*)(ws + WS_R1), W + W_PG / 2, TOK, 1024, 1024, 1024, 0, 0, 1}; S.init(TOK, 1024, 1, G, c);
              EpiProj1 E{(const bf16_t*)(ws + WS_R4), (bf16_t*)(ws + WS_R2)}; pg8::gemm_phase(lds, g, S, E); } break;
        case 12: if (EN(12)) { pg8::Gemm g{(const bf16_t*)(ws + WS_R6), W + W_PS / 2, TOK, 1024, 512, 512, 0, 0, 1}; S.init(TOK, 1024, 1, G, c);
              EpiProj2 E{(const bf16_t*)(ws + WS_R5), (bf16_t*)(ws + WS_R2)}; pg8::gemm_phase(lds, g, S, E); } break;
        case 13: if (EN(13)) { pg8::Gemm g{(const bf16_t*)(ws + WS_R2), W + W_OUT / 2, TOK, 1024, 1024, 1024, 0, 0, 1}; S.init(TOK, 1024, 1, G, c);
            EpiRes E{p.out, (const float*)(ws + WS_MOD) + (size_t)l * 9 * 6144 + 2048}; pg8::gemm_phase(lds, g, S, E); } break;
        case 14: if (EN(14)) phase_norm(p, l, 2); break;
        case 15: if (EN(15)) { pg8::Gemm g{(const bf16_t*)(ws + WS_R2), W + W_1 / 2, TOK, 4096, 1024, 1024, 0, 0, 1}; S.init(TOK, 4096, 1, G, c);
            EpiFF1 E{(bf16_t*)(ws + WS_HID)}; pg8::gemm_phase(lds, g, S, E); } break;
        case 16: if (EN(16)) { pg8::Gemm g{(const bf16_t*)(ws + WS_HID), W + W_2 / 2, TOK, 1024, 4096, 4096, 0, 0, 1}; S.init(TOK, 1024, 1, G, c);
            EpiRes E{p.out, (const float*)(ws + WS_MOD) + (size_t)l * 9 * 6144 + 5120}; pg8::gemm_phase(lds, g, S, E); } break;
        default: break;
    }
}

__global__ void __launch_bounds__(NTHR, 2) fwd_megakernel(P p) {
    extern __shared__ __attribute__((aligned(16))) unsigned char lds_raw[];
    LAS unsigned char* lds = (LAS unsigned char*)lds_raw;
#if MULTI_LAUNCH
    for (int ph = p.ph_lo; ph < p.ph_hi; ++ph) run_phase(p, ph, lds);
#else
    cg::grid_group grid = cg::this_grid();
    for (int ph = p.ph_lo; ph < p.ph_hi; ++ph) {
        run_phase(p, ph, lds);
        if (ph + 1 < p.ph_hi && (ph % PPL) != 11) grid.sync();
    }
#endif
}

extern "C" void kernel_launch(void* const* d_in, const int* in_sizes, int n_in, void* d_out, int out_size, void* d_ws, size_t ws_size, hipStream_t stream) {
    static int grid = 0;
    if (grid == 0) {
        if (n_in != 31 || ws_size < WS_END) { fprintf(stderr, "kernel_launch: unexpected n_in %d or ws_size %zu (< %zu)\n", n_in, ws_size, (size_t)WS_END); grid = -1; return; }
        int dev = 0, cus = 0, per_cu = 0;
        hipGetDevice(&dev);
        hipDeviceGetAttribute(&cus, hipDeviceAttributeMultiprocessorCount, dev);
        if (hipFuncSetAttribute((const void*)fwd_megakernel, hipFuncAttributeMaxDynamicSharedMemorySize, LDS_BYTES) != hipSuccess) { fprintf(stderr, "kernel_launch: hipFuncSetAttribute failed\n"); grid = -1; return; }
        hipOccupancyMaxActiveBlocksPerMultiprocessor(&per_cu, (const void*)fwd_megakernel, NTHR, LDS_BYTES);
        (void)hipGetLastError();
        if (per_cu < 1) fprintf(stderr, "kernel_launch: occupancy query says %d blocks per CU\n", per_cu);
        grid = cus > 0 ? cus : 256;
    }
    if (grid < 0) return;
    P p{};
    for (int i = 0; i < 31; ++i) p.in[i] = (const float*)d_in[i];
    p.out = (float*)d_out; p.ws = (unsigned char*)d_ws;
#if MULTI_LAUNCH
    for (int ph = 0; ph < NPHASE; ++ph) { p.ph_lo = ph; p.ph_hi = ph + 1; hipLaunchKernelGGL(fwd_megakernel, dim3(grid), dim3(NTHR), LDS_BYTES, stream, p); }
#else
    p.ph_lo = 0; p.ph_hi = NPHASE;
    void* args[] = {&p};
    hipError_t e = hipLaunchCooperativeKernel((const void*)fwd_megakernel, dim3(grid), dim3(NTHR), args, LDS_BYTES, stream);
    if (e != hipSuccess) fprintf(stderr, "cooperative launch failed: %s (grid %d)\n", hipGetErrorString(e), grid);
#endif
}
```

```cpp
#include <hip/hip_runtime.h>
#include <hip/hip_cooperative_groups.h>
#include <cstdio>
namespace cg = cooperative_groups;

#ifndef MULTI_LAUNCH
#define MULTI_LAUNCH 0
#endif

#ifndef REP_MASK
#define REP_MASK 0
#endif
#ifndef PHASE_SEL
#define PHASE_SEL -1
#endif
#define EN(q) (PHASE_SEL < 0 || PHASE_SEL == (q))
#define LAS __attribute__((address_space(3)))
typedef unsigned short bf16_t;
typedef short bf16x8 __attribute__((ext_vector_type(8)));
typedef float f32x4 __attribute__((ext_vector_type(4)));
typedef unsigned u32x4 __attribute__((ext_vector_type(4)));
typedef unsigned u32x2 __attribute__((ext_vector_type(2)));

constexpr int NTHR = 512;
constexpr int TOK = 40960, TOKP = 8192;
constexpr int LDS_BYTES = 147456;
constexpr int NPHASE = 35;
constexpr int PPL = 17;

constexpr size_t MiB = (size_t)1 << 20;
constexpr size_t WS_MOD = 0;
constexpr size_t WS_GLR = 1 * MiB;
constexpr size_t WS_TOTF = 7 * MiB;
constexpr size_t WS_TOTB = 9 * MiB;
constexpr size_t WS_BAR = 12 * MiB;
constexpr size_t WS_W = 16 * MiB;
constexpr size_t W_A = 0;
constexpr size_t W_B = W_A + (size_t)2816 * 1024 * 2;
constexpr size_t W_PG = W_B + (size_t)3072 * 1024 * 2;
constexpr size_t W_GLU = W_PG + (size_t)1024 * 1024 * 2;
constexpr size_t W_PS = W_GLU + (size_t)512 * 512 * 2;
constexpr size_t W_OUT = W_PS + (size_t)1024 * 512 * 2;
constexpr size_t W_1 = W_OUT + (size_t)1024 * 1024 * 2;
constexpr size_t W_2 = W_1 + (size_t)4096 * 1024 * 2;
constexpr size_t WS_R2 = 50 * MiB;
constexpr size_t WS_R3 = 130 * MiB;
constexpr size_t WS_R4 = 210 * MiB;
constexpr size_t WS_R5 = 290 * MiB;
constexpr size_t WS_E = 350 * MiB;
constexpr size_t WS_R6 = 390 * MiB;
constexpr size_t WS_R1 = 430 * MiB;
constexpr size_t WS_EMAT = 454 * MiB;
constexpr size_t WS_HID = 130 * MiB;
constexpr size_t WS_END = 510 * MiB;

struct P { const float* in[31]; float* out; unsigned char* ws; int ph_lo, ph_hi; };

__device__ __forceinline__ int tid_() { int t = threadIdx.x; asm volatile("" : "+v"(t)); return t; }
__device__ __forceinline__ int bid_() { int b = blockIdx.x; asm volatile("" : "+s"(b)); return b; }
__device__ __forceinline__ int lnd(int k) { asm volatile("" : "+s"(k)); return k; }
__device__ __forceinline__ unsigned pk_bf16(float lo, float hi) { unsigned r; asm("v_cvt_pk_bf16_f32 %0, %1, %2" : "=v"(r) : "v"(lo), "v"(hi)); return r; }
__device__ __forceinline__ float bf2f(bf16_t b) { return __uint_as_float(((unsigned)b) << 16); }
__device__ __forceinline__ float bflo(unsigned w) { return __uint_as_float(w << 16); }
__device__ __forceinline__ float bfhi(unsigned w) { return __uint_as_float(w & 0xffff0000u); }
__device__ __forceinline__ bf16_t f2bf(float f) { return (bf16_t)(pk_bf16(f, 0.f) & 0xffffu); }
__device__ __forceinline__ float sigmoidf_(float x) { return 1.0f / (1.0f + __expf(-x)); }
__device__ __forceinline__ void store4bf(bf16_t* ptr, f32x4 v) { u32x2 w; w.x = pk_bf16(v[0], v[1]); w.y = pk_bf16(v[2], v[3]); *(u32x2*)ptr = w; }
__device__ __forceinline__ f32x4 load4bf(const bf16_t* ptr) { u32x2 w = *(const u32x2*)ptr; return (f32x4){bflo(w.x), bfhi(w.x), bflo(w.y), bfhi(w.y)}; }
__device__ __forceinline__ int mod_index(int tok) { return tok < TOKP ? 0 : (tok >> 12) - 1; }
__device__ __forceinline__ float wave_sum(float v) {
#pragma unroll
    for (int o = 32; o >= 1; o >>= 1) v += __shfl_xor(v, o);
    return v;
}

namespace pg8 {
constexpr int BM = 256, BK = 64, HALF = 128, HTB = HALF * BK * 2, STAGE_BYTES = 8 * HTB, NXCD = 8, WGM = 8;
__device__ __forceinline__ int lds_byte(int r, int c) { const int st = (r >> 4) * 2 + (c >> 5), rr = r & 15, cc = c & 31, ob = rr * 64 + cc * 2; return st * 1024 + (ob ^ (((ob >> 9) & 1) << 5)); }
__device__ __forceinline__ void stage_rc(int b, int& R, int& C) { const int st = b / 1024, sb = b % 1024, swz = sb ^ (((sb >> 9) & 1) << 5); R = (st >> 1) * 16 + swz / 64; C = (st & 1) * 32 + (swz % 64) / 2; }

struct Unit { int pm, pn, z; };
struct Gemm { const bf16_t* A; const bf16_t* Bt; int M, N, K, lda; size_t sA, sB; int nz; };
struct Order {
    int nM, nN, nwg, G, c, nz;
    __device__ void init(int M, int N, int nz_, int G_, int c_) { nM = M / BM; nN = N / BM; nwg = nM * nN; G = G_; c = c_; nz = nz_; }
    __device__ bool next(int i, Unit& u) const {
        const long L = (long)i * G + c; if (L >= (long)nwg * nz) return false;
        if (nz == 1) {
            int wgid = (int)L; { const int q = nwg / NXCD, r = nwg % NXCD, xcd = wgid % NXCD, off = wgid / NXCD; wgid = (xcd < r ? xcd * (q + 1) : r * (q + 1) + (xcd - r) * q) + off; }
            const int nig = WGM * nN, gid = wgid / nig, fm = gid * WGM, gsz = (nM - fm) < WGM ? (nM - fm) : WGM;
            u.pm = fm + ((wgid % nig) % gsz); u.pn = (wgid % nig) / gsz; u.z = 0;
        } else {
            const int z = (int)(L / nwg), r = (int)(L % nwg); u.z = z; u.pm = r % nM; u.pn = r / nM;
        }
        return true;
    }
};

template <class Epi>
__device__ __forceinline__ void gemm_phase(LAS unsigned char* lds, const Gemm g, const Order& S, const Epi& E) {
    const int tid = tid_(), wid = __builtin_amdgcn_readfirstlane(tid >> 6), lane = tid & 63, wr = wid >> 2, wc = wid & 3, fr = lane & 15, fq = lane >> 4;
    const int K = g.K, nt = K / BK;
    unsigned voffA[2], voffB[2];
#pragma unroll
    for (int i = 0; i < 2; ++i) { int R, C; stage_rc(tid * 16 + i * 8192, R, C); voffA[i] = (unsigned)(R * g.lda + C) * 2u; voffB[i] = (unsigned)(R * K + C) * 2u; }
    const size_t kstep = (size_t)(BK * 2);
    const size_t hstepA = (size_t)HALF * g.lda * 2, hstepB = (size_t)HALF * K * 2;
    const unsigned ldsw = (unsigned)wid * 1024u;
    const int aoff = lds_byte(wr * 64 + fr, fq * 8), boff = lds_byte(wc * 32 + fr, fq * 8);
#define PG8_SA(b, h) (((b) * 2 + (h)) * HTB)
#define PG8_SB(b, h) ((4 + (b) * 2 + (h)) * HTB)
#define PG8_STAGE(bufoff, gbase, voff) do { _Pragma("unroll") for (int _i = 0; _i < 2; ++_i) \
        __builtin_amdgcn_global_load_lds((const unsigned*)((const char*)(gbase) + (voff)[_i]), (LAS unsigned*)(lds + (bufoff) + ldsw + _i * 8192), 16, 0, 0); } while (0)
#define PG8_LDA(dst, b, h) do { _Pragma("unroll") for (int m = 0; m < 4; ++m) _Pragma("unroll") for (int k = 0; k < 2; ++k) dst[m][k] = *(const LAS bf16x8*)(lds + PG8_SA(b, h) + aoff + m * 2048 + k * 1024); } while (0)
#define PG8_LDB(dst, b, h) do { _Pragma("unroll") for (int n = 0; n < 2; ++n) _Pragma("unroll") for (int k = 0; k < 2; ++k) dst[n][k] = *(const LAS bf16x8*)(lds + PG8_SB(b, h) + boff + n * 2048 + k * 1024); } while (0)
#define PG8_MMA(ai, bj, At, Bt) do { __builtin_amdgcn_s_setprio(1); _Pragma("unroll") for (int m = 0; m < 4; ++m) _Pragma("unroll") for (int n = 0; n < 2; ++n) _Pragma("unroll") for (int k = 0; k < 2; ++k) \
        acc[ai][bj][m][n] = __builtin_amdgcn_mfma_f32_16x16x32_bf16(Bt[n][k], At[m][k], acc[ai][bj][m][n], 0, 0, 0); __builtin_amdgcn_s_setprio(0); } while (0)
#define PG8_WAIT_V(n) asm volatile("s_waitcnt vmcnt(" #n ")" ::: "memory")
#define PG8_WAIT_L(n) asm volatile("s_waitcnt lgkmcnt(" #n ")" ::: "memory")
#define PG8_BAR __builtin_amdgcn_s_barrier()
#define PG8_SCHED __builtin_amdgcn_sched_barrier(0)
    Unit cur, nxt; int ui = 0;
    if (!S.next(0, cur)) return;
    f32x4 acc[2][2][4][2];
#pragma unroll
    for (int a = 0; a < 2; ++a)
#pragma unroll
        for (int b = 0; b < 2; ++b)
#pragma unroll
            for (int m = 0; m < 4; ++m)
#pragma unroll
                for (int n = 0; n < 2; ++n) acc[a][b][m][n] = (f32x4){0.f, 0.f, 0.f, 0.f};
    bf16x8 At[4][2], B0[2][2], B1[2][2];
    const char* cA = (const char*)g.A + ((size_t)cur.z * g.sA + (size_t)cur.pm * BM * g.lda) * 2;
    const char* cB = (const char*)g.Bt + ((size_t)cur.z * g.sB + (size_t)cur.pn * BM * K) * 2;
    PG8_STAGE(PG8_SB(0, 0), cB, voffB); PG8_STAGE(PG8_SB(0, 1), cB + hstepB, voffB); PG8_STAGE(PG8_SA(0, 0), cA, voffA); PG8_STAGE(PG8_SA(0, 1), cA + hstepA, voffA);
    if (wr == 1) PG8_BAR;
    PG8_WAIT_V(2); PG8_BAR;
    PG8_STAGE(PG8_SB(1, 0), cB + kstep, voffB); PG8_STAGE(PG8_SA(1, 0), cA + kstep, voffA); PG8_STAGE(PG8_SB(1, 1), cB + hstepB + kstep, voffB);
    PG8_WAIT_V(6); PG8_BAR;
    for (;;) {
        const bool has_next = S.next(ui + 1, nxt);
        const char* nA = has_next ? (const char*)g.A + ((size_t)nxt.z * g.sA + (size_t)nxt.pm * BM * g.lda) * 2 : cA;
        const char* nB = has_next ? (const char*)g.Bt + ((size_t)nxt.z * g.sB + (size_t)nxt.pn * BM * K) * 2 : cB;
        for (int t = 0; t < nt; t += 2) {
            const bool last = (t == nt - 2);
            const char* a1 = cA + (size_t)(t + 1) * kstep;
            const char* a2 = last ? nA : cA + (size_t)(t + 2) * kstep; const char* b2 = last ? nB : cB + (size_t)(t + 2) * kstep;
            const char* a3 = a2 + kstep; const char* b3 = b2 + kstep;
            PG8_LDB(B0, 0, 0); PG8_LDB(B1, 0, 1); PG8_SCHED; PG8_LDA(At, 0, 0); PG8_STAGE(PG8_SA(1, 1), a1 + hstepA, voffA);
            PG8_WAIT_V(8); PG8_WAIT_L(0); PG8_BAR; PG8_MMA(0, 0, At, B0); PG8_MMA(0, 1, At, B1); PG8_BAR; PG8_SCHED;
            PG8_LDA(At, 0, 1); PG8_STAGE(PG8_SB(0, 0), b2, voffB); PG8_STAGE(PG8_SB(0, 1), b2 + hstepB, voffB); PG8_STAGE(PG8_SA(0, 0), a2, voffA);
            PG8_WAIT_V(8); PG8_WAIT_L(0); PG8_BAR; PG8_MMA(1, 0, At, B0); PG8_MMA(1, 1, At, B1); PG8_BAR; PG8_SCHED;
            PG8_LDB(B0, 1, 0); PG8_LDB(B1, 1, 1); PG8_SCHED; PG8_LDA(At, 1, 0); PG8_STAGE(PG8_SA(0, 1), a2 + hstepA, voffA);
            PG8_WAIT_V(8); PG8_WAIT_L(0); PG8_BAR; PG8_MMA(0, 0, At, B0); PG8_MMA(0, 1, At, B1); PG8_BAR; PG8_SCHED;
            PG8_LDA(At, 1, 1); PG8_STAGE(PG8_SB(1, 0), b3, voffB); PG8_STAGE(PG8_SB(1, 1), b3 + hstepB, voffB); PG8_STAGE(PG8_SA(1, 0), a3, voffA);
            PG8_WAIT_V(8); PG8_WAIT_L(0); PG8_BAR; PG8_MMA(1, 0, At, B0); PG8_MMA(1, 1, At, B1); PG8_BAR; PG8_SCHED;
        }
        if (wr == 0) PG8_BAR;
        E.tile(acc, cur.z, cur.pm * BM + wr * 64 + fr, cur.pn * BM + wc * 32 + 4 * fq);
        if (!has_next) break;
#pragma unroll
        for (int a = 0; a < 2; ++a)
#pragma unroll
            for (int b = 0; b < 2; ++b)
#pragma unroll
                for (int m = 0; m < 4; ++m)
#pragma unroll
                    for (int n = 0; n < 2; ++n) acc[a][b][m][n] = (f32x4){0.f, 0.f, 0.f, 0.f};
        cur = nxt; cA = nA; cB = nB; ++ui;
        if (wr == 1) PG8_BAR;
    }
    PG8_WAIT_V(0);
    PG8_BAR;
#undef PG8_SA
#undef PG8_SB
#undef PG8_STAGE
#undef PG8_LDA
#undef PG8_LDB
#undef PG8_MMA
#undef PG8_WAIT_V
#undef PG8_WAIT_L
#undef PG8_BAR
#undef PG8_SCHED
}
}

#define EPI_SIMPLE_TILE() \
    __device__ __forceinline__ void tile(const f32x4 (&acc)[2][2][4][2], int z, int row0, int col0) const { \
        _Pragma("unroll") for (int ai = 0; ai < 2; ++ai) _Pragma("unroll") for (int m = 0; m < 4; ++m) _Pragma("unroll") for (int bj = 0; bj < 2; ++bj) _Pragma("unroll") for (int n = 0; n < 2; ++n) \
            (*this)(z, row0 + ai * 128 + m * 16, col0 + bj * 128 + n * 16, acc[ai][bj][m][n]); }
#define EPI_PIPE_TILE() \
    __device__ __forceinline__ void tile(const f32x4 (&acc)[2][2][4][2], int z, int row0, int col0) const { \
        Pre pre; begin(row0, col0, pre); L buf[2][8]; \
        _Pragma("unroll") for (int mm = 0; mm < 2; ++mm) _Pragma("unroll") for (int bj = 0; bj < 2; ++bj) _Pragma("unroll") for (int n = 0; n < 2; ++n) load(row0 + mm * 16, col0 + bj * 128 + n * 16, buf[0][mm * 4 + bj * 2 + n]); \
        _Pragma("unroll") for (int b = 0; b < 4; ++b) { \
            if (b < 3) { _Pragma("unroll") for (int mm = 0; mm < 2; ++mm) _Pragma("unroll") for (int bj = 0; bj < 2; ++bj) _Pragma("unroll") for (int n = 0; n < 2; ++n) \
                load(row0 + ((b + 1) >> 1) * 128 + (((b + 1) & 1) * 2 + mm) * 16, col0 + bj * 128 + n * 16, buf[(b + 1) & 1][mm * 4 + bj * 2 + n]); } \
            _Pragma("unroll") for (int mm = 0; mm < 2; ++mm) _Pragma("unroll") for (int bj = 0; bj < 2; ++bj) _Pragma("unroll") for (int n = 0; n < 2; ++n) \
                apply(row0 + (b >> 1) * 128 + ((b & 1) * 2 + mm) * 16, col0 + bj * 128 + n * 16, acc[b >> 1][bj][(b & 1) * 2 + mm][n], buf[b & 1][mm * 4 + bj * 2 + n], pre, bj * 2 + n); } }

struct EpiPartA {
    bf16_t* Q; bf16_t* Kk; bf16_t* V; bf16_t* UG; float* GLR;
    __device__ __forceinline__ void operator()(int, int row, int col, f32x4 v) const {
        if (col < 512) store4bf(Q + (size_t)row * 512 + col, v);
        else if (col < 1024) store4bf(Kk + (size_t)row * 512 + (col - 512), v);
        else if (col < 2048) store4bf(V + (size_t)row * 1024 + (col - 1024), v);
        else if (col < 2304) { const int c = col - 2048; if (c < 32) *(f32x4*)(GLR + (size_t)row * 32 + c) = v; }
        else { const int c = col - 2304, g = c >> 4, n = c & 15, chunk = row >> 5, j = row & 31; store4bf(UG + ((size_t)(g * 1280 + chunk) * 768 + j * 16 + n), v); }
    }
    EPI_SIMPLE_TILE()
};
struct EpiE { float* E; __device__ __forceinline__ void operator()(int z, int row, int col, f32x4 v) const { *(f32x4*)(E + ((size_t)(z * 1280 + row) * 256 + col)) = v; } EPI_SIMPLE_TILE() };
struct EpiY {
    bf16_t* YB;
    __device__ __forceinline__ void operator()(int z, int row, int col, f32x4 v) const {
        const int tok = row * 32 + (col >> 4), ch = z * 16 + (col & 15);
        f32x4 o;
#pragma unroll
        for (int e = 0; e < 4; ++e) { const float x = v[e]; o[e] = x * sigmoidf_(1.5957691216f * (x + 0.044715f * x * x * x)); }
        store4bf(YB + (size_t)tok * 512 + ch, o);
    }
    EPI_SIMPLE_TILE()
};
struct EpiGLU {
    const bf16_t* YB; bf16_t* OS5; const float* bglu;
    typedef u32x2 L; struct Pre { f32x4 b[4]; };
    __device__ __forceinline__ void begin(int, int col0, Pre& pr) const {
#pragma unroll
        for (int k = 0; k < 4; ++k) pr.b[k] = *(const f32x4*)(bglu + col0 + (k >> 1) * 128 + (k & 1) * 16); }
    __device__ __forceinline__ void load(int row, int col, L& l) const { l = *(const u32x2*)(YB + (size_t)row * 512 + col); }
    __device__ __forceinline__ void apply(int row, int col, f32x4 v, const L& l, const Pre& pr, int k) const {
        const f32x4 y = (f32x4){bflo(l.x), bfhi(l.x), bflo(l.y), bfhi(l.y)}; f32x4 o;
#pragma unroll
        for (int e = 0; e < 4; ++e) o[e] = y[e] * sigmoidf_(v[e] + pr.b[k][e]);
        store4bf(OS5 + (size_t)row * 512 + col, o); }
    EPI_PIPE_TILE()
};
struct EpiPartB {
    bf16_t* R; bf16_t* GA; bf16_t* GB;
    __device__ __forceinline__ void operator()(int, int row, int col, f32x4 v) const {
        f32x4 s;
#pragma unroll
        for (int e = 0; e < 4; ++e) s[e] = sigmoidf_(v[e]);
        if (col < 1024) { store4bf(R + (size_t)row * 1024 + col, v * s); }
        else if (col < 2048) store4bf(GA + (size_t)row * 1024 + (col - 1024), s);
        else store4bf(GB + (size_t)row * 1024 + (col - 2048), s);
    }
    EPI_SIMPLE_TILE()
};
struct EpiProj1 { const bf16_t* GA; bf16_t* T1;
    typedef u32x2 L; struct Pre { int dummy; };
    __device__ __forceinline__ void begin(int, int, Pre&) const {}
    __device__ __forceinline__ void load(int row, int col, L& l) const { l = *(const u32x2*)(GA + (size_t)row * 1024 + col); }
    __device__ __forceinline__ void apply(int row, int col, f32x4 v, const L& l, const Pre&, int) const {
        const f32x4 g = (f32x4){bflo(l.x), bfhi(l.x), bflo(l.y), bfhi(l.y)}; store4bf(T1 + (size_t)row * 1024 + col, g * v); }
    EPI_PIPE_TILE()
};
struct EpiProj2 { const bf16_t* GB; bf16_t* T1;
    struct L { u32x2 t, g; }; struct Pre { int dummy; };
    __device__ __forceinline__ void begin(int, int, Pre&) const {}
    __device__ __forceinline__ void load(int row, int col, L& l) const { const size_t o = (size_t)row * 1024 + col; l.t = *(const u32x2*)(T1 + o); l.g = *(const u32x2*)(GB + o); }
    __device__ __forceinline__ void apply(int row, int col, f32x4 v, const L& l, const Pre&, int) const {
        const f32x4 g = (f32x4){bflo(l.g.x), bfhi(l.g.x), bflo(l.g.y), bfhi(l.g.y)}, t = (f32x4){bflo(l.t.x), bfhi(l.t.x), bflo(l.t.y), bfhi(l.t.y)};
        store4bf(T1 + (size_t)row * 1024 + col, t + g * v); }
    EPI_PIPE_TILE()
};
struct EpiDelta { bf16_t* Dl; const float* gate;
    __device__ __forceinline__ void tile(const f32x4 (&acc)[2][2][4][2], int, int row0, int col0) const {
        const float* gp = gate + (size_t)mod_index(row0) * 6144 + col0; f32x4 g[2][2];
#pragma unroll
        for (int bj = 0; bj < 2; ++bj)
#pragma unroll
            for (int n = 0; n < 2; ++n) g[bj][n] = *(const f32x4*)(gp + bj * 128 + n * 16);
#pragma unroll
        for (int ai = 0; ai < 2; ++ai)
#pragma unroll
            for (int m = 0; m < 4; ++m)
#pragma unroll
                for (int bj = 0; bj < 2; ++bj)
#pragma unroll
                    for (int n = 0; n < 2; ++n) store4bf(Dl + (size_t)(row0 + ai * 128 + m * 16) * 1024 + col0 + bj * 128 + n * 16, g[bj][n] * acc[ai][bj][m][n]);
    } };
struct EpiFF1 { bf16_t* H;
    __device__ __forceinline__ void operator()(int, int row, int col, f32x4 v) const {
        f32x4 o;
#pragma unroll
        for (int e = 0; e < 4; ++e) { const float r = fmaxf(v[e], 0.f); o[e] = r * r; }
        store4bf(H + (size_t)row * 4096 + col, o); }
    EPI_SIMPLE_TILE()
};

struct ConvJob { const float* src; int ld, K, c0, nvalid, ndst; bf16_t* dst; float scale; };
__device__ __forceinline__ bool conv_job(const P& p, int l, int j, ConvJob& J) {
    bf16_t* W = (bf16_t*)(p.ws + WS_W);
    const float* win = p.in[lnd(10)] + (size_t)l * 1024 * 5664;
    J.scale = 1.0f;
    switch (j) {
        case 0: J = {win, 5664, 1024, 0, 512, 512, W + W_A / 2, 0.08838834764831845f}; break;
        case 1: J = {win, 5664, 1024, 512, 512, 512, W + W_A / 2 + (size_t)512 * 1024, 1.f}; break;
        case 2: J = {win, 5664, 1024, 1024, 1024, 1024, W + W_A / 2 + (size_t)1024 * 1024, 1.f}; break;
        case 3: J = {win, 5664, 1024, 3072, 32, 256, W + W_A / 2 + (size_t)2048 * 1024, 1.f}; break;
        case 4: J = {win, 5664, 1024, 3104, 512, 512, W + W_A / 2 + (size_t)2304 * 1024, 1.f}; break;
        case 5: J = {win, 5664, 1024, 2048, 1024, 1024, W + W_B / 2, 1.f}; break;
        case 6: J = {win, 5664, 1024, 3616, 1024, 1024, W + W_B / 2 + (size_t)1024 * 1024, 1.f}; break;
        case 7: J = {win, 5664, 1024, 4640, 1024, 1024, W + W_B / 2 + (size_t)2048 * 1024, 1.f}; break;
        case 8: J = {p.in[lnd(14)] + (size_t)l * 1024 * 1024, 1024, 1024, 0, 1024, 1024, W + W_PG / 2, 1.f}; break;
        case 9: J = {p.in[lnd(23)] + (size_t)l * 512 * 512, 512, 512, 0, 512, 512, W + W_GLU / 2, 1.f}; break;
        case 10: J = {p.in[lnd(25)] + (size_t)l * 512 * 1024, 1024, 512, 0, 1024, 1024, W + W_PS / 2, 1.f}; break;
        case 11: J = {p.in[lnd(26)] + (size_t)l * 1024 * 1024, 1024, 1024, 0, 1024, 1024, W + W_OUT / 2, 1.f}; break;
        case 12: J = {p.in[lnd(28)] + (size_t)l * 1024 * 4096, 4096, 1024, 0, 4096, 4096, W + W_1 / 2, 1.f}; break;
        case 13: J = {p.in[lnd(29)] + (size_t)l * 4096 * 1024, 1024, 4096, 0, 1024, 1024, W + W_2 / 2, 1.f}; break;
        default: return false;
    }
    return true;
}
constexpr int CONV_TILES = 4224;
__device__ __forceinline__ void conv_tile(const P& p, int l, int tile, LAS float* sT) {
    const int tid = tid_();
    ConvJob J; int j = 0, rem = tile;
    for (; j < 14; ++j) { conv_job(p, l, j, J); const int nt = (J.ndst / 64) * (J.K / 64); if (rem < nt) break; rem -= nt; }
    const int kts = J.K / 64, ntile = rem / kts, ktile = rem % kts, n0 = ntile * 64, k0 = ktile * 64;
    {
        const int kk = tid >> 4, c4 = (tid & 15) * 4;
#pragma unroll
        for (int i = 0; i < 2; ++i) {
            const int k = kk + 32 * i; f32x4 v = (f32x4){0.f, 0.f, 0.f, 0.f};
            if (n0 + c4 < J.nvalid) v = *(const f32x4*)(J.src + (size_t)(k0 + k) * J.ld + J.c0 + n0 + c4);
#pragma unroll
            for (int e = 0; e < 4; ++e) sT[(c4 + e) * 65 + k] = v[e] * J.scale;
        }
    }
    __syncthreads();
    {
        const int n = tid >> 3, ks = (tid & 7) * 8; u32x4 w;
        const LAS float* s = sT + n * 65 + ks;
        w.x = pk_bf16(s[0], s[1]); w.y = pk_bf16(s[2], s[3]); w.z = pk_bf16(s[4], s[5]); w.w = pk_bf16(s[6], s[7]);
        *(u32x4*)(J.dst + (size_t)(n0 + n) * J.K + k0 + ks) = w;
    }
}

__device__ __forceinline__ void mod_task(const P& p, int m, LAS float* sm) {
    const int tid = tid_(), l = m / 192, colbase = (m % 192) * 32, cl = tid & 31, ks = tid >> 5;
    LAS float* SC = sm; LAS float* RED = sm + 9216;
    for (int i = tid; i < 9216; i += NTHR) { const int j = i >> 10, k = i & 1023; const float c = (j == 0) ? p.in[lnd(6)][k] : p.in[lnd(2)][(j - 1) * 1024 + k]; SC[i] = c * sigmoidf_(c); }
    __syncthreads();
    float acc[9];
#pragma unroll
    for (int j = 0; j < 9; ++j) acc[j] = 0.f;
    const float* w = p.in[lnd(7)] + (size_t)l * 1024 * 6144 + colbase + cl;
    for (int k8 = 0; k8 < 64; k8 += 16) { float wv[16];
#pragma unroll
        for (int u = 0; u < 16; ++u) wv[u] = w[(size_t)(ks * 64 + k8 + u) * 6144];
#pragma unroll
        for (int u = 0; u < 16; ++u)
#pragma unroll
            for (int j = 0; j < 9; ++j) acc[j] += SC[j * 1024 + ks * 64 + k8 + u] * wv[u]; }
#pragma unroll
    for (int j = 0; j < 9; ++j) RED[(ks * 9 + j) * 32 + cl] = acc[j];
    __syncthreads();
    if (tid < 288) { const int j = tid >> 5, c = tid & 31; float s = 0.f;
#pragma unroll
        for (int q = 0; q < 16; ++q) s += RED[(q * 9 + j) * 32 + c];
        float* mod = (float*)(p.ws + WS_MOD);
        mod[((size_t)l * 9 + j) * 6144 + colbase + c] = s + p.in[lnd(8)][(size_t)l * 6144 + colbase + c]; }
}

__device__ __forceinline__ void s5_mats(const P& p, int l, int g, LAS float* sm) {
    const int tid = tid_();
    LAS float* KF = sm; LAS float* KB = sm + 8192; LAS float* LT = sm + 16384; LAS float* CC = sm + 20608; LAS float* BB = sm + 22656;
    bf16_t* MC = (bf16_t*)(p.ws + WS_R1) + (size_t)g * 512 * 768;
    bf16_t* EM = (bf16_t*)(p.ws + WS_EMAT) + (size_t)g * 256 * 512;
    for (int d = 0; d < 2; ++d) {
        const int pg = (l * 2 + d) * 32 + g;
        const float* lamr = p.in[lnd(15)] + (size_t)pg * 64; const float* lami = p.in[lnd(16)] + (size_t)pg * 64;
        const float dt = expf(p.in[lnd(17)][pg]);
        const float* bre = p.in[lnd(18)] + (size_t)pg * 1024; const float* bim = p.in[lnd(19)] + (size_t)pg * 1024;
        const float* cre = p.in[lnd(20)] + (size_t)pg * 1024; const float* cim = p.in[lnd(21)] + (size_t)pg * 1024;
        for (int i = tid; i < 33 * 64; i += NTHR) { const int tau = i >> 6, pp = i & 63; const float a = expf(lamr[pp] * dt * (float)tau); float s, c; sincosf(lami[pp] * dt * (float)tau, &s, &c); LT[2 * i] = a * c; LT[2 * i + 1] = a * s; }
        for (int i = tid; i < 1024; i += NTHR) { CC[2 * i] = cre[i]; CC[2 * i + 1] = cim[i]; }
        for (int i = tid; i < 1024; i += NTHR) {
            const int pp = i >> 4; const float lr = lamr[pp], li = lami[pp]; float s, c; sincosf(li * dt, &s, &c);
            const float em1 = expm1f(lr * dt); float sh, ch; sincosf(0.5f * li * dt, &sh, &ch);
            const float nr = em1 * c - 2.f * sh * sh, ni = (em1 + 1.f) * s;
            const float inv = 1.f / (lr * lr + li * li);
            const float qr = (nr * lr + ni * li) * inv, qi = (ni * lr - nr * li) * inv;
            const float br = bre[i], bi = bim[i];
            BB[2 * i] = qr * br - qi * bi; BB[2 * i + 1] = qr * bi + qi * br;
        }
        __syncthreads();
        {
            const int tau = tid >> 4, n = tid & 15; float acc[16];
#pragma unroll
            for (int m = 0; m < 16; ++m) acc[m] = 0.f;
            for (int pp = 0; pp < 64; ++pp) {
                const float cr = CC[2 * (n * 64 + pp)], ci = CC[2 * (n * 64 + pp) + 1], lr = LT[2 * (tau * 64 + pp)], li = LT[2 * (tau * 64 + pp) + 1];
                const float xr = cr * lr - ci * li, xi = cr * li + ci * lr;
#pragma unroll
                for (int m = 0; m < 16; ++m) acc[m] += xr * BB[2 * (pp * 16 + m)] - xi * BB[2 * (pp * 16 + m) + 1];
            }
            LAS float* Kd = d ? KB : KF;
#pragma unroll
            for (int m = 0; m < 16; ++m) Kd[(tau * 16 + n) * 16 + m] = acc[m];
        }
        {
            const int pp = tid >> 3, cseg = tid & 7;
#pragma unroll 1
            for (int jj = 0; jj < 4; ++jj) {
                const int j = cseg * 4 + jj, e = d == 0 ? 31 - j : j; const float lr = LT[2 * (e * 64 + pp)], li = LT[2 * (e * 64 + pp) + 1];
                float re[16], im[16];
#pragma unroll
                for (int m = 0; m < 16; ++m) { const float br = BB[2 * (pp * 16 + m)], bi = BB[2 * (pp * 16 + m) + 1]; re[m] = lr * br - li * bi; im[m] = lr * bi + li * br; }
                bf16_t* er = EM + (size_t)(d * 128 + pp) * 512 + j * 16; bf16_t* ei = EM + (size_t)(d * 128 + 64 + pp) * 512 + j * 16;
#pragma unroll
                for (int h = 0; h < 2; ++h) {
                    u32x4 w; w.x = pk_bf16(re[8 * h], re[8 * h + 1]); w.y = pk_bf16(re[8 * h + 2], re[8 * h + 3]); w.z = pk_bf16(re[8 * h + 4], re[8 * h + 5]); w.w = pk_bf16(re[8 * h + 6], re[8 * h + 7]); *(u32x4*)(er + 8 * h) = w;
                    u32x4 x; x.x = pk_bf16(im[8 * h], im[8 * h + 1]); x.y = pk_bf16(im[8 * h + 2], im[8 * h + 3]); x.z = pk_bf16(im[8 * h + 4], im[8 * h + 5]); x.w = pk_bf16(im[8 * h + 6], im[8 * h + 7]); *(u32x4*)(ei + 8 * h) = x;
                }
            }
        }
        {
            const int t = tid >> 4, n = tid & 15, f = d == 0 ? t + 1 : 32 - t;
            bf16_t* mr = MC + (size_t)tid * 768 + 512 + d * 128;
#pragma unroll 1
            for (int p8 = 0; p8 < 8; ++p8) {
                float re[8], im[8];
#pragma unroll
                for (int q = 0; q < 8; ++q) { const int pp = p8 * 8 + q; const float cr = CC[2 * (n * 64 + pp)], ci = CC[2 * (n * 64 + pp) + 1], lr = LT[2 * (f * 64 + pp)], li = LT[2 * (f * 64 + pp) + 1];
                    re[q] = cr * lr - ci * li; im[q] = -(cr * li + ci * lr); }
                u32x4 w; w.x = pk_bf16(re[0], re[1]); w.y = pk_bf16(re[2], re[3]); w.z = pk_bf16(re[4], re[5]); w.w = pk_bf16(re[6], re[7]); *(u32x4*)(mr + p8 * 8) = w;
                u32x4 x; x.x = pk_bf16(im[0], im[1]); x.y = pk_bf16(im[2], im[3]); x.z = pk_bf16(im[4], im[5]); x.w = pk_bf16(im[6], im[7]); *(u32x4*)(mr + 64 + p8 * 8) = x;
            }
        }
        __syncthreads();
    }
    {
        const int t = tid >> 4, n = tid & 15; const float dsk = p.in[lnd(22)][(size_t)l * 512 + g * 16 + n];
        bf16_t* mr = MC + (size_t)tid * 768;
#pragma unroll 1
        for (int j = 0; j < 32; ++j) {
            float v[16];
#pragma unroll
            for (int m = 0; m < 16; ++m) v[m] = 0.f;
            if (j <= t) { const LAS float* k = KF + ((t - j) * 16 + n) * 16;
#pragma unroll
                for (int m = 0; m < 16; ++m) v[m] += k[m]; }
            if (j >= t) { const LAS float* k = KB + ((j - t) * 16 + n) * 16;
#pragma unroll
                for (int m = 0; m < 16; ++m) v[m] += k[m]; }
            if (j == t) {
#pragma unroll
                for (int m = 0; m < 16; ++m) v[m] += (m == n) ? dsk : 0.f; }
            u32x4 w; w.x = pk_bf16(v[0], v[1]); w.y = pk_bf16(v[2], v[3]); w.z = pk_bf16(v[4], v[5]); w.w = pk_bf16(v[6], v[7]); *(u32x4*)(mr + j * 16) = w;
            u32x4 x; x.x = pk_bf16(v[8], v[9]); x.y = pk_bf16(v[10], v[11]); x.z = pk_bf16(v[12], v[13]); x.w = pk_bf16(v[14], v[15]); *(u32x4*)(mr + j * 16 + 8) = x;
        }
    }
}

__device__ __forceinline__ void phase_prep(const P& p, int l, LAS unsigned char* lds) {
    LAS float* sm = (LAS float*)lds;
    const int nmod = (l == 0) ? 384 : 0, total = 32 + nmod + CONV_TILES;
    for (int task = bid_(); task < total; task += gridDim.x) {
        if (task < 32) s5_mats(p, l, task, sm);
        else if (task < 32 + nmod) mod_task(p, task - 32, sm);
        else conv_tile(p, l, task - 32 - nmod, sm);
        __syncthreads();
    }
}

__device__ __forceinline__ void norm_row_write(const f32x4 (&x)[4], const float* g, const float* mod, int shoff, int scoff, bf16_t* hrow, int lane) {
    float ss = 0.f;
#pragma unroll
    for (int i = 0; i < 4; ++i) ss += x[i][0] * x[i][0] + x[i][1] * x[i][1] + x[i][2] * x[i][2] + x[i][3] * x[i][3];
    ss = wave_sum(ss);
    const float rstd = rsqrtf(ss * (1.0f / 1024.0f) + 1e-6f);
#pragma unroll
    for (int i = 0; i < 4; ++i) { const int d = i * 256 + lane * 4; const f32x4 gg = *(const f32x4*)(g + d), sc = *(const f32x4*)(mod + scoff + d), sh = *(const f32x4*)(mod + shoff + d);
        f32x4 h;
#pragma unroll
        for (int e = 0; e < 4; ++e) h[e] = x[i][e] * rstd * gg[e] * (1.f + sc[e]) + sh[e];
        store4bf(hrow + d, h); }
}
__device__ __forceinline__ void phase_norm(const P& p, int l, int which) {
    const int lane = tid_() & 63, gw = bid_() * 8 + (tid_() >> 6), nw = gridDim.x * 8;
    const float* g = (which == 1 ? p.in[lnd(9)] : p.in[lnd(27)]) + (size_t)l * 1024;
    const float* modl = (const float*)(p.ws + WS_MOD) + (size_t)l * 9 * 6144;
    const int shoff = which == 1 ? 0 : 3072, scoff = which == 1 ? 1024 : 4096;
    bf16_t* H = (bf16_t*)(p.ws + WS_R2); float* X = p.out;
    if (which == 1 && l == 0) {
        for (int item = gw; item < 4096 + 8192; item += nw) {
            if (item < 4096) {
                const int n = item; const float rr = (float)(n >> 6), cc = (float)(n & 63); f32x4 pe[4];
#pragma unroll
                for (int e = 0; e < 4; ++e) { const float om = expf(-(float)(lane * 4 + e) * (9.210340371976184f / 256.0f)); float s, c; sincosf(rr * om, &s, &c); pe[0][e] = s; pe[1][e] = c; sincosf(cc * om, &s, &c); pe[2][e] = s; pe[3][e] = c; }
                for (int b = 0; b < 8; ++b) { const int row = TOKP + b * 4096 + n; const float* src = p.in[lnd(1)] + ((size_t)b * 4096 + n) * 1024; f32x4 x[4];
#pragma unroll
                    for (int i = 0; i < 4; ++i) { x[i] = *(const f32x4*)(src + i * 256 + lane * 4) + pe[i]; *(f32x4*)(X + (size_t)row * 1024 + i * 256 + lane * 4) = x[i]; }
                    norm_row_write(x, g, modl + (size_t)(1 + b) * 6144, shoff, scoff, H + (size_t)row * 1024, lane); }
            } else { const int row = item - 4096; const float* src = p.in[lnd(0)] + (size_t)row * 1024; f32x4 x[4];
#pragma unroll
                for (int i = 0; i < 4; ++i) { x[i] = *(const f32x4*)(src + i * 256 + lane * 4); *(f32x4*)(X + (size_t)row * 1024 + i * 256 + lane * 4) = x[i]; }
                norm_row_write(x, g, modl, shoff, scoff, H + (size_t)row * 1024, lane); }
        }
    } else {
        const bf16_t* DL = (const bf16_t*)(p.ws + (which == 1 ? WS_R2 : WS_R3));
        for (int row = gw; row < TOK; row += nw) { f32x4 x[4];
#pragma unroll
            for (int i = 0; i < 4; ++i) { float* xp = X + (size_t)row * 1024 + i * 256 + lane * 4; x[i] = *(const f32x4*)xp + load4bf(DL + (size_t)row * 1024 + i * 256 + lane * 4); *(f32x4*)xp = x[i]; }
            norm_row_write(x, g, modl + (size_t)mod_index(row) * 6144, shoff, scoff, H + (size_t)row * 1024, lane); }
    }
}
__device__ __forceinline__ void phase_final(const P& p) {
    const int lane = tid_() & 63, gw = bid_() * 8 + (tid_() >> 6), nw = gridDim.x * 8; float* X = p.out; const float* g = p.in[lnd(30)]; const bf16_t* DL = (const bf16_t*)(p.ws + WS_R2);
    for (int row = gw; row < TOK; row += nw) { f32x4 x[4]; float ss = 0.f;
#pragma unroll
        for (int i = 0; i < 4; ++i) { x[i] = *(const f32x4*)(X + (size_t)row * 1024 + i * 256 + lane * 4) + load4bf(DL + (size_t)row * 1024 + i * 256 + lane * 4); ss += x[i][0] * x[i][0] + x[i][1] * x[i][1] + x[i][2] * x[i][2] + x[i][3] * x[i][3]; }
        ss = wave_sum(ss); const float rstd = rsqrtf(ss * (1.0f / 1024.0f) + 1e-6f);
#pragma unroll
        for (int i = 0; i < 4; ++i) { const f32x4 gg = *(const f32x4*)(g + i * 256 + lane * 4); *(f32x4*)(X + (size_t)row * 1024 + i * 256 + lane * 4) = x[i] * rstd * gg; } }
}

__device__ __forceinline__ void phase_s5scan(const P& p, int l) {
    const float* E = (const float*)(p.ws + WS_E); bf16_t* UG = (bf16_t*)(p.ws + WS_R5);
    float* ore = p.out + (size_t)TOK * 1024 + 16777216; float* oim = ore + 262144;
    for (int task = bid_(); task < 320; task += gridDim.x) {
        const int idx = task * NTHR + tid_(), pp = idx & 63, d = (idx >> 6) & 1, g = (idx >> 7) & 31, s = 39 - (idx >> 12);
        const int nch = s < 32 ? 8 : 128, cbase = s < 32 ? s * 8 : 256 + (s - 32) * 128;
        const int pg = (l * 2 + d) * 32 + g; const float dt = expf(p.in[lnd(17)][pg]);
        const float a = expf(p.in[lnd(15)][(size_t)pg * 64 + pp] * dt * 32.f); float sn, cs; sincosf(p.in[lnd(16)][(size_t)pg * 64 + pp] * dt * 32.f, &sn, &cs);
        const float ar = a * cs, ai = a * sn;
        float sr = 0.f, si = 0.f;
        if (s >= 32) { const size_t o = ((((size_t)(s - 32) * 2 + l) * 2 + d) * 32 + g) * 64 + pp; sr = p.in[lnd(4)][o]; si = p.in[lnd(5)][o]; }
        const float* Eb = E + ((size_t)(g * 1280 + cbase) * 256 + d * 128 + pp);
        bf16_t* Ub = UG + ((size_t)(g * 1280 + cbase) * 768 + 512 + d * 128 + pp);
        for (int c0 = 0; c0 < nch; c0 += 8) {
            float er[8], ei[8];
#pragma unroll
            for (int k = 0; k < 8; ++k) { const int c = d == 0 ? c0 + k : nch - 1 - (c0 + k); er[k] = Eb[(size_t)c * 256]; ei[k] = Eb[(size_t)c * 256 + 64]; }
#pragma unroll
            for (int k = 0; k < 8; ++k) { const int c = d == 0 ? c0 + k : nch - 1 - (c0 + k);
                Ub[(size_t)c * 768] = f2bf(sr); Ub[(size_t)c * 768 + 64] = f2bf(si);
                const float nr = ar * sr - ai * si + er[k], ni = ar * si + ai * sr + ei[k]; sr = nr; si = ni; }
        }
        if (s < 32) { const size_t o = ((((size_t)s * 2 + l) * 2 + d) * 32 + g) * 64 + pp; ore[o] = sr; oim[o] = si; }
    }
}

__device__ __forceinline__ void phase_glapre(const P& p, int l, LAS unsigned char* lds) {
    const int tid = tid_(), d = tid & 127, tq = tid >> 7;
    LAS float* sG = (LAS float*)lds; LAS float* sT4 = sG + 2048;
    bf16_t* Q = (bf16_t*)(p.ws + WS_R3); bf16_t* Kk = Q + (size_t)TOK * 512;
    bf16_t* QB = (bf16_t*)(p.ws + WS_R5); bf16_t* KB = QB + (size_t)TOK * 512;
    const float* GLR = (const float*)(p.ws + WS_GLR);
    for (int task = bid_(); task < 2560; task += gridDim.x) {
        const int c64 = task >> 2, h = task & 3, tb = c64 * 64;
        { const int row = tid >> 3, c4 = (tid & 7) * 4; *(LAS f32x4*)(sG + row * 32 + c4) = *(const f32x4*)(GLR + (size_t)(tb + row) * 32 + c4); }
        float qv[16], kv[16];
#pragma unroll
        for (int i = 0; i < 16; ++i) { const size_t o = (size_t)(tb + tq * 16 + i) * 512 + h * 128 + d; qv[i] = bf2f(Q[o]); kv[i] = bf2f(Kk[o]); }
        __syncthreads();
#pragma unroll 1
        for (int dir = 0; dir < 2; ++dir) {
            float w[16];
#pragma unroll
            for (int r = 0; r < 16; ++r) w[r] = p.in[lnd(11)][((size_t)(l * 2 + dir) * 16 + r) * 512 + h * 128 + d];
            const float bg = p.in[lnd(12)][(size_t)(l * 2 + dir) * 512 + h * 128 + d];
            float cum[16];
#pragma unroll
            for (int i = 0; i < 16; ++i) { const LAS float* gr = sG + (tq * 16 + i) * 32 + dir * 16; float z = bg;
#pragma unroll
                for (int r = 0; r < 16; ++r) z += gr[r] * w[r];
                cum[i] = (fminf(z, 0.f) - __logf(1.0f + __expf(-fabsf(z)))) * 0.0625f; }
            if (dir == 0) {
#pragma unroll
                for (int i = 1; i < 16; ++i) cum[i] += cum[i - 1];
            } else {
#pragma unroll
                for (int i = 14; i >= 0; --i) cum[i] += cum[i + 1];
            }
            sT4[tq * 128 + d] = dir == 0 ? cum[15] : cum[0];
            __syncthreads();
            float off = 0.f, total = 0.f;
#pragma unroll
            for (int q = 0; q < 4; ++q) { const float v = sT4[q * 128 + d]; total += v; if (dir == 0 ? (q < tq) : (q > tq)) off += v; }
            bf16_t* QD = dir == 0 ? Q : QB; bf16_t* KI = dir == 0 ? Kk : KB;
#pragma unroll
            for (int i = 0; i < 16; ++i) { const float cm = cum[i] + off; const size_t o = (size_t)(tb + tq * 16 + i) * 512 + h * 128 + d;
                QD[o] = f2bf(qv[i] * __expf(cm)); KI[o] = f2bf(kv[i] * __expf(-cm)); }
            if (tq == 0) ((float*)(p.ws + (dir == 0 ? WS_TOTF : WS_TOTB)))[(size_t)c64 * 512 + h * 128 + d] = total;
            __syncthreads();
        }
    }
}

constexpr int GLA_GRP = 71168;
typedef short s16x4 __attribute__((ext_vector_type(4)));
__device__ __forceinline__ bf16x8 tr_frag(const LAS bf16_t* base, int stride, int krow0, int col0, int fr, int fq) {
    const LAS bf16_t* q = base + (krow0 + 8 * fq + (fr >> 2)) * stride + col0 + 4 * (fr & 3);
    const s16x4 a = __builtin_amdgcn_ds_read_tr16_b64_v4i16((LAS s16x4*)q);
    const s16x4 b = __builtin_amdgcn_ds_read_tr16_b64_v4i16((LAS s16x4*)(q + 4 * stride));
    return __builtin_shufflevector(a, b, 0, 1, 2, 3, 4, 5, 6, 7);
}
#define LDS_BAR() do { asm volatile("s_waitcnt lgkmcnt(0)" ::: "memory"); __builtin_amdgcn_s_barrier(); asm volatile("" ::: "memory"); } while (0)
__device__ __forceinline__ void phase_gla(const P& p, int l, LAS unsigned char* lds) {
    const int tid = tid_(), grp = tid >> 8, gt = tid & 255, wv = (tid >> 6) & 3, lane = tid & 63, fr = lane & 15, fq = lane >> 4;
    LAS unsigned char* gl = lds + grp * GLA_GRP;
    LAS bf16_t* sQ = (LAS bf16_t*)gl; LAS bf16_t* sK = (LAS bf16_t*)(gl + 17408); LAS bf16_t* sV = (LAS bf16_t*)(gl + 34816);
    LAS bf16_t* sP = (LAS bf16_t*)(gl + 44032); LAS bf16_t* sS = (LAS bf16_t*)(gl + 53248); LAS float* sTot = (LAS float*)(gl + 70656);
    const bf16_t* QD = grp == 0 ? (const bf16_t*)(p.ws + WS_R3) : (const bf16_t*)(p.ws + WS_R5);
    const bf16_t* KI = QD + (size_t)TOK * 512;
    const bf16_t* V = (const bf16_t*)(p.ws + WS_R4);
    const float* TOT = (const float*)(p.ws + (grp == 0 ? WS_TOTF : WS_TOTB));
    bf16_t* O = (bf16_t*)(p.ws + WS_R1);
    float* OST = p.out + (size_t)TOK * 1024;
    const int G = gridDim.x, b = bid_();
    const bool custom = (G == 256);
    const int ntask_mine = custom ? (b < 128 ? 1 : 4) : ((640 - b + G - 1) / G);
    for (int ti = 0; ti < ntask_mine; ++ti) {
        const int task = custom ? (b < 128 ? b : b + 128 * ti) : b + G * ti;
        if (task >= 640) break;
        const bool sample = task < 128;
        const int t2 = sample ? task : task - 128, sb = t2 >> 4, h = (t2 >> 2) & 3, vs = t2 & 3;
        const int base = sample ? TOKP + sb * 4096 : sb * 256, nch = sample ? 64 : 4;
        f32x4 accS[2][4];
#pragma unroll
        for (int dt = 0; dt < 2; ++dt)
#pragma unroll
            for (int vt = 0; vt < 4; ++vt) {
                f32x4 a = (f32x4){0.f, 0.f, 0.f, 0.f};
                if (sample) { const float* cp = p.in[lnd(3)] + (((((size_t)sb * 2 + l) * 2 + grp) * 4 + h) * 128 + 16 * (2 * wv + dt) + 4 * fq) * 256 + vs * 64 + 16 * vt + fr;
#pragma unroll
                    for (int e = 0; e < 4; ++e) a[e] = cp[(size_t)e * 256]; }
                accS[dt][vt] = a;
                u32x2 w; w.x = pk_bf16(a[0], a[1]); w.y = pk_bf16(a[2], a[3]);
                *(LAS u32x2*)(sS + (16 * vt + fr) * 136 + 16 * (2 * wv + dt) + 4 * fq) = w;
            }
        u32x4 rq[4], rk[4], rv[2]; float rt = 0.f;
#define GLA_LOAD(ci) do { const int tb_ = base + (ci) * 64; \
        _Pragma("unroll") for (int i = 0; i < 4; ++i) { const int idx = gt + 256 * i, row = idx >> 4, c16 = idx & 15; const size_t o = (size_t)(tb_ + row) * 512 + h * 128 + c16 * 8; rq[i] = *(const u32x4*)(QD + o); rk[i] = *(const u32x4*)(KI + o); } \
        _Pragma("unroll") for (int i = 0; i < 2; ++i) { const int idx = gt + 256 * i, row = idx >> 3, c8 = idx & 7; rv[i] = *(const u32x4*)(V + (size_t)(tb_ + row) * 1024 + h * 256 + vs * 64 + c8 * 8); } \
        if (gt < 128) rt = TOT[(size_t)(tb_ >> 6) * 512 + h * 128 + gt]; } while (0)
#define GLA_STORE() do { \
        _Pragma("unroll") for (int i = 0; i < 4; ++i) { const int idx = gt + 256 * i, row = idx >> 4, c16 = idx & 15; *(LAS u32x4*)(sQ + row * 136 + c16 * 8) = rq[i]; *(LAS u32x4*)(sK + row * 136 + c16 * 8) = rk[i]; } \
        _Pragma("unroll") for (int i = 0; i < 2; ++i) { const int idx = gt + 256 * i, row = idx >> 3, c8 = idx & 7; *(LAS u32x4*)(sV + row * 72 + c8 * 8) = rv[i]; } \
        if (gt < 128) sTot[gt] = rt; } while (0)
        GLA_LOAD(grp == 0 ? 0 : nch - 1);
        GLA_STORE();
        __syncthreads();
        for (int s = 0; s < nch; ++s) {
            const int ci = grp == 0 ? s : nch - 1 - s, tb = base + ci * 64;
            const bool second = (s >= (nch >> 1));
            if (s + 1 < nch) GLA_LOAD(grp == 0 ? s + 1 : nch - 2 - s);
            u32x2 oprev[4];
#pragma unroll
            for (int it = 0; it < 4; ++it) oprev[it] = (u32x2){0u, 0u};
            if (second) {
#pragma unroll
                for (int it = 0; it < 4; ++it) oprev[it] = *(const u32x2*)(O + (size_t)(tb + 16 * it + fr) * 1024 + h * 256 + vs * 64 + 16 * wv + 4 * fq);
            }
#pragma unroll
            for (int jt = 0; jt < 4; ++jt) {
                f32x4 acc = (f32x4){0.f, 0.f, 0.f, 0.f};
                const bool skip = grp == 0 ? (jt > wv) : (jt < wv);
                if (!skip) {
#pragma unroll
                    for (int ks = 0; ks < 4; ++ks) { const bf16x8 a = *(const LAS bf16x8*)(sQ + (16 * wv + fr) * 136 + 32 * ks + 8 * fq); const bf16x8 bb = *(const LAS bf16x8*)(sK + (16 * jt + fr) * 136 + 32 * ks + 8 * fq);
                        acc = __builtin_amdgcn_mfma_f32_16x16x32_bf16(a, bb, acc, 0, 0, 0); }
                }
#pragma unroll
                for (int e = 0; e < 4; ++e) { const int i = 16 * wv + 4 * fq + e, j = 16 * jt + fr; const bool keep = grp == 0 ? (j <= i) : (j >= i); sP[i * 72 + j] = f2bf(keep ? acc[e] : 0.f); }
            }
            LDS_BAR();
            bf16x8 vf[4][2];
#pragma unroll
            for (int vt = 0; vt < 4; ++vt)
#pragma unroll
                for (int ks = 0; ks < 2; ++ks) vf[vt][ks] = tr_frag(sV, 72, 32 * ks, 16 * vt, fr, fq);
#pragma unroll
            for (int it = 0; it < 4; ++it) {
                f32x4 acc = (f32x4){0.f, 0.f, 0.f, 0.f};
#pragma unroll
                for (int ks = 0; ks < 2; ++ks) { const bf16x8 pf = *(const LAS bf16x8*)(sP + (16 * it + fr) * 72 + 32 * ks + 8 * fq);
                    bf16x8 vsel = vf[0][ks];
                    if (wv == 1) vsel = vf[1][ks]; else if (wv == 2) vsel = vf[2][ks]; else if (wv == 3) vsel = vf[3][ks];
                    acc = __builtin_amdgcn_mfma_f32_16x16x32_bf16(vsel, pf, acc, 0, 0, 0); }
#pragma unroll
                for (int ks = 0; ks < 4; ++ks) { const bf16x8 qf = *(const LAS bf16x8*)(sQ + (16 * it + fr) * 136 + 32 * ks + 8 * fq); const bf16x8 sf = *(const LAS bf16x8*)(sS + (16 * wv + fr) * 136 + 32 * ks + 8 * fq);
                    acc = __builtin_amdgcn_mfma_f32_16x16x32_bf16(sf, qf, acc, 0, 0, 0); }
                if (second) acc = acc + (f32x4){bflo(oprev[it].x), bfhi(oprev[it].x), bflo(oprev[it].y), bfhi(oprev[it].y)};
                store4bf(O + (size_t)(tb + 16 * it + fr) * 1024 + h * 256 + vs * 64 + 16 * wv + 4 * fq, acc);
            }
#pragma unroll
            for (int dt = 0; dt < 2; ++dt) {
                bf16x8 kf[2];
#pragma unroll
                for (int ks = 0; ks < 2; ++ks) kf[ks] = tr_frag(sK, 136, 32 * ks, 16 * (2 * wv + dt), fr, fq);
                const f32x4 tt = *(const LAS f32x4*)(sTot + 16 * (2 * wv + dt) + 4 * fq);
                const f32x4 sc = (f32x4){__expf(tt[0]), __expf(tt[1]), __expf(tt[2]), __expf(tt[3])};
#pragma unroll
                for (int vt = 0; vt < 4; ++vt) {
#pragma unroll
                    for (int ks = 0; ks < 2; ++ks) accS[dt][vt] = __builtin_amdgcn_mfma_f32_16x16x32_bf16(kf[ks], vf[vt][ks], accS[dt][vt], 0, 0, 0);
                    accS[dt][vt] = accS[dt][vt] * sc;
                }
            }
            LDS_BAR();
#pragma unroll
            for (int dt = 0; dt < 2; ++dt)
#pragma unroll
                for (int vt = 0; vt < 4; ++vt) { u32x2 w; w.x = pk_bf16(accS[dt][vt][0], accS[dt][vt][1]); w.y = pk_bf16(accS[dt][vt][2], accS[dt][vt][3]);
                    *(LAS u32x2*)(sS + (16 * vt + fr) * 136 + 16 * (2 * wv + dt) + 4 * fq) = w; }
            if (s + 1 < nch) GLA_STORE();
            __syncthreads();
        }
        if (!sample) {
#pragma unroll
            for (int dt = 0; dt < 2; ++dt)
#pragma unroll
                for (int vt = 0; vt < 4; ++vt) { float* op = OST + (((((size_t)sb * 2 + l) * 2 + grp) * 4 + h) * 128 + 16 * (2 * wv + dt) + 4 * fq) * 256 + vs * 64 + 16 * vt + fr;
#pragma unroll
                    for (int e = 0; e < 4; ++e) op[(size_t)e * 256] = accS[dt][vt][e]; }
        }
    }
#undef GLA_LOAD
#undef GLA_STORE
}

__device__ __forceinline__ void phase_glapost(const P& p, int l) {
    const int lane = tid_() & 63, gw = bid_() * 8 + (tid_() >> 6), nw = gridDim.x * 8;
    bf16_t* O = (bf16_t*)(p.ws + WS_R1); const bf16_t* R = (const bf16_t*)(p.ws + WS_R3);
    const float* gn = p.in[lnd(13)] + (size_t)l * 256 + (lane & 15) * 16;
    for (int row = gw; row < TOK; row += nw) {
        const size_t o = (size_t)row * 1024 + lane * 16; float x[16], r[16];
#pragma unroll
        for (int hh = 0; hh < 2; ++hh) { const u32x4 a = *(const u32x4*)(O + o + 8 * hh), c = *(const u32x4*)(R + o + 8 * hh);
            x[8 * hh + 0] = bflo(a.x); x[8 * hh + 1] = bfhi(a.x); x[8 * hh + 2] = bflo(a.y); x[8 * hh + 3] = bfhi(a.y); x[8 * hh + 4] = bflo(a.z); x[8 * hh + 5] = bfhi(a.z); x[8 * hh + 6] = bflo(a.w); x[8 * hh + 7] = bfhi(a.w);
            r[8 * hh + 0] = bflo(c.x); r[8 * hh + 1] = bfhi(c.x); r[8 * hh + 2] = bflo(c.y); r[8 * hh + 3] = bfhi(c.y); r[8 * hh + 4] = bflo(c.z); r[8 * hh + 5] = bfhi(c.z); r[8 * hh + 6] = bflo(c.w); r[8 * hh + 7] = bfhi(c.w); }
        float ss = 0.f;
#pragma unroll
        for (int e = 0; e < 16; ++e) ss += x[e] * x[e];
        ss += __shfl_xor(ss, 1); ss += __shfl_xor(ss, 2); ss += __shfl_xor(ss, 4); ss += __shfl_xor(ss, 8);
        const float rstd = rsqrtf(ss * (1.0f / 256.0f) + 1e-6f);
        float y[16];
#pragma unroll
        for (int e = 0; e < 16; ++e) y[e] = x[e] * rstd * gn[e] * r[e];
#pragma unroll
        for (int hh = 0; hh < 2; ++hh) { u32x4 w; w.x = pk_bf16(y[8 * hh], y[8 * hh + 1]); w.y = pk_bf16(y[8 * hh + 2], y[8 * hh + 3]); w.z = pk_bf16(y[8 * hh + 4], y[8 * hh + 5]); w.w = pk_bf16(y[8 * hh + 6], y[8 * hh + 7]); *(u32x4*)(O + o + 8 * hh) = w; }
    }
}


#define XB_TMO      128
#define XB_XCNT(j)  (256  + 64 * (j))
#define XB_XSUB(j)  (1280 + 64 * (j))
#define XB_XGEN(j)  (2304 + 64 * (j))
#define XB_TOP      3328
#define XB_TOPGEN   3392
#define XCD_BAR_WORDS 3456
#define XB_SPIN_CAP (1u << 18)
__device__ __forceinline__ unsigned xb_ld(unsigned* p)              { return __hip_atomic_load(p, __ATOMIC_RELAXED, __HIP_MEMORY_SCOPE_AGENT); }
__device__ __forceinline__ unsigned xb_add(unsigned* p, unsigned v) { return __hip_atomic_fetch_add(p, v, __ATOMIC_RELAXED, __HIP_MEMORY_SCOPE_AGENT); }
__device__ __forceinline__ unsigned xb_xcc_id() { return (unsigned)__builtin_amdgcn_s_getreg((3 << 11) | 20) & 0xFu; }
#define XB_SPIN(cond, bar) do { unsigned _sp = 0; while (cond) { __builtin_amdgcn_s_sleep(1); \
    if ((++_sp & 255u) == 0u) { if (xb_ld(&(bar)[XB_TMO])) break; if (_sp > XB_SPIN_CAP) { atomicAdd(&(bar)[XB_TMO], 1u); break; } } } } while (0)
struct XcdBarrier { unsigned* bar; unsigned x; volatile LAS unsigned* st; };
__device__ __forceinline__ XcdBarrier xcd_barrier_post(unsigned* bar, volatile LAS unsigned* st) {
    XcdBarrier b; b.bar = bar; b.x = xb_xcc_id(); b.st = st;
    if (threadIdx.x == 0) (void)xb_add(&bar[XB_XCNT(b.x)], 1u);
    return b;
}
__device__ __forceinline__ void xcd_barrier_complete(unsigned* bar, unsigned x, unsigned& nloc, unsigned& nx) {
    const unsigned G = gridDim.x * gridDim.y * gridDim.z;
    unsigned sum, cnt, mine, sp = 0u;
    for (;;) {
        sum = 0u; cnt = 0u; mine = 0u;
#pragma unroll
        for (unsigned j = 0; j < 16; ++j) { const unsigned c = xb_ld(&bar[XB_XCNT(j)]); sum += c; cnt += (c > 0u) ? 1u : 0u; mine = (j == x) ? c : mine; }
        if (sum == G) break;
        __builtin_amdgcn_s_sleep(1);
        if ((++sp & 255u) == 0u) { if (xb_ld(&bar[XB_TMO])) break; if (sp > XB_SPIN_CAP) { atomicAdd(&bar[XB_TMO], 1u); break; } }
    }
    nloc = mine > 0u ? mine : 1u; nx = cnt > 0u ? cnt : 1u;
}
__device__ __forceinline__ void xcd_barrier(const XcdBarrier& b) {
    asm volatile("s_waitcnt vmcnt(0)" ::: "memory");
    __syncthreads();
    if (threadIdx.x == 0) {
        unsigned* bar = b.bar;
        __builtin_amdgcn_s_waitcnt(0);
        unsigned nloc = b.st[0], nx = b.st[1];
        if (nloc == 0u) { xcd_barrier_complete(bar, b.x, nloc, nx); b.st[0] = nloc; b.st[1] = nx; }
        const unsigned old = xb_add(&bar[XB_XSUB(b.x)], 1u);
        const unsigned gen = old / nloc;
        if (old + 1u == (gen + 1u) * nloc) {
            __builtin_amdgcn_fence(__ATOMIC_RELEASE, "agent");
            asm volatile("s_waitcnt vmcnt(0)" ::: "memory");
            const unsigned og = xb_add(&bar[XB_TOP], 1u);
            const unsigned tg = og / nx;
            if (og + 1u == (tg + 1u) * nx) xb_add(&bar[XB_TOPGEN], 1u);
            else XB_SPIN(xb_ld(&bar[XB_TOPGEN]) == tg, bar);
            __builtin_amdgcn_fence(__ATOMIC_ACQUIRE, "agent");
            xb_add(&bar[XB_XGEN(b.x)], 1u);
            asm volatile("s_waitcnt vmcnt(0)" ::: "memory");
        } else {
            XB_SPIN(xb_ld(&bar[XB_XGEN(b.x)]) == gen, bar);
            __builtin_amdgcn_fence(__ATOMIC_ACQUIRE, "agent");
            asm volatile("s_waitcnt vmcnt(0)" ::: "memory");
        }
    }
    __syncthreads();
}

__device__ __forceinline__ void run_phase(const P& p, int ph, LAS unsigned char* lds) {
    if (ph == 2 * PPL) { if (EN(34)) phase_final(p); return; }
    const int l = ph / PPL, q = ph % PPL;
    unsigned char* ws = p.ws; bf16_t* W = (bf16_t*)(ws + WS_W);
    const int G = gridDim.x, c = bid_();
    pg8::Order S;
    switch (q) {
        case 0: if (EN(0)) phase_prep(p, l, lds); break;
        case 1: if (EN(1)) phase_norm(p, l, 1); break;
        case 2: if (EN(2)) { pg8::Gemm g{(const bf16_t*)(ws + WS_R2), W + W_A / 2, TOK, 2816, 1024, 1024, 0, 0, 1}; S.init(TOK, 2816, 1, G, c);
            EpiPartA E{(bf16_t*)(ws + WS_R3), (bf16_t*)(ws + WS_R3) + (size_t)TOK * 512, (bf16_t*)(ws + WS_R4), (bf16_t*)(ws + WS_R5), (float*)(ws + WS_GLR)};
            pg8::gemm_phase(lds, g, S, E); } break;
        case 3: if (EN(3)) { pg8::Gemm g{(const bf16_t*)(ws + WS_R5), (const bf16_t*)(ws + WS_EMAT), 1280, 256, 512, 768, (size_t)1280 * 768, (size_t)256 * 512, 32}; S.init(1280, 256, 32, G, c);
            EpiE E{(float*)(ws + WS_E)}; pg8::gemm_phase(lds, g, S, E); } break;
        case 4: if (EN(4)) phase_s5scan(p, l); break;
        case 5: if (EN(5)) { pg8::Gemm g{(const bf16_t*)(ws + WS_R5), (const bf16_t*)(ws + WS_R1), 1280, 512, 768, 768, (size_t)1280 * 768, (size_t)512 * 768, 32}; S.init(1280, 512, 32, G, c);
            EpiY E{(bf16_t*)(ws + WS_E)}; pg8::gemm_phase(lds, g, S, E); } break;
        case 6: if (EN(6)) { pg8::Gemm g{(const bf16_t*)(ws + WS_E), W + W_GLU / 2, TOK, 512, 512, 512, 0, 0, 1}; S.init(TOK, 512, 1, G, c);
            EpiGLU E{(const bf16_t*)(ws + WS_E), (bf16_t*)(ws + WS_R6), p.in[lnd(24)] + (size_t)l * 512}; pg8::gemm_phase(lds, g, S, E); } break;
        case 7: if (EN(7)) phase_glapre(p, l, lds); break;
        case 8: if (EN(8)) phase_gla(p, l, lds); break;
        case 9: if (EN(9)) { pg8::Gemm g{(const bf16_t*)(ws + WS_R2), W + W_B / 2, TOK, 3072, 1024, 1024, 0, 0, 1}; S.init(TOK, 3072, 1, G, c);
            EpiPartB E{(bf16_t*)(ws + WS_R3), (bf16_t*)(ws + WS_R4), (bf16_t*)(ws + WS_R5)}; pg8::gemm_phase(lds, g, S, E); } break;
        case 10: if (EN(10)) phase_glapost(p, l); break;
        case 11: if (EN(11)) { pg8::Gemm g{(const bf16_t*)(ws + WS_R1), W + W_PG / 2, TOK, 1024, 1024, 1024, 0, 0, 1}; S.init(TOK, 1024, 1, G, c);
              EpiProj1 E{(const bf16_t*)(ws + WS_R4), (bf16_t*)(ws + WS_R2)}; pg8::gemm_phase(lds, g, S, E); } break;
        case 12: if (EN(12)) { pg8::Gemm g{(const bf16_t*)(ws + WS_R6), W + W_PS / 2, TOK, 1024, 512, 512, 0, 0, 1}; S.init(TOK, 1024, 1, G, c);
              EpiProj2 E{(const bf16_t*)(ws + WS_R5), (bf16_t*)(ws + WS_R2)}; pg8::gemm_phase(lds, g, S, E); } break;
        case 13: if (EN(13)) { pg8::Gemm g{(const bf16_t*)(ws + WS_R2), W + W_OUT / 2, TOK, 1024, 1024, 1024, 0, 0, 1}; S.init(TOK, 1024, 1, G, c);
            EpiDelta E{(bf16_t*)(ws + WS_R3), (const float*)(ws + WS_MOD) + (size_t)l * 9 * 6144 + 2048}; pg8::gemm_phase(lds, g, S, E); } break;
        case 14: if (EN(14)) phase_norm(p, l, 2); break;
        case 15: if (EN(15)) { pg8::Gemm g{(const bf16_t*)(ws + WS_R2), W + W_1 / 2, TOK, 4096, 1024, 1024, 0, 0, 1}; S.init(TOK, 4096, 1, G, c);
            EpiFF1 E{(bf16_t*)(ws + WS_HID)}; pg8::gemm_phase(lds, g, S, E); } break;
        case 16: if (EN(16)) { pg8::Gemm g{(const bf16_t*)(ws + WS_HID), W + W_2 / 2, TOK, 1024, 4096, 4096, 0, 0, 1}; S.init(TOK, 1024, 1, G, c);
            EpiDelta E{(bf16_t*)(ws + WS_R2), (const float*)(ws + WS_MOD) + (size_t)l * 9 * 6144 + 5120}; pg8::gemm_phase(lds, g, S, E); } break;
        default: break;
    }
}

__global__ void __launch_bounds__(NTHR, 2) fwd_megakernel(P p) {
    extern __shared__ __attribute__((aligned(16))) unsigned char lds_raw[];
    LAS unsigned char* lds = (LAS unsigned char*)lds_raw;
#if MULTI_LAUNCH
    for (int ph = p.ph_lo; ph < p.ph_hi; ++ph) run_phase(p, ph, lds);
#else
    cg::grid_group grid = cg::this_grid();
    if (p.ph_lo < 0) grid.sync();
    volatile LAS unsigned* stw = (volatile LAS unsigned*)(lds + LDS_BYTES - 16);
    if (threadIdx.x < 4) stw[threadIdx.x] = 0u;
    __syncthreads();
    const XcdBarrier bar = xcd_barrier_post((unsigned*)(p.ws + WS_BAR), stw);
    for (int ph = p.ph_lo; ph < p.ph_hi; ++ph) {
        run_phase(p, ph, lds);
#if REP_MASK
        if (ph < 2 * PPL && ((REP_MASK >> (ph % PPL)) & 1)) {
            xcd_barrier(bar);
            if ((ph % PPL) == 12) { run_phase(p, ph - 1, lds); }
            run_phase(p, ph, lds);
        }
#endif
        if (ph + 1 < p.ph_hi && (ph % PPL) != 11) xcd_barrier(bar);
    }
#endif
}

extern "C" void kernel_launch(void* const* d_in, const int* in_sizes, int n_in, void* d_out, int out_size, void* d_ws, size_t ws_size, hipStream_t stream) {
    static int grid = 0;
    if (grid == 0) {
        if (n_in != 31 || ws_size < WS_END) { fprintf(stderr, "kernel_launch: unexpected n_in %d or ws_size %zu (< %zu)\n", n_in, ws_size, (size_t)WS_END); grid = -1; return; }
        int dev = 0, cus = 0, per_cu = 0;
        hipGetDevice(&dev);
        hipDeviceGetAttribute(&cus, hipDeviceAttributeMultiprocessorCount, dev);
        if (hipFuncSetAttribute((const void*)fwd_megakernel, hipFuncAttributeMaxDynamicSharedMemorySize, LDS_BYTES) != hipSuccess) { fprintf(stderr, "kernel_launch: hipFuncSetAttribute failed\n"); grid = -1; return; }
        hipOccupancyMaxActiveBlocksPerMultiprocessor(&per_cu, (const void*)fwd_megakernel, NTHR, LDS_BYTES);
        (void)hipGetLastError();
        if (per_cu < 1) fprintf(stderr, "kernel_launch: occupancy query says %d blocks per CU\n", per_cu);
        grid = cus > 0 ? cus : 256;
    }
    if (grid < 0) return;
    P p{};
    for (int i = 0; i < 31; ++i) p.in[i] = (const float*)d_in[i];
    p.out = (float*)d_out; p.ws = (unsigned char*)d_ws;
#if MULTI_LAUNCH
    for (int ph = 0; ph < NPHASE; ++ph) { p.ph_lo = ph; p.ph_hi = ph + 1; hipLaunchKernelGGL(fwd_megakernel, dim3(grid), dim3(NTHR), LDS_BYTES, stream, p); }
#else
    p.ph_lo = 0; p.ph_hi = NPHASE;
    (void)hipMemsetAsync((char*)d_ws + WS_BAR, 0, XCD_BAR_WORDS * sizeof(unsigned), stream);
    void* args[] = {&p};
    hipError_t e = hipLaunchCooperativeKernel((const void*)fwd_megakernel, dim3(grid), dim3(NTHR), args, LDS_BYTES, stream);
    if (e != hipSuccess) fprintf(stderr, "cooperative launch failed: %s (grid %d)\n", hipGetErrorString(e), grid);
#endif
}
```

```cpp
#include <hip/hip_runtime.h>
#include <hip/hip_cooperative_groups.h>
#include <cstdio>
namespace cg = cooperative_groups;

#ifndef MULTI_LAUNCH
#define MULTI_LAUNCH 0
#endif

#ifndef REP_MASK
#define REP_MASK 0
#endif
#ifndef PHASE_SEL
#define PHASE_SEL -1
#endif
#define EN(q) (PHASE_SEL < 0 || PHASE_SEL == (q))
#define LAS __attribute__((address_space(3)))
typedef unsigned short bf16_t;
typedef short bf16x8 __attribute__((ext_vector_type(8)));
typedef float f32x4 __attribute__((ext_vector_type(4)));
typedef unsigned u32x4 __attribute__((ext_vector_type(4)));
typedef unsigned u32x2 __attribute__((ext_vector_type(2)));

constexpr int NTHR = 512;
constexpr int TOK = 40960, TOKP = 8192;
constexpr int LDS_BYTES = 147456;
constexpr int NPHASE = 35;
constexpr int PPL = 17;

constexpr size_t MiB = (size_t)1 << 20;
constexpr size_t WS_MOD = 0;
constexpr size_t WS_GLR = 1 * MiB;
constexpr size_t WS_TOTF = 7 * MiB;
constexpr size_t WS_TOTB = 9 * MiB;
constexpr size_t WS_BAR = 12 * MiB;
constexpr size_t WS_W = 16 * MiB;
constexpr size_t W_A = 0;
constexpr size_t W_B = W_A + (size_t)2816 * 1024 * 2;
constexpr size_t W_PG = W_B + (size_t)3072 * 1024 * 2;
constexpr size_t W_GLU = W_PG + (size_t)1024 * 1024 * 2;
constexpr size_t W_PS = W_GLU + (size_t)512 * 512 * 2;
constexpr size_t W_OUT = W_PS + (size_t)1024 * 512 * 2;
constexpr size_t W_1 = W_OUT + (size_t)1024 * 1024 * 2;
constexpr size_t W_2 = W_1 + (size_t)4096 * 1024 * 2;
constexpr size_t WS_R2 = 50 * MiB;
constexpr size_t WS_R3 = 130 * MiB;
constexpr size_t WS_R4 = 210 * MiB;
constexpr size_t WS_R5 = 290 * MiB;
constexpr size_t WS_E = 350 * MiB;
constexpr size_t WS_R6 = 390 * MiB;
constexpr size_t WS_R1 = 430 * MiB;
constexpr size_t WS_EMAT = 454 * MiB;
constexpr size_t WS_HID = 130 * MiB;
constexpr size_t WS_END = 510 * MiB;

struct P { const float* in[31]; float* out; unsigned char* ws; int ph_lo, ph_hi; };

__device__ __forceinline__ int tid_() { int t = threadIdx.x; asm volatile("" : "+v"(t)); return t; }
__device__ __forceinline__ int bid_() { int b = blockIdx.x; asm volatile("" : "+s"(b)); return b; }
__device__ __forceinline__ int lnd(int k) { asm volatile("" : "+s"(k)); return k; }
__device__ __forceinline__ unsigned pk_bf16(float lo, float hi) { unsigned r; asm("v_cvt_pk_bf16_f32 %0, %1, %2" : "=v"(r) : "v"(lo), "v"(hi)); return r; }
__device__ __forceinline__ float bf2f(bf16_t b) { return __uint_as_float(((unsigned)b) << 16); }
__device__ __forceinline__ float bflo(unsigned w) { return __uint_as_float(w << 16); }
__device__ __forceinline__ float bfhi(unsigned w) { return __uint_as_float(w & 0xffff0000u); }
__device__ __forceinline__ bf16_t f2bf(float f) { return (bf16_t)(pk_bf16(f, 0.f) & 0xffffu); }
__device__ __forceinline__ float sigmoidf_(float x) { return 1.0f / (1.0f + __expf(-x)); }
__device__ __forceinline__ void store4bf(bf16_t* ptr, f32x4 v) { u32x2 w; w.x = pk_bf16(v[0], v[1]); w.y = pk_bf16(v[2], v[3]); *(u32x2*)ptr = w; }
__device__ __forceinline__ f32x4 load4bf(const bf16_t* ptr) { u32x2 w = *(const u32x2*)ptr; return (f32x4){bflo(w.x), bfhi(w.x), bflo(w.y), bfhi(w.y)}; }
__device__ __forceinline__ int mod_index(int tok) { return tok < TOKP ? 0 : (tok >> 12) - 1; }
__device__ __forceinline__ float wave_sum(float v) {
#pragma unroll
    for (int o = 32; o >= 1; o >>= 1) v += __shfl_xor(v, o);
    return v;
}

namespace pg8 {
constexpr int BM = 256, BK = 64, HALF = 128, HTB = HALF * BK * 2, STAGE_BYTES = 8 * HTB, NXCD = 8, WGM = 8;
__device__ __forceinline__ int lds_byte(int r, int c) { const int st = (r >> 4) * 2 + (c >> 5), rr = r & 15, cc = c & 31, ob = rr * 64 + cc * 2; return st * 1024 + (ob ^ (((ob >> 9) & 1) << 5)); }
__device__ __forceinline__ void stage_rc(int b, int& R, int& C) { const int st = b / 1024, sb = b % 1024, swz = sb ^ (((sb >> 9) & 1) << 5); R = (st >> 1) * 16 + swz / 64; C = (st & 1) * 32 + (swz % 64) / 2; }

struct Unit { int pm, pn, z; };
struct Gemm { const bf16_t* A; const bf16_t* Bt; int M, N, K, lda; size_t sA, sB; int nz; };
struct Order {
    int nM, nN, nwg, G, c, nz;
    __device__ void init(int M, int N, int nz_, int G_, int c_) { nM = M / BM; nN = N / BM; nwg = nM * nN; G = G_; c = c_; nz = nz_; }
    __device__ bool next(int i, Unit& u) const {
        const long L = (long)i * G + c; if (L >= (long)nwg * nz) return false;
        if (nz == 1) {
            int wgid = (int)L; { const int q = nwg / NXCD, r = nwg % NXCD, xcd = wgid % NXCD, off = wgid / NXCD; wgid = (xcd < r ? xcd * (q + 1) : r * (q + 1) + (xcd - r) * q) + off; }
            const int nig = WGM * nN, gid = wgid / nig, fm = gid * WGM, gsz = (nM - fm) < WGM ? (nM - fm) : WGM;
            u.pm = fm + ((wgid % nig) % gsz); u.pn = (wgid % nig) / gsz; u.z = 0;
        } else {
            const int z = (int)(L / nwg), r = (int)(L % nwg); u.z = z; u.pm = r % nM; u.pn = r / nM;
        }
        return true;
    }
};

template <class Epi>
__device__ __forceinline__ void gemm_phase(LAS unsigned char* lds, const Gemm g, const Order& S, const Epi& E) {
    const int tid = tid_(), wid = __builtin_amdgcn_readfirstlane(tid >> 6), lane = tid & 63, wr = wid >> 2, wc = wid & 3, fr = lane & 15, fq = lane >> 4;
    const int K = g.K, nt = K / BK;
    unsigned voffA[2], voffB[2];
#pragma unroll
    for (int i = 0; i < 2; ++i) { int R, C; stage_rc(tid * 16 + i * 8192, R, C); voffA[i] = (unsigned)(R * g.lda + C) * 2u; voffB[i] = (unsigned)(R * K + C) * 2u; }
    const size_t kstep = (size_t)(BK * 2);
    const size_t hstepA = (size_t)HALF * g.lda * 2, hstepB = (size_t)HALF * K * 2;
    const unsigned ldsw = (unsigned)wid * 1024u;
    const int aoff = lds_byte(wr * 64 + fr, fq * 8), boff = lds_byte(wc * 32 + fr, fq * 8);
#define PG8_SA(b, h) (((b) * 2 + (h)) * HTB)
#define PG8_SB(b, h) ((4 + (b) * 2 + (h)) * HTB)
#define PG8_STAGE(bufoff, gbase, voff) do { _Pragma("unroll") for (int _i = 0; _i < 2; ++_i) \
        __builtin_amdgcn_global_load_lds((const unsigned*)((const char*)(gbase) + (voff)[_i]), (LAS unsigned*)(lds + (bufoff) + ldsw + _i * 8192), 16, 0, 0); } while (0)
#define PG8_LDA(dst, b, h) do { _Pragma("unroll") for (int m = 0; m < 4; ++m) _Pragma("unroll") for (int k = 0; k < 2; ++k) dst[m][k] = *(const LAS bf16x8*)(lds + PG8_SA(b, h) + aoff + m * 2048 + k * 1024); } while (0)
#define PG8_LDB(dst, b, h) do { _Pragma("unroll") for (int n = 0; n < 2; ++n) _Pragma("unroll") for (int k = 0; k < 2; ++k) dst[n][k] = *(const LAS bf16x8*)(lds + PG8_SB(b, h) + boff + n * 2048 + k * 1024); } while (0)
#define PG8_MMA(ai, bj, At, Bt) do { __builtin_amdgcn_s_setprio(1); _Pragma("unroll") for (int m = 0; m < 4; ++m) _Pragma("unroll") for (int n = 0; n < 2; ++n) _Pragma("unroll") for (int k = 0; k < 2; ++k) \
        acc[ai][bj][m][n] = __builtin_amdgcn_mfma_f32_16x16x32_bf16(Bt[n][k], At[m][k], acc[ai][bj][m][n], 0, 0, 0); __builtin_amdgcn_s_setprio(0); } while (0)
#define PG8_WAIT_V(n) asm volatile("s_waitcnt vmcnt(" #n ")" ::: "memory")
#define PG8_WAIT_L(n) asm volatile("s_waitcnt lgkmcnt(" #n ")" ::: "memory")
#define PG8_BAR __builtin_amdgcn_s_barrier()
#define PG8_SCHED __builtin_amdgcn_sched_barrier(0)
    Unit cur, nxt; int ui = 0;
    if (!S.next(0, cur)) return;
    f32x4 acc[2][2][4][2];
#pragma unroll
    for (int a = 0; a < 2; ++a)
#pragma unroll
        for (int b = 0; b < 2; ++b)
#pragma unroll
            for (int m = 0; m < 4; ++m)
#pragma unroll
                for (int n = 0; n < 2; ++n) acc[a][b][m][n] = (f32x4){0.f, 0.f, 0.f, 0.f};
    bf16x8 At[4][2], B0[2][2], B1[2][2];
    const char* cA = (const char*)g.A + ((size_t)cur.z * g.sA + (size_t)cur.pm * BM * g.lda) * 2;
    const char* cB = (const char*)g.Bt + ((size_t)cur.z * g.sB + (size_t)cur.pn * BM * K) * 2;
    PG8_STAGE(PG8_SB(0, 0), cB, voffB); PG8_STAGE(PG8_SB(0, 1), cB + hstepB, voffB); PG8_STAGE(PG8_SA(0, 0), cA, voffA); PG8_STAGE(PG8_SA(0, 1), cA + hstepA, voffA);
    if (wr == 1) PG8_BAR;
    PG8_WAIT_V(2); PG8_BAR;
    PG8_STAGE(PG8_SB(1, 0), cB + kstep, voffB); PG8_STAGE(PG8_SA(1, 0), cA + kstep, voffA); PG8_STAGE(PG8_SB(1, 1), cB + hstepB + kstep, voffB);
    PG8_WAIT_V(6); PG8_BAR;
    for (;;) {
        const bool has_next = S.next(ui + 1, nxt);
        const char* nA = has_next ? (const char*)g.A + ((size_t)nxt.z * g.sA + (size_t)nxt.pm * BM * g.lda) * 2 : cA;
        const char* nB = has_next ? (const char*)g.Bt + ((size_t)nxt.z * g.sB + (size_t)nxt.pn * BM * K) * 2 : cB;
        for (int t = 0; t < nt; t += 2) {
            const bool last = (t == nt - 2);
            const char* a1 = cA + (size_t)(t + 1) * kstep;
            const char* a2 = last ? nA : cA + (size_t)(t + 2) * kstep; const char* b2 = last ? nB : cB + (size_t)(t + 2) * kstep;
            const char* a3 = a2 + kstep; const char* b3 = b2 + kstep;
            PG8_LDB(B0, 0, 0); PG8_LDB(B1, 0, 1); PG8_SCHED; PG8_LDA(At, 0, 0); PG8_STAGE(PG8_SA(1, 1), a1 + hstepA, voffA);
            PG8_WAIT_V(8); PG8_WAIT_L(0); PG8_BAR; PG8_MMA(0, 0, At, B0); PG8_MMA(0, 1, At, B1); PG8_BAR; PG8_SCHED;
            PG8_LDA(At, 0, 1); PG8_STAGE(PG8_SB(0, 0), b2, voffB); PG8_STAGE(PG8_SB(0, 1), b2 + hstepB, voffB); PG8_STAGE(PG8_SA(0, 0), a2, voffA);
            PG8_WAIT_V(8); PG8_WAIT_L(0); PG8_BAR; PG8_MMA(1, 0, At, B0); PG8_MMA(1, 1, At, B1); PG8_BAR; PG8_SCHED;
            PG8_LDB(B0, 1, 0); PG8_LDB(B1, 1, 1); PG8_SCHED; PG8_LDA(At, 1, 0); PG8_STAGE(PG8_SA(0, 1), a2 + hstepA, voffA);
            PG8_WAIT_V(8); PG8_WAIT_L(0); PG8_BAR; PG8_MMA(0, 0, At, B0); PG8_MMA(0, 1, At, B1); PG8_BAR; PG8_SCHED;
            PG8_LDA(At, 1, 1); PG8_STAGE(PG8_SB(1, 0), b3, voffB); PG8_STAGE(PG8_SB(1, 1), b3 + hstepB, voffB); PG8_STAGE(PG8_SA(1, 0), a3, voffA);
            PG8_WAIT_V(8); PG8_WAIT_L(0); PG8_BAR; PG8_MMA(1, 0, At, B0); PG8_MMA(1, 1, At, B1); PG8_BAR; PG8_SCHED;
        }
        if (wr == 0) PG8_BAR;
        E.tile(acc, cur.z, cur.pm * BM + wr * 64 + fr, cur.pn * BM + wc * 32 + 4 * fq);
        if (!has_next) break;
#pragma unroll
        for (int a = 0; a < 2; ++a)
#pragma unroll
            for (int b = 0; b < 2; ++b)
#pragma unroll
                for (int m = 0; m < 4; ++m)
#pragma unroll
                    for (int n = 0; n < 2; ++n) acc[a][b][m][n] = (f32x4){0.f, 0.f, 0.f, 0.f};
        cur = nxt; cA = nA; cB = nB; ++ui;
        if (wr == 1) PG8_BAR;
    }
    PG8_WAIT_V(0);
    PG8_BAR;
#undef PG8_SA
#undef PG8_SB
#undef PG8_STAGE
#undef PG8_LDA
#undef PG8_LDB
#undef PG8_MMA
#undef PG8_WAIT_V
#undef PG8_WAIT_L
#undef PG8_BAR
#undef PG8_SCHED
}
}

#define EPI_SIMPLE_TILE() \
    __device__ __forceinline__ void tile(const f32x4 (&acc)[2][2][4][2], int z, int row0, int col0) const { \
        _Pragma("unroll") for (int ai = 0; ai < 2; ++ai) _Pragma("unroll") for (int m = 0; m < 4; ++m) _Pragma("unroll") for (int bj = 0; bj < 2; ++bj) _Pragma("unroll") for (int n = 0; n < 2; ++n) \
            (*this)(z, row0 + ai * 128 + m * 16, col0 + bj * 128 + n * 16, acc[ai][bj][m][n]); }
#define EPI_PIPE_TILE() \
    __device__ __forceinline__ void tile(const f32x4 (&acc)[2][2][4][2], int z, int row0, int col0) const { \
        Pre pre; begin(row0, col0, pre); L buf[2][8]; \
        _Pragma("unroll") for (int mm = 0; mm < 2; ++mm) _Pragma("unroll") for (int bj = 0; bj < 2; ++bj) _Pragma("unroll") for (int n = 0; n < 2; ++n) load(row0 + mm * 16, col0 + bj * 128 + n * 16, buf[0][mm * 4 + bj * 2 + n]); \
        _Pragma("unroll") for (int b = 0; b < 4; ++b) { \
            if (b < 3) { _Pragma("unroll") for (int mm = 0; mm < 2; ++mm) _Pragma("unroll") for (int bj = 0; bj < 2; ++bj) _Pragma("unroll") for (int n = 0; n < 2; ++n) \
                load(row0 + ((b + 1) >> 1) * 128 + (((b + 1) & 1) * 2 + mm) * 16, col0 + bj * 128 + n * 16, buf[(b + 1) & 1][mm * 4 + bj * 2 + n]); } \
            _Pragma("unroll") for (int mm = 0; mm < 2; ++mm) _Pragma("unroll") for (int bj = 0; bj < 2; ++bj) _Pragma("unroll") for (int n = 0; n < 2; ++n) \
                apply(row0 + (b >> 1) * 128 + ((b & 1) * 2 + mm) * 16, col0 + bj * 128 + n * 16, acc[b >> 1][bj][(b & 1) * 2 + mm][n], buf[b & 1][mm * 4 + bj * 2 + n], pre, bj * 2 + n); } }

struct EpiPartA {
    bf16_t* Q; bf16_t* Kk; bf16_t* V; bf16_t* UG; float* GLR;
    __device__ __forceinline__ void operator()(int, int row, int col, f32x4 v) const {
        if (col < 512) store4bf(Q + (size_t)row * 512 + col, v);
        else if (col < 1024) store4bf(Kk + (size_t)row * 512 + (col - 512), v);
        else if (col < 2048) store4bf(V + (size_t)row * 1024 + (col - 1024), v);
        else if (col < 2304) { const int c = col - 2048; if (c < 32) *(f32x4*)(GLR + (size_t)row * 32 + c) = v; }
        else { const int c = col - 2304, g = c >> 4, n = c & 15, chunk = row >> 5, j = row & 31; store4bf(UG + ((size_t)(g * 1280 + chunk) * 768 + j * 16 + n), v); }
    }
    EPI_SIMPLE_TILE()
};
struct EpiE { float* E; __device__ __forceinline__ void operator()(int z, int row, int col, f32x4 v) const { *(f32x4*)(E + ((size_t)(z * 1280 + row) * 256 + col)) = v; } EPI_SIMPLE_TILE() };
struct EpiY {
    bf16_t* YB;
    __device__ __forceinline__ void operator()(int z, int row, int col, f32x4 v) const {
        const int tok = row * 32 + (col >> 4), ch = z * 16 + (col & 15);
        f32x4 o;
#pragma unroll
        for (int e = 0; e < 4; ++e) { const float x = v[e]; o[e] = x * sigmoidf_(1.5957691216f * (x + 0.044715f * x * x * x)); }
        store4bf(YB + (size_t)tok * 512 + ch, o);
    }
    EPI_SIMPLE_TILE()
};
struct EpiGLU {
    const bf16_t* YB; bf16_t* OS5; const float* bglu;
    typedef u32x2 L; struct Pre { f32x4 b[4]; };
    __device__ __forceinline__ void begin(int, int col0, Pre& pr) const {
#pragma unroll
        for (int k = 0; k < 4; ++k) pr.b[k] = *(const f32x4*)(bglu + col0 + (k >> 1) * 128 + (k & 1) * 16); }
    __device__ __forceinline__ void load(int row, int col, L& l) const { l = *(const u32x2*)(YB + (size_t)row * 512 + col); }
    __device__ __forceinline__ void apply(int row, int col, f32x4 v, const L& l, const Pre& pr, int k) const {
        const f32x4 y = (f32x4){bflo(l.x), bfhi(l.x), bflo(l.y), bfhi(l.y)}; f32x4 o;
#pragma unroll
        for (int e = 0; e < 4; ++e) o[e] = y[e] * sigmoidf_(v[e] + pr.b[k][e]);
        store4bf(OS5 + (size_t)row * 512 + col, o); }
    EPI_PIPE_TILE()
};
struct EpiPartB {
    bf16_t* R; bf16_t* GA; bf16_t* GB;
    __device__ __forceinline__ void operator()(int, int row, int col, f32x4 v) const {
        f32x4 s;
#pragma unroll
        for (int e = 0; e < 4; ++e) s[e] = sigmoidf_(v[e]);
        if (col < 1024) { store4bf(R + (size_t)row * 1024 + col, v * s); }
        else if (col < 2048) store4bf(GA + (size_t)row * 1024 + (col - 1024), s);
        else store4bf(GB + (size_t)row * 1024 + (col - 2048), s);
    }
    EPI_SIMPLE_TILE()
};
struct EpiProj1 { const bf16_t* GA; bf16_t* T1;
    typedef u32x2 L; struct Pre { int dummy; };
    __device__ __forceinline__ void begin(int, int, Pre&) const {}
    __device__ __forceinline__ void load(int row, int col, L& l) const { l = *(const u32x2*)(GA + (size_t)row * 1024 + col); }
    __device__ __forceinline__ void apply(int row, int col, f32x4 v, const L& l, const Pre&, int) const {
        const f32x4 g = (f32x4){bflo(l.x), bfhi(l.x), bflo(l.y), bfhi(l.y)}; store4bf(T1 + (size_t)row * 1024 + col, g * v); }
    EPI_PIPE_TILE()
};
struct EpiProj2 { const bf16_t* GB; bf16_t* T1;
    struct L { u32x2 t, g; }; struct Pre { int dummy; };
    __device__ __forceinline__ void begin(int, int, Pre&) const {}
    __device__ __forceinline__ void load(int row, int col, L& l) const { const size_t o = (size_t)row * 1024 + col; l.t = *(const u32x2*)(T1 + o); l.g = *(const u32x2*)(GB + o); }
    __device__ __forceinline__ void apply(int row, int col, f32x4 v, const L& l, const Pre&, int) const {
        const f32x4 g = (f32x4){bflo(l.g.x), bfhi(l.g.x), bflo(l.g.y), bfhi(l.g.y)}, t = (f32x4){bflo(l.t.x), bfhi(l.t.x), bflo(l.t.y), bfhi(l.t.y)};
        store4bf(T1 + (size_t)row * 1024 + col, t + g * v); }
    EPI_PIPE_TILE()
};
struct EpiDelta { bf16_t* Dl; const float* gate;
    __device__ __forceinline__ void tile(const f32x4 (&acc)[2][2][4][2], int, int row0, int col0) const {
        const float* gp = gate + (size_t)mod_index(row0) * 6144 + col0; f32x4 g[2][2];
#pragma unroll
        for (int bj = 0; bj < 2; ++bj)
#pragma unroll
            for (int n = 0; n < 2; ++n) g[bj][n] = *(const f32x4*)(gp + bj * 128 + n * 16);
#pragma unroll
        for (int ai = 0; ai < 2; ++ai)
#pragma unroll
            for (int m = 0; m < 4; ++m)
#pragma unroll
                for (int bj = 0; bj < 2; ++bj)
#pragma unroll
                    for (int n = 0; n < 2; ++n) store4bf(Dl + (size_t)(row0 + ai * 128 + m * 16) * 1024 + col0 + bj * 128 + n * 16, g[bj][n] * acc[ai][bj][m][n]);
    } };
struct EpiFF1 { bf16_t* H;
    __device__ __forceinline__ void operator()(int, int row, int col, f32x4 v) const {
        f32x4 o;
#pragma unroll
        for (int e = 0; e < 4; ++e) { const float r = fmaxf(v[e], 0.f); o[e] = r * r; }
        store4bf(H + (size_t)row * 4096 + col, o); }
    EPI_SIMPLE_TILE()
};

struct ConvJob { const float* src; int ld, K, c0, nvalid, ndst; bf16_t* dst; float scale; };
__device__ __forceinline__ bool conv_job(const P& p, int l, int j, ConvJob& J) {
    bf16_t* W = (bf16_t*)(p.ws + WS_W);
    const float* win = p.in[lnd(10)] + (size_t)l * 1024 * 5664;
    J.scale = 1.0f;
    switch (j) {
        case 0: J = {win, 5664, 1024, 0, 512, 512, W + W_A / 2, 0.08838834764831845f}; break;
        case 1: J = {win, 5664, 1024, 512, 512, 512, W + W_A / 2 + (size_t)512 * 1024, 1.f}; break;
        case 2: J = {win, 5664, 1024, 1024, 1024, 1024, W + W_A / 2 + (size_t)1024 * 1024, 1.f}; break;
        case 3: J = {win, 5664, 1024, 3072, 32, 256, W + W_A / 2 + (size_t)2048 * 1024, 1.f}; break;
        case 4: J = {win, 5664, 1024, 3104, 512, 512, W + W_A / 2 + (size_t)2304 * 1024, 1.f}; break;
        case 5: J = {win, 5664, 1024, 2048, 1024, 1024, W + W_B / 2, 1.f}; break;
        case 6: J = {win, 5664, 1024, 3616, 1024, 1024, W + W_B / 2 + (size_t)1024 * 1024, 1.f}; break;
        case 7: J = {win, 5664, 1024, 4640, 1024, 1024, W + W_B / 2 + (size_t)2048 * 1024, 1.f}; break;
        case 8: J = {p.in[lnd(14)] + (size_t)l * 1024 * 1024, 1024, 1024, 0, 1024, 1024, W + W_PG / 2, 1.f}; break;
        case 9: J = {p.in[lnd(23)] + (size_t)l * 512 * 512, 512, 512, 0, 512, 512, W + W_GLU / 2, 1.f}; break;
        case 10: J = {p.in[lnd(25)] + (size_t)l * 512 * 1024, 1024, 512, 0, 1024, 1024, W + W_PS / 2, 1.f}; break;
        case 11: J = {p.in[lnd(26)] + (size_t)l * 1024 * 1024, 1024, 1024, 0, 1024, 1024, W + W_OUT / 2, 1.f}; break;
        case 12: J = {p.in[lnd(28)] + (size_t)l * 1024 * 4096, 4096, 1024, 0, 4096, 4096, W + W_1 / 2, 1.f}; break;
        case 13: J = {p.in[lnd(29)] + (size_t)l * 4096 * 1024, 1024, 4096, 0, 1024, 1024, W + W_2 / 2, 1.f}; break;
        default: return false;
    }
    return true;
}
constexpr int CONV_TILES = 2112;
__device__ __forceinline__ void conv_tile(const P& p, int l, int tile, LAS float* sT) {
    const int tid = tid_();
    ConvJob J; int j = 0, rem = tile;
    for (; j < 14; ++j) { conv_job(p, l, j, J); const int nt = (J.ndst / 64) * (J.K / 128); if (rem < nt) break; rem -= nt; }
    const int kts = J.K / 128, ntile = rem / kts, ktile = rem % kts, n0 = ntile * 64, k0 = ktile * 128;
    {
        const int kk = tid >> 4, c4 = (tid & 15) * 4; f32x4 v[4];
#pragma unroll
        for (int i = 0; i < 4; ++i) { v[i] = (f32x4){0.f, 0.f, 0.f, 0.f};
            if (n0 + c4 < J.nvalid) v[i] = *(const f32x4*)(J.src + (size_t)(k0 + kk + 32 * i) * J.ld + J.c0 + n0 + c4); }
#pragma unroll
        for (int i = 0; i < 4; ++i)
#pragma unroll
            for (int e = 0; e < 4; ++e) sT[(c4 + e) * 129 + kk + 32 * i] = v[i][e] * J.scale;
    }
    __syncthreads();
    {
        const int n = tid >> 3, ks = (tid & 7) * 16;
        const LAS float* sp = sT + n * 129 + ks;
#pragma unroll
        for (int hh = 0; hh < 2; ++hh) { u32x4 w; const LAS float* q = sp + 8 * hh;
            w.x = pk_bf16(q[0], q[1]); w.y = pk_bf16(q[2], q[3]); w.z = pk_bf16(q[4], q[5]); w.w = pk_bf16(q[6], q[7]);
            *(u32x4*)(J.dst + (size_t)(n0 + n) * J.K + k0 + ks + 8 * hh) = w; }
    }
}

__device__ __forceinline__ void mod_task(const P& p, int m, LAS float* sm) {
    const int tid = tid_(), l = m / 192, colbase = (m % 192) * 32, cl = tid & 31, ks = tid >> 5;
    LAS float* SC = sm; LAS float* RED = sm + 9216;
    for (int i = tid; i < 9216; i += NTHR) { const int j = i >> 10, k = i & 1023; const float c = (j == 0) ? p.in[lnd(6)][k] : p.in[lnd(2)][(j - 1) * 1024 + k]; SC[i] = c * sigmoidf_(c); }
    __syncthreads();
    float acc[9];
#pragma unroll
    for (int j = 0; j < 9; ++j) acc[j] = 0.f;
    const float* w = p.in[lnd(7)] + (size_t)l * 1024 * 6144 + colbase + cl;
    for (int k8 = 0; k8 < 64; k8 += 16) { float wv[16];
#pragma unroll
        for (int u = 0; u < 16; ++u) wv[u] = w[(size_t)(ks * 64 + k8 + u) * 6144];
#pragma unroll
        for (int u = 0; u < 16; ++u)
#pragma unroll
            for (int j = 0; j < 9; ++j) acc[j] += SC[j * 1024 + ks * 64 + k8 + u] * wv[u]; }
#pragma unroll
    for (int j = 0; j < 9; ++j) RED[(ks * 9 + j) * 32 + cl] = acc[j];
    __syncthreads();
    if (tid < 288) { const int j = tid >> 5, c = tid & 31; float s = 0.f;
#pragma unroll
        for (int q = 0; q < 16; ++q) s += RED[(q * 9 + j) * 32 + c];
        float* mod = (float*)(p.ws + WS_MOD);
        mod[((size_t)l * 9 + j) * 6144 + colbase + c] = s + p.in[lnd(8)][(size_t)l * 6144 + colbase + c]; }
}

__device__ __forceinline__ void s5_mats(const P& p, int l, int gq, LAS float* sm) {
    const int tid = tid_(), g = gq >> 2, part = gq & 3;
    LAS float* KF = sm; LAS float* KB = sm + 8192; LAS float* LT = sm + 16384; LAS float* CC = sm + 20608; LAS float* BB = sm + 22656;
    bf16_t* MC = (bf16_t*)(p.ws + WS_R1) + (size_t)g * 512 * 768;
    bf16_t* EM = (bf16_t*)(p.ws + WS_EMAT) + (size_t)g * 256 * 512;
    for (int d = 0; d < 2; ++d) {
        const int pg = (l * 2 + d) * 32 + g;
        const float* lamr = p.in[lnd(15)] + (size_t)pg * 64; const float* lami = p.in[lnd(16)] + (size_t)pg * 64;
        const float dt = expf(p.in[lnd(17)][pg]);
        const float* bre = p.in[lnd(18)] + (size_t)pg * 1024; const float* bim = p.in[lnd(19)] + (size_t)pg * 1024;
        const float* cre = p.in[lnd(20)] + (size_t)pg * 1024; const float* cim = p.in[lnd(21)] + (size_t)pg * 1024;
        for (int i = tid; i < 33 * 64; i += NTHR) { const int tau = i >> 6, pp = i & 63; const float a = expf(lamr[pp] * dt * (float)tau); float s, c; sincosf(lami[pp] * dt * (float)tau, &s, &c); LT[2 * i] = a * c; LT[2 * i + 1] = a * s; }
        for (int i = tid; i < 1024; i += NTHR) { CC[2 * i] = cre[i]; CC[2 * i + 1] = cim[i]; }
        for (int i = tid; i < 1024; i += NTHR) {
            const int pp = i >> 4; const float lr = lamr[pp], li = lami[pp]; float s, c; sincosf(li * dt, &s, &c);
            const float em1 = expm1f(lr * dt); float sh, ch; sincosf(0.5f * li * dt, &sh, &ch);
            const float nr = em1 * c - 2.f * sh * sh, ni = (em1 + 1.f) * s;
            const float inv = 1.f / (lr * lr + li * li);
            const float qr = (nr * lr + ni * li) * inv, qi = (ni * lr - nr * li) * inv;
            const float br = bre[i], bi = bim[i];
            BB[2 * i] = qr * br - qi * bi; BB[2 * i + 1] = qr * bi + qi * br;
        }
        __syncthreads();
        {
            const int tau = tid >> 4, n = tid & 15; float acc[16];
#pragma unroll
            for (int m = 0; m < 16; ++m) acc[m] = 0.f;
            for (int pp = 0; pp < 64; ++pp) {
                const float cr = CC[2 * (n * 64 + pp)], ci = CC[2 * (n * 64 + pp) + 1], lr = LT[2 * (tau * 64 + pp)], li = LT[2 * (tau * 64 + pp) + 1];
                const float xr = cr * lr - ci * li, xi = cr * li + ci * lr;
#pragma unroll
                for (int m = 0; m < 16; ++m) acc[m] += xr * BB[2 * (pp * 16 + m)] - xi * BB[2 * (pp * 16 + m) + 1];
            }
            LAS float* Kd = d ? KB : KF;
#pragma unroll
            for (int m = 0; m < 16; ++m) Kd[(tau * 16 + n) * 16 + m] = acc[m];
        }
        {
            const int pp = tid >> 3, cseg = tid & 7;
            { const int jj = part;
                const int j = cseg * 4 + jj, e = d == 0 ? 31 - j : j; const float lr = LT[2 * (e * 64 + pp)], li = LT[2 * (e * 64 + pp) + 1];
                float re[16], im[16];
#pragma unroll
                for (int m = 0; m < 16; ++m) { const float br = BB[2 * (pp * 16 + m)], bi = BB[2 * (pp * 16 + m) + 1]; re[m] = lr * br - li * bi; im[m] = lr * bi + li * br; }
                bf16_t* er = EM + (size_t)(d * 128 + pp) * 512 + j * 16; bf16_t* ei = EM + (size_t)(d * 128 + 64 + pp) * 512 + j * 16;
#pragma unroll
                for (int h = 0; h < 2; ++h) {
                    u32x4 w; w.x = pk_bf16(re[8 * h], re[8 * h + 1]); w.y = pk_bf16(re[8 * h + 2], re[8 * h + 3]); w.z = pk_bf16(re[8 * h + 4], re[8 * h + 5]); w.w = pk_bf16(re[8 * h + 6], re[8 * h + 7]); *(u32x4*)(er + 8 * h) = w;
                    u32x4 x; x.x = pk_bf16(im[8 * h], im[8 * h + 1]); x.y = pk_bf16(im[8 * h + 2], im[8 * h + 3]); x.z = pk_bf16(im[8 * h + 4], im[8 * h + 5]); x.w = pk_bf16(im[8 * h + 6], im[8 * h + 7]); *(u32x4*)(ei + 8 * h) = x;
                }
            }
        }
        {
            const int t = tid >> 4, n = tid & 15, f = d == 0 ? t + 1 : 32 - t;
            bf16_t* mr = MC + (size_t)tid * 768 + 512 + d * 128;
#pragma unroll 1
            for (int p8 = 2 * part; p8 < 2 * part + 2; ++p8) {
                float re[8], im[8];
#pragma unroll
                for (int q = 0; q < 8; ++q) { const int pp = p8 * 8 + q; const float cr = CC[2 * (n * 64 + pp)], ci = CC[2 * (n * 64 + pp) + 1], lr = LT[2 * (f * 64 + pp)], li = LT[2 * (f * 64 + pp) + 1];
                    re[q] = cr * lr - ci * li; im[q] = -(cr * li + ci * lr); }
                u32x4 w; w.x = pk_bf16(re[0], re[1]); w.y = pk_bf16(re[2], re[3]); w.z = pk_bf16(re[4], re[5]); w.w = pk_bf16(re[6], re[7]); *(u32x4*)(mr + p8 * 8) = w;
                u32x4 x; x.x = pk_bf16(im[0], im[1]); x.y = pk_bf16(im[2], im[3]); x.z = pk_bf16(im[4], im[5]); x.w = pk_bf16(im[6], im[7]); *(u32x4*)(mr + 64 + p8 * 8) = x;
            }
        }
        __syncthreads();
    }
    {
        const int t = tid >> 4, n = tid & 15; const float dsk = p.in[lnd(22)][(size_t)l * 512 + g * 16 + n];
        bf16_t* mr = MC + (size_t)tid * 768;
#pragma unroll 1
        for (int j = 8 * part; j < 8 * part + 8; ++j) {
            float v[16];
#pragma unroll
            for (int m = 0; m < 16; ++m) v[m] = 0.f;
            if (j <= t) { const LAS float* k = KF + ((t - j) * 16 + n) * 16;
#pragma unroll
                for (int m = 0; m < 16; ++m) v[m] += k[m]; }
            if (j >= t) { const LAS float* k = KB + ((j - t) * 16 + n) * 16;
#pragma unroll
                for (int m = 0; m < 16; ++m) v[m] += k[m]; }
            if (j == t) {
#pragma unroll
                for (int m = 0; m < 16; ++m) v[m] += (m == n) ? dsk : 0.f; }
            u32x4 w; w.x = pk_bf16(v[0], v[1]); w.y = pk_bf16(v[2], v[3]); w.z = pk_bf16(v[4], v[5]); w.w = pk_bf16(v[6], v[7]); *(u32x4*)(mr + j * 16) = w;
            u32x4 x; x.x = pk_bf16(v[8], v[9]); x.y = pk_bf16(v[10], v[11]); x.z = pk_bf16(v[12], v[13]); x.w = pk_bf16(v[14], v[15]); *(u32x4*)(mr + j * 16 + 8) = x;
        }
    }
}

__device__ __forceinline__ void phase_prep(const P& p, int l, LAS unsigned char* lds) {
    LAS float* sm = (LAS float*)lds;
    const int nmod = (l == 0) ? 384 : 0, total = 128 + nmod + CONV_TILES;
    for (int task = bid_(); task < total; task += gridDim.x) {
        if (task < 128) s5_mats(p, l, task, sm);
        else if (task < 128 + nmod) mod_task(p, task - 128, sm);
        else conv_tile(p, l, task - 128 - nmod, sm);
        __syncthreads();
    }
}

__device__ __forceinline__ void norm_row_write(const f32x4 (&x)[4], const float* g, const float* mod, int shoff, int scoff, bf16_t* hrow, int lane) {
    float ss = 0.f;
#pragma unroll
    for (int i = 0; i < 4; ++i) ss += x[i][0] * x[i][0] + x[i][1] * x[i][1] + x[i][2] * x[i][2] + x[i][3] * x[i][3];
    ss = wave_sum(ss);
    const float rstd = rsqrtf(ss * (1.0f / 1024.0f) + 1e-6f);
#pragma unroll
    for (int i = 0; i < 4; ++i) { const int d = i * 256 + lane * 4; const f32x4 gg = *(const f32x4*)(g + d), sc = *(const f32x4*)(mod + scoff + d), sh = *(const f32x4*)(mod + shoff + d);
        f32x4 h;
#pragma unroll
        for (int e = 0; e < 4; ++e) h[e] = x[i][e] * rstd * gg[e] * (1.f + sc[e]) + sh[e];
        store4bf(hrow + d, h); }
}
__device__ __forceinline__ void phase_norm(const P& p, int l, int which) {
    const int lane = tid_() & 63, gw = bid_() * 8 + (tid_() >> 6), nw = gridDim.x * 8;
    const float* g = (which == 1 ? p.in[lnd(9)] : p.in[lnd(27)]) + (size_t)l * 1024;
    const float* modl = (const float*)(p.ws + WS_MOD) + (size_t)l * 9 * 6144;
    const int shoff = which == 1 ? 0 : 3072, scoff = which == 1 ? 1024 : 4096;
    bf16_t* H = (bf16_t*)(p.ws + WS_R2); float* X = p.out;
    if (which == 1 && l == 0) {
        for (int item = gw; item < 4096 + 8192; item += nw) {
            if (item < 4096) {
                const int n = item; const float rr = (float)(n >> 6), cc = (float)(n & 63); f32x4 pe[4];
#pragma unroll
                for (int e = 0; e < 4; ++e) { const float om = expf(-(float)(lane * 4 + e) * (9.210340371976184f / 256.0f)); float s, c; sincosf(rr * om, &s, &c); pe[0][e] = s; pe[1][e] = c; sincosf(cc * om, &s, &c); pe[2][e] = s; pe[3][e] = c; }
                for (int b0 = 0; b0 < 8; b0 += 2) { f32x4 x[2][4];
#pragma unroll
                    for (int r = 0; r < 2; ++r) { const float* src = p.in[lnd(1)] + ((size_t)(b0 + r) * 4096 + n) * 1024;
#pragma unroll
                        for (int i = 0; i < 4; ++i) x[r][i] = *(const f32x4*)(src + i * 256 + lane * 4); }
#pragma unroll
                    for (int r = 0; r < 2; ++r) { const int row = TOKP + (b0 + r) * 4096 + n;
#pragma unroll
                        for (int i = 0; i < 4; ++i) { x[r][i] = x[r][i] + pe[i]; *(f32x4*)(X + (size_t)row * 1024 + i * 256 + lane * 4) = x[r][i]; }
                        norm_row_write(x[r], g, modl + (size_t)(1 + b0 + r) * 6144, shoff, scoff, H + (size_t)row * 1024, lane); } }
            } else { const int row = item - 4096; const float* src = p.in[lnd(0)] + (size_t)row * 1024; f32x4 x[4];
#pragma unroll
                for (int i = 0; i < 4; ++i) { x[i] = *(const f32x4*)(src + i * 256 + lane * 4); *(f32x4*)(X + (size_t)row * 1024 + i * 256 + lane * 4) = x[i]; }
                norm_row_write(x, g, modl, shoff, scoff, H + (size_t)row * 1024, lane); }
        }
    } else {
        const bf16_t* DL = (const bf16_t*)(p.ws + (which == 1 ? WS_R2 : WS_R3));
        for (int row0 = gw; row0 < TOK; row0 += 4 * nw) {
            f32x4 x[4][4]; u32x2 dv[4][4];
#pragma unroll
            for (int r = 0; r < 4; ++r) { const int row = row0 + r * nw;
                if (row < TOK) {
#pragma unroll
                    for (int i = 0; i < 4; ++i) { x[r][i] = *(const f32x4*)(X + (size_t)row * 1024 + i * 256 + lane * 4); dv[r][i] = *(const u32x2*)(DL + (size_t)row * 1024 + i * 256 + lane * 4); } } }
#pragma unroll
            for (int r = 0; r < 4; ++r) { const int row = row0 + r * nw;
                if (row < TOK) {
#pragma unroll
                    for (int i = 0; i < 4; ++i) { x[r][i] = x[r][i] + (f32x4){bflo(dv[r][i].x), bfhi(dv[r][i].x), bflo(dv[r][i].y), bfhi(dv[r][i].y)}; *(f32x4*)(X + (size_t)row * 1024 + i * 256 + lane * 4) = x[r][i]; }
                    norm_row_write(x[r], g, modl + (size_t)mod_index(row) * 6144, shoff, scoff, H + (size_t)row * 1024, lane); } }
        }
    }
}
__device__ __forceinline__ void phase_final(const P& p) {
    const int lane = tid_() & 63, gw = bid_() * 8 + (tid_() >> 6), nw = gridDim.x * 8; float* X = p.out; const float* g = p.in[lnd(30)]; const bf16_t* DL = (const bf16_t*)(p.ws + WS_R2);
    for (int row0 = gw; row0 < TOK; row0 += 4 * nw) {
        f32x4 x[4][4]; u32x2 dv[4][4];
#pragma unroll
        for (int r = 0; r < 4; ++r) { const int row = row0 + r * nw;
            if (row < TOK) {
#pragma unroll
                for (int i = 0; i < 4; ++i) { x[r][i] = *(const f32x4*)(X + (size_t)row * 1024 + i * 256 + lane * 4); dv[r][i] = *(const u32x2*)(DL + (size_t)row * 1024 + i * 256 + lane * 4); } } }
#pragma unroll
        for (int r = 0; r < 4; ++r) { const int row = row0 + r * nw;
            if (row < TOK) { float ss = 0.f;
#pragma unroll
                for (int i = 0; i < 4; ++i) { x[r][i] = x[r][i] + (f32x4){bflo(dv[r][i].x), bfhi(dv[r][i].x), bflo(dv[r][i].y), bfhi(dv[r][i].y)}; ss += x[r][i][0] * x[r][i][0] + x[r][i][1] * x[r][i][1] + x[r][i][2] * x[r][i][2] + x[r][i][3] * x[r][i][3]; }
                ss = wave_sum(ss); const float rstd = rsqrtf(ss * (1.0f / 1024.0f) + 1e-6f);
#pragma unroll
                for (int i = 0; i < 4; ++i) { const f32x4 gg = *(const f32x4*)(g + i * 256 + lane * 4); *(f32x4*)(X + (size_t)row * 1024 + i * 256 + lane * 4) = x[r][i] * rstd * gg; } } }
    }
}

__device__ __forceinline__ void phase_s5scan(const P& p, int l) {
    const float* E = (const float*)(p.ws + WS_E); bf16_t* UG = (bf16_t*)(p.ws + WS_R5);
    float* ore = p.out + (size_t)TOK * 1024 + 16777216; float* oim = ore + 262144;
    for (int task = bid_(); task < 320; task += gridDim.x) {
        const int idx = task * NTHR + tid_(), pp = idx & 63, d = (idx >> 6) & 1, g = (idx >> 7) & 31, s = 39 - (idx >> 12);
        const int nch = s < 32 ? 8 : 128, cbase = s < 32 ? s * 8 : 256 + (s - 32) * 128;
        const int pg = (l * 2 + d) * 32 + g; const float dt = expf(p.in[lnd(17)][pg]);
        const float a = expf(p.in[lnd(15)][(size_t)pg * 64 + pp] * dt * 32.f); float sn, cs; sincosf(p.in[lnd(16)][(size_t)pg * 64 + pp] * dt * 32.f, &sn, &cs);
        const float ar = a * cs, ai = a * sn;
        float sr = 0.f, si = 0.f;
        if (s >= 32) { const size_t o = ((((size_t)(s - 32) * 2 + l) * 2 + d) * 32 + g) * 64 + pp; sr = p.in[lnd(4)][o]; si = p.in[lnd(5)][o]; }
        const float* Eb = E + ((size_t)(g * 1280 + cbase) * 256 + d * 128 + pp);
        bf16_t* Ub = UG + ((size_t)(g * 1280 + cbase) * 768 + 512 + d * 128 + pp);
        for (int c0 = 0; c0 < nch; c0 += 8) {
            float er[8], ei[8];
#pragma unroll
            for (int k = 0; k < 8; ++k) { const int c = d == 0 ? c0 + k : nch - 1 - (c0 + k); er[k] = Eb[(size_t)c * 256]; ei[k] = Eb[(size_t)c * 256 + 64]; }
#pragma unroll
            for (int k = 0; k < 8; ++k) { const int c = d == 0 ? c0 + k : nch - 1 - (c0 + k);
                Ub[(size_t)c * 768] = f2bf(sr); Ub[(size_t)c * 768 + 64] = f2bf(si);
                const float nr = ar * sr - ai * si + er[k], ni = ar * si + ai * sr + ei[k]; sr = nr; si = ni; }
        }
        if (s < 32) { const size_t o = ((((size_t)s * 2 + l) * 2 + d) * 32 + g) * 64 + pp; ore[o] = sr; oim[o] = si; }
    }
}

__device__ __forceinline__ void phase_glapre(const P& p, int l, LAS unsigned char* lds) {
    const int tid = tid_(), d = tid & 127, tq = tid >> 7;
    LAS float* sG = (LAS float*)lds; LAS float* sT4 = sG + 2048;
    bf16_t* Q = (bf16_t*)(p.ws + WS_R3); bf16_t* Kk = Q + (size_t)TOK * 512;
    bf16_t* QB = (bf16_t*)(p.ws + WS_R5); bf16_t* KB = QB + (size_t)TOK * 512;
    const float* GLR = (const float*)(p.ws + WS_GLR);
    for (int task = bid_(); task < 2560; task += gridDim.x) {
        const int c64 = task >> 2, h = task & 3, tb = c64 * 64;
        { const int row = tid >> 3, c4 = (tid & 7) * 4; *(LAS f32x4*)(sG + row * 32 + c4) = *(const f32x4*)(GLR + (size_t)(tb + row) * 32 + c4); }
        float qv[16], kv[16];
#pragma unroll
        for (int i = 0; i < 16; ++i) { const size_t o = (size_t)(tb + tq * 16 + i) * 512 + h * 128 + d; qv[i] = bf2f(Q[o]); kv[i] = bf2f(Kk[o]); }
        __syncthreads();
#pragma unroll 1
        for (int dir = 0; dir < 2; ++dir) {
            float w[16];
#pragma unroll
            for (int r = 0; r < 16; ++r) w[r] = p.in[lnd(11)][((size_t)(l * 2 + dir) * 16 + r) * 512 + h * 128 + d];
            const float bg = p.in[lnd(12)][(size_t)(l * 2 + dir) * 512 + h * 128 + d];
            float cum[16];
#pragma unroll
            for (int i = 0; i < 16; ++i) { const LAS float* gr = sG + (tq * 16 + i) * 32 + dir * 16; float z = bg;
#pragma unroll
                for (int r = 0; r < 16; ++r) z += gr[r] * w[r];
                cum[i] = (fminf(z, 0.f) - __logf(1.0f + __expf(-fabsf(z)))) * 0.0625f; }
            if (dir == 0) {
#pragma unroll
                for (int i = 1; i < 16; ++i) cum[i] += cum[i - 1];
            } else {
#pragma unroll
                for (int i = 14; i >= 0; --i) cum[i] += cum[i + 1];
            }
            sT4[tq * 128 + d] = dir == 0 ? cum[15] : cum[0];
            __syncthreads();
            float off = 0.f, total = 0.f;
#pragma unroll
            for (int q = 0; q < 4; ++q) { const float v = sT4[q * 128 + d]; total += v; if (dir == 0 ? (q < tq) : (q > tq)) off += v; }
            bf16_t* QD = dir == 0 ? Q : QB; bf16_t* KI = dir == 0 ? Kk : KB;
#pragma unroll
            for (int i = 0; i < 16; ++i) { const float cm = cum[i] + off; const size_t o = (size_t)(tb + tq * 16 + i) * 512 + h * 128 + d;
                QD[o] = f2bf(qv[i] * __expf(cm)); KI[o] = f2bf(kv[i] * __expf(-cm)); }
            if (tq == 0) ((float*)(p.ws + (dir == 0 ? WS_TOTF : WS_TOTB)))[(size_t)c64 * 512 + h * 128 + d] = total;
            __syncthreads();
        }
    }
}

constexpr int GLA_GRP = 71168;
typedef short s16x4 __attribute__((ext_vector_type(4)));
__device__ __forceinline__ bf16x8 tr_frag(const LAS bf16_t* base, int stride, int krow0, int col0, int fr, int fq) {
    const LAS bf16_t* q = base + (krow0 + 8 * fq + (fr >> 2)) * stride + col0 + 4 * (fr & 3);
    const s16x4 a = __builtin_amdgcn_ds_read_tr16_b64_v4i16((LAS s16x4*)q);
    const s16x4 b = __builtin_amdgcn_ds_read_tr16_b64_v4i16((LAS s16x4*)(q + 4 * stride));
    return __builtin_shufflevector(a, b, 0, 1, 2, 3, 4, 5, 6, 7);
}
#define LDS_BAR() do { asm volatile("s_waitcnt lgkmcnt(0)" ::: "memory"); __builtin_amdgcn_s_barrier(); asm volatile("" ::: "memory"); } while (0)
__device__ __forceinline__ void phase_gla(const P& p, int l, LAS unsigned char* lds) {
    const int tid = tid_(), grp = __builtin_amdgcn_readfirstlane(tid >> 8), gt = tid & 255, wv = __builtin_amdgcn_readfirstlane((tid >> 6) & 3), lane = tid & 63, fr = lane & 15, fq = lane >> 4;
    LAS unsigned char* gl = lds + grp * GLA_GRP;
    LAS bf16_t* sQ = (LAS bf16_t*)gl; LAS bf16_t* sK = (LAS bf16_t*)(gl + 17408); LAS bf16_t* sV = (LAS bf16_t*)(gl + 34816);
    LAS bf16_t* sP = (LAS bf16_t*)(gl + 44032); LAS bf16_t* sS = (LAS bf16_t*)(gl + 53248); LAS float* sTot = (LAS float*)(gl + 70656);
    const bf16_t* QD = grp == 0 ? (const bf16_t*)(p.ws + WS_R3) : (const bf16_t*)(p.ws + WS_R5);
    const bf16_t* KI = QD + (size_t)TOK * 512;
    const bf16_t* V = (const bf16_t*)(p.ws + WS_R4);
    const float* TOT = (const float*)(p.ws + (grp == 0 ? WS_TOTF : WS_TOTB));
    bf16_t* O = (bf16_t*)(p.ws + WS_R1);
    float* OST = p.out + (size_t)TOK * 1024;
    const int G = gridDim.x, b = bid_();
    const bool custom = (G == 256);
    const int ntask_mine = custom ? (b < 128 ? 1 : 4) : ((640 - b + G - 1) / G);
    for (int ti = 0; ti < ntask_mine; ++ti) {
        const int task = custom ? (b < 128 ? b : b + 128 * ti) : b + G * ti;
        if (task >= 640) break;
        const bool sample = task < 128;
        const int t2 = sample ? task : task - 128, xcd_ = t2 & 7, vs = (t2 >> 3) & 3, sh_ = xcd_ + 8 * (t2 >> 5), sb = sh_ >> 2, h = sh_ & 3;
        const int base = sample ? TOKP + sb * 4096 : sb * 256, nch = sample ? 64 : 4;
        f32x4 accS[2][4];
#pragma unroll
        for (int dt = 0; dt < 2; ++dt)
#pragma unroll
            for (int vt = 0; vt < 4; ++vt) {
                f32x4 a = (f32x4){0.f, 0.f, 0.f, 0.f};
                if (sample) { const float* cp = p.in[lnd(3)] + (((((size_t)sb * 2 + l) * 2 + grp) * 4 + h) * 128 + 16 * (2 * wv + dt) + 4 * fq) * 256 + vs * 64 + 16 * vt + fr;
#pragma unroll
                    for (int e = 0; e < 4; ++e) a[e] = cp[(size_t)e * 256]; }
                accS[dt][vt] = a;
                u32x2 w; w.x = pk_bf16(a[0], a[1]); w.y = pk_bf16(a[2], a[3]);
                *(LAS u32x2*)(sS + (16 * vt + fr) * 136 + 16 * (2 * wv + dt) + 4 * fq) = w;
            }
        u32x4 rq[4], rk[4], rv[2]; float rt = 0.f;
#define GLA_LOAD(ci) do { const int tb_ = base + (ci) * 64; \
        _Pragma("unroll") for (int i = 0; i < 4; ++i) { const int idx = gt + 256 * i, row = idx >> 4, c16 = idx & 15; const size_t o = (size_t)(tb_ + row) * 512 + h * 128 + c16 * 8; rq[i] = *(const u32x4*)(QD + o); rk[i] = *(const u32x4*)(KI + o); } \
        _Pragma("unroll") for (int i = 0; i < 2; ++i) { const int idx = gt + 256 * i, row = idx >> 3, c8 = idx & 7; rv[i] = *(const u32x4*)(V + (size_t)(tb_ + row) * 1024 + h * 256 + vs * 64 + c8 * 8); } \
        if (gt < 128) rt = TOT[(size_t)(tb_ >> 6) * 512 + h * 128 + gt]; } while (0)
#define GLA_STORE() do { \
        _Pragma("unroll") for (int i = 0; i < 4; ++i) { const int idx = gt + 256 * i, row = idx >> 4, c16 = idx & 15; *(LAS u32x4*)(sQ + row * 136 + c16 * 8) = rq[i]; *(LAS u32x4*)(sK + row * 136 + c16 * 8) = rk[i]; } \
        _Pragma("unroll") for (int i = 0; i < 2; ++i) { const int idx = gt + 256 * i, row = idx >> 3, c8 = idx & 7; *(LAS u32x4*)(sV + row * 72 + c8 * 8) = rv[i]; } \
        if (gt < 128) sTot[gt] = rt; } while (0)
        GLA_LOAD(grp == 0 ? 0 : nch - 1);
        GLA_STORE();
        __syncthreads();
        for (int s = 0; s < nch; ++s) {
            const int ci = grp == 0 ? s : nch - 1 - s, tb = base + ci * 64;
            const bool second = (s >= (nch >> 1));
            u32x2 oprev[4];
#pragma unroll
            for (int vt = 0; vt < 4; ++vt) oprev[vt] = *(const u32x2*)(O + (size_t)(tb + 16 * wv + fr) * 1024 + h * 256 + vs * 64 + 16 * vt + 4 * fq);
            asm volatile("" ::: "memory");
            if (s + 1 < nch) GLA_LOAD(grp == 0 ? s + 1 : nch - 2 - s);
            bf16x8 qa[4];
#pragma unroll
            for (int ks = 0; ks < 4; ++ks) qa[ks] = *(const LAS bf16x8*)(sQ + (16 * wv + fr) * 136 + 32 * ks + 8 * fq);
#pragma unroll
            for (int jt = 0; jt < 4; ++jt) {
                bf16x8 kb[4];
#pragma unroll
                for (int ks = 0; ks < 4; ++ks) kb[ks] = *(const LAS bf16x8*)(sK + (16 * jt + fr) * 136 + 32 * ks + 8 * fq);
                f32x4 acc = (f32x4){0.f, 0.f, 0.f, 0.f};
#pragma unroll
                for (int ks = 0; ks < 4; ++ks) acc = __builtin_amdgcn_mfma_f32_16x16x32_bf16(qa[ks], kb[ks], acc, 0, 0, 0);
#pragma unroll
                for (int e = 0; e < 4; ++e) { const int i = 16 * wv + 4 * fq + e, j = 16 * jt + fr; const bool keep = grp == 0 ? (j <= i) : (j >= i); sP[i * 72 + j] = f2bf(keep ? acc[e] : 0.f); }
            }
            bf16x8 vf[4][2];
#pragma unroll
            for (int vt = 0; vt < 4; ++vt)
#pragma unroll
                for (int ks = 0; ks < 2; ++ks) vf[vt][ks] = tr_frag(sV, 72, 32 * ks, 16 * vt, fr, fq);
#pragma unroll
            for (int dt = 0; dt < 2; ++dt) {
                bf16x8 kf[2];
#pragma unroll
                for (int ks = 0; ks < 2; ++ks) kf[ks] = tr_frag(sK, 136, 32 * ks, 16 * (2 * wv + dt), fr, fq);
                const f32x4 tt = *(const LAS f32x4*)(sTot + 16 * (2 * wv + dt) + 4 * fq);
                const f32x4 sc = (f32x4){__expf(tt[0]), __expf(tt[1]), __expf(tt[2]), __expf(tt[3])};
#pragma unroll
                for (int vt = 0; vt < 4; ++vt) {
#pragma unroll
                    for (int ks = 0; ks < 2; ++ks) accS[dt][vt] = __builtin_amdgcn_mfma_f32_16x16x32_bf16(kf[ks], vf[vt][ks], accS[dt][vt], 0, 0, 0);
                    accS[dt][vt] = accS[dt][vt] * sc;
                }
            }
            asm volatile("s_waitcnt lgkmcnt(0)" ::: "memory");
            {
                bf16x8 pf[2];
#pragma unroll
                for (int ks = 0; ks < 2; ++ks) pf[ks] = *(const LAS bf16x8*)(sP + (16 * wv + fr) * 72 + 32 * ks + 8 * fq);
#pragma unroll
                for (int vt = 0; vt < 4; ++vt) {
                    f32x4 acc = (f32x4){0.f, 0.f, 0.f, 0.f};
#pragma unroll
                    for (int ks = 0; ks < 2; ++ks) acc = __builtin_amdgcn_mfma_f32_16x16x32_bf16(vf[vt][ks], pf[ks], acc, 0, 0, 0);
#pragma unroll
                    for (int ks = 0; ks < 4; ++ks) { const bf16x8 sf = *(const LAS bf16x8*)(sS + (16 * vt + fr) * 136 + 32 * ks + 8 * fq);
                        acc = __builtin_amdgcn_mfma_f32_16x16x32_bf16(sf, qa[ks], acc, 0, 0, 0); }
                    { u32x2 pv = oprev[vt]; asm volatile("" : "+v"(pv));
                      if (second) acc = acc + (f32x4){bflo(pv.x), bfhi(pv.x), bflo(pv.y), bfhi(pv.y)}; }
                    store4bf(O + (size_t)(tb + 16 * wv + fr) * 1024 + h * 256 + vs * 64 + 16 * vt + 4 * fq, acc);
                }
            }
            LDS_BAR();
#pragma unroll
            for (int dt = 0; dt < 2; ++dt)
#pragma unroll
                for (int vt = 0; vt < 4; ++vt) { u32x2 w; w.x = pk_bf16(accS[dt][vt][0], accS[dt][vt][1]); w.y = pk_bf16(accS[dt][vt][2], accS[dt][vt][3]);
                    *(LAS u32x2*)(sS + (16 * vt + fr) * 136 + 16 * (2 * wv + dt) + 4 * fq) = w; }
            if (s + 1 < nch) GLA_STORE();
            if (s == (nch >> 1) - 1) { asm volatile("s_waitcnt vmcnt(0)" ::: "memory"); __syncthreads(); } else LDS_BAR();
        }
        if (!sample) {
#pragma unroll
            for (int dt = 0; dt < 2; ++dt)
#pragma unroll
                for (int vt = 0; vt < 4; ++vt) { float* op = OST + (((((size_t)sb * 2 + l) * 2 + grp) * 4 + h) * 128 + 16 * (2 * wv + dt) + 4 * fq) * 256 + vs * 64 + 16 * vt + fr;
#pragma unroll
                    for (int e = 0; e < 4; ++e) op[(size_t)e * 256] = accS[dt][vt][e]; }
        }
    }
#undef GLA_LOAD
#undef GLA_STORE
}

__device__ __forceinline__ void phase_glapost(const P& p, int l) {
    const int lane = tid_() & 63, gw = bid_() * 8 + (tid_() >> 6), nw = gridDim.x * 8;
    bf16_t* O = (bf16_t*)(p.ws + WS_R1); const bf16_t* R = (const bf16_t*)(p.ws + WS_R3);
    const float* gn = p.in[lnd(13)] + (size_t)l * 256 + (lane & 15) * 16;
    for (int row = gw; row < TOK; row += nw) {
        const size_t o = (size_t)row * 1024 + lane * 16; float x[16], r[16];
#pragma unroll
        for (int hh = 0; hh < 2; ++hh) { const u32x4 a = *(const u32x4*)(O + o + 8 * hh), c = *(const u32x4*)(R + o + 8 * hh);
            x[8 * hh + 0] = bflo(a.x); x[8 * hh + 1] = bfhi(a.x); x[8 * hh + 2] = bflo(a.y); x[8 * hh + 3] = bfhi(a.y); x[8 * hh + 4] = bflo(a.z); x[8 * hh + 5] = bfhi(a.z); x[8 * hh + 6] = bflo(a.w); x[8 * hh + 7] = bfhi(a.w);
            r[8 * hh + 0] = bflo(c.x); r[8 * hh + 1] = bfhi(c.x); r[8 * hh + 2] = bflo(c.y); r[8 * hh + 3] = bfhi(c.y); r[8 * hh + 4] = bflo(c.z); r[8 * hh + 5] = bfhi(c.z); r[8 * hh + 6] = bflo(c.w); r[8 * hh + 7] = bfhi(c.w); }
        float ss = 0.f;
#pragma unroll
        for (int e = 0; e < 16; ++e) ss += x[e] * x[e];
        ss += __shfl_xor(ss, 1); ss += __shfl_xor(ss, 2); ss += __shfl_xor(ss, 4); ss += __shfl_xor(ss, 8);
        const float rstd = rsqrtf(ss * (1.0f / 256.0f) + 1e-6f);
        float y[16];
#pragma unroll
        for (int e = 0; e < 16; ++e) y[e] = x[e] * rstd * gn[e] * r[e];
#pragma unroll
        for (int hh = 0; hh < 2; ++hh) { u32x4 w; w.x = pk_bf16(y[8 * hh], y[8 * hh + 1]); w.y = pk_bf16(y[8 * hh + 2], y[8 * hh + 3]); w.z = pk_bf16(y[8 * hh + 4], y[8 * hh + 5]); w.w = pk_bf16(y[8 * hh + 6], y[8 * hh + 7]); *(u32x4*)(O + o + 8 * hh) = w; }
    }
}


#define XB_TMO      128
#define XB_XCNT(j)  (256  + 64 * (j))
#define XB_XSUB(j)  (1280 + 64 * (j))
#define XB_XGEN(j)  (2304 + 64 * (j))
#define XB_TOP      3328
#define XB_TOPGEN   3392
#define XCD_BAR_WORDS 3456
#define XB_SPIN_CAP (1u << 18)
__device__ __forceinline__ unsigned xb_ld(unsigned* p)              { return __hip_atomic_load(p, __ATOMIC_RELAXED, __HIP_MEMORY_SCOPE_AGENT); }
__device__ __forceinline__ unsigned xb_add(unsigned* p, unsigned v) { return __hip_atomic_fetch_add(p, v, __ATOMIC_RELAXED, __HIP_MEMORY_SCOPE_AGENT); }
__device__ __forceinline__ unsigned xb_xcc_id() { return (unsigned)__builtin_amdgcn_s_getreg((3 << 11) | 20) & 0xFu; }
#define XB_SPIN(cond, bar) do { unsigned _sp = 0; while (cond) { __builtin_amdgcn_s_sleep(1); \
    if ((++_sp & 255u) == 0u) { if (xb_ld(&(bar)[XB_TMO])) break; if (_sp > XB_SPIN_CAP) { atomicAdd(&(bar)[XB_TMO], 1u); break; } } } } while (0)
struct XcdBarrier { unsigned* bar; unsigned x; volatile LAS unsigned* st; };
__device__ __forceinline__ XcdBarrier xcd_barrier_post(unsigned* bar, volatile LAS unsigned* st) {
    XcdBarrier b; b.bar = bar; b.x = xb_xcc_id(); b.st = st;
    if (threadIdx.x == 0) (void)xb_add(&bar[XB_XCNT(b.x)], 1u);
    return b;
}
__device__ __forceinline__ void xcd_barrier_complete(unsigned* bar, unsigned x, unsigned& nloc, unsigned& nx) {
    const unsigned G = gridDim.x * gridDim.y * gridDim.z;
    unsigned sum, cnt, mine, sp = 0u;
    for (;;) {
        sum = 0u; cnt = 0u; mine = 0u;
#pragma unroll
        for (unsigned j = 0; j < 16; ++j) { const unsigned c = xb_ld(&bar[XB_XCNT(j)]); sum += c; cnt += (c > 0u) ? 1u : 0u; mine = (j == x) ? c : mine; }
        if (sum == G) break;
        __builtin_amdgcn_s_sleep(1);
        if ((++sp & 255u) == 0u) { if (xb_ld(&bar[XB_TMO])) break; if (sp > XB_SPIN_CAP) { atomicAdd(&bar[XB_TMO], 1u); break; } }
    }
    nloc = mine > 0u ? mine : 1u; nx = cnt > 0u ? cnt : 1u;
}
__device__ __forceinline__ void xcd_barrier(const XcdBarrier& b) {
    asm volatile("s_waitcnt vmcnt(0)" ::: "memory");
    __syncthreads();
    if (threadIdx.x == 0) {
        unsigned* bar = b.bar;
        __builtin_amdgcn_s_waitcnt(0);
        unsigned nloc = b.st[0], nx = b.st[1];
        if (nloc == 0u) { xcd_barrier_complete(bar, b.x, nloc, nx); b.st[0] = nloc; b.st[1] = nx; }
        const unsigned old = xb_add(&bar[XB_XSUB(b.x)], 1u);
        const unsigned gen = old / nloc;
        if (old + 1u == (gen + 1u) * nloc) {
            __builtin_amdgcn_fence(__ATOMIC_RELEASE, "agent");
            asm volatile("s_waitcnt vmcnt(0)" ::: "memory");
            const unsigned og = xb_add(&bar[XB_TOP], 1u);
            const unsigned tg = og / nx;
            if (og + 1u == (tg + 1u) * nx) xb_add(&bar[XB_TOPGEN], 1u);
            else XB_SPIN(xb_ld(&bar[XB_TOPGEN]) == tg, bar);
            __builtin_amdgcn_fence(__ATOMIC_ACQUIRE, "agent");
            xb_add(&bar[XB_XGEN(b.x)], 1u);
            asm volatile("s_waitcnt vmcnt(0)" ::: "memory");
        } else {
            XB_SPIN(xb_ld(&bar[XB_XGEN(b.x)]) == gen, bar);
            __builtin_amdgcn_fence(__ATOMIC_ACQUIRE, "agent");
            asm volatile("s_waitcnt vmcnt(0)" ::: "memory");
        }
    }
    __syncthreads();
}

__device__ __forceinline__ void run_phase(const P& p, int ph, LAS unsigned char* lds) {
    if (ph == 2 * PPL) { if (EN(34)) phase_final(p); return; }
    const int l = ph / PPL, q = ph % PPL;
    unsigned char* ws = p.ws; bf16_t* W = (bf16_t*)(ws + WS_W);
    const int G = gridDim.x, c = bid_();
    pg8::Order S;
    switch (q) {
        case 0: if (EN(0)) phase_prep(p, l, lds); break;
        case 1: if (EN(1)) phase_norm(p, l, 1); break;
        case 2: if (EN(2)) { pg8::Gemm g{(const bf16_t*)(ws + WS_R2), W + W_A / 2, TOK, 2816, 1024, 1024, 0, 0, 1}; S.init(TOK, 2816, 1, G, c);
            EpiPartA E{(bf16_t*)(ws + WS_R3), (bf16_t*)(ws + WS_R3) + (size_t)TOK * 512, (bf16_t*)(ws + WS_R4), (bf16_t*)(ws + WS_R5), (float*)(ws + WS_GLR)};
            pg8::gemm_phase(lds, g, S, E); } break;
        case 3: if (EN(3)) { pg8::Gemm g{(const bf16_t*)(ws + WS_R5), (const bf16_t*)(ws + WS_EMAT), 1280, 256, 512, 768, (size_t)1280 * 768, (size_t)256 * 512, 32}; S.init(1280, 256, 32, G, c);
            EpiE E{(float*)(ws + WS_E)}; pg8::gemm_phase(lds, g, S, E); } break;
        case 4: if (EN(4)) phase_s5scan(p, l); break;
        case 5: if (EN(5)) { pg8::Gemm g{(const bf16_t*)(ws + WS_R5), (const bf16_t*)(ws + WS_R1), 1280, 512, 768, 768, (size_t)1280 * 768, (size_t)512 * 768, 32}; S.init(1280, 512, 32, G, c);
            EpiY E{(bf16_t*)(ws + WS_E)}; pg8::gemm_phase(lds, g, S, E); } break;
        case 6: if (EN(6)) { pg8::Gemm g{(const bf16_t*)(ws + WS_E), W + W_GLU / 2, TOK, 512, 512, 512, 0, 0, 1}; S.init(TOK, 512, 1, G, c);
            EpiGLU E{(const bf16_t*)(ws + WS_E), (bf16_t*)(ws + WS_R6), p.in[lnd(24)] + (size_t)l * 512}; pg8::gemm_phase(lds, g, S, E); } break;
        case 7: if (EN(7)) phase_glapre(p, l, lds); break;
        case 8: if (EN(8)) phase_gla(p, l, lds); break;
        case 9: if (EN(9)) { pg8::Gemm g{(const bf16_t*)(ws + WS_R2), W + W_B / 2, TOK, 3072, 1024, 1024, 0, 0, 1}; S.init(TOK, 3072, 1, G, c);
            EpiPartB E{(bf16_t*)(ws + WS_R3), (bf16_t*)(ws + WS_R4), (bf16_t*)(ws + WS_R5)}; pg8::gemm_phase(lds, g, S, E); } break;
        case 10: if (EN(10)) phase_glapost(p, l); break;
        case 11: if (EN(11)) { pg8::Gemm g{(const bf16_t*)(ws + WS_R1), W + W_PG / 2, TOK, 1024, 1024, 1024, 0, 0, 1}; S.init(TOK, 1024, 1, G, c);
              EpiProj1 E{(const bf16_t*)(ws + WS_R4), (bf16_t*)(ws + WS_R2)}; pg8::gemm_phase(lds, g, S, E); } break;
        case 12: if (EN(12)) { pg8::Gemm g{(const bf16_t*)(ws + WS_R6), W + W_PS / 2, TOK, 1024, 512, 512, 0, 0, 1}; S.init(TOK, 1024, 1, G, c);
              EpiProj2 E{(const bf16_t*)(ws + WS_R5), (bf16_t*)(ws + WS_R2)}; pg8::gemm_phase(lds, g, S, E); } break;
        case 13: if (EN(13)) { pg8::Gemm g{(const bf16_t*)(ws + WS_R2), W + W_OUT / 2, TOK, 1024, 1024, 1024, 0, 0, 1}; S.init(TOK, 1024, 1, G, c);
            EpiDelta E{(bf16_t*)(ws + WS_R3), (const float*)(ws + WS_MOD) + (size_t)l * 9 * 6144 + 2048}; pg8::gemm_phase(lds, g, S, E); } break;
        case 14: if (EN(14)) phase_norm(p, l, 2); break;
        case 15: if (EN(15)) { pg8::Gemm g{(const bf16_t*)(ws + WS_R2), W + W_1 / 2, TOK, 4096, 1024, 1024, 0, 0, 1}; S.init(TOK, 4096, 1, G, c);
            EpiFF1 E{(bf16_t*)(ws + WS_HID)}; pg8::gemm_phase(lds, g, S, E); } break;
        case 16: if (EN(16)) { pg8::Gemm g{(const bf16_t*)(ws + WS_HID), W + W_2 / 2, TOK, 1024, 4096, 4096, 0, 0, 1}; S.init(TOK, 1024, 1, G, c);
            EpiDelta E{(bf16_t*)(ws + WS_R2), (const float*)(ws + WS_MOD) + (size_t)l * 9 * 6144 + 5120}; pg8::gemm_phase(lds, g, S, E); } break;
        default: break;
    }
}

__global__ void __launch_bounds__(NTHR, 2) fwd_megakernel(P p) {
    extern __shared__ __attribute__((aligned(16))) unsigned char lds_raw[];
    LAS unsigned char* lds = (LAS unsigned char*)lds_raw;
#if MULTI_LAUNCH
    for (int ph = p.ph_lo; ph < p.ph_hi; ++ph) run_phase(p, ph, lds);
#else
    cg::grid_group grid = cg::this_grid();
    if (p.ph_lo < 0) grid.sync();
    volatile LAS unsigned* stw = (volatile LAS unsigned*)(lds + LDS_BYTES - 16);
    if (threadIdx.x < 4) stw[threadIdx.x] = 0u;
    __syncthreads();
    const XcdBarrier bar = xcd_barrier_post((unsigned*)(p.ws + WS_BAR), stw);
    for (int ph = p.ph_lo; ph < p.ph_hi; ++ph) {
        run_phase(p, ph, lds);
#if REP_MASK
        if (ph < 2 * PPL && ((REP_MASK >> (ph % PPL)) & 1)) {
            xcd_barrier(bar);
            if ((ph % PPL) == 12) { run_phase(p, ph - 1, lds); }
            run_phase(p, ph, lds);
        }
#endif
        if (ph + 1 < p.ph_hi && (ph % PPL) != 11) xcd_barrier(bar);
    }
#endif
}

extern "C" void kernel_launch(void* const* d_in, const int* in_sizes, int n_in, void* d_out, int out_size, void* d_ws, size_t ws_size, hipStream_t stream) {
    static int grid = 0;
    if (grid == 0) {
        if (n_in != 31 || ws_size < WS_END) { fprintf(stderr, "kernel_launch: unexpected n_in %d or ws_size %zu (< %zu)\n", n_in, ws_size, (size_t)WS_END); grid = -1; return; }
        int dev = 0, cus = 0, per_cu = 0;
        hipGetDevice(&dev);
        hipDeviceGetAttribute(&cus, hipDeviceAttributeMultiprocessorCount, dev);
        if (hipFuncSetAttribute((const void*)fwd_megakernel, hipFuncAttributeMaxDynamicSharedMemorySize, LDS_BYTES) != hipSuccess) { fprintf(stderr, "kernel_launch: hipFuncSetAttribute failed\n"); grid = -1; return; }
        hipOccupancyMaxActiveBlocksPerMultiprocessor(&per_cu, (const void*)fwd_megakernel, NTHR, LDS_BYTES);
        (void)hipGetLastError();
        if (per_cu < 1) fprintf(stderr, "kernel_launch: occupancy query says %d blocks per CU\n", per_cu);
        grid = cus > 0 ? cus : 256;
    }
    if (grid < 0) return;
    P p{};
    for (int i = 0; i < 31; ++i) p.in[i] = (const float*)d_in[i];
    p.out = (float*)d_out; p.ws = (unsigned char*)d_ws;
#if MULTI_LAUNCH
    for (int ph = 0; ph < NPHASE; ++ph) { p.ph_lo = ph; p.ph_hi = ph + 1; hipLaunchKernelGGL(fwd_megakernel, dim3(grid), dim3(NTHR), LDS_BYTES, stream, p); }
#else
    p.ph_lo = 0; p.ph_hi = NPHASE;
    (void)hipMemsetAsync((char*)d_ws + WS_BAR, 0, XCD_BAR_WORDS * sizeof(unsigned), stream);
    void* args[] = {&p};
    hipError_t e = hipLaunchCooperativeKernel((const void*)fwd_megakernel, dim3(grid), dim3(NTHR), args, LDS_BYTES, stream);
    if (e != hipSuccess) fprintf(stderr, "cooperative launch failed: %s (grid %d)\n", hipGetErrorString(e), grid);
#endif
}
```

```cpp
#include <hip/hip_runtime.h>
#include <hip/hip_cooperative_groups.h>
#include <cstdio>
namespace cg = cooperative_groups;

#ifndef MULTI_LAUNCH
#define MULTI_LAUNCH 0
#endif

#ifndef REP_MASK
#define REP_MASK 0
#endif
#ifndef PHASE_SEL
#define PHASE_SEL -1
#endif
#define EN(q) (PHASE_SEL < 0 || PHASE_SEL == (q))
#define LAS __attribute__((address_space(3)))
typedef unsigned short bf16_t;
typedef short bf16x8 __attribute__((ext_vector_type(8)));
typedef float f32x4 __attribute__((ext_vector_type(4)));
typedef unsigned u32x4 __attribute__((ext_vector_type(4)));
typedef unsigned u32x2 __attribute__((ext_vector_type(2)));

constexpr int NTHR = 512;
constexpr int TOK = 40960, TOKP = 8192;
constexpr int LDS_BYTES = 147456;
constexpr int NPHASE = 35;
constexpr int PPL = 17;

constexpr size_t MiB = (size_t)1 << 20;
constexpr size_t WS_MOD = 0;
constexpr size_t WS_GLR = 1 * MiB;
constexpr size_t WS_TOTF = 7 * MiB;
constexpr size_t WS_TOTB = 9 * MiB;
constexpr size_t WS_BAR = 12 * MiB;
constexpr size_t WS_W = 16 * MiB;
constexpr size_t W_A = 0;
constexpr size_t W_B = W_A + (size_t)2816 * 1024 * 2;
constexpr size_t W_PG = W_B + (size_t)3072 * 1024 * 2;
constexpr size_t W_GLU = W_PG + (size_t)1024 * 1024 * 2;
constexpr size_t W_PS = W_GLU + (size_t)512 * 512 * 2;
constexpr size_t W_OUT = W_PS + (size_t)1024 * 512 * 2;
constexpr size_t W_1 = W_OUT + (size_t)1024 * 1024 * 2;
constexpr size_t W_2 = W_1 + (size_t)4096 * 1024 * 2;
constexpr size_t WS_R2 = 50 * MiB;
constexpr size_t WS_R3 = 130 * MiB;
constexpr size_t WS_R4 = 210 * MiB;
constexpr size_t WS_R5 = 290 * MiB;
constexpr size_t WS_E = 350 * MiB;
constexpr size_t WS_R6 = 390 * MiB;
constexpr size_t WS_R1 = 430 * MiB;
constexpr size_t WS_EMAT = 454 * MiB;
constexpr size_t WS_HID = 130 * MiB;
constexpr size_t WS_END = 510 * MiB;

struct P { const float* in[31]; float* out; unsigned char* ws; int ph_lo, ph_hi; };

__device__ __forceinline__ int tid_() { int t = threadIdx.x; asm volatile("" : "+v"(t)); return t; }
__device__ __forceinline__ int bid_() { int b = blockIdx.x; asm volatile("" : "+s"(b)); return b; }
__device__ __forceinline__ int lnd(int k) { asm volatile("" : "+s"(k)); return k; }
__device__ __forceinline__ unsigned pk_bf16(float lo, float hi) { unsigned r; asm("v_cvt_pk_bf16_f32 %0, %1, %2" : "=v"(r) : "v"(lo), "v"(hi)); return r; }
__device__ __forceinline__ float bf2f(bf16_t b) { return __uint_as_float(((unsigned)b) << 16); }
__device__ __forceinline__ float bflo(unsigned w) { return __uint_as_float(w << 16); }
__device__ __forceinline__ float bfhi(unsigned w) { return __uint_as_float(w & 0xffff0000u); }
__device__ __forceinline__ bf16_t f2bf(float f) { return (bf16_t)(pk_bf16(f, 0.f) & 0xffffu); }
__device__ __forceinline__ float sigmoidf_(float x) { return 1.0f / (1.0f + __expf(-x)); }
__device__ __forceinline__ void store4bf(bf16_t* ptr, f32x4 v) { u32x2 w; w.x = pk_bf16(v[0], v[1]); w.y = pk_bf16(v[2], v[3]); *(u32x2*)ptr = w; }
__device__ __forceinline__ f32x4 load4bf(const bf16_t* ptr) { u32x2 w = *(const u32x2*)ptr; return (f32x4){bflo(w.x), bfhi(w.x), bflo(w.y), bfhi(w.y)}; }
__device__ __forceinline__ int mod_index(int tok) { return tok < TOKP ? 0 : (tok >> 12) - 1; }
__device__ __forceinline__ float wave_sum(float v) {
#pragma unroll
    for (int o = 32; o >= 1; o >>= 1) v += __shfl_xor(v, o);
    return v;
}

namespace pg8 {
constexpr int BM = 256, BK = 64, HALF = 128, HTB = HALF * BK * 2, STAGE_BYTES = 8 * HTB, NXCD = 8, WGM = 8;
__device__ __forceinline__ int lds_byte(int r, int c) { const int st = (r >> 4) * 2 + (c >> 5), rr = r & 15, cc = c & 31, ob = rr * 64 + cc * 2; return st * 1024 + (ob ^ (((ob >> 9) & 1) << 5)); }
__device__ __forceinline__ void stage_rc(int b, int& R, int& C) { const int st = b / 1024, sb = b % 1024, swz = sb ^ (((sb >> 9) & 1) << 5); R = (st >> 1) * 16 + swz / 64; C = (st & 1) * 32 + (swz % 64) / 2; }

struct Unit { int pm, pn, z, hf; };
struct Gemm { const bf16_t* A; const bf16_t* Bt; int M, N, K, lda; size_t sA, sB; int nz; };
struct Order {
    int nM, nN, nwg, G, c, nz, nfull, rem2;
    __device__ __forceinline__ void init(int M, int N, int nz_, int G_, int c_) { nM = M / BM; nN = N / BM; nwg = nM * nN; G = G_; c = c_; nz = nz_;
        nfull = nwg; rem2 = 0;
        if (nz == 1) { const int full = (nwg / G) * G, rem = nwg - full; if (rem > 0 && 2 * rem <= G) { nfull = full; rem2 = 2 * rem; } } }
    __device__ __forceinline__ void map(int wgid, Unit& u) const {
        { const int q = nwg / NXCD, r = nwg % NXCD, xcd = wgid % NXCD, off = wgid / NXCD; wgid = (xcd < r ? xcd * (q + 1) : r * (q + 1) + (xcd - r) * q) + off; }
        const int nig = WGM * nN, gid = wgid / nig, fm = gid * WGM, gsz = (nM - fm) < WGM ? (nM - fm) : WGM;
        u.pm = fm + ((wgid % nig) % gsz); u.pn = (wgid % nig) / gsz; u.z = 0; }
    __device__ __forceinline__ bool next(int i, Unit& u) const {
        const long L = (long)i * G + c;
        if (nz == 1) {
            if (L < nfull) { map((int)L, u); u.hf = 0; return true; }
            const int t = (int)(L - nfull); if (t >= rem2) return false;
            map(nfull + (t >> 1), u); u.hf = 1 + (t & 1); return true;
        }
        if (L >= (long)nwg * nz) return false;
        const int z = (int)(L / nwg), r = (int)(L % nwg); u.z = z; u.pm = r % nM; u.pn = r / nM; u.hf = 0;
        return true;
    }
};

template <class Epi>
__device__ __forceinline__ void gemm_phase(LAS unsigned char* lds, const Gemm g, const Order& S, const Epi& E) {
    const int tid = tid_(), wid = __builtin_amdgcn_readfirstlane(tid >> 6), lane = tid & 63, wr = wid >> 2, wc = wid & 3, fr = lane & 15, fq = lane >> 4;
    const int K = g.K, nt = K / BK;
    unsigned voffA[2], voffB[2];
#pragma unroll
    for (int i = 0; i < 2; ++i) { int R, C; stage_rc(tid * 16 + i * 8192, R, C); voffA[i] = (unsigned)(R * g.lda + C) * 2u; voffB[i] = (unsigned)(R * K + C) * 2u; }
    const size_t kstep = (size_t)(BK * 2);
    const size_t hstepA = (size_t)HALF * g.lda * 2, hstepB = (size_t)HALF * K * 2;
    const unsigned ldsw = (unsigned)wid * 1024u;
    const int aoff = lds_byte(wr * 64 + fr, fq * 8), boff = lds_byte(wc * 32 + fr, fq * 8);
#define PG8_SA(b, h) (((b) * 2 + (h)) * HTB)
#define PG8_SB(b, h) ((4 + (b) * 2 + (h)) * HTB)
#define PG8_STAGE(bufoff, gbase, voff) do { _Pragma("unroll") for (int _i = 0; _i < 2; ++_i) \
        __builtin_amdgcn_global_load_lds((const unsigned*)((const char*)(gbase) + (voff)[_i]), (LAS unsigned*)(lds + (bufoff) + ldsw + _i * 8192), 16, 0, 0); } while (0)
#define PG8_LDA(dst, b, h) do { _Pragma("unroll") for (int m = 0; m < 4; ++m) _Pragma("unroll") for (int k = 0; k < 2; ++k) dst[m][k] = *(const LAS bf16x8*)(lds + PG8_SA(b, h) + aoff + m * 2048 + k * 1024); } while (0)
#define PG8_LDB(dst, b, h) do { _Pragma("unroll") for (int n = 0; n < 2; ++n) _Pragma("unroll") for (int k = 0; k < 2; ++k) dst[n][k] = *(const LAS bf16x8*)(lds + PG8_SB(b, h) + boff + n * 2048 + k * 1024); } while (0)
#define PG8_MMA(ai, bj, At, Bt) do { __builtin_amdgcn_s_setprio(1); _Pragma("unroll") for (int m = 0; m < 4; ++m) _Pragma("unroll") for (int n = 0; n < 2; ++n) _Pragma("unroll") for (int k = 0; k < 2; ++k) \
        acc[ai][bj][m][n] = __builtin_amdgcn_mfma_f32_16x16x32_bf16(Bt[n][k], At[m][k], acc[ai][bj][m][n], 0, 0, 0); __builtin_amdgcn_s_setprio(0); } while (0)
#define PG8_WAIT_V(n) asm volatile("s_waitcnt vmcnt(" #n ")" ::: "memory")
#define PG8_WAIT_L(n) asm volatile("s_waitcnt lgkmcnt(" #n ")" ::: "memory")
#define PG8_BAR __builtin_amdgcn_s_barrier()
#define PG8_SCHED __builtin_amdgcn_sched_barrier(0)
    Unit cur, nxt; int ui = 0;
    if (!S.next(0, cur)) return;
    f32x4 acc[2][2][4][2];
#pragma unroll
    for (int a = 0; a < 2; ++a)
#pragma unroll
        for (int b = 0; b < 2; ++b)
#pragma unroll
            for (int m = 0; m < 4; ++m)
#pragma unroll
                for (int n = 0; n < 2; ++n) acc[a][b][m][n] = (f32x4){0.f, 0.f, 0.f, 0.f};
    bf16x8 At[4][2], B0[2][2], B1[2][2];
    const char* cA = (const char*)g.A + ((size_t)cur.z * g.sA + (size_t)(cur.pm * BM + (cur.hf == 2 ? HALF : 0)) * g.lda) * 2;
    const char* cB = (const char*)g.Bt + ((size_t)cur.z * g.sB + (size_t)cur.pn * BM * K) * 2;
    PG8_STAGE(PG8_SB(0, 0), cB, voffB); PG8_STAGE(PG8_SB(0, 1), cB + hstepB, voffB); PG8_STAGE(PG8_SA(0, 0), cA, voffA); PG8_STAGE(PG8_SA(0, 1), cA + hstepA, voffA);
    if (wr == 1) PG8_BAR;
    PG8_WAIT_V(2); PG8_BAR;
    PG8_STAGE(PG8_SB(1, 0), cB + kstep, voffB); PG8_STAGE(PG8_SA(1, 0), cA + kstep, voffA); PG8_STAGE(PG8_SB(1, 1), cB + hstepB + kstep, voffB);
    PG8_WAIT_V(6); PG8_BAR;
    for (;;) {
        const bool has_next = S.next(ui + 1, nxt);
        const char* nA = has_next ? (const char*)g.A + ((size_t)nxt.z * g.sA + (size_t)(nxt.pm * BM + (nxt.hf == 2 ? HALF : 0)) * g.lda) * 2 : cA;
        const bool fullu = (cur.hf == 0);
        const char* nB = has_next ? (const char*)g.Bt + ((size_t)nxt.z * g.sB + (size_t)nxt.pn * BM * K) * 2 : cB;
        for (int t = 0; t < nt; t += 2) {
            const bool last = (t == nt - 2);
            const char* a1 = cA + (size_t)(t + 1) * kstep;
            const char* a2 = last ? nA : cA + (size_t)(t + 2) * kstep; const char* b2 = last ? nB : cB + (size_t)(t + 2) * kstep;
            const char* a3 = a2 + kstep; const char* b3 = b2 + kstep;
            PG8_LDB(B0, 0, 0); PG8_LDB(B1, 0, 1); PG8_SCHED; PG8_LDA(At, 0, 0); PG8_STAGE(PG8_SA(1, 1), a1 + hstepA, voffA);
            PG8_WAIT_V(8); PG8_WAIT_L(0); PG8_BAR; PG8_MMA(0, 0, At, B0); PG8_MMA(0, 1, At, B1); PG8_BAR; PG8_SCHED;
            if (fullu) PG8_LDA(At, 0, 1); PG8_STAGE(PG8_SB(0, 0), b2, voffB); PG8_STAGE(PG8_SB(0, 1), b2 + hstepB, voffB); PG8_STAGE(PG8_SA(0, 0), a2, voffA);
            PG8_WAIT_V(8); PG8_WAIT_L(0); PG8_BAR; if (fullu) { PG8_MMA(1, 0, At, B0); PG8_MMA(1, 1, At, B1); } PG8_BAR; PG8_SCHED;
            PG8_LDB(B0, 1, 0); PG8_LDB(B1, 1, 1); PG8_SCHED; PG8_LDA(At, 1, 0); PG8_STAGE(PG8_SA(0, 1), a2 + hstepA, voffA);
            PG8_WAIT_V(8); PG8_WAIT_L(0); PG8_BAR; PG8_MMA(0, 0, At, B0); PG8_MMA(0, 1, At, B1); PG8_BAR; PG8_SCHED;
            if (fullu) PG8_LDA(At, 1, 1); PG8_STAGE(PG8_SB(1, 0), b3, voffB); PG8_STAGE(PG8_SB(1, 1), b3 + hstepB, voffB); PG8_STAGE(PG8_SA(1, 0), a3, voffA);
            PG8_WAIT_V(8); PG8_WAIT_L(0); PG8_BAR; if (fullu) { PG8_MMA(1, 0, At, B0); PG8_MMA(1, 1, At, B1); } PG8_BAR; PG8_SCHED;
        }
        if (wr == 0) PG8_BAR;
        if (fullu) E.template tile<2>(acc, cur.z, cur.pm * BM + wr * 64 + fr, cur.pn * BM + wc * 32 + 4 * fq);
        else E.template tile<1>(acc, cur.z, cur.pm * BM + (cur.hf == 2 ? HALF : 0) + wr * 64 + fr, cur.pn * BM + wc * 32 + 4 * fq);
        if (!has_next) break;
#pragma unroll
        for (int a = 0; a < 2; ++a)
#pragma unroll
            for (int b = 0; b < 2; ++b)
#pragma unroll
                for (int m = 0; m < 4; ++m)
#pragma unroll
                    for (int n = 0; n < 2; ++n) acc[a][b][m][n] = (f32x4){0.f, 0.f, 0.f, 0.f};
        cur = nxt; cA = nA; cB = nB; ++ui;
        if (wr == 1) PG8_BAR;
    }
    PG8_WAIT_V(0);
    PG8_BAR;
#undef PG8_SA
#undef PG8_SB
#undef PG8_STAGE
#undef PG8_LDA
#undef PG8_LDB
#undef PG8_MMA
#undef PG8_WAIT_V
#undef PG8_WAIT_L
#undef PG8_BAR
#undef PG8_SCHED
}
}

#define EPI_SIMPLE_TILE() \
    template <int NAI> __device__ __forceinline__ void tile(const f32x4 (&acc)[2][2][4][2], int z, int row0, int col0) const { \
        _Pragma("unroll") for (int ai = 0; ai < NAI; ++ai) _Pragma("unroll") for (int m = 0; m < 4; ++m) _Pragma("unroll") for (int bj = 0; bj < 2; ++bj) _Pragma("unroll") for (int n = 0; n < 2; ++n) \
            (*this)(z, row0 + ai * 128 + m * 16, col0 + bj * 128 + n * 16, acc[ai][bj][m][n]); }
#define EPI_PIPE_TILE() \
    template <int NAI> __device__ __forceinline__ void tile(const f32x4 (&acc)[2][2][4][2], int z, int row0, int col0) const { \
        Pre pre; begin(row0, col0, pre); L buf[2][8]; \
        _Pragma("unroll") for (int mm = 0; mm < 2; ++mm) _Pragma("unroll") for (int bj = 0; bj < 2; ++bj) _Pragma("unroll") for (int n = 0; n < 2; ++n) load(row0 + mm * 16, col0 + bj * 128 + n * 16, buf[0][mm * 4 + bj * 2 + n]); \
        _Pragma("unroll") for (int b = 0; b < 2 * NAI; ++b) { \
            if (b < 2 * NAI - 1) { _Pragma("unroll") for (int mm = 0; mm < 2; ++mm) _Pragma("unroll") for (int bj = 0; bj < 2; ++bj) _Pragma("unroll") for (int n = 0; n < 2; ++n) \
                load(row0 + ((b + 1) >> 1) * 128 + (((b + 1) & 1) * 2 + mm) * 16, col0 + bj * 128 + n * 16, buf[(b + 1) & 1][mm * 4 + bj * 2 + n]); } \
            _Pragma("unroll") for (int mm = 0; mm < 2; ++mm) _Pragma("unroll") for (int bj = 0; bj < 2; ++bj) _Pragma("unroll") for (int n = 0; n < 2; ++n) \
                apply(row0 + (b >> 1) * 128 + ((b & 1) * 2 + mm) * 16, col0 + bj * 128 + n * 16, acc[b >> 1][bj][(b & 1) * 2 + mm][n], buf[b & 1][mm * 4 + bj * 2 + n], pre, bj * 2 + n); } }

struct EpiPartA {
    bf16_t* Q; bf16_t* Kk; bf16_t* V; bf16_t* UG; float* GLR;
    __device__ __forceinline__ void operator()(int, int row, int col, f32x4 v) const {
        if (col < 512) store4bf(Q + (size_t)row * 512 + col, v);
        else if (col < 1024) store4bf(Kk + (size_t)row * 512 + (col - 512), v);
        else if (col < 2048) store4bf(V + (size_t)row * 1024 + (col - 1024), v);
        else if (col < 2304) { const int c = col - 2048; if (c < 32) *(f32x4*)(GLR + (size_t)row * 32 + c) = v; }
        else { const int c = col - 2304, g = c >> 4, n = c & 15, chunk = row >> 5, j = row & 31; store4bf(UG + ((size_t)(g * 1280 + chunk) * 768 + j * 16 + n), v); }
    }
    EPI_SIMPLE_TILE()
};
struct EpiE { float* E; __device__ __forceinline__ void operator()(int z, int row, int col, f32x4 v) const { *(f32x4*)(E + ((size_t)(z * 1280 + row) * 256 + col)) = v; } EPI_SIMPLE_TILE() };
struct EpiY {
    bf16_t* YB;
    __device__ __forceinline__ void operator()(int z, int row, int col, f32x4 v) const {
        const int tok = row * 32 + (col >> 4), ch = z * 16 + (col & 15);
        f32x4 o;
#pragma unroll
        for (int e = 0; e < 4; ++e) { const float x = v[e]; o[e] = x * sigmoidf_(1.5957691216f * (x + 0.044715f * x * x * x)); }
        store4bf(YB + (size_t)tok * 512 + ch, o);
    }
    EPI_SIMPLE_TILE()
};
struct EpiGLU {
    const bf16_t* YB; bf16_t* OS5; const float* bglu;
    typedef u32x2 L; struct Pre { f32x4 b[4]; };
    __device__ __forceinline__ void begin(int, int col0, Pre& pr) const {
#pragma unroll
        for (int k = 0; k < 4; ++k) pr.b[k] = *(const f32x4*)(bglu + col0 + (k >> 1) * 128 + (k & 1) * 16); }
    __device__ __forceinline__ void load(int row, int col, L& l) const { l = *(const u32x2*)(YB + (size_t)row * 512 + col); }
    __device__ __forceinline__ void apply(int row, int col, f32x4 v, const L& l, const Pre& pr, int k) const {
        const f32x4 y = (f32x4){bflo(l.x), bfhi(l.x), bflo(l.y), bfhi(l.y)}; f32x4 o;
#pragma unroll
        for (int e = 0; e < 4; ++e) o[e] = y[e] * sigmoidf_(v[e] + pr.b[k][e]);
        store4bf(OS5 + (size_t)row * 512 + col, o); }
    EPI_PIPE_TILE()
};
struct EpiPartB {
    bf16_t* R; bf16_t* GA; bf16_t* GB;
    __device__ __forceinline__ void operator()(int, int row, int col, f32x4 v) const {
        f32x4 s;
#pragma unroll
        for (int e = 0; e < 4; ++e) s[e] = sigmoidf_(v[e]);
        if (col < 1024) { store4bf(R + (size_t)row * 1024 + col, v * s); }
        else if (col < 2048) store4bf(GA + (size_t)row * 1024 + (col - 1024), s);
        else store4bf(GB + (size_t)row * 1024 + (col - 2048), s);
    }
    EPI_SIMPLE_TILE()
};
struct EpiProj1 { const bf16_t* GA; bf16_t* T1;
    typedef u32x2 L; struct Pre { int dummy; };
    __device__ __forceinline__ void begin(int, int, Pre&) const {}
    __device__ __forceinline__ void load(int row, int col, L& l) const { l = *(const u32x2*)(GA + (size_t)row * 1024 + col); }
    __device__ __forceinline__ void apply(int row, int col, f32x4 v, const L& l, const Pre&, int) const {
        const f32x4 g = (f32x4){bflo(l.x), bfhi(l.x), bflo(l.y), bfhi(l.y)}; store4bf(T1 + (size_t)row * 1024 + col, g * v); }
    EPI_PIPE_TILE()
};
struct EpiProj2 { const bf16_t* GB; bf16_t* T1;
    struct L { u32x2 t, g; }; struct Pre { int dummy; };
    __device__ __forceinline__ void begin(int, int, Pre&) const {}
    __device__ __forceinline__ void load(int row, int col, L& l) const { const size_t o = (size_t)row * 1024 + col; l.t = *(const u32x2*)(T1 + o); l.g = *(const u32x2*)(GB + o); }
    __device__ __forceinline__ void apply(int row, int col, f32x4 v, const L& l, const Pre&, int) const {
        const f32x4 g = (f32x4){bflo(l.g.x), bfhi(l.g.x), bflo(l.g.y), bfhi(l.g.y)}, t = (f32x4){bflo(l.t.x), bfhi(l.t.x), bflo(l.t.y), bfhi(l.t.y)};
        store4bf(T1 + (size_t)row * 1024 + col, t + g * v); }
    EPI_PIPE_TILE()
};
struct EpiDelta { bf16_t* Dl; const float* gate;
    template <int NAI> __device__ __forceinline__ void tile(const f32x4 (&acc)[2][2][4][2], int, int row0, int col0) const {
        const float* gp = gate + (size_t)mod_index(row0) * 6144 + col0; f32x4 g[2][2];
#pragma unroll
        for (int bj = 0; bj < 2; ++bj)
#pragma unroll
            for (int n = 0; n < 2; ++n) g[bj][n] = *(const f32x4*)(gp + bj * 128 + n * 16);
#pragma unroll
        for (int ai = 0; ai < NAI; ++ai)
#pragma unroll
            for (int m = 0; m < 4; ++m)
#pragma unroll
                for (int bj = 0; bj < 2; ++bj)
#pragma unroll
                    for (int n = 0; n < 2; ++n) store4bf(Dl + (size_t)(row0 + ai * 128 + m * 16) * 1024 + col0 + bj * 128 + n * 16, g[bj][n] * acc[ai][bj][m][n]);
    } };
struct EpiFF1 { bf16_t* H;
    __device__ __forceinline__ void operator()(int, int row, int col, f32x4 v) const {
        f32x4 o;
#pragma unroll
        for (int e = 0; e < 4; ++e) { const float r = fmaxf(v[e], 0.f); o[e] = r * r; }
        store4bf(H + (size_t)row * 4096 + col, o); }
    EPI_SIMPLE_TILE()
};

struct ConvJob { const float* src; int ld, K, c0, nvalid, ndst; bf16_t* dst; float scale; };
__device__ __forceinline__ bool conv_job(const P& p, int l, int j, ConvJob& J) {
    bf16_t* W = (bf16_t*)(p.ws + WS_W);
    const float* win = p.in[lnd(10)] + (size_t)l * 1024 * 5664;
    J.scale = 1.0f;
    switch (j) {
        case 0: J = {win, 5664, 1024, 0, 512, 512, W + W_A / 2, 0.08838834764831845f}; break;
        case 1: J = {win, 5664, 1024, 512, 512, 512, W + W_A / 2 + (size_t)512 * 1024, 1.f}; break;
        case 2: J = {win, 5664, 1024, 1024, 1024, 1024, W + W_A / 2 + (size_t)1024 * 1024, 1.f}; break;
        case 3: J = {win, 5664, 1024, 3072, 32, 256, W + W_A / 2 + (size_t)2048 * 1024, 1.f}; break;
        case 4: J = {win, 5664, 1024, 3104, 512, 512, W + W_A / 2 + (size_t)2304 * 1024, 1.f}; break;
        case 5: J = {win, 5664, 1024, 2048, 1024, 1024, W + W_B / 2, 1.f}; break;
        case 6: J = {win, 5664, 1024, 3616, 1024, 1024, W + W_B / 2 + (size_t)1024 * 1024, 1.f}; break;
        case 7: J = {win, 5664, 1024, 4640, 1024, 1024, W + W_B / 2 + (size_t)2048 * 1024, 1.f}; break;
        case 8: J = {p.in[lnd(14)] + (size_t)l * 1024 * 1024, 1024, 1024, 0, 1024, 1024, W + W_PG / 2, 1.f}; break;
        case 9: J = {p.in[lnd(23)] + (size_t)l * 512 * 512, 512, 512, 0, 512, 512, W + W_GLU / 2, 1.f}; break;
        case 10: J = {p.in[lnd(25)] + (size_t)l * 512 * 1024, 1024, 512, 0, 1024, 1024, W + W_PS / 2, 1.f}; break;
        case 11: J = {p.in[lnd(26)] + (size_t)l * 1024 * 1024, 1024, 1024, 0, 1024, 1024, W + W_OUT / 2, 1.f}; break;
        case 12: J = {p.in[lnd(28)] + (size_t)l * 1024 * 4096, 4096, 1024, 0, 4096, 4096, W + W_1 / 2, 1.f}; break;
        case 13: J = {p.in[lnd(29)] + (size_t)l * 4096 * 1024, 1024, 4096, 0, 1024, 1024, W + W_2 / 2, 1.f}; break;
        default: return false;
    }
    return true;
}
constexpr int CONV_TILES = 2112;
__device__ __forceinline__ void conv_tile(const P& p, int l, int tile, LAS float* sT) {
    const int tid = tid_();
    ConvJob J; int j = 0, rem = tile;
    for (; j < 14; ++j) { conv_job(p, l, j, J); const int nt = (J.ndst / 64) * (J.K / 128); if (rem < nt) break; rem -= nt; }
    const int kts = J.K / 128, ntile = rem / kts, ktile = rem % kts, n0 = ntile * 64, k0 = ktile * 128;
    {
        const int kk = tid >> 4, c4 = (tid & 15) * 4; f32x4 v[4];
#pragma unroll
        for (int i = 0; i < 4; ++i) { v[i] = (f32x4){0.f, 0.f, 0.f, 0.f};
            if (n0 + c4 < J.nvalid) v[i] = *(const f32x4*)(J.src + (size_t)(k0 + kk + 32 * i) * J.ld + J.c0 + n0 + c4); }
#pragma unroll
        for (int i = 0; i < 4; ++i)
#pragma unroll
            for (int e = 0; e < 4; ++e) sT[(c4 + e) * 129 + kk + 32 * i] = v[i][e] * J.scale;
    }
    __syncthreads();
    {
        const int n = tid >> 3, ks = (tid & 7) * 16;
        const LAS float* sp = sT + n * 129 + ks;
#pragma unroll
        for (int hh = 0; hh < 2; ++hh) { u32x4 w; const LAS float* q = sp + 8 * hh;
            w.x = pk_bf16(q[0], q[1]); w.y = pk_bf16(q[2], q[3]); w.z = pk_bf16(q[4], q[5]); w.w = pk_bf16(q[6], q[7]);
            *(u32x4*)(J.dst + (size_t)(n0 + n) * J.K + k0 + ks + 8 * hh) = w; }
    }
}

__device__ __forceinline__ void mod_task(const P& p, int m, LAS float* sm) {
    const int tid = tid_(), l = m / 192, colbase = (m % 192) * 32, cl = tid & 31, ks = tid >> 5;
    LAS float* SC = sm; LAS float* RED = sm + 9216;
    for (int i = tid; i < 9216; i += NTHR) { const int j = i >> 10, k = i & 1023; const float c = (j == 0) ? p.in[lnd(6)][k] : p.in[lnd(2)][(j - 1) * 1024 + k]; SC[i] = c * sigmoidf_(c); }
    __syncthreads();
    float acc[9];
#pragma unroll
    for (int j = 0; j < 9; ++j) acc[j] = 0.f;
    const float* w = p.in[lnd(7)] + (size_t)l * 1024 * 6144 + colbase + cl;
    for (int k8 = 0; k8 < 64; k8 += 16) { float wv[16];
#pragma unroll
        for (int u = 0; u < 16; ++u) wv[u] = w[(size_t)(ks * 64 + k8 + u) * 6144];
#pragma unroll
        for (int u = 0; u < 16; ++u)
#pragma unroll
            for (int j = 0; j < 9; ++j) acc[j] += SC[j * 1024 + ks * 64 + k8 + u] * wv[u]; }
#pragma unroll
    for (int j = 0; j < 9; ++j) RED[(ks * 9 + j) * 32 + cl] = acc[j];
    __syncthreads();
    if (tid < 288) { const int j = tid >> 5, c = tid & 31; float s = 0.f;
#pragma unroll
        for (int q = 0; q < 16; ++q) s += RED[(q * 9 + j) * 32 + c];
        float* mod = (float*)(p.ws + WS_MOD);
        mod[((size_t)l * 9 + j) * 6144 + colbase + c] = s + p.in[lnd(8)][(size_t)l * 6144 + colbase + c]; }
}

__device__ __forceinline__ void s5_mats(const P& p, int l, int gq, LAS float* sm) {
    const int tid = tid_(), g = gq >> 2, part = gq & 3;
    LAS float* KF = sm; LAS float* KB = sm + 8192; LAS float* LT = sm + 16384; LAS float* CC = sm + 20608; LAS float* BB = sm + 22656;
    bf16_t* MC = (bf16_t*)(p.ws + WS_R1) + (size_t)g * 512 * 768;
    bf16_t* EM = (bf16_t*)(p.ws + WS_EMAT) + (size_t)g * 256 * 512;
    for (int d = 0; d < 2; ++d) {
        const int pg = (l * 2 + d) * 32 + g;
        const float* lamr = p.in[lnd(15)] + (size_t)pg * 64; const float* lami = p.in[lnd(16)] + (size_t)pg * 64;
        const float dt = expf(p.in[lnd(17)][pg]);
        const float* bre = p.in[lnd(18)] + (size_t)pg * 1024; const float* bim = p.in[lnd(19)] + (size_t)pg * 1024;
        const float* cre = p.in[lnd(20)] + (size_t)pg * 1024; const float* cim = p.in[lnd(21)] + (size_t)pg * 1024;
        for (int i = tid; i < 33 * 64; i += NTHR) { const int tau = i >> 6, pp = i & 63; const float a = expf(lamr[pp] * dt * (float)tau); float s, c; sincosf(lami[pp] * dt * (float)tau, &s, &c); LT[2 * i] = a * c; LT[2 * i + 1] = a * s; }
        for (int i = tid; i < 1024; i += NTHR) { CC[2 * i] = cre[i]; CC[2 * i + 1] = cim[i]; }
        for (int i = tid; i < 1024; i += NTHR) {
            const int pp = i >> 4; const float lr = lamr[pp], li = lami[pp]; float s, c; sincosf(li * dt, &s, &c);
            const float em1 = expm1f(lr * dt); float sh, ch; sincosf(0.5f * li * dt, &sh, &ch);
            const float nr = em1 * c - 2.f * sh * sh, ni = (em1 + 1.f) * s;
            const float inv = 1.f / (lr * lr + li * li);
            const float qr = (nr * lr + ni * li) * inv, qi = (ni * lr - nr * li) * inv;
            const float br = bre[i], bi = bim[i];
            BB[2 * i] = qr * br - qi * bi; BB[2 * i + 1] = qr * bi + qi * br;
        }
        __syncthreads();
        {
            const int tau = tid >> 4, n = tid & 15; float acc[16];
#pragma unroll
            for (int m = 0; m < 16; ++m) acc[m] = 0.f;
            for (int pp = 0; pp < 64; ++pp) {
                const float cr = CC[2 * (n * 64 + pp)], ci = CC[2 * (n * 64 + pp) + 1], lr = LT[2 * (tau * 64 + pp)], li = LT[2 * (tau * 64 + pp) + 1];
                const float xr = cr * lr - ci * li, xi = cr * li + ci * lr;
#pragma unroll
                for (int m = 0; m < 16; ++m) acc[m] += xr * BB[2 * (pp * 16 + m)] - xi * BB[2 * (pp * 16 + m) + 1];
            }
            LAS float* Kd = d ? KB : KF;
#pragma unroll
            for (int m = 0; m < 16; ++m) Kd[(tau * 16 + n) * 16 + m] = acc[m];
        }
        {
            const int pp = tid >> 3, cseg = tid & 7;
            { const int jj = part;
                const int j = cseg * 4 + jj, e = d == 0 ? 31 - j : j; const float lr = LT[2 * (e * 64 + pp)], li = LT[2 * (e * 64 + pp) + 1];
                float re[16], im[16];
#pragma unroll
                for (int m = 0; m < 16; ++m) { const float br = BB[2 * (pp * 16 + m)], bi = BB[2 * (pp * 16 + m) + 1]; re[m] = lr * br - li * bi; im[m] = lr * bi + li * br; }
                bf16_t* er = EM + (size_t)(d * 128 + pp) * 512 + j * 16; bf16_t* ei = EM + (size_t)(d * 128 + 64 + pp) * 512 + j * 16;
#pragma unroll
                for (int h = 0; h < 2; ++h) {
                    u32x4 w; w.x = pk_bf16(re[8 * h], re[8 * h + 1]); w.y = pk_bf16(re[8 * h + 2], re[8 * h + 3]); w.z = pk_bf16(re[8 * h + 4], re[8 * h + 5]); w.w = pk_bf16(re[8 * h + 6], re[8 * h + 7]); *(u32x4*)(er + 8 * h) = w;
                    u32x4 x; x.x = pk_bf16(im[8 * h], im[8 * h + 1]); x.y = pk_bf16(im[8 * h + 2], im[8 * h + 3]); x.z = pk_bf16(im[8 * h + 4], im[8 * h + 5]); x.w = pk_bf16(im[8 * h + 6], im[8 * h + 7]); *(u32x4*)(ei + 8 * h) = x;
                }
            }
        }
        {
            const int t = tid >> 4, n = tid & 15, f = d == 0 ? t + 1 : 32 - t;
            bf16_t* mr = MC + (size_t)tid * 768 + 512 + d * 128;
#pragma unroll 1
            for (int p8 = 2 * part; p8 < 2 * part + 2; ++p8) {
                float re[8], im[8];
#pragma unroll
                for (int q = 0; q < 8; ++q) { const int pp = p8 * 8 + q; const float cr = CC[2 * (n * 64 + pp)], ci = CC[2 * (n * 64 + pp) + 1], lr = LT[2 * (f * 64 + pp)], li = LT[2 * (f * 64 + pp) + 1];
                    re[q] = cr * lr - ci * li; im[q] = -(cr * li + ci * lr); }
                u32x4 w; w.x = pk_bf16(re[0], re[1]); w.y = pk_bf16(re[2], re[3]); w.z = pk_bf16(re[4], re[5]); w.w = pk_bf16(re[6], re[7]); *(u32x4*)(mr + p8 * 8) = w;
                u32x4 x; x.x = pk_bf16(im[0], im[1]); x.y = pk_bf16(im[2], im[3]); x.z = pk_bf16(im[4], im[5]); x.w = pk_bf16(im[6], im[7]); *(u32x4*)(mr + 64 + p8 * 8) = x;
            }
        }
        __syncthreads();
    }
    {
        const int t = tid >> 4, n = tid & 15; const float dsk = p.in[lnd(22)][(size_t)l * 512 + g * 16 + n];
        bf16_t* mr = MC + (size_t)tid * 768;
#pragma unroll 1
        for (int j = 8 * part; j < 8 * part + 8; ++j) {
            float v[16];
#pragma unroll
            for (int m = 0; m < 16; ++m) v[m] = 0.f;
            if (j <= t) { const LAS float* k = KF + ((t - j) * 16 + n) * 16;
#pragma unroll
                for (int m = 0; m < 16; ++m) v[m] += k[m]; }
            if (j >= t) { const LAS float* k = KB + ((j - t) * 16 + n) * 16;
#pragma unroll
                for (int m = 0; m < 16; ++m) v[m] += k[m]; }
            if (j == t) {
#pragma unroll
                for (int m = 0; m < 16; ++m) v[m] += (m == n) ? dsk : 0.f; }
            u32x4 w; w.x = pk_bf16(v[0], v[1]); w.y = pk_bf16(v[2], v[3]); w.z = pk_bf16(v[4], v[5]); w.w = pk_bf16(v[6], v[7]); *(u32x4*)(mr + j * 16) = w;
            u32x4 x; x.x = pk_bf16(v[8], v[9]); x.y = pk_bf16(v[10], v[11]); x.z = pk_bf16(v[12], v[13]); x.w = pk_bf16(v[14], v[15]); *(u32x4*)(mr + j * 16 + 8) = x;
        }
    }
}

__device__ __forceinline__ void phase_prep(const P& p, int l, LAS unsigned char* lds) {
    LAS float* sm = (LAS float*)lds;
    const int nmod = (l == 0) ? 384 : 0, total = 128 + nmod + CONV_TILES;
    for (int task = bid_(); task < total; task += gridDim.x) {
        if (task < 128) s5_mats(p, l, task, sm);
        else if (task < 128 + nmod) mod_task(p, task - 128, sm);
        else conv_tile(p, l, task - 128 - nmod, sm);
        __syncthreads();
    }
}

__device__ __forceinline__ void norm_row_write(const f32x4 (&x)[4], const float* g, const float* mod, int shoff, int scoff, bf16_t* hrow, int lane) {
    float ss = 0.f;
#pragma unroll
    for (int i = 0; i < 4; ++i) ss += x[i][0] * x[i][0] + x[i][1] * x[i][1] + x[i][2] * x[i][2] + x[i][3] * x[i][3];
    ss = wave_sum(ss);
    const float rstd = rsqrtf(ss * (1.0f / 1024.0f) + 1e-6f);
#pragma unroll
    for (int i = 0; i < 4; ++i) { const int d = i * 256 + lane * 4; const f32x4 gg = *(const f32x4*)(g + d), sc = *(const f32x4*)(mod + scoff + d), sh = *(const f32x4*)(mod + shoff + d);
        f32x4 h;
#pragma unroll
        for (int e = 0; e < 4; ++e) h[e] = x[i][e] * rstd * gg[e] * (1.f + sc[e]) + sh[e];
        store4bf(hrow + d, h); }
}
__device__ __forceinline__ void phase_norm(const P& p, int l, int which) {
    const int lane = tid_() & 63, gw = bid_() * 8 + (tid_() >> 6), nw = gridDim.x * 8;
    const float* g = (which == 1 ? p.in[lnd(9)] : p.in[lnd(27)]) + (size_t)l * 1024;
    const float* modl = (const float*)(p.ws + WS_MOD) + (size_t)l * 9 * 6144;
    const int shoff = which == 1 ? 0 : 3072, scoff = which == 1 ? 1024 : 4096;
    bf16_t* H = (bf16_t*)(p.ws + WS_R2); float* X = p.out;
    if (which == 1 && l == 0) {
        for (int item = gw; item < 4096 + 8192; item += nw) {
            if (item < 4096) {
                const int n = item; const float rr = (float)(n >> 6), cc = (float)(n & 63); f32x4 pe[4];
#pragma unroll
                for (int e = 0; e < 4; ++e) { const float om = expf(-(float)(lane * 4 + e) * (9.210340371976184f / 256.0f)); float s, c; sincosf(rr * om, &s, &c); pe[0][e] = s; pe[1][e] = c; sincosf(cc * om, &s, &c); pe[2][e] = s; pe[3][e] = c; }
                for (int b0 = 0; b0 < 8; b0 += 2) { f32x4 x[2][4];
#pragma unroll
                    for (int r = 0; r < 2; ++r) { const float* src = p.in[lnd(1)] + ((size_t)(b0 + r) * 4096 + n) * 1024;
#pragma unroll
                        for (int i = 0; i < 4; ++i) x[r][i] = *(const f32x4*)(src + i * 256 + lane * 4); }
#pragma unroll
                    for (int r = 0; r < 2; ++r) { const int row = TOKP + (b0 + r) * 4096 + n;
#pragma unroll
                        for (int i = 0; i < 4; ++i) { x[r][i] = x[r][i] + pe[i]; *(f32x4*)(X + (size_t)row * 1024 + i * 256 + lane * 4) = x[r][i]; }
                        norm_row_write(x[r], g, modl + (size_t)(1 + b0 + r) * 6144, shoff, scoff, H + (size_t)row * 1024, lane); } }
            } else { const int row = item - 4096; const float* src = p.in[lnd(0)] + (size_t)row * 1024; f32x4 x[4];
#pragma unroll
                for (int i = 0; i < 4; ++i) { x[i] = *(const f32x4*)(src + i * 256 + lane * 4); *(f32x4*)(X + (size_t)row * 1024 + i * 256 + lane * 4) = x[i]; }
                norm_row_write(x, g, modl, shoff, scoff, H + (size_t)row * 1024, lane); }
        }
    } else {
        const bf16_t* DL = (const bf16_t*)(p.ws + (which == 1 ? WS_R2 : WS_R3));
        for (int row0 = gw; row0 < TOK; row0 += 4 * nw) {
            f32x4 x[4][4]; u32x2 dv[4][4];
#pragma unroll
            for (int r = 0; r < 4; ++r) { const int row = row0 + r * nw;
                if (row < TOK) {
#pragma unroll
                    for (int i = 0; i < 4; ++i) { x[r][i] = *(const f32x4*)(X + (size_t)row * 1024 + i * 256 + lane * 4); dv[r][i] = *(const u32x2*)(DL + (size_t)row * 1024 + i * 256 + lane * 4); } } }
#pragma unroll
            for (int r = 0; r < 4; ++r) { const int row = row0 + r * nw;
                if (row < TOK) {
#pragma unroll
                    for (int i = 0; i < 4; ++i) { x[r][i] = x[r][i] + (f32x4){bflo(dv[r][i].x), bfhi(dv[r][i].x), bflo(dv[r][i].y), bfhi(dv[r][i].y)}; *(f32x4*)(X + (size_t)row * 1024 + i * 256 + lane * 4) = x[r][i]; }
                    norm_row_write(x[r], g, modl + (size_t)mod_index(row) * 6144, shoff, scoff, H + (size_t)row * 1024, lane); } }
        }
    }
}
__device__ __forceinline__ void phase_final(const P& p) {
    const int lane = tid_() & 63, gw = bid_() * 8 + (tid_() >> 6), nw = gridDim.x * 8; float* X = p.out; const float* g = p.in[lnd(30)]; const bf16_t* DL = (const bf16_t*)(p.ws + WS_R2);
    for (int row0 = gw; row0 < TOK; row0 += 4 * nw) {
        f32x4 x[4][4]; u32x2 dv[4][4];
#pragma unroll
        for (int r = 0; r < 4; ++r) { const int row = row0 + r * nw;
            if (row < TOK) {
#pragma unroll
                for (int i = 0; i < 4; ++i) { x[r][i] = *(const f32x4*)(X + (size_t)row * 1024 + i * 256 + lane * 4); dv[r][i] = *(const u32x2*)(DL + (size_t)row * 1024 + i * 256 + lane * 4); } } }
#pragma unroll
        for (int r = 0; r < 4; ++r) { const int row = row0 + r * nw;
            if (row < TOK) { float ss = 0.f;
#pragma unroll
                for (int i = 0; i < 4; ++i) { x[r][i] = x[r][i] + (f32x4){bflo(dv[r][i].x), bfhi(dv[r][i].x), bflo(dv[r][i].y), bfhi(dv[r][i].y)}; ss += x[r][i][0] * x[r][i][0] + x[r][i][1] * x[r][i][1] + x[r][i][2] * x[r][i][2] + x[r][i][3] * x[r][i][3]; }
                ss = wave_sum(ss); const float rstd = rsqrtf(ss * (1.0f / 1024.0f) + 1e-6f);
#pragma unroll
                for (int i = 0; i < 4; ++i) { const f32x4 gg = *(const f32x4*)(g + i * 256 + lane * 4); *(f32x4*)(X + (size_t)row * 1024 + i * 256 + lane * 4) = x[r][i] * rstd * gg; } } }
    }
}

__device__ __forceinline__ void phase_s5scan(const P& p, int l) {
    const float* E = (const float*)(p.ws + WS_E); bf16_t* UG = (bf16_t*)(p.ws + WS_R5);
    float* ore = p.out + (size_t)TOK * 1024 + 16777216; float* oim = ore + 262144;
    for (int task = bid_(); task < 320; task += gridDim.x) {
        const int idx = task * NTHR + tid_(), pp = idx & 63, d = (idx >> 6) & 1, g = (idx >> 7) & 31, s = 39 - (idx >> 12);
        const int nch = s < 32 ? 8 : 128, cbase = s < 32 ? s * 8 : 256 + (s - 32) * 128;
        const int pg = (l * 2 + d) * 32 + g; const float dt = expf(p.in[lnd(17)][pg]);
        const float a = expf(p.in[lnd(15)][(size_t)pg * 64 + pp] * dt * 32.f); float sn, cs; sincosf(p.in[lnd(16)][(size_t)pg * 64 + pp] * dt * 32.f, &sn, &cs);
        const float ar = a * cs, ai = a * sn;
        float sr = 0.f, si = 0.f;
        if (s >= 32) { const size_t o = ((((size_t)(s - 32) * 2 + l) * 2 + d) * 32 + g) * 64 + pp; sr = p.in[lnd(4)][o]; si = p.in[lnd(5)][o]; }
        const float* Eb = E + ((size_t)(g * 1280 + cbase) * 256 + d * 128 + pp);
        bf16_t* Ub = UG + ((size_t)(g * 1280 + cbase) * 768 + 512 + d * 128 + pp);
        for (int c0 = 0; c0 < nch; c0 += 8) {
            float er[8], ei[8];
#pragma unroll
            for (int k = 0; k < 8; ++k) { const int c = d == 0 ? c0 + k : nch - 1 - (c0 + k); er[k] = Eb[(size_t)c * 256]; ei[k] = Eb[(size_t)c * 256 + 64]; }
#pragma unroll
            for (int k = 0; k < 8; ++k) { const int c = d == 0 ? c0 + k : nch - 1 - (c0 + k);
                Ub[(size_t)c * 768] = f2bf(sr); Ub[(size_t)c * 768 + 64] = f2bf(si);
                const float nr = ar * sr - ai * si + er[k], ni = ar * si + ai * sr + ei[k]; sr = nr; si = ni; }
        }
        if (s < 32) { const size_t o = ((((size_t)s * 2 + l) * 2 + d) * 32 + g) * 64 + pp; ore[o] = sr; oim[o] = si; }
    }
}

__device__ __forceinline__ void phase_glapre(const P& p, int l, LAS unsigned char* lds) {
    const int tid = tid_(), d = tid & 127, tq = tid >> 7;
    LAS float* sG = (LAS float*)lds; LAS float* sT4 = sG + 2048;
    bf16_t* Q = (bf16_t*)(p.ws + WS_R3); bf16_t* Kk = Q + (size_t)TOK * 512;
    bf16_t* QB = (bf16_t*)(p.ws + WS_R5); bf16_t* KB = QB + (size_t)TOK * 512;
    const float* GLR = (const float*)(p.ws + WS_GLR);
    for (int task = bid_(); task < 2560; task += gridDim.x) {
        const int c64 = task >> 2, h = task & 3, tb = c64 * 64;
        { const int row = tid >> 3, c4 = (tid & 7) * 4; *(LAS f32x4*)(sG + row * 32 + c4) = *(const f32x4*)(GLR + (size_t)(tb + row) * 32 + c4); }
        float qv[16], kv[16];
#pragma unroll
        for (int i = 0; i < 16; ++i) { const size_t o = (size_t)(tb + tq * 16 + i) * 512 + h * 128 + d; qv[i] = bf2f(Q[o]); kv[i] = bf2f(Kk[o]); }
        __syncthreads();
#pragma unroll 1
        for (int dir = 0; dir < 2; ++dir) {
            float w[16];
#pragma unroll
            for (int r = 0; r < 16; ++r) w[r] = p.in[lnd(11)][((size_t)(l * 2 + dir) * 16 + r) * 512 + h * 128 + d];
            const float bg = p.in[lnd(12)][(size_t)(l * 2 + dir) * 512 + h * 128 + d];
            float cum[16];
#pragma unroll
            for (int i = 0; i < 16; ++i) { const LAS float* gr = sG + (tq * 16 + i) * 32 + dir * 16; float z = bg;
#pragma unroll
                for (int r = 0; r < 16; ++r) z += gr[r] * w[r];
                cum[i] = (fminf(z, 0.f) - __logf(1.0f + __expf(-fabsf(z)))) * 0.0625f; }
            if (dir == 0) {
#pragma unroll
                for (int i = 1; i < 16; ++i) cum[i] += cum[i - 1];
            } else {
#pragma unroll
                for (int i = 14; i >= 0; --i) cum[i] += cum[i + 1];
            }
            sT4[tq * 128 + d] = dir == 0 ? cum[15] : cum[0];
            __syncthreads();
            float off = 0.f, total = 0.f;
#pragma unroll
            for (int q = 0; q < 4; ++q) { const float v = sT4[q * 128 + d]; total += v; if (dir == 0 ? (q < tq) : (q > tq)) off += v; }
            bf16_t* QD = dir == 0 ? Q : QB; bf16_t* KI = dir == 0 ? Kk : KB;
#pragma unroll
            for (int i = 0; i < 16; ++i) { const float cm = cum[i] + off; const size_t o = (size_t)(tb + tq * 16 + i) * 512 + h * 128 + d;
                QD[o] = f2bf(qv[i] * __expf(cm)); KI[o] = f2bf(kv[i] * __expf(-cm)); }
            if (tq == 0) ((float*)(p.ws + (dir == 0 ? WS_TOTF : WS_TOTB)))[(size_t)c64 * 512 + h * 128 + d] = total;
            __syncthreads();
        }
    }
}

constexpr int GLA_GRP = 71168;
typedef short s16x4 __attribute__((ext_vector_type(4)));
__device__ __forceinline__ bf16x8 tr_frag(const LAS bf16_t* base, int stride, int krow0, int col0, int fr, int fq) {
    const LAS bf16_t* q = base + (krow0 + 8 * fq + (fr >> 2)) * stride + col0 + 4 * (fr & 3);
    const s16x4 a = __builtin_amdgcn_ds_read_tr16_b64_v4i16((LAS s16x4*)q);
    const s16x4 b = __builtin_amdgcn_ds_read_tr16_b64_v4i16((LAS s16x4*)(q + 4 * stride));
    return __builtin_shufflevector(a, b, 0, 1, 2, 3, 4, 5, 6, 7);
}
#define LDS_BAR() do { asm volatile("s_waitcnt lgkmcnt(0)" ::: "memory"); __builtin_amdgcn_s_barrier(); asm volatile("" ::: "memory"); } while (0)
__device__ __forceinline__ void phase_gla(const P& p, int l, LAS unsigned char* lds) {
    const int tid = tid_(), grp = __builtin_amdgcn_readfirstlane(tid >> 8), gt = tid & 255, wv = __builtin_amdgcn_readfirstlane((tid >> 6) & 3), lane = tid & 63, fr = lane & 15, fq = lane >> 4;
    LAS unsigned char* gl = lds + grp * GLA_GRP;
    LAS bf16_t* sQ = (LAS bf16_t*)gl; LAS bf16_t* sK = (LAS bf16_t*)(gl + 17408); LAS bf16_t* sV = (LAS bf16_t*)(gl + 34816);
    LAS bf16_t* sP = (LAS bf16_t*)(gl + 44032); LAS bf16_t* sS = (LAS bf16_t*)(gl + 53248); LAS float* sTot = (LAS float*)(gl + 70656);
    const bf16_t* QD = grp == 0 ? (const bf16_t*)(p.ws + WS_R3) : (const bf16_t*)(p.ws + WS_R5);
    const bf16_t* KI = QD + (size_t)TOK * 512;
    const bf16_t* V = (const bf16_t*)(p.ws + WS_R4);
    const float* TOT = (const float*)(p.ws + (grp == 0 ? WS_TOTF : WS_TOTB));
    bf16_t* O = (bf16_t*)(p.ws + WS_R1);
    float* OST = p.out + (size_t)TOK * 1024;
    const int G = gridDim.x, b = bid_();
    const bool custom = (G == 256);
    const int ntask_mine = custom ? (b < 128 ? 1 : 4) : ((640 - b + G - 1) / G);
    for (int ti = 0; ti < ntask_mine; ++ti) {
        const int task = custom ? (b < 128 ? b : b + 128 * ti) : b + G * ti;
        if (task >= 640) break;
        const bool sample = task < 128;
        const int t2 = sample ? task : task - 128, xcd_ = t2 & 7, vs = (t2 >> 3) & 3, sh_ = xcd_ + 8 * (t2 >> 5), sb = sh_ >> 2, h = sh_ & 3;
        const int base = sample ? TOKP + sb * 4096 : sb * 256, nch = sample ? 64 : 4;
        f32x4 accS[2][4];
#pragma unroll
        for (int dt = 0; dt < 2; ++dt)
#pragma unroll
            for (int vt = 0; vt < 4; ++vt) {
                f32x4 a = (f32x4){0.f, 0.f, 0.f, 0.f};
                if (sample) { const float* cp = p.in[lnd(3)] + (((((size_t)sb * 2 + l) * 2 + grp) * 4 + h) * 128 + 16 * (2 * wv + dt) + 4 * fq) * 256 + vs * 64 + 16 * vt + fr;
#pragma unroll
                    for (int e = 0; e < 4; ++e) a[e] = cp[(size_t)e * 256]; }
                accS[dt][vt] = a;
                u32x2 w; w.x = pk_bf16(a[0], a[1]); w.y = pk_bf16(a[2], a[3]);
                *(LAS u32x2*)(sS + (16 * vt + fr) * 136 + 16 * (2 * wv + dt) + 4 * fq) = w;
            }
        u32x4 rq[2][4], rk[2][4], rv[2][2]; float rt[2] = {0.f, 0.f};
        u32x2 oprev[2][4];
#pragma unroll
        for (int u = 0; u < 2; ++u)
#pragma unroll
            for (int vt = 0; vt < 4; ++vt) oprev[u][vt] = (u32x2){0u, 0u};
#define GLA_CHUNK(st) (grp == 0 ? (st) : nch - 1 - (st))
#define GLA_LOAD(U, ci) do { const int tb_ = base + (ci) * 64; \
        _Pragma("unroll") for (int i = 0; i < 4; ++i) { const int idx = gt + 256 * i, row = idx >> 4, c16 = idx & 15; const size_t o = (size_t)(tb_ + row) * 512 + h * 128 + c16 * 8; rq[U][i] = *(const u32x4*)(QD + o); rk[U][i] = *(const u32x4*)(KI + o); } \
        _Pragma("unroll") for (int i = 0; i < 2; ++i) { const int idx = gt + 256 * i, row = idx >> 3, c8 = idx & 7; rv[U][i] = *(const u32x4*)(V + (size_t)(tb_ + row) * 1024 + h * 256 + vs * 64 + c8 * 8); } \
        if (gt < 128) rt[U] = TOT[(size_t)(tb_ >> 6) * 512 + h * 128 + gt]; } while (0)
#define GLA_STORE(U) do { \
        _Pragma("unroll") for (int i = 0; i < 4; ++i) { const int idx = gt + 256 * i, row = idx >> 4, c16 = idx & 15; *(LAS u32x4*)(sQ + row * 136 + c16 * 8) = rq[U][i]; *(LAS u32x4*)(sK + row * 136 + c16 * 8) = rk[U][i]; } \
        _Pragma("unroll") for (int i = 0; i < 2; ++i) { const int idx = gt + 256 * i, row = idx >> 3, c8 = idx & 7; *(LAS u32x4*)(sV + row * 72 + c8 * 8) = rv[U][i]; } \
        if (gt < 128) sTot[gt] = rt[U]; } while (0)
#define GLA_OLOAD(U, st) do { const int tb_ = base + GLA_CHUNK(st) * 64; \
        _Pragma("unroll") for (int vt = 0; vt < 4; ++vt) oprev[U][vt] = *(const u32x2*)(O + (size_t)(tb_ + 16 * wv + fr) * 1024 + h * 256 + vs * 64 + 16 * vt + 4 * fq); } while (0)
        GLA_LOAD(0, GLA_CHUNK(0));
        GLA_STORE(0);
        GLA_LOAD(1, GLA_CHUNK(1));
        __syncthreads();
        const int half = nch >> 1;
        for (int s0 = 0; s0 < nch; s0 += 2) {
#pragma unroll
          for (int u = 0; u < 2; ++u) {
            const int s = s0 + u;
            const int ci = GLA_CHUNK(s), tb = base + ci * 64;
            const bool second = (s >= half);
            if (s == half) GLA_OLOAD(u, s);
            if (s + 1 < nch && s + 1 > half) GLA_OLOAD(u ^ 1, s + 1);
            asm volatile("" ::: "memory");
            if (s + 2 < nch) GLA_LOAD(u, GLA_CHUNK(s + 2));
            { bf16x8 qa[4];
#pragma unroll
            for (int ks = 0; ks < 4; ++ks) qa[ks] = *(const LAS bf16x8*)(sQ + (16 * wv + fr) * 136 + 32 * ks + 8 * fq);
#pragma unroll
            for (int jt = 0; jt < 4; ++jt) {
                bf16x8 kb[4];
#pragma unroll
                for (int ks = 0; ks < 4; ++ks) kb[ks] = *(const LAS bf16x8*)(sK + (16 * jt + fr) * 136 + 32 * ks + 8 * fq);
                f32x4 acc = (f32x4){0.f, 0.f, 0.f, 0.f};
#pragma unroll
                for (int ks = 0; ks < 4; ++ks) acc = __builtin_amdgcn_mfma_f32_16x16x32_bf16(qa[ks], kb[ks], acc, 0, 0, 0);
#pragma unroll
                for (int e = 0; e < 4; ++e) { const int i = 16 * wv + 4 * fq + e, j = 16 * jt + fr; const bool keep = grp == 0 ? (j <= i) : (j >= i); sP[i * 72 + j] = f2bf(keep ? acc[e] : 0.f); }
            } }
            asm volatile("" ::: "memory");
            bf16x8 vf[4][2];
#pragma unroll
            for (int vt = 0; vt < 4; ++vt)
#pragma unroll
                for (int ks = 0; ks < 2; ++ks) vf[vt][ks] = tr_frag(sV, 72, 32 * ks, 16 * vt, fr, fq);
#pragma unroll
            for (int dt = 0; dt < 2; ++dt) {
                bf16x8 kf[2];
#pragma unroll
                for (int ks = 0; ks < 2; ++ks) kf[ks] = tr_frag(sK, 136, 32 * ks, 16 * (2 * wv + dt), fr, fq);
                const f32x4 tt = *(const LAS f32x4*)(sTot + 16 * (2 * wv + dt) + 4 * fq);
                const f32x4 sc = (f32x4){__expf(tt[0]), __expf(tt[1]), __expf(tt[2]), __expf(tt[3])};
#pragma unroll
                for (int vt = 0; vt < 4; ++vt) {
#pragma unroll
                    for (int ks = 0; ks < 2; ++ks) accS[dt][vt] = __builtin_amdgcn_mfma_f32_16x16x32_bf16(kf[ks], vf[vt][ks], accS[dt][vt], 0, 0, 0);
                    accS[dt][vt] = accS[dt][vt] * sc;
                }
            }
            asm volatile("s_waitcnt lgkmcnt(0)" ::: "memory");
            {
                bf16x8 pf[2];
#pragma unroll
                for (int ks = 0; ks < 2; ++ks) pf[ks] = *(const LAS bf16x8*)(sP + (16 * wv + fr) * 72 + 32 * ks + 8 * fq);
                bf16x8 qf[4];
#pragma unroll
                for (int ks = 0; ks < 4; ++ks) qf[ks] = *(const LAS bf16x8*)(sQ + (16 * wv + fr) * 136 + 32 * ks + 8 * fq);
#pragma unroll
                for (int vt = 0; vt < 4; ++vt) {
                    f32x4 acc = (f32x4){0.f, 0.f, 0.f, 0.f};
#pragma unroll
                    for (int ks = 0; ks < 2; ++ks) acc = __builtin_amdgcn_mfma_f32_16x16x32_bf16(vf[vt][ks], pf[ks], acc, 0, 0, 0);
#pragma unroll
                    for (int ks = 0; ks < 4; ++ks) { const bf16x8 sf = *(const LAS bf16x8*)(sS + (16 * vt + fr) * 136 + 32 * ks + 8 * fq);
                        acc = __builtin_amdgcn_mfma_f32_16x16x32_bf16(sf, qf[ks], acc, 0, 0, 0); }
                    { u32x2 pv = oprev[u][vt]; asm volatile("" : "+v"(pv));
                      if (second) acc = acc + (f32x4){bflo(pv.x), bfhi(pv.x), bflo(pv.y), bfhi(pv.y)}; }
                    store4bf(O + (size_t)(tb + 16 * wv + fr) * 1024 + h * 256 + vs * 64 + 16 * vt + 4 * fq, acc);
                }
            }
            LDS_BAR();
#pragma unroll
            for (int dt = 0; dt < 2; ++dt)
#pragma unroll
                for (int vt = 0; vt < 4; ++vt) { u32x2 w; w.x = pk_bf16(accS[dt][vt][0], accS[dt][vt][1]); w.y = pk_bf16(accS[dt][vt][2], accS[dt][vt][3]);
                    *(LAS u32x2*)(sS + (16 * vt + fr) * 136 + 16 * (2 * wv + dt) + 4 * fq) = w; }
            if (s + 1 < nch) GLA_STORE(u ^ 1);
            if (s == half - 1) { asm volatile("s_waitcnt vmcnt(0)" ::: "memory"); __syncthreads(); } else LDS_BAR();
          }
        }
        if (!sample) {
#pragma unroll
            for (int dt = 0; dt < 2; ++dt)
#pragma unroll
                for (int vt = 0; vt < 4; ++vt) { float* op = OST + (((((size_t)sb * 2 + l) * 2 + grp) * 4 + h) * 128 + 16 * (2 * wv + dt) + 4 * fq) * 256 + vs * 64 + 16 * vt + fr;
#pragma unroll
                    for (int e = 0; e < 4; ++e) op[(size_t)e * 256] = accS[dt][vt][e]; }
        }
    }
#undef GLA_LOAD
#undef GLA_STORE
#undef GLA_OLOAD
#undef GLA_CHUNK
}

__device__ __forceinline__ void phase_glapost(const P& p, int l) {
    const int lane = tid_() & 63, gw = bid_() * 8 + (tid_() >> 6), nw = gridDim.x * 8;
    bf16_t* O = (bf16_t*)(p.ws + WS_R1); const bf16_t* R = (const bf16_t*)(p.ws + WS_R3);
    const float* gn = p.in[lnd(13)] + (size_t)l * 256 + (lane & 15) * 16;
    for (int row = gw; row < TOK; row += nw) {
        const size_t o = (size_t)row * 1024 + lane * 16; float x[16], r[16];
#pragma unroll
        for (int hh = 0; hh < 2; ++hh) { const u32x4 a = *(const u32x4*)(O + o + 8 * hh), c = *(const u32x4*)(R + o + 8 * hh);
            x[8 * hh + 0] = bflo(a.x); x[8 * hh + 1] = bfhi(a.x); x[8 * hh + 2] = bflo(a.y); x[8 * hh + 3] = bfhi(a.y); x[8 * hh + 4] = bflo(a.z); x[8 * hh + 5] = bfhi(a.z); x[8 * hh + 6] = bflo(a.w); x[8 * hh + 7] = bfhi(a.w);
            r[8 * hh + 0] = bflo(c.x); r[8 * hh + 1] = bfhi(c.x); r[8 * hh + 2] = bflo(c.y); r[8 * hh + 3] = bfhi(c.y); r[8 * hh + 4] = bflo(c.z); r[8 * hh + 5] = bfhi(c.z); r[8 * hh + 6] = bflo(c.w); r[8 * hh + 7] = bfhi(c.w); }
        float ss = 0.f;
#pragma unroll
        for (int e = 0; e < 16; ++e) ss += x[e] * x[e];
        ss += __shfl_xor(ss, 1); ss += __shfl_xor(ss, 2); ss += __shfl_xor(ss, 4); ss += __shfl_xor(ss, 8);
        const float rstd = rsqrtf(ss * (1.0f / 256.0f) + 1e-6f);
        float y[16];
#pragma unroll
        for (int e = 0; e < 16; ++e) y[e] = x[e] * rstd * gn[e] * r[e];
#pragma unroll
        for (int hh = 0; hh < 2; ++hh) { u32x4 w; w.x = pk_bf16(y[8 * hh], y[8 * hh + 1]); w.y = pk_bf16(y[8 * hh + 2], y[8 * hh + 3]); w.z = pk_bf16(y[8 * hh + 4], y[8 * hh + 5]); w.w = pk_bf16(y[8 * hh + 6], y[8 * hh + 7]); *(u32x4*)(O + o + 8 * hh) = w; }
    }
}


#define XB_TMO      128
#define XB_XCNT(j)  (256  + 64 * (j))
#define XB_XSUB(j)  (1280 + 64 * (j))
#define XB_XGEN(j)  (2304 + 64 * (j))
#define XB_TOP      3328
#define XB_TOPGEN   3392
#define XCD_BAR_WORDS 3456
#define XB_SPIN_CAP (1u << 18)
__device__ __forceinline__ unsigned xb_ld(unsigned* p)              { return __hip_atomic_load(p, __ATOMIC_RELAXED, __HIP_MEMORY_SCOPE_AGENT); }
__device__ __forceinline__ unsigned xb_add(unsigned* p, unsigned v) { return __hip_atomic_fetch_add(p, v, __ATOMIC_RELAXED, __HIP_MEMORY_SCOPE_AGENT); }
__device__ __forceinline__ unsigned xb_xcc_id() { return (unsigned)__builtin_amdgcn_s_getreg((3 << 11) | 20) & 0xFu; }
#define XB_SPIN(cond, bar) do { unsigned _sp = 0; while (cond) { __builtin_amdgcn_s_sleep(1); \
    if ((++_sp & 255u) == 0u) { if (xb_ld(&(bar)[XB_TMO])) break; if (_sp > XB_SPIN_CAP) { atomicAdd(&(bar)[XB_TMO], 1u); break; } } } } while (0)
struct XcdBarrier { unsigned* bar; unsigned x; volatile LAS unsigned* st; };
__device__ __forceinline__ XcdBarrier xcd_barrier_post(unsigned* bar, volatile LAS unsigned* st) {
    XcdBarrier b; b.bar = bar; b.x = xb_xcc_id(); b.st = st;
    if (threadIdx.x == 0) (void)xb_add(&bar[XB_XCNT(b.x)], 1u);
    return b;
}
__device__ __forceinline__ void xcd_barrier_complete(unsigned* bar, unsigned x, unsigned& nloc, unsigned& nx) {
    const unsigned G = gridDim.x * gridDim.y * gridDim.z;
    unsigned sum, cnt, mine, sp = 0u;
    for (;;) {
        sum = 0u; cnt = 0u; mine = 0u;
#pragma unroll
        for (unsigned j = 0; j < 16; ++j) { const unsigned c = xb_ld(&bar[XB_XCNT(j)]); sum += c; cnt += (c > 0u) ? 1u : 0u; mine = (j == x) ? c : mine; }
        if (sum == G) break;
        __builtin_amdgcn_s_sleep(1);
        if ((++sp & 255u) == 0u) { if (xb_ld(&bar[XB_TMO])) break; if (sp > XB_SPIN_CAP) { atomicAdd(&bar[XB_TMO], 1u); break; } }
    }
    nloc = mine > 0u ? mine : 1u; nx = cnt > 0u ? cnt : 1u;
}
__device__ __forceinline__ void xcd_barrier(const XcdBarrier& b) {
    asm volatile("s_waitcnt vmcnt(0)" ::: "memory");
    __syncthreads();
    if (threadIdx.x == 0) {
        unsigned* bar = b.bar;
        __builtin_amdgcn_s_waitcnt(0);
        unsigned nloc = b.st[0], nx = b.st[1];
        if (nloc == 0u) { xcd_barrier_complete(bar, b.x, nloc, nx); b.st[0] = nloc; b.st[1] = nx; }
        const unsigned old = xb_add(&bar[XB_XSUB(b.x)], 1u);
        const unsigned gen = old / nloc;
        if (old + 1u == (gen + 1u) * nloc) {
            __builtin_amdgcn_fence(__ATOMIC_RELEASE, "agent");
            asm volatile("s_waitcnt vmcnt(0)" ::: "memory");
            const unsigned og = xb_add(&bar[XB_TOP], 1u);
            const unsigned tg = og / nx;
            if (og + 1u == (tg + 1u) * nx) xb_add(&bar[XB_TOPGEN], 1u);
            else XB_SPIN(xb_ld(&bar[XB_TOPGEN]) == tg, bar);
            __builtin_amdgcn_fence(__ATOMIC_ACQUIRE, "agent");
            xb_add(&bar[XB_XGEN(b.x)], 1u);
            asm volatile("s_waitcnt vmcnt(0)" ::: "memory");
        } else {
            XB_SPIN(xb_ld(&bar[XB_XGEN(b.x)]) == gen, bar);
            __builtin_amdgcn_fence(__ATOMIC_ACQUIRE, "agent");
            asm volatile("s_waitcnt vmcnt(0)" ::: "memory");
        }
    }
    __syncthreads();
}

__device__ __forceinline__ void run_phase(const P& p, int ph, LAS unsigned char* lds) {
    if (ph == 2 * PPL) { if (EN(34)) phase_final(p); return; }
    const int l = ph / PPL, q = ph % PPL;
    unsigned char* ws = p.ws; bf16_t* W = (bf16_t*)(ws + WS_W);
    const int G = gridDim.x, c = bid_();
    pg8::Order S;
    switch (q) {
        case 0: if (EN(0)) phase_prep(p, l, lds); break;
        case 1: if (EN(1)) phase_norm(p, l, 1); break;
        case 2: if (EN(2)) { pg8::Gemm g{(const bf16_t*)(ws + WS_R2), W + W_A / 2, TOK, 2816, 1024, 1024, 0, 0, 1}; S.init(TOK, 2816, 1, G, c);
            EpiPartA E{(bf16_t*)(ws + WS_R3), (bf16_t*)(ws + WS_R3) + (size_t)TOK * 512, (bf16_t*)(ws + WS_R4), (bf16_t*)(ws + WS_R5), (float*)(ws + WS_GLR)};
            pg8::gemm_phase(lds, g, S, E); } break;
        case 3: if (EN(3)) { pg8::Gemm g{(const bf16_t*)(ws + WS_R5), (const bf16_t*)(ws + WS_EMAT), 1280, 256, 512, 768, (size_t)1280 * 768, (size_t)256 * 512, 32}; S.init(1280, 256, 32, G, c);
            EpiE E{(float*)(ws + WS_E)}; pg8::gemm_phase(lds, g, S, E); } break;
        case 4: if (EN(4)) phase_s5scan(p, l); break;
        case 5: if (EN(5)) { pg8::Gemm g{(const bf16_t*)(ws + WS_R5), (const bf16_t*)(ws + WS_R1), 1280, 512, 768, 768, (size_t)1280 * 768, (size_t)512 * 768, 32}; S.init(1280, 512, 32, G, c);
            EpiY E{(bf16_t*)(ws + WS_E)}; pg8::gemm_phase(lds, g, S, E); } break;
        case 6: if (EN(6)) { pg8::Gemm g{(const bf16_t*)(ws + WS_E), W + W_GLU / 2, TOK, 512, 512, 512, 0, 0, 1}; S.init(TOK, 512, 1, G, c);
            EpiGLU E{(const bf16_t*)(ws + WS_E), (bf16_t*)(ws + WS_R6), p.in[lnd(24)] + (size_t)l * 512}; pg8::gemm_phase(lds, g, S, E); } break;
        case 7: if (EN(7)) phase_glapre(p, l, lds); break;
        case 8: if (EN(8)) phase_gla(p, l, lds); break;
        case 9: if (EN(9)) { pg8::Gemm g{(const bf16_t*)(ws + WS_R2), W + W_B / 2, TOK, 3072, 1024, 1024, 0, 0, 1}; S.init(TOK, 3072, 1, G, c);
            EpiPartB E{(bf16_t*)(ws + WS_R3), (bf16_t*)(ws + WS_R4), (bf16_t*)(ws + WS_R5)}; pg8::gemm_phase(lds, g, S, E); } break;
        case 10: if (EN(10)) phase_glapost(p, l); break;
        case 11: if (EN(11)) { pg8::Gemm g{(const bf16_t*)(ws + WS_R1), W + W_PG / 2, TOK, 1024, 1024, 1024, 0, 0, 1}; S.init(TOK, 1024, 1, G, c);
              EpiProj1 E{(const bf16_t*)(ws + WS_R4), (bf16_t*)(ws + WS_R2)}; pg8::gemm_phase(lds, g, S, E); } break;
        case 12: if (EN(12)) { pg8::Gemm g{(const bf16_t*)(ws + WS_R6), W + W_PS / 2, TOK, 1024, 512, 512, 0, 0, 1}; S.init(TOK, 1024, 1, G, c);
              EpiProj2 E{(const bf16_t*)(ws + WS_R5), (bf16_t*)(ws + WS_R2)}; pg8::gemm_phase(lds, g, S, E); } break;
        case 13: if (EN(13)) { pg8::Gemm g{(const bf16_t*)(ws + WS_R2), W + W_OUT / 2, TOK, 1024, 1024, 1024, 0, 0, 1}; S.init(TOK, 1024, 1, G, c);
            EpiDelta E{(bf16_t*)(ws + WS_R3), (const float*)(ws + WS_MOD) + (size_t)l * 9 * 6144 + 2048}; pg8::gemm_phase(lds, g, S, E); } break;
        case 14: if (EN(14)) phase_norm(p, l, 2); break;
        case 15: if (EN(15)) { pg8::Gemm g{(const bf16_t*)(ws + WS_R2), W + W_1 / 2, TOK, 4096, 1024, 1024, 0, 0, 1}; S.init(TOK, 4096, 1, G, c);
            EpiFF1 E{(bf16_t*)(ws + WS_HID)}; pg8::gemm_phase(lds, g, S, E); } break;
        case 16: if (EN(16)) { pg8::Gemm g{(const bf16_t*)(ws + WS_HID), W + W_2 / 2, TOK, 1024, 4096, 4096, 0, 0, 1}; S.init(TOK, 1024, 1, G, c);
            EpiDelta E{(bf16_t*)(ws + WS_R2), (const float*)(ws + WS_MOD) + (size_t)l * 9 * 6144 + 5120}; pg8::gemm_phase(lds, g, S, E); } break;
        default: break;
    }
}

__global__ void __launch_bounds__(NTHR, 2) fwd_megakernel(P p) {
    extern __shared__ __attribute__((aligned(16))) unsigned char lds_raw[];
    LAS unsigned char* lds = (LAS unsigned char*)lds_raw;
#if MULTI_LAUNCH
    for (int ph = p.ph_lo; ph < p.ph_hi; ++ph) run_phase(p, ph, lds);
#else
    cg::grid_group grid = cg::this_grid();
    if (p.ph_lo < 0) grid.sync();
    volatile LAS unsigned* stw = (volatile LAS unsigned*)(lds + LDS_BYTES - 16);
    if (threadIdx.x < 4) stw[threadIdx.x] = 0u;
    __syncthreads();
    const XcdBarrier bar = xcd_barrier_post((unsigned*)(p.ws + WS_BAR), stw);
    for (int ph = p.ph_lo; ph < p.ph_hi; ++ph) {
        run_phase(p, ph, lds);
#if REP_MASK
        if (ph < 2 * PPL && ((REP_MASK >> (ph % PPL)) & 1)) {
            xcd_barrier(bar);
            if ((ph % PPL) == 12) { run_phase(p, ph - 1, lds); }
            run_phase(p, ph, lds);
        }
#endif
        if (ph + 1 < p.ph_hi && (ph % PPL) != 11) xcd_barrier(bar);
    }
#endif
}

extern "C" void kernel_launch(void* const* d_in, const int* in_sizes, int n_in, void* d_out, int out_size, void* d_ws, size_t ws_size, hipStream_t stream) {
    static int grid = 0;
    if (grid == 0) {
        if (n_in != 31 || ws_size < WS_END) { fprintf(stderr, "kernel_launch: unexpected n_in %d or ws_size %zu (< %zu)\n", n_in, ws_size, (size_t)WS_END); grid = -1; return; }
        int dev = 0, cus = 0, per_cu = 0;
        hipGetDevice(&dev);
        hipDeviceGetAttribute(&cus, hipDeviceAttributeMultiprocessorCount, dev);
        if (hipFuncSetAttribute((const void*)fwd_megakernel, hipFuncAttributeMaxDynamicSharedMemorySize, LDS_BYTES) != hipSuccess) { fprintf(stderr, "kernel_launch: hipFuncSetAttribute failed\n"); grid = -1; return; }
        hipOccupancyMaxActiveBlocksPerMultiprocessor(&per_cu, (const void*)fwd_megakernel, NTHR, LDS_BYTES);
        (void)hipGetLastError();
        if (per_cu < 1) fprintf(stderr, "kernel_launch: occupancy query says %d blocks per CU\n", per_cu);
        grid = cus > 0 ? cus : 256;
    }
    if (grid < 0) return;
    P p{};
    for (int i = 0; i < 31; ++i) p.in[i] = (const float*)d_in[i];
    p.out = (float*)d_out; p.ws = (unsigned char*)d_ws;
#if MULTI_LAUNCH
    for (int ph = 0; ph < NPHASE; ++ph) { p.ph_lo = ph; p.ph_hi = ph + 1; hipLaunchKernelGGL(fwd_megakernel, dim3(grid), dim3(NTHR), LDS_BYTES, stream, p); }
#else
    p.ph_lo = 0; p.ph_hi = NPHASE;
    (void)hipMemsetAsync((char*)d_ws + WS_BAR, 0, XCD_BAR_WORDS * sizeof(unsigned), stream);
    void* args[] = {&p};
    hipError_t e = hipLaunchCooperativeKernel((const void*)fwd_megakernel, dim3(grid), dim3(NTHR), args, LDS_BYTES, stream);
    if (e != hipSuccess) fprintf(stderr, "cooperative launch failed: %s (grid %d)\n", hipGetErrorString(e), grid);
#endif
}
```

```cpp
#include <hip/hip_runtime.h>
#include <hip/hip_cooperative_groups.h>
#include <cstdio>
namespace cg = cooperative_groups;

#ifndef MULTI_LAUNCH
#define MULTI_LAUNCH 0
#endif

#ifndef REP_MASK
#define REP_MASK 0
#endif
#ifndef PHASE_SEL
#define PHASE_SEL -1
#endif
#define EN(q) (PHASE_SEL < 0 || PHASE_SEL == (q))
#define LAS __attribute__((address_space(3)))
typedef unsigned short bf16_t;
typedef short bf16x8 __attribute__((ext_vector_type(8)));
typedef float f32x4 __attribute__((ext_vector_type(4)));
typedef unsigned u32x4 __attribute__((ext_vector_type(4)));
typedef unsigned u32x2 __attribute__((ext_vector_type(2)));

constexpr int NTHR = 512;
constexpr int TOK = 40960, TOKP = 8192;
constexpr int LDS_BYTES = 147456;
constexpr int NPHASE = 35;
constexpr int PPL = 17;

constexpr size_t MiB = (size_t)1 << 20;
constexpr size_t WS_MOD = 0;
constexpr size_t WS_GLR = 1 * MiB;
constexpr size_t WS_TOTF = 7 * MiB;
constexpr size_t WS_TOTB = 9 * MiB;
constexpr size_t WS_BAR = 12 * MiB;
constexpr size_t WS_W = 16 * MiB;
constexpr size_t W_A = 0;
constexpr size_t W_B = W_A + (size_t)2816 * 1024 * 2;
constexpr size_t W_PG = W_B + (size_t)3072 * 1024 * 2;
constexpr size_t W_GLU = W_PG + (size_t)1024 * 1024 * 2;
constexpr size_t W_PS = W_GLU + (size_t)512 * 512 * 2;
constexpr size_t W_OUT = W_PS + (size_t)1024 * 512 * 2;
constexpr size_t W_1 = W_OUT + (size_t)1024 * 1024 * 2;
constexpr size_t W_2 = W_1 + (size_t)4096 * 1024 * 2;
constexpr size_t WS_R2 = 50 * MiB;
constexpr size_t WS_R3 = 130 * MiB;
constexpr size_t WS_R4 = 210 * MiB;
constexpr size_t WS_R5 = 290 * MiB;
constexpr size_t WS_E = 350 * MiB;
constexpr size_t WS_R6 = 390 * MiB;
constexpr size_t WS_R1 = 430 * MiB;
constexpr size_t WS_EMAT = 454 * MiB;
constexpr size_t WS_HID = 130 * MiB;
constexpr size_t WS_END = 510 * MiB;

struct P { const float* in[31]; float* out; unsigned char* ws; int ph_lo, ph_hi; };

__device__ __forceinline__ int tid_() { int t = threadIdx.x; asm volatile("" : "+v"(t)); return t; }
__device__ __forceinline__ int bid_() { int b = blockIdx.x; asm volatile("" : "+s"(b)); return b; }
__device__ __forceinline__ int lnd(int k) { asm volatile("" : "+s"(k)); return k; }
__device__ __forceinline__ unsigned pk_bf16(float lo, float hi) { unsigned r; asm("v_cvt_pk_bf16_f32 %0, %1, %2" : "=v"(r) : "v"(lo), "v"(hi)); return r; }
__device__ __forceinline__ float bf2f(bf16_t b) { return __uint_as_float(((unsigned)b) << 16); }
__device__ __forceinline__ float bflo(unsigned w) { return __uint_as_float(w << 16); }
__device__ __forceinline__ float bfhi(unsigned w) { return __uint_as_float(w & 0xffff0000u); }
__device__ __forceinline__ bf16_t f2bf(float f) { return (bf16_t)(pk_bf16(f, 0.f) & 0xffffu); }
__device__ __forceinline__ float sigmoidf_(float x) { return 1.0f / (1.0f + __expf(-x)); }
__device__ __forceinline__ void store4bf(bf16_t* ptr, f32x4 v) { u32x2 w; w.x = pk_bf16(v[0], v[1]); w.y = pk_bf16(v[2], v[3]); *(u32x2*)ptr = w; }
__device__ __forceinline__ f32x4 load4bf(const bf16_t* ptr) { u32x2 w = *(const u32x2*)ptr; return (f32x4){bflo(w.x), bfhi(w.x), bflo(w.y), bfhi(w.y)}; }
__device__ __forceinline__ int mod_index(int tok) { return tok < TOKP ? 0 : (tok >> 12) - 1; }
__device__ __forceinline__ float wave_sum(float v) {
#pragma unroll
    for (int o = 32; o >= 1; o >>= 1) v += __shfl_xor(v, o);
    return v;
}

namespace pg8 {
constexpr int BM = 256, BK = 64, HALF = 128, HTB = HALF * BK * 2, STAGE_BYTES = 8 * HTB, NXCD = 8, WGM = 8;
__device__ __forceinline__ int lds_byte(int r, int c) { const int st = (r >> 4) * 2 + (c >> 5), rr = r & 15, cc = c & 31, ob = rr * 64 + cc * 2; return st * 1024 + (ob ^ (((ob >> 9) & 1) << 5)); }
__device__ __forceinline__ void stage_rc(int b, int& R, int& C) { const int st = b / 1024, sb = b % 1024, swz = sb ^ (((sb >> 9) & 1) << 5); R = (st >> 1) * 16 + swz / 64; C = (st & 1) * 32 + (swz % 64) / 2; }

struct Unit { int pm, pn, z, hf; };
struct Gemm { const bf16_t* A; const bf16_t* Bt; int M, N, K, lda; size_t sA, sB; int nz; };
struct Order {
    int nM, nN, nwg, G, c, nz, nfull, rem2;
    __device__ __forceinline__ void init(int M, int N, int nz_, int G_, int c_) { nM = M / BM; nN = N / BM; nwg = nM * nN; G = G_; c = c_; nz = nz_;
        nfull = nwg; rem2 = 0;
        if (nz == 1) { const int full = (nwg / G) * G, rem = nwg - full; if (rem > 0 && 2 * rem <= G) { nfull = full; rem2 = 2 * rem; } } }
    __device__ __forceinline__ void map(int wgid, Unit& u) const {
        { const int q = nwg / NXCD, r = nwg % NXCD, xcd = wgid % NXCD, off = wgid / NXCD; wgid = (xcd < r ? xcd * (q + 1) : r * (q + 1) + (xcd - r) * q) + off; }
        const int nig = WGM * nN, gid = wgid / nig, fm = gid * WGM, gsz = (nM - fm) < WGM ? (nM - fm) : WGM;
        u.pm = fm + ((wgid % nig) % gsz); u.pn = (wgid % nig) / gsz; u.z = 0; }
    __device__ __forceinline__ bool next(int i, Unit& u) const {
        const long L = (long)i * G + c;
        if (nz == 1) {
            if (L < nfull) { map((int)L, u); u.hf = 0; return true; }
            const int t = (int)(L - nfull); if (t >= rem2) return false;
            map(nfull + (t >> 1), u); u.hf = 1 + (t & 1); return true;
        }
        if (L >= (long)nwg * nz) return false;
        const int z = (int)(L / nwg), r = (int)(L % nwg); u.z = z; u.pm = r % nM; u.pn = r / nM; u.hf = 0;
        return true;
    }
};

template <class Epi>
__device__ __forceinline__ void gemm_phase(LAS unsigned char* lds, const Gemm g, const Order& S, const Epi& E) {
    const int tid = tid_(), wid = __builtin_amdgcn_readfirstlane(tid >> 6), lane = tid & 63, wr = wid >> 2, wc = wid & 3, fr = lane & 15, fq = lane >> 4;
    const int K = g.K, nt = K / BK;
    unsigned voffA[2], voffB[2];
#pragma unroll
    for (int i = 0; i < 2; ++i) { int R, C; stage_rc(tid * 16 + i * 8192, R, C); voffA[i] = (unsigned)(R * g.lda + C) * 2u; voffB[i] = (unsigned)(R * K + C) * 2u; }
    const size_t kstep = (size_t)(BK * 2);
    const size_t hstepA = (size_t)HALF * g.lda * 2, hstepB = (size_t)HALF * K * 2;
    const unsigned ldsw = (unsigned)wid * 1024u;
    const int aoff = lds_byte(wr * 64 + fr, fq * 8), boff = lds_byte(wc * 32 + fr, fq * 8);
#define PG8_SA(b, h) (((b) * 2 + (h)) * HTB)
#define PG8_SB(b, h) ((4 + (b) * 2 + (h)) * HTB)
#define PG8_STAGE(bufoff, gbase, voff) do { _Pragma("unroll") for (int _i = 0; _i < 2; ++_i) \
        __builtin_amdgcn_global_load_lds((const unsigned*)((const char*)(gbase) + (voff)[_i]), (LAS unsigned*)(lds + (bufoff) + ldsw + _i * 8192), 16, 0, 0); } while (0)
#define PG8_LDA(dst, b, h) do { _Pragma("unroll") for (int m = 0; m < 4; ++m) _Pragma("unroll") for (int k = 0; k < 2; ++k) dst[m][k] = *(const LAS bf16x8*)(lds + PG8_SA(b, h) + aoff + m * 2048 + k * 1024); } while (0)
#define PG8_LDB(dst, b, h) do { _Pragma("unroll") for (int n = 0; n < 2; ++n) _Pragma("unroll") for (int k = 0; k < 2; ++k) dst[n][k] = *(const LAS bf16x8*)(lds + PG8_SB(b, h) + boff + n * 2048 + k * 1024); } while (0)
#define PG8_MMA(ai, bj, At, Bt) do { __builtin_amdgcn_s_setprio(1); _Pragma("unroll") for (int m = 0; m < 4; ++m) _Pragma("unroll") for (int n = 0; n < 2; ++n) _Pragma("unroll") for (int k = 0; k < 2; ++k) \
        acc[ai][bj][m][n] = __builtin_amdgcn_mfma_f32_16x16x32_bf16(Bt[n][k], At[m][k], acc[ai][bj][m][n], 0, 0, 0); __builtin_amdgcn_s_setprio(0); } while (0)
#define PG8_WAIT_V(n) asm volatile("s_waitcnt vmcnt(" #n ")" ::: "memory")
#define PG8_WAIT_L(n) asm volatile("s_waitcnt lgkmcnt(" #n ")" ::: "memory")
#define PG8_BAR __builtin_amdgcn_s_barrier()
#define PG8_SCHED __builtin_amdgcn_sched_barrier(0)
    Unit cur, nxt; int ui = 0;
    if (!S.next(0, cur)) return;
    f32x4 acc[2][2][4][2];
#pragma unroll
    for (int a = 0; a < 2; ++a)
#pragma unroll
        for (int b = 0; b < 2; ++b)
#pragma unroll
            for (int m = 0; m < 4; ++m)
#pragma unroll
                for (int n = 0; n < 2; ++n) acc[a][b][m][n] = (f32x4){0.f, 0.f, 0.f, 0.f};
    bf16x8 At[4][2], B0[2][2], B1[2][2];
    const char* cA = (const char*)g.A + ((size_t)cur.z * g.sA + (size_t)(cur.pm * BM + (cur.hf == 2 ? HALF : 0)) * g.lda) * 2;
    const char* cB = (const char*)g.Bt + ((size_t)cur.z * g.sB + (size_t)cur.pn * BM * K) * 2;
    PG8_STAGE(PG8_SB(0, 0), cB, voffB); PG8_STAGE(PG8_SB(0, 1), cB + hstepB, voffB); PG8_STAGE(PG8_SA(0, 0), cA, voffA); PG8_STAGE(PG8_SA(0, 1), cA + hstepA, voffA);
    if (wr == 1) PG8_BAR;
    PG8_WAIT_V(2); PG8_BAR;
    PG8_STAGE(PG8_SB(1, 0), cB + kstep, voffB); PG8_STAGE(PG8_SA(1, 0), cA + kstep, voffA); PG8_STAGE(PG8_SB(1, 1), cB + hstepB + kstep, voffB);
    PG8_WAIT_V(6); PG8_BAR;
    for (;;) {
        const bool has_next = S.next(ui + 1, nxt);
        const char* nA = has_next ? (const char*)g.A + ((size_t)nxt.z * g.sA + (size_t)(nxt.pm * BM + (nxt.hf == 2 ? HALF : 0)) * g.lda) * 2 : cA;
        const bool fullu = (cur.hf == 0);
        const char* nB = has_next ? (const char*)g.Bt + ((size_t)nxt.z * g.sB + (size_t)nxt.pn * BM * K) * 2 : cB;
        for (int t = 0; t < nt; t += 2) {
            const bool last = (t == nt - 2);
            const char* a1 = cA + (size_t)(t + 1) * kstep;
            const char* a2 = last ? nA : cA + (size_t)(t + 2) * kstep; const char* b2 = last ? nB : cB + (size_t)(t + 2) * kstep;
            const char* a3 = a2 + kstep; const char* b3 = b2 + kstep;
            PG8_LDB(B0, 0, 0); PG8_LDB(B1, 0, 1); PG8_SCHED; PG8_LDA(At, 0, 0); PG8_STAGE(PG8_SA(1, 1), a1 + hstepA, voffA);
            PG8_WAIT_V(8); PG8_WAIT_L(0); PG8_BAR; PG8_MMA(0, 0, At, B0); PG8_MMA(0, 1, At, B1); PG8_BAR; PG8_SCHED;
            if (fullu) PG8_LDA(At, 0, 1); PG8_STAGE(PG8_SB(0, 0), b2, voffB); PG8_STAGE(PG8_SB(0, 1), b2 + hstepB, voffB); PG8_STAGE(PG8_SA(0, 0), a2, voffA);
            PG8_WAIT_V(8); PG8_WAIT_L(0); PG8_BAR; if (fullu) { PG8_MMA(1, 0, At, B0); PG8_MMA(1, 1, At, B1); } PG8_BAR; PG8_SCHED;
            PG8_LDB(B0, 1, 0); PG8_LDB(B1, 1, 1); PG8_SCHED; PG8_LDA(At, 1, 0); PG8_STAGE(PG8_SA(0, 1), a2 + hstepA, voffA);
            PG8_WAIT_V(8); PG8_WAIT_L(0); PG8_BAR; PG8_MMA(0, 0, At, B0); PG8_MMA(0, 1, At, B1); PG8_BAR; PG8_SCHED;
            if (fullu) PG8_LDA(At, 1, 1); PG8_STAGE(PG8_SB(1, 0), b3, voffB); PG8_STAGE(PG8_SB(1, 1), b3 + hstepB, voffB); PG8_STAGE(PG8_SA(1, 0), a3, voffA);
            PG8_WAIT_V(8); PG8_WAIT_L(0); PG8_BAR; if (fullu) { PG8_MMA(1, 0, At, B0); PG8_MMA(1, 1, At, B1); } PG8_BAR; PG8_SCHED;
        }
        if (wr == 0) PG8_BAR;
        if (fullu) E.template tile<2>(acc, cur.z, cur.pm * BM + wr * 64 + fr, cur.pn * BM + wc * 32 + (Epi::PERM ? 8 : 4) * fq);
        else E.template tile<1>(acc, cur.z, cur.pm * BM + (cur.hf == 2 ? HALF : 0) + wr * 64 + fr, cur.pn * BM + wc * 32 + (Epi::PERM ? 8 : 4) * fq);
        if (!has_next) break;
#pragma unroll
        for (int a = 0; a < 2; ++a)
#pragma unroll
            for (int b = 0; b < 2; ++b)
#pragma unroll
                for (int m = 0; m < 4; ++m)
#pragma unroll
                    for (int n = 0; n < 2; ++n) acc[a][b][m][n] = (f32x4){0.f, 0.f, 0.f, 0.f};
        cur = nxt; cA = nA; cB = nB; ++ui;
        if (wr == 1) PG8_BAR;
    }
    PG8_WAIT_V(0);
    PG8_BAR;
#undef PG8_SA
#undef PG8_SB
#undef PG8_STAGE
#undef PG8_LDA
#undef PG8_LDB
#undef PG8_MMA
#undef PG8_WAIT_V
#undef PG8_WAIT_L
#undef PG8_BAR
#undef PG8_SCHED
}
}

#define EPI_SIMPLE_TILE() \
    static constexpr bool PERM = false; \
    template <int NAI> __device__ __forceinline__ void tile(const f32x4 (&acc)[2][2][4][2], int z, int row0, int col0) const { \
        _Pragma("unroll") for (int ai = 0; ai < NAI; ++ai) _Pragma("unroll") for (int m = 0; m < 4; ++m) _Pragma("unroll") for (int bj = 0; bj < 2; ++bj) _Pragma("unroll") for (int n = 0; n < 2; ++n) \
            (*this)(z, row0 + ai * 128 + m * 16, col0 + bj * 128 + n * 16, acc[ai][bj][m][n]); }
#define EPI_PAIR_TILE() \
    static constexpr bool PERM = true; \
    template <int NAI> __device__ __forceinline__ void tile(const f32x4 (&acc)[2][2][4][2], int z, int row0, int col0) const { \
        _Pragma("unroll") for (int ai = 0; ai < NAI; ++ai) _Pragma("unroll") for (int m = 0; m < 4; ++m) _Pragma("unroll") for (int bj = 0; bj < 2; ++bj) \
            pair(row0 + ai * 128 + m * 16, col0 + bj * 128, acc[ai][bj][m][0], acc[ai][bj][m][1]); }
#define EPI_PIPE_TILE() \
    static constexpr bool PERM = true; \
    template <int NAI> __device__ __forceinline__ void tile(const f32x4 (&acc)[2][2][4][2], int z, int row0, int col0) const { \
        Pre pre; begin(row0, col0, pre); L buf[2][8]; \
        _Pragma("unroll") for (int mm = 0; mm < 2; ++mm) _Pragma("unroll") for (int bj = 0; bj < 2; ++bj) _Pragma("unroll") for (int n = 0; n < 2; ++n) load(row0 + mm * 16, col0 + bj * 128 + n * 4, buf[0][mm * 4 + bj * 2 + n]); \
        _Pragma("unroll") for (int b = 0; b < 2 * NAI; ++b) { \
            if (b < 2 * NAI - 1) { _Pragma("unroll") for (int mm = 0; mm < 2; ++mm) _Pragma("unroll") for (int bj = 0; bj < 2; ++bj) _Pragma("unroll") for (int n = 0; n < 2; ++n) \
                load(row0 + ((b + 1) >> 1) * 128 + (((b + 1) & 1) * 2 + mm) * 16, col0 + bj * 128 + n * 4, buf[(b + 1) & 1][mm * 4 + bj * 2 + n]); } \
            _Pragma("unroll") for (int mm = 0; mm < 2; ++mm) _Pragma("unroll") for (int bj = 0; bj < 2; ++bj) _Pragma("unroll") for (int n = 0; n < 2; ++n) \
                apply(row0 + (b >> 1) * 128 + ((b & 1) * 2 + mm) * 16, col0 + bj * 128 + n * 4, acc[b >> 1][bj][(b & 1) * 2 + mm][n], buf[b & 1][mm * 4 + bj * 2 + n], pre, bj * 2 + n); } }
__device__ __forceinline__ void store8bf(bf16_t* ptr, f32x4 a, f32x4 b) { u32x4 w; w.x = pk_bf16(a[0], a[1]); w.y = pk_bf16(a[2], a[3]); w.z = pk_bf16(b[0], b[1]); w.w = pk_bf16(b[2], b[3]); *(u32x4*)ptr = w; }

struct EpiPartA {
    bf16_t* Q; bf16_t* Kk; bf16_t* V; bf16_t* UG; float* GLR;
    __device__ __forceinline__ void pair(int row, int col, f32x4 a, f32x4 b) const {
        if (col < 512) store8bf(Q + (size_t)row * 512 + col, a, b);
        else if (col < 1024) store8bf(Kk + (size_t)row * 512 + (col - 512), a, b);
        else if (col < 2048) store8bf(V + (size_t)row * 1024 + (col - 1024), a, b);
        else if (col < 2304) { const int c = col - 2048; if (c < 32) { *(f32x4*)(GLR + (size_t)row * 32 + c) = a; *(f32x4*)(GLR + (size_t)row * 32 + c + 4) = b; } }
        else { const int c = col - 2304, g = c >> 4, n = c & 15, chunk = row >> 5, j = row & 31; store8bf(UG + ((size_t)(g * 1280 + chunk) * 768 + j * 16 + n), a, b); }
    }
    EPI_PAIR_TILE()
};
struct EpiE { float* E; __device__ __forceinline__ void operator()(int z, int row, int col, f32x4 v) const { *(f32x4*)(E + ((size_t)(z * 1280 + row) * 256 + col)) = v; } EPI_SIMPLE_TILE() };
struct EpiY {
    bf16_t* YB;
    __device__ __forceinline__ void operator()(int z, int row, int col, f32x4 v) const {
        const int tok = row * 32 + (col >> 4), ch = z * 16 + (col & 15);
        f32x4 o;
#pragma unroll
        for (int e = 0; e < 4; ++e) { const float x = v[e]; o[e] = x * sigmoidf_(1.5957691216f * (x + 0.044715f * x * x * x)); }
        store4bf(YB + (size_t)tok * 512 + ch, o);
    }
    EPI_SIMPLE_TILE()
};
struct EpiGLU {
    const bf16_t* YB; bf16_t* OS5; const float* bglu;
    typedef u32x2 L; struct Pre { f32x4 b[4]; };
    __device__ __forceinline__ void begin(int, int col0, Pre& pr) const {
#pragma unroll
        for (int k = 0; k < 4; ++k) pr.b[k] = *(const f32x4*)(bglu + col0 + (k >> 1) * 128 + (k & 1) * 4); }
    __device__ __forceinline__ void load(int row, int col, L& l) const { l = *(const u32x2*)(YB + (size_t)row * 512 + col); }
    __device__ __forceinline__ void apply(int row, int col, f32x4 v, const L& l, const Pre& pr, int k) const {
        const f32x4 y = (f32x4){bflo(l.x), bfhi(l.x), bflo(l.y), bfhi(l.y)}; f32x4 o;
#pragma unroll
        for (int e = 0; e < 4; ++e) o[e] = y[e] * sigmoidf_(v[e] + pr.b[k][e]);
        store4bf(OS5 + (size_t)row * 512 + col, o); }
    EPI_PIPE_TILE()
};
struct EpiPartB {
    bf16_t* R; bf16_t* GA; bf16_t* GB;
    __device__ __forceinline__ void pair(int row, int col, f32x4 a, f32x4 b) const {
        f32x4 sa, sb;
#pragma unroll
        for (int e = 0; e < 4; ++e) { sa[e] = sigmoidf_(a[e]); sb[e] = sigmoidf_(b[e]); }
        if (col < 1024) store8bf(R + (size_t)row * 1024 + col, a * sa, b * sb);
        else if (col < 2048) store8bf(GA + (size_t)row * 1024 + (col - 1024), sa, sb);
        else store8bf(GB + (size_t)row * 1024 + (col - 2048), sa, sb);
    }
    EPI_PAIR_TILE()
};
struct EpiProj1 { const bf16_t* GA; bf16_t* T1;
    typedef u32x2 L; struct Pre { int dummy; };
    __device__ __forceinline__ void begin(int, int, Pre&) const {}
    __device__ __forceinline__ void load(int row, int col, L& l) const { l = *(const u32x2*)(GA + (size_t)row * 1024 + col); }
    __device__ __forceinline__ void apply(int row, int col, f32x4 v, const L& l, const Pre&, int) const {
        const f32x4 g = (f32x4){bflo(l.x), bfhi(l.x), bflo(l.y), bfhi(l.y)}; store4bf(T1 + (size_t)row * 1024 + col, g * v); }
    EPI_PIPE_TILE()
};
struct EpiProj2 { const bf16_t* GB; bf16_t* T1;
    struct L { u32x2 t, g; }; struct Pre { int dummy; };
    __device__ __forceinline__ void begin(int, int, Pre&) const {}
    __device__ __forceinline__ void load(int row, int col, L& l) const { const size_t o = (size_t)row * 1024 + col; l.t = *(const u32x2*)(T1 + o); l.g = *(const u32x2*)(GB + o); }
    __device__ __forceinline__ void apply(int row, int col, f32x4 v, const L& l, const Pre&, int) const {
        const f32x4 g = (f32x4){bflo(l.g.x), bfhi(l.g.x), bflo(l.g.y), bfhi(l.g.y)}, t = (f32x4){bflo(l.t.x), bfhi(l.t.x), bflo(l.t.y), bfhi(l.t.y)};
        store4bf(T1 + (size_t)row * 1024 + col, t + g * v); }
    EPI_PIPE_TILE()
};
struct EpiDelta { bf16_t* Dl; const float* gate;
    static constexpr bool PERM = true;
    template <int NAI> __device__ __forceinline__ void tile(const f32x4 (&acc)[2][2][4][2], int, int row0, int col0) const {
        const float* gp = gate + (size_t)mod_index(row0) * 6144 + col0; f32x4 g[2][2];
#pragma unroll
        for (int bj = 0; bj < 2; ++bj)
#pragma unroll
            for (int n = 0; n < 2; ++n) g[bj][n] = *(const f32x4*)(gp + bj * 128 + n * 4);
#pragma unroll
        for (int ai = 0; ai < NAI; ++ai)
#pragma unroll
            for (int m = 0; m < 4; ++m)
#pragma unroll
                for (int bj = 0; bj < 2; ++bj) store8bf(Dl + (size_t)(row0 + ai * 128 + m * 16) * 1024 + col0 + bj * 128, g[bj][0] * acc[ai][bj][m][0], g[bj][1] * acc[ai][bj][m][1]);
    } };
struct EpiFF1 { bf16_t* H;
    __device__ __forceinline__ void pair(int row, int col, f32x4 a, f32x4 b) const {
        f32x4 oa, ob;
#pragma unroll
        for (int e = 0; e < 4; ++e) { const float ra = fmaxf(a[e], 0.f), rb = fmaxf(b[e], 0.f); oa[e] = ra * ra; ob[e] = rb * rb; }
        store8bf(H + (size_t)row * 4096 + col, oa, ob); }
    EPI_PAIR_TILE()
};

struct ConvJob { const float* src; int ld, K, c0, nvalid, ndst; bf16_t* dst; float scale; };
__device__ __forceinline__ bool conv_job(const P& p, int l, int j, ConvJob& J) {
    bf16_t* W = (bf16_t*)(p.ws + WS_W);
    const float* win = p.in[lnd(10)] + (size_t)l * 1024 * 5664;
    J.scale = 1.0f;
    switch (j) {
        case 0: J = {win, 5664, 1024, 0, 512, 512, W + W_A / 2, 0.08838834764831845f}; break;
        case 1: J = {win, 5664, 1024, 512, 512, 512, W + W_A / 2 + (size_t)512 * 1024, 1.f}; break;
        case 2: J = {win, 5664, 1024, 1024, 1024, 1024, W + W_A / 2 + (size_t)1024 * 1024, 1.f}; break;
        case 3: J = {win, 5664, 1024, 3072, 32, 256, W + W_A / 2 + (size_t)2048 * 1024, 1.f}; break;
        case 4: J = {win, 5664, 1024, 3104, 512, 512, W + W_A / 2 + (size_t)2304 * 1024, 1.f}; break;
        case 5: J = {win, 5664, 1024, 2048, 1024, 1024, W + W_B / 2, 1.f}; break;
        case 6: J = {win, 5664, 1024, 3616, 1024, 1024, W + W_B / 2 + (size_t)1024 * 1024, 1.f}; break;
        case 7: J = {win, 5664, 1024, 4640, 1024, 1024, W + W_B / 2 + (size_t)2048 * 1024, 1.f}; break;
        case 8: J = {p.in[lnd(14)] + (size_t)l * 1024 * 1024, 1024, 1024, 0, 1024, 1024, W + W_PG / 2, 1.f}; break;
        case 9: J = {p.in[lnd(23)] + (size_t)l * 512 * 512, 512, 512, 0, 512, 512, W + W_GLU / 2, 1.f}; break;
        case 10: J = {p.in[lnd(25)] + (size_t)l * 512 * 1024, 1024, 512, 0, 1024, 1024, W + W_PS / 2, 1.f}; break;
        case 11: J = {p.in[lnd(26)] + (size_t)l * 1024 * 1024, 1024, 1024, 0, 1024, 1024, W + W_OUT / 2, 1.f}; break;
        case 12: J = {p.in[lnd(28)] + (size_t)l * 1024 * 4096, 4096, 1024, 0, 4096, 4096, W + W_1 / 2, 1.f}; break;
        case 13: J = {p.in[lnd(29)] + (size_t)l * 4096 * 1024, 1024, 4096, 0, 1024, 1024, W + W_2 / 2, 1.f}; break;
        default: return false;
    }
    return true;
}
constexpr int CONV_TILES = 2112;
__device__ __forceinline__ void conv_tile(const P& p, int l, int tile, LAS float* sT) {
    const int tid = tid_();
    ConvJob J; int j = 0, rem = tile;
    for (; j < 14; ++j) { conv_job(p, l, j, J); const int nt = (J.ndst / 64) * (J.K / 128); if (rem < nt) break; rem -= nt; }
    const int kts = J.K / 128, ntile = rem / kts, ktile = rem % kts, n0 = ntile * 64, k0 = ktile * 128;
    {
        const int kk = tid >> 4, c4 = (tid & 15) * 4; f32x4 v[4];
#pragma unroll
        for (int i = 0; i < 4; ++i) { v[i] = (f32x4){0.f, 0.f, 0.f, 0.f};
            if (n0 + c4 < J.nvalid) v[i] = *(const f32x4*)(J.src + (size_t)(k0 + kk + 32 * i) * J.ld + J.c0 + n0 + c4); }
#pragma unroll
        for (int i = 0; i < 4; ++i)
#pragma unroll
            for (int e = 0; e < 4; ++e) sT[(c4 + e) * 129 + kk + 32 * i] = v[i][e] * J.scale;
    }
    __syncthreads();
    {
        const int n = tid >> 3, ks = (tid & 7) * 16;
        const int rho = n & 31, nsrc = (n & ~31) + 8 * ((rho & 15) >> 2) + 4 * (rho >> 4) + (rho & 3);
        const LAS float* sp = sT + nsrc * 129 + ks;
#pragma unroll
        for (int hh = 0; hh < 2; ++hh) { u32x4 w; const LAS float* q = sp + 8 * hh;
            w.x = pk_bf16(q[0], q[1]); w.y = pk_bf16(q[2], q[3]); w.z = pk_bf16(q[4], q[5]); w.w = pk_bf16(q[6], q[7]);
            *(u32x4*)(J.dst + (size_t)(n0 + n) * J.K + k0 + ks + 8 * hh) = w; }
    }
}

__device__ __forceinline__ void mod_task(const P& p, int m, LAS float* sm) {
    const int tid = tid_(), l = m / 192, colbase = (m % 192) * 32, cl = tid & 31, ks = tid >> 5;
    LAS float* SC = sm; LAS float* RED = sm + 9216;
    for (int i = tid; i < 9216; i += NTHR) { const int j = i >> 10, k = i & 1023; const float c = (j == 0) ? p.in[lnd(6)][k] : p.in[lnd(2)][(j - 1) * 1024 + k]; SC[i] = c * sigmoidf_(c); }
    __syncthreads();
    float acc[9];
#pragma unroll
    for (int j = 0; j < 9; ++j) acc[j] = 0.f;
    const float* w = p.in[lnd(7)] + (size_t)l * 1024 * 6144 + colbase + cl;
    for (int k8 = 0; k8 < 64; k8 += 16) { float wv[16];
#pragma unroll
        for (int u = 0; u < 16; ++u) wv[u] = w[(size_t)(ks * 64 + k8 + u) * 6144];
#pragma unroll
        for (int u = 0; u < 16; ++u)
#pragma unroll
            for (int j = 0; j < 9; ++j) acc[j] += SC[j * 1024 + ks * 64 + k8 + u] * wv[u]; }
#pragma unroll
    for (int j = 0; j < 9; ++j) RED[(ks * 9 + j) * 32 + cl] = acc[j];
    __syncthreads();
    if (tid < 288) { const int j = tid >> 5, c = tid & 31; float s = 0.f;
#pragma unroll
        for (int q = 0; q < 16; ++q) s += RED[(q * 9 + j) * 32 + c];
        float* mod = (float*)(p.ws + WS_MOD);
        mod[((size_t)l * 9 + j) * 6144 + colbase + c] = s + p.in[lnd(8)][(size_t)l * 6144 + colbase + c]; }
}

__device__ __forceinline__ void s5_mats(const P& p, int l, int gq, LAS float* sm) {
    const int tid = tid_(), g = gq >> 2, part = gq & 3;
    LAS float* KF = sm; LAS float* KB = sm + 8192; LAS float* LT = sm + 16384; LAS float* CC = sm + 20608; LAS float* BB = sm + 22656;
    bf16_t* MC = (bf16_t*)(p.ws + WS_R1) + (size_t)g * 512 * 768;
    bf16_t* EM = (bf16_t*)(p.ws + WS_EMAT) + (size_t)g * 256 * 512;
    for (int d = 0; d < 2; ++d) {
        const int pg = (l * 2 + d) * 32 + g;
        const float* lamr = p.in[lnd(15)] + (size_t)pg * 64; const float* lami = p.in[lnd(16)] + (size_t)pg * 64;
        const float dt = expf(p.in[lnd(17)][pg]);
        const float* bre = p.in[lnd(18)] + (size_t)pg * 1024; const float* bim = p.in[lnd(19)] + (size_t)pg * 1024;
        const float* cre = p.in[lnd(20)] + (size_t)pg * 1024; const float* cim = p.in[lnd(21)] + (size_t)pg * 1024;
        for (int i = tid; i < 33 * 64; i += NTHR) { const int tau = i >> 6, pp = i & 63; const float a = expf(lamr[pp] * dt * (float)tau); float s, c; sincosf(lami[pp] * dt * (float)tau, &s, &c); LT[2 * i] = a * c; LT[2 * i + 1] = a * s; }
        for (int i = tid; i < 1024; i += NTHR) { CC[2 * i] = cre[i]; CC[2 * i + 1] = cim[i]; }
        for (int i = tid; i < 1024; i += NTHR) {
            const int pp = i >> 4; const float lr = lamr[pp], li = lami[pp]; float s, c; sincosf(li * dt, &s, &c);
            const float em1 = expm1f(lr * dt); float sh, ch; sincosf(0.5f * li * dt, &sh, &ch);
            const float nr = em1 * c - 2.f * sh * sh, ni = (em1 + 1.f) * s;
            const float inv = 1.f / (lr * lr + li * li);
            const float qr = (nr * lr + ni * li) * inv, qi = (ni * lr - nr * li) * inv;
            const float br = bre[i], bi = bim[i];
            BB[2 * i] = qr * br - qi * bi; BB[2 * i + 1] = qr * bi + qi * br;
        }
        __syncthreads();
        {
            const int tau = tid >> 4, n = tid & 15; float acc[16];
#pragma unroll
            for (int m = 0; m < 16; ++m) acc[m] = 0.f;
            for (int pp = 0; pp < 64; ++pp) {
                const float cr = CC[2 * (n * 64 + pp)], ci = CC[2 * (n * 64 + pp) + 1], lr = LT[2 * (tau * 64 + pp)], li = LT[2 * (tau * 64 + pp) + 1];
                const float xr = cr * lr - ci * li, xi = cr * li + ci * lr;
#pragma unroll
                for (int m = 0; m < 16; ++m) acc[m] += xr * BB[2 * (pp * 16 + m)] - xi * BB[2 * (pp * 16 + m) + 1];
            }
            LAS float* Kd = d ? KB : KF;
#pragma unroll
            for (int m = 0; m < 16; ++m) Kd[(tau * 16 + n) * 16 + m] = acc[m];
        }
        {
            const int pp = tid >> 3, cseg = tid & 7;
            { const int jj = part;
                const int j = cseg * 4 + jj, e = d == 0 ? 31 - j : j; const float lr = LT[2 * (e * 64 + pp)], li = LT[2 * (e * 64 + pp) + 1];
                float re[16], im[16];
#pragma unroll
                for (int m = 0; m < 16; ++m) { const float br = BB[2 * (pp * 16 + m)], bi = BB[2 * (pp * 16 + m) + 1]; re[m] = lr * br - li * bi; im[m] = lr * bi + li * br; }
                bf16_t* er = EM + (size_t)(d * 128 + pp) * 512 + j * 16; bf16_t* ei = EM + (size_t)(d * 128 + 64 + pp) * 512 + j * 16;
#pragma unroll
                for (int h = 0; h < 2; ++h) {
                    u32x4 w; w.x = pk_bf16(re[8 * h], re[8 * h + 1]); w.y = pk_bf16(re[8 * h + 2], re[8 * h + 3]); w.z = pk_bf16(re[8 * h + 4], re[8 * h + 5]); w.w = pk_bf16(re[8 * h + 6], re[8 * h + 7]); *(u32x4*)(er + 8 * h) = w;
                    u32x4 x; x.x = pk_bf16(im[8 * h], im[8 * h + 1]); x.y = pk_bf16(im[8 * h + 2], im[8 * h + 3]); x.z = pk_bf16(im[8 * h + 4], im[8 * h + 5]); x.w = pk_bf16(im[8 * h + 6], im[8 * h + 7]); *(u32x4*)(ei + 8 * h) = x;
                }
            }
        }
        {
            const int t = tid >> 4, n = tid & 15, f = d == 0 ? t + 1 : 32 - t;
            bf16_t* mr = MC + (size_t)tid * 768 + 512 + d * 128;
#pragma unroll 1
            for (int p8 = 2 * part; p8 < 2 * part + 2; ++p8) {
                float re[8], im[8];
#pragma unroll
                for (int q = 0; q < 8; ++q) { const int pp = p8 * 8 + q; const float cr = CC[2 * (n * 64 + pp)], ci = CC[2 * (n * 64 + pp) + 1], lr = LT[2 * (f * 64 + pp)], li = LT[2 * (f * 64 + pp) + 1];
                    re[q] = cr * lr - ci * li; im[q] = -(cr * li + ci * lr); }
                u32x4 w; w.x = pk_bf16(re[0], re[1]); w.y = pk_bf16(re[2], re[3]); w.z = pk_bf16(re[4], re[5]); w.w = pk_bf16(re[6], re[7]); *(u32x4*)(mr + p8 * 8) = w;
                u32x4 x; x.x = pk_bf16(im[0], im[1]); x.y = pk_bf16(im[2], im[3]); x.z = pk_bf16(im[4], im[5]); x.w = pk_bf16(im[6], im[7]); *(u32x4*)(mr + 64 + p8 * 8) = x;
            }
        }
        __syncthreads();
    }
    {
        const int t = tid >> 4, n = tid & 15; const float dsk = p.in[lnd(22)][(size_t)l * 512 + g * 16 + n];
        bf16_t* mr = MC + (size_t)tid * 768;
#pragma unroll 1
        for (int j = 8 * part; j < 8 * part + 8; ++j) {
            float v[16];
#pragma unroll
            for (int m = 0; m < 16; ++m) v[m] = 0.f;
            if (j <= t) { const LAS float* k = KF + ((t - j) * 16 + n) * 16;
#pragma unroll
                for (int m = 0; m < 16; ++m) v[m] += k[m]; }
            if (j >= t) { const LAS float* k = KB + ((j - t) * 16 + n) * 16;
#pragma unroll
                for (int m = 0; m < 16; ++m) v[m] += k[m]; }
            if (j == t) {
#pragma unroll
                for (int m = 0; m < 16; ++m) v[m] += (m == n) ? dsk : 0.f; }
            u32x4 w; w.x = pk_bf16(v[0], v[1]); w.y = pk_bf16(v[2], v[3]); w.z = pk_bf16(v[4], v[5]); w.w = pk_bf16(v[6], v[7]); *(u32x4*)(mr + j * 16) = w;
            u32x4 x; x.x = pk_bf16(v[8], v[9]); x.y = pk_bf16(v[10], v[11]); x.z = pk_bf16(v[12], v[13]); x.w = pk_bf16(v[14], v[15]); *(u32x4*)(mr + j * 16 + 8) = x;
        }
    }
}

__device__ __forceinline__ void phase_prep(const P& p, int l, LAS unsigned char* lds) {
    LAS float* sm = (LAS float*)lds;
    const int nmod = (l == 0) ? 384 : 0, total = 128 + nmod + CONV_TILES;
    for (int task = bid_(); task < total; task += gridDim.x) {
        if (task < 128) s5_mats(p, l, task, sm);
        else if (task < 128 + nmod) mod_task(p, task - 128, sm);
        else conv_tile(p, l, task - 128 - nmod, sm);
        __syncthreads();
    }
}

__device__ __forceinline__ void norm_row_write(const f32x4 (&x)[4], const float* g, const float* mod, int shoff, int scoff, bf16_t* hrow, int lane) {
    float ss = 0.f;
#pragma unroll
    for (int i = 0; i < 4; ++i) ss += x[i][0] * x[i][0] + x[i][1] * x[i][1] + x[i][2] * x[i][2] + x[i][3] * x[i][3];
    ss = wave_sum(ss);
    const float rstd = rsqrtf(ss * (1.0f / 1024.0f) + 1e-6f);
#pragma unroll
    for (int i = 0; i < 4; ++i) { const int d = i * 256 + lane * 4; const f32x4 gg = *(const f32x4*)(g + d), sc = *(const f32x4*)(mod + scoff + d), sh = *(const f32x4*)(mod + shoff + d);
        f32x4 h;
#pragma unroll
        for (int e = 0; e < 4; ++e) h[e] = x[i][e] * rstd * gg[e] * (1.f + sc[e]) + sh[e];
        { u32x2 w; w.x = pk_bf16(h[0], h[1]); w.y = pk_bf16(h[2], h[3]); __builtin_nontemporal_store(w, (u32x2*)(hrow + d)); } }
}
__device__ __forceinline__ void phase_norm(const P& p, int l, int which) {
    const int lane = tid_() & 63, gw = bid_() * 8 + (tid_() >> 6), nw = gridDim.x * 8;
    const float* g = (which == 1 ? p.in[lnd(9)] : p.in[lnd(27)]) + (size_t)l * 1024;
    const float* modl = (const float*)(p.ws + WS_MOD) + (size_t)l * 9 * 6144;
    const int shoff = which == 1 ? 0 : 3072, scoff = which == 1 ? 1024 : 4096;
    bf16_t* H = (bf16_t*)(p.ws + WS_R2); float* X = p.out;
    if (which == 1 && l == 0) {
        for (int item = gw; item < 4096 + 8192; item += nw) {
            if (item < 4096) {
                const int n = item; const float rr = (float)(n >> 6), cc = (float)(n & 63); f32x4 pe[4];
#pragma unroll
                for (int e = 0; e < 4; ++e) { const float om = expf(-(float)(lane * 4 + e) * (9.210340371976184f / 256.0f)); float s, c; sincosf(rr * om, &s, &c); pe[0][e] = s; pe[1][e] = c; sincosf(cc * om, &s, &c); pe[2][e] = s; pe[3][e] = c; }
                for (int b0 = 0; b0 < 8; b0 += 2) { f32x4 x[2][4];
#pragma unroll
                    for (int r = 0; r < 2; ++r) { const float* src = p.in[lnd(1)] + ((size_t)(b0 + r) * 4096 + n) * 1024;
#pragma unroll
                        for (int i = 0; i < 4; ++i) x[r][i] = *(const f32x4*)(src + i * 256 + lane * 4); }
#pragma unroll
                    for (int r = 0; r < 2; ++r) { const int row = TOKP + (b0 + r) * 4096 + n;
#pragma unroll
                        for (int i = 0; i < 4; ++i) { x[r][i] = x[r][i] + pe[i]; *(f32x4*)(X + (size_t)row * 1024 + i * 256 + lane * 4) = x[r][i]; }
                        norm_row_write(x[r], g, modl + (size_t)(1 + b0 + r) * 6144, shoff, scoff, H + (size_t)row * 1024, lane); } }
            } else { const int row = item - 4096; const float* src = p.in[lnd(0)] + (size_t)row * 1024; f32x4 x[4];
#pragma unroll
                for (int i = 0; i < 4; ++i) { x[i] = *(const f32x4*)(src + i * 256 + lane * 4); *(f32x4*)(X + (size_t)row * 1024 + i * 256 + lane * 4) = x[i]; }
                norm_row_write(x, g, modl, shoff, scoff, H + (size_t)row * 1024, lane); }
        }
    } else {
        const bf16_t* DL = (const bf16_t*)(p.ws + (which == 1 ? WS_R2 : WS_R3));
        for (int row0 = gw; row0 < TOK; row0 += 4 * nw) {
            f32x4 x[4][4]; u32x2 dv[4][4];
#pragma unroll
            for (int r = 0; r < 4; ++r) { const int row = row0 + r * nw;
                if (row < TOK) {
#pragma unroll
                    for (int i = 0; i < 4; ++i) { x[r][i] = *(const f32x4*)(X + (size_t)row * 1024 + i * 256 + lane * 4); dv[r][i] = *(const u32x2*)(DL + (size_t)row * 1024 + i * 256 + lane * 4); } } }
#pragma unroll
            for (int r = 0; r < 4; ++r) { const int row = row0 + r * nw;
                if (row < TOK) {
#pragma unroll
                    for (int i = 0; i < 4; ++i) { x[r][i] = x[r][i] + (f32x4){bflo(dv[r][i].x), bfhi(dv[r][i].x), bflo(dv[r][i].y), bfhi(dv[r][i].y)}; *(f32x4*)(X + (size_t)row * 1024 + i * 256 + lane * 4) = x[r][i]; }
                    norm_row_write(x[r], g, modl + (size_t)mod_index(row) * 6144, shoff, scoff, H + (size_t)row * 1024, lane); } }
        }
    }
}
__device__ __forceinline__ void phase_final(const P& p) {
    const int lane = tid_() & 63, gw = bid_() * 8 + (tid_() >> 6), nw = gridDim.x * 8; float* X = p.out; const float* g = p.in[lnd(30)]; const bf16_t* DL = (const bf16_t*)(p.ws + WS_R2);
    for (int row0 = gw; row0 < TOK; row0 += 4 * nw) {
        f32x4 x[4][4]; u32x2 dv[4][4];
#pragma unroll
        for (int r = 0; r < 4; ++r) { const int row = row0 + r * nw;
            if (row < TOK) {
#pragma unroll
                for (int i = 0; i < 4; ++i) { x[r][i] = *(const f32x4*)(X + (size_t)row * 1024 + i * 256 + lane * 4); dv[r][i] = *(const u32x2*)(DL + (size_t)row * 1024 + i * 256 + lane * 4); } } }
#pragma unroll
        for (int r = 0; r < 4; ++r) { const int row = row0 + r * nw;
            if (row < TOK) { float ss = 0.f;
#pragma unroll
                for (int i = 0; i < 4; ++i) { x[r][i] = x[r][i] + (f32x4){bflo(dv[r][i].x), bfhi(dv[r][i].x), bflo(dv[r][i].y), bfhi(dv[r][i].y)}; ss += x[r][i][0] * x[r][i][0] + x[r][i][1] * x[r][i][1] + x[r][i][2] * x[r][i][2] + x[r][i][3] * x[r][i][3]; }
                ss = wave_sum(ss); const float rstd = rsqrtf(ss * (1.0f / 1024.0f) + 1e-6f);
#pragma unroll
                for (int i = 0; i < 4; ++i) { const f32x4 gg = *(const f32x4*)(g + i * 256 + lane * 4); *(f32x4*)(X + (size_t)row * 1024 + i * 256 + lane * 4) = x[r][i] * rstd * gg; } } }
    }
}

__device__ __forceinline__ void phase_s5scan(const P& p, int l) {
    const float* E = (const float*)(p.ws + WS_E); bf16_t* UG = (bf16_t*)(p.ws + WS_R5);
    float* ore = p.out + (size_t)TOK * 1024 + 16777216; float* oim = ore + 262144;
    for (int task = bid_(); task < 320; task += gridDim.x) {
        const int idx = task * NTHR + tid_(), pp = idx & 63, d = (idx >> 6) & 1, g = (idx >> 7) & 31, s = 39 - (idx >> 12);
        const int nch = s < 32 ? 8 : 128, cbase = s < 32 ? s * 8 : 256 + (s - 32) * 128;
        const int pg = (l * 2 + d) * 32 + g; const float dt = expf(p.in[lnd(17)][pg]);
        const float a = expf(p.in[lnd(15)][(size_t)pg * 64 + pp] * dt * 32.f); float sn, cs; sincosf(p.in[lnd(16)][(size_t)pg * 64 + pp] * dt * 32.f, &sn, &cs);
        const float ar = a * cs, ai = a * sn;
        float sr = 0.f, si = 0.f;
        if (s >= 32) { const size_t o = ((((size_t)(s - 32) * 2 + l) * 2 + d) * 32 + g) * 64 + pp; sr = p.in[lnd(4)][o]; si = p.in[lnd(5)][o]; }
        const float* Eb = E + ((size_t)(g * 1280 + cbase) * 256 + d * 128 + pp);
        bf16_t* Ub = UG + ((size_t)(g * 1280 + cbase) * 768 + 512 + d * 128 + pp);
        for (int c0 = 0; c0 < nch; c0 += 8) {
            float er[8], ei[8];
#pragma unroll
            for (int k = 0; k < 8; ++k) { const int c = d == 0 ? c0 + k : nch - 1 - (c0 + k); er[k] = Eb[(size_t)c * 256]; ei[k] = Eb[(size_t)c * 256 + 64]; }
#pragma unroll
            for (int k = 0; k < 8; ++k) { const int c = d == 0 ? c0 + k : nch - 1 - (c0 + k);
                Ub[(size_t)c * 768] = f2bf(sr); Ub[(size_t)c * 768 + 64] = f2bf(si);
                const float nr = ar * sr - ai * si + er[k], ni = ar * si + ai * sr + ei[k]; sr = nr; si = ni; }
        }
        if (s < 32) { const size_t o = ((((size_t)s * 2 + l) * 2 + d) * 32 + g) * 64 + pp; ore[o] = sr; oim[o] = si; }
    }
}

__device__ __forceinline__ void phase_glapre(const P& p, int l, LAS unsigned char* lds) {
    const int tid = tid_(), d = tid & 127, tq = tid >> 7;
    LAS float* sG = (LAS float*)lds; LAS float* sT4 = sG + 2048;
    bf16_t* Q = (bf16_t*)(p.ws + WS_R3); bf16_t* Kk = Q + (size_t)TOK * 512;
    bf16_t* QB = (bf16_t*)(p.ws + WS_R5); bf16_t* KB = QB + (size_t)TOK * 512;
    const float* GLR = (const float*)(p.ws + WS_GLR);
    for (int task = bid_(); task < 2560; task += gridDim.x) {
        const int c64 = task >> 2, h = task & 3, tb = c64 * 64;
        { const int row = tid >> 3, c4 = (tid & 7) * 4; *(LAS f32x4*)(sG + row * 32 + c4) = *(const f32x4*)(GLR + (size_t)(tb + row) * 32 + c4); }
        float qv[16], kv[16];
#pragma unroll
        for (int i = 0; i < 16; ++i) { const size_t o = (size_t)(tb + tq * 16 + i) * 512 + h * 128 + d; qv[i] = bf2f(Q[o]); kv[i] = bf2f(Kk[o]); }
        __syncthreads();
#pragma unroll 1
        for (int dir = 0; dir < 2; ++dir) {
            float w[16];
#pragma unroll
            for (int r = 0; r < 16; ++r) w[r] = p.in[lnd(11)][((size_t)(l * 2 + dir) * 16 + r) * 512 + h * 128 + d];
            const float bg = p.in[lnd(12)][(size_t)(l * 2 + dir) * 512 + h * 128 + d];
            float cum[16];
#pragma unroll
            for (int i = 0; i < 16; ++i) { const LAS float* gr = sG + (tq * 16 + i) * 32 + dir * 16; float z = bg;
#pragma unroll
                for (int r = 0; r < 16; ++r) z += gr[r] * w[r];
                cum[i] = (fminf(z, 0.f) - __logf(1.0f + __expf(-fabsf(z)))) * 0.0625f; }
            if (dir == 0) {
#pragma unroll
                for (int i = 1; i < 16; ++i) cum[i] += cum[i - 1];
            } else {
#pragma unroll
                for (int i = 14; i >= 0; --i) cum[i] += cum[i + 1];
            }
            sT4[tq * 128 + d] = dir == 0 ? cum[15] : cum[0];
            __syncthreads();
            float off = 0.f, total = 0.f;
#pragma unroll
            for (int q = 0; q < 4; ++q) { const float v = sT4[q * 128 + d]; total += v; if (dir == 0 ? (q < tq) : (q > tq)) off += v; }
            bf16_t* QD = dir == 0 ? Q : QB; bf16_t* KI = dir == 0 ? Kk : KB;
#pragma unroll
            for (int i = 0; i < 16; ++i) { const float cm = cum[i] + off; const size_t o = (size_t)(tb + tq * 16 + i) * 512 + h * 128 + d;
                QD[o] = f2bf(qv[i] * __expf(cm)); KI[o] = f2bf(kv[i] * __expf(-cm)); }
            if (tq == 0) ((float*)(p.ws + (dir == 0 ? WS_TOTF : WS_TOTB)))[(size_t)c64 * 512 + h * 128 + d] = total;
            __syncthreads();
        }
    }
}

constexpr int GLA_GRP = 71168;
typedef short s16x4 __attribute__((ext_vector_type(4)));
__device__ __forceinline__ bf16x8 tr_frag(const LAS bf16_t* base, int stride, int krow0, int col0, int fr, int fq) {
    const LAS bf16_t* q = base + (krow0 + 8 * fq + (fr >> 2)) * stride + col0 + 4 * (fr & 3);
    const s16x4 a = __builtin_amdgcn_ds_read_tr16_b64_v4i16((LAS s16x4*)q);
    const s16x4 b = __builtin_amdgcn_ds_read_tr16_b64_v4i16((LAS s16x4*)(q + 4 * stride));
    return __builtin_shufflevector(a, b, 0, 1, 2, 3, 4, 5, 6, 7);
}
#define LDS_BAR() do { asm volatile("s_waitcnt lgkmcnt(0)" ::: "memory"); __builtin_amdgcn_s_barrier(); asm volatile("" ::: "memory"); } while (0)
__device__ __forceinline__ void phase_gla(const P& p, int l, LAS unsigned char* lds) {
    const int tid = tid_(), grp = __builtin_amdgcn_readfirstlane(tid >> 8), gt = tid & 255, wv = __builtin_amdgcn_readfirstlane((tid >> 6) & 3), lane = tid & 63, fr = lane & 15, fq = lane >> 4;
    LAS unsigned char* gl = lds + grp * GLA_GRP;
    LAS bf16_t* sQ = (LAS bf16_t*)gl; LAS bf16_t* sK = (LAS bf16_t*)(gl + 17408); LAS bf16_t* sV = (LAS bf16_t*)(gl + 34816);
    LAS bf16_t* sP = (LAS bf16_t*)(gl + 44032); LAS bf16_t* sS = (LAS bf16_t*)(gl + 53248); LAS float* sTot = (LAS float*)(gl + 70656);
    const bf16_t* QD = grp == 0 ? (const bf16_t*)(p.ws + WS_R3) : (const bf16_t*)(p.ws + WS_R5);
    const bf16_t* KI = QD + (size_t)TOK * 512;
    const bf16_t* V = (const bf16_t*)(p.ws + WS_R4);
    const float* TOT = (const float*)(p.ws + (grp == 0 ? WS_TOTF : WS_TOTB));
    bf16_t* O = (bf16_t*)(p.ws + WS_R1);
    float* OST = p.out + (size_t)TOK * 1024;
    const int G = gridDim.x, b = bid_();
    const bool custom = (G == 256);
    const int ntask_mine = custom ? (b < 128 ? 1 : 4) : ((640 - b + G - 1) / G);
    for (int ti = 0; ti < ntask_mine; ++ti) {
        const int task = custom ? (b < 128 ? b : b + 128 * ti) : b + G * ti;
        if (task >= 640) break;
        const bool sample = task < 128;
        const int t2 = sample ? task : task - 128, xcd_ = t2 & 7, vs = (t2 >> 3) & 3, sh_ = xcd_ + 8 * (t2 >> 5), sb = sh_ >> 2, h = sh_ & 3;
        const int base = sample ? TOKP + sb * 4096 : sb * 256, nch = sample ? 64 : 4;
        f32x4 accS[2][4];
#pragma unroll
        for (int dt = 0; dt < 2; ++dt)
#pragma unroll
            for (int vt = 0; vt < 4; ++vt) {
                f32x4 a = (f32x4){0.f, 0.f, 0.f, 0.f};
                if (sample) { const float* cp = p.in[lnd(3)] + (((((size_t)sb * 2 + l) * 2 + grp) * 4 + h) * 128 + 16 * (2 * wv + dt) + 4 * fq) * 256 + vs * 64 + 16 * vt + fr;
#pragma unroll
                    for (int e = 0; e < 4; ++e) a[e] = cp[(size_t)e * 256]; }
                accS[dt][vt] = a;
                u32x2 w; w.x = pk_bf16(a[0], a[1]); w.y = pk_bf16(a[2], a[3]);
                *(LAS u32x2*)(sS + (16 * vt + fr) * 136 + 16 * (2 * wv + dt) + 4 * fq) = w;
            }
        u32x4 rq[2][4], rk[2][4], rv[2][2]; float rt[2] = {0.f, 0.f};
        u32x2 oprev[2][4];
#pragma unroll
        for (int u = 0; u < 2; ++u)
#pragma unroll
            for (int vt = 0; vt < 4; ++vt) oprev[u][vt] = (u32x2){0u, 0u};
#define GLA_CHUNK(st) (grp == 0 ? (st) : nch - 1 - (st))
#define GLA_LOAD(U, ci) do { const int tb_ = base + (ci) * 64; \
        _Pragma("unroll") for (int i = 0; i < 4; ++i) { const int idx = gt + 256 * i, row = idx >> 4, c16 = idx & 15; const size_t o = (size_t)(tb_ + row) * 512 + h * 128 + c16 * 8; rq[U][i] = *(const u32x4*)(QD + o); rk[U][i] = *(const u32x4*)(KI + o); } \
        _Pragma("unroll") for (int i = 0; i < 2; ++i) { const int idx = gt + 256 * i, row = idx >> 3, c8 = idx & 7; rv[U][i] = *(const u32x4*)(V + (size_t)(tb_ + row) * 1024 + h * 256 + vs * 64 + c8 * 8); } \
        if (gt < 128) rt[U] = TOT[(size_t)(tb_ >> 6) * 512 + h * 128 + gt]; } while (0)
#define GLA_STORE(U) do { \
        _Pragma("unroll") for (int i = 0; i < 4; ++i) { const int idx = gt + 256 * i, row = idx >> 4, c16 = idx & 15; *(LAS u32x4*)(sQ + row * 136 + c16 * 8) = rq[U][i]; *(LAS u32x4*)(sK + row * 136 + c16 * 8) = rk[U][i]; } \
        _Pragma("unroll") for (int i = 0; i < 2; ++i) { const int idx = gt + 256 * i, row = idx >> 3, c8 = idx & 7; *(LAS u32x4*)(sV + row * 72 + c8 * 8) = rv[U][i]; } \
        if (gt < 128) sTot[gt] = rt[U]; } while (0)
#define GLA_OLOAD(U, st) do { const int tb_ = base + GLA_CHUNK(st) * 64; \
        _Pragma("unroll") for (int vt = 0; vt < 4; ++vt) oprev[U][vt] = *(const u32x2*)(O + (size_t)(tb_ + 16 * wv + fr) * 1024 + h * 256 + vs * 64 + 16 * vt + 4 * fq); } while (0)
        GLA_LOAD(0, GLA_CHUNK(0));
        GLA_STORE(0);
        GLA_LOAD(1, GLA_CHUNK(1));
        __syncthreads();
        const int half = nch >> 1;
        for (int s0 = 0; s0 < nch; s0 += 2) {
#pragma unroll
          for (int u = 0; u < 2; ++u) {
            const int s = s0 + u;
            const int ci = GLA_CHUNK(s), tb = base + ci * 64;
            const bool second = (s >= half);
            if (s == half) GLA_OLOAD(u, s);
            if (s + 1 < nch && s + 1 > half) GLA_OLOAD(u ^ 1, s + 1);
            asm volatile("" ::: "memory");
            if (s + 2 < nch) GLA_LOAD(u, GLA_CHUNK(s + 2));
            { bf16x8 qa[4];
#pragma unroll
            for (int ks = 0; ks < 4; ++ks) qa[ks] = *(const LAS bf16x8*)(sQ + (16 * wv + fr) * 136 + 32 * ks + 8 * fq);
#pragma unroll
            for (int jt = 0; jt < 4; ++jt) {
                bf16x8 kb[4];
#pragma unroll
                for (int ks = 0; ks < 4; ++ks) kb[ks] = *(const LAS bf16x8*)(sK + (16 * jt + fr) * 136 + 32 * ks + 8 * fq);
                f32x4 acc = (f32x4){0.f, 0.f, 0.f, 0.f};
#pragma unroll
                for (int ks = 0; ks < 4; ++ks) acc = __builtin_amdgcn_mfma_f32_16x16x32_bf16(qa[ks], kb[ks], acc, 0, 0, 0);
#pragma unroll
                for (int e = 0; e < 4; ++e) { const int i = 16 * wv + 4 * fq + e, j = 16 * jt + fr; const bool keep = grp == 0 ? (j <= i) : (j >= i); sP[i * 72 + j] = f2bf(keep ? acc[e] : 0.f); }
            } }
            asm volatile("" ::: "memory");
            bf16x8 vf[4][2];
#pragma unroll
            for (int vt = 0; vt < 4; ++vt)
#pragma unroll
                for (int ks = 0; ks < 2; ++ks) vf[vt][ks] = tr_frag(sV, 72, 32 * ks, 16 * vt, fr, fq);
#pragma unroll
            for (int dt = 0; dt < 2; ++dt) {
                bf16x8 kf[2];
#pragma unroll
                for (int ks = 0; ks < 2; ++ks) kf[ks] = tr_frag(sK, 136, 32 * ks, 16 * (2 * wv + dt), fr, fq);
                const f32x4 tt = *(const LAS f32x4*)(sTot + 16 * (2 * wv + dt) + 4 * fq);
                const f32x4 sc = (f32x4){__expf(tt[0]), __expf(tt[1]), __expf(tt[2]), __expf(tt[3])};
#pragma unroll
                for (int vt = 0; vt < 4; ++vt) {
#pragma unroll
                    for (int ks = 0; ks < 2; ++ks) accS[dt][vt] = __builtin_amdgcn_mfma_f32_16x16x32_bf16(kf[ks], vf[vt][ks], accS[dt][vt], 0, 0, 0);
                    accS[dt][vt] = accS[dt][vt] * sc;
                }
            }
            asm volatile("s_waitcnt lgkmcnt(0)" ::: "memory");
            {
                bf16x8 pf[2];
#pragma unroll
                for (int ks = 0; ks < 2; ++ks) pf[ks] = *(const LAS bf16x8*)(sP + (16 * wv + fr) * 72 + 32 * ks + 8 * fq);
                bf16x8 qf[4];
#pragma unroll
                for (int ks = 0; ks < 4; ++ks) qf[ks] = *(const LAS bf16x8*)(sQ + (16 * wv + fr) * 136 + 32 * ks + 8 * fq);
#pragma unroll
                for (int vt = 0; vt < 4; ++vt) {
                    f32x4 acc = (f32x4){0.f, 0.f, 0.f, 0.f};
#pragma unroll
                    for (int ks = 0; ks < 2; ++ks) acc = __builtin_amdgcn_mfma_f32_16x16x32_bf16(vf[vt][ks], pf[ks], acc, 0, 0, 0);
#pragma unroll
                    for (int ks = 0; ks < 4; ++ks) { const bf16x8 sf = *(const LAS bf16x8*)(sS + (16 * vt + fr) * 136 + 32 * ks + 8 * fq);
                        acc = __builtin_amdgcn_mfma_f32_16x16x32_bf16(sf, qf[ks], acc, 0, 0, 0); }
                    { u32x2 pv = oprev[u][vt]; asm volatile("" : "+v"(pv));
                      if (second) acc = acc + (f32x4){bflo(pv.x), bfhi(pv.x), bflo(pv.y), bfhi(pv.y)}; }
                    store4bf(O + (size_t)(tb + 16 * wv + fr) * 1024 + h * 256 + vs * 64 + 16 * vt + 4 * fq, acc);
                }
            }
            LDS_BAR();
#pragma unroll
            for (int dt = 0; dt < 2; ++dt)
#pragma unroll
                for (int vt = 0; vt < 4; ++vt) { u32x2 w; w.x = pk_bf16(accS[dt][vt][0], accS[dt][vt][1]); w.y = pk_bf16(accS[dt][vt][2], accS[dt][vt][3]);
                    *(LAS u32x2*)(sS + (16 * vt + fr) * 136 + 16 * (2 * wv + dt) + 4 * fq) = w; }
            if (s + 1 < nch) GLA_STORE(u ^ 1);
            if (s == half - 1) { asm volatile("s_waitcnt vmcnt(0)" ::: "memory"); __syncthreads(); } else LDS_BAR();
          }
        }
        if (!sample) {
#pragma unroll
            for (int dt = 0; dt < 2; ++dt)
#pragma unroll
                for (int vt = 0; vt < 4; ++vt) { float* op = OST + (((((size_t)sb * 2 + l) * 2 + grp) * 4 + h) * 128 + 16 * (2 * wv + dt) + 4 * fq) * 256 + vs * 64 + 16 * vt + fr;
#pragma unroll
                    for (int e = 0; e < 4; ++e) op[(size_t)e * 256] = accS[dt][vt][e]; }
        }
    }
#undef GLA_LOAD
#undef GLA_STORE
#undef GLA_OLOAD
#undef GLA_CHUNK
}

__device__ __forceinline__ void phase_glapost(const P& p, int l) {
    const int lane = tid_() & 63, gw = bid_() * 8 + (tid_() >> 6), nw = gridDim.x * 8;
    bf16_t* O = (bf16_t*)(p.ws + WS_R1); const bf16_t* R = (const bf16_t*)(p.ws + WS_R3);
    const float* gn = p.in[lnd(13)] + (size_t)l * 256 + (lane & 15) * 16;
    for (int row = gw; row < TOK; row += nw) {
        const size_t o = (size_t)row * 1024 + lane * 16; float x[16], r[16];
#pragma unroll
        for (int hh = 0; hh < 2; ++hh) { const u32x4 a = *(const u32x4*)(O + o + 8 * hh), c = *(const u32x4*)(R + o + 8 * hh);
            x[8 * hh + 0] = bflo(a.x); x[8 * hh + 1] = bfhi(a.x); x[8 * hh + 2] = bflo(a.y); x[8 * hh + 3] = bfhi(a.y); x[8 * hh + 4] = bflo(a.z); x[8 * hh + 5] = bfhi(a.z); x[8 * hh + 6] = bflo(a.w); x[8 * hh + 7] = bfhi(a.w);
            r[8 * hh + 0] = bflo(c.x); r[8 * hh + 1] = bfhi(c.x); r[8 * hh + 2] = bflo(c.y); r[8 * hh + 3] = bfhi(c.y); r[8 * hh + 4] = bflo(c.z); r[8 * hh + 5] = bfhi(c.z); r[8 * hh + 6] = bflo(c.w); r[8 * hh + 7] = bfhi(c.w); }
        float ss = 0.f;
#pragma unroll
        for (int e = 0; e < 16; ++e) ss += x[e] * x[e];
        ss += __shfl_xor(ss, 1); ss += __shfl_xor(ss, 2); ss += __shfl_xor(ss, 4); ss += __shfl_xor(ss, 8);
        const float rstd = rsqrtf(ss * (1.0f / 256.0f) + 1e-6f);
        float y[16];
#pragma unroll
        for (int e = 0; e < 16; ++e) y[e] = x[e] * rstd * gn[e] * r[e];
#pragma unroll
        for (int hh = 0; hh < 2; ++hh) { u32x4 w; w.x = pk_bf16(y[8 * hh], y[8 * hh + 1]); w.y = pk_bf16(y[8 * hh + 2], y[8 * hh + 3]); w.z = pk_bf16(y[8 * hh + 4], y[8 * hh + 5]); w.w = pk_bf16(y[8 * hh + 6], y[8 * hh + 7]); *(u32x4*)(O + o + 8 * hh) = w; }
    }
}


#define XB_TMO      128
#define XB_XCNT(j)  (256  + 64 * (j))
#define XB_XSUB(j)  (1280 + 64 * (j))
#define XB_XGEN(j)  (2304 + 64 * (j))
#define XB_TOP      3328
#define XB_TOPGEN   3392
#define XCD_BAR_WORDS 3456
#define XB_SPIN_CAP (1u << 18)
__device__ __forceinline__ unsigned xb_ld(unsigned* p)              { return __hip_atomic_load(p, __ATOMIC_RELAXED, __HIP_MEMORY_SCOPE_AGENT); }
__device__ __forceinline__ unsigned xb_add(unsigned* p, unsigned v) { return __hip_atomic_fetch_add(p, v, __ATOMIC_RELAXED, __HIP_MEMORY_SCOPE_AGENT); }
__device__ __forceinline__ unsigned xb_xcc_id() { return (unsigned)__builtin_amdgcn_s_getreg((3 << 11) | 20) & 0xFu; }
#define XB_SPIN(cond, bar) do { unsigned _sp = 0; while (cond) { __builtin_amdgcn_s_sleep(1); \
    if ((++_sp & 255u) == 0u) { if (xb_ld(&(bar)[XB_TMO])) break; if (_sp > XB_SPIN_CAP) { atomicAdd(&(bar)[XB_TMO], 1u); break; } } } } while (0)
struct XcdBarrier { unsigned* bar; unsigned x; volatile LAS unsigned* st; };
__device__ __forceinline__ XcdBarrier xcd_barrier_post(unsigned* bar, volatile LAS unsigned* st) {
    XcdBarrier b; b.bar = bar; b.x = xb_xcc_id(); b.st = st;
    if (threadIdx.x == 0) (void)xb_add(&bar[XB_XCNT(b.x)], 1u);
    return b;
}
__device__ __forceinline__ void xcd_barrier_complete(unsigned* bar, unsigned x, unsigned& nloc, unsigned& nx) {
    const unsigned G = gridDim.x * gridDim.y * gridDim.z;
    unsigned sum, cnt, mine, sp = 0u;
    for (;;) {
        sum = 0u; cnt = 0u; mine = 0u;
#pragma unroll
        for (unsigned j = 0; j < 16; ++j) { const unsigned c = xb_ld(&bar[XB_XCNT(j)]); sum += c; cnt += (c > 0u) ? 1u : 0u; mine = (j == x) ? c : mine; }
        if (sum == G) break;
        __builtin_amdgcn_s_sleep(1);
        if ((++sp & 255u) == 0u) { if (xb_ld(&bar[XB_TMO])) break; if (sp > XB_SPIN_CAP) { atomicAdd(&bar[XB_TMO], 1u); break; } }
    }
    nloc = mine > 0u ? mine : 1u; nx = cnt > 0u ? cnt : 1u;
}
__device__ __forceinline__ void xcd_barrier(const XcdBarrier& b) {
    asm volatile("s_waitcnt vmcnt(0)" ::: "memory");
    __syncthreads();
    if (threadIdx.x == 0) {
        unsigned* bar = b.bar;
        __builtin_amdgcn_s_waitcnt(0);
        unsigned nloc = b.st[0], nx = b.st[1];
        if (nloc == 0u) { xcd_barrier_complete(bar, b.x, nloc, nx); b.st[0] = nloc; b.st[1] = nx; }
        const unsigned old = xb_add(&bar[XB_XSUB(b.x)], 1u);
        const unsigned gen = old / nloc;
        if (old + 1u == (gen + 1u) * nloc) {
            __builtin_amdgcn_fence(__ATOMIC_RELEASE, "agent");
            asm volatile("s_waitcnt vmcnt(0)" ::: "memory");
            const unsigned og = xb_add(&bar[XB_TOP], 1u);
            const unsigned tg = og / nx;
            if (og + 1u == (tg + 1u) * nx) xb_add(&bar[XB_TOPGEN], 1u);
            else XB_SPIN(xb_ld(&bar[XB_TOPGEN]) == tg, bar);
            __builtin_amdgcn_fence(__ATOMIC_ACQUIRE, "agent");
            xb_add(&bar[XB_XGEN(b.x)], 1u);
            asm volatile("s_waitcnt vmcnt(0)" ::: "memory");
        } else {
            XB_SPIN(xb_ld(&bar[XB_XGEN(b.x)]) == gen, bar);
            __builtin_amdgcn_fence(__ATOMIC_ACQUIRE, "agent");
            asm volatile("s_waitcnt vmcnt(0)" ::: "memory");
        }
    }
    __syncthreads();
}

__device__ __forceinline__ void run_phase(const P& p, int ph, LAS unsigned char* lds) {
    if (ph == 2 * PPL) { if (EN(34)) phase_final(p); return; }
    const int l = ph / PPL, q = ph % PPL;
    unsigned char* ws = p.ws; bf16_t* W = (bf16_t*)(ws + WS_W);
    const int G = gridDim.x, c = bid_();
    pg8::Order S;
    switch (q) {
        case 0: if (EN(0)) { phase_prep(p, l, lds); if (l == 1) phase_norm(p, l, 1); } break;
        case 1: if (EN(1)) { if (l == 0) phase_norm(p, l, 1); } break;
        case 2: if (EN(2)) { pg8::Gemm g{(const bf16_t*)(ws + WS_R2), W + W_A / 2, TOK, 2816, 1024, 1024, 0, 0, 1}; S.init(TOK, 2816, 1, G, c);
            EpiPartA E{(bf16_t*)(ws + WS_R3), (bf16_t*)(ws + WS_R3) + (size_t)TOK * 512, (bf16_t*)(ws + WS_R4), (bf16_t*)(ws + WS_R5), (float*)(ws + WS_GLR)};
            pg8::gemm_phase(lds, g, S, E); } break;
        case 3: if (EN(3)) { pg8::Gemm g{(const bf16_t*)(ws + WS_R5), (const bf16_t*)(ws + WS_EMAT), 1280, 256, 512, 768, (size_t)1280 * 768, (size_t)256 * 512, 32}; S.init(1280, 256, 32, G, c);
            EpiE E{(float*)(ws + WS_E)}; pg8::gemm_phase(lds, g, S, E); } break;
        case 4: if (EN(4)) phase_s5scan(p, l); break;
        case 5: if (EN(5)) { pg8::Gemm g{(const bf16_t*)(ws + WS_R5), (const bf16_t*)(ws + WS_R1), 1280, 512, 768, 768, (size_t)1280 * 768, (size_t)512 * 768, 32}; S.init(1280, 512, 32, G, c);
            EpiY E{(bf16_t*)(ws + WS_E)}; pg8::gemm_phase(lds, g, S, E); } break;
        case 6: if (EN(6)) { pg8::Gemm g{(const bf16_t*)(ws + WS_E), W + W_GLU / 2, TOK, 512, 512, 512, 0, 0, 1}; S.init(TOK, 512, 1, G, c);
            EpiGLU E{(const bf16_t*)(ws + WS_E), (bf16_t*)(ws + WS_R6), p.in[lnd(24)] + (size_t)l * 512}; pg8::gemm_phase(lds, g, S, E); } break;
        case 7: if (EN(7)) phase_glapre(p, l, lds); break;
        case 8: if (EN(8)) phase_gla(p, l, lds); break;
        case 9: if (EN(9)) { pg8::Gemm g{(const bf16_t*)(ws + WS_R2), W + W_B / 2, TOK, 3072, 1024, 1024, 0, 0, 1}; S.init(TOK, 3072, 1, G, c);
            EpiPartB E{(bf16_t*)(ws + WS_R3), (bf16_t*)(ws + WS_R4), (bf16_t*)(ws + WS_R5)}; pg8::gemm_phase(lds, g, S, E); } break;
        case 10: if (EN(10)) phase_glapost(p, l); break;
        case 11: if (EN(11)) { pg8::Gemm g{(const bf16_t*)(ws + WS_R1), W + W_PG / 2, TOK, 1024, 1024, 1024, 0, 0, 1}; S.init(TOK, 1024, 1, G, c);
              EpiProj1 E{(const bf16_t*)(ws + WS_R4), (bf16_t*)(ws + WS_R2)}; pg8::gemm_phase(lds, g, S, E); } break;
        case 12: if (EN(12)) { pg8::Gemm g{(const bf16_t*)(ws + WS_R6), W + W_PS / 2, TOK, 1024, 512, 512, 0, 0, 1}; S.init(TOK, 1024, 1, G, c);
              EpiProj2 E{(const bf16_t*)(ws + WS_R5), (bf16_t*)(ws + WS_R2)}; pg8::gemm_phase(lds, g, S, E); } break;
        case 13: if (EN(13)) { pg8::Gemm g{(const bf16_t*)(ws + WS_R2), W + W_OUT / 2, TOK, 1024, 1024, 1024, 0, 0, 1}; S.init(TOK, 1024, 1, G, c);
            EpiDelta E{(bf16_t*)(ws + WS_R3), (const float*)(ws + WS_MOD) + (size_t)l * 9 * 6144 + 2048}; pg8::gemm_phase(lds, g, S, E); } break;
        case 14: if (EN(14)) phase_norm(p, l, 2); break;
        case 15: if (EN(15)) { pg8::Gemm g{(const bf16_t*)(ws + WS_R2), W + W_1 / 2, TOK, 4096, 1024, 1024, 0, 0, 1}; S.init(TOK, 4096, 1, G, c);
            EpiFF1 E{(bf16_t*)(ws + WS_HID)}; pg8::gemm_phase(lds, g, S, E); } break;
        case 16: if (EN(16)) { pg8::Gemm g{(const bf16_t*)(ws + WS_HID), W + W_2 / 2, TOK, 1024, 4096, 4096, 0, 0, 1}; S.init(TOK, 1024, 1, G, c);
            EpiDelta E{(bf16_t*)(ws + WS_R2), (const float*)(ws + WS_MOD) + (size_t)l * 9 * 6144 + 5120}; pg8::gemm_phase(lds, g, S, E); } break;
        default: break;
    }
}

__global__ void __launch_bounds__(NTHR, 2) fwd_megakernel(P p) {
    extern __shared__ __attribute__((aligned(16))) unsigned char lds_raw[];
    LAS unsigned char* lds = (LAS unsigned char*)lds_raw;
#if MULTI_LAUNCH
    for (int ph = p.ph_lo; ph < p.ph_hi; ++ph) run_phase(p, ph, lds);
#else
    cg::grid_group grid = cg::this_grid();
    if (p.ph_lo < 0) grid.sync();
    volatile LAS unsigned* stw = (volatile LAS unsigned*)(lds + LDS_BYTES - 16);
    if (threadIdx.x < 4) stw[threadIdx.x] = 0u;
    __syncthreads();
    const XcdBarrier bar = xcd_barrier_post((unsigned*)(p.ws + WS_BAR), stw);
    for (int ph = p.ph_lo; ph < p.ph_hi; ++ph) {
        run_phase(p, ph, lds);
#if REP_MASK
        if (ph < 2 * PPL && ((REP_MASK >> (ph % PPL)) & 1)) {
            xcd_barrier(bar);
            if ((ph % PPL) == 12) { run_phase(p, ph - 1, lds); }
            run_phase(p, ph, lds);
        }
#endif
        if (ph + 1 < p.ph_hi && (ph % PPL) != 11 && ph != PPL) xcd_barrier(bar);
    }
#endif
}

extern "C" void kernel_launch(void* const* d_in, const int* in_sizes, int n_in, void* d_out, int out_size, void* d_ws, size_t ws_size, hipStream_t stream) {
    static int grid = 0;
    if (grid == 0) {
        if (n_in != 31 || ws_size < WS_END) { fprintf(stderr, "kernel_launch: unexpected n_in %d or ws_size %zu (< %zu)\n", n_in, ws_size, (size_t)WS_END); grid = -1; return; }
        int dev = 0, cus = 0, per_cu = 0;
        hipGetDevice(&dev);
        hipDeviceGetAttribute(&cus, hipDeviceAttributeMultiprocessorCount, dev);
        if (hipFuncSetAttribute((const void*)fwd_megakernel, hipFuncAttributeMaxDynamicSharedMemorySize, LDS_BYTES) != hipSuccess) { fprintf(stderr, "kernel_launch: hipFuncSetAttribute failed\n"); grid = -1; return; }
        hipOccupancyMaxActiveBlocksPerMultiprocessor(&per_cu, (const void*)fwd_megakernel, NTHR, LDS_BYTES);
        (void)hipGetLastError();
        if (per_cu < 1) fprintf(stderr, "kernel_launch: occupancy query says %d blocks per CU\n", per_cu);
        grid = cus > 0 ? cus : 256;
    }
    if (grid < 0) return;
    P p{};
    for (int i = 0; i < 31; ++i) p.in[i] = (const float*)d_in[i];
    p.out = (float*)d_out; p.ws = (unsigned char*)d_ws;
#if MULTI_LAUNCH
    for (int ph = 0; ph < NPHASE; ++ph) { p.ph_lo = ph; p.ph_hi = ph + 1; hipLaunchKernelGGL(fwd_megakernel, dim3(grid), dim3(NTHR), LDS_BYTES, stream, p); }
#else
    p.ph_lo = 0; p.ph_hi = NPHASE;
    (void)hipMemsetAsync((char*)d_ws + WS_BAR, 0, XCD_BAR_WORDS * sizeof(unsigned), stream);
    void* args[] = {&p};
    hipError_t e = hipLaunchCooperativeKernel((const void*)fwd_megakernel, dim3(grid), dim3(NTHR), args, LDS_BYTES, stream);
    if (e != hipSuccess) fprintf(stderr, "cooperative launch failed: %s (grid %d)\n", hipGetErrorString(e), grid);
#endif
}
```

```cpp
#include <hip/hip_runtime.h>
#include <hip/hip_cooperative_groups.h>
#include <cstdio>
namespace cg = cooperative_groups;

#ifndef MULTI_LAUNCH
#define MULTI_LAUNCH 0
#endif

#ifndef REP_MASK
#define REP_MASK 0
#endif
#ifndef PHASE_SEL
#define PHASE_SEL -1
#endif
#define EN(q) (PHASE_SEL < 0 || PHASE_SEL == (q))
#define LAS __attribute__((address_space(3)))
typedef unsigned short bf16_t;
typedef short bf16x8 __attribute__((ext_vector_type(8)));
typedef float f32x4 __attribute__((ext_vector_type(4)));
typedef unsigned u32x4 __attribute__((ext_vector_type(4)));
typedef unsigned u32x2 __attribute__((ext_vector_type(2)));

constexpr int NTHR = 512;
constexpr int TOK = 40960, TOKP = 8192;
constexpr int LDS_BYTES = 147456;
constexpr int NPHASE = 35;
constexpr int PPL = 17;

constexpr size_t MiB = (size_t)1 << 20;
constexpr size_t WS_MOD = 0;
constexpr size_t WS_GLR = 1 * MiB;
constexpr size_t WS_TOTF = 7 * MiB;
constexpr size_t WS_TOTB = 9 * MiB;
constexpr size_t WS_BAR = 12 * MiB;
constexpr size_t WS_W = 16 * MiB;
constexpr size_t W_A = 0;
constexpr size_t W_B = W_A + (size_t)2816 * 1024 * 2;
constexpr size_t W_PG = W_B + (size_t)3072 * 1024 * 2;
constexpr size_t W_GLU = W_PG + (size_t)1024 * 1024 * 2;
constexpr size_t W_PS = W_GLU + (size_t)512 * 512 * 2;
constexpr size_t W_OUT = W_PS + (size_t)1024 * 512 * 2;
constexpr size_t W_1 = W_OUT + (size_t)1024 * 1024 * 2;
constexpr size_t W_2 = W_1 + (size_t)4096 * 1024 * 2;
constexpr size_t WS_R2 = 50 * MiB;
constexpr size_t WS_R3 = 130 * MiB;
constexpr size_t WS_R4 = 210 * MiB;
constexpr size_t WS_R5 = 290 * MiB;
constexpr size_t WS_E = 350 * MiB;
constexpr size_t WS_R6 = 390 * MiB;
constexpr size_t WS_R1 = 430 * MiB;
constexpr size_t WS_EMAT = 454 * MiB;
constexpr size_t WS_HID = 130 * MiB;
constexpr size_t WS_END = 510 * MiB;

struct P { const float* in[31]; float* out; unsigned char* ws; int ph_lo, ph_hi; };

__device__ __forceinline__ int tid_() { int t = threadIdx.x; asm volatile("" : "+v"(t)); return t; }
__device__ __forceinline__ int bid_() { int b = blockIdx.x; asm volatile("" : "+s"(b)); return b; }
__device__ __forceinline__ int lnd(int k) { asm volatile("" : "+s"(k)); return k; }
__device__ __forceinline__ unsigned pk_bf16(float lo, float hi) { unsigned r; asm("v_cvt_pk_bf16_f32 %0, %1, %2" : "=v"(r) : "v"(lo), "v"(hi)); return r; }
__device__ __forceinline__ float bf2f(bf16_t b) { return __uint_as_float(((unsigned)b) << 16); }
__device__ __forceinline__ float bflo(unsigned w) { return __uint_as_float(w << 16); }
__device__ __forceinline__ float bfhi(unsigned w) { return __uint_as_float(w & 0xffff0000u); }
__device__ __forceinline__ bf16_t f2bf(float f) { return (bf16_t)(pk_bf16(f, 0.f) & 0xffffu); }
__device__ __forceinline__ float sigmoidf_(float x) { return 1.0f / (1.0f + __expf(-x)); }
__device__ __forceinline__ void store4bf(bf16_t* ptr, f32x4 v) { u32x2 w; w.x = pk_bf16(v[0], v[1]); w.y = pk_bf16(v[2], v[3]); *(u32x2*)ptr = w; }
__device__ __forceinline__ f32x4 load4bf(const bf16_t* ptr) { u32x2 w = *(const u32x2*)ptr; return (f32x4){bflo(w.x), bfhi(w.x), bflo(w.y), bfhi(w.y)}; }
__device__ __forceinline__ int mod_index(int tok) { return tok < TOKP ? 0 : (tok >> 12) - 1; }
__device__ __forceinline__ float wave_sum(float v) {
#pragma unroll
    for (int o = 32; o >= 1; o >>= 1) v += __shfl_xor(v, o);
    return v;
}

namespace pg8 {
constexpr int BM = 256, BK = 64, HALF = 128, HTB = HALF * BK * 2, STAGE_BYTES = 8 * HTB, NXCD = 8, WGM = 8;
__device__ __forceinline__ int lds_byte(int r, int c) { const int st = (r >> 4) * 2 + (c >> 5), rr = r & 15, cc = c & 31, ob = rr * 64 + cc * 2; return st * 1024 + (ob ^ (((ob >> 9) & 1) << 5)); }
__device__ __forceinline__ void stage_rc(int b, int& R, int& C) { const int st = b / 1024, sb = b % 1024, swz = sb ^ (((sb >> 9) & 1) << 5); R = (st >> 1) * 16 + swz / 64; C = (st & 1) * 32 + (swz % 64) / 2; }

struct Unit { int pm, pn, z, hf; };
struct Gemm { const bf16_t* A; const bf16_t* Bt; int M, N, K, lda; size_t sA, sB; int nz; };
struct Order {
    int nM, nN, nwg, G, c, nz, nfull, rem2;
    __device__ __forceinline__ void init(int M, int N, int nz_, int G_, int c_) { nM = M / BM; nN = N / BM; nwg = nM * nN; G = G_; c = c_; nz = nz_;
        nfull = nwg; rem2 = 0;
        if (nz == 1) { const int full = (nwg / G) * G, rem = nwg - full; if (rem > 0 && 2 * rem <= G) { nfull = full; rem2 = 2 * rem; } } }
    __device__ __forceinline__ void map(int wgid, Unit& u) const {
        { const int q = nwg / NXCD, r = nwg % NXCD, xcd = wgid % NXCD, off = wgid / NXCD; wgid = (xcd < r ? xcd * (q + 1) : r * (q + 1) + (xcd - r) * q) + off; }
        const int nig = WGM * nN, gid = wgid / nig, fm = gid * WGM, gsz = (nM - fm) < WGM ? (nM - fm) : WGM;
        u.pm = fm + ((wgid % nig) % gsz); u.pn = (wgid % nig) / gsz; u.z = 0; }
    __device__ __forceinline__ bool next(int i, Unit& u) const {
        const long L = (long)i * G + c;
        if (nz == 1) {
            if (L < nfull) { map((int)L, u); u.hf = 0; return true; }
            const int t = (int)(L - nfull); if (t >= rem2) return false;
            map(nfull + (t >> 1), u); u.hf = 1 + (t & 1); return true;
        }
        if (L >= (long)nwg * nz) return false;
        const int z = (int)(L / nwg), r = (int)(L % nwg); u.z = z; u.pm = r % nM; u.pn = r / nM; u.hf = 0;
        return true;
    }
};

template <class Epi>
__device__ __forceinline__ void gemm_phase(LAS unsigned char* lds, const Gemm g, const Order& S, const Epi& E) {
    const int tid = tid_(), wid = __builtin_amdgcn_readfirstlane(tid >> 6), lane = tid & 63, wr = wid >> 2, wc = wid & 3, fr = lane & 15, fq = lane >> 4;
    const int K = g.K, nt = K / BK;
    unsigned voffA[2], voffB[2];
#pragma unroll
    for (int i = 0; i < 2; ++i) { int R, C; stage_rc(tid * 16 + i * 8192, R, C); voffA[i] = (unsigned)(R * g.lda + C) * 2u; voffB[i] = (unsigned)(R * K + C) * 2u; }
    const size_t kstep = (size_t)(BK * 2);
    const size_t hstepA = (size_t)HALF * g.lda * 2, hstepB = (size_t)HALF * K * 2;
    const unsigned ldsw = (unsigned)wid * 1024u;
    const int aoff = lds_byte(wr * 64 + fr, fq * 8), boff = lds_byte(wc * 32 + fr, fq * 8);
#define PG8_SA(b, h) (((b) * 2 + (h)) * HTB)
#define PG8_SB(b, h) ((4 + (b) * 2 + (h)) * HTB)
#define PG8_STAGE(bufoff, gbase, voff) do { _Pragma("unroll") for (int _i = 0; _i < 2; ++_i) \
        __builtin_amdgcn_global_load_lds((const unsigned*)((const char*)(gbase) + (voff)[_i]), (LAS unsigned*)(lds + (bufoff) + ldsw + _i * 8192), 16, 0, 0); } while (0)
#define PG8_LDA(dst, b, h) do { _Pragma("unroll") for (int m = 0; m < 4; ++m) _Pragma("unroll") for (int k = 0; k < 2; ++k) dst[m][k] = *(const LAS bf16x8*)(lds + PG8_SA(b, h) + aoff + m * 2048 + k * 1024); } while (0)
#define PG8_LDB(dst, b, h) do { _Pragma("unroll") for (int n = 0; n < 2; ++n) _Pragma("unroll") for (int k = 0; k < 2; ++k) dst[n][k] = *(const LAS bf16x8*)(lds + PG8_SB(b, h) + boff + n * 2048 + k * 1024); } while (0)
#define PG8_MMA(ai, bj, At, Bt) do { __builtin_amdgcn_s_setprio(1); _Pragma("unroll") for (int m = 0; m < 4; ++m) _Pragma("unroll") for (int n = 0; n < 2; ++n) _Pragma("unroll") for (int k = 0; k < 2; ++k) \
        acc[ai][bj][m][n] = __builtin_amdgcn_mfma_f32_16x16x32_bf16(Bt[n][k], At[m][k], acc[ai][bj][m][n], 0, 0, 0); __builtin_amdgcn_s_setprio(0); } while (0)
#define PG8_WAIT_V(n) asm volatile("s_waitcnt vmcnt(" #n ")" ::: "memory")
#define PG8_WAIT_L(n) asm volatile("s_waitcnt lgkmcnt(" #n ")" ::: "memory")
#define PG8_BAR __builtin_amdgcn_s_barrier()
#define PG8_SCHED __builtin_amdgcn_sched_barrier(0)
    Unit cur, nxt; int ui = 0;
    if (!S.next(0, cur)) return;
    f32x4 acc[2][2][4][2];
#pragma unroll
    for (int a = 0; a < 2; ++a)
#pragma unroll
        for (int b = 0; b < 2; ++b)
#pragma unroll
            for (int m = 0; m < 4; ++m)
#pragma unroll
                for (int n = 0; n < 2; ++n) acc[a][b][m][n] = (f32x4){0.f, 0.f, 0.f, 0.f};
    bf16x8 At[4][2], B0[2][2], B1[2][2];
    const char* cA = (const char*)g.A + ((size_t)cur.z * g.sA + (size_t)(cur.pm * BM + (cur.hf == 2 ? HALF : 0)) * g.lda) * 2;
    const char* cB = (const char*)g.Bt + ((size_t)cur.z * g.sB + (size_t)cur.pn * BM * K) * 2;
    PG8_STAGE(PG8_SB(0, 0), cB, voffB); PG8_STAGE(PG8_SB(0, 1), cB + hstepB, voffB); PG8_STAGE(PG8_SA(0, 0), cA, voffA); PG8_STAGE(PG8_SA(0, 1), cA + hstepA, voffA);
    if (wr == 1) PG8_BAR;
    PG8_WAIT_V(2); PG8_BAR;
    PG8_STAGE(PG8_SB(1, 0), cB + kstep, voffB); PG8_STAGE(PG8_SA(1, 0), cA + kstep, voffA); PG8_STAGE(PG8_SB(1, 1), cB + hstepB + kstep, voffB);
    PG8_WAIT_V(6); PG8_BAR;
    for (;;) {
        const bool has_next = S.next(ui + 1, nxt);
        const char* nA = has_next ? (const char*)g.A + ((size_t)nxt.z * g.sA + (size_t)(nxt.pm * BM + (nxt.hf == 2 ? HALF : 0)) * g.lda) * 2 : cA;
        const bool fullu = (cur.hf == 0);
        const char* nB = has_next ? (const char*)g.Bt + ((size_t)nxt.z * g.sB + (size_t)nxt.pn * BM * K) * 2 : cB;
        for (int t = 0; t < nt; t += 2) {
            const bool last = (t == nt - 2);
            const char* a1 = cA + (size_t)(t + 1) * kstep;
            const char* a2 = last ? nA : cA + (size_t)(t + 2) * kstep; const char* b2 = last ? nB : cB + (size_t)(t + 2) * kstep;
            const char* a3 = a2 + kstep; const char* b3 = b2 + kstep;
            PG8_LDB(B0, 0, 0); PG8_LDB(B1, 0, 1); PG8_SCHED; PG8_LDA(At, 0, 0); PG8_STAGE(PG8_SA(1, 1), a1 + hstepA, voffA);
            PG8_WAIT_V(8); PG8_WAIT_L(0); PG8_BAR; PG8_MMA(0, 0, At, B0); PG8_MMA(0, 1, At, B1); PG8_BAR; PG8_SCHED;
            if (fullu) PG8_LDA(At, 0, 1); PG8_STAGE(PG8_SB(0, 0), b2, voffB); PG8_STAGE(PG8_SB(0, 1), b2 + hstepB, voffB); PG8_STAGE(PG8_SA(0, 0), a2, voffA);
            PG8_WAIT_V(8); PG8_WAIT_L(0); PG8_BAR; if (fullu) { PG8_MMA(1, 0, At, B0); PG8_MMA(1, 1, At, B1); } PG8_BAR; PG8_SCHED;
            PG8_LDB(B0, 1, 0); PG8_LDB(B1, 1, 1); PG8_SCHED; PG8_LDA(At, 1, 0); PG8_STAGE(PG8_SA(0, 1), a2 + hstepA, voffA);
            PG8_WAIT_V(8); PG8_WAIT_L(0); PG8_BAR; PG8_MMA(0, 0, At, B0); PG8_MMA(0, 1, At, B1); PG8_BAR; PG8_SCHED;
            if (fullu) PG8_LDA(At, 1, 1); PG8_STAGE(PG8_SB(1, 0), b3, voffB); PG8_STAGE(PG8_SB(1, 1), b3 + hstepB, voffB); PG8_STAGE(PG8_SA(1, 0), a3, voffA);
            PG8_WAIT_V(8); PG8_WAIT_L(0); PG8_BAR; if (fullu) { PG8_MMA(1, 0, At, B0); PG8_MMA(1, 1, At, B1); } PG8_BAR; PG8_SCHED;
        }
        if (wr == 0) PG8_BAR;
        if (fullu) E.template tile<2>(acc, cur.z, cur.pm * BM + wr * 64 + fr, cur.pn * BM + wc * 32 + (Epi::PERM ? 8 : 4) * fq);
        else E.template tile<1>(acc, cur.z, cur.pm * BM + (cur.hf == 2 ? HALF : 0) + wr * 64 + fr, cur.pn * BM + wc * 32 + (Epi::PERM ? 8 : 4) * fq);
        if (!has_next) break;
#pragma unroll
        for (int a = 0; a < 2; ++a)
#pragma unroll
            for (int b = 0; b < 2; ++b)
#pragma unroll
                for (int m = 0; m < 4; ++m)
#pragma unroll
                    for (int n = 0; n < 2; ++n) acc[a][b][m][n] = (f32x4){0.f, 0.f, 0.f, 0.f};
        cur = nxt; cA = nA; cB = nB; ++ui;
        if (wr == 1) PG8_BAR;
    }
    PG8_WAIT_V(0);
    PG8_BAR;
#undef PG8_SA
#undef PG8_SB
#undef PG8_STAGE
#undef PG8_LDA
#undef PG8_LDB
#undef PG8_MMA
#undef PG8_WAIT_V
#undef PG8_WAIT_L
#undef PG8_BAR
#undef PG8_SCHED
}
}

#define EPI_SIMPLE_TILE() \
    static constexpr bool PERM = false; \
    template <int NAI> __device__ __forceinline__ void tile(const f32x4 (&acc)[2][2][4][2], int z, int row0, int col0) const { \
        _Pragma("unroll") for (int ai = 0; ai < NAI; ++ai) _Pragma("unroll") for (int m = 0; m < 4; ++m) _Pragma("unroll") for (int bj = 0; bj < 2; ++bj) _Pragma("unroll") for (int n = 0; n < 2; ++n) \
            (*this)(z, row0 + ai * 128 + m * 16, col0 + bj * 128 + n * 16, acc[ai][bj][m][n]); }
#define EPI_PAIR_TILE() \
    static constexpr bool PERM = true; \
    template <int NAI> __device__ __forceinline__ void tile(const f32x4 (&acc)[2][2][4][2], int z, int row0, int col0) const { \
        _Pragma("unroll") for (int ai = 0; ai < NAI; ++ai) _Pragma("unroll") for (int m = 0; m < 4; ++m) _Pragma("unroll") for (int bj = 0; bj < 2; ++bj) \
            pair(row0 + ai * 128 + m * 16, col0 + bj * 128, acc[ai][bj][m][0], acc[ai][bj][m][1]); }
#define EPI_PIPE_TILE() \
    static constexpr bool PERM = true; \
    template <int NAI> __device__ __forceinline__ void tile(const f32x4 (&acc)[2][2][4][2], int z, int row0, int col0) const { \
        Pre pre; begin(row0, col0, pre); L buf[2][8]; \
        _Pragma("unroll") for (int mm = 0; mm < 2; ++mm) _Pragma("unroll") for (int bj = 0; bj < 2; ++bj) _Pragma("unroll") for (int n = 0; n < 2; ++n) load(row0 + mm * 16, col0 + bj * 128 + n * 4, buf[0][mm * 4 + bj * 2 + n]); \
        _Pragma("unroll") for (int b = 0; b < 2 * NAI; ++b) { \
            if (b < 2 * NAI - 1) { _Pragma("unroll") for (int mm = 0; mm < 2; ++mm) _Pragma("unroll") for (int bj = 0; bj < 2; ++bj) _Pragma("unroll") for (int n = 0; n < 2; ++n) \
                load(row0 + ((b + 1) >> 1) * 128 + (((b + 1) & 1) * 2 + mm) * 16, col0 + bj * 128 + n * 4, buf[(b + 1) & 1][mm * 4 + bj * 2 + n]); } \
            _Pragma("unroll") for (int mm = 0; mm < 2; ++mm) _Pragma("unroll") for (int bj = 0; bj < 2; ++bj) _Pragma("unroll") for (int n = 0; n < 2; ++n) \
                apply(row0 + (b >> 1) * 128 + ((b & 1) * 2 + mm) * 16, col0 + bj * 128 + n * 4, acc[b >> 1][bj][(b & 1) * 2 + mm][n], buf[b & 1][mm * 4 + bj * 2 + n], pre, bj * 2 + n); } }
__device__ __forceinline__ void store8bf(bf16_t* ptr, f32x4 a, f32x4 b) { u32x4 w; w.x = pk_bf16(a[0], a[1]); w.y = pk_bf16(a[2], a[3]); w.z = pk_bf16(b[0], b[1]); w.w = pk_bf16(b[2], b[3]); *(u32x4*)ptr = w; }

struct EpiPartA {
    bf16_t* Q; bf16_t* Kk; bf16_t* V; bf16_t* UG; float* GLR;
    __device__ __forceinline__ void pair(int row, int col, f32x4 a, f32x4 b) const {
        if (col < 512) store8bf(Q + (size_t)row * 512 + col, a, b);
        else if (col < 1024) store8bf(Kk + (size_t)row * 512 + (col - 512), a, b);
        else if (col < 2048) store8bf(V + (size_t)row * 1024 + (col - 1024), a, b);
        else if (col < 2304) { const int c = col - 2048; if (c < 32) { *(f32x4*)(GLR + (size_t)row * 32 + c) = a; *(f32x4*)(GLR + (size_t)row * 32 + c + 4) = b; } }
        else { const int c = col - 2304, g = c >> 4, n = c & 15, chunk = row >> 5, j = row & 31; store8bf(UG + ((size_t)(g * 1280 + chunk) * 768 + j * 16 + n), a, b); }
    }
    EPI_PAIR_TILE()
};
struct EpiE { float* E; __device__ __forceinline__ void operator()(int z, int row, int col, f32x4 v) const { *(f32x4*)(E + ((size_t)(z * 1280 + row) * 256 + col)) = v; } EPI_SIMPLE_TILE() };
struct EpiY {
    bf16_t* YB;
    __device__ __forceinline__ void operator()(int z, int row, int col, f32x4 v) const {
        const int tok = row * 32 + (col >> 4), ch = z * 16 + (col & 15);
        f32x4 o;
#pragma unroll
        for (int e = 0; e < 4; ++e) { const float x = v[e]; o[e] = x * sigmoidf_(1.5957691216f * (x + 0.044715f * x * x * x)); }
        store4bf(YB + (size_t)tok * 512 + ch, o);
    }
    EPI_SIMPLE_TILE()
};
struct EpiGLU {
    const bf16_t* YB; bf16_t* OS5; const float* bglu;
    typedef u32x2 L; struct Pre { f32x4 b[4]; };
    __device__ __forceinline__ void begin(int, int col0, Pre& pr) const {
#pragma unroll
        for (int k = 0; k < 4; ++k) pr.b[k] = *(const f32x4*)(bglu + col0 + (k >> 1) * 128 + (k & 1) * 4); }
    __device__ __forceinline__ void load(int row, int col, L& l) const { l = *(const u32x2*)(YB + (size_t)row * 512 + col); }
    __device__ __forceinline__ void apply(int row, int col, f32x4 v, const L& l, const Pre& pr, int k) const {
        const f32x4 y = (f32x4){bflo(l.x), bfhi(l.x), bflo(l.y), bfhi(l.y)}; f32x4 o;
#pragma unroll
        for (int e = 0; e < 4; ++e) o[e] = y[e] * sigmoidf_(v[e] + pr.b[k][e]);
        store4bf(OS5 + (size_t)row * 512 + col, o); }
    EPI_PIPE_TILE()
};
struct EpiPartB {
    bf16_t* R; bf16_t* GA; bf16_t* GB;
    __device__ __forceinline__ void pair(int row, int col, f32x4 a, f32x4 b) const {
        f32x4 sa, sb;
#pragma unroll
        for (int e = 0; e < 4; ++e) { sa[e] = sigmoidf_(a[e]); sb[e] = sigmoidf_(b[e]); }
        if (col < 1024) store8bf(R + (size_t)row * 1024 + col, a * sa, b * sb);
        else if (col < 2048) store8bf(GA + (size_t)row * 1024 + (col - 1024), sa, sb);
        else store8bf(GB + (size_t)row * 1024 + (col - 2048), sa, sb);
    }
    EPI_PAIR_TILE()
};
struct EpiProj1 { const bf16_t* GA; bf16_t* T1;
    typedef u32x2 L; struct Pre { int dummy; };
    __device__ __forceinline__ void begin(int, int, Pre&) const {}
    __device__ __forceinline__ void load(int row, int col, L& l) const { l = *(const u32x2*)(GA + (size_t)row * 1024 + col); }
    __device__ __forceinline__ void apply(int row, int col, f32x4 v, const L& l, const Pre&, int) const {
        const f32x4 g = (f32x4){bflo(l.x), bfhi(l.x), bflo(l.y), bfhi(l.y)}; store4bf(T1 + (size_t)row * 1024 + col, g * v); }
    EPI_PIPE_TILE()
};
struct EpiProj2 { const bf16_t* GB; bf16_t* T1;
    struct L { u32x2 t, g; }; struct Pre { int dummy; };
    __device__ __forceinline__ void begin(int, int, Pre&) const {}
    __device__ __forceinline__ void load(int row, int col, L& l) const { const size_t o = (size_t)row * 1024 + col; l.t = *(const u32x2*)(T1 + o); l.g = *(const u32x2*)(GB + o); }
    __device__ __forceinline__ void apply(int row, int col, f32x4 v, const L& l, const Pre&, int) const {
        const f32x4 g = (f32x4){bflo(l.g.x), bfhi(l.g.x), bflo(l.g.y), bfhi(l.g.y)}, t = (f32x4){bflo(l.t.x), bfhi(l.t.x), bflo(l.t.y), bfhi(l.t.y)};
        store4bf(T1 + (size_t)row * 1024 + col, t + g * v); }
    EPI_PIPE_TILE()
};
struct EpiDelta { bf16_t* Dl; const float* gate;
    static constexpr bool PERM = true;
    template <int NAI> __device__ __forceinline__ void tile(const f32x4 (&acc)[2][2][4][2], int, int row0, int col0) const {
        const float* gp = gate + (size_t)mod_index(row0) * 6144 + col0; f32x4 g[2][2];
#pragma unroll
        for (int bj = 0; bj < 2; ++bj)
#pragma unroll
            for (int n = 0; n < 2; ++n) g[bj][n] = *(const f32x4*)(gp + bj * 128 + n * 4);
#pragma unroll
        for (int ai = 0; ai < NAI; ++ai)
#pragma unroll
            for (int m = 0; m < 4; ++m)
#pragma unroll
                for (int bj = 0; bj < 2; ++bj) store8bf(Dl + (size_t)(row0 + ai * 128 + m * 16) * 1024 + col0 + bj * 128, g[bj][0] * acc[ai][bj][m][0], g[bj][1] * acc[ai][bj][m][1]);
    } };
struct EpiFF1 { bf16_t* H;
    __device__ __forceinline__ void pair(int row, int col, f32x4 a, f32x4 b) const {
        f32x4 oa, ob;
#pragma unroll
        for (int e = 0; e < 4; ++e) { const float ra = fmaxf(a[e], 0.f), rb = fmaxf(b[e], 0.f); oa[e] = ra * ra; ob[e] = rb * rb; }
        store8bf(H + (size_t)row * 4096 + col, oa, ob); }
    EPI_PAIR_TILE()
};

struct ConvJob { const float* src; int ld, K, c0, nvalid, ndst; bf16_t* dst; float scale; };
__device__ __forceinline__ bool conv_job(const P& p, int l, int j, ConvJob& J) {
    bf16_t* W = (bf16_t*)(p.ws + WS_W);
    const float* win = p.in[lnd(10)] + (size_t)l * 1024 * 5664;
    J.scale = 1.0f;
    switch (j) {
        case 0: J = {win, 5664, 1024, 0, 512, 512, W + W_A / 2, 0.08838834764831845f}; break;
        case 1: J = {win, 5664, 1024, 512, 512, 512, W + W_A / 2 + (size_t)512 * 1024, 1.f}; break;
        case 2: J = {win, 5664, 1024, 1024, 1024, 1024, W + W_A / 2 + (size_t)1024 * 1024, 1.f}; break;
        case 3: J = {win, 5664, 1024, 3072, 32, 256, W + W_A / 2 + (size_t)2048 * 1024, 1.f}; break;
        case 4: J = {win, 5664, 1024, 3104, 512, 512, W + W_A / 2 + (size_t)2304 * 1024, 1.f}; break;
        case 5: J = {win, 5664, 1024, 2048, 1024, 1024, W + W_B / 2, 1.f}; break;
        case 6: J = {win, 5664, 1024, 3616, 1024, 1024, W + W_B / 2 + (size_t)1024 * 1024, 1.f}; break;
        case 7: J = {win, 5664, 1024, 4640, 1024, 1024, W + W_B / 2 + (size_t)2048 * 1024, 1.f}; break;
        case 8: J = {p.in[lnd(14)] + (size_t)l * 1024 * 1024, 1024, 1024, 0, 1024, 1024, W + W_PG / 2, 1.f}; break;
        case 9: J = {p.in[lnd(23)] + (size_t)l * 512 * 512, 512, 512, 0, 512, 512, W + W_GLU / 2, 1.f}; break;
        case 10: J = {p.in[lnd(25)] + (size_t)l * 512 * 1024, 1024, 512, 0, 1024, 1024, W + W_PS / 2, 1.f}; break;
        case 11: J = {p.in[lnd(26)] + (size_t)l * 1024 * 1024, 1024, 1024, 0, 1024, 1024, W + W_OUT / 2, 1.f}; break;
        case 12: J = {p.in[lnd(28)] + (size_t)l * 1024 * 4096, 4096, 1024, 0, 4096, 4096, W + W_1 / 2, 1.f}; break;
        case 13: J = {p.in[lnd(29)] + (size_t)l * 4096 * 1024, 1024, 4096, 0, 1024, 1024, W + W_2 / 2, 1.f}; break;
        default: return false;
    }
    return true;
}
constexpr int CONV_TILES = 2112;
__device__ __forceinline__ void conv_tile(const P& p, int l, int tile, LAS float* sT) {
    const int tid = tid_();
    ConvJob J; int j = 0, rem = tile;
    for (; j < 14; ++j) { conv_job(p, l, j, J); const int nt = (J.ndst / 64) * (J.K / 128); if (rem < nt) break; rem -= nt; }
    const int kts = J.K / 128, ntile = rem / kts, ktile = rem % kts, n0 = ntile * 64, k0 = ktile * 128;
    {
        const int kk = tid >> 4, c4 = (tid & 15) * 4; f32x4 v[4];
#pragma unroll
        for (int i = 0; i < 4; ++i) { v[i] = (f32x4){0.f, 0.f, 0.f, 0.f};
            if (n0 + c4 < J.nvalid) v[i] = *(const f32x4*)(J.src + (size_t)(k0 + kk + 32 * i) * J.ld + J.c0 + n0 + c4); }
#pragma unroll
        for (int i = 0; i < 4; ++i)
#pragma unroll
            for (int e = 0; e < 4; ++e) sT[(c4 + e) * 129 + kk + 32 * i] = v[i][e] * J.scale;
    }
    __syncthreads();
    {
        const int n = tid >> 3, ks = (tid & 7) * 16;
        const int rho = n & 31, nsrc = (n & ~31) + 8 * ((rho & 15) >> 2) + 4 * (rho >> 4) + (rho & 3);
        const LAS float* sp = sT + nsrc * 129 + ks;
#pragma unroll
        for (int hh = 0; hh < 2; ++hh) { u32x4 w; const LAS float* q = sp + 8 * hh;
            w.x = pk_bf16(q[0], q[1]); w.y = pk_bf16(q[2], q[3]); w.z = pk_bf16(q[4], q[5]); w.w = pk_bf16(q[6], q[7]);
            *(u32x4*)(J.dst + (size_t)(n0 + n) * J.K + k0 + ks + 8 * hh) = w; }
    }
}

__device__ __forceinline__ void mod_task(const P& p, int m, LAS float* sm) {
    const int tid = tid_(), l = m / 192, colbase = (m % 192) * 32, cl = tid & 31, ks = tid >> 5;
    LAS float* SC = sm; LAS float* RED = sm + 9216;
    for (int i = tid; i < 9216; i += NTHR) { const int j = i >> 10, k = i & 1023; const float c = (j == 0) ? p.in[lnd(6)][k] : p.in[lnd(2)][(j - 1) * 1024 + k]; SC[i] = c * sigmoidf_(c); }
    __syncthreads();
    float acc[9];
#pragma unroll
    for (int j = 0; j < 9; ++j) acc[j] = 0.f;
    const float* w = p.in[lnd(7)] + (size_t)l * 1024 * 6144 + colbase + cl;
    for (int k8 = 0; k8 < 64; k8 += 16) { float wv[16];
#pragma unroll
        for (int u = 0; u < 16; ++u) wv[u] = w[(size_t)(ks * 64 + k8 + u) * 6144];
#pragma unroll
        for (int u = 0; u < 16; ++u)
#pragma unroll
            for (int j = 0; j < 9; ++j) acc[j] += SC[j * 1024 + ks * 64 + k8 + u] * wv[u]; }
#pragma unroll
    for (int j = 0; j < 9; ++j) RED[(ks * 9 + j) * 32 + cl] = acc[j];
    __syncthreads();
    if (tid < 288) { const int j = tid >> 5, c = tid & 31; float s = 0.f;
#pragma unroll
        for (int q = 0; q < 16; ++q) s += RED[(q * 9 + j) * 32 + c];
        float* mod = (float*)(p.ws + WS_MOD);
        mod[((size_t)l * 9 + j) * 6144 + colbase + c] = s + p.in[lnd(8)][(size_t)l * 6144 + colbase + c]; }
}

__device__ __forceinline__ void s5_mats(const P& p, int l, int gq, LAS float* sm) {
    const int tid = tid_(), g = gq >> 2, part = gq & 3;
    LAS float* KF = sm; LAS float* KB = sm + 8192; LAS float* LT = sm + 16384; LAS float* CC = sm + 20608; LAS float* BB = sm + 22656;
    bf16_t* MC = (bf16_t*)(p.ws + WS_R1) + (size_t)g * 512 * 768;
    bf16_t* EM = (bf16_t*)(p.ws + WS_EMAT) + (size_t)g * 256 * 512;
    for (int d = 0; d < 2; ++d) {
        const int pg = (l * 2 + d) * 32 + g;
        const float* lamr = p.in[lnd(15)] + (size_t)pg * 64; const float* lami = p.in[lnd(16)] + (size_t)pg * 64;
        const float dt = expf(p.in[lnd(17)][pg]);
        const float* bre = p.in[lnd(18)] + (size_t)pg * 1024; const float* bim = p.in[lnd(19)] + (size_t)pg * 1024;
        const float* cre = p.in[lnd(20)] + (size_t)pg * 1024; const float* cim = p.in[lnd(21)] + (size_t)pg * 1024;
        for (int i = tid; i < 33 * 64; i += NTHR) { const int tau = i >> 6, pp = i & 63; const float a = expf(lamr[pp] * dt * (float)tau); float s, c; sincosf(lami[pp] * dt * (float)tau, &s, &c); LT[2 * i] = a * c; LT[2 * i + 1] = a * s; }
        for (int i = tid; i < 1024; i += NTHR) { CC[2 * i] = cre[i]; CC[2 * i + 1] = cim[i]; }
        for (int i = tid; i < 1024; i += NTHR) {
            const int pp = i >> 4; const float lr = lamr[pp], li = lami[pp]; float s, c; sincosf(li * dt, &s, &c);
            const float em1 = expm1f(lr * dt); float sh, ch; sincosf(0.5f * li * dt, &sh, &ch);
            const float nr = em1 * c - 2.f * sh * sh, ni = (em1 + 1.f) * s;
            const float inv = 1.f / (lr * lr + li * li);
            const float qr = (nr * lr + ni * li) * inv, qi = (ni * lr - nr * li) * inv;
            const float br = bre[i], bi = bim[i];
            BB[2 * i] = qr * br - qi * bi; BB[2 * i + 1] = qr * bi + qi * br;
        }
        __syncthreads();
        {
            const int tau = tid >> 4, n = tid & 15; float acc[16];
#pragma unroll
            for (int m = 0; m < 16; ++m) acc[m] = 0.f;
            for (int pp = 0; pp < 64; ++pp) {
                const float cr = CC[2 * (n * 64 + pp)], ci = CC[2 * (n * 64 + pp) + 1], lr = LT[2 * (tau * 64 + pp)], li = LT[2 * (tau * 64 + pp) + 1];
                const float xr = cr * lr - ci * li, xi = cr * li + ci * lr;
#pragma unroll
                for (int m = 0; m < 16; ++m) acc[m] += xr * BB[2 * (pp * 16 + m)] - xi * BB[2 * (pp * 16 + m) + 1];
            }
            LAS float* Kd = d ? KB : KF;
#pragma unroll
            for (int m = 0; m < 16; ++m) Kd[(tau * 16 + n) * 16 + m] = acc[m];
        }
        {
            const int pp = tid >> 3, cseg = tid & 7;
            { const int jj = part;
                const int j = cseg * 4 + jj, e = d == 0 ? 31 - j : j; const float lr = LT[2 * (e * 64 + pp)], li = LT[2 * (e * 64 + pp) + 1];
                float re[16], im[16];
#pragma unroll
                for (int m = 0; m < 16; ++m) { const float br = BB[2 * (pp * 16 + m)], bi = BB[2 * (pp * 16 + m) + 1]; re[m] = lr * br - li * bi; im[m] = lr * bi + li * br; }
                bf16_t* er = EM + (size_t)(d * 128 + pp) * 512 + j * 16; bf16_t* ei = EM + (size_t)(d * 128 + 64 + pp) * 512 + j * 16;
#pragma unroll
                for (int h = 0; h < 2; ++h) {
                    u32x4 w; w.x = pk_bf16(re[8 * h], re[8 * h + 1]); w.y = pk_bf16(re[8 * h + 2], re[8 * h + 3]); w.z = pk_bf16(re[8 * h + 4], re[8 * h + 5]); w.w = pk_bf16(re[8 * h + 6], re[8 * h + 7]); *(u32x4*)(er + 8 * h) = w;
                    u32x4 x; x.x = pk_bf16(im[8 * h], im[8 * h + 1]); x.y = pk_bf16(im[8 * h + 2], im[8 * h + 3]); x.z = pk_bf16(im[8 * h + 4], im[8 * h + 5]); x.w = pk_bf16(im[8 * h + 6], im[8 * h + 7]); *(u32x4*)(ei + 8 * h) = x;
                }
            }
        }
        {
            const int t = tid >> 4, n = tid & 15, f = d == 0 ? t + 1 : 32 - t;
            bf16_t* mr = MC + (size_t)tid * 768 + 512 + d * 128;
#pragma unroll 1
            for (int p8 = 2 * part; p8 < 2 * part + 2; ++p8) {
                float re[8], im[8];
#pragma unroll
                for (int q = 0; q < 8; ++q) { const int pp = p8 * 8 + q; const float cr = CC[2 * (n * 64 + pp)], ci = CC[2 * (n * 64 + pp) + 1], lr = LT[2 * (f * 64 + pp)], li = LT[2 * (f * 64 + pp) + 1];
                    re[q] = cr * lr - ci * li; im[q] = -(cr * li + ci * lr); }
                u32x4 w; w.x = pk_bf16(re[0], re[1]); w.y = pk_bf16(re[2], re[3]); w.z = pk_bf16(re[4], re[5]); w.w = pk_bf16(re[6], re[7]); *(u32x4*)(mr + p8 * 8) = w;
                u32x4 x; x.x = pk_bf16(im[0], im[1]); x.y = pk_bf16(im[2], im[3]); x.z = pk_bf16(im[4], im[5]); x.w = pk_bf16(im[6], im[7]); *(u32x4*)(mr + 64 + p8 * 8) = x;
            }
        }
        __syncthreads();
    }
    {
        const int t = tid >> 4, n = tid & 15; const float dsk = p.in[lnd(22)][(size_t)l * 512 + g * 16 + n];
        bf16_t* mr = MC + (size_t)tid * 768;
#pragma unroll 1
        for (int j = 8 * part; j < 8 * part + 8; ++j) {
            float v[16];
#pragma unroll
            for (int m = 0; m < 16; ++m) v[m] = 0.f;
            if (j <= t) { const LAS float* k = KF + ((t - j) * 16 + n) * 16;
#pragma unroll
                for (int m = 0; m < 16; ++m) v[m] += k[m]; }
            if (j >= t) { const LAS float* k = KB + ((j - t) * 16 + n) * 16;
#pragma unroll
                for (int m = 0; m < 16; ++m) v[m] += k[m]; }
            if (j == t) {
#pragma unroll
                for (int m = 0; m < 16; ++m) v[m] += (m == n) ? dsk : 0.f; }
            u32x4 w; w.x = pk_bf16(v[0], v[1]); w.y = pk_bf16(v[2], v[3]); w.z = pk_bf16(v[4], v[5]); w.w = pk_bf16(v[6], v[7]); *(u32x4*)(mr + j * 16) = w;
            u32x4 x; x.x = pk_bf16(v[8], v[9]); x.y = pk_bf16(v[10], v[11]); x.z = pk_bf16(v[12], v[13]); x.w = pk_bf16(v[14], v[15]); *(u32x4*)(mr + j * 16 + 8) = x;
        }
    }
}

__device__ __forceinline__ void phase_prep(const P& p, int l, LAS unsigned char* lds) {
    LAS float* sm = (LAS float*)lds;
    const int nmod = (l == 0) ? 384 : 0, total = 128 + nmod + CONV_TILES;
    for (int task = bid_(); task < total; task += gridDim.x) {
        if (task < 128) s5_mats(p, l, task, sm);
        else if (task < 128 + nmod) mod_task(p, task - 128, sm);
        else conv_tile(p, l, task - 128 - nmod, sm);
        __syncthreads();
    }
}

__device__ __forceinline__ void norm_row_write(const f32x4 (&x)[4], const float* g, const float* mod, int shoff, int scoff, bf16_t* hrow, int lane) {
    float ss = 0.f;
#pragma unroll
    for (int i = 0; i < 4; ++i) ss += x[i][0] * x[i][0] + x[i][1] * x[i][1] + x[i][2] * x[i][2] + x[i][3] * x[i][3];
    ss = wave_sum(ss);
    const float rstd = rsqrtf(ss * (1.0f / 1024.0f) + 1e-6f);
#pragma unroll
    for (int i = 0; i < 4; ++i) { const int d = i * 256 + lane * 4; const f32x4 gg = *(const f32x4*)(g + d), sc = *(const f32x4*)(mod + scoff + d), sh = *(const f32x4*)(mod + shoff + d);
        f32x4 h;
#pragma unroll
        for (int e = 0; e < 4; ++e) h[e] = x[i][e] * rstd * gg[e] * (1.f + sc[e]) + sh[e];
        { u32x2 w; w.x = pk_bf16(h[0], h[1]); w.y = pk_bf16(h[2], h[3]); __builtin_nontemporal_store(w, (u32x2*)(hrow + d)); } }
}
__device__ __forceinline__ void phase_norm(const P& p, int l, int which) {
    const int lane = tid_() & 63, gw = bid_() * 8 + (tid_() >> 6), nw = gridDim.x * 8;
    const float* g = (which == 1 ? p.in[lnd(9)] : p.in[lnd(27)]) + (size_t)l * 1024;
    const float* modl = (const float*)(p.ws + WS_MOD) + (size_t)l * 9 * 6144;
    const int shoff = which == 1 ? 0 : 3072, scoff = which == 1 ? 1024 : 4096;
    bf16_t* H = (bf16_t*)(p.ws + WS_R2); float* X = p.out;
    if (which == 1 && l == 0) {
        for (int item = gw; item < 4096 + 8192; item += nw) {
            if (item < 4096) {
                const int n = item; const float rr = (float)(n >> 6), cc = (float)(n & 63); f32x4 pe[4];
#pragma unroll
                for (int e = 0; e < 4; ++e) { const float om = expf(-(float)(lane * 4 + e) * (9.210340371976184f / 256.0f)); float s, c; sincosf(rr * om, &s, &c); pe[0][e] = s; pe[1][e] = c; sincosf(cc * om, &s, &c); pe[2][e] = s; pe[3][e] = c; }
                for (int b0 = 0; b0 < 8; b0 += 2) { f32x4 x[2][4];
#pragma unroll
                    for (int r = 0; r < 2; ++r) { const float* src = p.in[lnd(1)] + ((size_t)(b0 + r) * 4096 + n) * 1024;
#pragma unroll
                        for (int i = 0; i < 4; ++i) x[r][i] = *(const f32x4*)(src + i * 256 + lane * 4); }
#pragma unroll
                    for (int r = 0; r < 2; ++r) { const int row = TOKP + (b0 + r) * 4096 + n;
#pragma unroll
                        for (int i = 0; i < 4; ++i) { x[r][i] = x[r][i] + pe[i]; *(f32x4*)(X + (size_t)row * 1024 + i * 256 + lane * 4) = x[r][i]; }
                        norm_row_write(x[r], g, modl + (size_t)(1 + b0 + r) * 6144, shoff, scoff, H + (size_t)row * 1024, lane); } }
            } else { const int row = item - 4096; const float* src = p.in[lnd(0)] + (size_t)row * 1024; f32x4 x[4];
#pragma unroll
                for (int i = 0; i < 4; ++i) { x[i] = *(const f32x4*)(src + i * 256 + lane * 4); *(f32x4*)(X + (size_t)row * 1024 + i * 256 + lane * 4) = x[i]; }
                norm_row_write(x, g, modl, shoff, scoff, H + (size_t)row * 1024, lane); }
        }
    } else {
        const bf16_t* DL = (const bf16_t*)(p.ws + (which == 1 ? WS_R2 : WS_R3));
        for (int row0 = gw; row0 < TOK; row0 += 4 * nw) {
            f32x4 x[4][4]; u32x2 dv[4][4];
#pragma unroll
            for (int r = 0; r < 4; ++r) { const int row = row0 + r * nw;
                if (row < TOK) {
#pragma unroll
                    for (int i = 0; i < 4; ++i) { x[r][i] = *(const f32x4*)(X + (size_t)row * 1024 + i * 256 + lane * 4); dv[r][i] = *(const u32x2*)(DL + (size_t)row * 1024 + i * 256 + lane * 4); } } }
#pragma unroll
            for (int r = 0; r < 4; ++r) { const int row = row0 + r * nw;
                if (row < TOK) {
#pragma unroll
                    for (int i = 0; i < 4; ++i) { x[r][i] = x[r][i] + (f32x4){bflo(dv[r][i].x), bfhi(dv[r][i].x), bflo(dv[r][i].y), bfhi(dv[r][i].y)}; *(f32x4*)(X + (size_t)row * 1024 + i * 256 + lane * 4) = x[r][i]; }
                    norm_row_write(x[r], g, modl + (size_t)mod_index(row) * 6144, shoff, scoff, H + (size_t)row * 1024, lane); } }
        }
    }
}
__device__ __forceinline__ void phase_final(const P& p) {
    const int lane = tid_() & 63, gw = bid_() * 8 + (tid_() >> 6), nw = gridDim.x * 8; float* X = p.out; const float* g = p.in[lnd(30)]; const bf16_t* DL = (const bf16_t*)(p.ws + WS_R2);
    for (int row0 = gw; row0 < TOK; row0 += 4 * nw) {
        f32x4 x[4][4]; u32x2 dv[4][4];
#pragma unroll
        for (int r = 0; r < 4; ++r) { const int row = row0 + r * nw;
            if (row < TOK) {
#pragma unroll
                for (int i = 0; i < 4; ++i) { x[r][i] = *(const f32x4*)(X + (size_t)row * 1024 + i * 256 + lane * 4); dv[r][i] = *(const u32x2*)(DL + (size_t)row * 1024 + i * 256 + lane * 4); } } }
#pragma unroll
        for (int r = 0; r < 4; ++r) { const int row = row0 + r * nw;
            if (row < TOK) { float ss = 0.f;
#pragma unroll
                for (int i = 0; i < 4; ++i) { x[r][i] = x[r][i] + (f32x4){bflo(dv[r][i].x), bfhi(dv[r][i].x), bflo(dv[r][i].y), bfhi(dv[r][i].y)}; ss += x[r][i][0] * x[r][i][0] + x[r][i][1] * x[r][i][1] + x[r][i][2] * x[r][i][2] + x[r][i][3] * x[r][i][3]; }
                ss = wave_sum(ss); const float rstd = rsqrtf(ss * (1.0f / 1024.0f) + 1e-6f);
#pragma unroll
                for (int i = 0; i < 4; ++i) { const f32x4 gg = *(const f32x4*)(g + i * 256 + lane * 4); *(f32x4*)(X + (size_t)row * 1024 + i * 256 + lane * 4) = x[r][i] * rstd * gg; } } }
    }
}

__device__ __forceinline__ void phase_s5scan(const P& p, int l) {
    const float* E = (const float*)(p.ws + WS_E); bf16_t* UG = (bf16_t*)(p.ws + WS_R5);
    float* ore = p.out + (size_t)TOK * 1024 + 16777216; float* oim = ore + 262144;
    for (int task = bid_(); task < 320; task += gridDim.x) {
        const int idx = task * NTHR + tid_(), pp = idx & 63, d = (idx >> 6) & 1, g = (idx >> 7) & 31, s = 39 - (idx >> 12);
        const int nch = s < 32 ? 8 : 128, cbase = s < 32 ? s * 8 : 256 + (s - 32) * 128;
        const int pg = (l * 2 + d) * 32 + g; const float dt = expf(p.in[lnd(17)][pg]);
        const float a = expf(p.in[lnd(15)][(size_t)pg * 64 + pp] * dt * 32.f); float sn, cs; sincosf(p.in[lnd(16)][(size_t)pg * 64 + pp] * dt * 32.f, &sn, &cs);
        const float ar = a * cs, ai = a * sn;
        float sr = 0.f, si = 0.f;
        if (s >= 32) { const size_t o = ((((size_t)(s - 32) * 2 + l) * 2 + d) * 32 + g) * 64 + pp; sr = p.in[lnd(4)][o]; si = p.in[lnd(5)][o]; }
        const float* Eb = E + ((size_t)(g * 1280 + cbase) * 256 + d * 128 + pp);
        bf16_t* Ub = UG + ((size_t)(g * 1280 + cbase) * 768 + 512 + d * 128 + pp);
        for (int c0 = 0; c0 < nch; c0 += 8) {
            float er[8], ei[8];
#pragma unroll
            for (int k = 0; k < 8; ++k) { const int c = d == 0 ? c0 + k : nch - 1 - (c0 + k); er[k] = Eb[(size_t)c * 256]; ei[k] = Eb[(size_t)c * 256 + 64]; }
#pragma unroll
            for (int k = 0; k < 8; ++k) { const int c = d == 0 ? c0 + k : nch - 1 - (c0 + k);
                Ub[(size_t)c * 768] = f2bf(sr); Ub[(size_t)c * 768 + 64] = f2bf(si);
                const float nr = ar * sr - ai * si + er[k], ni = ar * si + ai * sr + ei[k]; sr = nr; si = ni; }
        }
        if (s < 32) { const size_t o = ((((size_t)s * 2 + l) * 2 + d) * 32 + g) * 64 + pp; ore[o] = sr; oim[o] = si; }
    }
}

__device__ __forceinline__ void phase_glapre(const P& p, int l, LAS unsigned char* lds) {
    const int tid = tid_(), d = tid & 127, tq = tid >> 7, wv = tid >> 6, lane = tid & 63, fr = lane & 15, fq = lane >> 4;
    LAS float* sG = (LAS float*)lds; LAS float* sT4 = sG + 2048; LAS float* sZ = sG + 2560;
    bf16_t* Q = (bf16_t*)(p.ws + WS_R3); bf16_t* Kk = Q + (size_t)TOK * 512;
    bf16_t* QB = (bf16_t*)(p.ws + WS_R5); bf16_t* KB = QB + (size_t)TOK * 512;
    const float* GLR = (const float*)(p.ws + WS_GLR);
    for (int task = bid_(); task < 2560; task += gridDim.x) {
        const int c64 = task >> 2, h = task & 3, tb = c64 * 64;
        { const int row = tid >> 3, c4 = (tid & 7) * 4; *(LAS f32x4*)(sG + row * 32 + c4) = *(const f32x4*)(GLR + (size_t)(tb + row) * 32 + c4); }
        float qv[16], kv[16];
#pragma unroll
        for (int i = 0; i < 16; ++i) { const size_t o = (size_t)(tb + tq * 16 + i) * 512 + h * 128 + d; qv[i] = bf2f(Q[o]); kv[i] = bf2f(Kk[o]); }
        bf16x8 bw[2];
#pragma unroll
        for (int dir = 0; dir < 2; ++dir) { float w8[8];
#pragma unroll
            for (int e = 0; e < 8; ++e) { const int kk = 8 * fq + e - 16 * dir; w8[e] = (kk >= 0 && kk < 16) ? p.in[lnd(11)][((size_t)(l * 2 + dir) * 16 + kk) * 512 + h * 128 + 16 * wv + fr] : 0.f; }
            u32x4 pk; pk.x = pk_bf16(w8[0], w8[1]); pk.y = pk_bf16(w8[2], w8[3]); pk.z = pk_bf16(w8[4], w8[5]); pk.w = pk_bf16(w8[6], w8[7]);
            bw[dir] = __builtin_bit_cast(bf16x8, pk); }
        __syncthreads();
#pragma unroll
        for (int ti = 0; ti < 4; ++ti) {
            const LAS float* gr = sG + (16 * ti + fr) * 32 + 8 * fq; const f32x4 g0 = *(const LAS f32x4*)gr, g1 = *(const LAS f32x4*)(gr + 4);
            u32x4 pk; pk.x = pk_bf16(g0[0], g0[1]); pk.y = pk_bf16(g0[2], g0[3]); pk.z = pk_bf16(g1[0], g1[1]); pk.w = pk_bf16(g1[2], g1[3]);
            const bf16x8 af = __builtin_bit_cast(bf16x8, pk);
#pragma unroll
            for (int dir = 0; dir < 2; ++dir) { const f32x4 z = __builtin_amdgcn_mfma_f32_16x16x32_bf16(af, bw[dir], (f32x4){0.f, 0.f, 0.f, 0.f}, 0, 0, 0);
#pragma unroll
                for (int e = 0; e < 4; ++e) sZ[(dir * 64 + 16 * ti + 4 * fq + e) * 128 + 16 * wv + fr] = z[e]; }
        }
        __syncthreads();
#pragma unroll 1
        for (int dir = 0; dir < 2; ++dir) {
            const float bg = p.in[lnd(12)][(size_t)(l * 2 + dir) * 512 + h * 128 + d];
            float cum[16];
#pragma unroll
            for (int i = 0; i < 16; ++i) { const float z = sZ[(dir * 64 + tq * 16 + i) * 128 + d] + bg;
                cum[i] = (fminf(z, 0.f) - __logf(1.0f + __expf(-fabsf(z)))) * 0.0625f; }
            if (dir == 0) {
#pragma unroll
                for (int i = 1; i < 16; ++i) cum[i] += cum[i - 1];
            } else {
#pragma unroll
                for (int i = 14; i >= 0; --i) cum[i] += cum[i + 1];
            }
            sT4[tq * 128 + d] = dir == 0 ? cum[15] : cum[0];
            __syncthreads();
            float off = 0.f, total = 0.f;
#pragma unroll
            for (int q = 0; q < 4; ++q) { const float v = sT4[q * 128 + d]; total += v; if (dir == 0 ? (q < tq) : (q > tq)) off += v; }
            bf16_t* QD = dir == 0 ? Q : QB; bf16_t* KI = dir == 0 ? Kk : KB;
#pragma unroll
            for (int i = 0; i < 16; ++i) { const float cm = cum[i] + off; const size_t o = (size_t)(tb + tq * 16 + i) * 512 + h * 128 + d;
                QD[o] = f2bf(qv[i] * __expf(cm)); KI[o] = f2bf(kv[i] * __expf(-cm)); }
            if (tq == 0) ((float*)(p.ws + (dir == 0 ? WS_TOTF : WS_TOTB)))[(size_t)c64 * 512 + h * 128 + d] = total;
            __syncthreads();
        }
    }
}

constexpr int GLA_GRP = 71168;
typedef short s16x4 __attribute__((ext_vector_type(4)));
__device__ __forceinline__ bf16x8 tr_frag(const LAS bf16_t* base, int stride, int krow0, int col0, int fr, int fq) {
    const LAS bf16_t* q = base + (krow0 + 8 * fq + (fr >> 2)) * stride + col0 + 4 * (fr & 3);
    const s16x4 a = __builtin_amdgcn_ds_read_tr16_b64_v4i16((LAS s16x4*)q);
    const s16x4 b = __builtin_amdgcn_ds_read_tr16_b64_v4i16((LAS s16x4*)(q + 4 * stride));
    return __builtin_shufflevector(a, b, 0, 1, 2, 3, 4, 5, 6, 7);
}
#define LDS_BAR() do { asm volatile("s_waitcnt lgkmcnt(0)" ::: "memory"); __builtin_amdgcn_s_barrier(); asm volatile("" ::: "memory"); } while (0)
__device__ __forceinline__ void phase_gla(const P& p, int l, LAS unsigned char* lds) {
    const int tid = tid_(), grp = __builtin_amdgcn_readfirstlane(tid >> 8), gt = tid & 255, wv = __builtin_amdgcn_readfirstlane((tid >> 6) & 3), lane = tid & 63, fr = lane & 15, fq = lane >> 4;
    LAS unsigned char* gl = lds + grp * GLA_GRP;
    LAS bf16_t* sQ = (LAS bf16_t*)gl; LAS bf16_t* sK = (LAS bf16_t*)(gl + 17408); LAS bf16_t* sV = (LAS bf16_t*)(gl + 34816);
    LAS bf16_t* sP = (LAS bf16_t*)(gl + 44032); LAS bf16_t* sS = (LAS bf16_t*)(gl + 53248); LAS float* sTot = (LAS float*)(gl + 70656);
    const bf16_t* QD = grp == 0 ? (const bf16_t*)(p.ws + WS_R3) : (const bf16_t*)(p.ws + WS_R5);
    const bf16_t* KI = QD + (size_t)TOK * 512;
    const bf16_t* V = (const bf16_t*)(p.ws + WS_R4);
    const float* TOT = (const float*)(p.ws + (grp == 0 ? WS_TOTF : WS_TOTB));
    bf16_t* O = (bf16_t*)(p.ws + WS_R1);
    float* OST = p.out + (size_t)TOK * 1024;
    const int G = gridDim.x, b = bid_();
    const bool custom = (G == 256);
    const int ntask_mine = custom ? (b < 128 ? 1 : 4) : ((640 - b + G - 1) / G);
    for (int ti = 0; ti < ntask_mine; ++ti) {
        const int task = custom ? (b < 128 ? b : b + 128 * ti) : b + G * ti;
        if (task >= 640) break;
        const bool sample = task < 128;
        const int t2 = sample ? task : task - 128, xcd_ = t2 & 7, vs = (t2 >> 3) & 3, sh_ = xcd_ + 8 * (t2 >> 5), sb = sh_ >> 2, h = sh_ & 3;
        const int base = sample ? TOKP + sb * 4096 : sb * 256, nch = sample ? 64 : 4;
        f32x4 accS[2][4];
#pragma unroll
        for (int dt = 0; dt < 2; ++dt)
#pragma unroll
            for (int vt = 0; vt < 4; ++vt) {
                f32x4 a = (f32x4){0.f, 0.f, 0.f, 0.f};
                if (sample) { const float* cp = p.in[lnd(3)] + (((((size_t)sb * 2 + l) * 2 + grp) * 4 + h) * 128 + 16 * (2 * wv + dt) + 4 * fq) * 256 + vs * 64 + 16 * vt + fr;
#pragma unroll
                    for (int e = 0; e < 4; ++e) a[e] = cp[(size_t)e * 256]; }
                accS[dt][vt] = a;
                u32x2 w; w.x = pk_bf16(a[0], a[1]); w.y = pk_bf16(a[2], a[3]);
                *(LAS u32x2*)(sS + (16 * vt + fr) * 136 + 16 * (2 * wv + dt) + 4 * fq) = w;
            }
        u32x4 rq[2][4], rk[2][4], rv[2][2]; float rt[2] = {0.f, 0.f};
        u32x2 oprev[2][4];
#pragma unroll
        for (int u = 0; u < 2; ++u)
#pragma unroll
            for (int vt = 0; vt < 4; ++vt) oprev[u][vt] = (u32x2){0u, 0u};
#define GLA_CHUNK(st) (grp == 0 ? (st) : nch - 1 - (st))
#define GLA_LOAD(U, ci) do { const int tb_ = base + (ci) * 64; \
        _Pragma("unroll") for (int i = 0; i < 4; ++i) { const int idx = gt + 256 * i, row = idx >> 4, c16 = idx & 15; const size_t o = (size_t)(tb_ + row) * 512 + h * 128 + c16 * 8; rq[U][i] = *(const u32x4*)(QD + o); rk[U][i] = *(const u32x4*)(KI + o); } \
        _Pragma("unroll") for (int i = 0; i < 2; ++i) { const int idx = gt + 256 * i, row = idx >> 3, c8 = idx & 7; rv[U][i] = *(const u32x4*)(V + (size_t)(tb_ + row) * 1024 + h * 256 + vs * 64 + c8 * 8); } \
        if (gt < 128) rt[U] = TOT[(size_t)(tb_ >> 6) * 512 + h * 128 + gt]; } while (0)
#define GLA_STORE(U) do { \
        _Pragma("unroll") for (int i = 0; i < 4; ++i) { const int idx = gt + 256 * i, row = idx >> 4, c16 = idx & 15; *(LAS u32x4*)(sQ + row * 136 + c16 * 8) = rq[U][i]; *(LAS u32x4*)(sK + row * 136 + c16 * 8) = rk[U][i]; } \
        _Pragma("unroll") for (int i = 0; i < 2; ++i) { const int idx = gt + 256 * i, row = idx >> 3, c8 = idx & 7; *(LAS u32x4*)(sV + row * 72 + c8 * 8) = rv[U][i]; } \
        if (gt < 128) sTot[gt] = rt[U]; } while (0)
#define GLA_OLOAD(U, st) do { const int tb_ = base + GLA_CHUNK(st) * 64; \
        _Pragma("unroll") for (int vt = 0; vt < 4; ++vt) oprev[U][vt] = *(const u32x2*)(O + (size_t)(tb_ + 16 * wv + fr) * 1024 + h * 256 + vs * 64 + 16 * vt + 4 * fq); } while (0)
        GLA_LOAD(0, GLA_CHUNK(0));
        GLA_STORE(0);
        GLA_LOAD(1, GLA_CHUNK(1));
        __syncthreads();
        const int half = nch >> 1;
        for (int s0 = 0; s0 < nch; s0 += 2) {
#pragma unroll
          for (int u = 0; u < 2; ++u) {
            const int s = s0 + u;
            const int ci = GLA_CHUNK(s), tb = base + ci * 64;
            const bool second = (s >= half);
            if (s == half) GLA_OLOAD(u, s);
            if (s + 1 < nch && s + 1 > half) GLA_OLOAD(u ^ 1, s + 1);
            asm volatile("" ::: "memory");
            if (s + 2 < nch) GLA_LOAD(u, GLA_CHUNK(s + 2));
            { bf16x8 qa[4];
#pragma unroll
            for (int ks = 0; ks < 4; ++ks) qa[ks] = *(const LAS bf16x8*)(sQ + (16 * wv + fr) * 136 + 32 * ks + 8 * fq);
#pragma unroll
            for (int jt = 0; jt < 4; ++jt) {
                bf16x8 kb[4];
#pragma unroll
                for (int ks = 0; ks < 4; ++ks) kb[ks] = *(const LAS bf16x8*)(sK + (16 * jt + fr) * 136 + 32 * ks + 8 * fq);
                f32x4 acc = (f32x4){0.f, 0.f, 0.f, 0.f};
#pragma unroll
                for (int ks = 0; ks < 4; ++ks) acc = __builtin_amdgcn_mfma_f32_16x16x32_bf16(qa[ks], kb[ks], acc, 0, 0, 0);
#pragma unroll
                for (int e = 0; e < 4; ++e) { const int i = 16 * wv + 4 * fq + e, j = 16 * jt + fr; const bool keep = grp == 0 ? (j <= i) : (j >= i); sP[i * 72 + j] = f2bf(keep ? acc[e] : 0.f); }
            } }
            asm volatile("" ::: "memory");
            bf16x8 vf[4][2];
#pragma unroll
            for (int vt = 0; vt < 4; ++vt)
#pragma unroll
                for (int ks = 0; ks < 2; ++ks) vf[vt][ks] = tr_frag(sV, 72, 32 * ks, 16 * vt, fr, fq);
#pragma unroll
            for (int dt = 0; dt < 2; ++dt) {
                bf16x8 kf[2];
#pragma unroll
                for (int ks = 0; ks < 2; ++ks) kf[ks] = tr_frag(sK, 136, 32 * ks, 16 * (2 * wv + dt), fr, fq);
                const f32x4 tt = *(const LAS f32x4*)(sTot + 16 * (2 * wv + dt) + 4 * fq);
                const f32x4 sc = (f32x4){__expf(tt[0]), __expf(tt[1]), __expf(tt[2]), __expf(tt[3])};
#pragma unroll
                for (int vt = 0; vt < 4; ++vt) {
#pragma unroll
                    for (int ks = 0; ks < 2; ++ks) accS[dt][vt] = __builtin_amdgcn_mfma_f32_16x16x32_bf16(kf[ks], vf[vt][ks], accS[dt][vt], 0, 0, 0);
                    accS[dt][vt] = accS[dt][vt] * sc;
                }
            }
            asm volatile("s_waitcnt lgkmcnt(0)" ::: "memory");
            {
                bf16x8 pf[2];
#pragma unroll
                for (int ks = 0; ks < 2; ++ks) pf[ks] = *(const LAS bf16x8*)(sP + (16 * wv + fr) * 72 + 32 * ks + 8 * fq);
                bf16x8 qf[4];
#pragma unroll
                for (int ks = 0; ks < 4; ++ks) qf[ks] = *(const LAS bf16x8*)(sQ + (16 * wv + fr) * 136 + 32 * ks + 8 * fq);
#pragma unroll
                for (int vt = 0; vt < 4; ++vt) {
                    f32x4 acc = (f32x4){0.f, 0.f, 0.f, 0.f};
#pragma unroll
                    for (int ks = 0; ks < 2; ++ks) acc = __builtin_amdgcn_mfma_f32_16x16x32_bf16(vf[vt][ks], pf[ks], acc, 0, 0, 0);
#pragma unroll
                    for (int ks = 0; ks < 4; ++ks) { const bf16x8 sf = *(const LAS bf16x8*)(sS + (16 * vt + fr) * 136 + 32 * ks + 8 * fq);
                        acc = __builtin_amdgcn_mfma_f32_16x16x32_bf16(sf, qf[ks], acc, 0, 0, 0); }
                    { u32x2 pv = oprev[u][vt]; asm volatile("" : "+v"(pv));
                      if (second) acc = acc + (f32x4){bflo(pv.x), bfhi(pv.x), bflo(pv.y), bfhi(pv.y)}; }
                    store4bf(O + (size_t)(tb + 16 * wv + fr) * 1024 + h * 256 + vs * 64 + 16 * vt + 4 * fq, acc);
                }
            }
            LDS_BAR();
#pragma unroll
            for (int dt = 0; dt < 2; ++dt)
#pragma unroll
                for (int vt = 0; vt < 4; ++vt) { u32x2 w; w.x = pk_bf16(accS[dt][vt][0], accS[dt][vt][1]); w.y = pk_bf16(accS[dt][vt][2], accS[dt][vt][3]);
                    *(LAS u32x2*)(sS + (16 * vt + fr) * 136 + 16 * (2 * wv + dt) + 4 * fq) = w; }
            if (s + 1 < nch) GLA_STORE(u ^ 1);
            if (s == half - 1) { asm volatile("s_waitcnt vmcnt(0)" ::: "memory"); __syncthreads(); } else LDS_BAR();
          }
        }
        if (!sample) {
#pragma unroll
            for (int dt = 0; dt < 2; ++dt)
#pragma unroll
                for (int vt = 0; vt < 4; ++vt) { float* op = OST + (((((size_t)sb * 2 + l) * 2 + grp) * 4 + h) * 128 + 16 * (2 * wv + dt) + 4 * fq) * 256 + vs * 64 + 16 * vt + fr;
#pragma unroll
                    for (int e = 0; e < 4; ++e) op[(size_t)e * 256] = accS[dt][vt][e]; }
        }
    }
#undef GLA_LOAD
#undef GLA_STORE
#undef GLA_OLOAD
#undef GLA_CHUNK
}

__device__ __forceinline__ void phase_glapost(const P& p, int l) {
    const int lane = tid_() & 63, gw = bid_() * 8 + (tid_() >> 6), nw = gridDim.x * 8;
    bf16_t* O = (bf16_t*)(p.ws + WS_R1); const bf16_t* R = (const bf16_t*)(p.ws + WS_R3);
    const float* gn = p.in[lnd(13)] + (size_t)l * 256 + (lane & 15) * 16;
    for (int row = gw; row < TOK; row += nw) {
        const size_t o = (size_t)row * 1024 + lane * 16; float x[16], r[16];
#pragma unroll
        for (int hh = 0; hh < 2; ++hh) { const u32x4 a = *(const u32x4*)(O + o + 8 * hh), c = *(const u32x4*)(R + o + 8 * hh);
            x[8 * hh + 0] = bflo(a.x); x[8 * hh + 1] = bfhi(a.x); x[8 * hh + 2] = bflo(a.y); x[8 * hh + 3] = bfhi(a.y); x[8 * hh + 4] = bflo(a.z); x[8 * hh + 5] = bfhi(a.z); x[8 * hh + 6] = bflo(a.w); x[8 * hh + 7] = bfhi(a.w);
            r[8 * hh + 0] = bflo(c.x); r[8 * hh + 1] = bfhi(c.x); r[8 * hh + 2] = bflo(c.y); r[8 * hh + 3] = bfhi(c.y); r[8 * hh + 4] = bflo(c.z); r[8 * hh + 5] = bfhi(c.z); r[8 * hh + 6] = bflo(c.w); r[8 * hh + 7] = bfhi(c.w); }
        float ss = 0.f;
#pragma unroll
        for (int e = 0; e < 16; ++e) ss += x[e] * x[e];
        ss += __shfl_xor(ss, 1); ss += __shfl_xor(ss, 2); ss += __shfl_xor(ss, 4); ss += __shfl_xor(ss, 8);
        const float rstd = rsqrtf(ss * (1.0f / 256.0f) + 1e-6f);
        float y[16];
#pragma unroll
        for (int e = 0; e < 16; ++e) y[e] = x[e] * rstd * gn[e] * r[e];
#pragma unroll
        for (int hh = 0; hh < 2; ++hh) { u32x4 w; w.x = pk_bf16(y[8 * hh], y[8 * hh + 1]); w.y = pk_bf16(y[8 * hh + 2], y[8 * hh + 3]); w.z = pk_bf16(y[8 * hh + 4], y[8 * hh + 5]); w.w = pk_bf16(y[8 * hh + 6], y[8 * hh + 7]); *(u32x4*)(O + o + 8 * hh) = w; }
    }
}


#define XB_TMO      128
#define XB_XCNT(j)  (256  + 64 * (j))
#define XB_XSUB(j)  (1280 + 64 * (j))
#define XB_XGEN(j)  (2304 + 64 * (j))
#define XB_TOP      3328
#define XB_TOPGEN   3392
#define XCD_BAR_WORDS 3456
#define XB_SPIN_CAP (1u << 18)
__device__ __forceinline__ unsigned xb_ld(unsigned* p)              { return __hip_atomic_load(p, __ATOMIC_RELAXED, __HIP_MEMORY_SCOPE_AGENT); }
__device__ __forceinline__ unsigned xb_add(unsigned* p, unsigned v) { return __hip_atomic_fetch_add(p, v, __ATOMIC_RELAXED, __HIP_MEMORY_SCOPE_AGENT); }
__device__ __forceinline__ unsigned xb_xcc_id() { return (unsigned)__builtin_amdgcn_s_getreg((3 << 11) | 20) & 0xFu; }
#define XB_SPIN(cond, bar) do { unsigned _sp = 0; while (cond) { __builtin_amdgcn_s_sleep(1); \
    if ((++_sp & 255u) == 0u) { if (xb_ld(&(bar)[XB_TMO])) break; if (_sp > XB_SPIN_CAP) { atomicAdd(&(bar)[XB_TMO], 1u); break; } } } } while (0)
struct XcdBarrier { unsigned* bar; unsigned x; volatile LAS unsigned* st; };
__device__ __forceinline__ XcdBarrier xcd_barrier_post(unsigned* bar, volatile LAS unsigned* st) {
    XcdBarrier b; b.bar = bar; b.x = xb_xcc_id(); b.st = st;
    if (threadIdx.x == 0) (void)xb_add(&bar[XB_XCNT(b.x)], 1u);
    return b;
}
__device__ __forceinline__ void xcd_barrier_complete(unsigned* bar, unsigned x, unsigned& nloc, unsigned& nx) {
    const unsigned G = gridDim.x * gridDim.y * gridDim.z;
    unsigned sum, cnt, mine, sp = 0u;
    for (;;) {
        sum = 0u; cnt = 0u; mine = 0u;
#pragma unroll
        for (unsigned j = 0; j < 16; ++j) { const unsigned c = xb_ld(&bar[XB_XCNT(j)]); sum += c; cnt += (c > 0u) ? 1u : 0u; mine = (j == x) ? c : mine; }
        if (sum == G) break;
        __builtin_amdgcn_s_sleep(1);
        if ((++sp & 255u) == 0u) { if (xb_ld(&bar[XB_TMO])) break; if (sp > XB_SPIN_CAP) { atomicAdd(&bar[XB_TMO], 1u); break; } }
    }
    nloc = mine > 0u ? mine : 1u; nx = cnt > 0u ? cnt : 1u;
}
__device__ __forceinline__ void xcd_barrier(const XcdBarrier& b) {
    asm volatile("s_waitcnt vmcnt(0)" ::: "memory");
    __syncthreads();
    if (threadIdx.x == 0) {
        unsigned* bar = b.bar;
        __builtin_amdgcn_s_waitcnt(0);
        unsigned nloc = b.st[0], nx = b.st[1];
        if (nloc == 0u) { xcd_barrier_complete(bar, b.x, nloc, nx); b.st[0] = nloc; b.st[1] = nx; }
        const unsigned old = xb_add(&bar[XB_XSUB(b.x)], 1u);
        const unsigned gen = old / nloc;
        if (old + 1u == (gen + 1u) * nloc) {
            __builtin_amdgcn_fence(__ATOMIC_RELEASE, "agent");
            asm volatile("s_waitcnt vmcnt(0)" ::: "memory");
            const unsigned og = xb_add(&bar[XB_TOP], 1u);
            const unsigned tg = og / nx;
            if (og + 1u == (tg + 1u) * nx) xb_add(&bar[XB_TOPGEN], 1u);
            else XB_SPIN(xb_ld(&bar[XB_TOPGEN]) == tg, bar);
            __builtin_amdgcn_fence(__ATOMIC_ACQUIRE, "agent");
            xb_add(&bar[XB_XGEN(b.x)], 1u);
            asm volatile("s_waitcnt vmcnt(0)" ::: "memory");
        } else {
            XB_SPIN(xb_ld(&bar[XB_XGEN(b.x)]) == gen, bar);
            __builtin_amdgcn_fence(__ATOMIC_ACQUIRE, "agent");
            asm volatile("s_waitcnt vmcnt(0)" ::: "memory");
        }
    }
    __syncthreads();
}

__device__ __forceinline__ void run_phase(const P& p, int ph, LAS unsigned char* lds) {
    if (ph == 2 * PPL) { if (EN(34)) phase_final(p); return; }
    const int l = ph / PPL, q = ph % PPL;
    unsigned char* ws = p.ws; bf16_t* W = (bf16_t*)(ws + WS_W);
    const int G = gridDim.x, c = bid_();
    pg8::Order S;
    switch (q) {
        case 0: if (EN(0)) { phase_prep(p, l, lds); if (l == 1) phase_norm(p, l, 1); } break;
        case 1: if (EN(1)) { if (l == 0) phase_norm(p, l, 1); } break;
        case 2: if (EN(2)) { pg8::Gemm g{(const bf16_t*)(ws + WS_R2), W + W_A / 2, TOK, 2816, 1024, 1024, 0, 0, 1}; S.init(TOK, 2816, 1, G, c);
            EpiPartA E{(bf16_t*)(ws + WS_R3), (bf16_t*)(ws + WS_R3) + (size_t)TOK * 512, (bf16_t*)(ws + WS_R4), (bf16_t*)(ws + WS_R5), (float*)(ws + WS_GLR)};
            pg8::gemm_phase(lds, g, S, E); } break;
        case 3: if (EN(3)) { pg8::Gemm g{(const bf16_t*)(ws + WS_R5), (const bf16_t*)(ws + WS_EMAT), 1280, 256, 512, 768, (size_t)1280 * 768, (size_t)256 * 512, 32}; S.init(1280, 256, 32, G, c);
            EpiE E{(float*)(ws + WS_E)}; pg8::gemm_phase(lds, g, S, E); } break;
        case 4: if (EN(4)) phase_s5scan(p, l); break;
        case 5: if (EN(5)) { pg8::Gemm g{(const bf16_t*)(ws + WS_R5), (const bf16_t*)(ws + WS_R1), 1280, 512, 768, 768, (size_t)1280 * 768, (size_t)512 * 768, 32}; S.init(1280, 512, 32, G, c);
            EpiY E{(bf16_t*)(ws + WS_E)}; pg8::gemm_phase(lds, g, S, E); } break;
        case 6: if (EN(6)) { pg8::Gemm g{(const bf16_t*)(ws + WS_E), W + W_GLU / 2, TOK, 512, 512, 512, 0, 0, 1}; S.init(TOK, 512, 1, G, c);
            EpiGLU E{(const bf16_t*)(ws + WS_E), (bf16_t*)(ws + WS_R6), p.in[lnd(24)] + (size_t)l * 512}; pg8::gemm_phase(lds, g, S, E); } break;
        case 7: if (EN(7)) phase_glapre(p, l, lds); break;
        case 8: if (EN(8)) phase_gla(p, l, lds); break;
        case 9: if (EN(9)) { pg8::Gemm g{(const bf16_t*)(ws + WS_R2), W + W_B / 2, TOK, 3072, 1024, 1024, 0, 0, 1}; S.init(TOK, 3072, 1, G, c);
            EpiPartB E{(bf16_t*)(ws + WS_R3), (bf16_t*)(ws + WS_R4), (bf16_t*)(ws + WS_R5)}; pg8::gemm_phase(lds, g, S, E); } break;
        case 10: if (EN(10)) phase_glapost(p, l); break;
        case 11: if (EN(11)) { pg8::Gemm g{(const bf16_t*)(ws + WS_R1), W + W_PG / 2, TOK, 1024, 1024, 1024, 0, 0, 1}; S.init(TOK, 1024, 1, G, c);
              EpiProj1 E{(const bf16_t*)(ws + WS_R4), (bf16_t*)(ws + WS_R2)}; pg8::gemm_phase(lds, g, S, E); } break;
        case 12: if (EN(12)) { pg8::Gemm g{(const bf16_t*)(ws + WS_R6), W + W_PS / 2, TOK, 1024, 512, 512, 0, 0, 1}; S.init(TOK, 1024, 1, G, c);
              EpiProj2 E{(const bf16_t*)(ws + WS_R5), (bf16_t*)(ws + WS_R2)}; pg8::gemm_phase(lds, g, S, E); } break;
        case 13: if (EN(13)) { pg8::Gemm g{(const bf16_t*)(ws + WS_R2), W + W_OUT / 2, TOK, 1024, 1024, 1024, 0, 0, 1}; S.init(TOK, 1024, 1, G, c);
            EpiDelta E{(bf16_t*)(ws + WS_R3), (const float*)(ws + WS_MOD) + (size_t)l * 9 * 6144 + 2048}; pg8::gemm_phase(lds, g, S, E); } break;
        case 14: if (EN(14)) phase_norm(p, l, 2); break;
        case 15: if (EN(15)) { pg8::Gemm g{(const bf16_t*)(ws + WS_R2), W + W_1 / 2, TOK, 4096, 1024, 1024, 0, 0, 1}; S.init(TOK, 4096, 1, G, c);
            EpiFF1 E{(bf16_t*)(ws + WS_HID)}; pg8::gemm_phase(lds, g, S, E); } break;
        case 16: if (EN(16)) { pg8::Gemm g{(const bf16_t*)(ws + WS_HID), W + W_2 / 2, TOK, 1024, 4096, 4096, 0, 0, 1}; S.init(TOK, 1024, 1, G, c);
            EpiDelta E{(bf16_t*)(ws + WS_R2), (const float*)(ws + WS_MOD) + (size_t)l * 9 * 6144 + 5120}; pg8::gemm_phase(lds, g, S, E); } break;
        default: break;
    }
}

__global__ void __launch_bounds__(NTHR, 2) fwd_megakernel(P p) {
    extern __shared__ __attribute__((aligned(16))) unsigned char lds_raw[];
    LAS unsigned char* lds = (LAS unsigned char*)lds_raw;
#if MULTI_LAUNCH
    for (int ph = p.ph_lo; ph < p.ph_hi; ++ph) run_phase(p, ph, lds);
#else
    cg::grid_group grid = cg::this_grid();
    if (p.ph_lo < 0) grid.sync();
    volatile LAS unsigned* stw = (volatile LAS unsigned*)(lds + LDS_BYTES - 16);
    if (threadIdx.x < 4) stw[threadIdx.x] = 0u;
    __syncthreads();
    const XcdBarrier bar = xcd_barrier_post((unsigned*)(p.ws + WS_BAR), stw);
    for (int ph = p.ph_lo; ph < p.ph_hi; ++ph) {
        run_phase(p, ph, lds);
#if REP_MASK
        if (ph < 2 * PPL && ((REP_MASK >> (ph % PPL)) & 1)) {
            xcd_barrier(bar);
            if ((ph % PPL) == 12) { run_phase(p, ph - 1, lds); }
            run_phase(p, ph, lds);
        }
#endif
        if (ph + 1 < p.ph_hi && (ph % PPL) != 11 && ph != PPL) xcd_barrier(bar);
    }
#endif
}

extern "C" void kernel_launch(void* const* d_in, const int* in_sizes, int n_in, void* d_out, int out_size, void* d_ws, size_t ws_size, hipStream_t stream) {
    static int grid = 0;
    if (grid == 0) {
        if (n_in != 31 || ws_size < WS_END) { fprintf(stderr, "kernel_launch: unexpected n_in %d or ws_size %zu (< %zu)\n", n_in, ws_size, (size_t)WS_END); grid = -1; return; }
        int dev = 0, cus = 0, per_cu = 0;
        hipGetDevice(&dev);
        hipDeviceGetAttribute(&cus, hipDeviceAttributeMultiprocessorCount, dev);
        if (hipFuncSetAttribute((const void*)fwd_megakernel, hipFuncAttributeMaxDynamicSharedMemorySize, LDS_BYTES) != hipSuccess) { fprintf(stderr, "kernel_launch: hipFuncSetAttribute failed\n"); grid = -1; return; }
        hipOccupancyMaxActiveBlocksPerMultiprocessor(&per_cu, (const void*)fwd_megakernel, NTHR, LDS_BYTES);
        (void)hipGetLastError();
        if (per_cu < 1) fprintf(stderr, "kernel_launch: occupancy query says %d blocks per CU\n", per_cu);
        grid = cus > 0 ? cus : 256;
    }
    if (grid < 0) return;
    P p{};
    for (int i = 0; i < 31; ++i) p.in[i] = (const float*)d_in[i];
    p.out = (float*)d_out; p.ws = (unsigned char*)d_ws;
#if MULTI_LAUNCH
    for (int ph = 0; ph < NPHASE; ++ph) { p.ph_lo = ph; p.ph_hi = ph + 1; hipLaunchKernelGGL(fwd_megakernel, dim3(grid), dim3(NTHR), LDS_BYTES, stream, p); }
#else
    p.ph_lo = 0; p.ph_hi = NPHASE;
    (void)hipMemsetAsync((char*)d_ws + WS_BAR, 0, XCD_BAR_WORDS * sizeof(unsigned), stream);
    void* args[] = {&p};
    hipError_t e = hipLaunchCooperativeKernel((const void*)fwd_megakernel, dim3(grid), dim3(NTHR), args, LDS_BYTES, stream);
    if (e != hipSuccess) fprintf(stderr, "cooperative launch failed: %s (grid %d)\n", hipGetErrorString(e), grid);
#endif
}
```

```cpp
#include <hip/hip_runtime.h>
#include <hip/hip_cooperative_groups.h>
#include <cstdio>
namespace cg = cooperative_groups;

#ifndef MULTI_LAUNCH
#define MULTI_LAUNCH 0
#endif

#ifndef REP_MASK
#define REP_MASK 0
#endif
#ifndef PHASE_SEL
#define PHASE_SEL -1
#endif
#define EN(q) (PHASE_SEL < 0 || PHASE_SEL == (q))
#define LAS __attribute__((address_space(3)))
typedef unsigned short bf16_t;
typedef short bf16x8 __attribute__((ext_vector_type(8)));
typedef float f32x4 __attribute__((ext_vector_type(4)));
typedef unsigned u32x4 __attribute__((ext_vector_type(4)));
typedef unsigned u32x2 __attribute__((ext_vector_type(2)));

constexpr int NTHR = 512;
constexpr int TOK = 40960, TOKP = 8192;
constexpr int LDS_BYTES = 147456;
constexpr int NPHASE = 35;
constexpr int PPL = 17;

constexpr size_t MiB = (size_t)1 << 20;
constexpr size_t WS_MOD = 0;
constexpr size_t WS_GLR = 1 * MiB;
constexpr size_t WS_TOTF = 7 * MiB;
constexpr size_t WS_TOTB = 9 * MiB;
constexpr size_t WS_BAR = 12 * MiB;
constexpr size_t WS_W = 16 * MiB;
constexpr size_t W_A = 0;
constexpr size_t W_B = W_A + (size_t)2816 * 1024 * 2;
constexpr size_t W_PG = W_B + (size_t)3072 * 1024 * 2;
constexpr size_t W_GLU = W_PG + (size_t)1024 * 1024 * 2;
constexpr size_t W_PS = W_GLU + (size_t)512 * 512 * 2;
constexpr size_t W_OUT = W_PS + (size_t)1024 * 512 * 2;
constexpr size_t W_1 = W_OUT + (size_t)1024 * 1024 * 2;
constexpr size_t W_2 = W_1 + (size_t)4096 * 1024 * 2;
constexpr size_t WS_R2 = 50 * MiB;
constexpr size_t WS_R3 = 130 * MiB;
constexpr size_t WS_R4 = 210 * MiB;
constexpr size_t WS_R5 = 290 * MiB;
constexpr size_t WS_E = 350 * MiB;
constexpr size_t WS_R6 = 390 * MiB;
constexpr size_t WS_R1 = 430 * MiB;
constexpr size_t WS_EMAT = 454 * MiB;
constexpr size_t WS_HID = 130 * MiB;
constexpr size_t WS_END = 510 * MiB;

struct P { const float* in[31]; float* out; unsigned char* ws; int ph_lo, ph_hi; };

__device__ __forceinline__ int tid_() { int t = threadIdx.x; asm volatile("" : "+v"(t)); return t; }
__device__ __forceinline__ int bid_() { int b = blockIdx.x; asm volatile("" : "+s"(b)); return b; }
__device__ __forceinline__ int lnd(int k) { asm volatile("" : "+s"(k)); return k; }
__device__ __forceinline__ unsigned pk_bf16(float lo, float hi) { unsigned r; asm("v_cvt_pk_bf16_f32 %0, %1, %2" : "=v"(r) : "v"(lo), "v"(hi)); return r; }
__device__ __forceinline__ float bf2f(bf16_t b) { return __uint_as_float(((unsigned)b) << 16); }
__device__ __forceinline__ float bflo(unsigned w) { return __uint_as_float(w << 16); }
__device__ __forceinline__ float bfhi(unsigned w) { return __uint_as_float(w & 0xffff0000u); }
__device__ __forceinline__ bf16_t f2bf(float f) { return (bf16_t)(pk_bf16(f, 0.f) & 0xffffu); }
__device__ __forceinline__ float sigmoidf_(float x) { return 1.0f / (1.0f + __expf(-x)); }
__device__ __forceinline__ void store4bf(bf16_t* ptr, f32x4 v) { u32x2 w; w.x = pk_bf16(v[0], v[1]); w.y = pk_bf16(v[2], v[3]); *(u32x2*)ptr = w; }
__device__ __forceinline__ f32x4 load4bf(const bf16_t* ptr) { u32x2 w = *(const u32x2*)ptr; return (f32x4){bflo(w.x), bfhi(w.x), bflo(w.y), bfhi(w.y)}; }
__device__ __forceinline__ int mod_index(int tok) { return tok < TOKP ? 0 : (tok >> 12) - 1; }
__device__ __forceinline__ float wave_sum(float v) {
#pragma unroll
    for (int o = 32; o >= 1; o >>= 1) v += __shfl_xor(v, o);
    return v;
}

namespace pg8 {
constexpr int BM = 256, BK = 64, HALF = 128, HTB = HALF * BK * 2, STAGE_BYTES = 8 * HTB, NXCD = 8, WGM = 8;
__device__ __forceinline__ int lds_byte(int r, int c) { const int st = (r >> 4) * 2 + (c >> 5), rr = r & 15, cc = c & 31, ob = rr * 64 + cc * 2; return st * 1024 + (ob ^ (((ob >> 9) & 1) << 5)); }
__device__ __forceinline__ void stage_rc(int b, int& R, int& C) { const int st = b / 1024, sb = b % 1024, swz = sb ^ (((sb >> 9) & 1) << 5); R = (st >> 1) * 16 + swz / 64; C = (st & 1) * 32 + (swz % 64) / 2; }

struct Unit { int pm, pn, z, hf; };
struct Gemm { const bf16_t* A; const bf16_t* Bt; int M, N, K, lda; size_t sA, sB; int nz; };
struct Order {
    int nM, nN, nwg, G, c, nz, nfull, rem2;
    __device__ __forceinline__ void init(int M, int N, int nz_, int G_, int c_) { nM = M / BM; nN = N / BM; nwg = nM * nN; G = G_; c = c_; nz = nz_;
        nfull = nwg; rem2 = 0;
        if (nz == 1) { const int full = (nwg / G) * G, rem = nwg - full; if (rem > 0 && 2 * rem <= G) { nfull = full; rem2 = 2 * rem; } } }
    __device__ __forceinline__ void map(int wgid, Unit& u) const {
        { const int q = nwg / NXCD, r = nwg % NXCD, xcd = wgid % NXCD, off = wgid / NXCD; wgid = (xcd < r ? xcd * (q + 1) : r * (q + 1) + (xcd - r) * q) + off; }
        const int nig = WGM * nN, gid = wgid / nig, fm = gid * WGM, gsz = (nM - fm) < WGM ? (nM - fm) : WGM;
        u.pm = fm + ((wgid % nig) % gsz); u.pn = (wgid % nig) / gsz; u.z = 0; }
    __device__ __forceinline__ bool next(int i, Unit& u) const {
        const long L = (long)i * G + c;
        if (nz == 1) {
            if (L < nfull) { map((int)L, u); u.hf = 0; return true; }
            const int t = (int)(L - nfull); if (t >= rem2) return false;
            map(nfull + (t >> 1), u); u.hf = 1 + (t & 1); return true;
        }
        if (L >= (long)nwg * nz) return false;
        const int z = (int)(L / nwg), r = (int)(L % nwg); u.z = z; u.pm = r % nM; u.pn = r / nM; u.hf = 0;
        return true;
    }
};

template <class Epi>
__device__ __forceinline__ void gemm_phase(LAS unsigned char* lds, const Gemm g, const Order& S, const Epi& E) {
    const int tid = tid_(), wid = __builtin_amdgcn_readfirstlane(tid >> 6), lane = tid & 63, wr = wid >> 2, wc = wid & 3, fr = lane & 15, fq = lane >> 4;
    const int K = g.K, nt = K / BK;
    unsigned voffA[2], voffB[2];
#pragma unroll
    for (int i = 0; i < 2; ++i) { int R, C; stage_rc(tid * 16 + i * 8192, R, C); voffA[i] = (unsigned)(R * g.lda + C) * 2u; voffB[i] = (unsigned)(R * K + C) * 2u; }
    const size_t kstep = (size_t)(BK * 2);
    const size_t hstepA = (size_t)HALF * g.lda * 2, hstepB = (size_t)HALF * K * 2;
    const unsigned ldsw = (unsigned)wid * 1024u;
    const int aoff = lds_byte(wr * 64 + fr, fq * 8), boff = lds_byte(wc * 32 + fr, fq * 8);
#define PG8_SA(b, h) (((b) * 2 + (h)) * HTB)
#define PG8_SB(b, h) ((4 + (b) * 2 + (h)) * HTB)
#define PG8_STAGE(bufoff, gbase, voff) do { _Pragma("unroll") for (int _i = 0; _i < 2; ++_i) \
        __builtin_amdgcn_global_load_lds((const unsigned*)((const char*)(gbase) + (voff)[_i]), (LAS unsigned*)(lds + (bufoff) + ldsw + _i * 8192), 16, 0, 0); } while (0)
#define PG8_LDA(dst, b, h) do { _Pragma("unroll") for (int m = 0; m < 4; ++m) _Pragma("unroll") for (int k = 0; k < 2; ++k) dst[m][k] = *(const LAS bf16x8*)(lds + PG8_SA(b, h) + aoff + m * 2048 + k * 1024); } while (0)
#define PG8_LDB(dst, b, h) do { _Pragma("unroll") for (int n = 0; n < 2; ++n) _Pragma("unroll") for (int k = 0; k < 2; ++k) dst[n][k] = *(const LAS bf16x8*)(lds + PG8_SB(b, h) + boff + n * 2048 + k * 1024); } while (0)
#define PG8_MMA(ai, bj, At, Bt) do { __builtin_amdgcn_s_setprio(1); _Pragma("unroll") for (int m = 0; m < 4; ++m) _Pragma("unroll") for (int n = 0; n < 2; ++n) _Pragma("unroll") for (int k = 0; k < 2; ++k) \
        acc[ai][bj][m][n] = __builtin_amdgcn_mfma_f32_16x16x32_bf16(Bt[n][k], At[m][k], acc[ai][bj][m][n], 0, 0, 0); __builtin_amdgcn_s_setprio(0); } while (0)
#define PG8_WAIT_V(n) asm volatile("s_waitcnt vmcnt(" #n ")" ::: "memory")
#define PG8_WAIT_L(n) asm volatile("s_waitcnt lgkmcnt(" #n ")" ::: "memory")
#define PG8_BAR __builtin_amdgcn_s_barrier()
#define PG8_SCHED __builtin_amdgcn_sched_barrier(0)
    Unit cur, nxt; int ui = 0;
    if (!S.next(0, cur)) return;
    f32x4 acc[2][2][4][2];
#pragma unroll
    for (int a = 0; a < 2; ++a)
#pragma unroll
        for (int b = 0; b < 2; ++b)
#pragma unroll
            for (int m = 0; m < 4; ++m)
#pragma unroll
                for (int n = 0; n < 2; ++n) acc[a][b][m][n] = (f32x4){0.f, 0.f, 0.f, 0.f};
    bf16x8 At[4][2], B0[2][2], B1[2][2];
    const char* cA = (const char*)g.A + ((size_t)cur.z * g.sA + (size_t)(cur.pm * BM + (cur.hf == 2 ? HALF : 0)) * g.lda) * 2;
    const char* cB = (const char*)g.Bt + ((size_t)cur.z * g.sB + (size_t)cur.pn * BM * K) * 2;
    PG8_STAGE(PG8_SB(0, 0), cB, voffB); PG8_STAGE(PG8_SB(0, 1), cB + hstepB, voffB); PG8_STAGE(PG8_SA(0, 0), cA, voffA); PG8_STAGE(PG8_SA(0, 1), cA + hstepA, voffA);
    if (wr == 1) PG8_BAR;
    PG8_WAIT_V(2); PG8_BAR;
    PG8_STAGE(PG8_SB(1, 0), cB + kstep, voffB); PG8_STAGE(PG8_SA(1, 0), cA + kstep, voffA); PG8_STAGE(PG8_SB(1, 1), cB + hstepB + kstep, voffB);
    PG8_WAIT_V(6); PG8_BAR;
    for (;;) {
        const bool has_next = S.next(ui + 1, nxt);
        const char* nA = has_next ? (const char*)g.A + ((size_t)nxt.z * g.sA + (size_t)(nxt.pm * BM + (nxt.hf == 2 ? HALF : 0)) * g.lda) * 2 : cA;
        const bool fullu = (cur.hf == 0);
        const char* nB = has_next ? (const char*)g.Bt + ((size_t)nxt.z * g.sB + (size_t)nxt.pn * BM * K) * 2 : cB;
        for (int t = 0; t < nt; t += 2) {
            const bool last = (t == nt - 2);
            const char* a1 = cA + (size_t)(t + 1) * kstep;
            const char* a2 = last ? nA : cA + (size_t)(t + 2) * kstep; const char* b2 = last ? nB : cB + (size_t)(t + 2) * kstep;
            const char* a3 = a2 + kstep; const char* b3 = b2 + kstep;
            PG8_LDB(B0, 0, 0); PG8_LDB(B1, 0, 1); PG8_SCHED; PG8_LDA(At, 0, 0); PG8_STAGE(PG8_SA(1, 1), a1 + hstepA, voffA);
            PG8_WAIT_V(8); PG8_WAIT_L(0); PG8_BAR; PG8_MMA(0, 0, At, B0); PG8_MMA(0, 1, At, B1); PG8_BAR; PG8_SCHED;
            if (fullu) PG8_LDA(At, 0, 1); PG8_STAGE(PG8_SB(0, 0), b2, voffB); PG8_STAGE(PG8_SB(0, 1), b2 + hstepB, voffB); PG8_STAGE(PG8_SA(0, 0), a2, voffA);
            PG8_WAIT_V(8); PG8_WAIT_L(0); PG8_BAR; if (fullu) { PG8_MMA(1, 0, At, B0); PG8_MMA(1, 1, At, B1); } PG8_BAR; PG8_SCHED;
            PG8_LDB(B0, 1, 0); PG8_LDB(B1, 1, 1); PG8_SCHED; PG8_LDA(At, 1, 0); PG8_STAGE(PG8_SA(0, 1), a2 + hstepA, voffA);
            PG8_WAIT_V(8); PG8_WAIT_L(0); PG8_BAR; PG8_MMA(0, 0, At, B0); PG8_MMA(0, 1, At, B1); PG8_BAR; PG8_SCHED;
            if (fullu) PG8_LDA(At, 1, 1); PG8_STAGE(PG8_SB(1, 0), b3, voffB); PG8_STAGE(PG8_SB(1, 1), b3 + hstepB, voffB); PG8_STAGE(PG8_SA(1, 0), a3, voffA);
            PG8_WAIT_V(8); PG8_WAIT_L(0); PG8_BAR; if (fullu) { PG8_MMA(1, 0, At, B0); PG8_MMA(1, 1, At, B1); } PG8_BAR; PG8_SCHED;
        }
        if (wr == 0) PG8_BAR;
        if (fullu) E.template tile<2>(acc, cur.z, cur.pm * BM + wr * 64 + fr, cur.pn * BM + wc * 32 + (Epi::PERM ? 8 : 4) * fq);
        else E.template tile<1>(acc, cur.z, cur.pm * BM + (cur.hf == 2 ? HALF : 0) + wr * 64 + fr, cur.pn * BM + wc * 32 + (Epi::PERM ? 8 : 4) * fq);
        if (!has_next) break;
#pragma unroll
        for (int a = 0; a < 2; ++a)
#pragma unroll
            for (int b = 0; b < 2; ++b)
#pragma unroll
                for (int m = 0; m < 4; ++m)
#pragma unroll
                    for (int n = 0; n < 2; ++n) acc[a][b][m][n] = (f32x4){0.f, 0.f, 0.f, 0.f};
        cur = nxt; cA = nA; cB = nB; ++ui;
        if (wr == 1) PG8_BAR;
    }
    PG8_WAIT_V(0);
    PG8_BAR;
#undef PG8_SA
#undef PG8_SB
#undef PG8_STAGE
#undef PG8_LDA
#undef PG8_LDB
#undef PG8_MMA
#undef PG8_WAIT_V
#undef PG8_WAIT_L
#undef PG8_BAR
#undef PG8_SCHED
}
}

#define EPI_SIMPLE_TILE() \
    static constexpr bool PERM = false; \
    template <int NAI> __device__ __forceinline__ void tile(const f32x4 (&acc)[2][2][4][2], int z, int row0, int col0) const { \
        _Pragma("unroll") for (int ai = 0; ai < NAI; ++ai) _Pragma("unroll") for (int m = 0; m < 4; ++m) _Pragma("unroll") for (int bj = 0; bj < 2; ++bj) _Pragma("unroll") for (int n = 0; n < 2; ++n) \
            (*this)(z, row0 + ai * 128 + m * 16, col0 + bj * 128 + n * 16, acc[ai][bj][m][n]); }
#define EPI_PAIR_TILE() \
    static constexpr bool PERM = true; \
    template <int NAI> __device__ __forceinline__ void tile(const f32x4 (&acc)[2][2][4][2], int z, int row0, int col0) const { \
        _Pragma("unroll") for (int ai = 0; ai < NAI; ++ai) _Pragma("unroll") for (int m = 0; m < 4; ++m) _Pragma("unroll") for (int bj = 0; bj < 2; ++bj) \
            pair(row0 + ai * 128 + m * 16, col0 + bj * 128, acc[ai][bj][m][0], acc[ai][bj][m][1]); }
#define EPI_PIPE_TILE() \
    static constexpr bool PERM = true; \
    template <int NAI> __device__ __forceinline__ void tile(const f32x4 (&acc)[2][2][4][2], int z, int row0, int col0) const { \
        Pre pre; begin(row0, col0, pre); L buf[2][8]; \
        _Pragma("unroll") for (int mm = 0; mm < 2; ++mm) _Pragma("unroll") for (int bj = 0; bj < 2; ++bj) _Pragma("unroll") for (int n = 0; n < 2; ++n) load(row0 + mm * 16, col0 + bj * 128 + n * 4, buf[0][mm * 4 + bj * 2 + n]); \
        _Pragma("unroll") for (int b = 0; b < 2 * NAI; ++b) { \
            if (b < 2 * NAI - 1) { _Pragma("unroll") for (int mm = 0; mm < 2; ++mm) _Pragma("unroll") for (int bj = 0; bj < 2; ++bj) _Pragma("unroll") for (int n = 0; n < 2; ++n) \
                load(row0 + ((b + 1) >> 1) * 128 + (((b + 1) & 1) * 2 + mm) * 16, col0 + bj * 128 + n * 4, buf[(b + 1) & 1][mm * 4 + bj * 2 + n]); } \
            _Pragma("unroll") for (int mm = 0; mm < 2; ++mm) _Pragma("unroll") for (int bj = 0; bj < 2; ++bj) _Pragma("unroll") for (int n = 0; n < 2; ++n) \
                apply(row0 + (b >> 1) * 128 + ((b & 1) * 2 + mm) * 16, col0 + bj * 128 + n * 4, acc[b >> 1][bj][(b & 1) * 2 + mm][n], buf[b & 1][mm * 4 + bj * 2 + n], pre, bj * 2 + n); } }
__device__ __forceinline__ void store8bf(bf16_t* ptr, f32x4 a, f32x4 b) { u32x4 w; w.x = pk_bf16(a[0], a[1]); w.y = pk_bf16(a[2], a[3]); w.z = pk_bf16(b[0], b[1]); w.w = pk_bf16(b[2], b[3]); *(u32x4*)ptr = w; }

struct EpiPartA {
    bf16_t* Q; bf16_t* Kk; bf16_t* V; bf16_t* UG; float* GLR;
    __device__ __forceinline__ void pair(int row, int col, f32x4 a, f32x4 b) const {
        if (col < 512) store8bf(Q + (size_t)row * 512 + col, a, b);
        else if (col < 1024) store8bf(Kk + (size_t)row * 512 + (col - 512), a, b);
        else if (col < 2048) store8bf(V + (size_t)row * 1024 + (col - 1024), a, b);
        else if (col < 2304) { const int c = col - 2048; if (c < 32) { *(f32x4*)(GLR + (size_t)row * 32 + c) = a; *(f32x4*)(GLR + (size_t)row * 32 + c + 4) = b; } }
        else { const int c = col - 2304, g = c >> 4, n = c & 15, chunk = row >> 5, j = row & 31; store8bf(UG + ((size_t)(g * 1280 + chunk) * 768 + j * 16 + n), a, b); }
    }
    EPI_PAIR_TILE()
};
struct EpiE { float* E; __device__ __forceinline__ void operator()(int z, int row, int col, f32x4 v) const { *(f32x4*)(E + ((size_t)(z * 1280 + row) * 256 + col)) = v; } EPI_SIMPLE_TILE() };
struct EpiY {
    bf16_t* YB;
    __device__ __forceinline__ void operator()(int z, int row, int col, f32x4 v) const {
        const int tok = row * 32 + (col >> 4), ch = z * 16 + (col & 15);
        f32x4 o;
#pragma unroll
        for (int e = 0; e < 4; ++e) { const float x = v[e]; o[e] = x * sigmoidf_(1.5957691216f * (x + 0.044715f * x * x * x)); }
        store4bf(YB + (size_t)tok * 512 + ch, o);
    }
    EPI_SIMPLE_TILE()
};
struct EpiGLU {
    const bf16_t* YB; bf16_t* OS5; const float* bglu;
    typedef u32x2 L; struct Pre { f32x4 b[4]; };
    __device__ __forceinline__ void begin(int, int col0, Pre& pr) const {
#pragma unroll
        for (int k = 0; k < 4; ++k) pr.b[k] = *(const f32x4*)(bglu + col0 + (k >> 1) * 128 + (k & 1) * 4); }
    __device__ __forceinline__ void load(int row, int col, L& l) const { l = *(const u32x2*)(YB + (size_t)row * 512 + col); }
    __device__ __forceinline__ void apply(int row, int col, f32x4 v, const L& l, const Pre& pr, int k) const {
        const f32x4 y = (f32x4){bflo(l.x), bfhi(l.x), bflo(l.y), bfhi(l.y)}; f32x4 o;
#pragma unroll
        for (int e = 0; e < 4; ++e) o[e] = y[e] * sigmoidf_(v[e] + pr.b[k][e]);
        store4bf(OS5 + (size_t)row * 512 + col, o); }
    EPI_PIPE_TILE()
};
struct EpiPartB {
    bf16_t* R; bf16_t* GA; bf16_t* GB;
    __device__ __forceinline__ void pair(int row, int col, f32x4 a, f32x4 b) const {
        f32x4 sa, sb;
#pragma unroll
        for (int e = 0; e < 4; ++e) { sa[e] = sigmoidf_(a[e]); sb[e] = sigmoidf_(b[e]); }
        if (col < 1024) store8bf(R + (size_t)row * 1024 + col, a * sa, b * sb);
        else if (col < 2048) store8bf(GA + (size_t)row * 1024 + (col - 1024), sa, sb);
        else store8bf(GB + (size_t)row * 1024 + (col - 2048), sa, sb);
    }
    EPI_PAIR_TILE()
};
struct EpiProj1 { const bf16_t* GA; bf16_t* T1;
    typedef u32x2 L; struct Pre { int dummy; };
    __device__ __forceinline__ void begin(int, int, Pre&) const {}
    __device__ __forceinline__ void load(int row, int col, L& l) const { l = *(const u32x2*)(GA + (size_t)row * 1024 + col); }
    __device__ __forceinline__ void apply(int row, int col, f32x4 v, const L& l, const Pre&, int) const {
        const f32x4 g = (f32x4){bflo(l.x), bfhi(l.x), bflo(l.y), bfhi(l.y)}; store4bf(T1 + (size_t)row * 1024 + col, g * v); }
    EPI_PIPE_TILE()
};
struct EpiProj2 { const bf16_t* GB; bf16_t* T1;
    struct L { u32x2 t, g; }; struct Pre { int dummy; };
    __device__ __forceinline__ void begin(int, int, Pre&) const {}
    __device__ __forceinline__ void load(int row, int col, L& l) const { const size_t o = (size_t)row * 1024 + col; l.t = *(const u32x2*)(T1 + o); l.g = *(const u32x2*)(GB + o); }
    __device__ __forceinline__ void apply(int row, int col, f32x4 v, const L& l, const Pre&, int) const {
        const f32x4 g = (f32x4){bflo(l.g.x), bfhi(l.g.x), bflo(l.g.y), bfhi(l.g.y)}, t = (f32x4){bflo(l.t.x), bfhi(l.t.x), bflo(l.t.y), bfhi(l.t.y)};
        store4bf(T1 + (size_t)row * 1024 + col, t + g * v); }
    EPI_PIPE_TILE()
};
struct EpiDelta { bf16_t* Dl; const float* gate;
    static constexpr bool PERM = true;
    template <int NAI> __device__ __forceinline__ void tile(const f32x4 (&acc)[2][2][4][2], int, int row0, int col0) const {
        const float* gp = gate + (size_t)mod_index(row0) * 6144 + col0; f32x4 g[2][2];
#pragma unroll
        for (int bj = 0; bj < 2; ++bj)
#pragma unroll
            for (int n = 0; n < 2; ++n) g[bj][n] = *(const f32x4*)(gp + bj * 128 + n * 4);
#pragma unroll
        for (int ai = 0; ai < NAI; ++ai)
#pragma unroll
            for (int m = 0; m < 4; ++m)
#pragma unroll
                for (int bj = 0; bj < 2; ++bj) store8bf(Dl + (size_t)(row0 + ai * 128 + m * 16) * 1024 + col0 + bj * 128, g[bj][0] * acc[ai][bj][m][0], g[bj][1] * acc[ai][bj][m][1]);
    } };
struct EpiFF1 { bf16_t* H;
    __device__ __forceinline__ void pair(int row, int col, f32x4 a, f32x4 b) const {
        f32x4 oa, ob;
#pragma unroll
        for (int e = 0; e < 4; ++e) { const float ra = fmaxf(a[e], 0.f), rb = fmaxf(b[e], 0.f); oa[e] = ra * ra; ob[e] = rb * rb; }
        store8bf(H + (size_t)row * 4096 + col, oa, ob); }
    EPI_PAIR_TILE()
};

struct ConvJob { const float* src; int ld, K, c0, nvalid, ndst; bf16_t* dst; float scale; };
__device__ __forceinline__ bool conv_job(const P& p, int l, int j, ConvJob& J) {
    bf16_t* W = (bf16_t*)(p.ws + WS_W);
    const float* win = p.in[lnd(10)] + (size_t)l * 1024 * 5664;
    J.scale = 1.0f;
    switch (j) {
        case 0: J = {win, 5664, 1024, 0, 512, 512, W + W_A / 2, 0.08838834764831845f}; break;
        case 1: J = {win, 5664, 1024, 512, 512, 512, W + W_A / 2 + (size_t)512 * 1024, 1.f}; break;
        case 2: J = {win, 5664, 1024, 1024, 1024, 1024, W + W_A / 2 + (size_t)1024 * 1024, 1.f}; break;
        case 3: J = {win, 5664, 1024, 3072, 32, 256, W + W_A / 2 + (size_t)2048 * 1024, 1.f}; break;
        case 4: J = {win, 5664, 1024, 3104, 512, 512, W + W_A / 2 + (size_t)2304 * 1024, 1.f}; break;
        case 5: J = {win, 5664, 1024, 2048, 1024, 1024, W + W_B / 2, 1.f}; break;
        case 6: J = {win, 5664, 1024, 3616, 1024, 1024, W + W_B / 2 + (size_t)1024 * 1024, 1.f}; break;
        case 7: J = {win, 5664, 1024, 4640, 1024, 1024, W + W_B / 2 + (size_t)2048 * 1024, 1.f}; break;
        case 8: J = {p.in[lnd(14)] + (size_t)l * 1024 * 1024, 1024, 1024, 0, 1024, 1024, W + W_PG / 2, 1.f}; break;
        case 9: J = {p.in[lnd(23)] + (size_t)l * 512 * 512, 512, 512, 0, 512, 512, W + W_GLU / 2, 1.f}; break;
        case 10: J = {p.in[lnd(25)] + (size_t)l * 512 * 1024, 1024, 512, 0, 1024, 1024, W + W_PS / 2, 1.f}; break;
        case 11: J = {p.in[lnd(26)] + (size_t)l * 1024 * 1024, 1024, 1024, 0, 1024, 1024, W + W_OUT / 2, 1.f}; break;
        case 12: J = {p.in[lnd(28)] + (size_t)l * 1024 * 4096, 4096, 1024, 0, 4096, 4096, W + W_1 / 2, 1.f}; break;
        case 13: J = {p.in[lnd(29)] + (size_t)l * 4096 * 1024, 1024, 4096, 0, 1024, 1024, W + W_2 / 2, 1.f}; break;
        default: return false;
    }
    return true;
}
constexpr int CONV_TILES = 2112;
__device__ __forceinline__ void conv_tile(const P& p, int l, int tile, LAS float* sT) {
    const int tid = tid_();
    ConvJob J; int j = 0, rem = tile;
    for (; j < 14; ++j) { conv_job(p, l, j, J); const int nt = (J.ndst / 64) * (J.K / 128); if (rem < nt) break; rem -= nt; }
    const int kts = J.K / 128, ntile = rem / kts, ktile = rem % kts, n0 = ntile * 64, k0 = ktile * 128;
    {
        const int kk = tid >> 4, c4 = (tid & 15) * 4; f32x4 v[4];
#pragma unroll
        for (int i = 0; i < 4; ++i) { v[i] = (f32x4){0.f, 0.f, 0.f, 0.f};
            if (n0 + c4 < J.nvalid) v[i] = *(const f32x4*)(J.src + (size_t)(k0 + kk + 32 * i) * J.ld + J.c0 + n0 + c4); }
#pragma unroll
        for (int i = 0; i < 4; ++i)
#pragma unroll
            for (int e = 0; e < 4; ++e) sT[(c4 + e) * 129 + kk + 32 * i] = v[i][e] * J.scale;
    }
    __syncthreads();
    {
        const int n = tid >> 3, ks = (tid & 7) * 16;
        const int rho = n & 31, nsrc = (n & ~31) + 8 * ((rho & 15) >> 2) + 4 * (rho >> 4) + (rho & 3);
        const LAS float* sp = sT + nsrc * 129 + ks;
#pragma unroll
        for (int hh = 0; hh < 2; ++hh) { u32x4 w; const LAS float* q = sp + 8 * hh;
            w.x = pk_bf16(q[0], q[1]); w.y = pk_bf16(q[2], q[3]); w.z = pk_bf16(q[4], q[5]); w.w = pk_bf16(q[6], q[7]);
            *(u32x4*)(J.dst + (size_t)(n0 + n) * J.K + k0 + ks + 8 * hh) = w; }
    }
}

__device__ __forceinline__ void mod_task(const P& p, int m, LAS float* sm) {
    const int tid = tid_(), l = m / 192, colbase = (m % 192) * 32, cl = tid & 31, ks = tid >> 5;
    LAS float* SC = sm; LAS float* RED = sm + 9216;
    for (int i = tid; i < 9216; i += NTHR) { const int j = i >> 10, k = i & 1023; const float c = (j == 0) ? p.in[lnd(6)][k] : p.in[lnd(2)][(j - 1) * 1024 + k]; SC[i] = c * sigmoidf_(c); }
    __syncthreads();
    float acc[9];
#pragma unroll
    for (int j = 0; j < 9; ++j) acc[j] = 0.f;
    const float* w = p.in[lnd(7)] + (size_t)l * 1024 * 6144 + colbase + cl;
    for (int k8 = 0; k8 < 64; k8 += 16) { float wv[16];
#pragma unroll
        for (int u = 0; u < 16; ++u) wv[u] = w[(size_t)(ks * 64 + k8 + u) * 6144];
#pragma unroll
        for (int u = 0; u < 16; ++u)
#pragma unroll
            for (int j = 0; j < 9; ++j) acc[j] += SC[j * 1024 + ks * 64 + k8 + u] * wv[u]; }
#pragma unroll
    for (int j = 0; j < 9; ++j) RED[(ks * 9 + j) * 32 + cl] = acc[j];
    __syncthreads();
    if (tid < 288) { const int j = tid >> 5, c = tid & 31; float s = 0.f;
#pragma unroll
        for (int q = 0; q < 16; ++q) s += RED[(q * 9 + j) * 32 + c];
        float* mod = (float*)(p.ws + WS_MOD);
        mod[((size_t)l * 9 + j) * 6144 + colbase + c] = s + p.in[lnd(8)][(size_t)l * 6144 + colbase + c]; }
}

__device__ __forceinline__ void s5_mats(const P& p, int l, int gq, LAS float* sm) {
    const int tid = tid_(), g = gq >> 2, part = gq & 3;
    LAS float* KF = sm; LAS float* KB = sm + 8192; LAS float* LT = sm + 16384; LAS float* CC = sm + 20608; LAS float* BB = sm + 22656;
    bf16_t* MC = (bf16_t*)(p.ws + WS_R1) + (size_t)g * 512 * 768;
    bf16_t* EM = (bf16_t*)(p.ws + WS_EMAT) + (size_t)g * 256 * 512;
    for (int d = 0; d < 2; ++d) {
        const int pg = (l * 2 + d) * 32 + g;
        const float* lamr = p.in[lnd(15)] + (size_t)pg * 64; const float* lami = p.in[lnd(16)] + (size_t)pg * 64;
        const float dt = expf(p.in[lnd(17)][pg]);
        const float* bre = p.in[lnd(18)] + (size_t)pg * 1024; const float* bim = p.in[lnd(19)] + (size_t)pg * 1024;
        const float* cre = p.in[lnd(20)] + (size_t)pg * 1024; const float* cim = p.in[lnd(21)] + (size_t)pg * 1024;
        for (int i = tid; i < 33 * 64; i += NTHR) { const int tau = i >> 6, pp = i & 63; const float a = expf(lamr[pp] * dt * (float)tau); float s, c; sincosf(lami[pp] * dt * (float)tau, &s, &c); LT[2 * i] = a * c; LT[2 * i + 1] = a * s; }
        for (int i = tid; i < 1024; i += NTHR) { CC[2 * i] = cre[i]; CC[2 * i + 1] = cim[i]; }
        for (int i = tid; i < 1024; i += NTHR) {
            const int pp = i >> 4; const float lr = lamr[pp], li = lami[pp]; float s, c; sincosf(li * dt, &s, &c);
            const float em1 = expm1f(lr * dt); float sh, ch; sincosf(0.5f * li * dt, &sh, &ch);
            const float nr = em1 * c - 2.f * sh * sh, ni = (em1 + 1.f) * s;
            const float inv = 1.f / (lr * lr + li * li);
            const float qr = (nr * lr + ni * li) * inv, qi = (ni * lr - nr * li) * inv;
            const float br = bre[i], bi = bim[i];
            BB[2 * i] = qr * br - qi * bi; BB[2 * i + 1] = qr * bi + qi * br;
        }
        __syncthreads();
        {
            const int tau = tid >> 4, n = tid & 15; float acc[16];
#pragma unroll
            for (int m = 0; m < 16; ++m) acc[m] = 0.f;
            for (int pp = 0; pp < 64; ++pp) {
                const float cr = CC[2 * (n * 64 + pp)], ci = CC[2 * (n * 64 + pp) + 1], lr = LT[2 * (tau * 64 + pp)], li = LT[2 * (tau * 64 + pp) + 1];
                const float xr = cr * lr - ci * li, xi = cr * li + ci * lr;
#pragma unroll
                for (int m = 0; m < 16; ++m) acc[m] += xr * BB[2 * (pp * 16 + m)] - xi * BB[2 * (pp * 16 + m) + 1];
            }
            LAS float* Kd = d ? KB : KF;
#pragma unroll
            for (int m = 0; m < 16; ++m) Kd[(tau * 16 + n) * 16 + m] = acc[m];
        }
        {
            const int pp = tid >> 3, cseg = tid & 7;
            { const int jj = part;
                const int j = cseg * 4 + jj, e = d == 0 ? 31 - j : j; const float lr = LT[2 * (e * 64 + pp)], li = LT[2 * (e * 64 + pp) + 1];
                float re[16], im[16];
#pragma unroll
                for (int m = 0; m < 16; ++m) { const float br = BB[2 * (pp * 16 + m)], bi = BB[2 * (pp * 16 + m) + 1]; re[m] = lr * br - li * bi; im[m] = lr * bi + li * br; }
                bf16_t* er = EM + (size_t)(d * 128 + pp) * 512 + j * 16; bf16_t* ei = EM + (size_t)(d * 128 + 64 + pp) * 512 + j * 16;
#pragma unroll
                for (int h = 0; h < 2; ++h) {
                    u32x4 w; w.x = pk_bf16(re[8 * h], re[8 * h + 1]); w.y = pk_bf16(re[8 * h + 2], re[8 * h + 3]); w.z = pk_bf16(re[8 * h + 4], re[8 * h + 5]); w.w = pk_bf16(re[8 * h + 6], re[8 * h + 7]); *(u32x4*)(er + 8 * h) = w;
                    u32x4 x; x.x = pk_bf16(im[8 * h], im[8 * h + 1]); x.y = pk_bf16(im[8 * h + 2], im[8 * h + 3]); x.z = pk_bf16(im[8 * h + 4], im[8 * h + 5]); x.w = pk_bf16(im[8 * h + 6], im[8 * h + 7]); *(u32x4*)(ei + 8 * h) = x;
                }
            }
        }
        {
            const int t = tid >> 4, n = tid & 15, f = d == 0 ? t + 1 : 32 - t;
            bf16_t* mr = MC + (size_t)tid * 768 + 512 + d * 128;
#pragma unroll 1
            for (int p8 = 2 * part; p8 < 2 * part + 2; ++p8) {
                float re[8], im[8];
#pragma unroll
                for (int q = 0; q < 8; ++q) { const int pp = p8 * 8 + q; const float cr = CC[2 * (n * 64 + pp)], ci = CC[2 * (n * 64 + pp) + 1], lr = LT[2 * (f * 64 + pp)], li = LT[2 * (f * 64 + pp) + 1];
                    re[q] = cr * lr - ci * li; im[q] = -(cr * li + ci * lr); }
                u32x4 w; w.x = pk_bf16(re[0], re[1]); w.y = pk_bf16(re[2], re[3]); w.z = pk_bf16(re[4], re[5]); w.w = pk_bf16(re[6], re[7]); *(u32x4*)(mr + p8 * 8) = w;
                u32x4 x; x.x = pk_bf16(im[0], im[1]); x.y = pk_bf16(im[2], im[3]); x.z = pk_bf16(im[4], im[5]); x.w = pk_bf16(im[6], im[7]); *(u32x4*)(mr + 64 + p8 * 8) = x;
            }
        }
        __syncthreads();
    }
    {
        const int t = tid >> 4, n = tid & 15; const float dsk = p.in[lnd(22)][(size_t)l * 512 + g * 16 + n];
        bf16_t* mr = MC + (size_t)tid * 768;
#pragma unroll 1
        for (int j = 8 * part; j < 8 * part + 8; ++j) {
            float v[16];
#pragma unroll
            for (int m = 0; m < 16; ++m) v[m] = 0.f;
            if (j <= t) { const LAS float* k = KF + ((t - j) * 16 + n) * 16;
#pragma unroll
                for (int m = 0; m < 16; ++m) v[m] += k[m]; }
            if (j >= t) { const LAS float* k = KB + ((j - t) * 16 + n) * 16;
#pragma unroll
                for (int m = 0; m < 16; ++m) v[m] += k[m]; }
            if (j == t) {
#pragma unroll
                for (int m = 0; m < 16; ++m) v[m] += (m == n) ? dsk : 0.f; }
            u32x4 w; w.x = pk_bf16(v[0], v[1]); w.y = pk_bf16(v[2], v[3]); w.z = pk_bf16(v[4], v[5]); w.w = pk_bf16(v[6], v[7]); *(u32x4*)(mr + j * 16) = w;
            u32x4 x; x.x = pk_bf16(v[8], v[9]); x.y = pk_bf16(v[10], v[11]); x.z = pk_bf16(v[12], v[13]); x.w = pk_bf16(v[14], v[15]); *(u32x4*)(mr + j * 16 + 8) = x;
        }
    }
}

__device__ __forceinline__ void phase_prep(const P& p, int l, LAS unsigned char* lds) {
    LAS float* sm = (LAS float*)lds;
    const int b = bid_(), G = gridDim.x, ha = G >> 1;
    if (b < ha) { for (int t = b; t < 128; t += ha) { s5_mats(p, l, t, sm); __syncthreads(); } }
    else { for (int t = b - ha; t < CONV_TILES; t += G - ha) { conv_tile(p, l, t, sm); __syncthreads(); } }
    if (l == 0) for (int t = b; t < 384; t += G) { mod_task(p, t, sm); __syncthreads(); }
}

__device__ __forceinline__ void norm_row_write(const f32x4 (&x)[4], const float* g, const float* mod, int shoff, int scoff, bf16_t* hrow, int lane) {
    float ss = 0.f;
#pragma unroll
    for (int i = 0; i < 4; ++i) ss += x[i][0] * x[i][0] + x[i][1] * x[i][1] + x[i][2] * x[i][2] + x[i][3] * x[i][3];
    ss = wave_sum(ss);
    const float rstd = rsqrtf(ss * (1.0f / 1024.0f) + 1e-6f);
#pragma unroll
    for (int i = 0; i < 4; ++i) { const int d = i * 256 + lane * 4; const f32x4 gg = *(const f32x4*)(g + d), sc = *(const f32x4*)(mod + scoff + d), sh = *(const f32x4*)(mod + shoff + d);
        f32x4 h;
#pragma unroll
        for (int e = 0; e < 4; ++e) h[e] = x[i][e] * rstd * gg[e] * (1.f + sc[e]) + sh[e];
        { u32x2 w; w.x = pk_bf16(h[0], h[1]); w.y = pk_bf16(h[2], h[3]); __builtin_nontemporal_store(w, (u32x2*)(hrow + d)); } }
}
__device__ __forceinline__ void phase_norm(const P& p, int l, int which) {
    const int lane = tid_() & 63, gw = bid_() * 8 + (tid_() >> 6), nw = gridDim.x * 8;
    const float* g = (which == 1 ? p.in[lnd(9)] : p.in[lnd(27)]) + (size_t)l * 1024;
    const float* modl = (const float*)(p.ws + WS_MOD) + (size_t)l * 9 * 6144;
    const int shoff = which == 1 ? 0 : 3072, scoff = which == 1 ? 1024 : 4096;
    bf16_t* H = (bf16_t*)(p.ws + WS_R2); float* X = p.out;
    if (which == 1 && l == 0) {
        for (int item = gw; item < 4096 + 8192; item += nw) {
            if (item < 4096) {
                const int n = item; const float rr = (float)(n >> 6), cc = (float)(n & 63); f32x4 pe[4];
#pragma unroll
                for (int e = 0; e < 4; ++e) { const float om = expf(-(float)(lane * 4 + e) * (9.210340371976184f / 256.0f)); float s, c; sincosf(rr * om, &s, &c); pe[0][e] = s; pe[1][e] = c; sincosf(cc * om, &s, &c); pe[2][e] = s; pe[3][e] = c; }
                for (int b0 = 0; b0 < 8; b0 += 2) { f32x4 x[2][4];
#pragma unroll
                    for (int r = 0; r < 2; ++r) { const float* src = p.in[lnd(1)] + ((size_t)(b0 + r) * 4096 + n) * 1024;
#pragma unroll
                        for (int i = 0; i < 4; ++i) x[r][i] = *(const f32x4*)(src + i * 256 + lane * 4); }
#pragma unroll
                    for (int r = 0; r < 2; ++r) { const int row = TOKP + (b0 + r) * 4096 + n;
#pragma unroll
                        for (int i = 0; i < 4; ++i) { x[r][i] = x[r][i] + pe[i]; *(f32x4*)(X + (size_t)row * 1024 + i * 256 + lane * 4) = x[r][i]; }
                        norm_row_write(x[r], g, modl + (size_t)(1 + b0 + r) * 6144, shoff, scoff, H + (size_t)row * 1024, lane); } }
            } else { const int row = item - 4096; const float* src = p.in[lnd(0)] + (size_t)row * 1024; f32x4 x[4];
#pragma unroll
                for (int i = 0; i < 4; ++i) { x[i] = *(const f32x4*)(src + i * 256 + lane * 4); *(f32x4*)(X + (size_t)row * 1024 + i * 256 + lane * 4) = x[i]; }
                norm_row_write(x, g, modl, shoff, scoff, H + (size_t)row * 1024, lane); }
        }
    } else {
        const bf16_t* DL = (const bf16_t*)(p.ws + (which == 1 ? WS_R2 : WS_R3));
        for (int row0 = gw; row0 < TOK; row0 += 4 * nw) {
            f32x4 x[4][4]; u32x2 dv[4][4];
#pragma unroll
            for (int r = 0; r < 4; ++r) { const int row = row0 + r * nw;
                if (row < TOK) {
#pragma unroll
                    for (int i = 0; i < 4; ++i) { x[r][i] = *(const f32x4*)(X + (size_t)row * 1024 + i * 256 + lane * 4); dv[r][i] = *(const u32x2*)(DL + (size_t)row * 1024 + i * 256 + lane * 4); } } }
#pragma unroll
            for (int r = 0; r < 4; ++r) { const int row = row0 + r * nw;
                if (row < TOK) {
#pragma unroll
                    for (int i = 0; i < 4; ++i) { x[r][i] = x[r][i] + (f32x4){bflo(dv[r][i].x), bfhi(dv[r][i].x), bflo(dv[r][i].y), bfhi(dv[r][i].y)}; *(f32x4*)(X + (size_t)row * 1024 + i * 256 + lane * 4) = x[r][i]; }
                    norm_row_write(x[r], g, modl + (size_t)mod_index(row) * 6144, shoff, scoff, H + (size_t)row * 1024, lane); } }
        }
    }
}
__device__ __forceinline__ void phase_final(const P& p) {
    const int lane = tid_() & 63, gw = bid_() * 8 + (tid_() >> 6), nw = gridDim.x * 8; float* X = p.out; const float* g = p.in[lnd(30)]; const bf16_t* DL = (const bf16_t*)(p.ws + WS_R2);
    for (int row0 = gw; row0 < TOK; row0 += 4 * nw) {
        f32x4 x[4][4]; u32x2 dv[4][4];
#pragma unroll
        for (int r = 0; r < 4; ++r) { const int row = row0 + r * nw;
            if (row < TOK) {
#pragma unroll
                for (int i = 0; i < 4; ++i) { x[r][i] = *(const f32x4*)(X + (size_t)row * 1024 + i * 256 + lane * 4); dv[r][i] = *(const u32x2*)(DL + (size_t)row * 1024 + i * 256 + lane * 4); } } }
#pragma unroll
        for (int r = 0; r < 4; ++r) { const int row = row0 + r * nw;
            if (row < TOK) { float ss = 0.f;
#pragma unroll
                for (int i = 0; i < 4; ++i) { x[r][i] = x[r][i] + (f32x4){bflo(dv[r][i].x), bfhi(dv[r][i].x), bflo(dv[r][i].y), bfhi(dv[r][i].y)}; ss += x[r][i][0] * x[r][i][0] + x[r][i][1] * x[r][i][1] + x[r][i][2] * x[r][i][2] + x[r][i][3] * x[r][i][3]; }
                ss = wave_sum(ss); const float rstd = rsqrtf(ss * (1.0f / 1024.0f) + 1e-6f);
#pragma unroll
                for (int i = 0; i < 4; ++i) { const f32x4 gg = *(const f32x4*)(g + i * 256 + lane * 4); *(f32x4*)(X + (size_t)row * 1024 + i * 256 + lane * 4) = x[r][i] * rstd * gg; } } }
    }
}

__device__ __forceinline__ void phase_s5scan(const P& p, int l) {
    const float* E = (const float*)(p.ws + WS_E); bf16_t* UG = (bf16_t*)(p.ws + WS_R5);
    float* ore = p.out + (size_t)TOK * 1024 + 16777216; float* oim = ore + 262144;
    for (int task = bid_(); task < 320; task += gridDim.x) {
        const int idx = task * NTHR + tid_(), pp = idx & 63, d = (idx >> 6) & 1, g = (idx >> 7) & 31, s = 39 - (idx >> 12);
        const int nch = s < 32 ? 8 : 128, cbase = s < 32 ? s * 8 : 256 + (s - 32) * 128;
        const int pg = (l * 2 + d) * 32 + g; const float dt = expf(p.in[lnd(17)][pg]);
        const float a = expf(p.in[lnd(15)][(size_t)pg * 64 + pp] * dt * 32.f); float sn, cs; sincosf(p.in[lnd(16)][(size_t)pg * 64 + pp] * dt * 32.f, &sn, &cs);
        const float ar = a * cs, ai = a * sn;
        float sr = 0.f, si = 0.f;
        if (s >= 32) { const size_t o = ((((size_t)(s - 32) * 2 + l) * 2 + d) * 32 + g) * 64 + pp; sr = p.in[lnd(4)][o]; si = p.in[lnd(5)][o]; }
        const float* Eb = E + ((size_t)(g * 1280 + cbase) * 256 + d * 128 + pp);
        bf16_t* Ub = UG + ((size_t)(g * 1280 + cbase) * 768 + 512 + d * 128 + pp);
        for (int c0 = 0; c0 < nch; c0 += 8) {
            float er[8], ei[8];
#pragma unroll
            for (int k = 0; k < 8; ++k) { const int c = d == 0 ? c0 + k : nch - 1 - (c0 + k); er[k] = Eb[(size_t)c * 256]; ei[k] = Eb[(size_t)c * 256 + 64]; }
#pragma unroll
            for (int k = 0; k < 8; ++k) { const int c = d == 0 ? c0 + k : nch - 1 - (c0 + k);
                Ub[(size_t)c * 768] = f2bf(sr); Ub[(size_t)c * 768 + 64] = f2bf(si);
                const float nr = ar * sr - ai * si + er[k], ni = ar * si + ai * sr + ei[k]; sr = nr; si = ni; }
        }
        if (s < 32) { const size_t o = ((((size_t)s * 2 + l) * 2 + d) * 32 + g) * 64 + pp; ore[o] = sr; oim[o] = si; }
    }
}

__device__ __forceinline__ void phase_glapre(const P& p, int l, LAS unsigned char* lds) {
    const int tid = tid_(), d = tid & 127, tq = tid >> 7, wv = tid >> 6, lane = tid & 63, fr = lane & 15, fq = lane >> 4;
    LAS float* sG = (LAS float*)lds; LAS float* sT4 = sG + 2048; LAS float* sZ = sG + 2560;
    bf16_t* Q = (bf16_t*)(p.ws + WS_R3); bf16_t* Kk = Q + (size_t)TOK * 512;
    bf16_t* QB = (bf16_t*)(p.ws + WS_R5); bf16_t* KB = QB + (size_t)TOK * 512;
    const float* GLR = (const float*)(p.ws + WS_GLR);
    for (int task = bid_(); task < 2560; task += gridDim.x) {
        const int c64 = task >> 2, h = task & 3, tb = c64 * 64;
        { const int row = tid >> 3, c4 = (tid & 7) * 4; *(LAS f32x4*)(sG + row * 32 + c4) = *(const f32x4*)(GLR + (size_t)(tb + row) * 32 + c4); }
        float qv[16], kv[16];
#pragma unroll
        for (int i = 0; i < 16; ++i) { const size_t o = (size_t)(tb + tq * 16 + i) * 512 + h * 128 + d; qv[i] = bf2f(Q[o]); kv[i] = bf2f(Kk[o]); }
        bf16x8 bw[2];
#pragma unroll
        for (int dir = 0; dir < 2; ++dir) { float w8[8];
#pragma unroll
            for (int e = 0; e < 8; ++e) { const int kk = 8 * fq + e - 16 * dir; w8[e] = (kk >= 0 && kk < 16) ? p.in[lnd(11)][((size_t)(l * 2 + dir) * 16 + kk) * 512 + h * 128 + 16 * wv + fr] : 0.f; }
            u32x4 pk; pk.x = pk_bf16(w8[0], w8[1]); pk.y = pk_bf16(w8[2], w8[3]); pk.z = pk_bf16(w8[4], w8[5]); pk.w = pk_bf16(w8[6], w8[7]);
            bw[dir] = __builtin_bit_cast(bf16x8, pk); }
        __syncthreads();
#pragma unroll
        for (int ti = 0; ti < 4; ++ti) {
            const LAS float* gr = sG + (16 * ti + fr) * 32 + 8 * fq; const f32x4 g0 = *(const LAS f32x4*)gr, g1 = *(const LAS f32x4*)(gr + 4);
            u32x4 pk; pk.x = pk_bf16(g0[0], g0[1]); pk.y = pk_bf16(g0[2], g0[3]); pk.z = pk_bf16(g1[0], g1[1]); pk.w = pk_bf16(g1[2], g1[3]);
            const bf16x8 af = __builtin_bit_cast(bf16x8, pk);
#pragma unroll
            for (int dir = 0; dir < 2; ++dir) { const f32x4 z = __builtin_amdgcn_mfma_f32_16x16x32_bf16(af, bw[dir], (f32x4){0.f, 0.f, 0.f, 0.f}, 0, 0, 0);
#pragma unroll
                for (int e = 0; e < 4; ++e) sZ[(dir * 64 + 16 * ti + 4 * fq + e) * 128 + 16 * wv + fr] = z[e]; }
        }
        __syncthreads();
#pragma unroll 1
        for (int dir = 0; dir < 2; ++dir) {
            const float bg = p.in[lnd(12)][(size_t)(l * 2 + dir) * 512 + h * 128 + d];
            float cum[16];
#pragma unroll
            for (int i = 0; i < 16; ++i) { const float z = sZ[(dir * 64 + tq * 16 + i) * 128 + d] + bg;
                cum[i] = (fminf(z, 0.f) - __logf(1.0f + __expf(-fabsf(z)))) * 0.0625f; }
            if (dir == 0) {
#pragma unroll
                for (int i = 1; i < 16; ++i) cum[i] += cum[i - 1];
            } else {
#pragma unroll
                for (int i = 14; i >= 0; --i) cum[i] += cum[i + 1];
            }
            sT4[tq * 128 + d] = dir == 0 ? cum[15] : cum[0];
            __syncthreads();
            float off = 0.f, total = 0.f;
#pragma unroll
            for (int q = 0; q < 4; ++q) { const float v = sT4[q * 128 + d]; total += v; if (dir == 0 ? (q < tq) : (q > tq)) off += v; }
            bf16_t* QD = dir == 0 ? Q : QB; bf16_t* KI = dir == 0 ? Kk : KB;
#pragma unroll
            for (int i = 0; i < 16; ++i) { const float cm = cum[i] + off; const size_t o = (size_t)(tb + tq * 16 + i) * 512 + h * 128 + d;
                QD[o] = f2bf(qv[i] * __expf(cm)); KI[o] = f2bf(kv[i] * __expf(-cm)); }
            if (tq == 0) ((float*)(p.ws + (dir == 0 ? WS_TOTF : WS_TOTB)))[(size_t)c64 * 512 + h * 128 + d] = total;
            __syncthreads();
        }
    }
}

constexpr int GLA_GRP = 71168;
typedef short s16x4 __attribute__((ext_vector_type(4)));
__device__ __forceinline__ bf16x8 tr_frag(const LAS bf16_t* base, int stride, int krow0, int col0, int fr, int fq) {
    const LAS bf16_t* q = base + (krow0 + 8 * fq + (fr >> 2)) * stride + col0 + 4 * (fr & 3);
    const s16x4 a = __builtin_amdgcn_ds_read_tr16_b64_v4i16((LAS s16x4*)q);
    const s16x4 b = __builtin_amdgcn_ds_read_tr16_b64_v4i16((LAS s16x4*)(q + 4 * stride));
    return __builtin_shufflevector(a, b, 0, 1, 2, 3, 4, 5, 6, 7);
}
#define LDS_BAR() do { asm volatile("s_waitcnt lgkmcnt(0)" ::: "memory"); __builtin_amdgcn_s_barrier(); asm volatile("" ::: "memory"); } while (0)
__device__ __forceinline__ void phase_gla(const P& p, int l, LAS unsigned char* lds) {
    const int tid = tid_(), grp = __builtin_amdgcn_readfirstlane(tid >> 8), gt = tid & 255, wv = __builtin_amdgcn_readfirstlane((tid >> 6) & 3), lane = tid & 63, fr = lane & 15, fq = lane >> 4;
    LAS unsigned char* gl = lds + grp * GLA_GRP;
    LAS bf16_t* sQ = (LAS bf16_t*)gl; LAS bf16_t* sK = (LAS bf16_t*)(gl + 17408); LAS bf16_t* sV = (LAS bf16_t*)(gl + 34816);
    LAS bf16_t* sP = (LAS bf16_t*)(gl + 44032); LAS bf16_t* sS = (LAS bf16_t*)(gl + 53248); LAS float* sTot = (LAS float*)(gl + 70656);
    const bf16_t* QD = grp == 0 ? (const bf16_t*)(p.ws + WS_R3) : (const bf16_t*)(p.ws + WS_R5);
    const bf16_t* KI = QD + (size_t)TOK * 512;
    const bf16_t* V = (const bf16_t*)(p.ws + WS_R4);
    const float* TOT = (const float*)(p.ws + (grp == 0 ? WS_TOTF : WS_TOTB));
    bf16_t* O = (bf16_t*)(p.ws + WS_R1);
    float* OST = p.out + (size_t)TOK * 1024;
    const int G = gridDim.x, b = bid_();
    const bool custom = (G == 256);
    const int ntask_mine = custom ? (b < 128 ? 1 : 4) : ((640 - b + G - 1) / G);
    for (int ti = 0; ti < ntask_mine; ++ti) {
        const int task = custom ? (b < 128 ? b : b + 128 * ti) : b + G * ti;
        if (task >= 640) break;
        const bool sample = task < 128;
        const int t2 = sample ? task : task - 128, xcd_ = t2 & 7, vs = (t2 >> 3) & 3, sh_ = xcd_ + 8 * (t2 >> 5), sb = sh_ >> 2, h = sh_ & 3;
        const int base = sample ? TOKP + sb * 4096 : sb * 256, nch = sample ? 64 : 4;
        f32x4 accS[2][4];
#pragma unroll
        for (int dt = 0; dt < 2; ++dt)
#pragma unroll
            for (int vt = 0; vt < 4; ++vt) {
                f32x4 a = (f32x4){0.f, 0.f, 0.f, 0.f};
                if (sample) { const float* cp = p.in[lnd(3)] + (((((size_t)sb * 2 + l) * 2 + grp) * 4 + h) * 128 + 16 * (2 * wv + dt) + 4 * fq) * 256 + vs * 64 + 16 * vt + fr;
#pragma unroll
                    for (int e = 0; e < 4; ++e) a[e] = cp[(size_t)e * 256]; }
                accS[dt][vt] = a;
                u32x2 w; w.x = pk_bf16(a[0], a[1]); w.y = pk_bf16(a[2], a[3]);
                *(LAS u32x2*)(sS + (16 * vt + fr) * 136 + 16 * (2 * wv + dt) + 4 * fq) = w;
            }
        u32x4 rq[2][4], rk[2][4], rv[2][2]; float rt[2] = {0.f, 0.f};
        u32x2 oprev[2][4];
#pragma unroll
        for (int u = 0; u < 2; ++u)
#pragma unroll
            for (int vt = 0; vt < 4; ++vt) oprev[u][vt] = (u32x2){0u, 0u};
#define GLA_CHUNK(st) (grp == 0 ? (st) : nch - 1 - (st))
#define GLA_LOAD(U, ci) do { const int tb_ = base + (ci) * 64; \
        _Pragma("unroll") for (int i = 0; i < 4; ++i) { const int idx = gt + 256 * i, row = idx >> 4, c16 = idx & 15; const size_t o = (size_t)(tb_ + row) * 512 + h * 128 + c16 * 8; rq[U][i] = *(const u32x4*)(QD + o); rk[U][i] = *(const u32x4*)(KI + o); } \
        _Pragma("unroll") for (int i = 0; i < 2; ++i) { const int idx = gt + 256 * i, row = idx >> 3, c8 = idx & 7; rv[U][i] = *(const u32x4*)(V + (size_t)(tb_ + row) * 1024 + h * 256 + vs * 64 + c8 * 8); } \
        if (gt < 128) rt[U] = TOT[(size_t)(tb_ >> 6) * 512 + h * 128 + gt]; } while (0)
#define GLA_STORE(U) do { \
        _Pragma("unroll") for (int i = 0; i < 4; ++i) { const int idx = gt + 256 * i, row = idx >> 4, c16 = idx & 15; *(LAS u32x4*)(sQ + row * 136 + c16 * 8) = rq[U][i]; *(LAS u32x4*)(sK + row * 136 + c16 * 8) = rk[U][i]; } \
        _Pragma("unroll") for (int i = 0; i < 2; ++i) { const int idx = gt + 256 * i, row = idx >> 3, c8 = idx & 7; *(LAS u32x4*)(sV + row * 72 + c8 * 8) = rv[U][i]; } \
        if (gt < 128) sTot[gt] = rt[U]; } while (0)
#define GLA_OLOAD(U, st) do { const int tb_ = base + GLA_CHUNK(st) * 64; \
        _Pragma("unroll") for (int vt = 0; vt < 4; ++vt) oprev[U][vt] = *(const u32x2*)(O + (size_t)(tb_ + 16 * wv + fr) * 1024 + h * 256 + vs * 64 + 16 * vt + 4 * fq); } while (0)
        GLA_LOAD(0, GLA_CHUNK(0));
        GLA_STORE(0);
        GLA_LOAD(1, GLA_CHUNK(1));
        __syncthreads();
        const int half = nch >> 1;
        for (int s0 = 0; s0 < nch; s0 += 2) {
#pragma unroll
          for (int u = 0; u < 2; ++u) {
            const int s = s0 + u;
            const int ci = GLA_CHUNK(s), tb = base + ci * 64;
            const bool second = (s >= half);
            if (s == half) GLA_OLOAD(u, s);
            if (s + 1 < nch && s + 1 > half) GLA_OLOAD(u ^ 1, s + 1);
            asm volatile("" ::: "memory");
            if (s + 2 < nch) GLA_LOAD(u, GLA_CHUNK(s + 2));
            { bf16x8 qa[4];
#pragma unroll
            for (int ks = 0; ks < 4; ++ks) qa[ks] = *(const LAS bf16x8*)(sQ + (16 * wv + fr) * 136 + 32 * ks + 8 * fq);
#pragma unroll
            for (int jt = 0; jt < 4; ++jt) {
                bf16x8 kb[4];
#pragma unroll
                for (int ks = 0; ks < 4; ++ks) kb[ks] = *(const LAS bf16x8*)(sK + (16 * jt + fr) * 136 + 32 * ks + 8 * fq);
                f32x4 acc = (f32x4){0.f, 0.f, 0.f, 0.f};
#pragma unroll
                for (int ks = 0; ks < 4; ++ks) acc = __builtin_amdgcn_mfma_f32_16x16x32_bf16(qa[ks], kb[ks], acc, 0, 0, 0);
#pragma unroll
                for (int e = 0; e < 4; ++e) { const int i = 16 * wv + 4 * fq + e, j = 16 * jt + fr; const bool keep = grp == 0 ? (j <= i) : (j >= i); sP[i * 72 + j] = f2bf(keep ? acc[e] : 0.f); }
            } }
            asm volatile("" ::: "memory");
            bf16x8 vf[4][2];
#pragma unroll
            for (int vt = 0; vt < 4; ++vt)
#pragma unroll
                for (int ks = 0; ks < 2; ++ks) vf[vt][ks] = tr_frag(sV, 72, 32 * ks, 16 * vt, fr, fq);
#pragma unroll
            for (int dt = 0; dt < 2; ++dt) {
                bf16x8 kf[2];
#pragma unroll
                for (int ks = 0; ks < 2; ++ks) kf[ks] = tr_frag(sK, 136, 32 * ks, 16 * (2 * wv + dt), fr, fq);
                const f32x4 tt = *(const LAS f32x4*)(sTot + 16 * (2 * wv + dt) + 4 * fq);
                const f32x4 sc = (f32x4){__expf(tt[0]), __expf(tt[1]), __expf(tt[2]), __expf(tt[3])};
#pragma unroll
                for (int vt = 0; vt < 4; ++vt) {
#pragma unroll
                    for (int ks = 0; ks < 2; ++ks) accS[dt][vt] = __builtin_amdgcn_mfma_f32_16x16x32_bf16(kf[ks], vf[vt][ks], accS[dt][vt], 0, 0, 0);
                    accS[dt][vt] = accS[dt][vt] * sc;
                }
            }
            asm volatile("s_waitcnt lgkmcnt(0)" ::: "memory");
            {
                bf16x8 pf[2];
#pragma unroll
                for (int ks = 0; ks < 2; ++ks) pf[ks] = *(const LAS bf16x8*)(sP + (16 * wv + fr) * 72 + 32 * ks + 8 * fq);
                bf16x8 qf[4];
#pragma unroll
                for (int ks = 0; ks < 4; ++ks) qf[ks] = *(const LAS bf16x8*)(sQ + (16 * wv + fr) * 136 + 32 * ks + 8 * fq);
#pragma unroll
                for (int vt = 0; vt < 4; ++vt) {
                    f32x4 acc = (f32x4){0.f, 0.f, 0.f, 0.f};
#pragma unroll
                    for (int ks = 0; ks < 2; ++ks) acc = __builtin_amdgcn_mfma_f32_16x16x32_bf16(vf[vt][ks], pf[ks], acc, 0, 0, 0);
#pragma unroll
                    for (int ks = 0; ks < 4; ++ks) { const bf16x8 sf = *(const LAS bf16x8*)(sS + (16 * vt + fr) * 136 + 32 * ks + 8 * fq);
                        acc = __builtin_amdgcn_mfma_f32_16x16x32_bf16(sf, qf[ks], acc, 0, 0, 0); }
                    { u32x2 pv = oprev[u][vt]; asm volatile("" : "+v"(pv));
                      if (second) acc = acc + (f32x4){bflo(pv.x), bfhi(pv.x), bflo(pv.y), bfhi(pv.y)}; }
                    store4bf(O + (size_t)(tb + 16 * wv + fr) * 1024 + h * 256 + vs * 64 + 16 * vt + 4 * fq, acc);
                }
            }
            LDS_BAR();
#pragma unroll
            for (int dt = 0; dt < 2; ++dt)
#pragma unroll
                for (int vt = 0; vt < 4; ++vt) { u32x2 w; w.x = pk_bf16(accS[dt][vt][0], accS[dt][vt][1]); w.y = pk_bf16(accS[dt][vt][2], accS[dt][vt][3]);
                    *(LAS u32x2*)(sS + (16 * vt + fr) * 136 + 16 * (2 * wv + dt) + 4 * fq) = w; }
            if (s + 1 < nch) GLA_STORE(u ^ 1);
            if (s == half - 1) { asm volatile("s_waitcnt vmcnt(0)" ::: "memory"); __syncthreads(); } else LDS_BAR();
          }
        }
        if (!sample) {
#pragma unroll
            for (int dt = 0; dt < 2; ++dt)
#pragma unroll
                for (int vt = 0; vt < 4; ++vt) { float* op = OST + (((((size_t)sb * 2 + l) * 2 + grp) * 4 + h) * 128 + 16 * (2 * wv + dt) + 4 * fq) * 256 + vs * 64 + 16 * vt + fr;
#pragma unroll
                    for (int e = 0; e < 4; ++e) op[(size_t)e * 256] = accS[dt][vt][e]; }
        }
    }
#undef GLA_LOAD
#undef GLA_STORE
#undef GLA_OLOAD
#undef GLA_CHUNK
}

__device__ __forceinline__ void phase_glapost(const P& p, int l) {
    const int lane = tid_() & 63, gw = bid_() * 8 + (tid_() >> 6), nw = gridDim.x * 8;
    bf16_t* O = (bf16_t*)(p.ws + WS_R1); const bf16_t* R = (const bf16_t*)(p.ws + WS_R3);
    const float* gn = p.in[lnd(13)] + (size_t)l * 256 + (lane & 15) * 16;
    for (int row = gw; row < TOK; row += nw) {
        const size_t o = (size_t)row * 1024 + lane * 16; float x[16], r[16];
#pragma unroll
        for (int hh = 0; hh < 2; ++hh) { const u32x4 a = *(const u32x4*)(O + o + 8 * hh), c = *(const u32x4*)(R + o + 8 * hh);
            x[8 * hh + 0] = bflo(a.x); x[8 * hh + 1] = bfhi(a.x); x[8 * hh + 2] = bflo(a.y); x[8 * hh + 3] = bfhi(a.y); x[8 * hh + 4] = bflo(a.z); x[8 * hh + 5] = bfhi(a.z); x[8 * hh + 6] = bflo(a.w); x[8 * hh + 7] = bfhi(a.w);
            r[8 * hh + 0] = bflo(c.x); r[8 * hh + 1] = bfhi(c.x); r[8 * hh + 2] = bflo(c.y); r[8 * hh + 3] = bfhi(c.y); r[8 * hh + 4] = bflo(c.z); r[8 * hh + 5] = bfhi(c.z); r[8 * hh + 6] = bflo(c.w); r[8 * hh + 7] = bfhi(c.w); }
        float ss = 0.f;
#pragma unroll
        for (int e = 0; e < 16; ++e) ss += x[e] * x[e];
        ss += __shfl_xor(ss, 1); ss += __shfl_xor(ss, 2); ss += __shfl_xor(ss, 4); ss += __shfl_xor(ss, 8);
        const float rstd = rsqrtf(ss * (1.0f / 256.0f) + 1e-6f);
        float y[16];
#pragma unroll
        for (int e = 0; e < 16; ++e) y[e] = x[e] * rstd * gn[e] * r[e];
#pragma unroll
        for (int hh = 0; hh < 2; ++hh) { u32x4 w; w.x = pk_bf16(y[8 * hh], y[8 * hh + 1]); w.y = pk_bf16(y[8 * hh + 2], y[8 * hh + 3]); w.z = pk_bf16(y[8 * hh + 4], y[8 * hh + 5]); w.w = pk_bf16(y[8 * hh + 6], y[8 * hh + 7]); *(u32x4*)(O + o + 8 * hh) = w; }
    }
}


#define XB_TMO      128
#define XB_XCNT(j)  (256  + 64 * (j))
#define XB_XSUB(j)  (1280 + 64 * (j))
#define XB_XGEN(j)  (2304 + 64 * (j))
#define XB_TOP      3328
#define XB_TOPGEN   3392
#define XCD_BAR_WORDS 3456
#define XB_SPIN_CAP (1u << 18)
__device__ __forceinline__ unsigned xb_ld(unsigned* p)              { return __hip_atomic_load(p, __ATOMIC_RELAXED, __HIP_MEMORY_SCOPE_AGENT); }
__device__ __forceinline__ unsigned xb_add(unsigned* p, unsigned v) { return __hip_atomic_fetch_add(p, v, __ATOMIC_RELAXED, __HIP_MEMORY_SCOPE_AGENT); }
__device__ __forceinline__ unsigned xb_xcc_id() { return (unsigned)__builtin_amdgcn_s_getreg((3 << 11) | 20) & 0xFu; }
#define XB_SPIN(cond, bar) do { unsigned _sp = 0; while (cond) { __builtin_amdgcn_s_sleep(1); \
    if ((++_sp & 255u) == 0u) { if (xb_ld(&(bar)[XB_TMO])) break; if (_sp > XB_SPIN_CAP) { atomicAdd(&(bar)[XB_TMO], 1u); break; } } } } while (0)
struct XcdBarrier { unsigned* bar; unsigned x; volatile LAS unsigned* st; };
__device__ __forceinline__ XcdBarrier xcd_barrier_post(unsigned* bar, volatile LAS unsigned* st) {
    XcdBarrier b; b.bar = bar; b.x = xb_xcc_id(); b.st = st;
    if (threadIdx.x == 0) (void)xb_add(&bar[XB_XCNT(b.x)], 1u);
    return b;
}
__device__ __forceinline__ void xcd_barrier_complete(unsigned* bar, unsigned x, unsigned& nloc, unsigned& nx) {
    const unsigned G = gridDim.x * gridDim.y * gridDim.z;
    unsigned sum, cnt, mine, sp = 0u;
    for (;;) {
        sum = 0u; cnt = 0u; mine = 0u;
#pragma unroll
        for (unsigned j = 0; j < 16; ++j) { const unsigned c = xb_ld(&bar[XB_XCNT(j)]); sum += c; cnt += (c > 0u) ? 1u : 0u; mine = (j == x) ? c : mine; }
        if (sum == G) break;
        __builtin_amdgcn_s_sleep(1);
        if ((++sp & 255u) == 0u) { if (xb_ld(&bar[XB_TMO])) break; if (sp > XB_SPIN_CAP) { atomicAdd(&bar[XB_TMO], 1u); break; } }
    }
    nloc = mine > 0u ? mine : 1u; nx = cnt > 0u ? cnt : 1u;
}
__device__ __forceinline__ void xcd_barrier(const XcdBarrier& b) {
    asm volatile("s_waitcnt vmcnt(0)" ::: "memory");
    __syncthreads();
    if (threadIdx.x == 0) {
        unsigned* bar = b.bar;
        __builtin_amdgcn_s_waitcnt(0);
        unsigned nloc = b.st[0], nx = b.st[1];
        if (nloc == 0u) { xcd_barrier_complete(bar, b.x, nloc, nx); b.st[0] = nloc; b.st[1] = nx; }
        const unsigned old = xb_add(&bar[XB_XSUB(b.x)], 1u);
        const unsigned gen = old / nloc;
        if (old + 1u == (gen + 1u) * nloc) {
            __builtin_amdgcn_fence(__ATOMIC_RELEASE, "agent");
            asm volatile("s_waitcnt vmcnt(0)" ::: "memory");
            const unsigned og = xb_add(&bar[XB_TOP], 1u);
            const unsigned tg = og / nx;
            if (og + 1u == (tg + 1u) * nx) xb_add(&bar[XB_TOPGEN], 1u);
            else XB_SPIN(xb_ld(&bar[XB_TOPGEN]) == tg, bar);
            __builtin_amdgcn_fence(__ATOMIC_ACQUIRE, "agent");
            xb_add(&bar[XB_XGEN(b.x)], 1u);
            asm volatile("s_waitcnt vmcnt(0)" ::: "memory");
        } else {
            XB_SPIN(xb_ld(&bar[XB_XGEN(b.x)]) == gen, bar);
            __builtin_amdgcn_fence(__ATOMIC_ACQUIRE, "agent");
            asm volatile("s_waitcnt vmcnt(0)" ::: "memory");
        }
    }
    __syncthreads();
}

__device__ __forceinline__ void run_phase(const P& p, int ph, LAS unsigned char* lds) {
    if (ph == 2 * PPL) { if (EN(34)) phase_final(p); return; }
    const int l = ph / PPL, q = ph % PPL;
    unsigned char* ws = p.ws; bf16_t* W = (bf16_t*)(ws + WS_W);
    const int G = gridDim.x, c = bid_();
    pg8::Order S;
    switch (q) {
        case 0: if (EN(0)) { phase_prep(p, l, lds); if (l == 1) phase_norm(p, l, 1); } break;
        case 1: if (EN(1)) { if (l == 0) phase_norm(p, l, 1); } break;
        case 2: if (EN(2)) { pg8::Gemm g{(const bf16_t*)(ws + WS_R2), W + W_A / 2, TOK, 2816, 1024, 1024, 0, 0, 1}; S.init(TOK, 2816, 1, G, c);
            EpiPartA E{(bf16_t*)(ws + WS_R3), (bf16_t*)(ws + WS_R3) + (size_t)TOK * 512, (bf16_t*)(ws + WS_R4), (bf16_t*)(ws + WS_R5), (float*)(ws + WS_GLR)};
            pg8::gemm_phase(lds, g, S, E); } break;
        case 3: if (EN(3)) { pg8::Gemm g{(const bf16_t*)(ws + WS_R5), (const bf16_t*)(ws + WS_EMAT), 1280, 256, 512, 768, (size_t)1280 * 768, (size_t)256 * 512, 32}; S.init(1280, 256, 32, G, c);
            EpiE E{(float*)(ws + WS_E)}; pg8::gemm_phase(lds, g, S, E); } break;
        case 4: if (EN(4)) phase_s5scan(p, l); break;
        case 5: if (EN(5)) { pg8::Gemm g{(const bf16_t*)(ws + WS_R5), (const bf16_t*)(ws + WS_R1), 1280, 512, 768, 768, (size_t)1280 * 768, (size_t)512 * 768, 32}; S.init(1280, 512, 32, G, c);
            EpiY E{(bf16_t*)(ws + WS_E)}; pg8::gemm_phase(lds, g, S, E); } break;
        case 6: if (EN(6)) { pg8::Gemm g{(const bf16_t*)(ws + WS_E), W + W_GLU / 2, TOK, 512, 512, 512, 0, 0, 1}; S.init(TOK, 512, 1, G, c);
            EpiGLU E{(const bf16_t*)(ws + WS_E), (bf16_t*)(ws + WS_R6), p.in[lnd(24)] + (size_t)l * 512}; pg8::gemm_phase(lds, g, S, E); } break;
        case 7: if (EN(7)) phase_glapre(p, l, lds); break;
        case 8: if (EN(8)) phase_gla(p, l, lds); break;
        case 9: if (EN(9)) { pg8::Gemm g{(const bf16_t*)(ws + WS_R2), W + W_B / 2, TOK, 3072, 1024, 1024, 0, 0, 1}; S.init(TOK, 3072, 1, G, c);
            EpiPartB E{(bf16_t*)(ws + WS_R3), (bf16_t*)(ws + WS_R4), (bf16_t*)(ws + WS_R5)}; pg8::gemm_phase(lds, g, S, E); } break;
        case 10: if (EN(10)) phase_glapost(p, l); break;
        case 11: if (EN(11)) { pg8::Gemm g{(const bf16_t*)(ws + WS_R1), W + W_PG / 2, TOK, 1024, 1024, 1024, 0, 0, 1}; S.init(TOK, 1024, 1, G, c);
              EpiProj1 E{(const bf16_t*)(ws + WS_R4), (bf16_t*)(ws + WS_R2)}; pg8::gemm_phase(lds, g, S, E); } break;
        case 12: if (EN(12)) { pg8::Gemm g{(const bf16_t*)(ws + WS_R6), W + W_PS / 2, TOK, 1024, 512, 512, 0, 0, 1}; S.init(TOK, 1024, 1, G, c);
              EpiProj2 E{(const bf16_t*)(ws + WS_R5), (bf16_t*)(ws + WS_R2)}; pg8::gemm_phase(lds, g, S, E); } break;
        case 13: if (EN(13)) { pg8::Gemm g{(const bf16_t*)(ws + WS_R2), W + W_OUT / 2, TOK, 1024, 1024, 1024, 0, 0, 1}; S.init(TOK, 1024, 1, G, c);
            EpiDelta E{(bf16_t*)(ws + WS_R3), (const float*)(ws + WS_MOD) + (size_t)l * 9 * 6144 + 2048}; pg8::gemm_phase(lds, g, S, E); } break;
        case 14: if (EN(14)) phase_norm(p, l, 2); break;
        case 15: if (EN(15)) { pg8::Gemm g{(const bf16_t*)(ws + WS_R2), W + W_1 / 2, TOK, 4096, 1024, 1024, 0, 0, 1}; S.init(TOK, 4096, 1, G, c);
            EpiFF1 E{(bf16_t*)(ws + WS_HID)}; pg8::gemm_phase(lds, g, S, E); } break;
        case 16: if (EN(16)) { pg8::Gemm g{(const bf16_t*)(ws + WS_HID), W + W_2 / 2, TOK, 1024, 4096, 4096, 0, 0, 1}; S.init(TOK, 1024, 1, G, c);
            EpiDelta E{(bf16_t*)(ws + WS_R2), (const float*)(ws + WS_MOD) + (size_t)l * 9 * 6144 + 5120}; pg8::gemm_phase(lds, g, S, E); } break;
        default: break;
    }
}

__global__ void __launch_bounds__(NTHR, 2) fwd_megakernel(P p) {
    extern __shared__ __attribute__((aligned(16))) unsigned char lds_raw[];
    LAS unsigned char* lds = (LAS unsigned char*)lds_raw;
#if MULTI_LAUNCH
    for (int ph = p.ph_lo; ph < p.ph_hi; ++ph) run_phase(p, ph, lds);
#else
    cg::grid_group grid = cg::this_grid();
    if (p.ph_lo < 0) grid.sync();
    volatile LAS unsigned* stw = (volatile LAS unsigned*)(lds + LDS_BYTES - 16);
    if (threadIdx.x < 4) stw[threadIdx.x] = 0u;
    __syncthreads();
    const XcdBarrier bar = xcd_barrier_post((unsigned*)(p.ws + WS_BAR), stw);
    for (int ph = p.ph_lo; ph < p.ph_hi; ++ph) {
        run_phase(p, ph, lds);
#if REP_MASK
        if (ph < 2 * PPL && ((REP_MASK >> (ph % PPL)) & 1)) {
            xcd_barrier(bar);
            if ((ph % PPL) == 12) { run_phase(p, ph - 1, lds); }
            run_phase(p, ph, lds);
        }
#endif
        if (ph + 1 < p.ph_hi && (ph % PPL) != 11 && ph != PPL) xcd_barrier(bar);
    }
#endif
}

extern "C" void kernel_launch(void* const* d_in, const int* in_sizes, int n_in, void* d_out, int out_size, void* d_ws, size_t ws_size, hipStream_t stream) {
    static int grid = 0;
    if (grid == 0) {
        if (n_in != 31 || ws_size < WS_END) { fprintf(stderr, "kernel_launch: unexpected n_in %d or ws_size %zu (< %zu)\n", n_in, ws_size, (size_t)WS_END); grid = -1; return; }
        int dev = 0, cus = 0, per_cu = 0;
        hipGetDevice(&dev);
        hipDeviceGetAttribute(&cus, hipDeviceAttributeMultiprocessorCount, dev);
        if (hipFuncSetAttribute((const void*)fwd_megakernel, hipFuncAttributeMaxDynamicSharedMemorySize, LDS_BYTES) != hipSuccess) { fprintf(stderr, "kernel_launch: hipFuncSetAttribute failed\n"); grid = -1; return; }
        hipOccupancyMaxActiveBlocksPerMultiprocessor(&per_cu, (const void*)fwd_megakernel, NTHR, LDS_BYTES);
        (void)hipGetLastError();
        if (per_cu < 1) fprintf(stderr, "kernel_launch: occupancy query says %d blocks per CU\n", per_cu);
        grid = cus > 0 ? cus : 256;
    }
    if (grid < 0) return;
    P p{};
    for (int i = 0; i < 31; ++i) p.in[i] = (const float*)d_in[i];
    p.out = (float*)d_out; p.ws = (unsigned char*)d_ws;
#if MULTI_LAUNCH
    for (int ph = 0; ph < NPHASE; ++ph) { p.ph_lo = ph; p.ph_hi = ph + 1; hipLaunchKernelGGL(fwd_megakernel, dim3(grid), dim3(NTHR), LDS_BYTES, stream, p); }
#else
    p.ph_lo = 0; p.ph_hi = NPHASE;
    (void)hipMemsetAsync((char*)d_ws + WS_BAR, 0, XCD_BAR_WORDS * sizeof(unsigned), stream);
    void* args[] = {&p};
    hipError_t e = hipLaunchCooperativeKernel((const void*)fwd_megakernel, dim3(grid), dim3(NTHR), args, LDS_BYTES, stream);
    if (e != hipSuccess) fprintf(stderr, "cooperative launch failed: %s (grid %d)\n", hipGetErrorString(e), grid);
#endif
}
```

```cpp
#include <hip/hip_runtime.h>
#include <hip/hip_cooperative_groups.h>
#include <cstdio>
namespace cg = cooperative_groups;

#ifndef MULTI_LAUNCH
#define MULTI_LAUNCH 0
#endif

#ifndef REP_MASK
#define REP_MASK 0
#endif
#ifndef PHASE_SEL
#define PHASE_SEL -1
#endif
#define EN(q) (PHASE_SEL < 0 || PHASE_SEL == (q))
#define LAS __attribute__((address_space(3)))
typedef unsigned short bf16_t;
typedef short bf16x8 __attribute__((ext_vector_type(8)));
typedef float f32x4 __attribute__((ext_vector_type(4)));
typedef unsigned u32x4 __attribute__((ext_vector_type(4)));
typedef unsigned u32x2 __attribute__((ext_vector_type(2)));

constexpr int NTHR = 512;
constexpr int TOK = 40960, TOKP = 8192;
constexpr int LDS_BYTES = 147456;
constexpr int NPHASE = 35;
constexpr int PPL = 17;

constexpr size_t MiB = (size_t)1 << 20;
constexpr size_t WS_MOD = 0;
constexpr size_t WS_GLR = 1 * MiB;
constexpr size_t WS_TOTF = 7 * MiB;
constexpr size_t WS_TOTB = 9 * MiB;
constexpr size_t WS_BAR = 12 * MiB;
constexpr size_t WS_W = 16 * MiB;
constexpr size_t W_A = 0;
constexpr size_t W_B = W_A + (size_t)2816 * 1024 * 2;
constexpr size_t W_PG = W_B + (size_t)3072 * 1024 * 2;
constexpr size_t W_GLU = W_PG + (size_t)1024 * 1024 * 2;
constexpr size_t W_PS = W_GLU + (size_t)512 * 512 * 2;
constexpr size_t W_OUT = W_PS + (size_t)1024 * 512 * 2;
constexpr size_t W_1 = W_OUT + (size_t)1024 * 1024 * 2;
constexpr size_t W_2 = W_1 + (size_t)4096 * 1024 * 2;
constexpr size_t WS_R2 = 50 * MiB;
constexpr size_t WS_R3 = 130 * MiB;
constexpr size_t WS_R4 = 210 * MiB;
constexpr size_t WS_R5 = 290 * MiB;
constexpr size_t WS_E = 350 * MiB;
constexpr size_t WS_R6 = 390 * MiB;
constexpr size_t WS_R1 = 430 * MiB;
constexpr size_t WS_EMAT = 454 * MiB;
constexpr size_t WS_HID = 130 * MiB;
constexpr size_t WS_END = 510 * MiB;

struct P { const float* in[31]; float* out; unsigned char* ws; int ph_lo, ph_hi; };

__device__ __forceinline__ int tid_() { int t = threadIdx.x; asm volatile("" : "+v"(t)); return t; }
__device__ __forceinline__ int bid_() { int b = blockIdx.x; asm volatile("" : "+s"(b)); return b; }
__device__ __forceinline__ int lnd(int k) { asm volatile("" : "+s"(k)); return k; }
__device__ __forceinline__ unsigned pk_bf16(float lo, float hi) { unsigned r; asm("v_cvt_pk_bf16_f32 %0, %1, %2" : "=v"(r) : "v"(lo), "v"(hi)); return r; }
__device__ __forceinline__ float bf2f(bf16_t b) { return __uint_as_float(((unsigned)b) << 16); }
__device__ __forceinline__ float bflo(unsigned w) { return __uint_as_float(w << 16); }
__device__ __forceinline__ float bfhi(unsigned w) { return __uint_as_float(w & 0xffff0000u); }
__device__ __forceinline__ bf16_t f2bf(float f) { return (bf16_t)(pk_bf16(f, 0.f) & 0xffffu); }
__device__ __forceinline__ float sigmoidf_(float x) { return 1.0f / (1.0f + __expf(-x)); }
__device__ __forceinline__ void store4bf(bf16_t* ptr, f32x4 v) { u32x2 w; w.x = pk_bf16(v[0], v[1]); w.y = pk_bf16(v[2], v[3]); *(u32x2*)ptr = w; }
__device__ __forceinline__ f32x4 load4bf(const bf16_t* ptr) { u32x2 w = *(const u32x2*)ptr; return (f32x4){bflo(w.x), bfhi(w.x), bflo(w.y), bfhi(w.y)}; }
__device__ __forceinline__ int mod_index(int tok) { return tok < TOKP ? 0 : (tok >> 12) - 1; }
__device__ __forceinline__ float wave_sum(float v) {
#pragma unroll
    for (int o = 32; o >= 1; o >>= 1) v += __shfl_xor(v, o);
    return v;
}

namespace pg8 {
constexpr int BM = 256, BK = 64, HALF = 128, HTB = HALF * BK * 2, STAGE_BYTES = 8 * HTB, NXCD = 8, WGM = 8;
__device__ __forceinline__ int lds_byte(int r, int c) { const int st = (r >> 4) * 2 + (c >> 5), rr = r & 15, cc = c & 31, ob = rr * 64 + cc * 2; return st * 1024 + (ob ^ (((ob >> 9) & 1) << 5)); }
__device__ __forceinline__ void stage_rc(int b, int& R, int& C) { const int st = b / 1024, sb = b % 1024, swz = sb ^ (((sb >> 9) & 1) << 5); R = (st >> 1) * 16 + swz / 64; C = (st & 1) * 32 + (swz % 64) / 2; }

struct Unit { int pm, pn, z, hf; };
struct Gemm { const bf16_t* A; const bf16_t* Bt; int M, N, K, lda; size_t sA, sB; int nz; };
struct Order {
    int nM, nN, nwg, G, c, nz, nfull, rem2;
    __device__ __forceinline__ void init(int M, int N, int nz_, int G_, int c_) { nM = M / BM; nN = N / BM; nwg = nM * nN; G = G_; c = c_; nz = nz_;
        nfull = nwg; rem2 = 0;
        if (nz == 1) { const int full = (nwg / G) * G, rem = nwg - full; if (rem > 0 && 2 * rem <= G) { nfull = full; rem2 = 2 * rem; } } }
    __device__ __forceinline__ void map(int wgid, Unit& u) const {
        { const int q = nwg / NXCD, r = nwg % NXCD, xcd = wgid % NXCD, off = wgid / NXCD; wgid = (xcd < r ? xcd * (q + 1) : r * (q + 1) + (xcd - r) * q) + off; }
        const int nig = WGM * nN, gid = wgid / nig, fm = gid * WGM, gsz = (nM - fm) < WGM ? (nM - fm) : WGM;
        u.pm = fm + ((wgid % nig) % gsz); u.pn = (wgid % nig) / gsz; u.z = 0; }
    __device__ __forceinline__ bool next(int i, Unit& u) const {
        const long L = (long)i * G + c;
        if (nz == 1) {
            if (L < nfull) { map((int)L, u); u.hf = 0; return true; }
            const int t = (int)(L - nfull); if (t >= rem2) return false;
            map(nfull + (t >> 1), u); u.hf = 1 + (t & 1); return true;
        }
        if (L >= (long)nwg * nz) return false;
        const int z = (int)(L / nwg), r = (int)(L % nwg); u.z = z; u.pm = r % nM; u.pn = r / nM; u.hf = 0;
        return true;
    }
};

template <class Epi>
__device__ __forceinline__ void gemm_phase(LAS unsigned char* lds, const Gemm g, const Order& S, const Epi& E) {
    const int tid = tid_(), wid = __builtin_amdgcn_readfirstlane(tid >> 6), lane = tid & 63, wr = wid >> 2, wc = wid & 3, fr = lane & 15, fq = lane >> 4;
    const int K = g.K, nt = K / BK;
    unsigned voffA[2], voffB[2];
#pragma unroll
    for (int i = 0; i < 2; ++i) { int R, C; stage_rc(tid * 16 + i * 8192, R, C); voffA[i] = (unsigned)(R * g.lda + C) * 2u; voffB[i] = (unsigned)(R * K + C) * 2u; }
    const size_t kstep = (size_t)(BK * 2);
    const size_t hstepA = (size_t)HALF * g.lda * 2, hstepB = (size_t)HALF * K * 2;
    const unsigned ldsw = (unsigned)wid * 1024u;
    const int aoff = lds_byte(wr * 64 + fr, fq * 8), boff = lds_byte(wc * 32 + fr, fq * 8);
#define PG8_SA(b, h) (((b) * 2 + (h)) * HTB)
#define PG8_SB(b, h) ((4 + (b) * 2 + (h)) * HTB)
#define PG8_STAGE(bufoff, gbase, voff) do { _Pragma("unroll") for (int _i = 0; _i < 2; ++_i) \
        __builtin_amdgcn_global_load_lds((const unsigned*)((const char*)(gbase) + (voff)[_i]), (LAS unsigned*)(lds + (bufoff) + ldsw + _i * 8192), 16, 0, 0); } while (0)
#define PG8_LDA(dst, b, h) do { _Pragma("unroll") for (int m = 0; m < 4; ++m) _Pragma("unroll") for (int k = 0; k < 2; ++k) dst[m][k] = *(const LAS bf16x8*)(lds + PG8_SA(b, h) + aoff + m * 2048 + k * 1024); } while (0)
#define PG8_LDB(dst, b, h) do { _Pragma("unroll") for (int n = 0; n < 2; ++n) _Pragma("unroll") for (int k = 0; k < 2; ++k) dst[n][k] = *(const LAS bf16x8*)(lds + PG8_SB(b, h) + boff + n * 2048 + k * 1024); } while (0)
#define PG8_MMA(ai, bj, At, Bt) do { __builtin_amdgcn_s_setprio(1); _Pragma("unroll") for (int m = 0; m < 4; ++m) _Pragma("unroll") for (int n = 0; n < 2; ++n) _Pragma("unroll") for (int k = 0; k < 2; ++k) \
        acc[ai][bj][m][n] = __builtin_amdgcn_mfma_f32_16x16x32_bf16(Bt[n][k], At[m][k], acc[ai][bj][m][n], 0, 0, 0); __builtin_amdgcn_s_setprio(0); } while (0)
#define PG8_WAIT_V(n) asm volatile("s_waitcnt vmcnt(" #n ")" ::: "memory")
#define PG8_WAIT_L(n) asm volatile("s_waitcnt lgkmcnt(" #n ")" ::: "memory")
#define PG8_BAR __builtin_amdgcn_s_barrier()
#define PG8_SCHED __builtin_amdgcn_sched_barrier(0)
    Unit cur, nxt; int ui = 0;
    if (!S.next(0, cur)) return;
    f32x4 acc[2][2][4][2];
#pragma unroll
    for (int a = 0; a < 2; ++a)
#pragma unroll
        for (int b = 0; b < 2; ++b)
#pragma unroll
            for (int m = 0; m < 4; ++m)
#pragma unroll
                for (int n = 0; n < 2; ++n) acc[a][b][m][n] = (f32x4){0.f, 0.f, 0.f, 0.f};
    bf16x8 At[4][2], B0[2][2], B1[2][2];
    const char* cA = (const char*)g.A + ((size_t)cur.z * g.sA + (size_t)(cur.pm * BM + (cur.hf == 2 ? HALF : 0)) * g.lda) * 2;
    const char* cB = (const char*)g.Bt + ((size_t)cur.z * g.sB + (size_t)cur.pn * BM * K) * 2;
    PG8_STAGE(PG8_SB(0, 0), cB, voffB); PG8_STAGE(PG8_SB(0, 1), cB + hstepB, voffB); PG8_STAGE(PG8_SA(0, 0), cA, voffA); PG8_STAGE(PG8_SA(0, 1), cA + hstepA, voffA);
    if (wr == 1) PG8_BAR;
    PG8_WAIT_V(2); PG8_BAR;
    PG8_STAGE(PG8_SB(1, 0), cB + kstep, voffB); PG8_STAGE(PG8_SA(1, 0), cA + kstep, voffA); PG8_STAGE(PG8_SB(1, 1), cB + hstepB + kstep, voffB);
    PG8_WAIT_V(6); PG8_BAR;
    for (;;) {
        const bool has_next = S.next(ui + 1, nxt);
        const char* nA = has_next ? (const char*)g.A + ((size_t)nxt.z * g.sA + (size_t)(nxt.pm * BM + (nxt.hf == 2 ? HALF : 0)) * g.lda) * 2 : cA;
        const bool fullu = (cur.hf == 0);
        const char* nB = has_next ? (const char*)g.Bt + ((size_t)nxt.z * g.sB + (size_t)nxt.pn * BM * K) * 2 : cB;
        for (int t = 0; t < nt; t += 2) {
            const bool last = (t == nt - 2);
            const char* a1 = cA + (size_t)(t + 1) * kstep;
            const char* a2 = last ? nA : cA + (size_t)(t + 2) * kstep; const char* b2 = last ? nB : cB + (size_t)(t + 2) * kstep;
            const char* a3 = a2 + kstep; const char* b3 = b2 + kstep;
            PG8_LDB(B0, 0, 0); PG8_LDB(B1, 0, 1); PG8_SCHED; PG8_LDA(At, 0, 0); PG8_STAGE(PG8_SA(1, 1), a1 + hstepA, voffA);
            PG8_WAIT_V(8); PG8_WAIT_L(0); PG8_BAR; PG8_MMA(0, 0, At, B0); PG8_MMA(0, 1, At, B1); PG8_BAR; PG8_SCHED;
            if (fullu) PG8_LDA(At, 0, 1); PG8_STAGE(PG8_SB(0, 0), b2, voffB); PG8_STAGE(PG8_SB(0, 1), b2 + hstepB, voffB); PG8_STAGE(PG8_SA(0, 0), a2, voffA);
            PG8_WAIT_V(8); PG8_WAIT_L(0); PG8_BAR; if (fullu) { PG8_MMA(1, 0, At, B0); PG8_MMA(1, 1, At, B1); } PG8_BAR; PG8_SCHED;
            PG8_LDB(B0, 1, 0); PG8_LDB(B1, 1, 1); PG8_SCHED; PG8_LDA(At, 1, 0); PG8_STAGE(PG8_SA(0, 1), a2 + hstepA, voffA);
            PG8_WAIT_V(8); PG8_WAIT_L(0); PG8_BAR; PG8_MMA(0, 0, At, B0); PG8_MMA(0, 1, At, B1); PG8_BAR; PG8_SCHED;
            if (fullu) PG8_LDA(At, 1, 1); PG8_STAGE(PG8_SB(1, 0), b3, voffB); PG8_STAGE(PG8_SB(1, 1), b3 + hstepB, voffB); PG8_STAGE(PG8_SA(1, 0), a3, voffA);
            PG8_WAIT_V(8); PG8_WAIT_L(0); PG8_BAR; if (fullu) { PG8_MMA(1, 0, At, B0); PG8_MMA(1, 1, At, B1); } PG8_BAR; PG8_SCHED;
        }
        if (wr == 0) PG8_BAR;
        if (fullu) E.template tile<2>(acc, cur.z, cur.pm * BM + wr * 64 + fr, cur.pn * BM + wc * 32 + (Epi::PERM ? 8 : 4) * fq);
        else E.template tile<1>(acc, cur.z, cur.pm * BM + (cur.hf == 2 ? HALF : 0) + wr * 64 + fr, cur.pn * BM + wc * 32 + (Epi::PERM ? 8 : 4) * fq);
        if (!has_next) break;
#pragma unroll
        for (int a = 0; a < 2; ++a)
#pragma unroll
            for (int b = 0; b < 2; ++b)
#pragma unroll
                for (int m = 0; m < 4; ++m)
#pragma unroll
                    for (int n = 0; n < 2; ++n) acc[a][b][m][n] = (f32x4){0.f, 0.f, 0.f, 0.f};
        cur = nxt; cA = nA; cB = nB; ++ui;
        if (wr == 1) PG8_BAR;
    }
    PG8_WAIT_V(0);
    PG8_BAR;
#undef PG8_SA
#undef PG8_SB
#undef PG8_STAGE
#undef PG8_LDA
#undef PG8_LDB
#undef PG8_MMA
#undef PG8_WAIT_V
#undef PG8_WAIT_L
#undef PG8_BAR
#undef PG8_SCHED
}
}

#define EPI_SIMPLE_TILE() \
    static constexpr bool PERM = false; \
    template <int NAI> __device__ __forceinline__ void tile(const f32x4 (&acc)[2][2][4][2], int z, int row0, int col0) const { \
        _Pragma("unroll") for (int ai = 0; ai < NAI; ++ai) _Pragma("unroll") for (int m = 0; m < 4; ++m) _Pragma("unroll") for (int bj = 0; bj < 2; ++bj) _Pragma("unroll") for (int n = 0; n < 2; ++n) \
            (*this)(z, row0 + ai * 128 + m * 16, col0 + bj * 128 + n * 16, acc[ai][bj][m][n]); }
#define EPI_PAIR_TILE() \
    static constexpr bool PERM = true; \
    template <int NAI> __device__ __forceinline__ void tile(const f32x4 (&acc)[2][2][4][2], int z, int row0, int col0) const { \
        _Pragma("unroll") for (int ai = 0; ai < NAI; ++ai) _Pragma("unroll") for (int m = 0; m < 4; ++m) _Pragma("unroll") for (int bj = 0; bj < 2; ++bj) \
            pair(row0 + ai * 128 + m * 16, col0 + bj * 128, acc[ai][bj][m][0], acc[ai][bj][m][1]); }
#define EPI_PIPE_TILE() \
    static constexpr bool PERM = true; \
    template <int NAI> __device__ __forceinline__ void tile(const f32x4 (&acc)[2][2][4][2], int z, int row0, int col0) const { \
        Pre pre; begin(row0, col0, pre); L buf[2][8]; \
        _Pragma("unroll") for (int mm = 0; mm < 2; ++mm) _Pragma("unroll") for (int bj = 0; bj < 2; ++bj) _Pragma("unroll") for (int n = 0; n < 2; ++n) load(row0 + mm * 16, col0 + bj * 128 + n * 4, buf[0][mm * 4 + bj * 2 + n]); \
        _Pragma("unroll") for (int b = 0; b < 2 * NAI; ++b) { \
            if (b < 2 * NAI - 1) { _Pragma("unroll") for (int mm = 0; mm < 2; ++mm) _Pragma("unroll") for (int bj = 0; bj < 2; ++bj) _Pragma("unroll") for (int n = 0; n < 2; ++n) \
                load(row0 + ((b + 1) >> 1) * 128 + (((b + 1) & 1) * 2 + mm) * 16, col0 + bj * 128 + n * 4, buf[(b + 1) & 1][mm * 4 + bj * 2 + n]); } \
            _Pragma("unroll") for (int mm = 0; mm < 2; ++mm) _Pragma("unroll") for (int bj = 0; bj < 2; ++bj) _Pragma("unroll") for (int n = 0; n < 2; ++n) \
                apply(row0 + (b >> 1) * 128 + ((b & 1) * 2 + mm) * 16, col0 + bj * 128 + n * 4, acc[b >> 1][bj][(b & 1) * 2 + mm][n], buf[b & 1][mm * 4 + bj * 2 + n], pre, bj * 2 + n); } }
__device__ __forceinline__ void store8bf(bf16_t* ptr, f32x4 a, f32x4 b) { u32x4 w; w.x = pk_bf16(a[0], a[1]); w.y = pk_bf16(a[2], a[3]); w.z = pk_bf16(b[0], b[1]); w.w = pk_bf16(b[2], b[3]); *(u32x4*)ptr = w; }

struct EpiPartA {
    bf16_t* Q; bf16_t* Kk; bf16_t* V; bf16_t* UG; float* GLR;
    __device__ __forceinline__ void pair(int row, int col, f32x4 a, f32x4 b) const {
        if (col < 512) store8bf(Q + (size_t)row * 512 + col, a, b);
        else if (col < 1024) store8bf(Kk + (size_t)row * 512 + (col - 512), a, b);
        else if (col < 2048) store8bf(V + (size_t)row * 1024 + (col - 1024), a, b);
        else if (col < 2304) { const int c = col - 2048; if (c < 32) { *(f32x4*)(GLR + (size_t)row * 32 + c) = a; *(f32x4*)(GLR + (size_t)row * 32 + c + 4) = b; } }
        else { const int c = col - 2304, g = c >> 4, n = c & 15, chunk = row >> 5, j = row & 31; store8bf(UG + ((size_t)(g * 1280 + chunk) * 768 + j * 16 + n), a, b); }
    }
    EPI_PAIR_TILE()
};
struct EpiE { float* E; __device__ __forceinline__ void operator()(int z, int row, int col, f32x4 v) const { *(f32x4*)(E + ((size_t)(z * 1280 + row) * 256 + col)) = v; } EPI_SIMPLE_TILE() };
struct EpiY {
    bf16_t* YB;
    __device__ __forceinline__ void operator()(int z, int row, int col, f32x4 v) const {
        const int tok = row * 32 + (col >> 4), ch = z * 16 + (col & 15);
        f32x4 o;
#pragma unroll
        for (int e = 0; e < 4; ++e) { const float x = v[e]; o[e] = x * sigmoidf_(1.5957691216f * (x + 0.044715f * x * x * x)); }
        store4bf(YB + (size_t)tok * 512 + ch, o);
    }
    EPI_SIMPLE_TILE()
};
struct EpiGLU {
    const bf16_t* YB; bf16_t* OS5; const float* bglu;
    typedef u32x2 L; struct Pre { f32x4 b[4]; };
    __device__ __forceinline__ void begin(int, int col0, Pre& pr) const {
#pragma unroll
        for (int k = 0; k < 4; ++k) pr.b[k] = *(const f32x4*)(bglu + col0 + (k >> 1) * 128 + (k & 1) * 4); }
    __device__ __forceinline__ void load(int row, int col, L& l) const { l = *(const u32x2*)(YB + (size_t)row * 512 + col); }
    __device__ __forceinline__ void apply(int row, int col, f32x4 v, const L& l, const Pre& pr, int k) const {
        const f32x4 y = (f32x4){bflo(l.x), bfhi(l.x), bflo(l.y), bfhi(l.y)}; f32x4 o;
#pragma unroll
        for (int e = 0; e < 4; ++e) o[e] = y[e] * sigmoidf_(v[e] + pr.b[k][e]);
        store4bf(OS5 + (size_t)row * 512 + col, o); }
    EPI_PIPE_TILE()
};
struct EpiPartB {
    bf16_t* R; bf16_t* GA; bf16_t* GB;
    __device__ __forceinline__ void pair(int row, int col, f32x4 a, f32x4 b) const {
        f32x4 sa, sb;
#pragma unroll
        for (int e = 0; e < 4; ++e) { sa[e] = sigmoidf_(a[e]); sb[e] = sigmoidf_(b[e]); }
        if (col < 1024) store8bf(R + (size_t)row * 1024 + col, a * sa, b * sb);
        else if (col < 2048) store8bf(GA + (size_t)row * 1024 + (col - 1024), sa, sb);
        else store8bf(GB + (size_t)row * 1024 + (col - 2048), sa, sb);
    }
    EPI_PAIR_TILE()
};
struct EpiProj1 { const bf16_t* GA; bf16_t* T1;
    typedef u32x2 L; struct Pre { int dummy; };
    __device__ __forceinline__ void begin(int, int, Pre&) const {}
    __device__ __forceinline__ void load(int row, int col, L& l) const { l = *(const u32x2*)(GA + (size_t)row * 1024 + col); }
    __device__ __forceinline__ void apply(int row, int col, f32x4 v, const L& l, const Pre&, int) const {
        const f32x4 g = (f32x4){bflo(l.x), bfhi(l.x), bflo(l.y), bfhi(l.y)}; store4bf(T1 + (size_t)row * 1024 + col, g * v); }
    EPI_PIPE_TILE()
};
struct EpiProj2 { const bf16_t* GB; bf16_t* T1;
    struct L { u32x2 t, g; }; struct Pre { int dummy; };
    __device__ __forceinline__ void begin(int, int, Pre&) const {}
    __device__ __forceinline__ void load(int row, int col, L& l) const { const size_t o = (size_t)row * 1024 + col; l.t = *(const u32x2*)(T1 + o); l.g = *(const u32x2*)(GB + o); }
    __device__ __forceinline__ void apply(int row, int col, f32x4 v, const L& l, const Pre&, int) const {
        const f32x4 g = (f32x4){bflo(l.g.x), bfhi(l.g.x), bflo(l.g.y), bfhi(l.g.y)}, t = (f32x4){bflo(l.t.x), bfhi(l.t.x), bflo(l.t.y), bfhi(l.t.y)};
        store4bf(T1 + (size_t)row * 1024 + col, t + g * v); }
    EPI_PIPE_TILE()
};
struct EpiDelta { bf16_t* Dl; const float* gate;
    static constexpr bool PERM = true;
    template <int NAI> __device__ __forceinline__ void tile(const f32x4 (&acc)[2][2][4][2], int, int row0, int col0) const {
        const float* gp = gate + (size_t)mod_index(row0) * 6144 + col0; f32x4 g[2][2];
#pragma unroll
        for (int bj = 0; bj < 2; ++bj)
#pragma unroll
            for (int n = 0; n < 2; ++n) g[bj][n] = *(const f32x4*)(gp + bj * 128 + n * 4);
#pragma unroll
        for (int ai = 0; ai < NAI; ++ai)
#pragma unroll
            for (int m = 0; m < 4; ++m)
#pragma unroll
                for (int bj = 0; bj < 2; ++bj) store8bf(Dl + (size_t)(row0 + ai * 128 + m * 16) * 1024 + col0 + bj * 128, g[bj][0] * acc[ai][bj][m][0], g[bj][1] * acc[ai][bj][m][1]);
    } };
struct EpiFF1 { bf16_t* H;
    __device__ __forceinline__ void pair(int row, int col, f32x4 a, f32x4 b) const {
        f32x4 oa, ob;
#pragma unroll
        for (int e = 0; e < 4; ++e) { const float ra = fmaxf(a[e], 0.f), rb = fmaxf(b[e], 0.f); oa[e] = ra * ra; ob[e] = rb * rb; }
        store8bf(H + (size_t)row * 4096 + col, oa, ob); }
    EPI_PAIR_TILE()
};

struct ConvJob { const float* src; int ld, K, c0, nvalid, ndst; bf16_t* dst; float scale; };
__device__ __forceinline__ bool conv_job(const P& p, int l, int j, ConvJob& J) {
    bf16_t* W = (bf16_t*)(p.ws + WS_W);
    const float* win = p.in[lnd(10)] + (size_t)l * 1024 * 5664;
    J.scale = 1.0f;
    switch (j) {
        case 0: J = {win, 5664, 1024, 0, 512, 512, W + W_A / 2, 0.08838834764831845f}; break;
        case 1: J = {win, 5664, 1024, 512, 512, 512, W + W_A / 2 + (size_t)512 * 1024, 1.f}; break;
        case 2: J = {win, 5664, 1024, 1024, 1024, 1024, W + W_A / 2 + (size_t)1024 * 1024, 1.f}; break;
        case 3: J = {win, 5664, 1024, 3072, 32, 256, W + W_A / 2 + (size_t)2048 * 1024, 1.f}; break;
        case 4: J = {win, 5664, 1024, 3104, 512, 512, W + W_A / 2 + (size_t)2304 * 1024, 1.f}; break;
        case 5: J = {win, 5664, 1024, 2048, 1024, 1024, W + W_B / 2, 1.f}; break;
        case 6: J = {win, 5664, 1024, 3616, 1024, 1024, W + W_B / 2 + (size_t)1024 * 1024, 1.f}; break;
        case 7: J = {win, 5664, 1024, 4640, 1024, 1024, W + W_B / 2 + (size_t)2048 * 1024, 1.f}; break;
        case 8: J = {p.in[lnd(14)] + (size_t)l * 1024 * 1024, 1024, 1024, 0, 1024, 1024, W + W_PG / 2, 1.f}; break;
        case 9: J = {p.in[lnd(23)] + (size_t)l * 512 * 512, 512, 512, 0, 512, 512, W + W_GLU / 2, 1.f}; break;
        case 10: J = {p.in[lnd(25)] + (size_t)l * 512 * 1024, 1024, 512, 0, 1024, 1024, W + W_PS / 2, 1.f}; break;
        case 11: J = {p.in[lnd(26)] + (size_t)l * 1024 * 1024, 1024, 1024, 0, 1024, 1024, W + W_OUT / 2, 1.f}; break;
        case 12: J = {p.in[lnd(28)] + (size_t)l * 1024 * 4096, 4096, 1024, 0, 4096, 4096, W + W_1 / 2, 1.f}; break;
        case 13: J = {p.in[lnd(29)] + (size_t)l * 4096 * 1024, 1024, 4096, 0, 1024, 1024, W + W_2 / 2, 1.f}; break;
        default: return false;
    }
    return true;
}
constexpr int CONV_TILES = 2112;
__device__ __forceinline__ void conv_tile(const P& p, int l, int tile, LAS float* sT) {
    const int tid = tid_();
    ConvJob J; int j = 0, rem = tile;
    for (; j < 14; ++j) { conv_job(p, l, j, J); const int nt = (J.ndst / 64) * (J.K / 128); if (rem < nt) break; rem -= nt; }
    const int kts = J.K / 128, ntile = rem / kts, ktile = rem % kts, n0 = ntile * 64, k0 = ktile * 128;
    {
        const int kk = tid >> 4, c4 = (tid & 15) * 4; f32x4 v[4];
#pragma unroll
        for (int i = 0; i < 4; ++i) { v[i] = (f32x4){0.f, 0.f, 0.f, 0.f};
            if (n0 + c4 < J.nvalid) v[i] = *(const f32x4*)(J.src + (size_t)(k0 + kk + 32 * i) * J.ld + J.c0 + n0 + c4); }
#pragma unroll
        for (int i = 0; i < 4; ++i)
#pragma unroll
            for (int e = 0; e < 4; ++e) sT[(c4 + e) * 129 + kk + 32 * i] = v[i][e] * J.scale;
    }
    __syncthreads();
    {
        const int n = tid >> 3, ks = (tid & 7) * 16;
        const int rho = n & 31, nsrc = (n & ~31) + 8 * ((rho & 15) >> 2) + 4 * (rho >> 4) + (rho & 3);
        const LAS float* sp = sT + nsrc * 129 + ks;
#pragma unroll
        for (int hh = 0; hh < 2; ++hh) { u32x4 w; const LAS float* q = sp + 8 * hh;
            w.x = pk_bf16(q[0], q[1]); w.y = pk_bf16(q[2], q[3]); w.z = pk_bf16(q[4], q[5]); w.w = pk_bf16(q[6], q[7]);
            *(u32x4*)(J.dst + (size_t)(n0 + n) * J.K + k0 + ks + 8 * hh) = w; }
    }
}

__device__ __forceinline__ void mod_task(const P& p, int m, LAS float* sm) {
    const int tid = tid_(), l = m / 192, colbase = (m % 192) * 32, cl = tid & 31, ks = tid >> 5;
    LAS float* SC = sm; LAS float* RED = sm + 9216;
    for (int i = tid; i < 9216; i += NTHR) { const int j = i >> 10, k = i & 1023; const float c = (j == 0) ? p.in[lnd(6)][k] : p.in[lnd(2)][(j - 1) * 1024 + k]; SC[i] = c * sigmoidf_(c); }
    __syncthreads();
    float acc[9];
#pragma unroll
    for (int j = 0; j < 9; ++j) acc[j] = 0.f;
    const float* w = p.in[lnd(7)] + (size_t)l * 1024 * 6144 + colbase + cl;
    for (int k8 = 0; k8 < 64; k8 += 16) { float wv[16];
#pragma unroll
        for (int u = 0; u < 16; ++u) wv[u] = w[(size_t)(ks * 64 + k8 + u) * 6144];
#pragma unroll
        for (int u = 0; u < 16; ++u)
#pragma unroll
            for (int j = 0; j < 9; ++j) acc[j] += SC[j * 1024 + ks * 64 + k8 + u] * wv[u]; }
#pragma unroll
    for (int j = 0; j < 9; ++j) RED[(ks * 9 + j) * 32 + cl] = acc[j];
    __syncthreads();
    if (tid < 288) { const int j = tid >> 5, c = tid & 31; float s = 0.f;
#pragma unroll
        for (int q = 0; q < 16; ++q) s += RED[(q * 9 + j) * 32 + c];
        float* mod = (float*)(p.ws + WS_MOD);
        mod[((size_t)l * 9 + j) * 6144 + colbase + c] = s + p.in[lnd(8)][(size_t)l * 6144 + colbase + c]; }
}

__device__ __forceinline__ void s5_mats(const P& p, int l, int gq, LAS float* sm) {
    const int tid = tid_(), g = gq >> 2, part = gq & 3;
    LAS float* KF = sm; LAS float* KB = sm + 8192; LAS float* LT = sm + 16384; LAS float* CC = sm + 20608; LAS float* BB = sm + 22656;
    bf16_t* MC = (bf16_t*)(p.ws + WS_R1) + (size_t)g * 512 * 768;
    bf16_t* EM = (bf16_t*)(p.ws + WS_EMAT) + (size_t)g * 256 * 512;
    for (int d = 0; d < 2; ++d) {
        const int pg = (l * 2 + d) * 32 + g;
        const float* lamr = p.in[lnd(15)] + (size_t)pg * 64; const float* lami = p.in[lnd(16)] + (size_t)pg * 64;
        const float dt = expf(p.in[lnd(17)][pg]);
        const float* bre = p.in[lnd(18)] + (size_t)pg * 1024; const float* bim = p.in[lnd(19)] + (size_t)pg * 1024;
        const float* cre = p.in[lnd(20)] + (size_t)pg * 1024; const float* cim = p.in[lnd(21)] + (size_t)pg * 1024;
        for (int i = tid; i < 33 * 64; i += NTHR) { const int tau = i >> 6, pp = i & 63; const float a = expf(lamr[pp] * dt * (float)tau); float s, c; sincosf(lami[pp] * dt * (float)tau, &s, &c); LT[2 * i] = a * c; LT[2 * i + 1] = a * s; }
        for (int i = tid; i < 1024; i += NTHR) { CC[2 * i] = cre[i]; CC[2 * i + 1] = cim[i]; }
        for (int i = tid; i < 1024; i += NTHR) {
            const int pp = i >> 4; const float lr = lamr[pp], li = lami[pp]; float s, c; sincosf(li * dt, &s, &c);
            const float em1 = expm1f(lr * dt); float sh, ch; sincosf(0.5f * li * dt, &sh, &ch);
            const float nr = em1 * c - 2.f * sh * sh, ni = (em1 + 1.f) * s;
            const float inv = 1.f / (lr * lr + li * li);
            const float qr = (nr * lr + ni * li) * inv, qi = (ni * lr - nr * li) * inv;
            const float br = bre[i], bi = bim[i];
            BB[2 * i] = qr * br - qi * bi; BB[2 * i + 1] = qr * bi + qi * br;
        }
        __syncthreads();
        {
            const int tau = tid >> 4, n = tid & 15; float acc[16];
#pragma unroll
            for (int m = 0; m < 16; ++m) acc[m] = 0.f;
            for (int pp = 0; pp < 64; ++pp) {
                const float cr = CC[2 * (n * 64 + pp)], ci = CC[2 * (n * 64 + pp) + 1], lr = LT[2 * (tau * 64 + pp)], li = LT[2 * (tau * 64 + pp) + 1];
                const float xr = cr * lr - ci * li, xi = cr * li + ci * lr;
#pragma unroll
                for (int m = 0; m < 16; ++m) acc[m] += xr * BB[2 * (pp * 16 + m)] - xi * BB[2 * (pp * 16 + m) + 1];
            }
            LAS float* Kd = d ? KB : KF;
#pragma unroll
            for (int m = 0; m < 16; ++m) Kd[(tau * 16 + n) * 16 + m] = acc[m];
        }
        {
            const int pp = tid >> 3, cseg = tid & 7;
            { const int jj = part;
                const int j = cseg * 4 + jj, e = d == 0 ? 31 - j : j; const float lr = LT[2 * (e * 64 + pp)], li = LT[2 * (e * 64 + pp) + 1];
                float re[16], im[16];
#pragma unroll
                for (int m = 0; m < 16; ++m) { const float br = BB[2 * (pp * 16 + m)], bi = BB[2 * (pp * 16 + m) + 1]; re[m] = lr * br - li * bi; im[m] = lr * bi + li * br; }
                bf16_t* er = EM + (size_t)(d * 128 + pp) * 512 + j * 16; bf16_t* ei = EM + (size_t)(d * 128 + 64 + pp) * 512 + j * 16;
#pragma unroll
                for (int h = 0; h < 2; ++h) {
                    u32x4 w; w.x = pk_bf16(re[8 * h], re[8 * h + 1]); w.y = pk_bf16(re[8 * h + 2], re[8 * h + 3]); w.z = pk_bf16(re[8 * h + 4], re[8 * h + 5]); w.w = pk_bf16(re[8 * h + 6], re[8 * h + 7]); *(u32x4*)(er + 8 * h) = w;
                    u32x4 x; x.x = pk_bf16(im[8 * h], im[8 * h + 1]); x.y = pk_bf16(im[8 * h + 2], im[8 * h + 3]); x.z = pk_bf16(im[8 * h + 4], im[8 * h + 5]); x.w = pk_bf16(im[8 * h + 6], im[8 * h + 7]); *(u32x4*)(ei + 8 * h) = x;
                }
            }
        }
        {
            const int t = tid >> 4, n = tid & 15, f = d == 0 ? t + 1 : 32 - t;
            bf16_t* mr = MC + (size_t)tid * 768 + 512 + d * 128;
#pragma unroll 1
            for (int p8 = 2 * part; p8 < 2 * part + 2; ++p8) {
                float re[8], im[8];
#pragma unroll
                for (int q = 0; q < 8; ++q) { const int pp = p8 * 8 + q; const float cr = CC[2 * (n * 64 + pp)], ci = CC[2 * (n * 64 + pp) + 1], lr = LT[2 * (f * 64 + pp)], li = LT[2 * (f * 64 + pp) + 1];
                    re[q] = cr * lr - ci * li; im[q] = -(cr * li + ci * lr); }
                u32x4 w; w.x = pk_bf16(re[0], re[1]); w.y = pk_bf16(re[2], re[3]); w.z = pk_bf16(re[4], re[5]); w.w = pk_bf16(re[6], re[7]); *(u32x4*)(mr + p8 * 8) = w;
                u32x4 x; x.x = pk_bf16(im[0], im[1]); x.y = pk_bf16(im[2], im[3]); x.z = pk_bf16(im[4], im[5]); x.w = pk_bf16(im[6], im[7]); *(u32x4*)(mr + 64 + p8 * 8) = x;
            }
        }
        __syncthreads();
    }
    {
        const int t = tid >> 4, n = tid & 15; const float dsk = p.in[lnd(22)][(size_t)l * 512 + g * 16 + n];
        bf16_t* mr = MC + (size_t)tid * 768;
#pragma unroll 1
        for (int j = 8 * part; j < 8 * part + 8; ++j) {
            float v[16];
#pragma unroll
            for (int m = 0; m < 16; ++m) v[m] = 0.f;
            if (j <= t) { const LAS float* k = KF + ((t - j) * 16 + n) * 16;
#pragma unroll
                for (int m = 0; m < 16; ++m) v[m] += k[m]; }
            if (j >= t) { const LAS float* k = KB + ((j - t) * 16 + n) * 16;
#pragma unroll
                for (int m = 0; m < 16; ++m) v[m] += k[m]; }
            if (j == t) {
#pragma unroll
                for (int m = 0; m < 16; ++m) v[m] += (m == n) ? dsk : 0.f; }
            u32x4 w; w.x = pk_bf16(v[0], v[1]); w.y = pk_bf16(v[2], v[3]); w.z = pk_bf16(v[4], v[5]); w.w = pk_bf16(v[6], v[7]); *(u32x4*)(mr + j * 16) = w;
            u32x4 x; x.x = pk_bf16(v[8], v[9]); x.y = pk_bf16(v[10], v[11]); x.z = pk_bf16(v[12], v[13]); x.w = pk_bf16(v[14], v[15]); *(u32x4*)(mr + j * 16 + 8) = x;
        }
    }
}

__device__ __forceinline__ void phase_prep(const P& p, int l, LAS unsigned char* lds) {
    LAS float* sm = (LAS float*)lds;
    const int b = bid_(), G = gridDim.x, ha = G >> 1;
    if (b < ha) { for (int t = b; t < 128; t += ha) { s5_mats(p, l, t, sm); __syncthreads(); } }
    else { for (int t = b - ha; t < CONV_TILES; t += G - ha) { conv_tile(p, l, t, sm); __syncthreads(); } }
    if (l == 0) for (int t = b; t < 384; t += G) { mod_task(p, t, sm); __syncthreads(); }
}

__device__ __forceinline__ void norm_row_write(const f32x4 (&x)[4], const float* g, const float* mod, int shoff, int scoff, bf16_t* hrow, int lane) {
    float ss = 0.f;
#pragma unroll
    for (int i = 0; i < 4; ++i) ss += x[i][0] * x[i][0] + x[i][1] * x[i][1] + x[i][2] * x[i][2] + x[i][3] * x[i][3];
    ss = wave_sum(ss);
    const float rstd = rsqrtf(ss * (1.0f / 1024.0f) + 1e-6f);
#pragma unroll
    for (int i = 0; i < 4; ++i) { const int d = i * 256 + lane * 4; const f32x4 gg = *(const f32x4*)(g + d), sc = *(const f32x4*)(mod + scoff + d), sh = *(const f32x4*)(mod + shoff + d);
        f32x4 h;
#pragma unroll
        for (int e = 0; e < 4; ++e) h[e] = x[i][e] * rstd * gg[e] * (1.f + sc[e]) + sh[e];
        { u32x2 w; w.x = pk_bf16(h[0], h[1]); w.y = pk_bf16(h[2], h[3]); __builtin_nontemporal_store(w, (u32x2*)(hrow + d)); } }
}
__device__ __forceinline__ void phase_norm(const P& p, int l, int which) {
    const int lane = tid_() & 63, gw = bid_() * 8 + (tid_() >> 6), nw = gridDim.x * 8;
    const float* g = (which == 1 ? p.in[lnd(9)] : p.in[lnd(27)]) + (size_t)l * 1024;
    const float* modl = (const float*)(p.ws + WS_MOD) + (size_t)l * 9 * 6144;
    const int shoff = which == 1 ? 0 : 3072, scoff = which == 1 ? 1024 : 4096;
    bf16_t* H = (bf16_t*)(p.ws + WS_R2); float* X = p.out;
    if (which == 1 && l == 0) {
        for (int item = gw; item < 4096 + 8192; item += nw) {
            if (item < 4096) {
                const int n = item; const float rr = (float)(n >> 6), cc = (float)(n & 63); f32x4 pe[4];
#pragma unroll
                for (int e = 0; e < 4; ++e) { const float om = expf(-(float)(lane * 4 + e) * (9.210340371976184f / 256.0f)); float s, c; sincosf(rr * om, &s, &c); pe[0][e] = s; pe[1][e] = c; sincosf(cc * om, &s, &c); pe[2][e] = s; pe[3][e] = c; }
                for (int b0 = 0; b0 < 8; b0 += 2) { f32x4 x[2][4];
#pragma unroll
                    for (int r = 0; r < 2; ++r) { const float* src = p.in[lnd(1)] + ((size_t)(b0 + r) * 4096 + n) * 1024;
#pragma unroll
                        for (int i = 0; i < 4; ++i) x[r][i] = *(const f32x4*)(src + i * 256 + lane * 4); }
#pragma unroll
                    for (int r = 0; r < 2; ++r) { const int row = TOKP + (b0 + r) * 4096 + n;
#pragma unroll
                        for (int i = 0; i < 4; ++i) { x[r][i] = x[r][i] + pe[i]; *(f32x4*)(X + (size_t)row * 1024 + i * 256 + lane * 4) = x[r][i]; }
                        norm_row_write(x[r], g, modl + (size_t)(1 + b0 + r) * 6144, shoff, scoff, H + (size_t)row * 1024, lane); } }
            } else { const int row = item - 4096; const float* src = p.in[lnd(0)] + (size_t)row * 1024; f32x4 x[4];
#pragma unroll
                for (int i = 0; i < 4; ++i) { x[i] = *(const f32x4*)(src + i * 256 + lane * 4); *(f32x4*)(X + (size_t)row * 1024 + i * 256 + lane * 4) = x[i]; }
                norm_row_write(x, g, modl, shoff, scoff, H + (size_t)row * 1024, lane); }
        }
    } else {
        const bf16_t* DL = (const bf16_t*)(p.ws + (which == 1 ? WS_R2 : WS_R3));
        for (int row0 = gw; row0 < TOK; row0 += 4 * nw) {
            f32x4 x[4][4]; u32x2 dv[4][4];
#pragma unroll
            for (int r = 0; r < 4; ++r) { const int row = row0 + r * nw;
                if (row < TOK) {
#pragma unroll
                    for (int i = 0; i < 4; ++i) { x[r][i] = __builtin_nontemporal_load((const f32x4*)(X + (size_t)row * 1024 + i * 256 + lane * 4)); dv[r][i] = __builtin_nontemporal_load((const u32x2*)(DL + (size_t)row * 1024 + i * 256 + lane * 4)); } } }
#pragma unroll
            for (int r = 0; r < 4; ++r) { const int row = row0 + r * nw;
                if (row < TOK) {
#pragma unroll
                    for (int i = 0; i < 4; ++i) { x[r][i] = x[r][i] + (f32x4){bflo(dv[r][i].x), bfhi(dv[r][i].x), bflo(dv[r][i].y), bfhi(dv[r][i].y)}; *(f32x4*)(X + (size_t)row * 1024 + i * 256 + lane * 4) = x[r][i]; }
                    norm_row_write(x[r], g, modl + (size_t)mod_index(row) * 6144, shoff, scoff, H + (size_t)row * 1024, lane); } }
        }
    }
}
__device__ __forceinline__ void phase_final(const P& p) {
    const int lane = tid_() & 63, gw = bid_() * 8 + (tid_() >> 6), nw = gridDim.x * 8; float* X = p.out; const float* g = p.in[lnd(30)]; const bf16_t* DL = (const bf16_t*)(p.ws + WS_R2);
    for (int row0 = gw; row0 < TOK; row0 += 4 * nw) {
        f32x4 x[4][4]; u32x2 dv[4][4];
#pragma unroll
        for (int r = 0; r < 4; ++r) { const int row = row0 + r * nw;
            if (row < TOK) {
#pragma unroll
                for (int i = 0; i < 4; ++i) { x[r][i] = __builtin_nontemporal_load((const f32x4*)(X + (size_t)row * 1024 + i * 256 + lane * 4)); dv[r][i] = __builtin_nontemporal_load((const u32x2*)(DL + (size_t)row * 1024 + i * 256 + lane * 4)); } } }
#pragma unroll
        for (int r = 0; r < 4; ++r) { const int row = row0 + r * nw;
            if (row < TOK) { float ss = 0.f;
#pragma unroll
                for (int i = 0; i < 4; ++i) { x[r][i] = x[r][i] + (f32x4){bflo(dv[r][i].x), bfhi(dv[r][i].x), bflo(dv[r][i].y), bfhi(dv[r][i].y)}; ss += x[r][i][0] * x[r][i][0] + x[r][i][1] * x[r][i][1] + x[r][i][2] * x[r][i][2] + x[r][i][3] * x[r][i][3]; }
                ss = wave_sum(ss); const float rstd = rsqrtf(ss * (1.0f / 1024.0f) + 1e-6f);
#pragma unroll
                for (int i = 0; i < 4; ++i) { const f32x4 gg = *(const f32x4*)(g + i * 256 + lane * 4); *(f32x4*)(X + (size_t)row * 1024 + i * 256 + lane * 4) = x[r][i] * rstd * gg; } } }
    }
}

__device__ __forceinline__ void phase_s5scan(const P& p, int l) {
    const float* E = (const float*)(p.ws + WS_E); bf16_t* UG = (bf16_t*)(p.ws + WS_R5);
    float* ore = p.out + (size_t)TOK * 1024 + 16777216; float* oim = ore + 262144;
    for (int task = bid_(); task < 320; task += gridDim.x) {
        const int idx = task * NTHR + tid_(), pp = idx & 63, d = (idx >> 6) & 1, g = (idx >> 7) & 31, s = 39 - (idx >> 12);
        const int nch = s < 32 ? 8 : 128, cbase = s < 32 ? s * 8 : 256 + (s - 32) * 128;
        const int pg = (l * 2 + d) * 32 + g; const float dt = expf(p.in[lnd(17)][pg]);
        const float a = expf(p.in[lnd(15)][(size_t)pg * 64 + pp] * dt * 32.f); float sn, cs; sincosf(p.in[lnd(16)][(size_t)pg * 64 + pp] * dt * 32.f, &sn, &cs);
        const float ar = a * cs, ai = a * sn;
        float sr = 0.f, si = 0.f;
        if (s >= 32) { const size_t o = ((((size_t)(s - 32) * 2 + l) * 2 + d) * 32 + g) * 64 + pp; sr = p.in[lnd(4)][o]; si = p.in[lnd(5)][o]; }
        const float* Eb = E + ((size_t)(g * 1280 + cbase) * 256 + d * 128 + pp);
        bf16_t* Ub = UG + ((size_t)(g * 1280 + cbase) * 768 + 512 + d * 128 + pp);
        for (int c0 = 0; c0 < nch; c0 += 8) {
            float er[8], ei[8];
#pragma unroll
            for (int k = 0; k < 8; ++k) { const int c = d == 0 ? c0 + k : nch - 1 - (c0 + k); er[k] = Eb[(size_t)c * 256]; ei[k] = Eb[(size_t)c * 256 + 64]; }
#pragma unroll
            for (int k = 0; k < 8; ++k) { const int c = d == 0 ? c0 + k : nch - 1 - (c0 + k);
                Ub[(size_t)c * 768] = f2bf(sr); Ub[(size_t)c * 768 + 64] = f2bf(si);
                const float nr = ar * sr - ai * si + er[k], ni = ar * si + ai * sr + ei[k]; sr = nr; si = ni; }
        }
        if (s < 32) { const size_t o = ((((size_t)s * 2 + l) * 2 + d) * 32 + g) * 64 + pp; ore[o] = sr; oim[o] = si; }
    }
}

__device__ __forceinline__ void phase_glapre(const P& p, int l, LAS unsigned char* lds) {
    const int tid = tid_(), d = tid & 127, tq = tid >> 7, wv = tid >> 6, lane = tid & 63, fr = lane & 15, fq = lane >> 4;
    LAS float* sG = (LAS float*)lds; LAS float* sT4 = sG + 2048; LAS float* sZ = sG + 2560;
    bf16_t* Q = (bf16_t*)(p.ws + WS_R3); bf16_t* Kk = Q + (size_t)TOK * 512;
    bf16_t* QB = (bf16_t*)(p.ws + WS_R5); bf16_t* KB = QB + (size_t)TOK * 512;
    const float* GLR = (const float*)(p.ws + WS_GLR);
    for (int task = bid_(); task < 2560; task += gridDim.x) {
        const int c64 = task >> 2, h = task & 3, tb = c64 * 64;
        { const int row = tid >> 3, c4 = (tid & 7) * 4; *(LAS f32x4*)(sG + row * 32 + c4) = *(const f32x4*)(GLR + (size_t)(tb + row) * 32 + c4); }
        float qv[16], kv[16];
#pragma unroll
        for (int i = 0; i < 16; ++i) { const size_t o = (size_t)(tb + tq * 16 + i) * 512 + h * 128 + d; qv[i] = bf2f(Q[o]); kv[i] = bf2f(Kk[o]); }
        bf16x8 bw[2];
#pragma unroll
        for (int dir = 0; dir < 2; ++dir) { float w8[8];
#pragma unroll
            for (int e = 0; e < 8; ++e) { const int kk = 8 * fq + e - 16 * dir; w8[e] = (kk >= 0 && kk < 16) ? p.in[lnd(11)][((size_t)(l * 2 + dir) * 16 + kk) * 512 + h * 128 + 16 * wv + fr] : 0.f; }
            u32x4 pk; pk.x = pk_bf16(w8[0], w8[1]); pk.y = pk_bf16(w8[2], w8[3]); pk.z = pk_bf16(w8[4], w8[5]); pk.w = pk_bf16(w8[6], w8[7]);
            bw[dir] = __builtin_bit_cast(bf16x8, pk); }
        __syncthreads();
#pragma unroll
        for (int ti = 0; ti < 4; ++ti) {
            const LAS float* gr = sG + (16 * ti + fr) * 32 + 8 * fq; const f32x4 g0 = *(const LAS f32x4*)gr, g1 = *(const LAS f32x4*)(gr + 4);
            u32x4 pk; pk.x = pk_bf16(g0[0], g0[1]); pk.y = pk_bf16(g0[2], g0[3]); pk.z = pk_bf16(g1[0], g1[1]); pk.w = pk_bf16(g1[2], g1[3]);
            const bf16x8 af = __builtin_bit_cast(bf16x8, pk);
#pragma unroll
            for (int dir = 0; dir < 2; ++dir) { const f32x4 z = __builtin_amdgcn_mfma_f32_16x16x32_bf16(af, bw[dir], (f32x4){0.f, 0.f, 0.f, 0.f}, 0, 0, 0);
#pragma unroll
                for (int e = 0; e < 4; ++e) sZ[(dir * 64 + 16 * ti + 4 * fq + e) * 128 + 16 * wv + fr] = z[e]; }
        }
        __syncthreads();
#pragma unroll 1
        for (int dir = 0; dir < 2; ++dir) {
            const float bg = p.in[lnd(12)][(size_t)(l * 2 + dir) * 512 + h * 128 + d];
            float cum[16];
#pragma unroll
            for (int i = 0; i < 16; ++i) { const float z = sZ[(dir * 64 + tq * 16 + i) * 128 + d] + bg;
                cum[i] = (fminf(z, 0.f) - __logf(1.0f + __expf(-fabsf(z)))) * 0.0625f; }
            if (dir == 0) {
#pragma unroll
                for (int i = 1; i < 16; ++i) cum[i] += cum[i - 1];
            } else {
#pragma unroll
                for (int i = 14; i >= 0; --i) cum[i] += cum[i + 1];
            }
            sT4[tq * 128 + d] = dir == 0 ? cum[15] : cum[0];
            __syncthreads();
            float off = 0.f, total = 0.f;
#pragma unroll
            for (int q = 0; q < 4; ++q) { const float v = sT4[q * 128 + d]; total += v; if (dir == 0 ? (q < tq) : (q > tq)) off += v; }
            bf16_t* QD = dir == 0 ? Q : QB; bf16_t* KI = dir == 0 ? Kk : KB;
#pragma unroll
            for (int i = 0; i < 16; ++i) { const float cm = cum[i] + off; const size_t o = (size_t)(tb + tq * 16 + i) * 512 + h * 128 + d;
                QD[o] = f2bf(qv[i] * __expf(cm)); KI[o] = f2bf(kv[i] * __expf(-cm)); }
            if (tq == 0) ((float*)(p.ws + (dir == 0 ? WS_TOTF : WS_TOTB)))[(size_t)c64 * 512 + h * 128 + d] = total;
            __syncthreads();
        }
    }
}

constexpr int GLA_GRP = 71168;
typedef short s16x4 __attribute__((ext_vector_type(4)));
__device__ __forceinline__ bf16x8 tr_frag(const LAS bf16_t* base, int stride, int krow0, int col0, int fr, int fq) {
    const LAS bf16_t* q = base + (krow0 + 8 * fq + (fr >> 2)) * stride + col0 + 4 * (fr & 3);
    const s16x4 a = __builtin_amdgcn_ds_read_tr16_b64_v4i16((LAS s16x4*)q);
    const s16x4 b = __builtin_amdgcn_ds_read_tr16_b64_v4i16((LAS s16x4*)(q + 4 * stride));
    return __builtin_shufflevector(a, b, 0, 1, 2, 3, 4, 5, 6, 7);
}
#define LDS_BAR() do { asm volatile("s_waitcnt lgkmcnt(0)" ::: "memory"); __builtin_amdgcn_s_barrier(); asm volatile("" ::: "memory"); } while (0)
__device__ __forceinline__ void phase_gla(const P& p, int l, LAS unsigned char* lds) {
    const int tid = tid_(), grp = __builtin_amdgcn_readfirstlane(tid >> 8), gt = tid & 255, wv = __builtin_amdgcn_readfirstlane((tid >> 6) & 3), lane = tid & 63, fr = lane & 15, fq = lane >> 4;
    LAS unsigned char* gl = lds + grp * GLA_GRP;
    LAS bf16_t* sQ = (LAS bf16_t*)gl; LAS bf16_t* sK = (LAS bf16_t*)(gl + 17408); LAS bf16_t* sV = (LAS bf16_t*)(gl + 34816);
    LAS bf16_t* sP = (LAS bf16_t*)(gl + 44032); LAS bf16_t* sS = (LAS bf16_t*)(gl + 53248); LAS float* sTot = (LAS float*)(gl + 70656);
    const bf16_t* QD = grp == 0 ? (const bf16_t*)(p.ws + WS_R3) : (const bf16_t*)(p.ws + WS_R5);
    const bf16_t* KI = QD + (size_t)TOK * 512;
    const bf16_t* V = (const bf16_t*)(p.ws + WS_R4);
    const float* TOT = (const float*)(p.ws + (grp == 0 ? WS_TOTF : WS_TOTB));
    bf16_t* O = (bf16_t*)(p.ws + WS_R1);
    float* OST = p.out + (size_t)TOK * 1024;
    const int G = gridDim.x, b = bid_();
    const bool custom = (G == 256);
    const int ntask_mine = custom ? (b < 128 ? 1 : 4) : ((640 - b + G - 1) / G);
    for (int ti = 0; ti < ntask_mine; ++ti) {
        const int task = custom ? (b < 128 ? b : b + 128 * ti) : b + G * ti;
        if (task >= 640) break;
        const bool sample = task < 128;
        const int t2 = sample ? task : task - 128, xcd_ = t2 & 7, vs = (t2 >> 3) & 3, sh_ = xcd_ + 8 * (t2 >> 5), sb = sh_ >> 2, h = sh_ & 3;
        const int base = sample ? TOKP + sb * 4096 : sb * 256, nch = sample ? 64 : 4;
        f32x4 accS[2][4];
#pragma unroll
        for (int dt = 0; dt < 2; ++dt)
#pragma unroll
            for (int vt = 0; vt < 4; ++vt) {
                f32x4 a = (f32x4){0.f, 0.f, 0.f, 0.f};
                if (sample) { const float* cp = p.in[lnd(3)] + (((((size_t)sb * 2 + l) * 2 + grp) * 4 + h) * 128 + 16 * (2 * wv + dt) + 4 * fq) * 256 + vs * 64 + 16 * vt + fr;
#pragma unroll
                    for (int e = 0; e < 4; ++e) a[e] = cp[(size_t)e * 256]; }
                accS[dt][vt] = a;
                u32x2 w; w.x = pk_bf16(a[0], a[1]); w.y = pk_bf16(a[2], a[3]);
                *(LAS u32x2*)(sS + (16 * vt + fr) * 136 + 16 * (2 * wv + dt) + 4 * fq) = w;
            }
        u32x4 rq[2][4], rk[2][4], rv[2][2]; float rt[2] = {0.f, 0.f};
        u32x2 oprev[2][4];
#pragma unroll
        for (int u = 0; u < 2; ++u)
#pragma unroll
            for (int vt = 0; vt < 4; ++vt) oprev[u][vt] = (u32x2){0u, 0u};
#define GLA_CHUNK(st) (grp == 0 ? (st) : nch - 1 - (st))
#define GLA_LOAD(U, ci) do { const int tb_ = base + (ci) * 64; \
        _Pragma("unroll") for (int i = 0; i < 4; ++i) { const int idx = gt + 256 * i, row = idx >> 4, c16 = idx & 15; const size_t o = (size_t)(tb_ + row) * 512 + h * 128 + c16 * 8; rq[U][i] = *(const u32x4*)(QD + o); rk[U][i] = *(const u32x4*)(KI + o); } \
        _Pragma("unroll") for (int i = 0; i < 2; ++i) { const int idx = gt + 256 * i, row = idx >> 3, c8 = idx & 7; rv[U][i] = *(const u32x4*)(V + (size_t)(tb_ + row) * 1024 + h * 256 + vs * 64 + c8 * 8); } \
        if (gt < 128) rt[U] = TOT[(size_t)(tb_ >> 6) * 512 + h * 128 + gt]; } while (0)
#define GLA_STORE(U) do { \
        _Pragma("unroll") for (int i = 0; i < 4; ++i) { const int idx = gt + 256 * i, row = idx >> 4, c16 = idx & 15; *(LAS u32x4*)(sQ + row * 136 + c16 * 8) = rq[U][i]; *(LAS u32x4*)(sK + row * 136 + c16 * 8) = rk[U][i]; } \
        _Pragma("unroll") for (int i = 0; i < 2; ++i) { const int idx = gt + 256 * i, row = idx >> 3, c8 = idx & 7; *(LAS u32x4*)(sV + row * 72 + c8 * 8) = rv[U][i]; } \
        if (gt < 128) sTot[gt] = rt[U]; } while (0)
#define GLA_OLOAD(U, st) do { const int tb_ = base + GLA_CHUNK(st) * 64; \
        _Pragma("unroll") for (int vt = 0; vt < 4; ++vt) oprev[U][vt] = *(const u32x2*)(O + (size_t)(tb_ + 16 * wv + fr) * 1024 + h * 256 + vs * 64 + 16 * vt + 4 * fq); } while (0)
        GLA_LOAD(0, GLA_CHUNK(0));
        GLA_STORE(0);
        GLA_LOAD(1, GLA_CHUNK(1));
        __syncthreads();
        const int half = nch >> 1;
        for (int s0 = 0; s0 < nch; s0 += 2) {
#pragma unroll
          for (int u = 0; u < 2; ++u) {
            const int s = s0 + u;
            const int ci = GLA_CHUNK(s), tb = base + ci * 64;
            const bool second = (s >= half);
            if (s == half) GLA_OLOAD(u, s);
            if (s + 1 < nch && s + 1 > half) GLA_OLOAD(u ^ 1, s + 1);
            asm volatile("" ::: "memory");
            if (s + 2 < nch) GLA_LOAD(u, GLA_CHUNK(s + 2));
            { bf16x8 qa[4];
#pragma unroll
            for (int ks = 0; ks < 4; ++ks) qa[ks] = *(const LAS bf16x8*)(sQ + (16 * wv + fr) * 136 + 32 * ks + 8 * fq);
#pragma unroll
            for (int jt = 0; jt < 4; ++jt) {
                bf16x8 kb[4];
#pragma unroll
                for (int ks = 0; ks < 4; ++ks) kb[ks] = *(const LAS bf16x8*)(sK + (16 * jt + fr) * 136 + 32 * ks + 8 * fq);
                f32x4 acc = (f32x4){0.f, 0.f, 0.f, 0.f};
#pragma unroll
                for (int ks = 0; ks < 4; ++ks) acc = __builtin_amdgcn_mfma_f32_16x16x32_bf16(qa[ks], kb[ks], acc, 0, 0, 0);
#pragma unroll
                for (int e = 0; e < 4; ++e) { const int i = 16 * wv + 4 * fq + e, j = 16 * jt + fr; const bool keep = grp == 0 ? (j <= i) : (j >= i); sP[i * 72 + j] = f2bf(keep ? acc[e] : 0.f); }
            } }
            asm volatile("" ::: "memory");
            bf16x8 vf[4][2];
#pragma unroll
            for (int vt = 0; vt < 4; ++vt)
#pragma unroll
                for (int ks = 0; ks < 2; ++ks) vf[vt][ks] = tr_frag(sV, 72, 32 * ks, 16 * vt, fr, fq);
#pragma unroll
            for (int dt = 0; dt < 2; ++dt) {
                bf16x8 kf[2];
#pragma unroll
                for (int ks = 0; ks < 2; ++ks) kf[ks] = tr_frag(sK, 136, 32 * ks, 16 * (2 * wv + dt), fr, fq);
                const f32x4 tt = *(const LAS f32x4*)(sTot + 16 * (2 * wv + dt) + 4 * fq);
                const f32x4 sc = (f32x4){__expf(tt[0]), __expf(tt[1]), __expf(tt[2]), __expf(tt[3])};
#pragma unroll
                for (int vt = 0; vt < 4; ++vt) {
#pragma unroll
                    for (int ks = 0; ks < 2; ++ks) accS[dt][vt] = __builtin_amdgcn_mfma_f32_16x16x32_bf16(kf[ks], vf[vt][ks], accS[dt][vt], 0, 0, 0);
                    accS[dt][vt] = accS[dt][vt] * sc;
                }
            }
            asm volatile("s_waitcnt lgkmcnt(0)" ::: "memory");
            {
                bf16x8 pf[2];
#pragma unroll
                for (int ks = 0; ks < 2; ++ks) pf[ks] = *(const LAS bf16x8*)(sP + (16 * wv + fr) * 72 + 32 * ks + 8 * fq);
                bf16x8 qf[4];
#pragma unroll
                for (int ks = 0; ks < 4; ++ks) qf[ks] = *(const LAS bf16x8*)(sQ + (16 * wv + fr) * 136 + 32 * ks + 8 * fq);
#pragma unroll
                for (int vt = 0; vt < 4; ++vt) {
                    f32x4 acc = (f32x4){0.f, 0.f, 0.f, 0.f};
#pragma unroll
                    for (int ks = 0; ks < 2; ++ks) acc = __builtin_amdgcn_mfma_f32_16x16x32_bf16(vf[vt][ks], pf[ks], acc, 0, 0, 0);
#pragma unroll
                    for (int ks = 0; ks < 4; ++ks) { const bf16x8 sf = *(const LAS bf16x8*)(sS + (16 * vt + fr) * 136 + 32 * ks + 8 * fq);
                        acc = __builtin_amdgcn_mfma_f32_16x16x32_bf16(sf, qf[ks], acc, 0, 0, 0); }
                    { u32x2 pv = oprev[u][vt]; asm volatile("" : "+v"(pv));
                      if (second) acc = acc + (f32x4){bflo(pv.x), bfhi(pv.x), bflo(pv.y), bfhi(pv.y)}; }
                    store4bf(O + (size_t)(tb + 16 * wv + fr) * 1024 + h * 256 + vs * 64 + 16 * vt + 4 * fq, acc);
                }
            }
            LDS_BAR();
#pragma unroll
            for (int dt = 0; dt < 2; ++dt)
#pragma unroll
                for (int vt = 0; vt < 4; ++vt) { u32x2 w; w.x = pk_bf16(accS[dt][vt][0], accS[dt][vt][1]); w.y = pk_bf16(accS[dt][vt][2], accS[dt][vt][3]);
                    *(LAS u32x2*)(sS + (16 * vt + fr) * 136 + 16 * (2 * wv + dt) + 4 * fq) = w; }
            if (s + 1 < nch) GLA_STORE(u ^ 1);
            if (s == half - 1) { asm volatile("s_waitcnt vmcnt(0)" ::: "memory"); __syncthreads(); } else LDS_BAR();
          }
        }
        if (!sample) {
#pragma unroll
            for (int dt = 0; dt < 2; ++dt)
#pragma unroll
                for (int vt = 0; vt < 4; ++vt) { float* op = OST + (((((size_t)sb * 2 + l) * 2 + grp) * 4 + h) * 128 + 16 * (2 * wv + dt) + 4 * fq) * 256 + vs * 64 + 16 * vt + fr;
#pragma unroll
                    for (int e = 0; e < 4; ++e) op[(size_t)e * 256] = accS[dt][vt][e]; }
        }
    }
#undef GLA_LOAD
#undef GLA_STORE
#undef GLA_OLOAD
#undef GLA_CHUNK
}

__device__ __forceinline__ void phase_glapost(const P& p, int l) {
    const int lane = tid_() & 63, gw = bid_() * 8 + (tid_() >> 6), nw = gridDim.x * 8;
    bf16_t* O = (bf16_t*)(p.ws + WS_R1); const bf16_t* R = (const bf16_t*)(p.ws + WS_R3);
    const float* gn = p.in[lnd(13)] + (size_t)l * 256 + (lane & 15) * 16;
    for (int row = gw; row < TOK; row += nw) {
        const size_t o = (size_t)row * 1024 + lane * 16; float x[16], r[16];
#pragma unroll
        for (int hh = 0; hh < 2; ++hh) { const u32x4 a = *(const u32x4*)(O + o + 8 * hh), c = *(const u32x4*)(R + o + 8 * hh);
            x[8 * hh + 0] = bflo(a.x); x[8 * hh + 1] = bfhi(a.x); x[8 * hh + 2] = bflo(a.y); x[8 * hh + 3] = bfhi(a.y); x[8 * hh + 4] = bflo(a.z); x[8 * hh + 5] = bfhi(a.z); x[8 * hh + 6] = bflo(a.w); x[8 * hh + 7] = bfhi(a.w);
            r[8 * hh + 0] = bflo(c.x); r[8 * hh + 1] = bfhi(c.x); r[8 * hh + 2] = bflo(c.y); r[8 * hh + 3] = bfhi(c.y); r[8 * hh + 4] = bflo(c.z); r[8 * hh + 5] = bfhi(c.z); r[8 * hh + 6] = bflo(c.w); r[8 * hh + 7] = bfhi(c.w); }
        float ss = 0.f;
#pragma unroll
        for (int e = 0; e < 16; ++e) ss += x[e] * x[e];
        ss += __shfl_xor(ss, 1); ss += __shfl_xor(ss, 2); ss += __shfl_xor(ss, 4); ss += __shfl_xor(ss, 8);
        const float rstd = rsqrtf(ss * (1.0f / 256.0f) + 1e-6f);
        float y[16];
#pragma unroll
        for (int e = 0; e < 16; ++e) y[e] = x[e] * rstd * gn[e] * r[e];
#pragma unroll
        for (int hh = 0; hh < 2; ++hh) { u32x4 w; w.x = pk_bf16(y[8 * hh], y[8 * hh + 1]); w.y = pk_bf16(y[8 * hh + 2], y[8 * hh + 3]); w.z = pk_bf16(y[8 * hh + 4], y[8 * hh + 5]); w.w = pk_bf16(y[8 * hh + 6], y[8 * hh + 7]); *(u32x4*)(O + o + 8 * hh) = w; }
    }
}


#define XB_TMO      128
#define XB_XCNT(j)  (256  + 64 * (j))
#define XB_XSUB(j)  (1280 + 64 * (j))
#define XB_XGEN(j)  (2304 + 64 * (j))
#define XB_TOP      3328
#define XB_TOPGEN   3392
#define XCD_BAR_WORDS 3456
#define XB_SPIN_CAP (1u << 18)
__device__ __forceinline__ unsigned xb_ld(unsigned* p)              { return __hip_atomic_load(p, __ATOMIC_RELAXED, __HIP_MEMORY_SCOPE_AGENT); }
__device__ __forceinline__ unsigned xb_add(unsigned* p, unsigned v) { return __hip_atomic_fetch_add(p, v, __ATOMIC_RELAXED, __HIP_MEMORY_SCOPE_AGENT); }
__device__ __forceinline__ unsigned xb_xcc_id() { return (unsigned)__builtin_amdgcn_s_getreg((3 << 11) | 20) & 0xFu; }
#define XB_SPIN(cond, bar) do { unsigned _sp = 0; while (cond) { __builtin_amdgcn_s_sleep(1); \
    if ((++_sp & 255u) == 0u) { if (xb_ld(&(bar)[XB_TMO])) break; if (_sp > XB_SPIN_CAP) { atomicAdd(&(bar)[XB_TMO], 1u); break; } } } } while (0)
struct XcdBarrier { unsigned* bar; unsigned x; volatile LAS unsigned* st; };
__device__ __forceinline__ XcdBarrier xcd_barrier_post(unsigned* bar, volatile LAS unsigned* st) {
    XcdBarrier b; b.bar = bar; b.x = xb_xcc_id(); b.st = st;
    if (threadIdx.x == 0) (void)xb_add(&bar[XB_XCNT(b.x)], 1u);
    return b;
}
__device__ __forceinline__ void xcd_barrier_complete(unsigned* bar, unsigned x, unsigned& nloc, unsigned& nx) {
    const unsigned G = gridDim.x * gridDim.y * gridDim.z;
    unsigned sum, cnt, mine, sp = 0u;
    for (;;) {
        sum = 0u; cnt = 0u; mine = 0u;
#pragma unroll
        for (unsigned j = 0; j < 16; ++j) { const unsigned c = xb_ld(&bar[XB_XCNT(j)]); sum += c; cnt += (c > 0u) ? 1u : 0u; mine = (j == x) ? c : mine; }
        if (sum == G) break;
        __builtin_amdgcn_s_sleep(1);
        if ((++sp & 255u) == 0u) { if (xb_ld(&bar[XB_TMO])) break; if (sp > XB_SPIN_CAP) { atomicAdd(&bar[XB_TMO], 1u); break; } }
    }
    nloc = mine > 0u ? mine : 1u; nx = cnt > 0u ? cnt : 1u;
}
__device__ __forceinline__ void xcd_barrier(const XcdBarrier& b) {
    asm volatile("s_waitcnt vmcnt(0)" ::: "memory");
    __syncthreads();
    if (threadIdx.x == 0) {
        unsigned* bar = b.bar;
        __builtin_amdgcn_s_waitcnt(0);
        unsigned nloc = b.st[0], nx = b.st[1];
        if (nloc == 0u) { xcd_barrier_complete(bar, b.x, nloc, nx); b.st[0] = nloc; b.st[1] = nx; }
        const unsigned old = xb_add(&bar[XB_XSUB(b.x)], 1u);
        const unsigned gen = old / nloc;
        if (old + 1u == (gen + 1u) * nloc) {
            __builtin_amdgcn_fence(__ATOMIC_RELEASE, "agent");
            asm volatile("s_waitcnt vmcnt(0)" ::: "memory");
            const unsigned og = xb_add(&bar[XB_TOP], 1u);
            const unsigned tg = og / nx;
            if (og + 1u == (tg + 1u) * nx) xb_add(&bar[XB_TOPGEN], 1u);
            else XB_SPIN(xb_ld(&bar[XB_TOPGEN]) == tg, bar);
            __builtin_amdgcn_fence(__ATOMIC_ACQUIRE, "agent");
            xb_add(&bar[XB_XGEN(b.x)], 1u);
            asm volatile("s_waitcnt vmcnt(0)" ::: "memory");
        } else {
            XB_SPIN(xb_ld(&bar[XB_XGEN(b.x)]) == gen, bar);
            __builtin_amdgcn_fence(__ATOMIC_ACQUIRE, "agent");
            asm volatile("s_waitcnt vmcnt(0)" ::: "memory");
        }
    }
    __syncthreads();
}

__device__ __forceinline__ void run_phase(const P& p, int ph, LAS unsigned char* lds) {
    if (ph == 2 * PPL) { if (EN(34)) phase_final(p); return; }
    const int l = ph / PPL, q = ph % PPL;
    unsigned char* ws = p.ws; bf16_t* W = (bf16_t*)(ws + WS_W);
    const int G = gridDim.x, c = bid_();
    pg8::Order S;
    switch (q) {
        case 0: if (EN(0)) { phase_prep(p, l, lds); if (l == 1) phase_norm(p, l, 1); } break;
        case 1: if (EN(1)) { if (l == 0) phase_norm(p, l, 1); } break;
        case 2: if (EN(2)) { pg8::Gemm g{(const bf16_t*)(ws + WS_R2), W + W_A / 2, TOK, 2816, 1024, 1024, 0, 0, 1}; S.init(TOK, 2816, 1, G, c);
            EpiPartA E{(bf16_t*)(ws + WS_R3), (bf16_t*)(ws + WS_R3) + (size_t)TOK * 512, (bf16_t*)(ws + WS_R4), (bf16_t*)(ws + WS_R5), (float*)(ws + WS_GLR)};
            pg8::gemm_phase(lds, g, S, E); } break;
        case 3: if (EN(3)) { pg8::Gemm g{(const bf16_t*)(ws + WS_R5), (const bf16_t*)(ws + WS_EMAT), 1280, 256, 512, 768, (size_t)1280 * 768, (size_t)256 * 512, 32}; S.init(1280, 256, 32, G, c);
            EpiE E{(float*)(ws + WS_E)}; pg8::gemm_phase(lds, g, S, E); } break;
        case 4: if (EN(4)) phase_s5scan(p, l); break;
        case 5: if (EN(5)) { pg8::Gemm g{(const bf16_t*)(ws + WS_R5), (const bf16_t*)(ws + WS_R1), 1280, 512, 768, 768, (size_t)1280 * 768, (size_t)512 * 768, 32}; S.init(1280, 512, 32, G, c);
            EpiY E{(bf16_t*)(ws + WS_E)}; pg8::gemm_phase(lds, g, S, E); } break;
        case 6: if (EN(6)) { pg8::Gemm g{(const bf16_t*)(ws + WS_E), W + W_GLU / 2, TOK, 512, 512, 512, 0, 0, 1}; S.init(TOK, 512, 1, G, c);
            EpiGLU E{(const bf16_t*)(ws + WS_E), (bf16_t*)(ws + WS_R6), p.in[lnd(24)] + (size_t)l * 512}; pg8::gemm_phase(lds, g, S, E); } break;
        case 7: if (EN(7)) phase_glapre(p, l, lds); break;
        case 8: if (EN(8)) phase_gla(p, l, lds); break;
        case 9: if (EN(9)) { pg8::Gemm g{(const bf16_t*)(ws + WS_R2), W + W_B / 2, TOK, 3072, 1024, 1024, 0, 0, 1}; S.init(TOK, 3072, 1, G, c);
            EpiPartB E{(bf16_t*)(ws + WS_R3), (bf16_t*)(ws + WS_R4), (bf16_t*)(ws + WS_R5)}; pg8::gemm_phase(lds, g, S, E); } break;
        case 10: if (EN(10)) phase_glapost(p, l); break;
        case 11: if (EN(11)) { pg8::Gemm g{(const bf16_t*)(ws + WS_R1), W + W_PG / 2, TOK, 1024, 1024, 1024, 0, 0, 1}; S.init(TOK, 1024, 1, G, c);
              EpiProj1 E{(const bf16_t*)(ws + WS_R4), (bf16_t*)(ws + WS_R2)}; pg8::gemm_phase(lds, g, S, E); } break;
        case 12: if (EN(12)) { pg8::Gemm g{(const bf16_t*)(ws + WS_R6), W + W_PS / 2, TOK, 1024, 512, 512, 0, 0, 1}; S.init(TOK, 1024, 1, G, c);
              EpiProj2 E{(const bf16_t*)(ws + WS_R5), (bf16_t*)(ws + WS_R2)}; pg8::gemm_phase(lds, g, S, E); } break;
        case 13: if (EN(13)) { pg8::Gemm g{(const bf16_t*)(ws + WS_R2), W + W_OUT / 2, TOK, 1024, 1024, 1024, 0, 0, 1}; S.init(TOK, 1024, 1, G, c);
            EpiDelta E{(bf16_t*)(ws + WS_R3), (const float*)(ws + WS_MOD) + (size_t)l * 9 * 6144 + 2048}; pg8::gemm_phase(lds, g, S, E); } break;
        case 14: if (EN(14)) phase_norm(p, l, 2); break;
        case 15: if (EN(15)) { pg8::Gemm g{(const bf16_t*)(ws + WS_R2), W + W_1 / 2, TOK, 4096, 1024, 1024, 0, 0, 1}; S.init(TOK, 4096, 1, G, c);
            EpiFF1 E{(bf16_t*)(ws + WS_HID)}; pg8::gemm_phase(lds, g, S, E); } break;
        case 16: if (EN(16)) { pg8::Gemm g{(const bf16_t*)(ws + WS_HID), W + W_2 / 2, TOK, 1024, 4096, 4096, 0, 0, 1}; S.init(TOK, 1024, 1, G, c);
            EpiDelta E{(bf16_t*)(ws + WS_R2), (const float*)(ws + WS_MOD) + (size_t)l * 9 * 6144 + 5120}; pg8::gemm_phase(lds, g, S, E); } break;
        default: break;
    }
}

__global__ void __launch_bounds__(NTHR, 2) fwd_megakernel(P p) {
    extern __shared__ __attribute__((aligned(16))) unsigned char lds_raw[];
    LAS unsigned char* lds = (LAS unsigned char*)lds_raw;
#if MULTI_LAUNCH
    for (int ph = p.ph_lo; ph < p.ph_hi; ++ph) run_phase(p, ph, lds);
#else
    cg::grid_group grid = cg::this_grid();
    if (p.ph_lo < 0) grid.sync();
    volatile LAS unsigned* stw = (volatile LAS unsigned*)(lds + LDS_BYTES - 16);
    if (threadIdx.x < 4) stw[threadIdx.x] = 0u;
    __syncthreads();
    const XcdBarrier bar = xcd_barrier_post((unsigned*)(p.ws + WS_BAR), stw);
    for (int ph = p.ph_lo; ph < p.ph_hi; ++ph) {
        run_phase(p, ph, lds);
#if REP_MASK
        if (ph < 2 * PPL && ((REP_MASK >> (ph % PPL)) & 1)) {
            xcd_barrier(bar);
            if ((ph % PPL) == 12) { run_phase(p, ph - 1, lds); }
            run_phase(p, ph, lds);
        }
#endif
        if (ph + 1 < p.ph_hi && (ph % PPL) != 11 && ph != PPL) xcd_barrier(bar);
    }
#endif
}

extern "C" void kernel_launch(void* const* d_in, const int* in_sizes, int n_in, void* d_out, int out_size, void* d_ws, size_t ws_size, hipStream_t stream) {
    static int grid = 0;
    if (grid == 0) {
        if (n_in != 31 || ws_size < WS_END) { fprintf(stderr, "kernel_launch: unexpected n_in %d or ws_size %zu (< %zu)\n", n_in, ws_size, (size_t)WS_END); grid = -1; return; }
        int dev = 0, cus = 0, per_cu = 0;
        hipGetDevice(&dev);
        hipDeviceGetAttribute(&cus, hipDeviceAttributeMultiprocessorCount, dev);
        if (hipFuncSetAttribute((const void*)fwd_megakernel, hipFuncAttributeMaxDynamicSharedMemorySize, LDS_BYTES) != hipSuccess) { fprintf(stderr, "kernel_launch: hipFuncSetAttribute failed\n"); grid = -1; return; }
        hipOccupancyMaxActiveBlocksPerMultiprocessor(&per_cu, (const void*)fwd_megakernel, NTHR, LDS_BYTES);
        (void)hipGetLastError();
        if (per_cu < 1) fprintf(stderr, "kernel_launch: occupancy query says %d blocks per CU\n", per_cu);
        grid = cus > 0 ? cus : 256;
    }
    if (grid < 0) return;
    P p{};
    for (int i = 0; i < 31; ++i) p.in[i] = (const float*)d_in[i];
    p.out = (float*)d_out; p.ws = (unsigned char*)d_ws;
#if MULTI_LAUNCH
    for (int ph = 0; ph < NPHASE; ++ph) { p.ph_lo = ph; p.ph_hi = ph + 1; hipLaunchKernelGGL(fwd_megakernel, dim3(grid), dim3(NTHR), LDS_BYTES, stream, p); }
#else
    p.ph_lo = 0; p.ph_hi = NPHASE;
    (void)hipMemsetAsync((char*)d_ws + WS_BAR, 0, XCD_BAR_WORDS * sizeof(unsigned), stream);
    void* args[] = {&p};
    hipError_t e = hipLaunchCooperativeKernel((const void*)fwd_megakernel, dim3(grid), dim3(NTHR), args, LDS_BYTES, stream);
    if (e != hipSuccess) fprintf(stderr, "cooperative launch failed: %s (grid %d)\n", hipGetErrorString(e), grid);
#endif
}
```

```cpp
#include <hip/hip_runtime.h>
#include <hip/hip_cooperative_groups.h>
#include <cstdio>
namespace cg = cooperative_groups;

#ifndef MULTI_LAUNCH
#define MULTI_LAUNCH 0
#endif

#ifndef REP_MASK
#define REP_MASK 0
#endif
#ifndef PHASE_SEL
#define PHASE_SEL -1
#endif
#define EN(q) (PHASE_SEL < 0 || PHASE_SEL == (q))
#define LAS __attribute__((address_space(3)))
typedef unsigned short bf16_t;
typedef short bf16x8 __attribute__((ext_vector_type(8)));
typedef float f32x4 __attribute__((ext_vector_type(4)));
typedef unsigned u32x4 __attribute__((ext_vector_type(4)));
typedef unsigned u32x2 __attribute__((ext_vector_type(2)));

constexpr int NTHR = 512;
constexpr int TOK = 40960, TOKP = 8192;
constexpr int LDS_BYTES = 147456;
constexpr int NPHASE = 35;
constexpr int PPL = 17;

constexpr size_t MiB = (size_t)1 << 20;
constexpr size_t WS_MOD = 0;
constexpr size_t WS_GLR = 1 * MiB;
constexpr size_t WS_TOTF = 7 * MiB;
constexpr size_t WS_TOTB = 9 * MiB;
constexpr size_t WS_BAR = 12 * MiB;
constexpr size_t WS_W = 16 * MiB;
constexpr size_t W_A = 0;
constexpr size_t W_B = W_A + (size_t)2816 * 1024 * 2;
constexpr size_t W_PG = W_B + (size_t)3072 * 1024 * 2;
constexpr size_t W_GLU = W_PG + (size_t)1024 * 1024 * 2;
constexpr size_t W_PS = W_GLU + (size_t)512 * 512 * 2;
constexpr size_t W_OUT = W_PS + (size_t)1024 * 512 * 2;
constexpr size_t W_1 = W_OUT + (size_t)1024 * 1024 * 2;
constexpr size_t W_2 = W_1 + (size_t)4096 * 1024 * 2;
constexpr size_t WS_R2 = 50 * MiB;
constexpr size_t WS_R3 = 130 * MiB;
constexpr size_t WS_R4 = 210 * MiB;
constexpr size_t WS_R5 = 290 * MiB;
constexpr size_t WS_E = 350 * MiB;
constexpr size_t WS_R6 = 390 * MiB;
constexpr size_t WS_R1 = 430 * MiB;
constexpr size_t WS_EMAT = 454 * MiB;
constexpr size_t WS_HID = 130 * MiB;
constexpr size_t WS_END = 510 * MiB;

struct P { const float* in[31]; float* out; unsigned char* ws; int ph_lo, ph_hi; };

__device__ __forceinline__ int tid_() { int t = threadIdx.x; asm volatile("" : "+v"(t)); return t; }
__device__ __forceinline__ int bid_() { int b = blockIdx.x; asm volatile("" : "+s"(b)); return b; }
__device__ __forceinline__ int lnd(int k) { asm volatile("" : "+s"(k)); return k; }
__device__ __forceinline__ unsigned pk_bf16(float lo, float hi) { unsigned r; asm("v_cvt_pk_bf16_f32 %0, %1, %2" : "=v"(r) : "v"(lo), "v"(hi)); return r; }
__device__ __forceinline__ float bf2f(bf16_t b) { return __uint_as_float(((unsigned)b) << 16); }
__device__ __forceinline__ float bflo(unsigned w) { return __uint_as_float(w << 16); }
__device__ __forceinline__ float bfhi(unsigned w) { return __uint_as_float(w & 0xffff0000u); }
__device__ __forceinline__ bf16_t f2bf(float f) { return (bf16_t)(pk_bf16(f, 0.f) & 0xffffu); }
__device__ __forceinline__ float sigmoidf_(float x) { return 1.0f / (1.0f + __expf(-x)); }
__device__ __forceinline__ void store4bf(bf16_t* ptr, f32x4 v) { u32x2 w; w.x = pk_bf16(v[0], v[1]); w.y = pk_bf16(v[2], v[3]); *(u32x2*)ptr = w; }
__device__ __forceinline__ f32x4 load4bf(const bf16_t* ptr) { u32x2 w = *(const u32x2*)ptr; return (f32x4){bflo(w.x), bfhi(w.x), bflo(w.y), bfhi(w.y)}; }
__device__ __forceinline__ int mod_index(int tok) { return tok < TOKP ? 0 : (tok >> 12) - 1; }
__device__ __forceinline__ float wave_sum(float v) {
#pragma unroll
    for (int o = 32; o >= 1; o >>= 1) v += __shfl_xor(v, o);
    return v;
}

namespace pg8 {
constexpr int BM = 256, BK = 64, HALF = 128, HTB = HALF * BK * 2, STAGE_BYTES = 8 * HTB, NXCD = 8, WGM = 8;
__device__ __forceinline__ int lds_byte(int r, int c) { const int st = (r >> 4) * 2 + (c >> 5), rr = r & 15, cc = c & 31, ob = rr * 64 + cc * 2; return st * 1024 + (ob ^ (((ob >> 9) & 1) << 5)); }
__device__ __forceinline__ void stage_rc(int b, int& R, int& C) { const int st = b / 1024, sb = b % 1024, swz = sb ^ (((sb >> 9) & 1) << 5); R = (st >> 1) * 16 + swz / 64; C = (st & 1) * 32 + (swz % 64) / 2; }

struct Unit { int pm, pn, z, hf; };
struct Gemm { const bf16_t* A; const bf16_t* Bt; int M, N, K, lda; size_t sA, sB; int nz; };
struct Order {
    int nM, nN, nwg, G, c, nz, nfull, rem2;
    __device__ __forceinline__ void init(int M, int N, int nz_, int G_, int c_) { nM = M / BM; nN = N / BM; nwg = nM * nN; G = G_; c = c_; nz = nz_;
        nfull = nwg; rem2 = 0;
        if (nz == 1) { const int full = (nwg / G) * G, rem = nwg - full; if (rem > 0 && 2 * rem <= G) { nfull = full; rem2 = 2 * rem; } } }
    __device__ __forceinline__ void map(int wgid, Unit& u) const {
        { const int q = nwg / NXCD, r = nwg % NXCD, xcd = wgid % NXCD, off = wgid / NXCD; wgid = (xcd < r ? xcd * (q + 1) : r * (q + 1) + (xcd - r) * q) + off; }
        const int nig = WGM * nN, gid = wgid / nig, fm = gid * WGM, gsz = (nM - fm) < WGM ? (nM - fm) : WGM;
        u.pm = fm + ((wgid % nig) % gsz); u.pn = (wgid % nig) / gsz; u.z = 0; }
    __device__ __forceinline__ bool next(int i, Unit& u) const {
        const long L = (long)i * G + c;
        if (nz == 1) {
            if (L < nfull) { map((int)L, u); u.hf = 0; return true; }
            const int t = (int)(L - nfull); if (t >= rem2) return false;
            map(nfull + (t >> 1), u); u.hf = 1 + (t & 1); return true;
        }
        if (L >= (long)nwg * nz) return false;
        const int z = (int)(L / nwg), r = (int)(L % nwg); u.z = z; u.pm = r % nM; u.pn = r / nM; u.hf = 0;
        return true;
    }
};

template <class Epi>
__device__ __forceinline__ void gemm_phase(LAS unsigned char* lds, const Gemm g, const Order& S, const Epi& E) {
    const int tid = tid_(), wid = __builtin_amdgcn_readfirstlane(tid >> 6), lane = tid & 63, wr = wid >> 2, wc = wid & 3, fr = lane & 15, fq = lane >> 4;
    const int K = g.K, nt = K / BK;
    unsigned voffA[2], voffB[2];
#pragma unroll
    for (int i = 0; i < 2; ++i) { int R, C; stage_rc(tid * 16 + i * 8192, R, C); voffA[i] = (unsigned)(R * g.lda + C) * 2u; voffB[i] = (unsigned)(R * K + C) * 2u; }
    const size_t kstep = (size_t)(BK * 2);
    const size_t hstepA = (size_t)HALF * g.lda * 2, hstepB = (size_t)HALF * K * 2;
    const unsigned ldsw = (unsigned)wid * 1024u;
    const int aoff = lds_byte(wr * 64 + fr, fq * 8), boff = lds_byte(wc * 32 + fr, fq * 8);
#define PG8_SA(b, h) (((b) * 2 + (h)) * HTB)
#define PG8_SB(b, h) ((4 + (b) * 2 + (h)) * HTB)
#define PG8_STAGE(bufoff, gbase, voff) do { _Pragma("unroll") for (int _i = 0; _i < 2; ++_i) \
        __builtin_amdgcn_global_load_lds((const unsigned*)((const char*)(gbase) + (voff)[_i]), (LAS unsigned*)(lds + (bufoff) + ldsw + _i * 8192), 16, 0, 0); } while (0)
#define PG8_LDA(dst, b, h) do { _Pragma("unroll") for (int m = 0; m < 4; ++m) _Pragma("unroll") for (int k = 0; k < 2; ++k) dst[m][k] = *(const LAS bf16x8*)(lds + PG8_SA(b, h) + aoff + m * 2048 + k * 1024); } while (0)
#define PG8_LDB(dst, b, h) do { _Pragma("unroll") for (int n = 0; n < 2; ++n) _Pragma("unroll") for (int k = 0; k < 2; ++k) dst[n][k] = *(const LAS bf16x8*)(lds + PG8_SB(b, h) + boff + n * 2048 + k * 1024); } while (0)
#define PG8_MMA(ai, bj, At, Bt) do { __builtin_amdgcn_s_setprio(1); _Pragma("unroll") for (int m = 0; m < 4; ++m) _Pragma("unroll") for (int n = 0; n < 2; ++n) _Pragma("unroll") for (int k = 0; k < 2; ++k) \
        acc[ai][bj][m][n] = __builtin_amdgcn_mfma_f32_16x16x32_bf16(Bt[n][k], At[m][k], acc[ai][bj][m][n], 0, 0, 0); __builtin_amdgcn_s_setprio(0); } while (0)
#define PG8_WAIT_V(n) asm volatile("s_waitcnt vmcnt(" #n ")" ::: "memory")
#define PG8_WAIT_L(n) asm volatile("s_waitcnt lgkmcnt(" #n ")" ::: "memory")
#define PG8_BAR __builtin_amdgcn_s_barrier()
#define PG8_SCHED __builtin_amdgcn_sched_barrier(0)
    Unit cur, nxt; int ui = 0;
    if (!S.next(0, cur)) return;
    f32x4 acc[2][2][4][2];
#pragma unroll
    for (int a = 0; a < 2; ++a)
#pragma unroll
        for (int b = 0; b < 2; ++b)
#pragma unroll
            for (int m = 0; m < 4; ++m)
#pragma unroll
                for (int n = 0; n < 2; ++n) acc[a][b][m][n] = (f32x4){0.f, 0.f, 0.f, 0.f};
    bf16x8 At[4][2], B0[2][2], B1[2][2];
    const char* cA = (const char*)g.A + ((size_t)cur.z * g.sA + (size_t)(cur.pm * BM + (cur.hf == 2 ? HALF : 0)) * g.lda) * 2;
    const char* cB = (const char*)g.Bt + ((size_t)cur.z * g.sB + (size_t)cur.pn * BM * K) * 2;
    PG8_STAGE(PG8_SB(0, 0), cB, voffB); PG8_STAGE(PG8_SB(0, 1), cB + hstepB, voffB); PG8_STAGE(PG8_SA(0, 0), cA, voffA); PG8_STAGE(PG8_SA(0, 1), cA + hstepA, voffA);
    if (wr == 1) PG8_BAR;
    PG8_WAIT_V(2); PG8_BAR;
    PG8_STAGE(PG8_SB(1, 0), cB + kstep, voffB); PG8_STAGE(PG8_SA(1, 0), cA + kstep, voffA); PG8_STAGE(PG8_SB(1, 1), cB + hstepB + kstep, voffB);
    PG8_WAIT_V(6); PG8_BAR;
    for (;;) {
        const bool has_next = S.next(ui + 1, nxt);
        const char* nA = has_next ? (const char*)g.A + ((size_t)nxt.z * g.sA + (size_t)(nxt.pm * BM + (nxt.hf == 2 ? HALF : 0)) * g.lda) * 2 : cA;
        const bool fullu = (cur.hf == 0);
        const char* nB = has_next ? (const char*)g.Bt + ((size_t)nxt.z * g.sB + (size_t)nxt.pn * BM * K) * 2 : cB;
        for (int t = 0; t < nt; t += 2) {
            const bool last = (t == nt - 2);
            const char* a1 = cA + (size_t)(t + 1) * kstep;
            const char* a2 = last ? nA : cA + (size_t)(t + 2) * kstep; const char* b2 = last ? nB : cB + (size_t)(t + 2) * kstep;
            const char* a3 = a2 + kstep; const char* b3 = b2 + kstep;
            PG8_LDB(B0, 0, 0); PG8_LDB(B1, 0, 1); PG8_SCHED; PG8_LDA(At, 0, 0); PG8_STAGE(PG8_SA(1, 1), a1 + hstepA, voffA);
            PG8_WAIT_V(8); PG8_WAIT_L(0); PG8_BAR; PG8_MMA(0, 0, At, B0); PG8_MMA(0, 1, At, B1); PG8_BAR; PG8_SCHED;
            if (fullu) PG8_LDA(At, 0, 1); PG8_STAGE(PG8_SB(0, 0), b2, voffB); PG8_STAGE(PG8_SB(0, 1), b2 + hstepB, voffB); PG8_STAGE(PG8_SA(0, 0), a2, voffA);
            PG8_WAIT_V(8); PG8_WAIT_L(0); PG8_BAR; if (fullu) { PG8_MMA(1, 0, At, B0); PG8_MMA(1, 1, At, B1); } PG8_BAR; PG8_SCHED;
            PG8_LDB(B0, 1, 0); PG8_LDB(B1, 1, 1); PG8_SCHED; PG8_LDA(At, 1, 0); PG8_STAGE(PG8_SA(0, 1), a2 + hstepA, voffA);
            PG8_WAIT_V(8); PG8_WAIT_L(0); PG8_BAR; PG8_MMA(0, 0, At, B0); PG8_MMA(0, 1, At, B1); PG8_BAR; PG8_SCHED;
            if (fullu) PG8_LDA(At, 1, 1); PG8_STAGE(PG8_SB(1, 0), b3, voffB); PG8_STAGE(PG8_SB(1, 1), b3 + hstepB, voffB); PG8_STAGE(PG8_SA(1, 0), a3, voffA);
            PG8_WAIT_V(8); PG8_WAIT_L(0); PG8_BAR; if (fullu) { PG8_MMA(1, 0, At, B0); PG8_MMA(1, 1, At, B1); } PG8_BAR; PG8_SCHED;
        }
        if (wr == 0) PG8_BAR;
        if (fullu) E.template tile<2>(acc, cur.z, cur.pm * BM + wr * 64 + fr, cur.pn * BM + wc * 32 + (Epi::PERM ? 8 : 4) * fq);
        else E.template tile<1>(acc, cur.z, cur.pm * BM + (cur.hf == 2 ? HALF : 0) + wr * 64 + fr, cur.pn * BM + wc * 32 + (Epi::PERM ? 8 : 4) * fq);
        if (!has_next) break;
#pragma unroll
        for (int a = 0; a < 2; ++a)
#pragma unroll
            for (int b = 0; b < 2; ++b)
#pragma unroll
                for (int m = 0; m < 4; ++m)
#pragma unroll
                    for (int n = 0; n < 2; ++n) acc[a][b][m][n] = (f32x4){0.f, 0.f, 0.f, 0.f};
        cur = nxt; cA = nA; cB = nB; ++ui;
        if (wr == 1) PG8_BAR;
    }
    PG8_WAIT_V(0);
    PG8_BAR;
#undef PG8_SA
#undef PG8_SB
#undef PG8_STAGE
#undef PG8_LDA
#undef PG8_LDB
#undef PG8_MMA
#undef PG8_WAIT_V
#undef PG8_WAIT_L
#undef PG8_BAR
#undef PG8_SCHED
}
}

#define EPI_SIMPLE_TILE() \
    static constexpr bool PERM = false; \
    template <int NAI> __device__ __forceinline__ void tile(const f32x4 (&acc)[2][2][4][2], int z, int row0, int col0) const { \
        _Pragma("unroll") for (int ai = 0; ai < NAI; ++ai) _Pragma("unroll") for (int m = 0; m < 4; ++m) _Pragma("unroll") for (int bj = 0; bj < 2; ++bj) _Pragma("unroll") for (int n = 0; n < 2; ++n) \
            (*this)(z, row0 + ai * 128 + m * 16, col0 + bj * 128 + n * 16, acc[ai][bj][m][n]); }
#define EPI_PAIR_TILE() \
    static constexpr bool PERM = true; \
    template <int NAI> __device__ __forceinline__ void tile(const f32x4 (&acc)[2][2][4][2], int z, int row0, int col0) const { \
        _Pragma("unroll") for (int ai = 0; ai < NAI; ++ai) _Pragma("unroll") for (int m = 0; m < 4; ++m) _Pragma("unroll") for (int bj = 0; bj < 2; ++bj) \
            pair(row0 + ai * 128 + m * 16, col0 + bj * 128, acc[ai][bj][m][0], acc[ai][bj][m][1]); }
#define EPI_PIPE_TILE() \
    static constexpr bool PERM = true; \
    template <int NAI> __device__ __forceinline__ void tile(const f32x4 (&acc)[2][2][4][2], int z, int row0, int col0) const { \
        Pre pre; begin(row0, col0, pre); L buf[2][8]; \
        _Pragma("unroll") for (int mm = 0; mm < 2; ++mm) _Pragma("unroll") for (int bj = 0; bj < 2; ++bj) _Pragma("unroll") for (int n = 0; n < 2; ++n) load(row0 + mm * 16, col0 + bj * 128 + n * 4, buf[0][mm * 4 + bj * 2 + n]); \
        _Pragma("unroll") for (int b = 0; b < 2 * NAI; ++b) { \
            if (b < 2 * NAI - 1) { _Pragma("unroll") for (int mm = 0; mm < 2; ++mm) _Pragma("unroll") for (int bj = 0; bj < 2; ++bj) _Pragma("unroll") for (int n = 0; n < 2; ++n) \
                load(row0 + ((b + 1) >> 1) * 128 + (((b + 1) & 1) * 2 + mm) * 16, col0 + bj * 128 + n * 4, buf[(b + 1) & 1][mm * 4 + bj * 2 + n]); } \
            _Pragma("unroll") for (int mm = 0; mm < 2; ++mm) _Pragma("unroll") for (int bj = 0; bj < 2; ++bj) _Pragma("unroll") for (int n = 0; n < 2; ++n) \
                apply(row0 + (b >> 1) * 128 + ((b & 1) * 2 + mm) * 16, col0 + bj * 128 + n * 4, acc[b >> 1][bj][(b & 1) * 2 + mm][n], buf[b & 1][mm * 4 + bj * 2 + n], pre, bj * 2 + n); } }
__device__ __forceinline__ void store8bf(bf16_t* ptr, f32x4 a, f32x4 b) { u32x4 w; w.x = pk_bf16(a[0], a[1]); w.y = pk_bf16(a[2], a[3]); w.z = pk_bf16(b[0], b[1]); w.w = pk_bf16(b[2], b[3]); *(u32x4*)ptr = w; }

struct EpiPartA {
    bf16_t* Q; bf16_t* Kk; bf16_t* V; bf16_t* UG; float* GLR;
    __device__ __forceinline__ void pair(int row, int col, f32x4 a, f32x4 b) const {
        if (col < 512) store8bf(Q + (size_t)row * 512 + col, a, b);
        else if (col < 1024) store8bf(Kk + (size_t)row * 512 + (col - 512), a, b);
        else if (col < 2048) store8bf(V + (size_t)row * 1024 + (col - 1024), a, b);
        else if (col < 2304) { const int c = col - 2048; if (c < 32) { *(f32x4*)(GLR + (size_t)row * 32 + c) = a; *(f32x4*)(GLR + (size_t)row * 32 + c + 4) = b; } }
        else { const int c = col - 2304, g = c >> 4, n = c & 15, chunk = row >> 5, j = row & 31; store8bf(UG + ((size_t)(g * 1280 + chunk) * 768 + j * 16 + n), a, b); }
    }
    EPI_PAIR_TILE()
};
struct EpiE { float* E; __device__ __forceinline__ void operator()(int z, int row, int col, f32x4 v) const { *(f32x4*)(E + ((size_t)(z * 1280 + row) * 256 + col)) = v; } EPI_SIMPLE_TILE() };
struct EpiY {
    bf16_t* YB;
    __device__ __forceinline__ void operator()(int z, int row, int col, f32x4 v) const {
        const int tok = row * 32 + (col >> 4), ch = z * 16 + (col & 15);
        f32x4 o;
#pragma unroll
        for (int e = 0; e < 4; ++e) { const float x = v[e]; o[e] = x * sigmoidf_(1.5957691216f * (x + 0.044715f * x * x * x)); }
        store4bf(YB + (size_t)tok * 512 + ch, o);
    }
    EPI_SIMPLE_TILE()
};
struct EpiGLU {
    const bf16_t* YB; bf16_t* OS5; const float* bglu;
    typedef u32x2 L; struct Pre { f32x4 b[4]; };
    __device__ __forceinline__ void begin(int, int col0, Pre& pr) const {
#pragma unroll
        for (int k = 0; k < 4; ++k) pr.b[k] = *(const f32x4*)(bglu + col0 + (k >> 1) * 128 + (k & 1) * 4); }
    __device__ __forceinline__ void load(int row, int col, L& l) const { l = *(const u32x2*)(YB + (size_t)row * 512 + col); }
    __device__ __forceinline__ void apply(int row, int col, f32x4 v, const L& l, const Pre& pr, int k) const {
        const f32x4 y = (f32x4){bflo(l.x), bfhi(l.x), bflo(l.y), bfhi(l.y)}; f32x4 o;
#pragma unroll
        for (int e = 0; e < 4; ++e) o[e] = y[e] * sigmoidf_(v[e] + pr.b[k][e]);
        store4bf(OS5 + (size_t)row * 512 + col, o); }
    EPI_PIPE_TILE()
};
struct EpiPartB {
    bf16_t* R; bf16_t* GA; bf16_t* GB;
    __device__ __forceinline__ void pair(int row, int col, f32x4 a, f32x4 b) const {
        f32x4 sa, sb;
#pragma unroll
        for (int e = 0; e < 4; ++e) { sa[e] = sigmoidf_(a[e]); sb[e] = sigmoidf_(b[e]); }
        if (col < 1024) store8bf(R + (size_t)row * 1024 + col, a * sa, b * sb);
        else if (col < 2048) store8bf(GA + (size_t)row * 1024 + (col - 1024), sa, sb);
        else store8bf(GB + (size_t)row * 1024 + (col - 2048), sa, sb);
    }
    EPI_PAIR_TILE()
};
struct EpiProj1 { const bf16_t* GA; bf16_t* T1;
    typedef u32x2 L; struct Pre { int dummy; };
    __device__ __forceinline__ void begin(int, int, Pre&) const {}
    __device__ __forceinline__ void load(int row, int col, L& l) const { l = *(const u32x2*)(GA + (size_t)row * 1024 + col); }
    __device__ __forceinline__ void apply(int row, int col, f32x4 v, const L& l, const Pre&, int) const {
        const f32x4 g = (f32x4){bflo(l.x), bfhi(l.x), bflo(l.y), bfhi(l.y)}; store4bf(T1 + (size_t)row * 1024 + col, g * v); }
    EPI_PIPE_TILE()
};
struct EpiProj2 { const bf16_t* GB; bf16_t* T1;
    struct L { u32x2 t, g; }; struct Pre { int dummy; };
    __device__ __forceinline__ void begin(int, int, Pre&) const {}
    __device__ __forceinline__ void load(int row, int col, L& l) const { const size_t o = (size_t)row * 1024 + col; l.t = *(const u32x2*)(T1 + o); l.g = *(const u32x2*)(GB + o); }
    __device__ __forceinline__ void apply(int row, int col, f32x4 v, const L& l, const Pre&, int) const {
        const f32x4 g = (f32x4){bflo(l.g.x), bfhi(l.g.x), bflo(l.g.y), bfhi(l.g.y)}, t = (f32x4){bflo(l.t.x), bfhi(l.t.x), bflo(l.t.y), bfhi(l.t.y)};
        store4bf(T1 + (size_t)row * 1024 + col, t + g * v); }
    EPI_PIPE_TILE()
};
struct EpiDelta { bf16_t* Dl; const float* gate;
    static constexpr bool PERM = true;
    template <int NAI> __device__ __forceinline__ void tile(const f32x4 (&acc)[2][2][4][2], int, int row0, int col0) const {
        const float* gp = gate + (size_t)mod_index(row0) * 6144 + col0; f32x4 g[2][2];
#pragma unroll
        for (int bj = 0; bj < 2; ++bj)
#pragma unroll
            for (int n = 0; n < 2; ++n) g[bj][n] = *(const f32x4*)(gp + bj * 128 + n * 4);
#pragma unroll
        for (int ai = 0; ai < NAI; ++ai)
#pragma unroll
            for (int m = 0; m < 4; ++m)
#pragma unroll
                for (int bj = 0; bj < 2; ++bj) store8bf(Dl + (size_t)(row0 + ai * 128 + m * 16) * 1024 + col0 + bj * 128, g[bj][0] * acc[ai][bj][m][0], g[bj][1] * acc[ai][bj][m][1]);
    } };
struct EpiFF1 { bf16_t* H;
    __device__ __forceinline__ void pair(int row, int col, f32x4 a, f32x4 b) const {
        f32x4 oa, ob;
#pragma unroll
        for (int e = 0; e < 4; ++e) { const float ra = fmaxf(a[e], 0.f), rb = fmaxf(b[e], 0.f); oa[e] = ra * ra; ob[e] = rb * rb; }
        store8bf(H + (size_t)row * 4096 + col, oa, ob); }
    EPI_PAIR_TILE()
};

struct ConvJob { const float* src; int ld, K, c0, nvalid, ndst; bf16_t* dst; float scale; };
__device__ __forceinline__ bool conv_job(const P& p, int l, int j, ConvJob& J) {
    bf16_t* W = (bf16_t*)(p.ws + WS_W);
    const float* win = p.in[lnd(10)] + (size_t)l * 1024 * 5664;
    J.scale = 1.0f;
    switch (j) {
        case 0: J = {win, 5664, 1024, 0, 512, 512, W + W_A / 2, 0.08838834764831845f}; break;
        case 1: J = {win, 5664, 1024, 512, 512, 512, W + W_A / 2 + (size_t)512 * 1024, 1.f}; break;
        case 2: J = {win, 5664, 1024, 1024, 1024, 1024, W + W_A / 2 + (size_t)1024 * 1024, 1.f}; break;
        case 3: J = {win, 5664, 1024, 3072, 32, 256, W + W_A / 2 + (size_t)2048 * 1024, 1.f}; break;
        case 4: J = {win, 5664, 1024, 3104, 512, 512, W + W_A / 2 + (size_t)2304 * 1024, 1.f}; break;
        case 5: J = {win, 5664, 1024, 2048, 1024, 1024, W + W_B / 2, 1.f}; break;
        case 6: J = {win, 5664, 1024, 3616, 1024, 1024, W + W_B / 2 + (size_t)1024 * 1024, 1.f}; break;
        case 7: J = {win, 5664, 1024, 4640, 1024, 1024, W + W_B / 2 + (size_t)2048 * 1024, 1.f}; break;
        case 8: J = {p.in[lnd(14)] + (size_t)l * 1024 * 1024, 1024, 1024, 0, 1024, 1024, W + W_PG / 2, 1.f}; break;
        case 9: J = {p.in[lnd(23)] + (size_t)l * 512 * 512, 512, 512, 0, 512, 512, W + W_GLU / 2, 1.f}; break;
        case 10: J = {p.in[lnd(25)] + (size_t)l * 512 * 1024, 1024, 512, 0, 1024, 1024, W + W_PS / 2, 1.f}; break;
        case 11: J = {p.in[lnd(26)] + (size_t)l * 1024 * 1024, 1024, 1024, 0, 1024, 1024, W + W_OUT / 2, 1.f}; break;
        case 12: J = {p.in[lnd(28)] + (size_t)l * 1024 * 4096, 4096, 1024, 0, 4096, 4096, W + W_1 / 2, 1.f}; break;
        case 13: J = {p.in[lnd(29)] + (size_t)l * 4096 * 1024, 1024, 4096, 0, 1024, 1024, W + W_2 / 2, 1.f}; break;
        default: return false;
    }
    return true;
}
constexpr int CONV_TILES = 2112;
__device__ __forceinline__ void conv_tile(const P& p, int l, int tile, LAS float* sT) {
    const int tid = tid_();
    ConvJob J; int j = 0, rem = tile;
    for (; j < 14; ++j) { conv_job(p, l, j, J); const int nt = (J.ndst / 64) * (J.K / 128); if (rem < nt) break; rem -= nt; }
    const int kts = J.K / 128, ntile = rem / kts, ktile = rem % kts, n0 = ntile * 64, k0 = ktile * 128;
    {
        const int kk = tid >> 4, c4 = (tid & 15) * 4; f32x4 v[4];
#pragma unroll
        for (int i = 0; i < 4; ++i) { v[i] = (f32x4){0.f, 0.f, 0.f, 0.f};
            if (n0 + c4 < J.nvalid) v[i] = *(const f32x4*)(J.src + (size_t)(k0 + kk + 32 * i) * J.ld + J.c0 + n0 + c4); }
#pragma unroll
        for (int i = 0; i < 4; ++i)
#pragma unroll
            for (int e = 0; e < 4; ++e) sT[(c4 + e) * 129 + kk + 32 * i] = v[i][e] * J.scale;
    }
    __syncthreads();
    {
        const int n = tid >> 3, ks = (tid & 7) * 16;
        const int rho = n & 31, nsrc = (n & ~31) + 8 * ((rho & 15) >> 2) + 4 * (rho >> 4) + (rho & 3);
        const LAS float* sp = sT + nsrc * 129 + ks;
#pragma unroll
        for (int hh = 0; hh < 2; ++hh) { u32x4 w; const LAS float* q = sp + 8 * hh;
            w.x = pk_bf16(q[0], q[1]); w.y = pk_bf16(q[2], q[3]); w.z = pk_bf16(q[4], q[5]); w.w = pk_bf16(q[6], q[7]);
            *(u32x4*)(J.dst + (size_t)(n0 + n) * J.K + k0 + ks + 8 * hh) = w; }
    }
}

__device__ __forceinline__ void mod_task(const P& p, int m, LAS float* sm) {
    const int tid = tid_(), l = m / 192, colbase = (m % 192) * 32, cl = tid & 31, ks = tid >> 5;
    LAS float* SC = sm; LAS float* RED = sm + 9216;
    for (int i = tid; i < 9216; i += NTHR) { const int j = i >> 10, k = i & 1023; const float c = (j == 0) ? p.in[lnd(6)][k] : p.in[lnd(2)][(j - 1) * 1024 + k]; SC[i] = c * sigmoidf_(c); }
    __syncthreads();
    float acc[9];
#pragma unroll
    for (int j = 0; j < 9; ++j) acc[j] = 0.f;
    const float* w = p.in[lnd(7)] + (size_t)l * 1024 * 6144 + colbase + cl;
    for (int k8 = 0; k8 < 64; k8 += 16) { float wv[16];
#pragma unroll
        for (int u = 0; u < 16; ++u) wv[u] = w[(size_t)(ks * 64 + k8 + u) * 6144];
#pragma unroll
        for (int u = 0; u < 16; ++u)
#pragma unroll
            for (int j = 0; j < 9; ++j) acc[j] += SC[j * 1024 + ks * 64 + k8 + u] * wv[u]; }
#pragma unroll
    for (int j = 0; j < 9; ++j) RED[(ks * 9 + j) * 32 + cl] = acc[j];
    __syncthreads();
    if (tid < 288) { const int j = tid >> 5, c = tid & 31; float s = 0.f;
#pragma unroll
        for (int q = 0; q < 16; ++q) s += RED[(q * 9 + j) * 32 + c];
        float* mod = (float*)(p.ws + WS_MOD);
        mod[((size_t)l * 9 + j) * 6144 + colbase + c] = s + p.in[lnd(8)][(size_t)l * 6144 + colbase + c]; }
}

__device__ __forceinline__ void s5_mats(const P& p, int l, int gq, LAS float* sm) {
    const int tid = tid_(), g = gq >> 2, part = gq & 3;
    LAS float* KF = sm; LAS float* KB = sm + 8192; LAS float* LT = sm + 16384; LAS float* CC = sm + 20608; LAS float* BB = sm + 22656;
    bf16_t* MC = (bf16_t*)(p.ws + WS_R1) + (size_t)g * 512 * 768;
    bf16_t* EM = (bf16_t*)(p.ws + WS_EMAT) + (size_t)g * 256 * 512;
    for (int d = 0; d < 2; ++d) {
        const int pg = (l * 2 + d) * 32 + g;
        const float* lamr = p.in[lnd(15)] + (size_t)pg * 64; const float* lami = p.in[lnd(16)] + (size_t)pg * 64;
        const float dt = expf(p.in[lnd(17)][pg]);
        const float* bre = p.in[lnd(18)] + (size_t)pg * 1024; const float* bim = p.in[lnd(19)] + (size_t)pg * 1024;
        const float* cre = p.in[lnd(20)] + (size_t)pg * 1024; const float* cim = p.in[lnd(21)] + (size_t)pg * 1024;
        for (int i = tid; i < 33 * 64; i += NTHR) { const int tau = i >> 6, pp = i & 63; const float a = expf(lamr[pp] * dt * (float)tau); float s, c; sincosf(lami[pp] * dt * (float)tau, &s, &c); LT[2 * i] = a * c; LT[2 * i + 1] = a * s; }
        for (int i = tid; i < 1024; i += NTHR) { CC[2 * i] = cre[i]; CC[2 * i + 1] = cim[i]; }
        for (int i = tid; i < 1024; i += NTHR) {
            const int pp = i >> 4; const float lr = lamr[pp], li = lami[pp]; float s, c; sincosf(li * dt, &s, &c);
            const float em1 = expm1f(lr * dt); float sh, ch; sincosf(0.5f * li * dt, &sh, &ch);
            const float nr = em1 * c - 2.f * sh * sh, ni = (em1 + 1.f) * s;
            const float inv = 1.f / (lr * lr + li * li);
            const float qr = (nr * lr + ni * li) * inv, qi = (ni * lr - nr * li) * inv;
            const float br = bre[i], bi = bim[i];
            BB[2 * i] = qr * br - qi * bi; BB[2 * i + 1] = qr * bi + qi * br;
        }
        __syncthreads();
        {
            const int tau = tid >> 4, n = tid & 15; float acc[16];
#pragma unroll
            for (int m = 0; m < 16; ++m) acc[m] = 0.f;
            for (int pp = 0; pp < 64; ++pp) {
                const float cr = CC[2 * (n * 64 + pp)], ci = CC[2 * (n * 64 + pp) + 1], lr = LT[2 * (tau * 64 + pp)], li = LT[2 * (tau * 64 + pp) + 1];
                const float xr = cr * lr - ci * li, xi = cr * li + ci * lr;
#pragma unroll
                for (int m = 0; m < 16; ++m) acc[m] += xr * BB[2 * (pp * 16 + m)] - xi * BB[2 * (pp * 16 + m) + 1];
            }
            LAS float* Kd = d ? KB : KF;
#pragma unroll
            for (int m = 0; m < 16; ++m) Kd[(tau * 16 + n) * 16 + m] = acc[m];
        }
        {
            const int pp = tid >> 3, cseg = tid & 7;
            { const int jj = part;
                const int j = cseg * 4 + jj, e = d == 0 ? 31 - j : j; const float lr = LT[2 * (e * 64 + pp)], li = LT[2 * (e * 64 + pp) + 1];
                float re[16], im[16];
#pragma unroll
                for (int m = 0; m < 16; ++m) { const float br = BB[2 * (pp * 16 + m)], bi = BB[2 * (pp * 16 + m) + 1]; re[m] = lr * br - li * bi; im[m] = lr * bi + li * br; }
                bf16_t* er = EM + (size_t)(d * 128 + pp) * 512 + j * 16; bf16_t* ei = EM + (size_t)(d * 128 + 64 + pp) * 512 + j * 16;
#pragma unroll
                for (int h = 0; h < 2; ++h) {
                    u32x4 w; w.x = pk_bf16(re[8 * h], re[8 * h + 1]); w.y = pk_bf16(re[8 * h + 2], re[8 * h + 3]); w.z = pk_bf16(re[8 * h + 4], re[8 * h + 5]); w.w = pk_bf16(re[8 * h + 6], re[8 * h + 7]); *(u32x4*)(er + 8 * h) = w;
                    u32x4 x; x.x = pk_bf16(im[8 * h], im[8 * h + 1]); x.y = pk_bf16(im[8 * h + 2], im[8 * h + 3]); x.z = pk_bf16(im[8 * h + 4], im[8 * h + 5]); x.w = pk_bf16(im[8 * h + 6], im[8 * h + 7]); *(u32x4*)(ei + 8 * h) = x;
                }
            }
        }
        {
            const int t = tid >> 4, n = tid & 15, f = d == 0 ? t + 1 : 32 - t;
            bf16_t* mr = MC + (size_t)tid * 768 + 512 + d * 128;
#pragma unroll 1
            for (int p8 = 2 * part; p8 < 2 * part + 2; ++p8) {
                float re[8], im[8];
#pragma unroll
                for (int q = 0; q < 8; ++q) { const int pp = p8 * 8 + q; const float cr = CC[2 * (n * 64 + pp)], ci = CC[2 * (n * 64 + pp) + 1], lr = LT[2 * (f * 64 + pp)], li = LT[2 * (f * 64 + pp) + 1];
                    re[q] = cr * lr - ci * li; im[q] = -(cr * li + ci * lr); }
                u32x4 w; w.x = pk_bf16(re[0], re[1]); w.y = pk_bf16(re[2], re[3]); w.z = pk_bf16(re[4], re[5]); w.w = pk_bf16(re[6], re[7]); *(u32x4*)(mr + p8 * 8) = w;
                u32x4 x; x.x = pk_bf16(im[0], im[1]); x.y = pk_bf16(im[2], im[3]); x.z = pk_bf16(im[4], im[5]); x.w = pk_bf16(im[6], im[7]); *(u32x4*)(mr + 64 + p8 * 8) = x;
            }
        }
        __syncthreads();
    }
    {
        const int t = tid >> 4, n = tid & 15; const float dsk = p.in[lnd(22)][(size_t)l * 512 + g * 16 + n];
        bf16_t* mr = MC + (size_t)tid * 768;
#pragma unroll 1
        for (int j = 8 * part; j < 8 * part + 8; ++j) {
            float v[16];
#pragma unroll
            for (int m = 0; m < 16; ++m) v[m] = 0.f;
            if (j <= t) { const LAS float* k = KF + ((t - j) * 16 + n) * 16;
#pragma unroll
                for (int m = 0; m < 16; ++m) v[m] += k[m]; }
            if (j >= t) { const LAS float* k = KB + ((j - t) * 16 + n) * 16;
#pragma unroll
                for (int m = 0; m < 16; ++m) v[m] += k[m]; }
            if (j == t) {
#pragma unroll
                for (int m = 0; m < 16; ++m) v[m] += (m == n) ? dsk : 0.f; }
            u32x4 w; w.x = pk_bf16(v[0], v[1]); w.y = pk_bf16(v[2], v[3]); w.z = pk_bf16(v[4], v[5]); w.w = pk_bf16(v[6], v[7]); *(u32x4*)(mr + j * 16) = w;
            u32x4 x; x.x = pk_bf16(v[8], v[9]); x.y = pk_bf16(v[10], v[11]); x.z = pk_bf16(v[12], v[13]); x.w = pk_bf16(v[14], v[15]); *(u32x4*)(mr + j * 16 + 8) = x;
        }
    }
}

__device__ __forceinline__ void phase_prep(const P& p, int l, LAS unsigned char* lds) {
    LAS float* sm = (LAS float*)lds;
    const int b = bid_(), G = gridDim.x, ha = G >> 1;
    if (b < ha) { for (int t = b; t < 128; t += ha) { s5_mats(p, l, t, sm); __syncthreads(); } }
    else { for (int t = b - ha; t < CONV_TILES; t += G - ha) { conv_tile(p, l, t, sm); __syncthreads(); } }
    if (l == 0) for (int t = b; t < 384; t += G) { mod_task(p, t, sm); __syncthreads(); }
}

__device__ __forceinline__ void norm_row_write(const f32x4 (&x)[4], const float* g, const float* mod, int shoff, int scoff, bf16_t* hrow, int lane) {
    float ss = 0.f;
#pragma unroll
    for (int i = 0; i < 4; ++i) ss += x[i][0] * x[i][0] + x[i][1] * x[i][1] + x[i][2] * x[i][2] + x[i][3] * x[i][3];
    ss = wave_sum(ss);
    const float rstd = rsqrtf(ss * (1.0f / 1024.0f) + 1e-6f);
#pragma unroll
    for (int i = 0; i < 4; ++i) { const int d = i * 256 + lane * 4; const f32x4 gg = *(const f32x4*)(g + d), sc = *(const f32x4*)(mod + scoff + d), sh = *(const f32x4*)(mod + shoff + d);
        f32x4 h;
#pragma unroll
        for (int e = 0; e < 4; ++e) h[e] = x[i][e] * rstd * gg[e] * (1.f + sc[e]) + sh[e];
        { u32x2 w; w.x = pk_bf16(h[0], h[1]); w.y = pk_bf16(h[2], h[3]); __builtin_nontemporal_store(w, (u32x2*)(hrow + d)); } }
}
__device__ __forceinline__ void phase_norm(const P& p, int l, int which) {
    const int lane = tid_() & 63, gw = bid_() * 8 + (tid_() >> 6), nw = gridDim.x * 8;
    const float* g = (which == 1 ? p.in[lnd(9)] : p.in[lnd(27)]) + (size_t)l * 1024;
    const float* modl = (const float*)(p.ws + WS_MOD) + (size_t)l * 9 * 6144;
    const int shoff = which == 1 ? 0 : 3072, scoff = which == 1 ? 1024 : 4096;
    bf16_t* H = (bf16_t*)(p.ws + WS_R2); float* X = p.out;
    if (which == 1 && l == 0) {
        for (int item = gw; item < 4096 + 8192; item += nw) {
            if (item < 4096) {
                const int n = item; const float rr = (float)(n >> 6), cc = (float)(n & 63); f32x4 pe[4];
#pragma unroll
                for (int e = 0; e < 4; ++e) { const float om = expf(-(float)(lane * 4 + e) * (9.210340371976184f / 256.0f)); float s, c; sincosf(rr * om, &s, &c); pe[0][e] = s; pe[1][e] = c; sincosf(cc * om, &s, &c); pe[2][e] = s; pe[3][e] = c; }
                for (int b0 = 0; b0 < 8; b0 += 2) { f32x4 x[2][4];
#pragma unroll
                    for (int r = 0; r < 2; ++r) { const float* src = p.in[lnd(1)] + ((size_t)(b0 + r) * 4096 + n) * 1024;
#pragma unroll
                        for (int i = 0; i < 4; ++i) x[r][i] = *(const f32x4*)(src + i * 256 + lane * 4); }
#pragma unroll
                    for (int r = 0; r < 2; ++r) { const int row = TOKP + (b0 + r) * 4096 + n;
#pragma unroll
                        for (int i = 0; i < 4; ++i) { x[r][i] = x[r][i] + pe[i]; *(f32x4*)(X + (size_t)row * 1024 + i * 256 + lane * 4) = x[r][i]; }
                        norm_row_write(x[r], g, modl + (size_t)(1 + b0 + r) * 6144, shoff, scoff, H + (size_t)row * 1024, lane); } }
            } else { const int row = item - 4096; const float* src = p.in[lnd(0)] + (size_t)row * 1024; f32x4 x[4];
#pragma unroll
                for (int i = 0; i < 4; ++i) { x[i] = *(const f32x4*)(src + i * 256 + lane * 4); *(f32x4*)(X + (size_t)row * 1024 + i * 256 + lane * 4) = x[i]; }
                norm_row_write(x, g, modl, shoff, scoff, H + (size_t)row * 1024, lane); }
        }
    } else {
        const bf16_t* DL = (const bf16_t*)(p.ws + (which == 1 ? WS_R2 : WS_R3));
        for (int it = gw; it < TOK / 4; it += nw) {
            const int rowb = it * 4; const float* mod = modl + (size_t)mod_index(rowb) * 6144;
            f32x4 x[4][4]; u32x2 dv[4][4];
#pragma unroll
            for (int r = 0; r < 4; ++r)
#pragma unroll
                for (int i = 0; i < 4; ++i) { x[r][i] = __builtin_nontemporal_load((const f32x4*)(X + (size_t)(rowb + r) * 1024 + i * 256 + lane * 4)); dv[r][i] = __builtin_nontemporal_load((const u32x2*)(DL + (size_t)(rowb + r) * 1024 + i * 256 + lane * 4)); }
            f32x4 gs[4], sh[4];
#pragma unroll
            for (int i = 0; i < 4; ++i) { const int d = i * 256 + lane * 4; const f32x4 gg = *(const f32x4*)(g + d), sc = *(const f32x4*)(mod + scoff + d); sh[i] = *(const f32x4*)(mod + shoff + d); gs[i] = gg * (sc + 1.f); }
#pragma unroll
            for (int r = 0; r < 4; ++r) { float ss = 0.f;
#pragma unroll
                for (int i = 0; i < 4; ++i) { x[r][i] = x[r][i] + (f32x4){bflo(dv[r][i].x), bfhi(dv[r][i].x), bflo(dv[r][i].y), bfhi(dv[r][i].y)}; *(f32x4*)(X + (size_t)(rowb + r) * 1024 + i * 256 + lane * 4) = x[r][i];
                    ss += x[r][i][0] * x[r][i][0] + x[r][i][1] * x[r][i][1] + x[r][i][2] * x[r][i][2] + x[r][i][3] * x[r][i][3]; }
                ss = wave_sum(ss); const float rstd = rsqrtf(ss * (1.0f / 1024.0f) + 1e-6f);
#pragma unroll
                for (int i = 0; i < 4; ++i) { const f32x4 hv = x[r][i] * rstd * gs[i] + sh[i]; u32x2 w; w.x = pk_bf16(hv[0], hv[1]); w.y = pk_bf16(hv[2], hv[3]); __builtin_nontemporal_store(w, (u32x2*)(H + (size_t)(rowb + r) * 1024 + i * 256 + lane * 4)); } }
        }
    }
}
__device__ __forceinline__ void phase_final(const P& p) {
    const int lane = tid_() & 63, gw = bid_() * 8 + (tid_() >> 6), nw = gridDim.x * 8; float* X = p.out; const float* g = p.in[lnd(30)]; const bf16_t* DL = (const bf16_t*)(p.ws + WS_R2);
    for (int row0 = gw; row0 < TOK; row0 += 4 * nw) {
        f32x4 x[4][4]; u32x2 dv[4][4];
#pragma unroll
        for (int r = 0; r < 4; ++r) { const int row = row0 + r * nw;
            if (row < TOK) {
#pragma unroll
                for (int i = 0; i < 4; ++i) { x[r][i] = __builtin_nontemporal_load((const f32x4*)(X + (size_t)row * 1024 + i * 256 + lane * 4)); dv[r][i] = __builtin_nontemporal_load((const u32x2*)(DL + (size_t)row * 1024 + i * 256 + lane * 4)); } } }
#pragma unroll
        for (int r = 0; r < 4; ++r) { const int row = row0 + r * nw;
            if (row < TOK) { float ss = 0.f;
#pragma unroll
                for (int i = 0; i < 4; ++i) { x[r][i] = x[r][i] + (f32x4){bflo(dv[r][i].x), bfhi(dv[r][i].x), bflo(dv[r][i].y), bfhi(dv[r][i].y)}; ss += x[r][i][0] * x[r][i][0] + x[r][i][1] * x[r][i][1] + x[r][i][2] * x[r][i][2] + x[r][i][3] * x[r][i][3]; }
                ss = wave_sum(ss); const float rstd = rsqrtf(ss * (1.0f / 1024.0f) + 1e-6f);
#pragma unroll
                for (int i = 0; i < 4; ++i) { const f32x4 gg = *(const f32x4*)(g + i * 256 + lane * 4); *(f32x4*)(X + (size_t)row * 1024 + i * 256 + lane * 4) = x[r][i] * rstd * gg; } } }
    }
}

__device__ __forceinline__ void phase_s5scan(const P& p, int l) {
    const float* E = (const float*)(p.ws + WS_E); bf16_t* UG = (bf16_t*)(p.ws + WS_R5);
    float* ore = p.out + (size_t)TOK * 1024 + 16777216; float* oim = ore + 262144;
    for (int task = bid_(); task < 320; task += gridDim.x) {
        const int idx = task * NTHR + tid_(), pp = idx & 63, d = (idx >> 6) & 1, g = (idx >> 7) & 31, s = 39 - (idx >> 12);
        const int nch = s < 32 ? 8 : 128, cbase = s < 32 ? s * 8 : 256 + (s - 32) * 128;
        const int pg = (l * 2 + d) * 32 + g; const float dt = expf(p.in[lnd(17)][pg]);
        const float a = expf(p.in[lnd(15)][(size_t)pg * 64 + pp] * dt * 32.f); float sn, cs; sincosf(p.in[lnd(16)][(size_t)pg * 64 + pp] * dt * 32.f, &sn, &cs);
        const float ar = a * cs, ai = a * sn;
        float sr = 0.f, si = 0.f;
        if (s >= 32) { const size_t o = ((((size_t)(s - 32) * 2 + l) * 2 + d) * 32 + g) * 64 + pp; sr = p.in[lnd(4)][o]; si = p.in[lnd(5)][o]; }
        const float* Eb = E + ((size_t)(g * 1280 + cbase) * 256 + d * 128 + pp);
        bf16_t* Ub = UG + ((size_t)(g * 1280 + cbase) * 768 + 512 + d * 128 + pp);
        for (int c0 = 0; c0 < nch; c0 += 8) {
            float er[8], ei[8];
#pragma unroll
            for (int k = 0; k < 8; ++k) { const int c = d == 0 ? c0 + k : nch - 1 - (c0 + k); er[k] = Eb[(size_t)c * 256]; ei[k] = Eb[(size_t)c * 256 + 64]; }
#pragma unroll
            for (int k = 0; k < 8; ++k) { const int c = d == 0 ? c0 + k : nch - 1 - (c0 + k);
                Ub[(size_t)c * 768] = f2bf(sr); Ub[(size_t)c * 768 + 64] = f2bf(si);
                const float nr = ar * sr - ai * si + er[k], ni = ar * si + ai * sr + ei[k]; sr = nr; si = ni; }
        }
        if (s < 32) { const size_t o = ((((size_t)s * 2 + l) * 2 + d) * 32 + g) * 64 + pp; ore[o] = sr; oim[o] = si; }
    }
}

__device__ __forceinline__ void phase_glapre(const P& p, int l, LAS unsigned char* lds) {
    const int tid = tid_(), d = tid & 127, tq = tid >> 7, wv = tid >> 6, lane = tid & 63, fr = lane & 15, fq = lane >> 4;
    LAS float* sG = (LAS float*)lds; LAS float* sT4 = sG + 2048; LAS float* sZ = sG + 2560;
    bf16_t* Q = (bf16_t*)(p.ws + WS_R3); bf16_t* Kk = Q + (size_t)TOK * 512;
    bf16_t* QB = (bf16_t*)(p.ws + WS_R5); bf16_t* KB = QB + (size_t)TOK * 512;
    const float* GLR = (const float*)(p.ws + WS_GLR);
    for (int task = bid_(); task < 2560; task += gridDim.x) {
        const int c64 = task >> 2, h = task & 3, tb = c64 * 64;
        { const int row = tid >> 3, c4 = (tid & 7) * 4; *(LAS f32x4*)(sG + row * 32 + c4) = *(const f32x4*)(GLR + (size_t)(tb + row) * 32 + c4); }
        float qv[16], kv[16];
#pragma unroll
        for (int i = 0; i < 16; ++i) { const size_t o = (size_t)(tb + tq * 16 + i) * 512 + h * 128 + d; qv[i] = bf2f(Q[o]); kv[i] = bf2f(Kk[o]); }
        bf16x8 bw[2];
#pragma unroll
        for (int dir = 0; dir < 2; ++dir) { float w8[8];
#pragma unroll
            for (int e = 0; e < 8; ++e) { const int kk = 8 * fq + e - 16 * dir; w8[e] = (kk >= 0 && kk < 16) ? p.in[lnd(11)][((size_t)(l * 2 + dir) * 16 + kk) * 512 + h * 128 + 16 * wv + fr] : 0.f; }
            u32x4 pk; pk.x = pk_bf16(w8[0], w8[1]); pk.y = pk_bf16(w8[2], w8[3]); pk.z = pk_bf16(w8[4], w8[5]); pk.w = pk_bf16(w8[6], w8[7]);
            bw[dir] = __builtin_bit_cast(bf16x8, pk); }
        __syncthreads();
#pragma unroll
        for (int ti = 0; ti < 4; ++ti) {
            const LAS float* gr = sG + (16 * ti + fr) * 32 + 8 * fq; const f32x4 g0 = *(const LAS f32x4*)gr, g1 = *(const LAS f32x4*)(gr + 4);
            u32x4 pk; pk.x = pk_bf16(g0[0], g0[1]); pk.y = pk_bf16(g0[2], g0[3]); pk.z = pk_bf16(g1[0], g1[1]); pk.w = pk_bf16(g1[2], g1[3]);
            const bf16x8 af = __builtin_bit_cast(bf16x8, pk);
#pragma unroll
            for (int dir = 0; dir < 2; ++dir) { const f32x4 z = __builtin_amdgcn_mfma_f32_16x16x32_bf16(af, bw[dir], (f32x4){0.f, 0.f, 0.f, 0.f}, 0, 0, 0);
#pragma unroll
                for (int e = 0; e < 4; ++e) sZ[(dir * 64 + 16 * ti + 4 * fq + e) * 128 + 16 * wv + fr] = z[e]; }
        }
        __syncthreads();
#pragma unroll 1
        for (int dir = 0; dir < 2; ++dir) {
            const float bg = p.in[lnd(12)][(size_t)(l * 2 + dir) * 512 + h * 128 + d];
            float cum[16];
#pragma unroll
            for (int i = 0; i < 16; ++i) { const float z = sZ[(dir * 64 + tq * 16 + i) * 128 + d] + bg;
                cum[i] = (fminf(z, 0.f) - __logf(1.0f + __expf(-fabsf(z)))) * 0.0625f; }
            if (dir == 0) {
#pragma unroll
                for (int i = 1; i < 16; ++i) cum[i] += cum[i - 1];
            } else {
#pragma unroll
                for (int i = 14; i >= 0; --i) cum[i] += cum[i + 1];
            }
            sT4[tq * 128 + d] = dir == 0 ? cum[15] : cum[0];
            __syncthreads();
            float off = 0.f, total = 0.f;
#pragma unroll
            for (int q = 0; q < 4; ++q) { const float v = sT4[q * 128 + d]; total += v; if (dir == 0 ? (q < tq) : (q > tq)) off += v; }
            bf16_t* QD = dir == 0 ? Q : QB; bf16_t* KI = dir == 0 ? Kk : KB;
#pragma unroll
            for (int i = 0; i < 16; ++i) { const float cm = cum[i] + off; const size_t o = (size_t)(tb + tq * 16 + i) * 512 + h * 128 + d;
                QD[o] = f2bf(qv[i] * __expf(cm)); KI[o] = f2bf(kv[i] * __expf(-cm)); }
            if (tq == 0) ((float*)(p.ws + (dir == 0 ? WS_TOTF : WS_TOTB)))[(size_t)c64 * 512 + h * 128 + d] = total;
            __syncthreads();
        }
    }
}

constexpr int GLA_GRP = 71168;
typedef short s16x4 __attribute__((ext_vector_type(4)));
__device__ __forceinline__ bf16x8 tr_frag(const LAS bf16_t* base, int stride, int krow0, int col0, int fr, int fq) {
    const LAS bf16_t* q = base + (krow0 + 8 * fq + (fr >> 2)) * stride + col0 + 4 * (fr & 3);
    const s16x4 a = __builtin_amdgcn_ds_read_tr16_b64_v4i16((LAS s16x4*)q);
    const s16x4 b = __builtin_amdgcn_ds_read_tr16_b64_v4i16((LAS s16x4*)(q + 4 * stride));
    return __builtin_shufflevector(a, b, 0, 1, 2, 3, 4, 5, 6, 7);
}
#define LDS_BAR() do { asm volatile("s_waitcnt lgkmcnt(0)" ::: "memory"); __builtin_amdgcn_s_barrier(); asm volatile("" ::: "memory"); } while (0)
__device__ __forceinline__ void phase_gla(const P& p, int l, LAS unsigned char* lds) {
    const int tid = tid_(), grp = __builtin_amdgcn_readfirstlane(tid >> 8), gt = tid & 255, wv = __builtin_amdgcn_readfirstlane((tid >> 6) & 3), lane = tid & 63, fr = lane & 15, fq = lane >> 4;
    LAS unsigned char* gl = lds + grp * GLA_GRP;
    LAS bf16_t* sQ = (LAS bf16_t*)gl; LAS bf16_t* sK = (LAS bf16_t*)(gl + 17408); LAS bf16_t* sV = (LAS bf16_t*)(gl + 34816);
    LAS bf16_t* sP = (LAS bf16_t*)(gl + 44032); LAS bf16_t* sS = (LAS bf16_t*)(gl + 53248); LAS float* sTot = (LAS float*)(gl + 70656);
    const bf16_t* QD = grp == 0 ? (const bf16_t*)(p.ws + WS_R3) : (const bf16_t*)(p.ws + WS_R5);
    const bf16_t* KI = QD + (size_t)TOK * 512;
    const bf16_t* V = (const bf16_t*)(p.ws + WS_R4);
    const float* TOT = (const float*)(p.ws + (grp == 0 ? WS_TOTF : WS_TOTB));
    bf16_t* O = (bf16_t*)(p.ws + WS_R1);
    float* OST = p.out + (size_t)TOK * 1024;
    const int G = gridDim.x, b = bid_();
    const bool custom = (G == 256);
    const int ntask_mine = custom ? (b < 128 ? 1 : 4) : ((640 - b + G - 1) / G);
    for (int ti = 0; ti < ntask_mine; ++ti) {
        const int task = custom ? (b < 128 ? b : b + 128 * ti) : b + G * ti;
        if (task >= 640) break;
        const bool sample = task < 128;
        const int t2 = sample ? task : task - 128, xcd_ = t2 & 7, vs = (t2 >> 3) & 3, sh_ = xcd_ + 8 * (t2 >> 5), sb = sh_ >> 2, h = sh_ & 3;
        const int base = sample ? TOKP + sb * 4096 : sb * 256, nch = sample ? 64 : 4;
        f32x4 accS[2][4];
#pragma unroll
        for (int dt = 0; dt < 2; ++dt)
#pragma unroll
            for (int vt = 0; vt < 4; ++vt) {
                f32x4 a = (f32x4){0.f, 0.f, 0.f, 0.f};
                if (sample) { const float* cp = p.in[lnd(3)] + (((((size_t)sb * 2 + l) * 2 + grp) * 4 + h) * 128 + 16 * (2 * wv + dt) + 4 * fq) * 256 + vs * 64 + 16 * vt + fr;
#pragma unroll
                    for (int e = 0; e < 4; ++e) a[e] = cp[(size_t)e * 256]; }
                accS[dt][vt] = a;
                u32x2 w; w.x = pk_bf16(a[0], a[1]); w.y = pk_bf16(a[2], a[3]);
                *(LAS u32x2*)(sS + (16 * vt + fr) * 136 + 16 * (2 * wv + dt) + 4 * fq) = w;
            }
        u32x4 rq[2][4], rk[2][4], rv[2][2]; float rt[2] = {0.f, 0.f};
        u32x2 oprev[2][4];
#pragma unroll
        for (int u = 0; u < 2; ++u)
#pragma unroll
            for (int vt = 0; vt < 4; ++vt) oprev[u][vt] = (u32x2){0u, 0u};
#define GLA_CHUNK(st) (grp == 0 ? (st) : nch - 1 - (st))
#define GLA_LOAD(U, ci) do { const int tb_ = base + (ci) * 64; \
        _Pragma("unroll") for (int i = 0; i < 4; ++i) { const int idx = gt + 256 * i, row = idx >> 4, c16 = idx & 15; const size_t o = (size_t)(tb_ + row) * 512 + h * 128 + c16 * 8; rq[U][i] = *(const u32x4*)(QD + o); rk[U][i] = *(const u32x4*)(KI + o); } \
        _Pragma("unroll") for (int i = 0; i < 2; ++i) { const int idx = gt + 256 * i, row = idx >> 3, c8 = idx & 7; rv[U][i] = *(const u32x4*)(V + (size_t)(tb_ + row) * 1024 + h * 256 + vs * 64 + c8 * 8); } \
        if (gt < 128) rt[U] = TOT[(size_t)(tb_ >> 6) * 512 + h * 128 + gt]; } while (0)
#define GLA_STORE(U) do { \
        _Pragma("unroll") for (int i = 0; i < 4; ++i) { const int idx = gt + 256 * i, row = idx >> 4, c16 = idx & 15; *(LAS u32x4*)(sQ + row * 136 + c16 * 8) = rq[U][i]; *(LAS u32x4*)(sK + row * 136 + c16 * 8) = rk[U][i]; } \
        _Pragma("unroll") for (int i = 0; i < 2; ++i) { const int idx = gt + 256 * i, row = idx >> 3, c8 = idx & 7; *(LAS u32x4*)(sV + row * 72 + c8 * 8) = rv[U][i]; } \
        if (gt < 128) sTot[gt] = rt[U]; } while (0)
#define GLA_OLOAD(U, st) do { const int tb_ = base + GLA_CHUNK(st) * 64; \
        _Pragma("unroll") for (int vt = 0; vt < 4; ++vt) oprev[U][vt] = *(const u32x2*)(O + (size_t)(tb_ + 16 * wv + fr) * 1024 + h * 256 + vs * 64 + 16 * vt + 4 * fq); } while (0)
        GLA_LOAD(0, GLA_CHUNK(0));
        GLA_STORE(0);
        GLA_LOAD(1, GLA_CHUNK(1));
        __syncthreads();
        const int half = nch >> 1;
        for (int s0 = 0; s0 < nch; s0 += 2) {
#pragma unroll
          for (int u = 0; u < 2; ++u) {
            const int s = s0 + u;
            const int ci = GLA_CHUNK(s), tb = base + ci * 64;
            const bool second = (s >= half);
            if (s == half) GLA_OLOAD(u, s);
            if (s + 1 < nch && s + 1 > half) GLA_OLOAD(u ^ 1, s + 1);
            asm volatile("" ::: "memory");
            if (s + 2 < nch) GLA_LOAD(u, GLA_CHUNK(s + 2));
            { bf16x8 qa[4];
#pragma unroll
            for (int ks = 0; ks < 4; ++ks) qa[ks] = *(const LAS bf16x8*)(sQ + (16 * wv + fr) * 136 + 32 * ks + 8 * fq);
#pragma unroll
            for (int jt = 0; jt < 4; ++jt) {
                bf16x8 kb[4];
#pragma unroll
                for (int ks = 0; ks < 4; ++ks) kb[ks] = *(const LAS bf16x8*)(sK + (16 * jt + fr) * 136 + 32 * ks + 8 * fq);
                f32x4 acc = (f32x4){0.f, 0.f, 0.f, 0.f};
#pragma unroll
                for (int ks = 0; ks < 4; ++ks) acc = __builtin_amdgcn_mfma_f32_16x16x32_bf16(qa[ks], kb[ks], acc, 0, 0, 0);
#pragma unroll
                for (int e = 0; e < 4; ++e) { const int i = 16 * wv + 4 * fq + e, j = 16 * jt + fr; const bool keep = grp == 0 ? (j <= i) : (j >= i); sP[i * 72 + j] = f2bf(keep ? acc[e] : 0.f); }
            } }
            asm volatile("" ::: "memory");
            bf16x8 vf[4][2];
#pragma unroll
            for (int vt = 0; vt < 4; ++vt)
#pragma unroll
                for (int ks = 0; ks < 2; ++ks) vf[vt][ks] = tr_frag(sV, 72, 32 * ks, 16 * vt, fr, fq);
#pragma unroll
            for (int dt = 0; dt < 2; ++dt) {
                bf16x8 kf[2];
#pragma unroll
                for (int ks = 0; ks < 2; ++ks) kf[ks] = tr_frag(sK, 136, 32 * ks, 16 * (2 * wv + dt), fr, fq);
                const f32x4 tt = *(const LAS f32x4*)(sTot + 16 * (2 * wv + dt) + 4 * fq);
                const f32x4 sc = (f32x4){__expf(tt[0]), __expf(tt[1]), __expf(tt[2]), __expf(tt[3])};
#pragma unroll
                for (int vt = 0; vt < 4; ++vt) {
#pragma unroll
                    for (int ks = 0; ks < 2; ++ks) accS[dt][vt] = __builtin_amdgcn_mfma_f32_16x16x32_bf16(kf[ks], vf[vt][ks], accS[dt][vt], 0, 0, 0);
                    accS[dt][vt] = accS[dt][vt] * sc;
                }
            }
            asm volatile("s_waitcnt lgkmcnt(0)" ::: "memory");
            {
                bf16x8 pf[2];
#pragma unroll
                for (int ks = 0; ks < 2; ++ks) pf[ks] = *(const LAS bf16x8*)(sP + (16 * wv + fr) * 72 + 32 * ks + 8 * fq);
                bf16x8 qf[4];
#pragma unroll
                for (int ks = 0; ks < 4; ++ks) qf[ks] = *(const LAS bf16x8*)(sQ + (16 * wv + fr) * 136 + 32 * ks + 8 * fq);
#pragma unroll
                for (int vt = 0; vt < 4; ++vt) {
                    f32x4 acc = (f32x4){0.f, 0.f, 0.f, 0.f};
#pragma unroll
                    for (int ks = 0; ks < 2; ++ks) acc = __builtin_amdgcn_mfma_f32_16x16x32_bf16(vf[vt][ks], pf[ks], acc, 0, 0, 0);
#pragma unroll
                    for (int ks = 0; ks < 4; ++ks) { const bf16x8 sf = *(const LAS bf16x8*)(sS + (16 * vt + fr) * 136 + 32 * ks + 8 * fq);
                        acc = __builtin_amdgcn_mfma_f32_16x16x32_bf16(sf, qf[ks], acc, 0, 0, 0); }
                    { u32x2 pv = oprev[u][vt]; asm volatile("" : "+v"(pv));
                      if (second) acc = acc + (f32x4){bflo(pv.x), bfhi(pv.x), bflo(pv.y), bfhi(pv.y)}; }
                    store4bf(O + (size_t)(tb + 16 * wv + fr) * 1024 + h * 256 + vs * 64 + 16 * vt + 4 * fq, acc);
                }
            }
            LDS_BAR();
#pragma unroll
            for (int dt = 0; dt < 2; ++dt)
#pragma unroll
                for (int vt = 0; vt < 4; ++vt) { u32x2 w; w.x = pk_bf16(accS[dt][vt][0], accS[dt][vt][1]); w.y = pk_bf16(accS[dt][vt][2], accS[dt][vt][3]);
                    *(LAS u32x2*)(sS + (16 * vt + fr) * 136 + 16 * (2 * wv + dt) + 4 * fq) = w; }
            if (s + 1 < nch) GLA_STORE(u ^ 1);
            if (s == half - 1) { asm volatile("s_waitcnt vmcnt(0)" ::: "memory"); __syncthreads(); } else LDS_BAR();
          }
        }
        if (!sample) {
#pragma unroll
            for (int dt = 0; dt < 2; ++dt)
#pragma unroll
                for (int vt = 0; vt < 4; ++vt) { float* op = OST + (((((size_t)sb * 2 + l) * 2 + grp) * 4 + h) * 128 + 16 * (2 * wv + dt) + 4 * fq) * 256 + vs * 64 + 16 * vt + fr;
#pragma unroll
                    for (int e = 0; e < 4; ++e) op[(size_t)e * 256] = accS[dt][vt][e]; }
        }
    }
#undef GLA_LOAD
#undef GLA_STORE
#undef GLA_OLOAD
#undef GLA_CHUNK
}

__device__ __forceinline__ void phase_glapost(const P& p, int l) {
    const int lane = tid_() & 63, gw = bid_() * 8 + (tid_() >> 6), nw = gridDim.x * 8;
    bf16_t* O = (bf16_t*)(p.ws + WS_R1); const bf16_t* R = (const bf16_t*)(p.ws + WS_R3);
    const float* gn = p.in[lnd(13)] + (size_t)l * 256 + (lane & 15) * 16;
    for (int row = gw; row < TOK; row += nw) {
        const size_t o = (size_t)row * 1024 + lane * 16; float x[16], r[16];
#pragma unroll
        for (int hh = 0; hh < 2; ++hh) { const u32x4 a = *(const u32x4*)(O + o + 8 * hh), c = *(const u32x4*)(R + o + 8 * hh);
            x[8 * hh + 0] = bflo(a.x); x[8 * hh + 1] = bfhi(a.x); x[8 * hh + 2] = bflo(a.y); x[8 * hh + 3] = bfhi(a.y); x[8 * hh + 4] = bflo(a.z); x[8 * hh + 5] = bfhi(a.z); x[8 * hh + 6] = bflo(a.w); x[8 * hh + 7] = bfhi(a.w);
            r[8 * hh + 0] = bflo(c.x); r[8 * hh + 1] = bfhi(c.x); r[8 * hh + 2] = bflo(c.y); r[8 * hh + 3] = bfhi(c.y); r[8 * hh + 4] = bflo(c.z); r[8 * hh + 5] = bfhi(c.z); r[8 * hh + 6] = bflo(c.w); r[8 * hh + 7] = bfhi(c.w); }
        float ss = 0.f;
#pragma unroll
        for (int e = 0; e < 16; ++e) ss += x[e] * x[e];
        ss += __shfl_xor(ss, 1); ss += __shfl_xor(ss, 2); ss += __shfl_xor(ss, 4); ss += __shfl_xor(ss, 8);
        const float rstd = rsqrtf(ss * (1.0f / 256.0f) + 1e-6f);
        float y[16];
#pragma unroll
        for (int e = 0; e < 16; ++e) y[e] = x[e] * rstd * gn[e] * r[e];
#pragma unroll
        for (int hh = 0; hh < 2; ++hh) { u32x4 w; w.x = pk_bf16(y[8 * hh], y[8 * hh + 1]); w.y = pk_bf16(y[8 * hh + 2], y[8 * hh + 3]); w.z = pk_bf16(y[8 * hh + 4], y[8 * hh + 5]); w.w = pk_bf16(y[8 * hh + 6], y[8 * hh + 7]); *(u32x4*)(O + o + 8 * hh) = w; }
    }
}


#define XB_TMO      128
#define XB_XCNT(j)  (256  + 64 * (j))
#define XB_XSUB(j)  (1280 + 64 * (j))
#define XB_XGEN(j)  (2304 + 64 * (j))
#define XB_TOP      3328
#define XB_TOPGEN   3392
#define XCD_BAR_WORDS 3456
#define XB_SPIN_CAP (1u << 18)
__device__ __forceinline__ unsigned xb_ld(unsigned* p)              { return __hip_atomic_load(p, __ATOMIC_RELAXED, __HIP_MEMORY_SCOPE_AGENT); }
__device__ __forceinline__ unsigned xb_add(unsigned* p, unsigned v) { return __hip_atomic_fetch_add(p, v, __ATOMIC_RELAXED, __HIP_MEMORY_SCOPE_AGENT); }
__device__ __forceinline__ unsigned xb_xcc_id() { return (unsigned)__builtin_amdgcn_s_getreg((3 << 11) | 20) & 0xFu; }
#define XB_SPIN(cond, bar) do { unsigned _sp = 0; while (cond) { __builtin_amdgcn_s_sleep(1); \
    if ((++_sp & 255u) == 0u) { if (xb_ld(&(bar)[XB_TMO])) break; if (_sp > XB_SPIN_CAP) { atomicAdd(&(bar)[XB_TMO], 1u); break; } } } } while (0)
struct XcdBarrier { unsigned* bar; unsigned x; volatile LAS unsigned* st; };
__device__ __forceinline__ XcdBarrier xcd_barrier_post(unsigned* bar, volatile LAS unsigned* st) {
    XcdBarrier b; b.bar = bar; b.x = xb_xcc_id(); b.st = st;
    if (threadIdx.x == 0) (void)xb_add(&bar[XB_XCNT(b.x)], 1u);
    return b;
}
__device__ __forceinline__ void xcd_barrier_complete(unsigned* bar, unsigned x, unsigned& nloc, unsigned& nx) {
    const unsigned G = gridDim.x * gridDim.y * gridDim.z;
    unsigned sum, cnt, mine, sp = 0u;
    for (;;) {
        sum = 0u; cnt = 0u; mine = 0u;
#pragma unroll
        for (unsigned j = 0; j < 16; ++j) { const unsigned c = xb_ld(&bar[XB_XCNT(j)]); sum += c; cnt += (c > 0u) ? 1u : 0u; mine = (j == x) ? c : mine; }
        if (sum == G) break;
        __builtin_amdgcn_s_sleep(1);
        if ((++sp & 255u) == 0u) { if (xb_ld(&bar[XB_TMO])) break; if (sp > XB_SPIN_CAP) { atomicAdd(&bar[XB_TMO], 1u); break; } }
    }
    nloc = mine > 0u ? mine : 1u; nx = cnt > 0u ? cnt : 1u;
}
__device__ __forceinline__ void xcd_barrier(const XcdBarrier& b) {
    asm volatile("s_waitcnt vmcnt(0)" ::: "memory");
    __syncthreads();
    if (threadIdx.x == 0) {
        unsigned* bar = b.bar;
        __builtin_amdgcn_s_waitcnt(0);
        unsigned nloc = b.st[0], nx = b.st[1];
        if (nloc == 0u) { xcd_barrier_complete(bar, b.x, nloc, nx); b.st[0] = nloc; b.st[1] = nx; }
        const unsigned old = xb_add(&bar[XB_XSUB(b.x)], 1u);
        const unsigned gen = old / nloc;
        if (old + 1u == (gen + 1u) * nloc) {
            __builtin_amdgcn_fence(__ATOMIC_RELEASE, "agent");
            asm volatile("s_waitcnt vmcnt(0)" ::: "memory");
            const unsigned og = xb_add(&bar[XB_TOP], 1u);
            const unsigned tg = og / nx;
            if (og + 1u == (tg + 1u) * nx) xb_add(&bar[XB_TOPGEN], 1u);
            else XB_SPIN(xb_ld(&bar[XB_TOPGEN]) == tg, bar);
            __builtin_amdgcn_fence(__ATOMIC_ACQUIRE, "agent");
            xb_add(&bar[XB_XGEN(b.x)], 1u);
            asm volatile("s_waitcnt vmcnt(0)" ::: "memory");
        } else {
            XB_SPIN(xb_ld(&bar[XB_XGEN(b.x)]) == gen, bar);
            __builtin_amdgcn_fence(__ATOMIC_ACQUIRE, "agent");
            asm volatile("s_waitcnt vmcnt(0)" ::: "memory");
        }
    }
    __syncthreads();
}

__device__ __forceinline__ void run_phase(const P& p, int ph, LAS unsigned char* lds) {
    if (ph == 2 * PPL) { if (EN(34)) phase_final(p); return; }
    const int l = ph / PPL, q = ph % PPL;
    unsigned char* ws = p.ws; bf16_t* W = (bf16_t*)(ws + WS_W);
    const int G = gridDim.x, c = bid_();
    pg8::Order S;
    switch (q) {
        case 0: if (EN(0)) { phase_prep(p, l, lds); if (l == 1) phase_norm(p, l, 1); } break;
        case 1: if (EN(1)) { if (l == 0) phase_norm(p, l, 1); } break;
        case 2: if (EN(2)) { pg8::Gemm g{(const bf16_t*)(ws + WS_R2), W + W_A / 2, TOK, 2816, 1024, 1024, 0, 0, 1}; S.init(TOK, 2816, 1, G, c);
            EpiPartA E{(bf16_t*)(ws + WS_R3), (bf16_t*)(ws + WS_R3) + (size_t)TOK * 512, (bf16_t*)(ws + WS_R4), (bf16_t*)(ws + WS_R5), (float*)(ws + WS_GLR)};
            pg8::gemm_phase(lds, g, S, E); } break;
        case 3: if (EN(3)) { pg8::Gemm g{(const bf16_t*)(ws + WS_R5), (const bf16_t*)(ws + WS_EMAT), 1280, 256, 512, 768, (size_t)1280 * 768, (size_t)256 * 512, 32}; S.init(1280, 256, 32, G, c);
            EpiE E{(float*)(ws + WS_E)}; pg8::gemm_phase(lds, g, S, E); } break;
        case 4: if (EN(4)) phase_s5scan(p, l); break;
        case 5: if (EN(5)) { pg8::Gemm g{(const bf16_t*)(ws + WS_R5), (const bf16_t*)(ws + WS_R1), 1280, 512, 768, 768, (size_t)1280 * 768, (size_t)512 * 768, 32}; S.init(1280, 512, 32, G, c);
            EpiY E{(bf16_t*)(ws + WS_E)}; pg8::gemm_phase(lds, g, S, E); } break;
        case 6: if (EN(6)) { pg8::Gemm g{(const bf16_t*)(ws + WS_E), W + W_GLU / 2, TOK, 512, 512, 512, 0, 0, 1}; S.init(TOK, 512, 1, G, c);
            EpiGLU E{(const bf16_t*)(ws + WS_E), (bf16_t*)(ws + WS_R6), p.in[lnd(24)] + (size_t)l * 512}; pg8::gemm_phase(lds, g, S, E); } break;
        case 7: if (EN(7)) phase_glapre(p, l, lds); break;
        case 8: if (EN(8)) phase_gla(p, l, lds); break;
        case 9: if (EN(9)) { pg8::Gemm g{(const bf16_t*)(ws + WS_R2), W + W_B / 2, TOK, 3072, 1024, 1024, 0, 0, 1}; S.init(TOK, 3072, 1, G, c);
            EpiPartB E{(bf16_t*)(ws + WS_R3), (bf16_t*)(ws + WS_R4), (bf16_t*)(ws + WS_R5)}; pg8::gemm_phase(lds, g, S, E); } break;
        case 10: if (EN(10)) phase_glapost(p, l); break;
        case 11: if (EN(11)) { pg8::Gemm g{(const bf16_t*)(ws + WS_R1), W + W_PG / 2, TOK, 1024, 1024, 1024, 0, 0, 1}; S.init(TOK, 1024, 1, G, c);
              EpiProj1 E{(const bf16_t*)(ws + WS_R4), (bf16_t*)(ws + WS_R2)}; pg8::gemm_phase(lds, g, S, E); } break;
        case 12: if (EN(12)) { pg8::Gemm g{(const bf16_t*)(ws + WS_R6), W + W_PS / 2, TOK, 1024, 512, 512, 0, 0, 1}; S.init(TOK, 1024, 1, G, c);
              EpiProj2 E{(const bf16_t*)(ws + WS_R5), (bf16_t*)(ws + WS_R2)}; pg8::gemm_phase(lds, g, S, E); } break;
        case 13: if (EN(13)) { pg8::Gemm g{(const bf16_t*)(ws + WS_R2), W + W_OUT / 2, TOK, 1024, 1024, 1024, 0, 0, 1}; S.init(TOK, 1024, 1, G, c);
            EpiDelta E{(bf16_t*)(ws + WS_R3), (const float*)(ws + WS_MOD) + (size_t)l * 9 * 6144 + 2048}; pg8::gemm_phase(lds, g, S, E); } break;
        case 14: if (EN(14)) phase_norm(p, l, 2); break;
        case 15: if (EN(15)) { pg8::Gemm g{(const bf16_t*)(ws + WS_R2), W + W_1 / 2, TOK, 4096, 1024, 1024, 0, 0, 1}; S.init(TOK, 4096, 1, G, c);
            EpiFF1 E{(bf16_t*)(ws + WS_HID)}; pg8::gemm_phase(lds, g, S, E); } break;
        case 16: if (EN(16)) { pg8::Gemm g{(const bf16_t*)(ws + WS_HID), W + W_2 / 2, TOK, 1024, 4096, 4096, 0, 0, 1}; S.init(TOK, 1024, 1, G, c);
            EpiDelta E{(bf16_t*)(ws + WS_R2), (const float*)(ws + WS_MOD) + (size_t)l * 9 * 6144 + 5120}; pg8::gemm_phase(lds, g, S, E); } break;
        default: break;
    }
}

__global__ void __launch_bounds__(NTHR, 2) fwd_megakernel(P p) {
    extern __shared__ __attribute__((aligned(16))) unsigned char lds_raw[];
    LAS unsigned char* lds = (LAS unsigned char*)lds_raw;
#if MULTI_LAUNCH
    for (int ph = p.ph_lo; ph < p.ph_hi; ++ph) run_phase(p, ph, lds);
#else
    cg::grid_group grid = cg::this_grid();
    if (p.ph_lo < 0) grid.sync();
    volatile LAS unsigned* stw = (volatile LAS unsigned*)(lds + LDS_BYTES - 16);
    if (threadIdx.x < 4) stw[threadIdx.x] = 0u;
    __syncthreads();
    const XcdBarrier bar = xcd_barrier_post((unsigned*)(p.ws + WS_BAR), stw);
    for (int ph = p.ph_lo; ph < p.ph_hi; ++ph) {
        run_phase(p, ph, lds);
#if REP_MASK
        if (ph < 2 * PPL && ((REP_MASK >> (ph % PPL)) & 1)) {
            xcd_barrier(bar);
            if ((ph % PPL) == 12) { run_phase(p, ph - 1, lds); }
            run_phase(p, ph, lds);
        }
#endif
        if (ph + 1 < p.ph_hi && (ph % PPL) != 11 && ph != PPL) xcd_barrier(bar);
    }
#endif
}

extern "C" void kernel_launch(void* const* d_in, const int* in_sizes, int n_in, void* d_out, int out_size, void* d_ws, size_t ws_size, hipStream_t stream) {
    static int grid = 0;
    if (grid == 0) {
        if (n_in != 31 || ws_size < WS_END) { fprintf(stderr, "kernel_launch: unexpected n_in %d or ws_size %zu (< %zu)\n", n_in, ws_size, (size_t)WS_END); grid = -1; return; }
        int dev = 0, cus = 0, per_cu = 0;
        hipGetDevice(&dev);
        hipDeviceGetAttribute(&cus, hipDeviceAttributeMultiprocessorCount, dev);
        if (hipFuncSetAttribute((const void*)fwd_megakernel, hipFuncAttributeMaxDynamicSharedMemorySize, LDS_BYTES) != hipSuccess) { fprintf(stderr, "kernel_launch: hipFuncSetAttribute failed\n"); grid = -1; return; }
        hipOccupancyMaxActiveBlocksPerMultiprocessor(&per_cu, (const void*)fwd_megakernel, NTHR, LDS_BYTES);
        (void)hipGetLastError();
        if (per_cu < 1) fprintf(stderr, "kernel_launch: occupancy query says %d blocks per CU\n", per_cu);
        grid = cus > 0 ? cus : 256;
    }
    if (grid < 0) return;
    P p{};
    for (int i = 0; i < 31; ++i) p.in[i] = (const float*)d_in[i];
    p.out = (float*)d_out; p.ws = (unsigned char*)d_ws;
#if MULTI_LAUNCH
    for (int ph = 0; ph < NPHASE; ++ph) { p.ph_lo = ph; p.ph_hi = ph + 1; hipLaunchKernelGGL(fwd_megakernel, dim3(grid), dim3(NTHR), LDS_BYTES, stream, p); }
#else
    p.ph_lo = 0; p.ph_hi = NPHASE;
    (void)hipMemsetAsync((char*)d_ws + WS_BAR, 0, XCD_BAR_WORDS * sizeof(unsigned), stream);
    void* args[] = {&p};
    hipError_t e = hipLaunchCooperativeKernel((const void*)fwd_megakernel, dim3(grid), dim3(NTHR), args, LDS_BYTES, stream);
    if (e != hipSuccess) fprintf(stderr, "cooperative launch failed: %s (grid %d)\n", hipGetErrorString(e), grid);
#endif
}
```

```cpp
#include <hip/hip_runtime.h>
#include <hip/hip_cooperative_groups.h>
#include <cstdio>
namespace cg = cooperative_groups;

#ifndef MULTI_LAUNCH
#define MULTI_LAUNCH 0
#endif

#ifndef REP_MASK
#define REP_MASK 0
#endif
#ifndef PHASE_SEL
#define PHASE_SEL -1
#endif
#define EN(q) (PHASE_SEL < 0 || PHASE_SEL == (q))
#define LAS __attribute__((address_space(3)))
typedef unsigned short bf16_t;
typedef short bf16x8 __attribute__((ext_vector_type(8)));
typedef float f32x4 __attribute__((ext_vector_type(4)));
typedef unsigned u32x4 __attribute__((ext_vector_type(4)));
typedef unsigned u32x2 __attribute__((ext_vector_type(2)));

constexpr int NTHR = 512;
constexpr int TOK = 40960, TOKP = 8192;
constexpr int LDS_BYTES = 147456;
constexpr int NPHASE = 35;
constexpr int PPL = 17;

constexpr size_t MiB = (size_t)1 << 20;
constexpr size_t WS_MOD = 0;
constexpr size_t WS_GLR = 1 * MiB;
constexpr size_t WS_TOTF = 7 * MiB;
constexpr size_t WS_TOTB = 9 * MiB;
constexpr size_t WS_BAR = 12 * MiB;
constexpr size_t WS_W = 16 * MiB;
constexpr size_t W_A = 0;
constexpr size_t W_B = W_A + (size_t)2816 * 1024 * 2;
constexpr size_t W_PG = W_B + (size_t)3072 * 1024 * 2;
constexpr size_t W_GLU = W_PG + (size_t)1024 * 1024 * 2;
constexpr size_t W_PS = W_GLU + (size_t)512 * 512 * 2;
constexpr size_t W_OUT = W_PS + (size_t)1024 * 512 * 2;
constexpr size_t W_1 = W_OUT + (size_t)1024 * 1024 * 2;
constexpr size_t W_2 = W_1 + (size_t)4096 * 1024 * 2;
constexpr size_t WS_R2 = 50 * MiB;
constexpr size_t WS_R3 = 130 * MiB;
constexpr size_t WS_R4 = 210 * MiB;
constexpr size_t WS_R5 = 290 * MiB;
constexpr size_t WS_E = 350 * MiB;
constexpr size_t WS_R6 = 390 * MiB;
constexpr size_t WS_R1 = 430 * MiB;
constexpr size_t WS_EMAT = 454 * MiB;
constexpr size_t WS_HID = 130 * MiB;
constexpr size_t WS_END = 510 * MiB;

struct P { const float* in[31]; float* out; unsigned char* ws; int ph_lo, ph_hi; };

__device__ __forceinline__ int tid_() { int t = threadIdx.x; asm volatile("" : "+v"(t)); return t; }
__device__ __forceinline__ int bid_() { int b = blockIdx.x; asm volatile("" : "+s"(b)); return b; }
__device__ __forceinline__ int lnd(int k) { asm volatile("" : "+s"(k)); return k; }
__device__ __forceinline__ unsigned pk_bf16(float lo, float hi) { unsigned r; asm("v_cvt_pk_bf16_f32 %0, %1, %2" : "=v"(r) : "v"(lo), "v"(hi)); return r; }
__device__ __forceinline__ float bf2f(bf16_t b) { return __uint_as_float(((unsigned)b) << 16); }
__device__ __forceinline__ float bflo(unsigned w) { return __uint_as_float(w << 16); }
__device__ __forceinline__ float bfhi(unsigned w) { return __uint_as_float(w & 0xffff0000u); }
__device__ __forceinline__ bf16_t f2bf(float f) { return (bf16_t)(pk_bf16(f, 0.f) & 0xffffu); }
__device__ __forceinline__ float sigmoidf_(float x) { return __builtin_amdgcn_rcpf(1.0f + __expf(-x)); }
__device__ __forceinline__ void store4bf(bf16_t* ptr, f32x4 v) { u32x2 w; w.x = pk_bf16(v[0], v[1]); w.y = pk_bf16(v[2], v[3]); *(u32x2*)ptr = w; }
__device__ __forceinline__ f32x4 load4bf(const bf16_t* ptr) { u32x2 w = *(const u32x2*)ptr; return (f32x4){bflo(w.x), bfhi(w.x), bflo(w.y), bfhi(w.y)}; }
__device__ __forceinline__ int mod_index(int tok) { return tok < TOKP ? 0 : (tok >> 12) - 1; }
__device__ __forceinline__ float wave_sum(float v) {
#pragma unroll
    for (int o = 32; o >= 1; o >>= 1) v += __shfl_xor(v, o);
    return v;
}

namespace pg8 {
constexpr int BM = 256, BK = 64, HALF = 128, HTB = HALF * BK * 2, STAGE_BYTES = 8 * HTB, NXCD = 8, WGM = 8;
__device__ __forceinline__ int lds_byte(int r, int c) { const int st = (r >> 4) * 2 + (c >> 5), rr = r & 15, cc = c & 31, ob = rr * 64 + cc * 2; return st * 1024 + (ob ^ (((ob >> 9) & 1) << 5)); }
__device__ __forceinline__ void stage_rc(int b, int& R, int& C) { const int st = b / 1024, sb = b % 1024, swz = sb ^ (((sb >> 9) & 1) << 5); R = (st >> 1) * 16 + swz / 64; C = (st & 1) * 32 + (swz % 64) / 2; }

struct Unit { int pm, pn, z, hf; };
struct Gemm { const bf16_t* A; const bf16_t* Bt; int M, N, K, lda; size_t sA, sB; int nz; };
struct Order {
    int nM, nN, nwg, G, c, nz, nfull, rem2;
    __device__ __forceinline__ void init(int M, int N, int nz_, int G_, int c_) { nM = M / BM; nN = N / BM; nwg = nM * nN; G = G_; c = c_; nz = nz_;
        nfull = nwg; rem2 = 0;
        if (nz == 1) { const int full = (nwg / G) * G, rem = nwg - full; if (rem > 0 && 2 * rem <= G) { nfull = full; rem2 = 2 * rem; } } }
    __device__ __forceinline__ void map(int wgid, Unit& u) const {
        { const int q = nwg / NXCD, r = nwg % NXCD, xcd = wgid % NXCD, off = wgid / NXCD; wgid = (xcd < r ? xcd * (q + 1) : r * (q + 1) + (xcd - r) * q) + off; }
        const int nig = WGM * nN, gid = wgid / nig, fm = gid * WGM, gsz = (nM - fm) < WGM ? (nM - fm) : WGM;
        u.pm = fm + ((wgid % nig) % gsz); u.pn = (wgid % nig) / gsz; u.z = 0; }
    __device__ __forceinline__ bool next(int i, Unit& u) const {
        const long L = (long)i * G + c;
        if (nz == 1) {
            if (L < nfull) { map((int)L, u); u.hf = 0; return true; }
            const int t = (int)(L - nfull); if (t >= rem2) return false;
            map(nfull + (t >> 1), u); u.hf = 1 + (t & 1); return true;
        }
        if (L >= (long)nwg * nz) return false;
        const int z = (int)(L / nwg), r = (int)(L % nwg); u.z = z; u.pm = r % nM; u.pn = r / nM; u.hf = 0;
        return true;
    }
};

template <class Epi>
__device__ __forceinline__ void gemm_phase(LAS unsigned char* lds, const Gemm g, const Order& S, const Epi& E) {
    const int tid = tid_(), wid = __builtin_amdgcn_readfirstlane(tid >> 6), lane = tid & 63, wr = wid >> 2, wc = wid & 3, fr = lane & 15, fq = lane >> 4;
    const int K = g.K, nt = K / BK;
    unsigned voffA[2], voffB[2];
#pragma unroll
    for (int i = 0; i < 2; ++i) { int R, C; stage_rc(tid * 16 + i * 8192, R, C); voffA[i] = (unsigned)(R * g.lda + C) * 2u; voffB[i] = (unsigned)(R * K + C) * 2u; }
    const size_t kstep = (size_t)(BK * 2);
    const size_t hstepA = (size_t)HALF * g.lda * 2, hstepB = (size_t)HALF * K * 2;
    const unsigned ldsw = (unsigned)wid * 1024u;
    const int aoff = lds_byte(wr * 64 + fr, fq * 8), boff = lds_byte(wc * 32 + fr, fq * 8);
#define PG8_SA(b, h) (((b) * 2 + (h)) * HTB)
#define PG8_SB(b, h) ((4 + (b) * 2 + (h)) * HTB)
#define PG8_STAGE(bufoff, gbase, voff) do { _Pragma("unroll") for (int _i = 0; _i < 2; ++_i) \
        __builtin_amdgcn_global_load_lds((const unsigned*)((const char*)(gbase) + (voff)[_i]), (LAS unsigned*)(lds + (bufoff) + ldsw + _i * 8192), 16, 0, 0); } while (0)
#define PG8_LDA(dst, b, h) do { _Pragma("unroll") for (int m = 0; m < 4; ++m) _Pragma("unroll") for (int k = 0; k < 2; ++k) dst[m][k] = *(const LAS bf16x8*)(lds + PG8_SA(b, h) + aoff + m * 2048 + k * 1024); } while (0)
#define PG8_LDB(dst, b, h) do { _Pragma("unroll") for (int n = 0; n < 2; ++n) _Pragma("unroll") for (int k = 0; k < 2; ++k) dst[n][k] = *(const LAS bf16x8*)(lds + PG8_SB(b, h) + boff + n * 2048 + k * 1024); } while (0)
#define PG8_MMA(ai, bj, At, Bt) do { __builtin_amdgcn_s_setprio(1); _Pragma("unroll") for (int m = 0; m < 4; ++m) _Pragma("unroll") for (int n = 0; n < 2; ++n) _Pragma("unroll") for (int k = 0; k < 2; ++k) \
        acc[ai][bj][m][n] = __builtin_amdgcn_mfma_f32_16x16x32_bf16(Bt[n][k], At[m][k], acc[ai][bj][m][n], 0, 0, 0); __builtin_amdgcn_s_setprio(0); } while (0)
#define PG8_WAIT_V(n) asm volatile("s_waitcnt vmcnt(" #n ")" ::: "memory")
#define PG8_WAIT_L(n) asm volatile("s_waitcnt lgkmcnt(" #n ")" ::: "memory")
#define PG8_BAR __builtin_amdgcn_s_barrier()
#define PG8_SCHED __builtin_amdgcn_sched_barrier(0)
    Unit cur, nxt; int ui = 0;
    if (!S.next(0, cur)) return;
    f32x4 acc[2][2][4][2];
#pragma unroll
    for (int a = 0; a < 2; ++a)
#pragma unroll
        for (int b = 0; b < 2; ++b)
#pragma unroll
            for (int m = 0; m < 4; ++m)
#pragma unroll
                for (int n = 0; n < 2; ++n) acc[a][b][m][n] = (f32x4){0.f, 0.f, 0.f, 0.f};
    bf16x8 At[4][2], B0[2][2], B1[2][2];
    const char* cA = (const char*)g.A + ((size_t)cur.z * g.sA + (size_t)(cur.pm * BM + (cur.hf == 2 ? HALF : 0)) * g.lda) * 2;
    const char* cB = (const char*)g.Bt + ((size_t)cur.z * g.sB + (size_t)cur.pn * BM * K) * 2;
    PG8_STAGE(PG8_SB(0, 0), cB, voffB); PG8_STAGE(PG8_SB(0, 1), cB + hstepB, voffB); PG8_STAGE(PG8_SA(0, 0), cA, voffA); PG8_STAGE(PG8_SA(0, 1), cA + hstepA, voffA);
    if (wr == 1) PG8_BAR;
    PG8_WAIT_V(2); PG8_BAR;
    PG8_STAGE(PG8_SB(1, 0), cB + kstep, voffB); PG8_STAGE(PG8_SA(1, 0), cA + kstep, voffA); PG8_STAGE(PG8_SB(1, 1), cB + hstepB + kstep, voffB);
    PG8_WAIT_V(6); PG8_BAR;
    for (;;) {
        const bool has_next = S.next(ui + 1, nxt);
        const char* nA = has_next ? (const char*)g.A + ((size_t)nxt.z * g.sA + (size_t)(nxt.pm * BM + (nxt.hf == 2 ? HALF : 0)) * g.lda) * 2 : cA;
        const bool fullu = (cur.hf == 0);
        const char* nB = has_next ? (const char*)g.Bt + ((size_t)nxt.z * g.sB + (size_t)nxt.pn * BM * K) * 2 : cB;
        for (int t = 0; t < nt; t += 2) {
            const bool last = (t == nt - 2);
            const char* a1 = cA + (size_t)(t + 1) * kstep;
            const char* a2 = last ? nA : cA + (size_t)(t + 2) * kstep; const char* b2 = last ? nB : cB + (size_t)(t + 2) * kstep;
            const char* a3 = a2 + kstep; const char* b3 = b2 + kstep;
            PG8_LDB(B0, 0, 0); PG8_LDB(B1, 0, 1); PG8_SCHED; PG8_LDA(At, 0, 0); PG8_STAGE(PG8_SA(1, 1), a1 + hstepA, voffA);
            PG8_WAIT_V(8); PG8_WAIT_L(0); PG8_BAR; PG8_MMA(0, 0, At, B0); PG8_MMA(0, 1, At, B1); PG8_BAR; PG8_SCHED;
            if (fullu) PG8_LDA(At, 0, 1); PG8_STAGE(PG8_SB(0, 0), b2, voffB); PG8_STAGE(PG8_SB(0, 1), b2 + hstepB, voffB); PG8_STAGE(PG8_SA(0, 0), a2, voffA);
            PG8_WAIT_V(8); PG8_WAIT_L(0); PG8_BAR; if (fullu) { PG8_MMA(1, 0, At, B0); PG8_MMA(1, 1, At, B1); } PG8_BAR; PG8_SCHED;
            PG8_LDB(B0, 1, 0); PG8_LDB(B1, 1, 1); PG8_SCHED; PG8_LDA(At, 1, 0); PG8_STAGE(PG8_SA(0, 1), a2 + hstepA, voffA);
            PG8_WAIT_V(8); PG8_WAIT_L(0); PG8_BAR; PG8_MMA(0, 0, At, B0); PG8_MMA(0, 1, At, B1); PG8_BAR; PG8_SCHED;
            if (fullu) PG8_LDA(At, 1, 1); PG8_STAGE(PG8_SB(1, 0), b3, voffB); PG8_STAGE(PG8_SB(1, 1), b3 + hstepB, voffB); PG8_STAGE(PG8_SA(1, 0), a3, voffA);
            PG8_WAIT_V(8); PG8_WAIT_L(0); PG8_BAR; if (fullu) { PG8_MMA(1, 0, At, B0); PG8_MMA(1, 1, At, B1); } PG8_BAR; PG8_SCHED;
        }
        if (wr == 0) PG8_BAR;
        if (fullu) E.template tile<2>(acc, cur.z, cur.pm * BM + wr * 64 + fr, cur.pn * BM + wc * 32 + (Epi::PERM ? 8 : 4) * fq);
        else E.template tile<1>(acc, cur.z, cur.pm * BM + (cur.hf == 2 ? HALF : 0) + wr * 64 + fr, cur.pn * BM + wc * 32 + (Epi::PERM ? 8 : 4) * fq);
        if (!has_next) break;
#pragma unroll
        for (int a = 0; a < 2; ++a)
#pragma unroll
            for (int b = 0; b < 2; ++b)
#pragma unroll
                for (int m = 0; m < 4; ++m)
#pragma unroll
                    for (int n = 0; n < 2; ++n) acc[a][b][m][n] = (f32x4){0.f, 0.f, 0.f, 0.f};
        cur = nxt; cA = nA; cB = nB; ++ui;
        if (wr == 1) PG8_BAR;
    }
    PG8_WAIT_V(0);
    PG8_BAR;
#undef PG8_SA
#undef PG8_SB
#undef PG8_STAGE
#undef PG8_LDA
#undef PG8_LDB
#undef PG8_MMA
#undef PG8_WAIT_V
#undef PG8_WAIT_L
#undef PG8_BAR
#undef PG8_SCHED
}
}

#define EPI_SIMPLE_TILE() \
    static constexpr bool PERM = false; \
    template <int NAI> __device__ __forceinline__ void tile(const f32x4 (&acc)[2][2][4][2], int z, int row0, int col0) const { \
        _Pragma("unroll") for (int ai = 0; ai < NAI; ++ai) _Pragma("unroll") for (int m = 0; m < 4; ++m) _Pragma("unroll") for (int bj = 0; bj < 2; ++bj) _Pragma("unroll") for (int n = 0; n < 2; ++n) \
            (*this)(z, row0 + ai * 128 + m * 16, col0 + bj * 128 + n * 16, acc[ai][bj][m][n]); }
#define EPI_PAIR_TILE() \
    static constexpr bool PERM = true; \
    template <int NAI> __device__ __forceinline__ void tile(const f32x4 (&acc)[2][2][4][2], int z, int row0, int col0) const { \
        _Pragma("unroll") for (int ai = 0; ai < NAI; ++ai) _Pragma("unroll") for (int m = 0; m < 4; ++m) _Pragma("unroll") for (int bj = 0; bj < 2; ++bj) \
            pair(row0 + ai * 128 + m * 16, col0 + bj * 128, acc[ai][bj][m][0], acc[ai][bj][m][1]); }
#define EPI_PIPE_TILE() \
    static constexpr bool PERM = true; \
    template <int NAI> __device__ __forceinline__ void tile(const f32x4 (&acc)[2][2][4][2], int z, int row0, int col0) const { \
        Pre pre; begin(row0, col0, pre); L buf[2][8]; \
        _Pragma("unroll") for (int mm = 0; mm < 2; ++mm) _Pragma("unroll") for (int bj = 0; bj < 2; ++bj) _Pragma("unroll") for (int n = 0; n < 2; ++n) load(row0 + mm * 16, col0 + bj * 128 + n * 4, buf[0][mm * 4 + bj * 2 + n]); \
        _Pragma("unroll") for (int b = 0; b < 2 * NAI; ++b) { \
            if (b < 2 * NAI - 1) { _Pragma("unroll") for (int mm = 0; mm < 2; ++mm) _Pragma("unroll") for (int bj = 0; bj < 2; ++bj) _Pragma("unroll") for (int n = 0; n < 2; ++n) \
                load(row0 + ((b + 1) >> 1) * 128 + (((b + 1) & 1) * 2 + mm) * 16, col0 + bj * 128 + n * 4, buf[(b + 1) & 1][mm * 4 + bj * 2 + n]); } \
            _Pragma("unroll") for (int mm = 0; mm < 2; ++mm) _Pragma("unroll") for (int bj = 0; bj < 2; ++bj) _Pragma("unroll") for (int n = 0; n < 2; ++n) \
                apply(row0 + (b >> 1) * 128 + ((b & 1) * 2 + mm) * 16, col0 + bj * 128 + n * 4, acc[b >> 1][bj][(b & 1) * 2 + mm][n], buf[b & 1][mm * 4 + bj * 2 + n], pre, bj * 2 + n); } }
__device__ __forceinline__ void store8bf(bf16_t* ptr, f32x4 a, f32x4 b) { u32x4 w; w.x = pk_bf16(a[0], a[1]); w.y = pk_bf16(a[2], a[3]); w.z = pk_bf16(b[0], b[1]); w.w = pk_bf16(b[2], b[3]); *(u32x4*)ptr = w; }

struct EpiPartA {
    bf16_t* Q; bf16_t* Kk; bf16_t* V; bf16_t* UG; float* GLR;
    __device__ __forceinline__ void pair(int row, int col, f32x4 a, f32x4 b) const {
        if (col < 512) store8bf(Q + (size_t)row * 512 + col, a, b);
        else if (col < 1024) store8bf(Kk + (size_t)row * 512 + (col - 512), a, b);
        else if (col < 2048) store8bf(V + (size_t)row * 1024 + (col - 1024), a, b);
        else if (col < 2304) { const int c = col - 2048; if (c < 32) { *(f32x4*)(GLR + (size_t)row * 32 + c) = a; *(f32x4*)(GLR + (size_t)row * 32 + c + 4) = b; } }
        else { const int c = col - 2304, g = c >> 4, n = c & 15, chunk = row >> 5, j = row & 31; store8bf(UG + ((size_t)(g * 1280 + chunk) * 768 + j * 16 + n), a, b); }
    }
    EPI_PAIR_TILE()
};
struct EpiE { float* E; __device__ __forceinline__ void operator()(int z, int row, int col, f32x4 v) const { *(f32x4*)(E + ((size_t)(z * 1280 + row) * 256 + col)) = v; } EPI_SIMPLE_TILE() };
struct EpiY {
    bf16_t* YB;
    __device__ __forceinline__ void operator()(int z, int row, int col, f32x4 v) const {
        const int tok = row * 32 + (col >> 4), ch = z * 16 + (col & 15);
        f32x4 o;
#pragma unroll
        for (int e = 0; e < 4; ++e) { const float x = v[e]; o[e] = x * sigmoidf_(1.5957691216f * (x + 0.044715f * x * x * x)); }
        store4bf(YB + (size_t)tok * 512 + ch, o);
    }
    EPI_SIMPLE_TILE()
};
struct EpiGLU {
    const bf16_t* YB; bf16_t* OS5; const float* bglu;
    typedef u32x2 L; struct Pre { f32x4 b[4]; };
    __device__ __forceinline__ void begin(int, int col0, Pre& pr) const {
#pragma unroll
        for (int k = 0; k < 4; ++k) pr.b[k] = *(const f32x4*)(bglu + col0 + (k >> 1) * 128 + (k & 1) * 4); }
    __device__ __forceinline__ void load(int row, int col, L& l) const { l = *(const u32x2*)(YB + (size_t)row * 512 + col); }
    __device__ __forceinline__ void apply(int row, int col, f32x4 v, const L& l, const Pre& pr, int k) const {
        const f32x4 y = (f32x4){bflo(l.x), bfhi(l.x), bflo(l.y), bfhi(l.y)}; f32x4 o;
#pragma unroll
        for (int e = 0; e < 4; ++e) o[e] = y[e] * sigmoidf_(v[e] + pr.b[k][e]);
        store4bf(OS5 + (size_t)row * 512 + col, o); }
    EPI_PIPE_TILE()
};
struct EpiPartB {
    bf16_t* R; bf16_t* GA; bf16_t* GB;
    __device__ __forceinline__ void pair(int row, int col, f32x4 a, f32x4 b) const {
        f32x4 sa, sb;
#pragma unroll
        for (int e = 0; e < 4; ++e) { sa[e] = sigmoidf_(a[e]); sb[e] = sigmoidf_(b[e]); }
        if (col < 1024) store8bf(R + (size_t)row * 1024 + col, a * sa, b * sb);
        else if (col < 2048) store8bf(GA + (size_t)row * 1024 + (col - 1024), sa, sb);
        else store8bf(GB + (size_t)row * 1024 + (col - 2048), sa, sb);
    }
    EPI_PAIR_TILE()
};
struct EpiProj1 { const bf16_t* GA; bf16_t* T1;
    typedef u32x2 L; struct Pre { int dummy; };
    __device__ __forceinline__ void begin(int, int, Pre&) const {}
    __device__ __forceinline__ void load(int row, int col, L& l) const { l = *(const u32x2*)(GA + (size_t)row * 1024 + col); }
    __device__ __forceinline__ void apply(int row, int col, f32x4 v, const L& l, const Pre&, int) const {
        const f32x4 g = (f32x4){bflo(l.x), bfhi(l.x), bflo(l.y), bfhi(l.y)}; store4bf(T1 + (size_t)row * 1024 + col, g * v); }
    EPI_PIPE_TILE()
};
struct EpiProj2 { const bf16_t* GB; bf16_t* T1;
    struct L { u32x2 t, g; }; struct Pre { int dummy; };
    __device__ __forceinline__ void begin(int, int, Pre&) const {}
    __device__ __forceinline__ void load(int row, int col, L& l) const { const size_t o = (size_t)row * 1024 + col; l.t = *(const u32x2*)(T1 + o); l.g = *(const u32x2*)(GB + o); }
    __device__ __forceinline__ void apply(int row, int col, f32x4 v, const L& l, const Pre&, int) const {
        const f32x4 g = (f32x4){bflo(l.g.x), bfhi(l.g.x), bflo(l.g.y), bfhi(l.g.y)}, t = (f32x4){bflo(l.t.x), bfhi(l.t.x), bflo(l.t.y), bfhi(l.t.y)};
        store4bf(T1 + (size_t)row * 1024 + col, t + g * v); }
    EPI_PIPE_TILE()
};
struct EpiDelta { bf16_t* Dl; const float* gate;
    static constexpr bool PERM = true;
    template <int NAI> __device__ __forceinline__ void tile(const f32x4 (&acc)[2][2][4][2], int, int row0, int col0) const {
        const float* gp = gate + (size_t)mod_index(row0) * 6144 + col0; f32x4 g[2][2];
#pragma unroll
        for (int bj = 0; bj < 2; ++bj)
#pragma unroll
            for (int n = 0; n < 2; ++n) g[bj][n] = *(const f32x4*)(gp + bj * 128 + n * 4);
#pragma unroll
        for (int ai = 0; ai < NAI; ++ai)
#pragma unroll
            for (int m = 0; m < 4; ++m)
#pragma unroll
                for (int bj = 0; bj < 2; ++bj) store8bf(Dl + (size_t)(row0 + ai * 128 + m * 16) * 1024 + col0 + bj * 128, g[bj][0] * acc[ai][bj][m][0], g[bj][1] * acc[ai][bj][m][1]);
    } };
struct EpiFF1 { bf16_t* H;
    __device__ __forceinline__ void pair(int row, int col, f32x4 a, f32x4 b) const {
        f32x4 oa, ob;
#pragma unroll
        for (int e = 0; e < 4; ++e) { const float ra = fmaxf(a[e], 0.f), rb = fmaxf(b[e], 0.f); oa[e] = ra * ra; ob[e] = rb * rb; }
        store8bf(H + (size_t)row * 4096 + col, oa, ob); }
    EPI_PAIR_TILE()
};

struct ConvJob { const float* src; int ld, K, c0, nvalid, ndst; bf16_t* dst; float scale; };
__device__ __forceinline__ bool conv_job(const P& p, int l, int j, ConvJob& J) {
    bf16_t* W = (bf16_t*)(p.ws + WS_W);
    const float* win = p.in[lnd(10)] + (size_t)l * 1024 * 5664;
    J.scale = 1.0f;
    switch (j) {
        case 0: J = {win, 5664, 1024, 0, 512, 512, W + W_A / 2, 0.08838834764831845f}; break;
        case 1: J = {win, 5664, 1024, 512, 512, 512, W + W_A / 2 + (size_t)512 * 1024, 1.f}; break;
        case 2: J = {win, 5664, 1024, 1024, 1024, 1024, W + W_A / 2 + (size_t)1024 * 1024, 1.f}; break;
        case 3: J = {win, 5664, 1024, 3072, 32, 256, W + W_A / 2 + (size_t)2048 * 1024, 1.f}; break;
        case 4: J = {win, 5664, 1024, 3104, 512, 512, W + W_A / 2 + (size_t)2304 * 1024, 1.f}; break;
        case 5: J = {win, 5664, 1024, 2048, 1024, 1024, W + W_B / 2, 1.f}; break;
        case 6: J = {win, 5664, 1024, 3616, 1024, 1024, W + W_B / 2 + (size_t)1024 * 1024, 1.f}; break;
        case 7: J = {win, 5664, 1024, 4640, 1024, 1024, W + W_B / 2 + (size_t)2048 * 1024, 1.f}; break;
        case 8: J = {p.in[lnd(14)] + (size_t)l * 1024 * 1024, 1024, 1024, 0, 1024, 1024, W + W_PG / 2, 1.f}; break;
        case 9: J = {p.in[lnd(23)] + (size_t)l * 512 * 512, 512, 512, 0, 512, 512, W + W_GLU / 2, 1.f}; break;
        case 10: J = {p.in[lnd(25)] + (size_t)l * 512 * 1024, 1024, 512, 0, 1024, 1024, W + W_PS / 2, 1.f}; break;
        case 11: J = {p.in[lnd(26)] + (size_t)l * 1024 * 1024, 1024, 1024, 0, 1024, 1024, W + W_OUT / 2, 1.f}; break;
        case 12: J = {p.in[lnd(28)] + (size_t)l * 1024 * 4096, 4096, 1024, 0, 4096, 4096, W + W_1 / 2, 1.f}; break;
        case 13: J = {p.in[lnd(29)] + (size_t)l * 4096 * 1024, 1024, 4096, 0, 1024, 1024, W + W_2 / 2, 1.f}; break;
        default: return false;
    }
    return true;
}
constexpr int CONV_TILES = 2112;
__device__ __forceinline__ void conv_tile(const P& p, int l, int tile, LAS float* sT) {
    const int tid = tid_();
    ConvJob J; int j = 0, rem = tile;
    for (; j < 14; ++j) { conv_job(p, l, j, J); const int nt = (J.ndst / 64) * (J.K / 128); if (rem < nt) break; rem -= nt; }
    const int kts = J.K / 128, ntile = rem / kts, ktile = rem % kts, n0 = ntile * 64, k0 = ktile * 128;
    {
        const int kk = tid >> 4, c4 = (tid & 15) * 4; f32x4 v[4];
#pragma unroll
        for (int i = 0; i < 4; ++i) { v[i] = (f32x4){0.f, 0.f, 0.f, 0.f};
            if (n0 + c4 < J.nvalid) v[i] = *(const f32x4*)(J.src + (size_t)(k0 + kk + 32 * i) * J.ld + J.c0 + n0 + c4); }
#pragma unroll
        for (int i = 0; i < 4; ++i)
#pragma unroll
            for (int e = 0; e < 4; ++e) sT[(c4 + e) * 129 + kk + 32 * i] = v[i][e] * J.scale;
    }
    __syncthreads();
    {
        const int n = tid >> 3, ks = (tid & 7) * 16;
        const int rho = n & 31, nsrc = (n & ~31) + 8 * ((rho & 15) >> 2) + 4 * (rho >> 4) + (rho & 3);
        const LAS float* sp = sT + nsrc * 129 + ks;
#pragma unroll
        for (int hh = 0; hh < 2; ++hh) { u32x4 w; const LAS float* q = sp + 8 * hh;
            w.x = pk_bf16(q[0], q[1]); w.y = pk_bf16(q[2], q[3]); w.z = pk_bf16(q[4], q[5]); w.w = pk_bf16(q[6], q[7]);
            *(u32x4*)(J.dst + (size_t)(n0 + n) * J.K + k0 + ks + 8 * hh) = w; }
    }
}

__device__ __forceinline__ void mod_task(const P& p, int m, LAS float* sm) {
    const int tid = tid_(), l = m / 192, colbase = (m % 192) * 32, cl = tid & 31, ks = tid >> 5;
    LAS float* SC = sm; LAS float* RED = sm + 9216;
    for (int i = tid; i < 9216; i += NTHR) { const int j = i >> 10, k = i & 1023; const float c = (j == 0) ? p.in[lnd(6)][k] : p.in[lnd(2)][(j - 1) * 1024 + k]; SC[i] = c * sigmoidf_(c); }
    __syncthreads();
    float acc[9];
#pragma unroll
    for (int j = 0; j < 9; ++j) acc[j] = 0.f;
    const float* w = p.in[lnd(7)] + (size_t)l * 1024 * 6144 + colbase + cl;
    for (int k8 = 0; k8 < 64; k8 += 16) { float wv[16];
#pragma unroll
        for (int u = 0; u < 16; ++u) wv[u] = w[(size_t)(ks * 64 + k8 + u) * 6144];
#pragma unroll
        for (int u = 0; u < 16; ++u)
#pragma unroll
            for (int j = 0; j < 9; ++j) acc[j] += SC[j * 1024 + ks * 64 + k8 + u] * wv[u]; }
#pragma unroll
    for (int j = 0; j < 9; ++j) RED[(ks * 9 + j) * 32 + cl] = acc[j];
    __syncthreads();
    if (tid < 288) { const int j = tid >> 5, c = tid & 31; float s = 0.f;
#pragma unroll
        for (int q = 0; q < 16; ++q) s += RED[(q * 9 + j) * 32 + c];
        float* mod = (float*)(p.ws + WS_MOD);
        mod[((size_t)l * 9 + j) * 6144 + colbase + c] = s + p.in[lnd(8)][(size_t)l * 6144 + colbase + c]; }
}

__device__ __forceinline__ void s5_mats(const P& p, int l, int gq, LAS float* sm) {
    const int tid = tid_(), g = gq >> 2, part = gq & 3;
    LAS float* KF = sm; LAS float* KB = sm + 8192; LAS float* LT = sm + 16384; LAS float* CC = sm + 20608; LAS float* BB = sm + 22656;
    bf16_t* MC = (bf16_t*)(p.ws + WS_R1) + (size_t)g * 512 * 768;
    bf16_t* EM = (bf16_t*)(p.ws + WS_EMAT) + (size_t)g * 256 * 512;
    for (int d = 0; d < 2; ++d) {
        const int pg = (l * 2 + d) * 32 + g;
        const float* lamr = p.in[lnd(15)] + (size_t)pg * 64; const float* lami = p.in[lnd(16)] + (size_t)pg * 64;
        const float dt = expf(p.in[lnd(17)][pg]);
        const float* bre = p.in[lnd(18)] + (size_t)pg * 1024; const float* bim = p.in[lnd(19)] + (size_t)pg * 1024;
        const float* cre = p.in[lnd(20)] + (size_t)pg * 1024; const float* cim = p.in[lnd(21)] + (size_t)pg * 1024;
        for (int i = tid; i < 33 * 64; i += NTHR) { const int tau = i >> 6, pp = i & 63; const float a = expf(lamr[pp] * dt * (float)tau); float s, c; sincosf(lami[pp] * dt * (float)tau, &s, &c); LT[2 * i] = a * c; LT[2 * i + 1] = a * s; }
        for (int i = tid; i < 1024; i += NTHR) { CC[2 * i] = cre[i]; CC[2 * i + 1] = cim[i]; }
        for (int i = tid; i < 1024; i += NTHR) {
            const int pp = i >> 4; const float lr = lamr[pp], li = lami[pp]; float s, c; sincosf(li * dt, &s, &c);
            const float em1 = expm1f(lr * dt); float sh, ch; sincosf(0.5f * li * dt, &sh, &ch);
            const float nr = em1 * c - 2.f * sh * sh, ni = (em1 + 1.f) * s;
            const float inv = 1.f / (lr * lr + li * li);
            const float qr = (nr * lr + ni * li) * inv, qi = (ni * lr - nr * li) * inv;
            const float br = bre[i], bi = bim[i];
            BB[2 * i] = qr * br - qi * bi; BB[2 * i + 1] = qr * bi + qi * br;
        }
        __syncthreads();
        {
            const int tau = tid >> 4, n = tid & 15; float acc[16];
#pragma unroll
            for (int m = 0; m < 16; ++m) acc[m] = 0.f;
            for (int pp = 0; pp < 64; ++pp) {
                const float cr = CC[2 * (n * 64 + pp)], ci = CC[2 * (n * 64 + pp) + 1], lr = LT[2 * (tau * 64 + pp)], li = LT[2 * (tau * 64 + pp) + 1];
                const float xr = cr * lr - ci * li, xi = cr * li + ci * lr;
#pragma unroll
                for (int m = 0; m < 16; ++m) acc[m] += xr * BB[2 * (pp * 16 + m)] - xi * BB[2 * (pp * 16 + m) + 1];
            }
            LAS float* Kd = d ? KB : KF;
#pragma unroll
            for (int m = 0; m < 16; ++m) Kd[(tau * 16 + n) * 16 + m] = acc[m];
        }
        {
            const int pp = tid >> 3, cseg = tid & 7;
            { const int jj = part;
                const int j = cseg * 4 + jj, e = d == 0 ? 31 - j : j; const float lr = LT[2 * (e * 64 + pp)], li = LT[2 * (e * 64 + pp) + 1];
                float re[16], im[16];
#pragma unroll
                for (int m = 0; m < 16; ++m) { const float br = BB[2 * (pp * 16 + m)], bi = BB[2 * (pp * 16 + m) + 1]; re[m] = lr * br - li * bi; im[m] = lr * bi + li * br; }
                bf16_t* er = EM + (size_t)(d * 128 + pp) * 512 + j * 16; bf16_t* ei = EM + (size_t)(d * 128 + 64 + pp) * 512 + j * 16;
#pragma unroll
                for (int h = 0; h < 2; ++h) {
                    u32x4 w; w.x = pk_bf16(re[8 * h], re[8 * h + 1]); w.y = pk_bf16(re[8 * h + 2], re[8 * h + 3]); w.z = pk_bf16(re[8 * h + 4], re[8 * h + 5]); w.w = pk_bf16(re[8 * h + 6], re[8 * h + 7]); *(u32x4*)(er + 8 * h) = w;
                    u32x4 x; x.x = pk_bf16(im[8 * h], im[8 * h + 1]); x.y = pk_bf16(im[8 * h + 2], im[8 * h + 3]); x.z = pk_bf16(im[8 * h + 4], im[8 * h + 5]); x.w = pk_bf16(im[8 * h + 6], im[8 * h + 7]); *(u32x4*)(ei + 8 * h) = x;
                }
            }
        }
        {
            const int t = tid >> 4, n = tid & 15, f = d == 0 ? t + 1 : 32 - t;
            bf16_t* mr = MC + (size_t)tid * 768 + 512 + d * 128;
#pragma unroll 1
            for (int p8 = 2 * part; p8 < 2 * part + 2; ++p8) {
                float re[8], im[8];
#pragma unroll
                for (int q = 0; q < 8; ++q) { const int pp = p8 * 8 + q; const float cr = CC[2 * (n * 64 + pp)], ci = CC[2 * (n * 64 + pp) + 1], lr = LT[2 * (f * 64 + pp)], li = LT[2 * (f * 64 + pp) + 1];
                    re[q] = cr * lr - ci * li; im[q] = -(cr * li + ci * lr); }
                u32x4 w; w.x = pk_bf16(re[0], re[1]); w.y = pk_bf16(re[2], re[3]); w.z = pk_bf16(re[4], re[5]); w.w = pk_bf16(re[6], re[7]); *(u32x4*)(mr + p8 * 8) = w;
                u32x4 x; x.x = pk_bf16(im[0], im[1]); x.y = pk_bf16(im[2], im[3]); x.z = pk_bf16(im[4], im[5]); x.w = pk_bf16(im[6], im[7]); *(u32x4*)(mr + 64 + p8 * 8) = x;
            }
        }
        __syncthreads();
    }
    {
        const int t = tid >> 4, n = tid & 15; const float dsk = p.in[lnd(22)][(size_t)l * 512 + g * 16 + n];
        bf16_t* mr = MC + (size_t)tid * 768;
#pragma unroll 1
        for (int j = 8 * part; j < 8 * part + 8; ++j) {
            float v[16];
#pragma unroll
            for (int m = 0; m < 16; ++m) v[m] = 0.f;
            if (j <= t) { const LAS float* k = KF + ((t - j) * 16 + n) * 16;
#pragma unroll
                for (int m = 0; m < 16; ++m) v[m] += k[m]; }
            if (j >= t) { const LAS float* k = KB + ((j - t) * 16 + n) * 16;
#pragma unroll
                for (int m = 0; m < 16; ++m) v[m] += k[m]; }
            if (j == t) {
#pragma unroll
                for (int m = 0; m < 16; ++m) v[m] += (m == n) ? dsk : 0.f; }
            u32x4 w; w.x = pk_bf16(v[0], v[1]); w.y = pk_bf16(v[2], v[3]); w.z = pk_bf16(v[4], v[5]); w.w = pk_bf16(v[6], v[7]); *(u32x4*)(mr + j * 16) = w;
            u32x4 x; x.x = pk_bf16(v[8], v[9]); x.y = pk_bf16(v[10], v[11]); x.z = pk_bf16(v[12], v[13]); x.w = pk_bf16(v[14], v[15]); *(u32x4*)(mr + j * 16 + 8) = x;
        }
    }
}

__device__ __forceinline__ void phase_prep(const P& p, int l, LAS unsigned char* lds) {
    LAS float* sm = (LAS float*)lds;
    const int b = bid_(), G = gridDim.x, ha = G >> 1;
    if (b < ha) { for (int t = b; t < 128; t += ha) { s5_mats(p, l, t, sm); __syncthreads(); } }
    else { for (int t = b - ha; t < CONV_TILES; t += G - ha) { conv_tile(p, l, t, sm); __syncthreads(); } }
    if (l == 0) for (int t = b; t < 384; t += G) { mod_task(p, t, sm); __syncthreads(); }
}

__device__ __forceinline__ void norm_row_write(const f32x4 (&x)[4], const float* g, const float* mod, int shoff, int scoff, bf16_t* hrow, int lane) {
    float ss = 0.f;
#pragma unroll
    for (int i = 0; i < 4; ++i) ss += x[i][0] * x[i][0] + x[i][1] * x[i][1] + x[i][2] * x[i][2] + x[i][3] * x[i][3];
    ss = wave_sum(ss);
    const float rstd = rsqrtf(ss * (1.0f / 1024.0f) + 1e-6f);
#pragma unroll
    for (int i = 0; i < 4; ++i) { const int d = i * 256 + lane * 4; const f32x4 gg = *(const f32x4*)(g + d), sc = *(const f32x4*)(mod + scoff + d), sh = *(const f32x4*)(mod + shoff + d);
        f32x4 h;
#pragma unroll
        for (int e = 0; e < 4; ++e) h[e] = x[i][e] * rstd * gg[e] * (1.f + sc[e]) + sh[e];
        { u32x2 w; w.x = pk_bf16(h[0], h[1]); w.y = pk_bf16(h[2], h[3]); __builtin_nontemporal_store(w, (u32x2*)(hrow + d)); } }
}
__device__ __forceinline__ void phase_norm(const P& p, int l, int which) {
    const int lane = tid_() & 63, gw = bid_() * 8 + (tid_() >> 6), nw = gridDim.x * 8;
    const float* g = (which == 1 ? p.in[lnd(9)] : p.in[lnd(27)]) + (size_t)l * 1024;
    const float* modl = (const float*)(p.ws + WS_MOD) + (size_t)l * 9 * 6144;
    const int shoff = which == 1 ? 0 : 3072, scoff = which == 1 ? 1024 : 4096;
    bf16_t* H = (bf16_t*)(p.ws + WS_R2); float* X = p.out;
    if (which == 1 && l == 0) {
        for (int item = gw; item < 4096 + 8192; item += nw) {
            if (item < 4096) {
                const int n = item; const float rr = (float)(n >> 6), cc = (float)(n & 63); f32x4 pe[4];
#pragma unroll
                for (int e = 0; e < 4; ++e) { const float om = expf(-(float)(lane * 4 + e) * (9.210340371976184f / 256.0f)); float s, c; sincosf(rr * om, &s, &c); pe[0][e] = s; pe[1][e] = c; sincosf(cc * om, &s, &c); pe[2][e] = s; pe[3][e] = c; }
                for (int b0 = 0; b0 < 8; b0 += 2) { f32x4 x[2][4];
#pragma unroll
                    for (int r = 0; r < 2; ++r) { const float* src = p.in[lnd(1)] + ((size_t)(b0 + r) * 4096 + n) * 1024;
#pragma unroll
                        for (int i = 0; i < 4; ++i) x[r][i] = *(const f32x4*)(src + i * 256 + lane * 4); }
#pragma unroll
                    for (int r = 0; r < 2; ++r) { const int row = TOKP + (b0 + r) * 4096 + n;
#pragma unroll
                        for (int i = 0; i < 4; ++i) { x[r][i] = x[r][i] + pe[i]; *(f32x4*)(X + (size_t)row * 1024 + i * 256 + lane * 4) = x[r][i]; }
                        norm_row_write(x[r], g, modl + (size_t)(1 + b0 + r) * 6144, shoff, scoff, H + (size_t)row * 1024, lane); } }
            } else { const int row = item - 4096; const float* src = p.in[lnd(0)] + (size_t)row * 1024; f32x4 x[4];
#pragma unroll
                for (int i = 0; i < 4; ++i) { x[i] = *(const f32x4*)(src + i * 256 + lane * 4); *(f32x4*)(X + (size_t)row * 1024 + i * 256 + lane * 4) = x[i]; }
                norm_row_write(x, g, modl, shoff, scoff, H + (size_t)row * 1024, lane); }
        }
    } else {
        const bf16_t* DL = (const bf16_t*)(p.ws + (which == 1 ? WS_R2 : WS_R3));
        for (int it = gw; it < TOK / 4; it += nw) {
            const int rowb = it * 4; const float* mod = modl + (size_t)mod_index(rowb) * 6144;
            f32x4 x[4][4]; u32x2 dv[4][4];
#pragma unroll
            for (int r = 0; r < 4; ++r)
#pragma unroll
                for (int i = 0; i < 4; ++i) { x[r][i] = __builtin_nontemporal_load((const f32x4*)(X + (size_t)(rowb + r) * 1024 + i * 256 + lane * 4)); dv[r][i] = __builtin_nontemporal_load((const u32x2*)(DL + (size_t)(rowb + r) * 1024 + i * 256 + lane * 4)); }
            f32x4 gs[4], sh[4];
#pragma unroll
            for (int i = 0; i < 4; ++i) { const int d = i * 256 + lane * 4; const f32x4 gg = *(const f32x4*)(g + d), sc = *(const f32x4*)(mod + scoff + d); sh[i] = *(const f32x4*)(mod + shoff + d); gs[i] = gg * (sc + 1.f); }
#pragma unroll
            for (int r = 0; r < 4; ++r) { float ss = 0.f;
#pragma unroll
                for (int i = 0; i < 4; ++i) { x[r][i] = x[r][i] + (f32x4){bflo(dv[r][i].x), bfhi(dv[r][i].x), bflo(dv[r][i].y), bfhi(dv[r][i].y)}; *(f32x4*)(X + (size_t)(rowb + r) * 1024 + i * 256 + lane * 4) = x[r][i];
                    ss += x[r][i][0] * x[r][i][0] + x[r][i][1] * x[r][i][1] + x[r][i][2] * x[r][i][2] + x[r][i][3] * x[r][i][3]; }
                ss = wave_sum(ss); const float rstd = rsqrtf(ss * (1.0f / 1024.0f) + 1e-6f);
#pragma unroll
                for (int i = 0; i < 4; ++i) { const f32x4 hv = x[r][i] * rstd * gs[i] + sh[i]; u32x2 w; w.x = pk_bf16(hv[0], hv[1]); w.y = pk_bf16(hv[2], hv[3]); __builtin_nontemporal_store(w, (u32x2*)(H + (size_t)(rowb + r) * 1024 + i * 256 + lane * 4)); } }
        }
    }
}
__device__ __forceinline__ void phase_final(const P& p) {
    const int lane = tid_() & 63, gw = bid_() * 8 + (tid_() >> 6), nw = gridDim.x * 8; float* X = p.out; const float* g = p.in[lnd(30)]; const bf16_t* DL = (const bf16_t*)(p.ws + WS_R2);
    for (int row0 = gw; row0 < TOK; row0 += 4 * nw) {
        f32x4 x[4][4]; u32x2 dv[4][4];
#pragma unroll
        for (int r = 0; r < 4; ++r) { const int row = row0 + r * nw;
            if (row < TOK) {
#pragma unroll
                for (int i = 0; i < 4; ++i) { x[r][i] = __builtin_nontemporal_load((const f32x4*)(X + (size_t)row * 1024 + i * 256 + lane * 4)); dv[r][i] = __builtin_nontemporal_load((const u32x2*)(DL + (size_t)row * 1024 + i * 256 + lane * 4)); } } }
#pragma unroll
        for (int r = 0; r < 4; ++r) { const int row = row0 + r * nw;
            if (row < TOK) { float ss = 0.f;
#pragma unroll
                for (int i = 0; i < 4; ++i) { x[r][i] = x[r][i] + (f32x4){bflo(dv[r][i].x), bfhi(dv[r][i].x), bflo(dv[r][i].y), bfhi(dv[r][i].y)}; ss += x[r][i][0] * x[r][i][0] + x[r][i][1] * x[r][i][1] + x[r][i][2] * x[r][i][2] + x[r][i][3] * x[r][i][3]; }
                ss = wave_sum(ss); const float rstd = rsqrtf(ss * (1.0f / 1024.0f) + 1e-6f);
#pragma unroll
                for (int i = 0; i < 4; ++i) { const f32x4 gg = *(const f32x4*)(g + i * 256 + lane * 4); *(f32x4*)(X + (size_t)row * 1024 + i * 256 + lane * 4) = x[r][i] * rstd * gg; } } }
    }
}

__device__ __forceinline__ void phase_s5scan(const P& p, int l) {
    const float* E = (const float*)(p.ws + WS_E); bf16_t* UG = (bf16_t*)(p.ws + WS_R5);
    float* ore = p.out + (size_t)TOK * 1024 + 16777216; float* oim = ore + 262144;
    for (int task = bid_(); task < 320; task += gridDim.x) {
        const int idx = task * NTHR + tid_(), pp = idx & 63, d = (idx >> 6) & 1, g = (idx >> 7) & 31, s = 39 - (idx >> 12);
        const int nch = s < 32 ? 8 : 128, cbase = s < 32 ? s * 8 : 256 + (s - 32) * 128;
        const int pg = (l * 2 + d) * 32 + g; const float dt = expf(p.in[lnd(17)][pg]);
        const float a = expf(p.in[lnd(15)][(size_t)pg * 64 + pp] * dt * 32.f); float sn, cs; sincosf(p.in[lnd(16)][(size_t)pg * 64 + pp] * dt * 32.f, &sn, &cs);
        const float ar = a * cs, ai = a * sn;
        float sr = 0.f, si = 0.f;
        if (s >= 32) { const size_t o = ((((size_t)(s - 32) * 2 + l) * 2 + d) * 32 + g) * 64 + pp; sr = p.in[lnd(4)][o]; si = p.in[lnd(5)][o]; }
        const float* Eb = E + ((size_t)(g * 1280 + cbase) * 256 + d * 128 + pp);
        bf16_t* Ub = UG + ((size_t)(g * 1280 + cbase) * 768 + 512 + d * 128 + pp);
        for (int c0 = 0; c0 < nch; c0 += 8) {
            float er[8], ei[8];
#pragma unroll
            for (int k = 0; k < 8; ++k) { const int c = d == 0 ? c0 + k : nch - 1 - (c0 + k); er[k] = Eb[(size_t)c * 256]; ei[k] = Eb[(size_t)c * 256 + 64]; }
#pragma unroll
            for (int k = 0; k < 8; ++k) { const int c = d == 0 ? c0 + k : nch - 1 - (c0 + k);
                Ub[(size_t)c * 768] = f2bf(sr); Ub[(size_t)c * 768 + 64] = f2bf(si);
                const float nr = ar * sr - ai * si + er[k], ni = ar * si + ai * sr + ei[k]; sr = nr; si = ni; }
        }
        if (s < 32) { const size_t o = ((((size_t)s * 2 + l) * 2 + d) * 32 + g) * 64 + pp; ore[o] = sr; oim[o] = si; }
    }
}

__device__ __forceinline__ void phase_glapre(const P& p, int l, LAS unsigned char* lds) {
    const int tid = tid_(), d = tid & 127, tq = tid >> 7, wv = tid >> 6, lane = tid & 63, fr = lane & 15, fq = lane >> 4;
    LAS float* sG = (LAS float*)lds; LAS float* sT4 = sG + 2048; LAS float* sZ = sG + 2560;
    bf16_t* Q = (bf16_t*)(p.ws + WS_R3); bf16_t* Kk = Q + (size_t)TOK * 512;
    bf16_t* QB = (bf16_t*)(p.ws + WS_R5); bf16_t* KB = QB + (size_t)TOK * 512;
    const float* GLR = (const float*)(p.ws + WS_GLR);
    for (int task = bid_(); task < 2560; task += gridDim.x) {
        const int c64 = task >> 2, h = task & 3, tb = c64 * 64;
        { const int row = tid >> 3, c4 = (tid & 7) * 4; *(LAS f32x4*)(sG + row * 32 + c4) = *(const f32x4*)(GLR + (size_t)(tb + row) * 32 + c4); }
        float qv[16], kv[16];
#pragma unroll
        for (int i = 0; i < 16; ++i) { const size_t o = (size_t)(tb + tq * 16 + i) * 512 + h * 128 + d; qv[i] = bf2f(Q[o]); kv[i] = bf2f(Kk[o]); }
        bf16x8 bw[2];
#pragma unroll
        for (int dir = 0; dir < 2; ++dir) { float w8[8];
#pragma unroll
            for (int e = 0; e < 8; ++e) { const int kk = 8 * fq + e - 16 * dir; w8[e] = (kk >= 0 && kk < 16) ? p.in[lnd(11)][((size_t)(l * 2 + dir) * 16 + kk) * 512 + h * 128 + 16 * wv + fr] : 0.f; }
            u32x4 pk; pk.x = pk_bf16(w8[0], w8[1]); pk.y = pk_bf16(w8[2], w8[3]); pk.z = pk_bf16(w8[4], w8[5]); pk.w = pk_bf16(w8[6], w8[7]);
            bw[dir] = __builtin_bit_cast(bf16x8, pk); }
        __syncthreads();
#pragma unroll
        for (int ti = 0; ti < 4; ++ti) {
            const LAS float* gr = sG + (16 * ti + fr) * 32 + 8 * fq; const f32x4 g0 = *(const LAS f32x4*)gr, g1 = *(const LAS f32x4*)(gr + 4);
            u32x4 pk; pk.x = pk_bf16(g0[0], g0[1]); pk.y = pk_bf16(g0[2], g0[3]); pk.z = pk_bf16(g1[0], g1[1]); pk.w = pk_bf16(g1[2], g1[3]);
            const bf16x8 af = __builtin_bit_cast(bf16x8, pk);
#pragma unroll
            for (int dir = 0; dir < 2; ++dir) { const f32x4 z = __builtin_amdgcn_mfma_f32_16x16x32_bf16(af, bw[dir], (f32x4){0.f, 0.f, 0.f, 0.f}, 0, 0, 0);
#pragma unroll
                for (int e = 0; e < 4; ++e) sZ[(dir * 64 + 16 * ti + 4 * fq + e) * 128 + 16 * wv + fr] = z[e]; }
        }
        __syncthreads();
#pragma unroll 1
        for (int dir = 0; dir < 2; ++dir) {
            const float bg = p.in[lnd(12)][(size_t)(l * 2 + dir) * 512 + h * 128 + d];
            float cum[16];
#pragma unroll
            for (int i = 0; i < 16; ++i) { const float z = sZ[(dir * 64 + tq * 16 + i) * 128 + d] + bg;
                cum[i] = (fminf(z, 0.f) - __logf(1.0f + __expf(-fabsf(z)))) * 0.0625f; }
            if (dir == 0) {
#pragma unroll
                for (int i = 1; i < 16; ++i) cum[i] += cum[i - 1];
            } else {
#pragma unroll
                for (int i = 14; i >= 0; --i) cum[i] += cum[i + 1];
            }
            sT4[tq * 128 + d] = dir == 0 ? cum[15] : cum[0];
            __syncthreads();
            float off = 0.f, total = 0.f;
#pragma unroll
            for (int q = 0; q < 4; ++q) { const float v = sT4[q * 128 + d]; total += v; if (dir == 0 ? (q < tq) : (q > tq)) off += v; }
            bf16_t* QD = dir == 0 ? Q : QB; bf16_t* KI = dir == 0 ? Kk : KB;
#pragma unroll
            for (int i = 0; i < 16; ++i) { const float cm = cum[i] + off; const size_t o = (size_t)(tb + tq * 16 + i) * 512 + h * 128 + d;
                QD[o] = f2bf(qv[i] * __expf(cm)); KI[o] = f2bf(kv[i] * __expf(-cm)); }
            if (tq == 0) ((float*)(p.ws + (dir == 0 ? WS_TOTF : WS_TOTB)))[(size_t)c64 * 512 + h * 128 + d] = total;
            __syncthreads();
        }
    }
}

constexpr int GLA_GRP = 71168;
typedef short s16x4 __attribute__((ext_vector_type(4)));
__device__ __forceinline__ bf16x8 tr_frag(const LAS bf16_t* base, int stride, int krow0, int col0, int fr, int fq) {
    const LAS bf16_t* q = base + (krow0 + 8 * fq + (fr >> 2)) * stride + col0 + 4 * (fr & 3);
    const s16x4 a = __builtin_amdgcn_ds_read_tr16_b64_v4i16((LAS s16x4*)q);
    const s16x4 b = __builtin_amdgcn_ds_read_tr16_b64_v4i16((LAS s16x4*)(q + 4 * stride));
    return __builtin_shufflevector(a, b, 0, 1, 2, 3, 4, 5, 6, 7);
}
#define LDS_BAR() do { asm volatile("s_waitcnt lgkmcnt(0)" ::: "memory"); __builtin_amdgcn_s_barrier(); asm volatile("" ::: "memory"); } while (0)
__device__ __forceinline__ void phase_gla(const P& p, int l, LAS unsigned char* lds) {
    const int tid = tid_(), grp = __builtin_amdgcn_readfirstlane(tid >> 8), gt = tid & 255, wv = __builtin_amdgcn_readfirstlane((tid >> 6) & 3), lane = tid & 63, fr = lane & 15, fq = lane >> 4;
    LAS unsigned char* gl = lds + grp * GLA_GRP;
    LAS bf16_t* sQ = (LAS bf16_t*)gl; LAS bf16_t* sK = (LAS bf16_t*)(gl + 17408); LAS bf16_t* sV = (LAS bf16_t*)(gl + 34816);
    LAS bf16_t* sP = (LAS bf16_t*)(gl + 44032); LAS bf16_t* sS = (LAS bf16_t*)(gl + 53248); LAS float* sTot = (LAS float*)(gl + 70656);
    const bf16_t* QD = grp == 0 ? (const bf16_t*)(p.ws + WS_R3) : (const bf16_t*)(p.ws + WS_R5);
    const bf16_t* KI = QD + (size_t)TOK * 512;
    const bf16_t* V = (const bf16_t*)(p.ws + WS_R4);
    const float* TOT = (const float*)(p.ws + (grp == 0 ? WS_TOTF : WS_TOTB));
    bf16_t* O = (bf16_t*)(p.ws + WS_R1);
    float* OST = p.out + (size_t)TOK * 1024;
    const int G = gridDim.x, b = bid_();
    const bool custom = (G == 256);
    const int ntask_mine = custom ? (b < 128 ? 1 : 4) : ((640 - b + G - 1) / G);
    for (int ti = 0; ti < ntask_mine; ++ti) {
        const int task = custom ? (b < 128 ? b : b + 128 * ti) : b + G * ti;
        if (task >= 640) break;
        const bool sample = task < 128;
        const int t2 = sample ? task : task - 128, xcd_ = t2 & 7, vs = (t2 >> 3) & 3, sh_ = xcd_ + 8 * (t2 >> 5), sb = sh_ >> 2, h = sh_ & 3;
        const int base = sample ? TOKP + sb * 4096 : sb * 256, nch = sample ? 64 : 4;
        f32x4 accS[2][4];
#pragma unroll
        for (int dt = 0; dt < 2; ++dt)
#pragma unroll
            for (int vt = 0; vt < 4; ++vt) {
                f32x4 a = (f32x4){0.f, 0.f, 0.f, 0.f};
                if (sample) { const float* cp = p.in[lnd(3)] + (((((size_t)sb * 2 + l) * 2 + grp) * 4 + h) * 128 + 16 * (2 * wv + dt) + 4 * fq) * 256 + vs * 64 + 16 * vt + fr;
#pragma unroll
                    for (int e = 0; e < 4; ++e) a[e] = cp[(size_t)e * 256]; }
                accS[dt][vt] = a;
                u32x2 w; w.x = pk_bf16(a[0], a[1]); w.y = pk_bf16(a[2], a[3]);
                *(LAS u32x2*)(sS + (16 * vt + fr) * 136 + 16 * (2 * wv + dt) + 4 * fq) = w;
            }
        u32x4 rq[2][4], rk[2][4], rv[2][2]; float rt[2] = {0.f, 0.f};
        u32x2 oprev[2][4];
#pragma unroll
        for (int u = 0; u < 2; ++u)
#pragma unroll
            for (int vt = 0; vt < 4; ++vt) oprev[u][vt] = (u32x2){0u, 0u};
#define GLA_CHUNK(st) (grp == 0 ? (st) : nch - 1 - (st))
#define GLA_LOAD(U, ci) do { const int tb_ = base + (ci) * 64; \
        _Pragma("unroll") for (int i = 0; i < 4; ++i) { const int idx = gt + 256 * i, row = idx >> 4, c16 = idx & 15; const size_t o = (size_t)(tb_ + row) * 512 + h * 128 + c16 * 8; rq[U][i] = *(const u32x4*)(QD + o); rk[U][i] = *(const u32x4*)(KI + o); } \
        _Pragma("unroll") for (int i = 0; i < 2; ++i) { const int idx = gt + 256 * i, row = idx >> 3, c8 = idx & 7; rv[U][i] = *(const u32x4*)(V + (size_t)(tb_ + row) * 1024 + h * 256 + vs * 64 + c8 * 8); } \
        if (gt < 128) rt[U] = TOT[(size_t)(tb_ >> 6) * 512 + h * 128 + gt]; } while (0)
#define GLA_STORE(U) do { \
        _Pragma("unroll") for (int i = 0; i < 4; ++i) { const int idx = gt + 256 * i, row = idx >> 4, c16 = idx & 15; *(LAS u32x4*)(sQ + row * 136 + c16 * 8) = rq[U][i]; *(LAS u32x4*)(sK + row * 136 + c16 * 8) = rk[U][i]; } \
        _Pragma("unroll") for (int i = 0; i < 2; ++i) { const int idx = gt + 256 * i, row = idx >> 3, c8 = idx & 7; *(LAS u32x4*)(sV + row * 72 + c8 * 8) = rv[U][i]; } \
        if (gt < 128) sTot[gt] = rt[U]; } while (0)
#define GLA_OLOAD(U, st) do { const int tb_ = base + GLA_CHUNK(st) * 64; \
        _Pragma("unroll") for (int vt = 0; vt < 4; ++vt) oprev[U][vt] = *(const u32x2*)(O + (size_t)(tb_ + 16 * wv + fr) * 1024 + h * 256 + vs * 64 + 16 * vt + 4 * fq); } while (0)
        GLA_LOAD(0, GLA_CHUNK(0));
        GLA_STORE(0);
        GLA_LOAD(1, GLA_CHUNK(1));
        __syncthreads();
        const int half = nch >> 1;
        for (int s0 = 0; s0 < nch; s0 += 2) {
#pragma unroll
          for (int u = 0; u < 2; ++u) {
            const int s = s0 + u;
            const int ci = GLA_CHUNK(s), tb = base + ci * 64;
            const bool second = (s >= half);
            if (s == half) GLA_OLOAD(u, s);
            if (s + 1 < nch && s + 1 > half) GLA_OLOAD(u ^ 1, s + 1);
            asm volatile("" ::: "memory");
            if (s + 2 < nch) GLA_LOAD(u, GLA_CHUNK(s + 2));
            { bf16x8 qa[4];
#pragma unroll
            for (int ks = 0; ks < 4; ++ks) qa[ks] = *(const LAS bf16x8*)(sQ + (16 * wv + fr) * 136 + 32 * ks + 8 * fq);
#pragma unroll
            for (int jt = 0; jt < 4; ++jt) {
                bf16x8 kb[4];
#pragma unroll
                for (int ks = 0; ks < 4; ++ks) kb[ks] = *(const LAS bf16x8*)(sK + (16 * jt + fr) * 136 + 32 * ks + 8 * fq);
                f32x4 acc = (f32x4){0.f, 0.f, 0.f, 0.f};
#pragma unroll
                for (int ks = 0; ks < 4; ++ks) acc = __builtin_amdgcn_mfma_f32_16x16x32_bf16(qa[ks], kb[ks], acc, 0, 0, 0);
#pragma unroll
                for (int e = 0; e < 4; ++e) { const int i = 16 * wv + 4 * fq + e, j = 16 * jt + fr; const bool keep = grp == 0 ? (j <= i) : (j >= i); sP[i * 72 + j] = f2bf(keep ? acc[e] : 0.f); }
            } }
            asm volatile("" ::: "memory");
            bf16x8 vf[4][2];
#pragma unroll
            for (int vt = 0; vt < 4; ++vt)
#pragma unroll
                for (int ks = 0; ks < 2; ++ks) vf[vt][ks] = tr_frag(sV, 72, 32 * ks, 16 * vt, fr, fq);
#pragma unroll
            for (int dt = 0; dt < 2; ++dt) {
                bf16x8 kf[2];
#pragma unroll
                for (int ks = 0; ks < 2; ++ks) kf[ks] = tr_frag(sK, 136, 32 * ks, 16 * (2 * wv + dt), fr, fq);
                const f32x4 tt = *(const LAS f32x4*)(sTot + 16 * (2 * wv + dt) + 4 * fq);
                const f32x4 sc = (f32x4){__expf(tt[0]), __expf(tt[1]), __expf(tt[2]), __expf(tt[3])};
#pragma unroll
                for (int vt = 0; vt < 4; ++vt) {
#pragma unroll
                    for (int ks = 0; ks < 2; ++ks) accS[dt][vt] = __builtin_amdgcn_mfma_f32_16x16x32_bf16(kf[ks], vf[vt][ks], accS[dt][vt], 0, 0, 0);
                    accS[dt][vt] = accS[dt][vt] * sc;
                }
            }
            asm volatile("s_waitcnt lgkmcnt(0)" ::: "memory");
            {
                bf16x8 pf[2];
#pragma unroll
                for (int ks = 0; ks < 2; ++ks) pf[ks] = *(const LAS bf16x8*)(sP + (16 * wv + fr) * 72 + 32 * ks + 8 * fq);
                bf16x8 qf[4];
#pragma unroll
                for (int ks = 0; ks < 4; ++ks) qf[ks] = *(const LAS bf16x8*)(sQ + (16 * wv + fr) * 136 + 32 * ks + 8 * fq);
#pragma unroll
                for (int vt = 0; vt < 4; ++vt) {
                    f32x4 acc = (f32x4){0.f, 0.f, 0.f, 0.f};
#pragma unroll
                    for (int ks = 0; ks < 2; ++ks) acc = __builtin_amdgcn_mfma_f32_16x16x32_bf16(vf[vt][ks], pf[ks], acc, 0, 0, 0);
#pragma unroll
                    for (int ks = 0; ks < 4; ++ks) { const bf16x8 sf = *(const LAS bf16x8*)(sS + (16 * vt + fr) * 136 + 32 * ks + 8 * fq);
                        acc = __builtin_amdgcn_mfma_f32_16x16x32_bf16(sf, qf[ks], acc, 0, 0, 0); }
                    { u32x2 pv = oprev[u][vt]; asm volatile("" : "+v"(pv));
                      if (second) acc = acc + (f32x4){bflo(pv.x), bfhi(pv.x), bflo(pv.y), bfhi(pv.y)}; }
                    store4bf(O + (size_t)(tb + 16 * wv + fr) * 1024 + h * 256 + vs * 64 + 16 * vt + 4 * fq, acc);
                }
            }
            LDS_BAR();
#pragma unroll
            for (int dt = 0; dt < 2; ++dt)
#pragma unroll
                for (int vt = 0; vt < 4; ++vt) { u32x2 w; w.x = pk_bf16(accS[dt][vt][0], accS[dt][vt][1]); w.y = pk_bf16(accS[dt][vt][2], accS[dt][vt][3]);
                    *(LAS u32x2*)(sS + (16 * vt + fr) * 136 + 16 * (2 * wv + dt) + 4 * fq) = w; }
            if (s + 1 < nch) GLA_STORE(u ^ 1);
            if (s == half - 1) { asm volatile("s_waitcnt vmcnt(0)" ::: "memory"); __syncthreads(); } else LDS_BAR();
          }
        }
        if (!sample) {
#pragma unroll
            for (int dt = 0; dt < 2; ++dt)
#pragma unroll
                for (int vt = 0; vt < 4; ++vt) { float* op = OST + (((((size_t)sb * 2 + l) * 2 + grp) * 4 + h) * 128 + 16 * (2 * wv + dt) + 4 * fq) * 256 + vs * 64 + 16 * vt + fr;
#pragma unroll
                    for (int e = 0; e < 4; ++e) op[(size_t)e * 256] = accS[dt][vt][e]; }
        }
    }
#undef GLA_LOAD
#undef GLA_STORE
#undef GLA_OLOAD
#undef GLA_CHUNK
}

__device__ __forceinline__ void phase_glapost(const P& p, int l) {
    const int lane = tid_() & 63, gw = bid_() * 8 + (tid_() >> 6), nw = gridDim.x * 8;
    bf16_t* O = (bf16_t*)(p.ws + WS_R1); const bf16_t* R = (const bf16_t*)(p.ws + WS_R3);
    const float* gn = p.in[lnd(13)] + (size_t)l * 256 + (lane & 15) * 16;
    for (int row = gw; row < TOK; row += nw) {
        const size_t o = (size_t)row * 1024 + lane * 16; float x[16], r[16];
#pragma unroll
        for (int hh = 0; hh < 2; ++hh) { const u32x4 a = *(const u32x4*)(O + o + 8 * hh), c = *(const u32x4*)(R + o + 8 * hh);
            x[8 * hh + 0] = bflo(a.x); x[8 * hh + 1] = bfhi(a.x); x[8 * hh + 2] = bflo(a.y); x[8 * hh + 3] = bfhi(a.y); x[8 * hh + 4] = bflo(a.z); x[8 * hh + 5] = bfhi(a.z); x[8 * hh + 6] = bflo(a.w); x[8 * hh + 7] = bfhi(a.w);
            r[8 * hh + 0] = bflo(c.x); r[8 * hh + 1] = bfhi(c.x); r[8 * hh + 2] = bflo(c.y); r[8 * hh + 3] = bfhi(c.y); r[8 * hh + 4] = bflo(c.z); r[8 * hh + 5] = bfhi(c.z); r[8 * hh + 6] = bflo(c.w); r[8 * hh + 7] = bfhi(c.w); }
        float ss = 0.f;
#pragma unroll
        for (int e = 0; e < 16; ++e) ss += x[e] * x[e];
        ss += __shfl_xor(ss, 1); ss += __shfl_xor(ss, 2); ss += __shfl_xor(ss, 4); ss += __shfl_xor(ss, 8);
        const float rstd = rsqrtf(ss * (1.0f / 256.0f) + 1e-6f);
        float y[16];
#pragma unroll
        for (int e = 0; e < 16; ++e) y[e] = x[e] * rstd * gn[e] * r[e];
#pragma unroll
        for (int hh = 0; hh < 2; ++hh) { u32x4 w; w.x = pk_bf16(y[8 * hh], y[8 * hh + 1]); w.y = pk_bf16(y[8 * hh + 2], y[8 * hh + 3]); w.z = pk_bf16(y[8 * hh + 4], y[8 * hh + 5]); w.w = pk_bf16(y[8 * hh + 6], y[8 * hh + 7]); *(u32x4*)(O + o + 8 * hh) = w; }
    }
}


#define XB_TMO      128
#define XB_XCNT(j)  (256  + 64 * (j))
#define XB_XSUB(j)  (1280 + 64 * (j))
#define XB_XGEN(j)  (2304 + 64 * (j))
#define XB_TOP      3328
#define XB_TOPGEN   3392
#define XCD_BAR_WORDS 3456
#define XB_SPIN_CAP (1u << 18)
__device__ __forceinline__ unsigned xb_ld(unsigned* p)              { return __hip_atomic_load(p, __ATOMIC_RELAXED, __HIP_MEMORY_SCOPE_AGENT); }
__device__ __forceinline__ unsigned xb_add(unsigned* p, unsigned v) { return __hip_atomic_fetch_add(p, v, __ATOMIC_RELAXED, __HIP_MEMORY_SCOPE_AGENT); }
__device__ __forceinline__ unsigned xb_xcc_id() { return (unsigned)__builtin_amdgcn_s_getreg((3 << 11) | 20) & 0xFu; }
#define XB_SPIN(cond, bar) do { unsigned _sp = 0; while (cond) { __builtin_amdgcn_s_sleep(1); \
    if ((++_sp & 255u) == 0u) { if (xb_ld(&(bar)[XB_TMO])) break; if (_sp > XB_SPIN_CAP) { atomicAdd(&(bar)[XB_TMO], 1u); break; } } } } while (0)
struct XcdBarrier { unsigned* bar; unsigned x; volatile LAS unsigned* st; };
__device__ __forceinline__ XcdBarrier xcd_barrier_post(unsigned* bar, volatile LAS unsigned* st) {
    XcdBarrier b; b.bar = bar; b.x = xb_xcc_id(); b.st = st;
    if (threadIdx.x == 0) (void)xb_add(&bar[XB_XCNT(b.x)], 1u);
    return b;
}
__device__ __forceinline__ void xcd_barrier_complete(unsigned* bar, unsigned x, unsigned& nloc, unsigned& nx) {
    const unsigned G = gridDim.x * gridDim.y * gridDim.z;
    unsigned sum, cnt, mine, sp = 0u;
    for (;;) {
        sum = 0u; cnt = 0u; mine = 0u;
#pragma unroll
        for (unsigned j = 0; j < 16; ++j) { const unsigned c = xb_ld(&bar[XB_XCNT(j)]); sum += c; cnt += (c > 0u) ? 1u : 0u; mine = (j == x) ? c : mine; }
        if (sum == G) break;
        __builtin_amdgcn_s_sleep(1);
        if ((++sp & 255u) == 0u) { if (xb_ld(&bar[XB_TMO])) break; if (sp > XB_SPIN_CAP) { atomicAdd(&bar[XB_TMO], 1u); break; } }
    }
    nloc = mine > 0u ? mine : 1u; nx = cnt > 0u ? cnt : 1u;
}
__device__ __forceinline__ void xcd_barrier(const XcdBarrier& b) {
    asm volatile("s_waitcnt vmcnt(0)" ::: "memory");
    __syncthreads();
    if (threadIdx.x == 0) {
        unsigned* bar = b.bar;
        __builtin_amdgcn_s_waitcnt(0);
        unsigned nloc = b.st[0], nx = b.st[1];
        if (nloc == 0u) { xcd_barrier_complete(bar, b.x, nloc, nx); b.st[0] = nloc; b.st[1] = nx; }
        const unsigned old = xb_add(&bar[XB_XSUB(b.x)], 1u);
        const unsigned gen = old / nloc;
        if (old + 1u == (gen + 1u) * nloc) {
            __builtin_amdgcn_fence(__ATOMIC_RELEASE, "agent");
            asm volatile("s_waitcnt vmcnt(0)" ::: "memory");
            const unsigned og = xb_add(&bar[XB_TOP], 1u);
            const unsigned tg = og / nx;
            if (og + 1u == (tg + 1u) * nx) xb_add(&bar[XB_TOPGEN], 1u);
            else XB_SPIN(xb_ld(&bar[XB_TOPGEN]) == tg, bar);
            __builtin_amdgcn_fence(__ATOMIC_ACQUIRE, "agent");
            xb_add(&bar[XB_XGEN(b.x)], 1u);
            asm volatile("s_waitcnt vmcnt(0)" ::: "memory");
        } else {
            XB_SPIN(xb_ld(&bar[XB_XGEN(b.x)]) == gen, bar);
            __builtin_amdgcn_fence(__ATOMIC_ACQUIRE, "agent");
            asm volatile("s_waitcnt vmcnt(0)" ::: "memory");
        }
    }
    __syncthreads();
}

__device__ __forceinline__ void run_phase(const P& p, int ph, LAS unsigned char* lds) {
    if (ph == 2 * PPL) { if (EN(34)) phase_final(p); return; }
    const int l = ph / PPL, q = ph % PPL;
    unsigned char* ws = p.ws; bf16_t* W = (bf16_t*)(ws + WS_W);
    const int G = gridDim.x, c = bid_();
    pg8::Order S;
    switch (q) {
        case 0: if (EN(0)) { phase_prep(p, l, lds); if (l == 1) phase_norm(p, l, 1); } break;
        case 1: if (EN(1)) { if (l == 0) phase_norm(p, l, 1); } break;
        case 2: if (EN(2)) { pg8::Gemm g{(const bf16_t*)(ws + WS_R2), W + W_A / 2, TOK, 2816, 1024, 1024, 0, 0, 1}; S.init(TOK, 2816, 1, G, c);
            EpiPartA E{(bf16_t*)(ws + WS_R3), (bf16_t*)(ws + WS_R3) + (size_t)TOK * 512, (bf16_t*)(ws + WS_R4), (bf16_t*)(ws + WS_R5), (float*)(ws + WS_GLR)};
            pg8::gemm_phase(lds, g, S, E); } break;
        case 3: if (EN(3)) { pg8::Gemm g{(const bf16_t*)(ws + WS_R5), (const bf16_t*)(ws + WS_EMAT), 1280, 256, 512, 768, (size_t)1280 * 768, (size_t)256 * 512, 32}; S.init(1280, 256, 32, G, c);
            EpiE E{(float*)(ws + WS_E)}; pg8::gemm_phase(lds, g, S, E); } break;
        case 4: if (EN(4)) phase_s5scan(p, l); break;
        case 5: if (EN(5)) { pg8::Gemm g{(const bf16_t*)(ws + WS_R5), (const bf16_t*)(ws + WS_R1), 1280, 512, 768, 768, (size_t)1280 * 768, (size_t)512 * 768, 32}; S.init(1280, 512, 32, G, c);
            EpiY E{(bf16_t*)(ws + WS_E)}; pg8::gemm_phase(lds, g, S, E); } break;
        case 6: if (EN(6)) { pg8::Gemm g{(const bf16_t*)(ws + WS_E), W + W_GLU / 2, TOK, 512, 512, 512, 0, 0, 1}; S.init(TOK, 512, 1, G, c);
            EpiGLU E{(const bf16_t*)(ws + WS_E), (bf16_t*)(ws + WS_R6), p.in[lnd(24)] + (size_t)l * 512}; pg8::gemm_phase(lds, g, S, E); } break;
        case 7: if (EN(7)) phase_glapre(p, l, lds); break;
        case 8: if (EN(8)) phase_gla(p, l, lds); break;
        case 9: if (EN(9)) { pg8::Gemm g{(const bf16_t*)(ws + WS_R2), W + W_B / 2, TOK, 3072, 1024, 1024, 0, 0, 1}; S.init(TOK, 3072, 1, G, c);
            EpiPartB E{(bf16_t*)(ws + WS_R3), (bf16_t*)(ws + WS_R4), (bf16_t*)(ws + WS_R5)}; pg8::gemm_phase(lds, g, S, E); } break;
        case 10: if (EN(10)) phase_glapost(p, l); break;
        case 11: if (EN(11)) { pg8::Gemm g{(const bf16_t*)(ws + WS_R1), W + W_PG / 2, TOK, 1024, 1024, 1024, 0, 0, 1}; S.init(TOK, 1024, 1, G, c);
              EpiProj1 E{(const bf16_t*)(ws + WS_R4), (bf16_t*)(ws + WS_R2)}; pg8::gemm_phase(lds, g, S, E); } break;
        case 12: if (EN(12)) { pg8::Gemm g{(const bf16_t*)(ws + WS_R6), W + W_PS / 2, TOK, 1024, 512, 512, 0, 0, 1}; S.init(TOK, 1024, 1, G, c);
              EpiProj2 E{(const bf16_t*)(ws + WS_R5), (bf16_t*)(ws + WS_R2)}; pg8::gemm_phase(lds, g, S, E); } break;
        case 13: if (EN(13)) { pg8::Gemm g{(const bf16_t*)(ws + WS_R2), W + W_OUT / 2, TOK, 1024, 1024, 1024, 0, 0, 1}; S.init(TOK, 1024, 1, G, c);
            EpiDelta E{(bf16_t*)(ws + WS_R3), (const float*)(ws + WS_MOD) + (size_t)l * 9 * 6144 + 2048}; pg8::gemm_phase(lds, g, S, E); } break;
        case 14: if (EN(14)) phase_norm(p, l, 2); break;
        case 15: if (EN(15)) { pg8::Gemm g{(const bf16_t*)(ws + WS_R2), W + W_1 / 2, TOK, 4096, 1024, 1024, 0, 0, 1}; S.init(TOK, 4096, 1, G, c);
            EpiFF1 E{(bf16_t*)(ws + WS_HID)}; pg8::gemm_phase(lds, g, S, E); } break;
        case 16: if (EN(16)) { pg8::Gemm g{(const bf16_t*)(ws + WS_HID), W + W_2 / 2, TOK, 1024, 4096, 4096, 0, 0, 1}; S.init(TOK, 1024, 1, G, c);
            EpiDelta E{(bf16_t*)(ws + WS_R2), (const float*)(ws + WS_MOD) + (size_t)l * 9 * 6144 + 5120}; pg8::gemm_phase(lds, g, S, E); } break;
        default: break;
    }
}

__global__ void __launch_bounds__(NTHR, 2) fwd_megakernel(P p) {
    extern __shared__ __attribute__((aligned(16))) unsigned char lds_raw[];
    LAS unsigned char* lds = (LAS unsigned char*)lds_raw;
#if MULTI_LAUNCH
    for (int ph = p.ph_lo; ph < p.ph_hi; ++ph) run_phase(p, ph, lds);
#else
    cg::grid_group grid = cg::this_grid();
    if (p.ph_lo < 0) grid.sync();
    volatile LAS unsigned* stw = (volatile LAS unsigned*)(lds + LDS_BYTES - 16);
    if (threadIdx.x < 4) stw[threadIdx.x] = 0u;
    __syncthreads();
    const XcdBarrier bar = xcd_barrier_post((unsigned*)(p.ws + WS_BAR), stw);
    for (int ph = p.ph_lo; ph < p.ph_hi; ++ph) {
        run_phase(p, ph, lds);
#if REP_MASK
        if (ph < 2 * PPL && ((REP_MASK >> (ph % PPL)) & 1)) {
            xcd_barrier(bar);
            if ((ph % PPL) == 12) { run_phase(p, ph - 1, lds); }
            run_phase(p, ph, lds);
        }
#endif
        if (ph + 1 < p.ph_hi && (ph % PPL) != 11 && ph != PPL) xcd_barrier(bar);
    }
#endif
}

extern "C" void kernel_launch(void* const* d_in, const int* in_sizes, int n_in, void* d_out, int out_size, void* d_ws, size_t ws_size, hipStream_t stream) {
    static int grid = 0;
    if (grid == 0) {
        if (n_in != 31 || ws_size < WS_END) { fprintf(stderr, "kernel_launch: unexpected n_in %d or ws_size %zu (< %zu)\n", n_in, ws_size, (size_t)WS_END); grid = -1; return; }
        int dev = 0, cus = 0, per_cu = 0;
        hipGetDevice(&dev);
        hipDeviceGetAttribute(&cus, hipDeviceAttributeMultiprocessorCount, dev);
        if (hipFuncSetAttribute((const void*)fwd_megakernel, hipFuncAttributeMaxDynamicSharedMemorySize, LDS_BYTES) != hipSuccess) { fprintf(stderr, "kernel_launch: hipFuncSetAttribute failed\n"); grid = -1; return; }
        hipOccupancyMaxActiveBlocksPerMultiprocessor(&per_cu, (const void*)fwd_megakernel, NTHR, LDS_BYTES);
        (void)hipGetLastError();
        if (per_cu < 1) fprintf(stderr, "kernel_launch: occupancy query says %d blocks per CU\n", per_cu);
        grid = cus > 0 ? cus : 256;
    }
    if (grid < 0) return;
    P p{};
    for (int i = 0; i < 31; ++i) p.in[i] = (const float*)d_in[i];
    p.out = (float*)d_out; p.ws = (unsigned char*)d_ws;
#if MULTI_LAUNCH
    for (int ph = 0; ph < NPHASE; ++ph) { p.ph_lo = ph; p.ph_hi = ph + 1; hipLaunchKernelGGL(fwd_megakernel, dim3(grid), dim3(NTHR), LDS_BYTES, stream, p); }
#else
    p.ph_lo = 0; p.ph_hi = NPHASE;
    (void)hipMemsetAsync((char*)d_ws + WS_BAR, 0, XCD_BAR_WORDS * sizeof(unsigned), stream);
    void* args[] = {&p};
    hipError_t e = hipLaunchCooperativeKernel((const void*)fwd_megakernel, dim3(grid), dim3(NTHR), args, LDS_BYTES, stream);
    if (e != hipSuccess) fprintf(stderr, "cooperative launch failed: %s (grid %d)\n", hipGetErrorString(e), grid);
#endif
}
```

```cpp
#include <hip/hip_runtime.h>
#include <hip/hip_cooperative_groups.h>
#include <cstdio>
namespace cg = cooperative_groups;

#ifndef MULTI_LAUNCH
#define MULTI_LAUNCH 0
#endif

#ifndef REP_MASK
#define REP_MASK 0
#endif
#ifndef PHASE_SEL
#define PHASE_SEL -1
#endif
#define EN(q) (PHASE_SEL < 0 || PHASE_SEL == (q))
#define LAS __attribute__((address_space(3)))
typedef unsigned short bf16_t;
typedef short bf16x8 __attribute__((ext_vector_type(8)));
typedef float f32x4 __attribute__((ext_vector_type(4)));
typedef unsigned u32x4 __attribute__((ext_vector_type(4)));
typedef unsigned u32x2 __attribute__((ext_vector_type(2)));

constexpr int NTHR = 512;
constexpr int TOK = 40960, TOKP = 8192;
constexpr int LDS_BYTES = 147456;
constexpr int NPHASE = 35;
constexpr int PPL = 17;

constexpr size_t MiB = (size_t)1 << 20;
constexpr size_t WS_MOD = 0;
constexpr size_t WS_GLR = 1 * MiB;
constexpr size_t WS_TOTF = 7 * MiB;
constexpr size_t WS_TOTB = 9 * MiB;
constexpr size_t WS_BAR = 12 * MiB;
constexpr size_t WS_W = 16 * MiB;
constexpr size_t W_A = 0;
constexpr size_t W_B = W_A + (size_t)2816 * 1024 * 2;
constexpr size_t W_PG = W_B + (size_t)3072 * 1024 * 2;
constexpr size_t W_GLU = W_PG + (size_t)1024 * 1024 * 2;
constexpr size_t W_PS = W_GLU + (size_t)512 * 512 * 2;
constexpr size_t W_OUT = W_PS + (size_t)1024 * 512 * 2;
constexpr size_t W_1 = W_OUT + (size_t)1024 * 1024 * 2;
constexpr size_t W_2 = W_1 + (size_t)4096 * 1024 * 2;
constexpr size_t WS_R2 = 50 * MiB;
constexpr size_t WS_R3 = 130 * MiB;
constexpr size_t WS_R4 = 210 * MiB;
constexpr size_t WS_R5 = 290 * MiB;
constexpr size_t WS_E = 350 * MiB;
constexpr size_t WS_R6 = 390 * MiB;
constexpr size_t WS_R1 = 430 * MiB;
constexpr size_t WS_EMAT = 454 * MiB;
constexpr size_t WS_HID = 130 * MiB;
constexpr size_t WS_END = 510 * MiB;

struct P { const float* in[31]; float* out; unsigned char* ws; int ph_lo, ph_hi; };

__device__ __forceinline__ int tid_() { int t = threadIdx.x; asm volatile("" : "+v"(t)); return t; }
__device__ __forceinline__ int bid_() { int b = blockIdx.x; asm volatile("" : "+s"(b)); return b; }
__device__ __forceinline__ int lnd(int k) { asm volatile("" : "+s"(k)); return k; }
__device__ __forceinline__ unsigned pk_bf16(float lo, float hi) { unsigned r; asm("v_cvt_pk_bf16_f32 %0, %1, %2" : "=v"(r) : "v"(lo), "v"(hi)); return r; }
__device__ __forceinline__ float bf2f(bf16_t b) { return __uint_as_float(((unsigned)b) << 16); }
__device__ __forceinline__ float bflo(unsigned w) { return __uint_as_float(w << 16); }
__device__ __forceinline__ float bfhi(unsigned w) { return __uint_as_float(w & 0xffff0000u); }
__device__ __forceinline__ bf16_t f2bf(float f) { return (bf16_t)(pk_bf16(f, 0.f) & 0xffffu); }
__device__ __forceinline__ float sigmoidf_(float x) { return __builtin_amdgcn_rcpf(1.0f + __expf(-x)); }
__device__ __forceinline__ void store4bf(bf16_t* ptr, f32x4 v) { u32x2 w; w.x = pk_bf16(v[0], v[1]); w.y = pk_bf16(v[2], v[3]); *(u32x2*)ptr = w; }
__device__ __forceinline__ f32x4 load4bf(const bf16_t* ptr) { u32x2 w = *(const u32x2*)ptr; return (f32x4){bflo(w.x), bfhi(w.x), bflo(w.y), bfhi(w.y)}; }
__device__ __forceinline__ int mod_index(int tok) { return tok < TOKP ? 0 : (tok >> 12) - 1; }
__device__ __forceinline__ float wave_sum(float v) {
#pragma unroll
    for (int o = 32; o >= 1; o >>= 1) v += __shfl_xor(v, o);
    return v;
}

namespace pg8 {
constexpr int BM = 256, BK = 64, HALF = 128, HTB = HALF * BK * 2, STAGE_BYTES = 8 * HTB, NXCD = 8, WGM = 8;
__device__ __forceinline__ int lds_byte(int r, int c) { const int st = (r >> 4) * 2 + (c >> 5), rr = r & 15, cc = c & 31, ob = rr * 64 + cc * 2; return st * 1024 + (ob ^ (((ob >> 9) & 1) << 5)); }
__device__ __forceinline__ void stage_rc(int b, int& R, int& C) { const int st = b / 1024, sb = b % 1024, swz = sb ^ (((sb >> 9) & 1) << 5); R = (st >> 1) * 16 + swz / 64; C = (st & 1) * 32 + (swz % 64) / 2; }

struct Unit { int pm, pn, z, hf; };
struct Gemm { const bf16_t* A; const bf16_t* Bt; int M, N, K, lda; size_t sA, sB; int nz; };
struct Order {
    int nM, nN, nwg, G, c, nz, nfull, rem2;
    __device__ __forceinline__ void init(int M, int N, int nz_, int G_, int c_) { nM = M / BM; nN = N / BM; nwg = nM * nN; G = G_; c = c_; nz = nz_;
        nfull = nwg; rem2 = 0;
        if (nz == 1) { const int full = (nwg / G) * G, rem = nwg - full; if (rem > 0 && 2 * rem <= G) { nfull = full; rem2 = 2 * rem; } } }
    __device__ __forceinline__ void map(int wgid, Unit& u) const {
        { const int q = nwg / NXCD, r = nwg % NXCD, xcd = wgid % NXCD, off = wgid / NXCD; wgid = (xcd < r ? xcd * (q + 1) : r * (q + 1) + (xcd - r) * q) + off; }
        const int nig = WGM * nN, gid = wgid / nig, fm = gid * WGM, gsz = (nM - fm) < WGM ? (nM - fm) : WGM;
        u.pm = fm + ((wgid % nig) % gsz); u.pn = (wgid % nig) / gsz; u.z = 0; }
    __device__ __forceinline__ bool next(int i, Unit& u) const {
        const long L = (long)i * G + c;
        if (nz == 1) {
            if (L < nfull) { map((int)L, u); u.hf = 0; return true; }
            const int t = (int)(L - nfull); if (t >= rem2) return false;
            map(nfull + (t >> 1), u); u.hf = 1 + (t & 1); return true;
        }
        if (L >= (long)nwg * nz) return false;
        const int z = (int)(L / nwg), r = (int)(L % nwg); u.z = z; u.pm = r % nM; u.pn = r / nM; u.hf = 0;
        return true;
    }
};

template <class Epi>
__device__ __forceinline__ void gemm_phase(LAS unsigned char* lds, const Gemm g, const Order& S, const Epi& E) {
    const int tid = tid_(), wid = __builtin_amdgcn_readfirstlane(tid >> 6), lane = tid & 63, wr = wid >> 2, wc = wid & 3, fr = lane & 15, fq = lane >> 4;
    const int K = g.K, nt = K / BK;
    unsigned voffA[2], voffB[2];
#pragma unroll
    for (int i = 0; i < 2; ++i) { int R, C; stage_rc(tid * 16 + i * 8192, R, C); voffA[i] = (unsigned)(R * g.lda + C) * 2u; voffB[i] = (unsigned)(R * K + C) * 2u; }
    const size_t kstep = (size_t)(BK * 2);
    const size_t hstepA = (size_t)HALF * g.lda * 2, hstepB = (size_t)HALF * K * 2;
    const unsigned ldsw = (unsigned)wid * 1024u;
    const int aoff = lds_byte(wr * 64 + fr, fq * 8), boff = lds_byte(wc * 32 + fr, fq * 8);
#define PG8_SA(b, h) (((b) * 2 + (h)) * HTB)
#define PG8_SB(b, h) ((4 + (b) * 2 + (h)) * HTB)
#define PG8_STAGE(bufoff, gbase, voff) do { _Pragma("unroll") for (int _i = 0; _i < 2; ++_i) \
        __builtin_amdgcn_global_load_lds((const unsigned*)((const char*)(gbase) + (voff)[_i]), (LAS unsigned*)(lds + (bufoff) + ldsw + _i * 8192), 16, 0, 0); } while (0)
#define PG8_LDA(dst, b, h) do { _Pragma("unroll") for (int m = 0; m < 4; ++m) _Pragma("unroll") for (int k = 0; k < 2; ++k) dst[m][k] = *(const LAS bf16x8*)(lds + PG8_SA(b, h) + aoff + m * 2048 + k * 1024); } while (0)
#define PG8_LDB(dst, b, h) do { _Pragma("unroll") for (int n = 0; n < 2; ++n) _Pragma("unroll") for (int k = 0; k < 2; ++k) dst[n][k] = *(const LAS bf16x8*)(lds + PG8_SB(b, h) + boff + n * 2048 + k * 1024); } while (0)
#define PG8_MMA(ai, bj, At, Bt) do { __builtin_amdgcn_s_setprio(1); _Pragma("unroll") for (int m = 0; m < 4; ++m) _Pragma("unroll") for (int n = 0; n < 2; ++n) _Pragma("unroll") for (int k = 0; k < 2; ++k) \
        acc[ai][bj][m][n] = __builtin_amdgcn_mfma_f32_16x16x32_bf16(Bt[n][k], At[m][k], acc[ai][bj][m][n], 0, 0, 0); __builtin_amdgcn_s_setprio(0); } while (0)
#define PG8_WAIT_V(n) asm volatile("s_waitcnt vmcnt(" #n ")" ::: "memory")
#define PG8_WAIT_L(n) asm volatile("s_waitcnt lgkmcnt(" #n ")" ::: "memory")
#define PG8_BAR __builtin_amdgcn_s_barrier()
#define PG8_SCHED __builtin_amdgcn_sched_barrier(0)
    Unit cur, nxt; int ui = 0;
    if (!S.next(0, cur)) return;
    f32x4 acc[2][2][4][2];
#pragma unroll
    for (int a = 0; a < 2; ++a)
#pragma unroll
        for (int b = 0; b < 2; ++b)
#pragma unroll
            for (int m = 0; m < 4; ++m)
#pragma unroll
                for (int n = 0; n < 2; ++n) acc[a][b][m][n] = (f32x4){0.f, 0.f, 0.f, 0.f};
    bf16x8 At[4][2], B0[2][2], B1[2][2];
    const char* cA = (const char*)g.A + ((size_t)cur.z * g.sA + (size_t)(cur.pm * BM + (cur.hf == 2 ? HALF : 0)) * g.lda) * 2;
    const char* cB = (const char*)g.Bt + ((size_t)cur.z * g.sB + (size_t)cur.pn * BM * K) * 2;
    PG8_STAGE(PG8_SB(0, 0), cB, voffB); PG8_STAGE(PG8_SB(0, 1), cB + hstepB, voffB); PG8_STAGE(PG8_SA(0, 0), cA, voffA); PG8_STAGE(PG8_SA(0, 1), cA + hstepA, voffA);
    if (wr == 1) PG8_BAR;
    PG8_WAIT_V(2); PG8_BAR;
    PG8_STAGE(PG8_SB(1, 0), cB + kstep, voffB); PG8_STAGE(PG8_SA(1, 0), cA + kstep, voffA); PG8_STAGE(PG8_SB(1, 1), cB + hstepB + kstep, voffB);
    PG8_WAIT_V(6); PG8_BAR;
    for (;;) {
        const bool has_next = S.next(ui + 1, nxt);
        const char* nA = has_next ? (const char*)g.A + ((size_t)nxt.z * g.sA + (size_t)(nxt.pm * BM + (nxt.hf == 2 ? HALF : 0)) * g.lda) * 2 : cA;
        const bool fullu = (cur.hf == 0);
        const char* nB = has_next ? (const char*)g.Bt + ((size_t)nxt.z * g.sB + (size_t)nxt.pn * BM * K) * 2 : cB;
        for (int t = 0; t < nt; t += 2) {
            const bool last = (t == nt - 2);
            const char* a1 = cA + (size_t)(t + 1) * kstep;
            const char* a2 = last ? nA : cA + (size_t)(t + 2) * kstep; const char* b2 = last ? nB : cB + (size_t)(t + 2) * kstep;
            const char* a3 = a2 + kstep; const char* b3 = b2 + kstep;
            PG8_LDB(B0, 0, 0); PG8_LDB(B1, 0, 1); PG8_SCHED; PG8_LDA(At, 0, 0); PG8_STAGE(PG8_SA(1, 1), a1 + hstepA, voffA);
            PG8_WAIT_V(8); PG8_WAIT_L(0); PG8_BAR; PG8_MMA(0, 0, At, B0); PG8_MMA(0, 1, At, B1); PG8_BAR; PG8_SCHED;
            if (fullu) PG8_LDA(At, 0, 1); PG8_STAGE(PG8_SB(0, 0), b2, voffB); PG8_STAGE(PG8_SB(0, 1), b2 + hstepB, voffB); PG8_STAGE(PG8_SA(0, 0), a2, voffA);
            PG8_WAIT_V(8); PG8_WAIT_L(0); PG8_BAR; if (fullu) { PG8_MMA(1, 0, At, B0); PG8_MMA(1, 1, At, B1); } PG8_BAR; PG8_SCHED;
            PG8_LDB(B0, 1, 0); PG8_LDB(B1, 1, 1); PG8_SCHED; PG8_LDA(At, 1, 0); PG8_STAGE(PG8_SA(0, 1), a2 + hstepA, voffA);
            PG8_WAIT_V(8); PG8_WAIT_L(0); PG8_BAR; PG8_MMA(0, 0, At, B0); PG8_MMA(0, 1, At, B1); PG8_BAR; PG8_SCHED;
            if (fullu) PG8_LDA(At, 1, 1); PG8_STAGE(PG8_SB(1, 0), b3, voffB); PG8_STAGE(PG8_SB(1, 1), b3 + hstepB, voffB); PG8_STAGE(PG8_SA(1, 0), a3, voffA);
            PG8_WAIT_V(8); PG8_WAIT_L(0); PG8_BAR; if (fullu) { PG8_MMA(1, 0, At, B0); PG8_MMA(1, 1, At, B1); } PG8_BAR; PG8_SCHED;
        }
        if (wr == 0) PG8_BAR;
        if (fullu) E.template tile<2>(acc, cur.z, cur.pm * BM + wr * 64 + fr, cur.pn * BM + wc * 32 + (Epi::PERM ? 8 : 4) * fq);
        else E.template tile<1>(acc, cur.z, cur.pm * BM + (cur.hf == 2 ? HALF : 0) + wr * 64 + fr, cur.pn * BM + wc * 32 + (Epi::PERM ? 8 : 4) * fq);
        if (!has_next) break;
#pragma unroll
        for (int a = 0; a < 2; ++a)
#pragma unroll
            for (int b = 0; b < 2; ++b)
#pragma unroll
                for (int m = 0; m < 4; ++m)
#pragma unroll
                    for (int n = 0; n < 2; ++n) acc[a][b][m][n] = (f32x4){0.f, 0.f, 0.f, 0.f};
        cur = nxt; cA = nA; cB = nB; ++ui;
        if (wr == 1) PG8_BAR;
    }
    PG8_WAIT_V(0);
    PG8_BAR;
#undef PG8_SA
#undef PG8_SB
#undef PG8_STAGE
#undef PG8_LDA
#undef PG8_LDB
#undef PG8_MMA
#undef PG8_WAIT_V
#undef PG8_WAIT_L
#undef PG8_BAR
#undef PG8_SCHED
}
}

#define EPI_SIMPLE_TILE() \
    static constexpr bool PERM = false; \
    template <int NAI> __device__ __forceinline__ void tile(const f32x4 (&acc)[2][2][4][2], int z, int row0, int col0) const { \
        _Pragma("unroll") for (int ai = 0; ai < NAI; ++ai) _Pragma("unroll") for (int m = 0; m < 4; ++m) _Pragma("unroll") for (int bj = 0; bj < 2; ++bj) _Pragma("unroll") for (int n = 0; n < 2; ++n) \
            (*this)(z, row0 + ai * 128 + m * 16, col0 + bj * 128 + n * 16, acc[ai][bj][m][n]); }
#define EPI_PAIR_TILE() \
    static constexpr bool PERM = true; \
    template <int NAI> __device__ __forceinline__ void tile(const f32x4 (&acc)[2][2][4][2], int z, int row0, int col0) const { \
        _Pragma("unroll") for (int ai = 0; ai < NAI; ++ai) _Pragma("unroll") for (int m = 0; m < 4; ++m) _Pragma("unroll") for (int bj = 0; bj < 2; ++bj) \
            pair(row0 + ai * 128 + m * 16, col0 + bj * 128, acc[ai][bj][m][0], acc[ai][bj][m][1]); }
#define EPI_PIPE_TILE() \
    static constexpr bool PERM = true; \
    template <int NAI> __device__ __forceinline__ void tile(const f32x4 (&acc)[2][2][4][2], int z, int row0, int col0) const { \
        Pre pre; begin(row0, col0, pre); L buf[2][8]; \
        _Pragma("unroll") for (int mm = 0; mm < 2; ++mm) _Pragma("unroll") for (int bj = 0; bj < 2; ++bj) _Pragma("unroll") for (int n = 0; n < 2; ++n) load(row0 + mm * 16, col0 + bj * 128 + n * 4, buf[0][mm * 4 + bj * 2 + n]); \
        _Pragma("unroll") for (int b = 0; b < 2 * NAI; ++b) { \
            if (b < 2 * NAI - 1) { _Pragma("unroll") for (int mm = 0; mm < 2; ++mm) _Pragma("unroll") for (int bj = 0; bj < 2; ++bj) _Pragma("unroll") for (int n = 0; n < 2; ++n) \
                load(row0 + ((b + 1) >> 1) * 128 + (((b + 1) & 1) * 2 + mm) * 16, col0 + bj * 128 + n * 4, buf[(b + 1) & 1][mm * 4 + bj * 2 + n]); } \
            _Pragma("unroll") for (int mm = 0; mm < 2; ++mm) _Pragma("unroll") for (int bj = 0; bj < 2; ++bj) _Pragma("unroll") for (int n = 0; n < 2; ++n) \
                apply(row0 + (b >> 1) * 128 + ((b & 1) * 2 + mm) * 16, col0 + bj * 128 + n * 4, acc[b >> 1][bj][(b & 1) * 2 + mm][n], buf[b & 1][mm * 4 + bj * 2 + n], pre, bj * 2 + n); } }
__device__ __forceinline__ void store8bf(bf16_t* ptr, f32x4 a, f32x4 b) { u32x4 w; w.x = pk_bf16(a[0], a[1]); w.y = pk_bf16(a[2], a[3]); w.z = pk_bf16(b[0], b[1]); w.w = pk_bf16(b[2], b[3]); *(u32x4*)ptr = w; }

struct EpiPartA {
    bf16_t* Q; bf16_t* Kk; bf16_t* V; bf16_t* UG; float* GLR;
    __device__ __forceinline__ void pair(int row, int col, f32x4 a, f32x4 b) const {
        if (col < 512) store8bf(Q + (size_t)row * 512 + col, a, b);
        else if (col < 1024) store8bf(Kk + (size_t)row * 512 + (col - 512), a, b);
        else if (col < 2048) store8bf(V + (size_t)row * 1024 + (col - 1024), a, b);
        else if (col < 2304) { const int c = col - 2048; if (c < 32) { *(f32x4*)(GLR + (size_t)row * 32 + c) = a; *(f32x4*)(GLR + (size_t)row * 32 + c + 4) = b; } }
        else { const int c = col - 2304, g = c >> 4, n = c & 15, chunk = row >> 5, j = row & 31; store8bf(UG + ((size_t)(g * 1280 + chunk) * 768 + j * 16 + n), a, b); }
    }
    EPI_PAIR_TILE()
};
struct EpiE { float* E; __device__ __forceinline__ void operator()(int z, int row, int col, f32x4 v) const { *(f32x4*)(E + ((size_t)(z * 1280 + row) * 256 + col)) = v; } EPI_SIMPLE_TILE() };
struct EpiY {
    bf16_t* YB;
    __device__ __forceinline__ void operator()(int z, int row, int col, f32x4 v) const {
        const int tok = row * 32 + (col >> 4), ch = z * 16 + (col & 15);
        f32x4 o;
#pragma unroll
        for (int e = 0; e < 4; ++e) { const float x = v[e]; o[e] = x * sigmoidf_(1.5957691216f * (x + 0.044715f * x * x * x)); }
        store4bf(YB + (size_t)tok * 512 + ch, o);
    }
    EPI_SIMPLE_TILE()
};
struct EpiGLU {
    const bf16_t* YB; bf16_t* OS5; const float* bglu;
    typedef u32x2 L; struct Pre { f32x4 b[4]; };
    __device__ __forceinline__ void begin(int, int col0, Pre& pr) const {
#pragma unroll
        for (int k = 0; k < 4; ++k) pr.b[k] = *(const f32x4*)(bglu + col0 + (k >> 1) * 128 + (k & 1) * 4); }
    __device__ __forceinline__ void load(int row, int col, L& l) const { l = *(const u32x2*)(YB + (size_t)row * 512 + col); }
    __device__ __forceinline__ void apply(int row, int col, f32x4 v, const L& l, const Pre& pr, int k) const {
        const f32x4 y = (f32x4){bflo(l.x), bfhi(l.x), bflo(l.y), bfhi(l.y)}; f32x4 o;
#pragma unroll
        for (int e = 0; e < 4; ++e) o[e] = y[e] * sigmoidf_(v[e] + pr.b[k][e]);
        store4bf(OS5 + (size_t)row * 512 + col, o); }
    EPI_PIPE_TILE()
};
struct EpiPartB {
    bf16_t* R; bf16_t* GA; bf16_t* GB;
    __device__ __forceinline__ void pair(int row, int col, f32x4 a, f32x4 b) const {
        f32x4 sa, sb;
#pragma unroll
        for (int e = 0; e < 4; ++e) { sa[e] = sigmoidf_(a[e]); sb[e] = sigmoidf_(b[e]); }
        if (col < 1024) store8bf(R + (size_t)row * 1024 + col, a * sa, b * sb);
        else if (col < 2048) store8bf(GA + (size_t)row * 1024 + (col - 1024), sa, sb);
        else store8bf(GB + (size_t)row * 1024 + (col - 2048), sa, sb);
    }
    EPI_PAIR_TILE()
};
struct EpiProj1 { const bf16_t* GA; bf16_t* T1;
    typedef u32x2 L; struct Pre { int dummy; };
    __device__ __forceinline__ void begin(int, int, Pre&) const {}
    __device__ __forceinline__ void load(int row, int col, L& l) const { l = *(const u32x2*)(GA + (size_t)row * 1024 + col); }
    __device__ __forceinline__ void apply(int row, int col, f32x4 v, const L& l, const Pre&, int) const {
        const f32x4 g = (f32x4){bflo(l.x), bfhi(l.x), bflo(l.y), bfhi(l.y)}; store4bf(T1 + (size_t)row * 1024 + col, g * v); }
    EPI_PIPE_TILE()
};
struct EpiProj2 { const bf16_t* GB; bf16_t* T1;
    struct L { u32x2 t, g; }; struct Pre { int dummy; };
    __device__ __forceinline__ void begin(int, int, Pre&) const {}
    __device__ __forceinline__ void load(int row, int col, L& l) const { const size_t o = (size_t)row * 1024 + col; l.t = *(const u32x2*)(T1 + o); l.g = *(const u32x2*)(GB + o); }
    __device__ __forceinline__ void apply(int row, int col, f32x4 v, const L& l, const Pre&, int) const {
        const f32x4 g = (f32x4){bflo(l.g.x), bfhi(l.g.x), bflo(l.g.y), bfhi(l.g.y)}, t = (f32x4){bflo(l.t.x), bfhi(l.t.x), bflo(l.t.y), bfhi(l.t.y)};
        store4bf(T1 + (size_t)row * 1024 + col, t + g * v); }
    EPI_PIPE_TILE()
};
struct EpiDelta { bf16_t* Dl; const float* gate;
    static constexpr bool PERM = true;
    template <int NAI> __device__ __forceinline__ void tile(const f32x4 (&acc)[2][2][4][2], int, int row0, int col0) const {
        const float* gp = gate + (size_t)mod_index(row0) * 6144 + col0; f32x4 g[2][2];
#pragma unroll
        for (int bj = 0; bj < 2; ++bj)
#pragma unroll
            for (int n = 0; n < 2; ++n) g[bj][n] = *(const f32x4*)(gp + bj * 128 + n * 4);
#pragma unroll
        for (int ai = 0; ai < NAI; ++ai)
#pragma unroll
            for (int m = 0; m < 4; ++m)
#pragma unroll
                for (int bj = 0; bj < 2; ++bj) store8bf(Dl + (size_t)(row0 + ai * 128 + m * 16) * 1024 + col0 + bj * 128, g[bj][0] * acc[ai][bj][m][0], g[bj][1] * acc[ai][bj][m][1]);
    } };
struct EpiFF1 { bf16_t* H;
    __device__ __forceinline__ void pair(int row, int col, f32x4 a, f32x4 b) const {
        f32x4 oa, ob;
#pragma unroll
        for (int e = 0; e < 4; ++e) { const float ra = fmaxf(a[e], 0.f), rb = fmaxf(b[e], 0.f); oa[e] = ra * ra; ob[e] = rb * rb; }
        store8bf(H + (size_t)row * 4096 + col, oa, ob); }
    EPI_PAIR_TILE()
};

struct ConvJob { const float* src; int ld, K, c0, nvalid, ndst; bf16_t* dst; float scale; };
__device__ __forceinline__ bool conv_job(const P& p, int l, int j, ConvJob& J) {
    bf16_t* W = (bf16_t*)(p.ws + WS_W);
    const float* win = p.in[lnd(10)] + (size_t)l * 1024 * 5664;
    J.scale = 1.0f;
    switch (j) {
        case 0: J = {win, 5664, 1024, 0, 512, 512, W + W_A / 2, 0.08838834764831845f}; break;
        case 1: J = {win, 5664, 1024, 512, 512, 512, W + W_A / 2 + (size_t)512 * 1024, 1.f}; break;
        case 2: J = {win, 5664, 1024, 1024, 1024, 1024, W + W_A / 2 + (size_t)1024 * 1024, 1.f}; break;
        case 3: J = {win, 5664, 1024, 3072, 32, 256, W + W_A / 2 + (size_t)2048 * 1024, 1.f}; break;
        case 4: J = {win, 5664, 1024, 3104, 512, 512, W + W_A / 2 + (size_t)2304 * 1024, 1.f}; break;
        case 5: J = {win, 5664, 1024, 2048, 1024, 1024, W + W_B / 2, 1.f}; break;
        case 6: J = {win, 5664, 1024, 3616, 1024, 1024, W + W_B / 2 + (size_t)1024 * 1024, 1.f}; break;
        case 7: J = {win, 5664, 1024, 4640, 1024, 1024, W + W_B / 2 + (size_t)2048 * 1024, 1.f}; break;
        case 8: J = {p.in[lnd(14)] + (size_t)l * 1024 * 1024, 1024, 1024, 0, 1024, 1024, W + W_PG / 2, 1.f}; break;
        case 9: J = {p.in[lnd(23)] + (size_t)l * 512 * 512, 512, 512, 0, 512, 512, W + W_GLU / 2, 1.f}; break;
        case 10: J = {p.in[lnd(25)] + (size_t)l * 512 * 1024, 1024, 512, 0, 1024, 1024, W + W_PS / 2, 1.f}; break;
        case 11: J = {p.in[lnd(26)] + (size_t)l * 1024 * 1024, 1024, 1024, 0, 1024, 1024, W + W_OUT / 2, 1.f}; break;
        case 12: J = {p.in[lnd(28)] + (size_t)l * 1024 * 4096, 4096, 1024, 0, 4096, 4096, W + W_1 / 2, 1.f}; break;
        case 13: J = {p.in[lnd(29)] + (size_t)l * 4096 * 1024, 1024, 4096, 0, 1024, 1024, W + W_2 / 2, 1.f}; break;
        default: return false;
    }
    return true;
}
constexpr int CONV_TILES = 2112;
__device__ __forceinline__ void conv_tile(const P& p, int l, int tile, LAS float* sT) {
    const int tid = tid_();
    ConvJob J; int j = 0, rem = tile;
    for (; j < 14; ++j) { conv_job(p, l, j, J); const int nt = (J.ndst / 64) * (J.K / 128); if (rem < nt) break; rem -= nt; }
    const int kts = J.K / 128, ntile = rem / kts, ktile = rem % kts, n0 = ntile * 64, k0 = ktile * 128;
    {
        const int kk = tid >> 4, c4 = (tid & 15) * 4; f32x4 v[4];
#pragma unroll
        for (int i = 0; i < 4; ++i) { v[i] = (f32x4){0.f, 0.f, 0.f, 0.f};
            if (n0 + c4 < J.nvalid) v[i] = *(const f32x4*)(J.src + (size_t)(k0 + kk + 32 * i) * J.ld + J.c0 + n0 + c4); }
#pragma unroll
        for (int i = 0; i < 4; ++i)
#pragma unroll
            for (int e = 0; e < 4; ++e) sT[(c4 + e) * 129 + kk + 32 * i] = v[i][e] * J.scale;
    }
    __syncthreads();
    {
        const int n = tid >> 3, ks = (tid & 7) * 16;
        const int rho = n & 31, nsrc = (n & ~31) + 8 * ((rho & 15) >> 2) + 4 * (rho >> 4) + (rho & 3);
        const LAS float* sp = sT + nsrc * 129 + ks;
#pragma unroll
        for (int hh = 0; hh < 2; ++hh) { u32x4 w; const LAS float* q = sp + 8 * hh;
            w.x = pk_bf16(q[0], q[1]); w.y = pk_bf16(q[2], q[3]); w.z = pk_bf16(q[4], q[5]); w.w = pk_bf16(q[6], q[7]);
            *(u32x4*)(J.dst + (size_t)(n0 + n) * J.K + k0 + ks + 8 * hh) = w; }
    }
}

__device__ __forceinline__ void mod_task(const P& p, int m, LAS float* sm) {
    const int tid = tid_(), l = m / 192, colbase = (m % 192) * 32, cl = tid & 31, ks = tid >> 5;
    LAS float* SC = sm; LAS float* RED = sm + 9216;
    for (int i = tid; i < 9216; i += NTHR) { const int j = i >> 10, k = i & 1023; const float c = (j == 0) ? p.in[lnd(6)][k] : p.in[lnd(2)][(j - 1) * 1024 + k]; SC[i] = c * sigmoidf_(c); }
    __syncthreads();
    float acc[9];
#pragma unroll
    for (int j = 0; j < 9; ++j) acc[j] = 0.f;
    const float* w = p.in[lnd(7)] + (size_t)l * 1024 * 6144 + colbase + cl;
    for (int k8 = 0; k8 < 64; k8 += 16) { float wv[16];
#pragma unroll
        for (int u = 0; u < 16; ++u) wv[u] = w[(size_t)(ks * 64 + k8 + u) * 6144];
#pragma unroll
        for (int u = 0; u < 16; ++u)
#pragma unroll
            for (int j = 0; j < 9; ++j) acc[j] += SC[j * 1024 + ks * 64 + k8 + u] * wv[u]; }
#pragma unroll
    for (int j = 0; j < 9; ++j) RED[(ks * 9 + j) * 32 + cl] = acc[j];
    __syncthreads();
    if (tid < 288) { const int j = tid >> 5, c = tid & 31; float s = 0.f;
#pragma unroll
        for (int q = 0; q < 16; ++q) s += RED[(q * 9 + j) * 32 + c];
        float* mod = (float*)(p.ws + WS_MOD);
        mod[((size_t)l * 9 + j) * 6144 + colbase + c] = s + p.in[lnd(8)][(size_t)l * 6144 + colbase + c]; }
}

__device__ __forceinline__ void s5_mats(const P& p, int l, int gq, LAS float* sm) {
    const int tid = tid_(), g = gq >> 2, part = gq & 3;
    LAS float* KF = sm; LAS float* KB = sm + 8192; LAS float* LT = sm + 16384; LAS float* CC = sm + 20608; LAS float* BB = sm + 22656;
    bf16_t* MC = (bf16_t*)(p.ws + WS_R1) + (size_t)g * 512 * 768;
    bf16_t* EM = (bf16_t*)(p.ws + WS_EMAT) + (size_t)g * 256 * 512;
    for (int d = 0; d < 2; ++d) {
        const int pg = (l * 2 + d) * 32 + g;
        const float* lamr = p.in[lnd(15)] + (size_t)pg * 64; const float* lami = p.in[lnd(16)] + (size_t)pg * 64;
        const float dt = expf(p.in[lnd(17)][pg]);
        const float* bre = p.in[lnd(18)] + (size_t)pg * 1024; const float* bim = p.in[lnd(19)] + (size_t)pg * 1024;
        const float* cre = p.in[lnd(20)] + (size_t)pg * 1024; const float* cim = p.in[lnd(21)] + (size_t)pg * 1024;
        for (int i = tid; i < 33 * 64; i += NTHR) { const int tau = i >> 6, pp = i & 63; const float a = expf(lamr[pp] * dt * (float)tau); float s, c; sincosf(lami[pp] * dt * (float)tau, &s, &c); LT[2 * i] = a * c; LT[2 * i + 1] = a * s; }
        for (int i = tid; i < 1024; i += NTHR) { CC[2 * i] = cre[i]; CC[2 * i + 1] = cim[i]; }
        for (int i = tid; i < 1024; i += NTHR) {
            const int pp = i >> 4; const float lr = lamr[pp], li = lami[pp]; float s, c; sincosf(li * dt, &s, &c);
            const float em1 = expm1f(lr * dt); float sh, ch; sincosf(0.5f * li * dt, &sh, &ch);
            const float nr = em1 * c - 2.f * sh * sh, ni = (em1 + 1.f) * s;
            const float inv = 1.f / (lr * lr + li * li);
            const float qr = (nr * lr + ni * li) * inv, qi = (ni * lr - nr * li) * inv;
            const float br = bre[i], bi = bim[i];
            BB[2 * i] = qr * br - qi * bi; BB[2 * i + 1] = qr * bi + qi * br;
        }
        __syncthreads();
        {
            const int tau = tid >> 4, n = tid & 15; float acc[16];
#pragma unroll
            for (int m = 0; m < 16; ++m) acc[m] = 0.f;
            for (int pp = 0; pp < 64; ++pp) {
                const float cr = CC[2 * (n * 64 + pp)], ci = CC[2 * (n * 64 + pp) + 1], lr = LT[2 * (tau * 64 + pp)], li = LT[2 * (tau * 64 + pp) + 1];
                const float xr = cr * lr - ci * li, xi = cr * li + ci * lr;
#pragma unroll
                for (int m = 0; m < 16; ++m) acc[m] += xr * BB[2 * (pp * 16 + m)] - xi * BB[2 * (pp * 16 + m) + 1];
            }
            LAS float* Kd = d ? KB : KF;
#pragma unroll
            for (int m = 0; m < 16; ++m) Kd[(tau * 16 + n) * 16 + m] = acc[m];
        }
        {
            const int pp = tid >> 3, cseg = tid & 7;
            { const int jj = part;
                const int j = cseg * 4 + jj, e = d == 0 ? 31 - j : j; const float lr = LT[2 * (e * 64 + pp)], li = LT[2 * (e * 64 + pp) + 1];
                float re[16], im[16];
#pragma unroll
                for (int m = 0; m < 16; ++m) { const float br = BB[2 * (pp * 16 + m)], bi = BB[2 * (pp * 16 + m) + 1]; re[m] = lr * br - li * bi; im[m] = lr * bi + li * br; }
                bf16_t* er = EM + (size_t)(d * 128 + pp) * 512 + j * 16; bf16_t* ei = EM + (size_t)(d * 128 + 64 + pp) * 512 + j * 16;
#pragma unroll
                for (int h = 0; h < 2; ++h) {
                    u32x4 w; w.x = pk_bf16(re[8 * h], re[8 * h + 1]); w.y = pk_bf16(re[8 * h + 2], re[8 * h + 3]); w.z = pk_bf16(re[8 * h + 4], re[8 * h + 5]); w.w = pk_bf16(re[8 * h + 6], re[8 * h + 7]); *(u32x4*)(er + 8 * h) = w;
                    u32x4 x; x.x = pk_bf16(im[8 * h], im[8 * h + 1]); x.y = pk_bf16(im[8 * h + 2], im[8 * h + 3]); x.z = pk_bf16(im[8 * h + 4], im[8 * h + 5]); x.w = pk_bf16(im[8 * h + 6], im[8 * h + 7]); *(u32x4*)(ei + 8 * h) = x;
                }
            }
        }
        {
            const int t = tid >> 4, n = tid & 15, f = d == 0 ? t + 1 : 32 - t;
            bf16_t* mr = MC + (size_t)tid * 768 + 512 + d * 128;
#pragma unroll 1
            for (int p8 = 2 * part; p8 < 2 * part + 2; ++p8) {
                float re[8], im[8];
#pragma unroll
                for (int q = 0; q < 8; ++q) { const int pp = p8 * 8 + q; const float cr = CC[2 * (n * 64 + pp)], ci = CC[2 * (n * 64 + pp) + 1], lr = LT[2 * (f * 64 + pp)], li = LT[2 * (f * 64 + pp) + 1];
                    re[q] = cr * lr - ci * li; im[q] = -(cr * li + ci * lr); }
                u32x4 w; w.x = pk_bf16(re[0], re[1]); w.y = pk_bf16(re[2], re[3]); w.z = pk_bf16(re[4], re[5]); w.w = pk_bf16(re[6], re[7]); *(u32x4*)(mr + p8 * 8) = w;
                u32x4 x; x.x = pk_bf16(im[0], im[1]); x.y = pk_bf16(im[2], im[3]); x.z = pk_bf16(im[4], im[5]); x.w = pk_bf16(im[6], im[7]); *(u32x4*)(mr + 64 + p8 * 8) = x;
            }
        }
        __syncthreads();
    }
    {
        const int t = tid >> 4, n = tid & 15; const float dsk = p.in[lnd(22)][(size_t)l * 512 + g * 16 + n];
        bf16_t* mr = MC + (size_t)tid * 768;
#pragma unroll 1
        for (int j = 8 * part; j < 8 * part + 8; ++j) {
            float v[16];
#pragma unroll
            for (int m = 0; m < 16; ++m) v[m] = 0.f;
            if (j <= t) { const LAS float* k = KF + ((t - j) * 16 + n) * 16;
#pragma unroll
                for (int m = 0; m < 16; ++m) v[m] += k[m]; }
            if (j >= t) { const LAS float* k = KB + ((j - t) * 16 + n) * 16;
#pragma unroll
                for (int m = 0; m < 16; ++m) v[m] += k[m]; }
            if (j == t) {
#pragma unroll
                for (int m = 0; m < 16; ++m) v[m] += (m == n) ? dsk : 0.f; }
            u32x4 w; w.x = pk_bf16(v[0], v[1]); w.y = pk_bf16(v[2], v[3]); w.z = pk_bf16(v[4], v[5]); w.w = pk_bf16(v[6], v[7]); *(u32x4*)(mr + j * 16) = w;
            u32x4 x; x.x = pk_bf16(v[8], v[9]); x.y = pk_bf16(v[10], v[11]); x.z = pk_bf16(v[12], v[13]); x.w = pk_bf16(v[14], v[15]); *(u32x4*)(mr + j * 16 + 8) = x;
        }
    }
}

__device__ __forceinline__ void phase_prep(const P& p, int l, LAS unsigned char* lds) {
    LAS float* sm = (LAS float*)lds;
    const int b = bid_(), G = gridDim.x, ha = G >> 1;
    if (b < ha) { for (int t = b; t < 128; t += ha) { s5_mats(p, l, t, sm); __syncthreads(); } }
    else { for (int t = b - ha; t < CONV_TILES; t += G - ha) { conv_tile(p, l, t, sm); __syncthreads(); } }
    if (l == 0) for (int t = b; t < 384; t += G) { mod_task(p, t, sm); __syncthreads(); }
}

__device__ __forceinline__ void norm_row_write(const f32x4 (&x)[4], const float* g, const float* mod, int shoff, int scoff, bf16_t* hrow, int lane) {
    float ss = 0.f;
#pragma unroll
    for (int i = 0; i < 4; ++i) ss += x[i][0] * x[i][0] + x[i][1] * x[i][1] + x[i][2] * x[i][2] + x[i][3] * x[i][3];
    ss = wave_sum(ss);
    const float rstd = rsqrtf(ss * (1.0f / 1024.0f) + 1e-6f);
#pragma unroll
    for (int i = 0; i < 4; ++i) { const int d = i * 256 + lane * 4; const f32x4 gg = *(const f32x4*)(g + d), sc = *(const f32x4*)(mod + scoff + d), sh = *(const f32x4*)(mod + shoff + d);
        f32x4 h;
#pragma unroll
        for (int e = 0; e < 4; ++e) h[e] = x[i][e] * rstd * gg[e] * (1.f + sc[e]) + sh[e];
        { u32x2 w; w.x = pk_bf16(h[0], h[1]); w.y = pk_bf16(h[2], h[3]); __builtin_nontemporal_store(w, (u32x2*)(hrow + d)); } }
}
__device__ __forceinline__ void phase_norm(const P& p, int l, int which) {
    const int lane = tid_() & 63, gw = bid_() * 8 + (tid_() >> 6), nw = gridDim.x * 8;
    const float* g = (which == 1 ? p.in[lnd(9)] : p.in[lnd(27)]) + (size_t)l * 1024;
    const float* modl = (const float*)(p.ws + WS_MOD) + (size_t)l * 9 * 6144;
    const int shoff = which == 1 ? 0 : 3072, scoff = which == 1 ? 1024 : 4096;
    bf16_t* H = (bf16_t*)(p.ws + WS_R2); float* X = p.out;
    if (which == 1 && l == 0) {
        for (int item = gw; item < 4096 + 8192; item += nw) {
            if (item < 4096) {
                const int n = item; const float rr = (float)(n >> 6), cc = (float)(n & 63); f32x4 pe[4];
#pragma unroll
                for (int e = 0; e < 4; ++e) { const float om = expf(-(float)(lane * 4 + e) * (9.210340371976184f / 256.0f)); float s, c; sincosf(rr * om, &s, &c); pe[0][e] = s; pe[1][e] = c; sincosf(cc * om, &s, &c); pe[2][e] = s; pe[3][e] = c; }
                for (int b0 = 0; b0 < 8; b0 += 2) { f32x4 x[2][4];
#pragma unroll
                    for (int r = 0; r < 2; ++r) { const float* src = p.in[lnd(1)] + ((size_t)(b0 + r) * 4096 + n) * 1024;
#pragma unroll
                        for (int i = 0; i < 4; ++i) x[r][i] = *(const f32x4*)(src + i * 256 + lane * 4); }
#pragma unroll
                    for (int r = 0; r < 2; ++r) { const int row = TOKP + (b0 + r) * 4096 + n;
#pragma unroll
                        for (int i = 0; i < 4; ++i) { x[r][i] = x[r][i] + pe[i]; *(f32x4*)(X + (size_t)row * 1024 + i * 256 + lane * 4) = x[r][i]; }
                        norm_row_write(x[r], g, modl + (size_t)(1 + b0 + r) * 6144, shoff, scoff, H + (size_t)row * 1024, lane); } }
            } else { const int row = item - 4096; const float* src = p.in[lnd(0)] + (size_t)row * 1024; f32x4 x[4];
#pragma unroll
                for (int i = 0; i < 4; ++i) { x[i] = *(const f32x4*)(src + i * 256 + lane * 4); *(f32x4*)(X + (size_t)row * 1024 + i * 256 + lane * 4) = x[i]; }
                norm_row_write(x, g, modl, shoff, scoff, H + (size_t)row * 1024, lane); }
        }
    } else {
        const bf16_t* DL = (const bf16_t*)(p.ws + (which == 1 ? WS_R2 : WS_R3));
        for (int it = gw; it < TOK / 4; it += nw) {
            const int rowb = it * 4; const float* mod = modl + (size_t)mod_index(rowb) * 6144;
            f32x4 x[4][4]; u32x2 dv[4][4];
#pragma unroll
            for (int r = 0; r < 4; ++r)
#pragma unroll
                for (int i = 0; i < 4; ++i) { x[r][i] = __builtin_nontemporal_load((const f32x4*)(X + (size_t)(rowb + r) * 1024 + i * 256 + lane * 4)); dv[r][i] = __builtin_nontemporal_load((const u32x2*)(DL + (size_t)(rowb + r) * 1024 + i * 256 + lane * 4)); }
            f32x4 gs[4], sh[4];
#pragma unroll
            for (int i = 0; i < 4; ++i) { const int d = i * 256 + lane * 4; const f32x4 gg = *(const f32x4*)(g + d), sc = *(const f32x4*)(mod + scoff + d); sh[i] = *(const f32x4*)(mod + shoff + d); gs[i] = gg * (sc + 1.f); }
#pragma unroll
            for (int r = 0; r < 4; ++r) { float ss = 0.f;
#pragma unroll
                for (int i = 0; i < 4; ++i) { x[r][i] = x[r][i] + (f32x4){bflo(dv[r][i].x), bfhi(dv[r][i].x), bflo(dv[r][i].y), bfhi(dv[r][i].y)}; *(f32x4*)(X + (size_t)(rowb + r) * 1024 + i * 256 + lane * 4) = x[r][i];
                    ss += x[r][i][0] * x[r][i][0] + x[r][i][1] * x[r][i][1] + x[r][i][2] * x[r][i][2] + x[r][i][3] * x[r][i][3]; }
                ss = wave_sum(ss); const float rstd = rsqrtf(ss * (1.0f / 1024.0f) + 1e-6f);
#pragma unroll
                for (int i = 0; i < 4; ++i) { const f32x4 hv = x[r][i] * rstd * gs[i] + sh[i]; u32x2 w; w.x = pk_bf16(hv[0], hv[1]); w.y = pk_bf16(hv[2], hv[3]); __builtin_nontemporal_store(w, (u32x2*)(H + (size_t)(rowb + r) * 1024 + i * 256 + lane * 4)); } }
        }
    }
}
__device__ __forceinline__ void phase_final(const P& p) {
    const int lane = tid_() & 63, gw = bid_() * 8 + (tid_() >> 6), nw = gridDim.x * 8; float* X = p.out; const float* g = p.in[lnd(30)]; const bf16_t* DL = (const bf16_t*)(p.ws + WS_R2);
    for (int row0 = gw; row0 < TOK; row0 += 4 * nw) {
        f32x4 x[4][4]; u32x2 dv[4][4];
#pragma unroll
        for (int r = 0; r < 4; ++r) { const int row = row0 + r * nw;
            if (row < TOK) {
#pragma unroll
                for (int i = 0; i < 4; ++i) { x[r][i] = __builtin_nontemporal_load((const f32x4*)(X + (size_t)row * 1024 + i * 256 + lane * 4)); dv[r][i] = __builtin_nontemporal_load((const u32x2*)(DL + (size_t)row * 1024 + i * 256 + lane * 4)); } } }
#pragma unroll
        for (int r = 0; r < 4; ++r) { const int row = row0 + r * nw;
            if (row < TOK) { float ss = 0.f;
#pragma unroll
                for (int i = 0; i < 4; ++i) { x[r][i] = x[r][i] + (f32x4){bflo(dv[r][i].x), bfhi(dv[r][i].x), bflo(dv[r][i].y), bfhi(dv[r][i].y)}; ss += x[r][i][0] * x[r][i][0] + x[r][i][1] * x[r][i][1] + x[r][i][2] * x[r][i][2] + x[r][i][3] * x[r][i][3]; }
                ss = wave_sum(ss); const float rstd = rsqrtf(ss * (1.0f / 1024.0f) + 1e-6f);
#pragma unroll
                for (int i = 0; i < 4; ++i) { const f32x4 gg = *(const f32x4*)(g + i * 256 + lane * 4); *(f32x4*)(X + (size_t)row * 1024 + i * 256 + lane * 4) = x[r][i] * rstd * gg; } } }
    }
}

__device__ __forceinline__ void phase_s5scan(const P& p, int l) {
    const float* E = (const float*)(p.ws + WS_E); bf16_t* UG = (bf16_t*)(p.ws + WS_R5);
    float* ore = p.out + (size_t)TOK * 1024 + 16777216; float* oim = ore + 262144;
    for (int task = bid_(); task < 320; task += gridDim.x) {
        const int idx = task * NTHR + tid_(), pp = idx & 63, d = (idx >> 6) & 1, g = (idx >> 7) & 31, s = 39 - (idx >> 12);
        const int nch = s < 32 ? 8 : 128, cbase = s < 32 ? s * 8 : 256 + (s - 32) * 128;
        const int pg = (l * 2 + d) * 32 + g; const float dt = expf(p.in[lnd(17)][pg]);
        const float a = expf(p.in[lnd(15)][(size_t)pg * 64 + pp] * dt * 32.f); float sn, cs; sincosf(p.in[lnd(16)][(size_t)pg * 64 + pp] * dt * 32.f, &sn, &cs);
        const float ar = a * cs, ai = a * sn;
        float sr = 0.f, si = 0.f;
        if (s >= 32) { const size_t o = ((((size_t)(s - 32) * 2 + l) * 2 + d) * 32 + g) * 64 + pp; sr = p.in[lnd(4)][o]; si = p.in[lnd(5)][o]; }
        const float* Eb = E + ((size_t)(g * 1280 + cbase) * 256 + d * 128 + pp);
        bf16_t* Ub = UG + ((size_t)(g * 1280 + cbase) * 768 + 512 + d * 128 + pp);
        for (int c0 = 0; c0 < nch; c0 += 8) {
            float er[8], ei[8];
#pragma unroll
            for (int k = 0; k < 8; ++k) { const int c = d == 0 ? c0 + k : nch - 1 - (c0 + k); er[k] = Eb[(size_t)c * 256]; ei[k] = Eb[(size_t)c * 256 + 64]; }
#pragma unroll
            for (int k = 0; k < 8; ++k) { const int c = d == 0 ? c0 + k : nch - 1 - (c0 + k);
                Ub[(size_t)c * 768] = f2bf(sr); Ub[(size_t)c * 768 + 64] = f2bf(si);
                const float nr = ar * sr - ai * si + er[k], ni = ar * si + ai * sr + ei[k]; sr = nr; si = ni; }
        }
        if (s < 32) { const size_t o = ((((size_t)s * 2 + l) * 2 + d) * 32 + g) * 64 + pp; ore[o] = sr; oim[o] = si; }
    }
}

__device__ __forceinline__ void phase_glapre(const P& p, int l, LAS unsigned char* lds) {
    const int tid = tid_(), d = tid & 127, tq = tid >> 7, wv = tid >> 6, lane = tid & 63, fr = lane & 15, fq = lane >> 4;
    LAS float* sG = (LAS float*)lds; LAS float* sT4 = sG + 2048; LAS float* sZ = sG + 2560;
    bf16_t* Q = (bf16_t*)(p.ws + WS_R3); bf16_t* Kk = Q + (size_t)TOK * 512;
    bf16_t* QB = (bf16_t*)(p.ws + WS_R5); bf16_t* KB = QB + (size_t)TOK * 512;
    const float* GLR = (const float*)(p.ws + WS_GLR);
    for (int task = bid_(); task < 2560; task += gridDim.x) {
        const int c64 = task >> 2, h = task & 3, tb = c64 * 64;
        { const int row = tid >> 3, c4 = (tid & 7) * 4; *(LAS f32x4*)(sG + row * 32 + c4) = *(const f32x4*)(GLR + (size_t)(tb + row) * 32 + c4); }
        float qv[16], kv[16];
#pragma unroll
        for (int i = 0; i < 16; ++i) { const size_t o = (size_t)(tb + tq * 16 + i) * 512 + h * 128 + d; qv[i] = bf2f(Q[o]); kv[i] = bf2f(Kk[o]); }
        bf16x8 bw[2];
#pragma unroll
        for (int dir = 0; dir < 2; ++dir) { float w8[8];
#pragma unroll
            for (int e = 0; e < 8; ++e) { const int kk = 8 * fq + e - 16 * dir; w8[e] = (kk >= 0 && kk < 16) ? p.in[lnd(11)][((size_t)(l * 2 + dir) * 16 + kk) * 512 + h * 128 + 16 * wv + fr] : 0.f; }
            u32x4 pk; pk.x = pk_bf16(w8[0], w8[1]); pk.y = pk_bf16(w8[2], w8[3]); pk.z = pk_bf16(w8[4], w8[5]); pk.w = pk_bf16(w8[6], w8[7]);
            bw[dir] = __builtin_bit_cast(bf16x8, pk); }
        __syncthreads();
#pragma unroll
        for (int ti = 0; ti < 4; ++ti) {
            const LAS float* gr = sG + (16 * ti + fr) * 32 + 8 * fq; const f32x4 g0 = *(const LAS f32x4*)gr, g1 = *(const LAS f32x4*)(gr + 4);
            u32x4 pk; pk.x = pk_bf16(g0[0], g0[1]); pk.y = pk_bf16(g0[2], g0[3]); pk.z = pk_bf16(g1[0], g1[1]); pk.w = pk_bf16(g1[2], g1[3]);
            const bf16x8 af = __builtin_bit_cast(bf16x8, pk);
#pragma unroll
            for (int dir = 0; dir < 2; ++dir) { const f32x4 z = __builtin_amdgcn_mfma_f32_16x16x32_bf16(af, bw[dir], (f32x4){0.f, 0.f, 0.f, 0.f}, 0, 0, 0);
#pragma unroll
                for (int e = 0; e < 4; ++e) sZ[(dir * 64 + 16 * ti + 4 * fq + e) * 128 + 16 * wv + fr] = z[e]; }
        }
        __syncthreads();
#pragma unroll 1
        for (int dir = 0; dir < 2; ++dir) {
            const float bg = p.in[lnd(12)][(size_t)(l * 2 + dir) * 512 + h * 128 + d];
            float cum[16];
#pragma unroll
            for (int i = 0; i < 16; ++i) { const float z = sZ[(dir * 64 + tq * 16 + i) * 128 + d] + bg;
                cum[i] = (fminf(z, 0.f) - __logf(1.0f + __expf(-fabsf(z)))) * 0.0625f; }
            if (dir == 0) {
#pragma unroll
                for (int i = 1; i < 16; ++i) cum[i] += cum[i - 1];
            } else {
#pragma unroll
                for (int i = 14; i >= 0; --i) cum[i] += cum[i + 1];
            }
            sT4[tq * 128 + d] = dir == 0 ? cum[15] : cum[0];
            __syncthreads();
            float off = 0.f, total = 0.f;
#pragma unroll
            for (int q = 0; q < 4; ++q) { const float v = sT4[q * 128 + d]; total += v; if (dir == 0 ? (q < tq) : (q > tq)) off += v; }
            bf16_t* QD = dir == 0 ? Q : QB; bf16_t* KI = dir == 0 ? Kk : KB;
#pragma unroll
            for (int i = 0; i < 16; ++i) { const float cm = cum[i] + off; const size_t o = (size_t)(tb + tq * 16 + i) * 512 + h * 128 + d;
                QD[o] = f2bf(qv[i] * __expf(cm)); KI[o] = f2bf(kv[i] * __expf(-cm)); }
            if (tq == 0) ((float*)(p.ws + (dir == 0 ? WS_TOTF : WS_TOTB)))[(size_t)c64 * 512 + h * 128 + d] = total;
            __syncthreads();
        }
    }
}

constexpr int GLA_GRP = 71168;
typedef short s16x4 __attribute__((ext_vector_type(4)));
__device__ __forceinline__ bf16x8 tr_frag(const LAS bf16_t* base, int stride, int krow0, int col0, int fr, int fq) {
    const LAS bf16_t* q = base + (krow0 + 8 * fq + (fr >> 2)) * stride + col0 + 4 * (fr & 3);
    const s16x4 a = __builtin_amdgcn_ds_read_tr16_b64_v4i16((LAS s16x4*)q);
    const s16x4 b = __builtin_amdgcn_ds_read_tr16_b64_v4i16((LAS s16x4*)(q + 4 * stride));
    return __builtin_shufflevector(a, b, 0, 1, 2, 3, 4, 5, 6, 7);
}
__device__ __forceinline__ bf16x8 tr_frag_perm(const LAS bf16_t* base, int stride, int ks, int col0, int fr, int fq) {
    const LAS bf16_t* q = base + (32 * ks + 4 * fq + (fr >> 2)) * stride + col0 + 4 * (fr & 3);
    const s16x4 a = __builtin_amdgcn_ds_read_tr16_b64_v4i16((LAS s16x4*)q);
    const s16x4 b = __builtin_amdgcn_ds_read_tr16_b64_v4i16((LAS s16x4*)(q + 16 * stride));
    return __builtin_shufflevector(a, b, 0, 1, 2, 3, 4, 5, 6, 7);
}
#define LDS_BAR() do { asm volatile("s_waitcnt lgkmcnt(0)" ::: "memory"); __builtin_amdgcn_s_barrier(); asm volatile("" ::: "memory"); } while (0)
__device__ __forceinline__ void phase_gla(const P& p, int l, LAS unsigned char* lds) {
    const int tid = tid_(), grp = __builtin_amdgcn_readfirstlane(tid >> 8), gt = tid & 255, wv = __builtin_amdgcn_readfirstlane((tid >> 6) & 3), lane = tid & 63, fr = lane & 15, fq = lane >> 4;
    LAS unsigned char* gl = lds + grp * GLA_GRP;
    LAS bf16_t* sQ = (LAS bf16_t*)gl; LAS bf16_t* sK = (LAS bf16_t*)(gl + 17408); LAS bf16_t* sV = (LAS bf16_t*)(gl + 34816);
    LAS bf16_t* sP = (LAS bf16_t*)(gl + 44032); LAS bf16_t* sS = (LAS bf16_t*)(gl + 53248); LAS float* sTot = (LAS float*)(gl + 70656);
    const bf16_t* QD = grp == 0 ? (const bf16_t*)(p.ws + WS_R3) : (const bf16_t*)(p.ws + WS_R5);
    const bf16_t* KI = QD + (size_t)TOK * 512;
    const bf16_t* V = (const bf16_t*)(p.ws + WS_R4);
    const float* TOT = (const float*)(p.ws + (grp == 0 ? WS_TOTF : WS_TOTB));
    bf16_t* O = (bf16_t*)(p.ws + WS_R1);
    float* OST = p.out + (size_t)TOK * 1024;
    const int G = gridDim.x, b = bid_();
    const bool custom = (G == 256);
    const int ntask_mine = custom ? (b < 128 ? 1 : 4) : ((640 - b + G - 1) / G);
    for (int ti = 0; ti < ntask_mine; ++ti) {
        const int task = custom ? (b < 128 ? b : b + 128 * ti) : b + G * ti;
        if (task >= 640) break;
        const bool sample = task < 128;
        const int t2 = sample ? task : task - 128, xcd_ = t2 & 7, vs = (t2 >> 3) & 3, sh_ = xcd_ + 8 * (t2 >> 5), sb = sh_ >> 2, h = sh_ & 3;
        const int base = sample ? TOKP + sb * 4096 : sb * 256, nch = sample ? 64 : 4;
        f32x4 accS[2][4];
#pragma unroll
        for (int dt = 0; dt < 2; ++dt)
#pragma unroll
            for (int vt = 0; vt < 4; ++vt) {
                f32x4 a = (f32x4){0.f, 0.f, 0.f, 0.f};
                if (sample) { const float* cp = p.in[lnd(3)] + (((((size_t)sb * 2 + l) * 2 + grp) * 4 + h) * 128 + 16 * (2 * wv + dt) + 4 * fq) * 256 + vs * 64 + 16 * vt + fr;
#pragma unroll
                    for (int e = 0; e < 4; ++e) a[e] = cp[(size_t)e * 256]; }
                accS[dt][vt] = a;
                u32x2 w; w.x = pk_bf16(a[0], a[1]); w.y = pk_bf16(a[2], a[3]);
                *(LAS u32x2*)(sS + (16 * vt + fr) * 136 + 16 * (2 * wv + dt) + 4 * fq) = w;
            }
        u32x4 rq[2][4], rk[2][4], rv[2][2]; float rt[2] = {0.f, 0.f};
        u32x2 oprev[2][4];
#pragma unroll
        for (int u = 0; u < 2; ++u)
#pragma unroll
            for (int vt = 0; vt < 4; ++vt) oprev[u][vt] = (u32x2){0u, 0u};
#define GLA_CHUNK(st) (grp == 0 ? (st) : nch - 1 - (st))
#define GLA_LOAD(U, ci) do { const int tb_ = base + (ci) * 64; \
        _Pragma("unroll") for (int i = 0; i < 4; ++i) { const int idx = gt + 256 * i, row = idx >> 4, c16 = idx & 15; const size_t o = (size_t)(tb_ + row) * 512 + h * 128 + c16 * 8; rq[U][i] = *(const u32x4*)(QD + o); rk[U][i] = *(const u32x4*)(KI + o); } \
        _Pragma("unroll") for (int i = 0; i < 2; ++i) { const int idx = gt + 256 * i, row = idx >> 3, c8 = idx & 7; rv[U][i] = *(const u32x4*)(V + (size_t)(tb_ + row) * 1024 + h * 256 + vs * 64 + c8 * 8); } \
        if (gt < 128) rt[U] = TOT[(size_t)(tb_ >> 6) * 512 + h * 128 + gt]; } while (0)
#define GLA_STORE(U) do { \
        _Pragma("unroll") for (int i = 0; i < 4; ++i) { const int idx = gt + 256 * i, row = idx >> 4, c16 = idx & 15; *(LAS u32x4*)(sQ + row * 136 + c16 * 8) = rq[U][i]; *(LAS u32x4*)(sK + row * 136 + c16 * 8) = rk[U][i]; } \
        _Pragma("unroll") for (int i = 0; i < 2; ++i) { const int idx = gt + 256 * i, row = idx >> 3, c8 = idx & 7; *(LAS u32x4*)(sV + row * 72 + c8 * 8) = rv[U][i]; } \
        if (gt < 128) sTot[gt] = rt[U]; } while (0)
#define GLA_OLOAD(U, st) do { const int tb_ = base + GLA_CHUNK(st) * 64; \
        _Pragma("unroll") for (int vt = 0; vt < 4; ++vt) oprev[U][vt] = *(const u32x2*)(O + (size_t)(tb_ + 16 * wv + fr) * 1024 + h * 256 + vs * 64 + 16 * vt + 4 * fq); } while (0)
        GLA_LOAD(0, GLA_CHUNK(0));
        GLA_STORE(0);
        GLA_LOAD(1, GLA_CHUNK(1));
        __syncthreads();
        const int half = nch >> 1;
        for (int s0 = 0; s0 < nch; s0 += 2) {
#pragma unroll
          for (int u = 0; u < 2; ++u) {
            const int s = s0 + u;
            const int ci = GLA_CHUNK(s), tb = base + ci * 64;
            const bool second = (s >= half);
            if (s == half) GLA_OLOAD(u, s);
            if (s + 1 < nch && s + 1 > half) GLA_OLOAD(u ^ 1, s + 1);
            asm volatile("" ::: "memory");
            if (s + 2 < nch) GLA_LOAD(u, GLA_CHUNK(s + 2));
            bf16x8 pfr[2];
            { bf16x8 qa[4];
#pragma unroll
            for (int ks = 0; ks < 4; ++ks) qa[ks] = *(const LAS bf16x8*)(sQ + (16 * wv + fr) * 136 + 32 * ks + 8 * fq);
            u32x2 pk2[4];
#pragma unroll
            for (int jt = 0; jt < 4; ++jt) {
                bf16x8 kb[4];
#pragma unroll
                for (int ks = 0; ks < 4; ++ks) kb[ks] = *(const LAS bf16x8*)(sK + (16 * jt + fr) * 136 + 32 * ks + 8 * fq);
                f32x4 acc = (f32x4){0.f, 0.f, 0.f, 0.f};
#pragma unroll
                for (int ks = 0; ks < 4; ++ks) acc = __builtin_amdgcn_mfma_f32_16x16x32_bf16(kb[ks], qa[ks], acc, 0, 0, 0);
                const int i = 16 * wv + fr;
#pragma unroll
                for (int e = 0; e < 4; ++e) { const int j = 16 * jt + 4 * fq + e; const bool keep = grp == 0 ? (j <= i) : (j >= i); acc[e] = keep ? acc[e] : 0.f; }
                pk2[jt].x = pk_bf16(acc[0], acc[1]); pk2[jt].y = pk_bf16(acc[2], acc[3]);
            }
#pragma unroll
            for (int ks = 0; ks < 2; ++ks) { u32x4 w; w.x = pk2[2 * ks].x; w.y = pk2[2 * ks].y; w.z = pk2[2 * ks + 1].x; w.w = pk2[2 * ks + 1].y; pfr[ks] = __builtin_bit_cast(bf16x8, w); }
            }
            asm volatile("" ::: "memory");
            bf16x8 vf[4][2];
#pragma unroll
            for (int vt = 0; vt < 4; ++vt)
#pragma unroll
                for (int ks = 0; ks < 2; ++ks) vf[vt][ks] = tr_frag_perm(sV, 72, ks, 16 * vt, fr, fq);
#pragma unroll
            for (int dt = 0; dt < 2; ++dt) {
                bf16x8 kf[2];
#pragma unroll
                for (int ks = 0; ks < 2; ++ks) kf[ks] = tr_frag_perm(sK, 136, ks, 16 * (2 * wv + dt), fr, fq);
                const f32x4 tt = *(const LAS f32x4*)(sTot + 16 * (2 * wv + dt) + 4 * fq);
                const f32x4 sc = (f32x4){__expf(tt[0]), __expf(tt[1]), __expf(tt[2]), __expf(tt[3])};
#pragma unroll
                for (int vt = 0; vt < 4; ++vt) {
#pragma unroll
                    for (int ks = 0; ks < 2; ++ks) accS[dt][vt] = __builtin_amdgcn_mfma_f32_16x16x32_bf16(kf[ks], vf[vt][ks], accS[dt][vt], 0, 0, 0);
                    accS[dt][vt] = accS[dt][vt] * sc;
                }
            }
            {
                bf16x8 qf[4];
#pragma unroll
                for (int ks = 0; ks < 4; ++ks) qf[ks] = *(const LAS bf16x8*)(sQ + (16 * wv + fr) * 136 + 32 * ks + 8 * fq);
#pragma unroll
                for (int vt = 0; vt < 4; ++vt) {
                    f32x4 acc = (f32x4){0.f, 0.f, 0.f, 0.f};
#pragma unroll
                    for (int ks = 0; ks < 2; ++ks) acc = __builtin_amdgcn_mfma_f32_16x16x32_bf16(vf[vt][ks], pfr[ks], acc, 0, 0, 0);
#pragma unroll
                    for (int ks = 0; ks < 4; ++ks) { const bf16x8 sf = *(const LAS bf16x8*)(sS + (16 * vt + fr) * 136 + 32 * ks + 8 * fq);
                        acc = __builtin_amdgcn_mfma_f32_16x16x32_bf16(sf, qf[ks], acc, 0, 0, 0); }
                    { u32x2 pv = oprev[u][vt]; asm volatile("" : "+v"(pv));
                      if (second) acc = acc + (f32x4){bflo(pv.x), bfhi(pv.x), bflo(pv.y), bfhi(pv.y)}; }
                    store4bf(O + (size_t)(tb + 16 * wv + fr) * 1024 + h * 256 + vs * 64 + 16 * vt + 4 * fq, acc);
                }
            }
            LDS_BAR();
#pragma unroll
            for (int dt = 0; dt < 2; ++dt)
#pragma unroll
                for (int vt = 0; vt < 4; ++vt) { u32x2 w; w.x = pk_bf16(accS[dt][vt][0], accS[dt][vt][1]); w.y = pk_bf16(accS[dt][vt][2], accS[dt][vt][3]);
                    *(LAS u32x2*)(sS + (16 * vt + fr) * 136 + 16 * (2 * wv + dt) + 4 * fq) = w; }
            if (s + 1 < nch) GLA_STORE(u ^ 1);
            if (s == half - 1) { asm volatile("s_waitcnt vmcnt(0)" ::: "memory"); __syncthreads(); } else LDS_BAR();
          }
        }
        if (!sample) {
#pragma unroll
            for (int dt = 0; dt < 2; ++dt)
#pragma unroll
                for (int vt = 0; vt < 4; ++vt) { float* op = OST + (((((size_t)sb * 2 + l) * 2 + grp) * 4 + h) * 128 + 16 * (2 * wv + dt) + 4 * fq) * 256 + vs * 64 + 16 * vt + fr;
#pragma unroll
                    for (int e = 0; e < 4; ++e) op[(size_t)e * 256] = accS[dt][vt][e]; }
        }
    }
#undef GLA_LOAD
#undef GLA_STORE
#undef GLA_OLOAD
#undef GLA_CHUNK
}

__device__ __forceinline__ void phase_glapost(const P& p, int l) {
    const int lane = tid_() & 63, gw = bid_() * 8 + (tid_() >> 6), nw = gridDim.x * 8;
    bf16_t* O = (bf16_t*)(p.ws + WS_R1); const bf16_t* R = (const bf16_t*)(p.ws + WS_R3);
    const float* gn = p.in[lnd(13)] + (size_t)l * 256 + (lane & 15) * 16;
    for (int row = gw; row < TOK; row += nw) {
        const size_t o = (size_t)row * 1024 + lane * 16; float x[16], r[16];
#pragma unroll
        for (int hh = 0; hh < 2; ++hh) { const u32x4 a = *(const u32x4*)(O + o + 8 * hh), c = *(const u32x4*)(R + o + 8 * hh);
            x[8 * hh + 0] = bflo(a.x); x[8 * hh + 1] = bfhi(a.x); x[8 * hh + 2] = bflo(a.y); x[8 * hh + 3] = bfhi(a.y); x[8 * hh + 4] = bflo(a.z); x[8 * hh + 5] = bfhi(a.z); x[8 * hh + 6] = bflo(a.w); x[8 * hh + 7] = bfhi(a.w);
            r[8 * hh + 0] = bflo(c.x); r[8 * hh + 1] = bfhi(c.x); r[8 * hh + 2] = bflo(c.y); r[8 * hh + 3] = bfhi(c.y); r[8 * hh + 4] = bflo(c.z); r[8 * hh + 5] = bfhi(c.z); r[8 * hh + 6] = bflo(c.w); r[8 * hh + 7] = bfhi(c.w); }
        float ss = 0.f;
#pragma unroll
        for (int e = 0; e < 16; ++e) ss += x[e] * x[e];
        ss += __shfl_xor(ss, 1); ss += __shfl_xor(ss, 2); ss += __shfl_xor(ss, 4); ss += __shfl_xor(ss, 8);
        const float rstd = rsqrtf(ss * (1.0f / 256.0f) + 1e-6f);
        float y[16];
#pragma unroll
        for (int e = 0; e < 16; ++e) y[e] = x[e] * rstd * gn[e] * r[e];
#pragma unroll
        for (int hh = 0; hh < 2; ++hh) { u32x4 w; w.x = pk_bf16(y[8 * hh], y[8 * hh + 1]); w.y = pk_bf16(y[8 * hh + 2], y[8 * hh + 3]); w.z = pk_bf16(y[8 * hh + 4], y[8 * hh + 5]); w.w = pk_bf16(y[8 * hh + 6], y[8 * hh + 7]); *(u32x4*)(O + o + 8 * hh) = w; }
    }
}


#define XB_TMO      128
#define XB_XCNT(j)  (256  + 64 * (j))
#define XB_XSUB(j)  (1280 + 64 * (j))
#define XB_XGEN(j)  (2304 + 64 * (j))
#define XB_TOP      3328
#define XB_TOPGEN   3392
#define XCD_BAR_WORDS 3456
#define XB_SPIN_CAP (1u << 18)
__device__ __forceinline__ unsigned xb_ld(unsigned* p)              { return __hip_atomic_load(p, __ATOMIC_RELAXED, __HIP_MEMORY_SCOPE_AGENT); }
__device__ __forceinline__ unsigned xb_add(unsigned* p, unsigned v) { return __hip_atomic_fetch_add(p, v, __ATOMIC_RELAXED, __HIP_MEMORY_SCOPE_AGENT); }
__device__ __forceinline__ unsigned xb_xcc_id() { return (unsigned)__builtin_amdgcn_s_getreg((3 << 11) | 20) & 0xFu; }
#define XB_SPIN(cond, bar) do { unsigned _sp = 0; while (cond) { __builtin_amdgcn_s_sleep(1); \
    if ((++_sp & 255u) == 0u) { if (xb_ld(&(bar)[XB_TMO])) break; if (_sp > XB_SPIN_CAP) { atomicAdd(&(bar)[XB_TMO], 1u); break; } } } } while (0)
struct XcdBarrier { unsigned* bar; unsigned x; volatile LAS unsigned* st; };
__device__ __forceinline__ XcdBarrier xcd_barrier_post(unsigned* bar, volatile LAS unsigned* st) {
    XcdBarrier b; b.bar = bar; b.x = xb_xcc_id(); b.st = st;
    if (threadIdx.x == 0) (void)xb_add(&bar[XB_XCNT(b.x)], 1u);
    return b;
}
__device__ __forceinline__ void xcd_barrier_complete(unsigned* bar, unsigned x, unsigned& nloc, unsigned& nx) {
    const unsigned G = gridDim.x * gridDim.y * gridDim.z;
    unsigned sum, cnt, mine, sp = 0u;
    for (;;) {
        sum = 0u; cnt = 0u; mine = 0u;
#pragma unroll
        for (unsigned j = 0; j < 16; ++j) { const unsigned c = xb_ld(&bar[XB_XCNT(j)]); sum += c; cnt += (c > 0u) ? 1u : 0u; mine = (j == x) ? c : mine; }
        if (sum == G) break;
        __builtin_amdgcn_s_sleep(1);
        if ((++sp & 255u) == 0u) { if (xb_ld(&bar[XB_TMO])) break; if (sp > XB_SPIN_CAP) { atomicAdd(&bar[XB_TMO], 1u); break; } }
    }
    nloc = mine > 0u ? mine : 1u; nx = cnt > 0u ? cnt : 1u;
}
__device__ __forceinline__ void xcd_barrier(const XcdBarrier& b) {
    asm volatile("s_waitcnt vmcnt(0)" ::: "memory");
    __syncthreads();
    if (threadIdx.x == 0) {
        unsigned* bar = b.bar;
        __builtin_amdgcn_s_waitcnt(0);
        unsigned nloc = b.st[0], nx = b.st[1];
        if (nloc == 0u) { xcd_barrier_complete(bar, b.x, nloc, nx); b.st[0] = nloc; b.st[1] = nx; }
        const unsigned old = xb_add(&bar[XB_XSUB(b.x)], 1u);
        const unsigned gen = old / nloc;
        if (old + 1u == (gen + 1u) * nloc) {
            __builtin_amdgcn_fence(__ATOMIC_RELEASE, "agent");
            asm volatile("s_waitcnt vmcnt(0)" ::: "memory");
            const unsigned og = xb_add(&bar[XB_TOP], 1u);
            const unsigned tg = og / nx;
            if (og + 1u == (tg + 1u) * nx) xb_add(&bar[XB_TOPGEN], 1u);
            else XB_SPIN(xb_ld(&bar[XB_TOPGEN]) == tg, bar);
            __builtin_amdgcn_fence(__ATOMIC_ACQUIRE, "agent");
            xb_add(&bar[XB_XGEN(b.x)], 1u);
            asm volatile("s_waitcnt vmcnt(0)" ::: "memory");
        } else {
            XB_SPIN(xb_ld(&bar[XB_XGEN(b.x)]) == gen, bar);
            __builtin_amdgcn_fence(__ATOMIC_ACQUIRE, "agent");
            asm volatile("s_waitcnt vmcnt(0)" ::: "memory");
        }
    }
    __syncthreads();
}

__device__ __forceinline__ void run_phase(const P& p, int ph, LAS unsigned char* lds) {
    if (ph == 2 * PPL) { if (EN(34)) phase_final(p); return; }
    const int l = ph / PPL, q = ph % PPL;
    unsigned char* ws = p.ws; bf16_t* W = (bf16_t*)(ws + WS_W);
    const int G = gridDim.x, c = bid_();
    pg8::Order S;
    switch (q) {
        case 0: if (EN(0)) { phase_prep(p, l, lds); if (l == 1) phase_norm(p, l, 1); } break;
        case 1: if (EN(1)) { if (l == 0) phase_norm(p, l, 1); } break;
        case 2: if (EN(2)) { pg8::Gemm g{(const bf16_t*)(ws + WS_R2), W + W_A / 2, TOK, 2816, 1024, 1024, 0, 0, 1}; S.init(TOK, 2816, 1, G, c);
            EpiPartA E{(bf16_t*)(ws + WS_R3), (bf16_t*)(ws + WS_R3) + (size_t)TOK * 512, (bf16_t*)(ws + WS_R4), (bf16_t*)(ws + WS_R5), (float*)(ws + WS_GLR)};
            pg8::gemm_phase(lds, g, S, E); } break;
        case 3: if (EN(3)) { pg8::Gemm g{(const bf16_t*)(ws + WS_R5), (const bf16_t*)(ws + WS_EMAT), 1280, 256, 512, 768, (size_t)1280 * 768, (size_t)256 * 512, 32}; S.init(1280, 256, 32, G, c);
            EpiE E{(float*)(ws + WS_E)}; pg8::gemm_phase(lds, g, S, E); } break;
        case 4: if (EN(4)) phase_s5scan(p, l); break;
        case 5: if (EN(5)) { pg8::Gemm g{(const bf16_t*)(ws + WS_R5), (const bf16_t*)(ws + WS_R1), 1280, 512, 768, 768, (size_t)1280 * 768, (size_t)512 * 768, 32}; S.init(1280, 512, 32, G, c);
            EpiY E{(bf16_t*)(ws + WS_E)}; pg8::gemm_phase(lds, g, S, E); } break;
        case 6: if (EN(6)) { pg8::Gemm g{(const bf16_t*)(ws + WS_E), W + W_GLU / 2, TOK, 512, 512, 512, 0, 0, 1}; S.init(TOK, 512, 1, G, c);
            EpiGLU E{(const bf16_t*)(ws + WS_E), (bf16_t*)(ws + WS_R6), p.in[lnd(24)] + (size_t)l * 512}; pg8::gemm_phase(lds, g, S, E); } break;
        case 7: if (EN(7)) phase_glapre(p, l, lds); break;
        case 8: if (EN(8)) phase_gla(p, l, lds); break;
        case 9: if (EN(9)) { pg8::Gemm g{(const bf16_t*)(ws + WS_R2), W + W_B / 2, TOK, 3072, 1024, 1024, 0, 0, 1}; S.init(TOK, 3072, 1, G, c);
            EpiPartB E{(bf16_t*)(ws + WS_R3), (bf16_t*)(ws + WS_R4), (bf16_t*)(ws + WS_R5)}; pg8::gemm_phase(lds, g, S, E); } break;
        case 10: if (EN(10)) phase_glapost(p, l); break;
        case 11: if (EN(11)) { pg8::Gemm g{(const bf16_t*)(ws + WS_R1), W + W_PG / 2, TOK, 1024, 1024, 1024, 0, 0, 1}; S.init(TOK, 1024, 1, G, c);
              EpiProj1 E{(const bf16_t*)(ws + WS_R4), (bf16_t*)(ws + WS_R2)}; pg8::gemm_phase(lds, g, S, E); } break;
        case 12: if (EN(12)) { pg8::Gemm g{(const bf16_t*)(ws + WS_R6), W + W_PS / 2, TOK, 1024, 512, 512, 0, 0, 1}; S.init(TOK, 1024, 1, G, c);
              EpiProj2 E{(const bf16_t*)(ws + WS_R5), (bf16_t*)(ws + WS_R2)}; pg8::gemm_phase(lds, g, S, E); } break;
        case 13: if (EN(13)) { pg8::Gemm g{(const bf16_t*)(ws + WS_R2), W + W_OUT / 2, TOK, 1024, 1024, 1024, 0, 0, 1}; S.init(TOK, 1024, 1, G, c);
            EpiDelta E{(bf16_t*)(ws + WS_R3), (const float*)(ws + WS_MOD) + (size_t)l * 9 * 6144 + 2048}; pg8::gemm_phase(lds, g, S, E); } break;
        case 14: if (EN(14)) phase_norm(p, l, 2); break;
        case 15: if (EN(15)) { pg8::Gemm g{(const bf16_t*)(ws + WS_R2), W + W_1 / 2, TOK, 4096, 1024, 1024, 0, 0, 1}; S.init(TOK, 4096, 1, G, c);
            EpiFF1 E{(bf16_t*)(ws + WS_HID)}; pg8::gemm_phase(lds, g, S, E); } break;
        case 16: if (EN(16)) { pg8::Gemm g{(const bf16_t*)(ws + WS_HID), W + W_2 / 2, TOK, 1024, 4096, 4096, 0, 0, 1}; S.init(TOK, 1024, 1, G, c);
            EpiDelta E{(bf16_t*)(ws + WS_R2), (const float*)(ws + WS_MOD) + (size_t)l * 9 * 6144 + 5120}; pg8::gemm_phase(lds, g, S, E); } break;
        default: break;
    }
}

__global__ void __launch_bounds__(NTHR, 2) fwd_megakernel(P p) {
    extern __shared__ __attribute__((aligned(16))) unsigned char lds_raw[];
    LAS unsigned char* lds = (LAS unsigned char*)lds_raw;
#if MULTI_LAUNCH
    for (int ph = p.ph_lo; ph < p.ph_hi; ++ph) run_phase(p, ph, lds);
#else
    cg::grid_group grid = cg::this_grid();
    if (p.ph_lo < 0) grid.sync();
    volatile LAS unsigned* stw = (volatile LAS unsigned*)(lds + LDS_BYTES - 16);
    if (threadIdx.x < 4) stw[threadIdx.x] = 0u;
    __syncthreads();
    const XcdBarrier bar = xcd_barrier_post((unsigned*)(p.ws + WS_BAR), stw);
    for (int ph = p.ph_lo; ph < p.ph_hi; ++ph) {
        run_phase(p, ph, lds);
#if REP_MASK
        if (ph < 2 * PPL && ((REP_MASK >> (ph % PPL)) & 1)) {
            xcd_barrier(bar);
            if ((ph % PPL) == 12) { run_phase(p, ph - 1, lds); }
            run_phase(p, ph, lds);
        }
#endif
        if (ph + 1 < p.ph_hi && (ph % PPL) != 11 && ph != PPL) xcd_barrier(bar);
    }
#endif
}

extern "C" void kernel_launch(void* const* d_in, const int* in_sizes, int n_in, void* d_out, int out_size, void* d_ws, size_t ws_size, hipStream_t stream) {
    static int grid = 0;
    if (grid == 0) {
        if (n_in != 31 || ws_size < WS_END) { fprintf(stderr, "kernel_launch: unexpected n_in %d or ws_size %zu (< %zu)\n", n_in, ws_size, (size_t)WS_END); grid = -1; return; }
        int dev = 0, cus = 0, per_cu = 0;
        hipGetDevice(&dev);
        hipDeviceGetAttribute(&cus, hipDeviceAttributeMultiprocessorCount, dev);
        if (hipFuncSetAttribute((const void*)fwd_megakernel, hipFuncAttributeMaxDynamicSharedMemorySize, LDS_BYTES) != hipSuccess) { fprintf(stderr, "kernel_launch: hipFuncSetAttribute failed\n"); grid = -1; return; }
        hipOccupancyMaxActiveBlocksPerMultiprocessor(&per_cu, (const void*)fwd_megakernel, NTHR, LDS_BYTES);
        (void)hipGetLastError();
        if (per_cu < 1) fprintf(stderr, "kernel_launch: occupancy query says %d blocks per CU\n", per_cu);
        grid = cus > 0 ? cus : 256;
    }
    if (grid < 0) return;
    P p{};
    for (int i = 0; i < 31; ++i) p.in[i] = (const float*)d_in[i];
    p.out = (float*)d_out; p.ws = (unsigned char*)d_ws;
#if MULTI_LAUNCH
    for (int ph = 0; ph < NPHASE; ++ph) { p.ph_lo = ph; p.ph_hi = ph + 1; hipLaunchKernelGGL(fwd_megakernel, dim3(grid), dim3(NTHR), LDS_BYTES, stream, p); }
#else
    p.ph_lo = 0; p.ph_hi = NPHASE;
    (void)hipMemsetAsync((char*)d_ws + WS_BAR, 0, XCD_BAR_WORDS * sizeof(unsigned), stream);
    void* args[] = {&p};
    hipError_t e = hipLaunchCooperativeKernel((const void*)fwd_megakernel, dim3(grid), dim3(NTHR), args, LDS_BYTES, stream);
    if (e != hipSuccess) fprintf(stderr, "cooperative launch failed: %s (grid %d)\n", hipGetErrorString(e), grid);
#endif
}
```

```cpp
#include <hip/hip_runtime.h>
#include <hip/hip_cooperative_groups.h>
#include <cstdio>
namespace cg = cooperative_groups;

#ifndef MULTI_LAUNCH
#define MULTI_LAUNCH 0
#endif

#ifndef REP_MASK
#define REP_MASK 0
#endif
#ifndef PHASE_SEL
#define PHASE_SEL -1
#endif
#define EN(q) (PHASE_SEL < 0 || PHASE_SEL == (q))
#define LAS __attribute__((address_space(3)))
typedef unsigned short bf16_t;
typedef short bf16x8 __attribute__((ext_vector_type(8)));
typedef float f32x4 __attribute__((ext_vector_type(4)));
typedef unsigned u32x4 __attribute__((ext_vector_type(4)));
typedef unsigned u32x2 __attribute__((ext_vector_type(2)));

constexpr int NTHR = 512;
constexpr int TOK = 40960, TOKP = 8192;
constexpr int LDS_BYTES = 147456;
constexpr int NPHASE = 35;
constexpr int PPL = 17;

constexpr size_t MiB = (size_t)1 << 20;
constexpr size_t WS_MOD = 0;
constexpr size_t WS_GLR = 1 * MiB;
constexpr size_t WS_TOTF = 7 * MiB;
constexpr size_t WS_TOTB = 9 * MiB;
constexpr size_t WS_BAR = 12 * MiB;
constexpr size_t WS_W = 16 * MiB;
constexpr size_t W_A = 0;
constexpr size_t W_B = W_A + (size_t)2816 * 1024 * 2;
constexpr size_t W_PG = W_B + (size_t)3072 * 1024 * 2;
constexpr size_t W_GLU = W_PG + (size_t)1024 * 1024 * 2;
constexpr size_t W_PS = W_GLU + (size_t)512 * 512 * 2;
constexpr size_t W_OUT = W_PS + (size_t)1024 * 512 * 2;
constexpr size_t W_1 = W_OUT + (size_t)1024 * 1024 * 2;
constexpr size_t W_2 = W_1 + (size_t)4096 * 1024 * 2;
constexpr size_t WS_R2 = 50 * MiB;
constexpr size_t WS_R3 = 130 * MiB;
constexpr size_t WS_R4 = 210 * MiB;
constexpr size_t WS_R5 = 290 * MiB;
constexpr size_t WS_E = 350 * MiB;
constexpr size_t WS_R6 = 390 * MiB;
constexpr size_t WS_R1 = 430 * MiB;
constexpr size_t WS_EMAT = 454 * MiB;
constexpr size_t WS_HID = 130 * MiB;
constexpr size_t WS_END = 510 * MiB;

struct P { const float* in[31]; float* out; unsigned char* ws; int ph_lo, ph_hi; };

__device__ __forceinline__ int tid_() { int t = threadIdx.x; asm volatile("" : "+v"(t)); return t; }
__device__ __forceinline__ int bid_() { int b = blockIdx.x; asm volatile("" : "+s"(b)); return b; }
__device__ __forceinline__ int lnd(int k) { asm volatile("" : "+s"(k)); return k; }
__device__ __forceinline__ unsigned pk_bf16(float lo, float hi) { unsigned r; asm("v_cvt_pk_bf16_f32 %0, %1, %2" : "=v"(r) : "v"(lo), "v"(hi)); return r; }
__device__ __forceinline__ float bf2f(bf16_t b) { return __uint_as_float(((unsigned)b) << 16); }
__device__ __forceinline__ float bflo(unsigned w) { return __uint_as_float(w << 16); }
__device__ __forceinline__ float bfhi(unsigned w) { return __uint_as_float(w & 0xffff0000u); }
__device__ __forceinline__ bf16_t f2bf(float f) { return (bf16_t)(pk_bf16(f, 0.f) & 0xffffu); }
__device__ __forceinline__ float sigmoidf_(float x) { return __builtin_amdgcn_rcpf(1.0f + __expf(-x)); }
__device__ __forceinline__ void store4bf(bf16_t* ptr, f32x4 v) { u32x2 w; w.x = pk_bf16(v[0], v[1]); w.y = pk_bf16(v[2], v[3]); *(u32x2*)ptr = w; }
__device__ __forceinline__ f32x4 load4bf(const bf16_t* ptr) { u32x2 w = *(const u32x2*)ptr; return (f32x4){bflo(w.x), bfhi(w.x), bflo(w.y), bfhi(w.y)}; }
__device__ __forceinline__ int mod_index(int tok) { return tok < TOKP ? 0 : (tok >> 12) - 1; }
__device__ __forceinline__ float wave_sum(float v) {
#pragma unroll
    for (int o = 32; o >= 1; o >>= 1) v += __shfl_xor(v, o);
    return v;
}

namespace pg8 {
constexpr int BM = 256, BK = 64, HALF = 128, HTB = HALF * BK * 2, STAGE_BYTES = 8 * HTB, NXCD = 8, WGM = 8;
__device__ __forceinline__ int lds_byte(int r, int c) { const int st = (r >> 4) * 2 + (c >> 5), rr = r & 15, cc = c & 31, ob = rr * 64 + cc * 2; return st * 1024 + (ob ^ (((ob >> 9) & 1) << 5)); }
__device__ __forceinline__ void stage_rc(int b, int& R, int& C) { const int st = b / 1024, sb = b % 1024, swz = sb ^ (((sb >> 9) & 1) << 5); R = (st >> 1) * 16 + swz / 64; C = (st & 1) * 32 + (swz % 64) / 2; }

struct Unit { int pm, pn, z, hf; };
struct Gemm { const bf16_t* A; const bf16_t* Bt; int M, N, K, lda; size_t sA, sB; int nz; };
struct Order {
    int nM, nN, nwg, G, c, nz, nfull, rem2;
    __device__ __forceinline__ void init(int M, int N, int nz_, int G_, int c_) { nM = M / BM; nN = N / BM; nwg = nM * nN; G = G_; c = c_; nz = nz_;
        nfull = nwg; rem2 = 0;
        if (nz == 1) { const int full = (nwg / G) * G, rem = nwg - full; if (rem > 0 && 2 * rem <= G) { nfull = full; rem2 = 2 * rem; } } }
    __device__ __forceinline__ void map(int wgid, Unit& u) const {
        { const int q = nwg / NXCD, r = nwg % NXCD, xcd = wgid % NXCD, off = wgid / NXCD; wgid = (xcd < r ? xcd * (q + 1) : r * (q + 1) + (xcd - r) * q) + off; }
        const int nig = WGM * nN, gid = wgid / nig, fm = gid * WGM, gsz = (nM - fm) < WGM ? (nM - fm) : WGM;
        u.pm = fm + ((wgid % nig) % gsz); u.pn = (wgid % nig) / gsz; u.z = 0; }
    __device__ __forceinline__ bool next(int i, Unit& u) const {
        const long L = (long)i * G + c;
        if (nz == 1) {
            if (L < nfull) { map((int)L, u); u.hf = 0; return true; }
            const int t = (int)(L - nfull); if (t >= rem2) return false;
            map(nfull + (t >> 1), u); u.hf = 1 + (t & 1); return true;
        }
        if (L >= (long)nwg * nz) return false;
        const int z = (int)(L / nwg), r = (int)(L % nwg); u.z = z; u.pm = r % nM; u.pn = r / nM; u.hf = 0;
        return true;
    }
};

template <class Epi>
__device__ __forceinline__ void gemm_phase(LAS unsigned char* lds, const Gemm g, const Order& S, const Epi& E) {
    const int tid = tid_(), wid = __builtin_amdgcn_readfirstlane(tid >> 6), lane = tid & 63, wr = wid >> 2, wc = wid & 3, fr = lane & 15, fq = lane >> 4;
    const int K = g.K, nt = K / BK;
    unsigned voffA[2], voffB[2];
#pragma unroll
    for (int i = 0; i < 2; ++i) { int R, C; stage_rc(tid * 16 + i * 8192, R, C); voffA[i] = (unsigned)(R * g.lda + C) * 2u; voffB[i] = (unsigned)(R * K + C) * 2u; }
    const size_t kstep = (size_t)(BK * 2);
    const size_t hstepA = (size_t)HALF * g.lda * 2, hstepB = (size_t)HALF * K * 2;
    const unsigned ldsw = (unsigned)wid * 1024u;
    const int aoff = lds_byte(wr * 64 + fr, fq * 8), boff = lds_byte(wc * 32 + fr, fq * 8);
#define PG8_SA(b, h) (((b) * 2 + (h)) * HTB)
#define PG8_SB(b, h) ((4 + (b) * 2 + (h)) * HTB)
#define PG8_STAGE(bufoff, gbase, voff) do { _Pragma("unroll") for (int _i = 0; _i < 2; ++_i) \
        __builtin_amdgcn_global_load_lds((const unsigned*)((const char*)(gbase) + (voff)[_i]), (LAS unsigned*)(lds + (bufoff) + ldsw + _i * 8192), 16, 0, 0); } while (0)
#define PG8_LDA(dst, b, h) do { _Pragma("unroll") for (int m = 0; m < 4; ++m) _Pragma("unroll") for (int k = 0; k < 2; ++k) dst[m][k] = *(const LAS bf16x8*)(lds + PG8_SA(b, h) + aoff + m * 2048 + k * 1024); } while (0)
#define PG8_LDB(dst, b, h) do { _Pragma("unroll") for (int n = 0; n < 2; ++n) _Pragma("unroll") for (int k = 0; k < 2; ++k) dst[n][k] = *(const LAS bf16x8*)(lds + PG8_SB(b, h) + boff + n * 2048 + k * 1024); } while (0)
#define PG8_MMA(ai, bj, At, Bt) do { __builtin_amdgcn_s_setprio(1); _Pragma("unroll") for (int m = 0; m < 4; ++m) _Pragma("unroll") for (int n = 0; n < 2; ++n) _Pragma("unroll") for (int k = 0; k < 2; ++k) \
        acc[ai][bj][m][n] = __builtin_amdgcn_mfma_f32_16x16x32_bf16(Bt[n][k], At[m][k], acc[ai][bj][m][n], 0, 0, 0); __builtin_amdgcn_s_setprio(0); } while (0)
#define PG8_WAIT_V(n) asm volatile("s_waitcnt vmcnt(" #n ")" ::: "memory")
#define PG8_WAIT_L(n) asm volatile("s_waitcnt lgkmcnt(" #n ")" ::: "memory")
#define PG8_BAR __builtin_amdgcn_s_barrier()
#define PG8_SCHED __builtin_amdgcn_sched_barrier(0)
    Unit cur, nxt; int ui = 0;
    if (!S.next(0, cur)) return;
    f32x4 acc[2][2][4][2];
#pragma unroll
    for (int a = 0; a < 2; ++a)
#pragma unroll
        for (int b = 0; b < 2; ++b)
#pragma unroll
            for (int m = 0; m < 4; ++m)
#pragma unroll
                for (int n = 0; n < 2; ++n) acc[a][b][m][n] = (f32x4){0.f, 0.f, 0.f, 0.f};
    bf16x8 At[4][2], B0[2][2], B1[2][2];
    const char* cA = (const char*)g.A + ((size_t)cur.z * g.sA + (size_t)(cur.pm * BM + (cur.hf == 2 ? HALF : 0)) * g.lda) * 2;
    const char* cB = (const char*)g.Bt + ((size_t)cur.z * g.sB + (size_t)cur.pn * BM * K) * 2;
    PG8_STAGE(PG8_SB(0, 0), cB, voffB); PG8_STAGE(PG8_SB(0, 1), cB + hstepB, voffB); PG8_STAGE(PG8_SA(0, 0), cA, voffA); PG8_STAGE(PG8_SA(0, 1), cA + hstepA, voffA);
    if (wr == 1) PG8_BAR;
    PG8_WAIT_V(2); PG8_BAR;
    PG8_STAGE(PG8_SB(1, 0), cB + kstep, voffB); PG8_STAGE(PG8_SA(1, 0), cA + kstep, voffA); PG8_STAGE(PG8_SB(1, 1), cB + hstepB + kstep, voffB);
    PG8_WAIT_V(6); PG8_BAR;
    for (;;) {
        const bool has_next = S.next(ui + 1, nxt);
        const char* nA = has_next ? (const char*)g.A + ((size_t)nxt.z * g.sA + (size_t)(nxt.pm * BM + (nxt.hf == 2 ? HALF : 0)) * g.lda) * 2 : cA;
        const bool fullu = (cur.hf == 0);
        const char* nB = has_next ? (const char*)g.Bt + ((size_t)nxt.z * g.sB + (size_t)nxt.pn * BM * K) * 2 : cB;
        for (int t = 0; t < nt; t += 2) {
            const bool last = (t == nt - 2);
            const char* a1 = cA + (size_t)(t + 1) * kstep;
            const char* a2 = last ? nA : cA + (size_t)(t + 2) * kstep; const char* b2 = last ? nB : cB + (size_t)(t + 2) * kstep;
            const char* a3 = a2 + kstep; const char* b3 = b2 + kstep;
            PG8_LDB(B0, 0, 0); PG8_LDB(B1, 0, 1); PG8_SCHED; PG8_LDA(At, 0, 0); PG8_STAGE(PG8_SA(1, 1), a1 + hstepA, voffA);
            PG8_WAIT_V(8); PG8_WAIT_L(0); PG8_BAR; PG8_MMA(0, 0, At, B0); PG8_MMA(0, 1, At, B1); PG8_BAR; PG8_SCHED;
            if (fullu) PG8_LDA(At, 0, 1); PG8_STAGE(PG8_SB(0, 0), b2, voffB); PG8_STAGE(PG8_SB(0, 1), b2 + hstepB, voffB); PG8_STAGE(PG8_SA(0, 0), a2, voffA);
            PG8_WAIT_V(8); PG8_WAIT_L(0); PG8_BAR; if (fullu) { PG8_MMA(1, 0, At, B0); PG8_MMA(1, 1, At, B1); } PG8_BAR; PG8_SCHED;
            PG8_LDB(B0, 1, 0); PG8_LDB(B1, 1, 1); PG8_SCHED; PG8_LDA(At, 1, 0); PG8_STAGE(PG8_SA(0, 1), a2 + hstepA, voffA);
            PG8_WAIT_V(8); PG8_WAIT_L(0); PG8_BAR; PG8_MMA(0, 0, At, B0); PG8_MMA(0, 1, At, B1); PG8_BAR; PG8_SCHED;
            if (fullu) PG8_LDA(At, 1, 1); PG8_STAGE(PG8_SB(1, 0), b3, voffB); PG8_STAGE(PG8_SB(1, 1), b3 + hstepB, voffB); PG8_STAGE(PG8_SA(1, 0), a3, voffA);
            PG8_WAIT_V(8); PG8_WAIT_L(0); PG8_BAR; if (fullu) { PG8_MMA(1, 0, At, B0); PG8_MMA(1, 1, At, B1); } PG8_BAR; PG8_SCHED;
        }
        if (wr == 0) PG8_BAR;
        if (fullu) E.template tile<2>(acc, cur.z, cur.pm * BM + wr * 64 + fr, cur.pn * BM + wc * 32 + (Epi::PERM ? 8 : 4) * fq);
        else E.template tile<1>(acc, cur.z, cur.pm * BM + (cur.hf == 2 ? HALF : 0) + wr * 64 + fr, cur.pn * BM + wc * 32 + (Epi::PERM ? 8 : 4) * fq);
        if (!has_next) break;
#pragma unroll
        for (int a = 0; a < 2; ++a)
#pragma unroll
            for (int b = 0; b < 2; ++b)
#pragma unroll
                for (int m = 0; m < 4; ++m)
#pragma unroll
                    for (int n = 0; n < 2; ++n) acc[a][b][m][n] = (f32x4){0.f, 0.f, 0.f, 0.f};
        cur = nxt; cA = nA; cB = nB; ++ui;
        if (wr == 1) PG8_BAR;
    }
    PG8_WAIT_V(0);
    PG8_BAR;
#undef PG8_SA
#undef PG8_SB
#undef PG8_STAGE
#undef PG8_LDA
#undef PG8_LDB
#undef PG8_MMA
#undef PG8_WAIT_V
#undef PG8_WAIT_L
#undef PG8_BAR
#undef PG8_SCHED
}
}

#define EPI_SIMPLE_TILE() \
    static constexpr bool PERM = false; \
    template <int NAI> __device__ __forceinline__ void tile(const f32x4 (&acc)[2][2][4][2], int z, int row0, int col0) const { \
        _Pragma("unroll") for (int ai = 0; ai < NAI; ++ai) _Pragma("unroll") for (int m = 0; m < 4; ++m) _Pragma("unroll") for (int bj = 0; bj < 2; ++bj) _Pragma("unroll") for (int n = 0; n < 2; ++n) \
            (*this)(z, row0 + ai * 128 + m * 16, col0 + bj * 128 + n * 16, acc[ai][bj][m][n]); }
#define EPI_PAIR_TILE() \
    static constexpr bool PERM = true; \
    template <int NAI> __device__ __forceinline__ void tile(const f32x4 (&acc)[2][2][4][2], int z, int row0, int col0) const { \
        _Pragma("unroll") for (int ai = 0; ai < NAI; ++ai) _Pragma("unroll") for (int m = 0; m < 4; ++m) _Pragma("unroll") for (int bj = 0; bj < 2; ++bj) \
            pair(row0 + ai * 128 + m * 16, col0 + bj * 128, acc[ai][bj][m][0], acc[ai][bj][m][1]); }
#define EPI_PIPE_TILE() \
    static constexpr bool PERM = true; \
    template <int NAI> __device__ __forceinline__ void tile(const f32x4 (&acc)[2][2][4][2], int z, int row0, int col0) const { \
        Pre pre; begin(row0, col0, pre); L buf[2][8]; \
        _Pragma("unroll") for (int mm = 0; mm < 2; ++mm) _Pragma("unroll") for (int bj = 0; bj < 2; ++bj) _Pragma("unroll") for (int n = 0; n < 2; ++n) load(row0 + mm * 16, col0 + bj * 128 + n * 4, buf[0][mm * 4 + bj * 2 + n]); \
        _Pragma("unroll") for (int b = 0; b < 2 * NAI; ++b) { \
            if (b < 2 * NAI - 1) { _Pragma("unroll") for (int mm = 0; mm < 2; ++mm) _Pragma("unroll") for (int bj = 0; bj < 2; ++bj) _Pragma("unroll") for (int n = 0; n < 2; ++n) \
                load(row0 + ((b + 1) >> 1) * 128 + (((b + 1) & 1) * 2 + mm) * 16, col0 + bj * 128 + n * 4, buf[(b + 1) & 1][mm * 4 + bj * 2 + n]); } \
            _Pragma("unroll") for (int mm = 0; mm < 2; ++mm) _Pragma("unroll") for (int bj = 0; bj < 2; ++bj) _Pragma("unroll") for (int n = 0; n < 2; ++n) \
                apply(row0 + (b >> 1) * 128 + ((b & 1) * 2 + mm) * 16, col0 + bj * 128 + n * 4, acc[b >> 1][bj][(b & 1) * 2 + mm][n], buf[b & 1][mm * 4 + bj * 2 + n], pre, bj * 2 + n); } }
__device__ __forceinline__ void store8bf(bf16_t* ptr, f32x4 a, f32x4 b) { u32x4 w; w.x = pk_bf16(a[0], a[1]); w.y = pk_bf16(a[2], a[3]); w.z = pk_bf16(b[0], b[1]); w.w = pk_bf16(b[2], b[3]); *(u32x4*)ptr = w; }

struct EpiPartA {
    bf16_t* Q; bf16_t* Kk; bf16_t* V; bf16_t* UG; float* GLR;
    __device__ __forceinline__ void pair(int row, int col, f32x4 a, f32x4 b) const {
        if (col < 512) store8bf(Q + (size_t)row * 512 + col, a, b);
        else if (col < 1024) store8bf(Kk + (size_t)row * 512 + (col - 512), a, b);
        else if (col < 2048) store8bf(V + (size_t)row * 1024 + (col - 1024), a, b);
        else if (col < 2304) { const int c = col - 2048; if (c < 32) { *(f32x4*)(GLR + (size_t)row * 32 + c) = a; *(f32x4*)(GLR + (size_t)row * 32 + c + 4) = b; } }
        else { const int c = col - 2304, g = c >> 4, n = c & 15, chunk = row >> 5, j = row & 31; store8bf(UG + ((size_t)(g * 1280 + chunk) * 768 + j * 16 + n), a, b); }
    }
    EPI_PAIR_TILE()
};
struct EpiE { float* E; __device__ __forceinline__ void operator()(int z, int row, int col, f32x4 v) const { *(f32x4*)(E + ((size_t)(z * 1280 + row) * 256 + col)) = v; } EPI_SIMPLE_TILE() };
struct EpiY {
    bf16_t* YB;
    __device__ __forceinline__ void operator()(int z, int row, int col, f32x4 v) const {
        const int tok = row * 32 + (col >> 4), ch = z * 16 + (col & 15);
        f32x4 o;
#pragma unroll
        for (int e = 0; e < 4; ++e) { const float x = v[e]; o[e] = x * sigmoidf_(1.5957691216f * (x + 0.044715f * x * x * x)); }
        store4bf(YB + (size_t)tok * 512 + ch, o);
    }
    EPI_SIMPLE_TILE()
};
struct EpiGLU {
    const bf16_t* YB; bf16_t* OS5; const float* bglu;
    typedef u32x2 L; struct Pre { f32x4 b[4]; };
    __device__ __forceinline__ void begin(int, int col0, Pre& pr) const {
#pragma unroll
        for (int k = 0; k < 4; ++k) pr.b[k] = *(const f32x4*)(bglu + col0 + (k >> 1) * 128 + (k & 1) * 4); }
    __device__ __forceinline__ void load(int row, int col, L& l) const { l = *(const u32x2*)(YB + (size_t)row * 512 + col); }
    __device__ __forceinline__ void apply(int row, int col, f32x4 v, const L& l, const Pre& pr, int k) const {
        const f32x4 y = (f32x4){bflo(l.x), bfhi(l.x), bflo(l.y), bfhi(l.y)}; f32x4 o;
#pragma unroll
        for (int e = 0; e < 4; ++e) o[e] = y[e] * sigmoidf_(v[e] + pr.b[k][e]);
        store4bf(OS5 + (size_t)row * 512 + col, o); }
    EPI_PIPE_TILE()
};
struct EpiPartB {
    bf16_t* R; bf16_t* GA; bf16_t* GB;
    __device__ __forceinline__ void pair(int row, int col, f32x4 a, f32x4 b) const {
        f32x4 sa, sb;
#pragma unroll
        for (int e = 0; e < 4; ++e) { sa[e] = sigmoidf_(a[e]); sb[e] = sigmoidf_(b[e]); }
        if (col < 1024) store8bf(R + (size_t)row * 1024 + col, a * sa, b * sb);
        else if (col < 2048) store8bf(GA + (size_t)row * 1024 + (col - 1024), sa, sb);
        else store8bf(GB + (size_t)row * 1024 + (col - 2048), sa, sb);
    }
    EPI_PAIR_TILE()
};
struct EpiProj1 { const bf16_t* GA; bf16_t* T1;
    typedef u32x2 L; struct Pre { int dummy; };
    __device__ __forceinline__ void begin(int, int, Pre&) const {}
    __device__ __forceinline__ void load(int row, int col, L& l) const { l = *(const u32x2*)(GA + (size_t)row * 1024 + col); }
    __device__ __forceinline__ void apply(int row, int col, f32x4 v, const L& l, const Pre&, int) const {
        const f32x4 g = (f32x4){bflo(l.x), bfhi(l.x), bflo(l.y), bfhi(l.y)}; store4bf(T1 + (size_t)row * 1024 + col, g * v); }
    EPI_PIPE_TILE()
};
struct EpiProj2 { const bf16_t* GB; bf16_t* T1;
    struct L { u32x2 t, g; }; struct Pre { int dummy; };
    __device__ __forceinline__ void begin(int, int, Pre&) const {}
    __device__ __forceinline__ void load(int row, int col, L& l) const { const size_t o = (size_t)row * 1024 + col; l.t = *(const u32x2*)(T1 + o); l.g = *(const u32x2*)(GB + o); }
    __device__ __forceinline__ void apply(int row, int col, f32x4 v, const L& l, const Pre&, int) const {
        const f32x4 g = (f32x4){bflo(l.g.x), bfhi(l.g.x), bflo(l.g.y), bfhi(l.g.y)}, t = (f32x4){bflo(l.t.x), bfhi(l.t.x), bflo(l.t.y), bfhi(l.t.y)};
        store4bf(T1 + (size_t)row * 1024 + col, t + g * v); }
    EPI_PIPE_TILE()
};
struct EpiDelta { bf16_t* Dl; const float* gate;
    static constexpr bool PERM = true;
    template <int NAI> __device__ __forceinline__ void tile(const f32x4 (&acc)[2][2][4][2], int, int row0, int col0) const {
        const float* gp = gate + (size_t)mod_index(row0) * 6144 + col0; f32x4 g[2][2];
#pragma unroll
        for (int bj = 0; bj < 2; ++bj)
#pragma unroll
            for (int n = 0; n < 2; ++n) g[bj][n] = *(const f32x4*)(gp + bj * 128 + n * 4);
#pragma unroll
        for (int ai = 0; ai < NAI; ++ai)
#pragma unroll
            for (int m = 0; m < 4; ++m)
#pragma unroll
                for (int bj = 0; bj < 2; ++bj) store8bf(Dl + (size_t)(row0 + ai * 128 + m * 16) * 1024 + col0 + bj * 128, g[bj][0] * acc[ai][bj][m][0], g[bj][1] * acc[ai][bj][m][1]);
    } };
struct EpiFF1 { bf16_t* H;
    __device__ __forceinline__ void pair(int row, int col, f32x4 a, f32x4 b) const {
        f32x4 oa, ob;
#pragma unroll
        for (int e = 0; e < 4; ++e) { const float ra = fmaxf(a[e], 0.f), rb = fmaxf(b[e], 0.f); oa[e] = ra * ra; ob[e] = rb * rb; }
        store8bf(H + (size_t)row * 4096 + col, oa, ob); }
    EPI_PAIR_TILE()
};

struct ConvJob { const float* src; int ld, K, c0, nvalid, ndst; bf16_t* dst; float scale; };
__device__ __forceinline__ bool conv_job(const P& p, int l, int j, ConvJob& J) {
    bf16_t* W = (bf16_t*)(p.ws + WS_W);
    const float* win = p.in[lnd(10)] + (size_t)l * 1024 * 5664;
    J.scale = 1.0f;
    switch (j) {
        case 0: J = {win, 5664, 1024, 0, 512, 512, W + W_A / 2, 0.08838834764831845f}; break;
        case 1: J = {win, 5664, 1024, 512, 512, 512, W + W_A / 2 + (size_t)512 * 1024, 1.f}; break;
        case 2: J = {win, 5664, 1024, 1024, 1024, 1024, W + W_A / 2 + (size_t)1024 * 1024, 1.f}; break;
        case 3: J = {win, 5664, 1024, 3072, 32, 256, W + W_A / 2 + (size_t)2048 * 1024, 1.f}; break;
        case 4: J = {win, 5664, 1024, 3104, 512, 512, W + W_A / 2 + (size_t)2304 * 1024, 1.f}; break;
        case 5: J = {win, 5664, 1024, 2048, 1024, 1024, W + W_B / 2, 1.f}; break;
        case 6: J = {win, 5664, 1024, 3616, 1024, 1024, W + W_B / 2 + (size_t)1024 * 1024, 1.f}; break;
        case 7: J = {win, 5664, 1024, 4640, 1024, 1024, W + W_B / 2 + (size_t)2048 * 1024, 1.f}; break;
        case 8: J = {p.in[lnd(14)] + (size_t)l * 1024 * 1024, 1024, 1024, 0, 1024, 1024, W + W_PG / 2, 1.f}; break;
        case 9: J = {p.in[lnd(23)] + (size_t)l * 512 * 512, 512, 512, 0, 512, 512, W + W_GLU / 2, 1.f}; break;
        case 10: J = {p.in[lnd(25)] + (size_t)l * 512 * 1024, 1024, 512, 0, 1024, 1024, W + W_PS / 2, 1.f}; break;
        case 11: J = {p.in[lnd(26)] + (size_t)l * 1024 * 1024, 1024, 1024, 0, 1024, 1024, W + W_OUT / 2, 1.f}; break;
        case 12: J = {p.in[lnd(28)] + (size_t)l * 1024 * 4096, 4096, 1024, 0, 4096, 4096, W + W_1 / 2, 1.f}; break;
        case 13: J = {p.in[lnd(29)] + (size_t)l * 4096 * 1024, 1024, 4096, 0, 1024, 1024, W + W_2 / 2, 1.f}; break;
        default: return false;
    }
    return true;
}
constexpr int CONV_TILES = 2112;
__device__ __forceinline__ void conv_tile(const P& p, int l, int tile, LAS float* sT) {
    const int tid = tid_();
    ConvJob J; int j = 0, rem = tile;
    for (; j < 14; ++j) { conv_job(p, l, j, J); const int nt = (J.ndst / 64) * (J.K / 128); if (rem < nt) break; rem -= nt; }
    const int kts = J.K / 128, ntile = rem / kts, ktile = rem % kts, n0 = ntile * 64, k0 = ktile * 128;
    {
        const int kk = tid >> 4, c4 = (tid & 15) * 4; f32x4 v[4];
#pragma unroll
        for (int i = 0; i < 4; ++i) { v[i] = (f32x4){0.f, 0.f, 0.f, 0.f};
            if (n0 + c4 < J.nvalid) v[i] = *(const f32x4*)(J.src + (size_t)(k0 + kk + 32 * i) * J.ld + J.c0 + n0 + c4); }
#pragma unroll
        for (int i = 0; i < 4; ++i)
#pragma unroll
            for (int e = 0; e < 4; ++e) sT[(c4 + e) * 129 + kk + 32 * i] = v[i][e] * J.scale;
    }
    __syncthreads();
    {
        const int n = tid >> 3, ks = (tid & 7) * 16;
        const int rho = n & 31, nsrc = (n & ~31) + 8 * ((rho & 15) >> 2) + 4 * (rho >> 4) + (rho & 3);
        const LAS float* sp = sT + nsrc * 129 + ks;
#pragma unroll
        for (int hh = 0; hh < 2; ++hh) { u32x4 w; const LAS float* q = sp + 8 * hh;
            w.x = pk_bf16(q[0], q[1]); w.y = pk_bf16(q[2], q[3]); w.z = pk_bf16(q[4], q[5]); w.w = pk_bf16(q[6], q[7]);
            *(u32x4*)(J.dst + (size_t)(n0 + n) * J.K + k0 + ks + 8 * hh) = w; }
    }
}

__device__ __forceinline__ void mod_task(const P& p, int m, LAS float* sm) {
    const int tid = tid_(), l = m / 192, colbase = (m % 192) * 32, cl = tid & 31, ks = tid >> 5;
    LAS float* SC = sm; LAS float* RED = sm + 9216;
    for (int i = tid; i < 9216; i += NTHR) { const int j = i >> 10, k = i & 1023; const float c = (j == 0) ? p.in[lnd(6)][k] : p.in[lnd(2)][(j - 1) * 1024 + k]; SC[i] = c * sigmoidf_(c); }
    __syncthreads();
    float acc[9];
#pragma unroll
    for (int j = 0; j < 9; ++j) acc[j] = 0.f;
    const float* w = p.in[lnd(7)] + (size_t)l * 1024 * 6144 + colbase + cl;
    for (int k8 = 0; k8 < 64; k8 += 16) { float wv[16];
#pragma unroll
        for (int u = 0; u < 16; ++u) wv[u] = w[(size_t)(ks * 64 + k8 + u) * 6144];
#pragma unroll
        for (int u = 0; u < 16; ++u)
#pragma unroll
            for (int j = 0; j < 9; ++j) acc[j] += SC[j * 1024 + ks * 64 + k8 + u] * wv[u]; }
#pragma unroll
    for (int j = 0; j < 9; ++j) RED[(ks * 9 + j) * 32 + cl] = acc[j];
    __syncthreads();
    if (tid < 288) { const int j = tid >> 5, c = tid & 31; float s = 0.f;
#pragma unroll
        for (int q = 0; q < 16; ++q) s += RED[(q * 9 + j) * 32 + c];
        float* mod = (float*)(p.ws + WS_MOD);
        mod[((size_t)l * 9 + j) * 6144 + colbase + c] = s + p.in[lnd(8)][(size_t)l * 6144 + colbase + c]; }
}

__device__ __forceinline__ void s5_mats(const P& p, int l, int gq, LAS float* sm) {
    const int tid = tid_(), g = gq >> 2, part = gq & 3;
    LAS float* KF = sm; LAS float* KB = sm + 8192; LAS float* LT = sm + 16384; LAS float* CC = sm + 20608; LAS float* BB = sm + 22656;
    bf16_t* MC = (bf16_t*)(p.ws + WS_R1) + (size_t)g * 512 * 768;
    bf16_t* EM = (bf16_t*)(p.ws + WS_EMAT) + (size_t)g * 256 * 512;
    for (int d = 0; d < 2; ++d) {
        const int pg = (l * 2 + d) * 32 + g;
        const float* lamr = p.in[lnd(15)] + (size_t)pg * 64; const float* lami = p.in[lnd(16)] + (size_t)pg * 64;
        const float dt = expf(p.in[lnd(17)][pg]);
        const float* bre = p.in[lnd(18)] + (size_t)pg * 1024; const float* bim = p.in[lnd(19)] + (size_t)pg * 1024;
        const float* cre = p.in[lnd(20)] + (size_t)pg * 1024; const float* cim = p.in[lnd(21)] + (size_t)pg * 1024;
        for (int i = tid; i < 33 * 64; i += NTHR) { const int tau = i >> 6, pp = i & 63; const float a = expf(lamr[pp] * dt * (float)tau); float s, c; sincosf(lami[pp] * dt * (float)tau, &s, &c); LT[2 * i] = a * c; LT[2 * i + 1] = a * s; }
        for (int i = tid; i < 1024; i += NTHR) { CC[2 * i] = cre[i]; CC[2 * i + 1] = cim[i]; }
        for (int i = tid; i < 1024; i += NTHR) {
            const int pp = i >> 4; const float lr = lamr[pp], li = lami[pp]; float s, c; sincosf(li * dt, &s, &c);
            const float em1 = expm1f(lr * dt); float sh, ch; sincosf(0.5f * li * dt, &sh, &ch);
            const float nr = em1 * c - 2.f * sh * sh, ni = (em1 + 1.f) * s;
            const float inv = 1.f / (lr * lr + li * li);
            const float qr = (nr * lr + ni * li) * inv, qi = (ni * lr - nr * li) * inv;
            const float br = bre[i], bi = bim[i];
            BB[2 * i] = qr * br - qi * bi; BB[2 * i + 1] = qr * bi + qi * br;
        }
        __syncthreads();
        {
            const int tau = tid >> 4, n = tid & 15; float acc[16];
#pragma unroll
            for (int m = 0; m < 16; ++m) acc[m] = 0.f;
            const bool need = d == 0 ? (tau <= 31 - 8 * part) : (tau <= 8 * part + 7);
            if (need) for (int pp = 0; pp < 64; ++pp) {
                const float cr = CC[2 * (n * 64 + pp)], ci = CC[2 * (n * 64 + pp) + 1], lr = LT[2 * (tau * 64 + pp)], li = LT[2 * (tau * 64 + pp) + 1];
                const float xr = cr * lr - ci * li, xi = cr * li + ci * lr;
#pragma unroll
                for (int m = 0; m < 16; ++m) acc[m] += xr * BB[2 * (pp * 16 + m)] - xi * BB[2 * (pp * 16 + m) + 1];
            }
            LAS float* Kd = d ? KB : KF;
#pragma unroll
            for (int m = 0; m < 16; ++m) Kd[(tau * 16 + n) * 16 + m] = acc[m];
        }
        {
            const int pp = tid >> 3, cseg = tid & 7;
            { const int jj = part;
                const int j = cseg * 4 + jj, e = d == 0 ? 31 - j : j; const float lr = LT[2 * (e * 64 + pp)], li = LT[2 * (e * 64 + pp) + 1];
                float re[16], im[16];
#pragma unroll
                for (int m = 0; m < 16; ++m) { const float br = BB[2 * (pp * 16 + m)], bi = BB[2 * (pp * 16 + m) + 1]; re[m] = lr * br - li * bi; im[m] = lr * bi + li * br; }
                bf16_t* er = EM + (size_t)(d * 128 + pp) * 512 + j * 16; bf16_t* ei = EM + (size_t)(d * 128 + 64 + pp) * 512 + j * 16;
#pragma unroll
                for (int h = 0; h < 2; ++h) {
                    u32x4 w; w.x = pk_bf16(re[8 * h], re[8 * h + 1]); w.y = pk_bf16(re[8 * h + 2], re[8 * h + 3]); w.z = pk_bf16(re[8 * h + 4], re[8 * h + 5]); w.w = pk_bf16(re[8 * h + 6], re[8 * h + 7]); *(u32x4*)(er + 8 * h) = w;
                    u32x4 x; x.x = pk_bf16(im[8 * h], im[8 * h + 1]); x.y = pk_bf16(im[8 * h + 2], im[8 * h + 3]); x.z = pk_bf16(im[8 * h + 4], im[8 * h + 5]); x.w = pk_bf16(im[8 * h + 6], im[8 * h + 7]); *(u32x4*)(ei + 8 * h) = x;
                }
            }
        }
        {
            const int t = tid >> 4, n = tid & 15, f = d == 0 ? t + 1 : 32 - t;
            bf16_t* mr = MC + (size_t)tid * 768 + 512 + d * 128;
#pragma unroll 1
            for (int p8 = 2 * part; p8 < 2 * part + 2; ++p8) {
                float re[8], im[8];
#pragma unroll
                for (int q = 0; q < 8; ++q) { const int pp = p8 * 8 + q; const float cr = CC[2 * (n * 64 + pp)], ci = CC[2 * (n * 64 + pp) + 1], lr = LT[2 * (f * 64 + pp)], li = LT[2 * (f * 64 + pp) + 1];
                    re[q] = cr * lr - ci * li; im[q] = -(cr * li + ci * lr); }
                u32x4 w; w.x = pk_bf16(re[0], re[1]); w.y = pk_bf16(re[2], re[3]); w.z = pk_bf16(re[4], re[5]); w.w = pk_bf16(re[6], re[7]); *(u32x4*)(mr + p8 * 8) = w;
                u32x4 x; x.x = pk_bf16(im[0], im[1]); x.y = pk_bf16(im[2], im[3]); x.z = pk_bf16(im[4], im[5]); x.w = pk_bf16(im[6], im[7]); *(u32x4*)(mr + 64 + p8 * 8) = x;
            }
        }
        __syncthreads();
    }
    {
        const int t = tid >> 4, n = tid & 15; const float dsk = p.in[lnd(22)][(size_t)l * 512 + g * 16 + n];
        bf16_t* mr = MC + (size_t)tid * 768;
#pragma unroll 1
        for (int j = 8 * part; j < 8 * part + 8; ++j) {
            float v[16];
#pragma unroll
            for (int m = 0; m < 16; ++m) v[m] = 0.f;
            if (j <= t) { const LAS float* k = KF + ((t - j) * 16 + n) * 16;
#pragma unroll
                for (int m = 0; m < 16; ++m) v[m] += k[m]; }
            if (j >= t) { const LAS float* k = KB + ((j - t) * 16 + n) * 16;
#pragma unroll
                for (int m = 0; m < 16; ++m) v[m] += k[m]; }
            if (j == t) {
#pragma unroll
                for (int m = 0; m < 16; ++m) v[m] += (m == n) ? dsk : 0.f; }
            u32x4 w; w.x = pk_bf16(v[0], v[1]); w.y = pk_bf16(v[2], v[3]); w.z = pk_bf16(v[4], v[5]); w.w = pk_bf16(v[6], v[7]); *(u32x4*)(mr + j * 16) = w;
            u32x4 x; x.x = pk_bf16(v[8], v[9]); x.y = pk_bf16(v[10], v[11]); x.z = pk_bf16(v[12], v[13]); x.w = pk_bf16(v[14], v[15]); *(u32x4*)(mr + j * 16 + 8) = x;
        }
    }
}

__device__ __forceinline__ void phase_prep(const P& p, int l, LAS unsigned char* lds) {
    LAS float* sm = (LAS float*)lds;
    const int b = bid_(), G = gridDim.x, ha = G >> 1;
    if (b < ha) { for (int t = b; t < 128; t += ha) { s5_mats(p, l, t, sm); __syncthreads(); } }
    else { for (int t = b - ha; t < CONV_TILES; t += G - ha) { conv_tile(p, l, t, sm); __syncthreads(); } }
    if (l == 0) for (int t = b; t < 384; t += G) { mod_task(p, t, sm); __syncthreads(); }
}

__device__ __forceinline__ void norm_row_write(const f32x4 (&x)[4], const float* g, const float* mod, int shoff, int scoff, bf16_t* hrow, int lane) {
    float ss = 0.f;
#pragma unroll
    for (int i = 0; i < 4; ++i) ss += x[i][0] * x[i][0] + x[i][1] * x[i][1] + x[i][2] * x[i][2] + x[i][3] * x[i][3];
    ss = wave_sum(ss);
    const float rstd = rsqrtf(ss * (1.0f / 1024.0f) + 1e-6f);
#pragma unroll
    for (int i = 0; i < 4; ++i) { const int d = i * 256 + lane * 4; const f32x4 gg = *(const f32x4*)(g + d), sc = *(const f32x4*)(mod + scoff + d), sh = *(const f32x4*)(mod + shoff + d);
        f32x4 h;
#pragma unroll
        for (int e = 0; e < 4; ++e) h[e] = x[i][e] * rstd * gg[e] * (1.f + sc[e]) + sh[e];
        { u32x2 w; w.x = pk_bf16(h[0], h[1]); w.y = pk_bf16(h[2], h[3]); __builtin_nontemporal_store(w, (u32x2*)(hrow + d)); } }
}
__device__ __forceinline__ void phase_norm(const P& p, int l, int which) {
    const int lane = tid_() & 63, gw = bid_() * 8 + (tid_() >> 6), nw = gridDim.x * 8;
    const float* g = (which == 1 ? p.in[lnd(9)] : p.in[lnd(27)]) + (size_t)l * 1024;
    const float* modl = (const float*)(p.ws + WS_MOD) + (size_t)l * 9 * 6144;
    const int shoff = which == 1 ? 0 : 3072, scoff = which == 1 ? 1024 : 4096;
    bf16_t* H = (bf16_t*)(p.ws + WS_R2); float* X = p.out;
    if (which == 1 && l == 0) {
        for (int item = gw; item < 4096 + 8192; item += nw) {
            if (item < 4096) {
                const int n = item; const float rr = (float)(n >> 6), cc = (float)(n & 63); f32x4 pe[4];
#pragma unroll
                for (int e = 0; e < 4; ++e) { const float om = expf(-(float)(lane * 4 + e) * (9.210340371976184f / 256.0f)); float s, c; sincosf(rr * om, &s, &c); pe[0][e] = s; pe[1][e] = c; sincosf(cc * om, &s, &c); pe[2][e] = s; pe[3][e] = c; }
                for (int b0 = 0; b0 < 8; b0 += 2) { f32x4 x[2][4];
#pragma unroll
                    for (int r = 0; r < 2; ++r) { const float* src = p.in[lnd(1)] + ((size_t)(b0 + r) * 4096 + n) * 1024;
#pragma unroll
                        for (int i = 0; i < 4; ++i) x[r][i] = *(const f32x4*)(src + i * 256 + lane * 4); }
#pragma unroll
                    for (int r = 0; r < 2; ++r) { const int row = TOKP + (b0 + r) * 4096 + n;
#pragma unroll
                        for (int i = 0; i < 4; ++i) { x[r][i] = x[r][i] + pe[i]; *(f32x4*)(X + (size_t)row * 1024 + i * 256 + lane * 4) = x[r][i]; }
                        norm_row_write(x[r], g, modl + (size_t)(1 + b0 + r) * 6144, shoff, scoff, H + (size_t)row * 1024, lane); } }
            } else { const int row = item - 4096; const float* src = p.in[lnd(0)] + (size_t)row * 1024; f32x4 x[4];
#pragma unroll
                for (int i = 0; i < 4; ++i) { x[i] = *(const f32x4*)(src + i * 256 + lane * 4); *(f32x4*)(X + (size_t)row * 1024 + i * 256 + lane * 4) = x[i]; }
                norm_row_write(x, g, modl, shoff, scoff, H + (size_t)row * 1024, lane); }
        }
    } else {
        const bf16_t* DL = (const bf16_t*)(p.ws + (which == 1 ? WS_R2 : WS_R3));
        for (int it = gw; it < TOK / 4; it += nw) {
            const int rowb = it * 4; const float* mod = modl + (size_t)mod_index(rowb) * 6144;
            f32x4 x[4][4]; u32x2 dv[4][4];
#pragma unroll
            for (int r = 0; r < 4; ++r)
#pragma unroll
                for (int i = 0; i < 4; ++i) { x[r][i] = __builtin_nontemporal_load((const f32x4*)(X + (size_t)(rowb + r) * 1024 + i * 256 + lane * 4)); dv[r][i] = __builtin_nontemporal_load((const u32x2*)(DL + (size_t)(rowb + r) * 1024 + i * 256 + lane * 4)); }
            f32x4 gs[4], sh[4];
#pragma unroll
            for (int i = 0; i < 4; ++i) { const int d = i * 256 + lane * 4; const f32x4 gg = *(const f32x4*)(g + d), sc = *(const f32x4*)(mod + scoff + d); sh[i] = *(const f32x4*)(mod + shoff + d); gs[i] = gg * (sc + 1.f); }
#pragma unroll
            for (int r = 0; r < 4; ++r) { float ss = 0.f;
#pragma unroll
                for (int i = 0; i < 4; ++i) { x[r][i] = x[r][i] + (f32x4){bflo(dv[r][i].x), bfhi(dv[r][i].x), bflo(dv[r][i].y), bfhi(dv[r][i].y)}; *(f32x4*)(X + (size_t)(rowb + r) * 1024 + i * 256 + lane * 4) = x[r][i];
                    ss += x[r][i][0] * x[r][i][0] + x[r][i][1] * x[r][i][1] + x[r][i][2] * x[r][i][2] + x[r][i][3] * x[r][i][3]; }
                ss = wave_sum(ss); const float rstd = rsqrtf(ss * (1.0f / 1024.0f) + 1e-6f);
#pragma unroll
                for (int i = 0; i < 4; ++i) { const f32x4 hv = x[r][i] * rstd * gs[i] + sh[i]; u32x2 w; w.x = pk_bf16(hv[0], hv[1]); w.y = pk_bf16(hv[2], hv[3]); __builtin_nontemporal_store(w, (u32x2*)(H + (size_t)(rowb + r) * 1024 + i * 256 + lane * 4)); } }
        }
    }
}
__device__ __forceinline__ void phase_final(const P& p) {
    const int lane = tid_() & 63, gw = bid_() * 8 + (tid_() >> 6), nw = gridDim.x * 8; float* X = p.out; const float* g = p.in[lnd(30)]; const bf16_t* DL = (const bf16_t*)(p.ws + WS_R2);
    for (int row0 = gw; row0 < TOK; row0 += 4 * nw) {
        f32x4 x[4][4]; u32x2 dv[4][4];
#pragma unroll
        for (int r = 0; r < 4; ++r) { const int row = row0 + r * nw;
            if (row < TOK) {
#pragma unroll
                for (int i = 0; i < 4; ++i) { x[r][i] = __builtin_nontemporal_load((const f32x4*)(X + (size_t)row * 1024 + i * 256 + lane * 4)); dv[r][i] = __builtin_nontemporal_load((const u32x2*)(DL + (size_t)row * 1024 + i * 256 + lane * 4)); } } }
#pragma unroll
        for (int r = 0; r < 4; ++r) { const int row = row0 + r * nw;
            if (row < TOK) { float ss = 0.f;
#pragma unroll
                for (int i = 0; i < 4; ++i) { x[r][i] = x[r][i] + (f32x4){bflo(dv[r][i].x), bfhi(dv[r][i].x), bflo(dv[r][i].y), bfhi(dv[r][i].y)}; ss += x[r][i][0] * x[r][i][0] + x[r][i][1] * x[r][i][1] + x[r][i][2] * x[r][i][2] + x[r][i][3] * x[r][i][3]; }
                ss = wave_sum(ss); const float rstd = rsqrtf(ss * (1.0f / 1024.0f) + 1e-6f);
#pragma unroll
                for (int i = 0; i < 4; ++i) { const f32x4 gg = *(const f32x4*)(g + i * 256 + lane * 4); *(f32x4*)(X + (size_t)row * 1024 + i * 256 + lane * 4) = x[r][i] * rstd * gg; } } }
    }
}

__device__ __forceinline__ void phase_s5scan(const P& p, int l) {
    const float* E = (const float*)(p.ws + WS_E); bf16_t* UG = (bf16_t*)(p.ws + WS_R5);
    float* ore = p.out + (size_t)TOK * 1024 + 16777216; float* oim = ore + 262144;
    for (int task = bid_(); task < 320; task += gridDim.x) {
        const int idx = task * NTHR + tid_(), pp = idx & 63, d = (idx >> 6) & 1, g = (idx >> 7) & 31, s = 39 - (idx >> 12);
        const int nch = s < 32 ? 8 : 128, cbase = s < 32 ? s * 8 : 256 + (s - 32) * 128;
        const int pg = (l * 2 + d) * 32 + g; const float dt = expf(p.in[lnd(17)][pg]);
        const float a = expf(p.in[lnd(15)][(size_t)pg * 64 + pp] * dt * 32.f); float sn, cs; sincosf(p.in[lnd(16)][(size_t)pg * 64 + pp] * dt * 32.f, &sn, &cs);
        const float ar = a * cs, ai = a * sn;
        float sr = 0.f, si = 0.f;
        if (s >= 32) { const size_t o = ((((size_t)(s - 32) * 2 + l) * 2 + d) * 32 + g) * 64 + pp; sr = p.in[lnd(4)][o]; si = p.in[lnd(5)][o]; }
        const float* Eb = E + ((size_t)(g * 1280 + cbase) * 256 + d * 128 + pp);
        bf16_t* Ub = UG + ((size_t)(g * 1280 + cbase) * 768 + 512 + d * 128 + pp);
        for (int c0 = 0; c0 < nch; c0 += 8) {
            float er[8], ei[8];
#pragma unroll
            for (int k = 0; k < 8; ++k) { const int c = d == 0 ? c0 + k : nch - 1 - (c0 + k); er[k] = Eb[(size_t)c * 256]; ei[k] = Eb[(size_t)c * 256 + 64]; }
#pragma unroll
            for (int k = 0; k < 8; ++k) { const int c = d == 0 ? c0 + k : nch - 1 - (c0 + k);
                Ub[(size_t)c * 768] = f2bf(sr); Ub[(size_t)c * 768 + 64] = f2bf(si);
                const float nr = ar * sr - ai * si + er[k], ni = ar * si + ai * sr + ei[k]; sr = nr; si = ni; }
        }
        if (s < 32) { const size_t o = ((((size_t)s * 2 + l) * 2 + d) * 32 + g) * 64 + pp; ore[o] = sr; oim[o] = si; }
    }
}

__device__ __forceinline__ void phase_glapre(const P& p, int l, LAS unsigned char* lds) {
    const int tid = tid_(), d = tid & 127, tq = tid >> 7, wv = tid >> 6, lane = tid & 63, fr = lane & 15, fq = lane >> 4;
    LAS float* sG = (LAS float*)lds; LAS float* sT4 = sG + 2048; LAS float* sZ = sG + 2560;
    bf16_t* Q = (bf16_t*)(p.ws + WS_R3); bf16_t* Kk = Q + (size_t)TOK * 512;
    bf16_t* QB = (bf16_t*)(p.ws + WS_R5); bf16_t* KB = QB + (size_t)TOK * 512;
    const float* GLR = (const float*)(p.ws + WS_GLR);
    for (int task = bid_(); task < 2560; task += gridDim.x) {
        const int c64 = task >> 2, h = task & 3, tb = c64 * 64;
        { const int row = tid >> 3, c4 = (tid & 7) * 4; *(LAS f32x4*)(sG + row * 32 + c4) = *(const f32x4*)(GLR + (size_t)(tb + row) * 32 + c4); }
        float qv[16], kv[16];
#pragma unroll
        for (int i = 0; i < 16; ++i) { const size_t o = (size_t)(tb + tq * 16 + i) * 512 + h * 128 + d; qv[i] = bf2f(Q[o]); kv[i] = bf2f(Kk[o]); }
        bf16x8 bw[2];
#pragma unroll
        for (int dir = 0; dir < 2; ++dir) { float w8[8];
#pragma unroll
            for (int e = 0; e < 8; ++e) { const int kk = 8 * fq + e - 16 * dir; w8[e] = (kk >= 0 && kk < 16) ? p.in[lnd(11)][((size_t)(l * 2 + dir) * 16 + kk) * 512 + h * 128 + 16 * wv + fr] : 0.f; }
            u32x4 pk; pk.x = pk_bf16(w8[0], w8[1]); pk.y = pk_bf16(w8[2], w8[3]); pk.z = pk_bf16(w8[4], w8[5]); pk.w = pk_bf16(w8[6], w8[7]);
            bw[dir] = __builtin_bit_cast(bf16x8, pk); }
        __syncthreads();
#pragma unroll
        for (int ti = 0; ti < 4; ++ti) {
            const LAS float* gr = sG + (16 * ti + fr) * 32 + 8 * fq; const f32x4 g0 = *(const LAS f32x4*)gr, g1 = *(const LAS f32x4*)(gr + 4);
            u32x4 pk; pk.x = pk_bf16(g0[0], g0[1]); pk.y = pk_bf16(g0[2], g0[3]); pk.z = pk_bf16(g1[0], g1[1]); pk.w = pk_bf16(g1[2], g1[3]);
            const bf16x8 af = __builtin_bit_cast(bf16x8, pk);
#pragma unroll
            for (int dir = 0; dir < 2; ++dir) { const f32x4 z = __builtin_amdgcn_mfma_f32_16x16x32_bf16(af, bw[dir], (f32x4){0.f, 0.f, 0.f, 0.f}, 0, 0, 0);
#pragma unroll
                for (int e = 0; e < 4; ++e) sZ[(dir * 64 + 16 * ti + 4 * fq + e) * 128 + 16 * wv + fr] = z[e]; }
        }
        __syncthreads();
#pragma unroll 1
        for (int dir = 0; dir < 2; ++dir) {
            const float bg = p.in[lnd(12)][(size_t)(l * 2 + dir) * 512 + h * 128 + d];
            float cum[16];
#pragma unroll
            for (int i = 0; i < 16; ++i) { const float z = sZ[(dir * 64 + tq * 16 + i) * 128 + d] + bg;
                cum[i] = (fminf(z, 0.f) - __logf(1.0f + __expf(-fabsf(z)))) * 0.0625f; }
            if (dir == 0) {
#pragma unroll
                for (int i = 1; i < 16; ++i) cum[i] += cum[i - 1];
            } else {
#pragma unroll
                for (int i = 14; i >= 0; --i) cum[i] += cum[i + 1];
            }
            sT4[tq * 128 + d] = dir == 0 ? cum[15] : cum[0];
            __syncthreads();
            float off = 0.f, total = 0.f;
#pragma unroll
            for (int q = 0; q < 4; ++q) { const float v = sT4[q * 128 + d]; total += v; if (dir == 0 ? (q < tq) : (q > tq)) off += v; }
            bf16_t* QD = dir == 0 ? Q : QB; bf16_t* KI = dir == 0 ? Kk : KB;
#pragma unroll
            for (int i = 0; i < 16; ++i) { const float cm = cum[i] + off; const size_t o = (size_t)(tb + tq * 16 + i) * 512 + h * 128 + d;
                QD[o] = f2bf(qv[i] * __expf(cm)); KI[o] = f2bf(kv[i] * __expf(-cm)); }
            if (tq == 0) ((float*)(p.ws + (dir == 0 ? WS_TOTF : WS_TOTB)))[(size_t)c64 * 512 + h * 128 + d] = total;
            __syncthreads();
        }
    }
}

constexpr int GLA_GRP = 71168;
typedef short s16x4 __attribute__((ext_vector_type(4)));
__device__ __forceinline__ bf16x8 tr_frag(const LAS bf16_t* base, int stride, int krow0, int col0, int fr, int fq) {
    const LAS bf16_t* q = base + (krow0 + 8 * fq + (fr >> 2)) * stride + col0 + 4 * (fr & 3);
    const s16x4 a = __builtin_amdgcn_ds_read_tr16_b64_v4i16((LAS s16x4*)q);
    const s16x4 b = __builtin_amdgcn_ds_read_tr16_b64_v4i16((LAS s16x4*)(q + 4 * stride));
    return __builtin_shufflevector(a, b, 0, 1, 2, 3, 4, 5, 6, 7);
}
__device__ __forceinline__ bf16x8 tr_frag_perm(const LAS bf16_t* base, int stride, int ks, int col0, int fr, int fq) {
    const LAS bf16_t* q = base + (32 * ks + 4 * fq + (fr >> 2)) * stride + col0 + 4 * (fr & 3);
    const s16x4 a = __builtin_amdgcn_ds_read_tr16_b64_v4i16((LAS s16x4*)q);
    const s16x4 b = __builtin_amdgcn_ds_read_tr16_b64_v4i16((LAS s16x4*)(q + 16 * stride));
    return __builtin_shufflevector(a, b, 0, 1, 2, 3, 4, 5, 6, 7);
}
#define LDS_BAR() do { asm volatile("s_waitcnt lgkmcnt(0)" ::: "memory"); __builtin_amdgcn_s_barrier(); asm volatile("" ::: "memory"); } while (0)
__device__ __forceinline__ void phase_gla(const P& p, int l, LAS unsigned char* lds) {
    const int tid = tid_(), grp = __builtin_amdgcn_readfirstlane(tid >> 8), gt = tid & 255, wv = __builtin_amdgcn_readfirstlane((tid >> 6) & 3), lane = tid & 63, fr = lane & 15, fq = lane >> 4;
    LAS unsigned char* gl = lds + grp * GLA_GRP;
    LAS bf16_t* sQ = (LAS bf16_t*)gl; LAS bf16_t* sK = (LAS bf16_t*)(gl + 17408); LAS bf16_t* sV = (LAS bf16_t*)(gl + 34816);
    LAS bf16_t* sP = (LAS bf16_t*)(gl + 44032); LAS bf16_t* sS = (LAS bf16_t*)(gl + 53248); LAS float* sTot = (LAS float*)(gl + 70656);
    const bf16_t* QD = grp == 0 ? (const bf16_t*)(p.ws + WS_R3) : (const bf16_t*)(p.ws + WS_R5);
    const bf16_t* KI = QD + (size_t)TOK * 512;
    const bf16_t* V = (const bf16_t*)(p.ws + WS_R4);
    const float* TOT = (const float*)(p.ws + (grp == 0 ? WS_TOTF : WS_TOTB));
    bf16_t* O = (bf16_t*)(p.ws + WS_R1);
    float* OST = p.out + (size_t)TOK * 1024;
    const int G = gridDim.x, b = bid_();
    const bool custom = (G == 256);
    const int ntask_mine = custom ? (b < 128 ? 1 : 4) : ((640 - b + G - 1) / G);
    for (int ti = 0; ti < ntask_mine; ++ti) {
        const int task = custom ? (b < 128 ? b : b + 128 * ti) : b + G * ti;
        if (task >= 640) break;
        const bool sample = task < 128;
        const int t2 = sample ? task : task - 128, xcd_ = t2 & 7, vs = (t2 >> 3) & 3, sh_ = xcd_ + 8 * (t2 >> 5), sb = sh_ >> 2, h = sh_ & 3;
        const int base = sample ? TOKP + sb * 4096 : sb * 256, nch = sample ? 64 : 4;
        f32x4 accS[2][4];
#pragma unroll
        for (int dt = 0; dt < 2; ++dt)
#pragma unroll
            for (int vt = 0; vt < 4; ++vt) {
                f32x4 a = (f32x4){0.f, 0.f, 0.f, 0.f};
                if (sample) { const float* cp = p.in[lnd(3)] + (((((size_t)sb * 2 + l) * 2 + grp) * 4 + h) * 128 + 16 * (2 * wv + dt) + 4 * fq) * 256 + vs * 64 + 16 * vt + fr;
#pragma unroll
                    for (int e = 0; e < 4; ++e) a[e] = cp[(size_t)e * 256]; }
                accS[dt][vt] = a;
                u32x2 w; w.x = pk_bf16(a[0], a[1]); w.y = pk_bf16(a[2], a[3]);
                *(LAS u32x2*)(sS + (16 * vt + fr) * 136 + 16 * (2 * wv + dt) + 4 * fq) = w;
            }
        u32x4 rq[2][4], rk[2][4], rv[2][2]; float rt[2] = {0.f, 0.f};
        u32x2 oprev[2][4];
#pragma unroll
        for (int u = 0; u < 2; ++u)
#pragma unroll
            for (int vt = 0; vt < 4; ++vt) oprev[u][vt] = (u32x2){0u, 0u};
#define GLA_CHUNK(st) (grp == 0 ? (st) : nch - 1 - (st))
#define GLA_LOAD(U, ci) do { const int tb_ = base + (ci) * 64; \
        _Pragma("unroll") for (int i = 0; i < 4; ++i) { const int idx = gt + 256 * i, row = idx >> 4, c16 = idx & 15; const size_t o = (size_t)(tb_ + row) * 512 + h * 128 + c16 * 8; rq[U][i] = *(const u32x4*)(QD + o); rk[U][i] = *(const u32x4*)(KI + o); } \
        _Pragma("unroll") for (int i = 0; i < 2; ++i) { const int idx = gt + 256 * i, row = idx >> 3, c8 = idx & 7; rv[U][i] = *(const u32x4*)(V + (size_t)(tb_ + row) * 1024 + h * 256 + vs * 64 + c8 * 8); } \
        if (gt < 128) rt[U] = TOT[(size_t)(tb_ >> 6) * 512 + h * 128 + gt]; } while (0)
#define GLA_STORE(U) do { \
        _Pragma("unroll") for (int i = 0; i < 4; ++i) { const int idx = gt + 256 * i, row = idx >> 4, c16 = idx & 15; *(LAS u32x4*)(sQ + row * 136 + c16 * 8) = rq[U][i]; *(LAS u32x4*)(sK + row * 136 + c16 * 8) = rk[U][i]; } \
        _Pragma("unroll") for (int i = 0; i < 2; ++i) { const int idx = gt + 256 * i, row = idx >> 3, c8 = idx & 7; *(LAS u32x4*)(sV + row * 72 + c8 * 8) = rv[U][i]; } \
        if (gt < 128) sTot[gt] = rt[U]; } while (0)
#define GLA_OLOAD(U, st) do { const int tb_ = base + GLA_CHUNK(st) * 64; \
        _Pragma("unroll") for (int vt = 0; vt < 4; ++vt) oprev[U][vt] = *(const u32x2*)(O + (size_t)(tb_ + 16 * wv + fr) * 1024 + h * 256 + vs * 64 + 16 * vt + 4 * fq); } while (0)
        GLA_LOAD(0, GLA_CHUNK(0));
        GLA_STORE(0);
        GLA_LOAD(1, GLA_CHUNK(1));
        __syncthreads();
        const int half = nch >> 1;
        for (int s0 = 0; s0 < nch; s0 += 2) {
#pragma unroll
          for (int u = 0; u < 2; ++u) {
            const int s = s0 + u;
            const int ci = GLA_CHUNK(s), tb = base + ci * 64;
            const bool second = (s >= half);
            if (s == half) GLA_OLOAD(u, s);
            if (s + 1 < nch && s + 1 > half) GLA_OLOAD(u ^ 1, s + 1);
            asm volatile("" ::: "memory");
            if (s + 2 < nch) GLA_LOAD(u, GLA_CHUNK(s + 2));
            bf16x8 pfr[2];
            { bf16x8 qa[4];
#pragma unroll
            for (int ks = 0; ks < 4; ++ks) qa[ks] = *(const LAS bf16x8*)(sQ + (16 * wv + fr) * 136 + 32 * ks + 8 * fq);
            u32x2 pk2[4];
#pragma unroll
            for (int jt = 0; jt < 4; ++jt) {
                bf16x8 kb[4];
#pragma unroll
                for (int ks = 0; ks < 4; ++ks) kb[ks] = *(const LAS bf16x8*)(sK + (16 * jt + fr) * 136 + 32 * ks + 8 * fq);
                f32x4 acc = (f32x4){0.f, 0.f, 0.f, 0.f};
#pragma unroll
                for (int ks = 0; ks < 4; ++ks) acc = __builtin_amdgcn_mfma_f32_16x16x32_bf16(kb[ks], qa[ks], acc, 0, 0, 0);
                const int i = 16 * wv + fr;
#pragma unroll
                for (int e = 0; e < 4; ++e) { const int j = 16 * jt + 4 * fq + e; const bool keep = grp == 0 ? (j <= i) : (j >= i); acc[e] = keep ? acc[e] : 0.f; }
                pk2[jt].x = pk_bf16(acc[0], acc[1]); pk2[jt].y = pk_bf16(acc[2], acc[3]);
            }
#pragma unroll
            for (int ks = 0; ks < 2; ++ks) { u32x4 w; w.x = pk2[2 * ks].x; w.y = pk2[2 * ks].y; w.z = pk2[2 * ks + 1].x; w.w = pk2[2 * ks + 1].y; pfr[ks] = __builtin_bit_cast(bf16x8, w); }
            }
            asm volatile("" ::: "memory");
            bf16x8 vf[4][2];
#pragma unroll
            for (int vt = 0; vt < 4; ++vt)
#pragma unroll
                for (int ks = 0; ks < 2; ++ks) vf[vt][ks] = tr_frag_perm(sV, 72, ks, 16 * vt, fr, fq);
#pragma unroll
            for (int dt = 0; dt < 2; ++dt) {
                bf16x8 kf[2];
#pragma unroll
                for (int ks = 0; ks < 2; ++ks) kf[ks] = tr_frag_perm(sK, 136, ks, 16 * (2 * wv + dt), fr, fq);
                const f32x4 tt = *(const LAS f32x4*)(sTot + 16 * (2 * wv + dt) + 4 * fq);
                const f32x4 sc = (f32x4){__expf(tt[0]), __expf(tt[1]), __expf(tt[2]), __expf(tt[3])};
#pragma unroll
                for (int vt = 0; vt < 4; ++vt) {
#pragma unroll
                    for (int ks = 0; ks < 2; ++ks) accS[dt][vt] = __builtin_amdgcn_mfma_f32_16x16x32_bf16(kf[ks], vf[vt][ks], accS[dt][vt], 0, 0, 0);
                    accS[dt][vt] = accS[dt][vt] * sc;
                }
            }
            {
                bf16x8 qf[4];
#pragma unroll
                for (int ks = 0; ks < 4; ++ks) qf[ks] = *(const LAS bf16x8*)(sQ + (16 * wv + fr) * 136 + 32 * ks + 8 * fq);
#pragma unroll
                for (int vt = 0; vt < 4; ++vt) {
                    f32x4 acc = (f32x4){0.f, 0.f, 0.f, 0.f};
#pragma unroll
                    for (int ks = 0; ks < 2; ++ks) acc = __builtin_amdgcn_mfma_f32_16x16x32_bf16(vf[vt][ks], pfr[ks], acc, 0, 0, 0);
#pragma unroll
                    for (int ks = 0; ks < 4; ++ks) { const bf16x8 sf = *(const LAS bf16x8*)(sS + (16 * vt + fr) * 136 + 32 * ks + 8 * fq);
                        acc = __builtin_amdgcn_mfma_f32_16x16x32_bf16(sf, qf[ks], acc, 0, 0, 0); }
                    { u32x2 pv = oprev[u][vt]; asm volatile("" : "+v"(pv));
                      if (second) acc = acc + (f32x4){bflo(pv.x), bfhi(pv.x), bflo(pv.y), bfhi(pv.y)}; }
                    store4bf(O + (size_t)(tb + 16 * wv + fr) * 1024 + h * 256 + vs * 64 + 16 * vt + 4 * fq, acc);
                }
            }
            LDS_BAR();
#pragma unroll
            for (int dt = 0; dt < 2; ++dt)
#pragma unroll
                for (int vt = 0; vt < 4; ++vt) { u32x2 w; w.x = pk_bf16(accS[dt][vt][0], accS[dt][vt][1]); w.y = pk_bf16(accS[dt][vt][2], accS[dt][vt][3]);
                    *(LAS u32x2*)(sS + (16 * vt + fr) * 136 + 16 * (2 * wv + dt) + 4 * fq) = w; }
            if (s + 1 < nch) GLA_STORE(u ^ 1);
            if (s == half - 1) { asm volatile("s_waitcnt vmcnt(0)" ::: "memory"); __syncthreads(); } else LDS_BAR();
          }
        }
        if (!sample) {
#pragma unroll
            for (int dt = 0; dt < 2; ++dt)
#pragma unroll
                for (int vt = 0; vt < 4; ++vt) { float* op = OST + (((((size_t)sb * 2 + l) * 2 + grp) * 4 + h) * 128 + 16 * (2 * wv + dt) + 4 * fq) * 256 + vs * 64 + 16 * vt + fr;
#pragma unroll
                    for (int e = 0; e < 4; ++e) op[(size_t)e * 256] = accS[dt][vt][e]; }
        }
    }
#undef GLA_LOAD
#undef GLA_STORE
#undef GLA_OLOAD
#undef GLA_CHUNK
}

__device__ __forceinline__ void phase_glapost(const P& p, int l) {
    const int lane = tid_() & 63, gw = bid_() * 8 + (tid_() >> 6), nw = gridDim.x * 8;
    bf16_t* O = (bf16_t*)(p.ws + WS_R1); const bf16_t* R = (const bf16_t*)(p.ws + WS_R3);
    const float* gn = p.in[lnd(13)] + (size_t)l * 256 + (lane & 15) * 16;
    for (int row = gw; row < TOK; row += nw) {
        const size_t o = (size_t)row * 1024 + lane * 16; float x[16], r[16];
#pragma unroll
        for (int hh = 0; hh < 2; ++hh) { const u32x4 a = *(const u32x4*)(O + o + 8 * hh), c = *(const u32x4*)(R + o + 8 * hh);
            x[8 * hh + 0] = bflo(a.x); x[8 * hh + 1] = bfhi(a.x); x[8 * hh + 2] = bflo(a.y); x[8 * hh + 3] = bfhi(a.y); x[8 * hh + 4] = bflo(a.z); x[8 * hh + 5] = bfhi(a.z); x[8 * hh + 6] = bflo(a.w); x[8 * hh + 7] = bfhi(a.w);
            r[8 * hh + 0] = bflo(c.x); r[8 * hh + 1] = bfhi(c.x); r[8 * hh + 2] = bflo(c.y); r[8 * hh + 3] = bfhi(c.y); r[8 * hh + 4] = bflo(c.z); r[8 * hh + 5] = bfhi(c.z); r[8 * hh + 6] = bflo(c.w); r[8 * hh + 7] = bfhi(c.w); }
        float ss = 0.f;
#pragma unroll
        for (int e = 0; e < 16; ++e) ss += x[e] * x[e];
        ss += __shfl_xor(ss, 1); ss += __shfl_xor(ss, 2); ss += __shfl_xor(ss, 4); ss += __shfl_xor(ss, 8);
        const float rstd = rsqrtf(ss * (1.0f / 256.0f) + 1e-6f);
        float y[16];
#pragma unroll
        for (int e = 0; e < 16; ++e) y[e] = x[e] * rstd * gn[e] * r[e];
#pragma unroll
        for (int hh = 0; hh < 2; ++hh) { u32x4 w; w.x = pk_bf16(y[8 * hh], y[8 * hh + 1]); w.y = pk_bf16(y[8 * hh + 2], y[8 * hh + 3]); w.z = pk_bf16(y[8 * hh + 4], y[8 * hh + 5]); w.w = pk_bf16(y[8 * hh + 6], y[8 * hh + 7]); *(u32x4*)(O + o + 8 * hh) = w; }
    }
}


#define XB_TMO      128
#define XB_XCNT(j)  (256  + 64 * (j))
#define XB_XSUB(j)  (1280 + 64 * (j))
#define XB_XGEN(j)  (2304 + 64 * (j))
#define XB_TOP      3328
#define XB_TOPGEN   3392
#define XCD_BAR_WORDS 3456
#define XB_SPIN_CAP (1u << 18)
__device__ __forceinline__ unsigned xb_ld(unsigned* p)              { return __hip_atomic_load(p, __ATOMIC_RELAXED, __HIP_MEMORY_SCOPE_AGENT); }
__device__ __forceinline__ unsigned xb_add(unsigned* p, unsigned v) { return __hip_atomic_fetch_add(p, v, __ATOMIC_RELAXED, __HIP_MEMORY_SCOPE_AGENT); }
__device__ __forceinline__ unsigned xb_xcc_id() { return (unsigned)__builtin_amdgcn_s_getreg((3 << 11) | 20) & 0xFu; }
#define XB_SPIN(cond, bar) do { unsigned _sp = 0; while (cond) { __builtin_amdgcn_s_sleep(1); \
    if ((++_sp & 255u) == 0u) { if (xb_ld(&(bar)[XB_TMO])) break; if (_sp > XB_SPIN_CAP) { atomicAdd(&(bar)[XB_TMO], 1u); break; } } } } while (0)
struct XcdBarrier { unsigned* bar; unsigned x; volatile LAS unsigned* st; };
__device__ __forceinline__ XcdBarrier xcd_barrier_post(unsigned* bar, volatile LAS unsigned* st) {
    XcdBarrier b; b.bar = bar; b.x = xb_xcc_id(); b.st = st;
    if (threadIdx.x == 0) (void)xb_add(&bar[XB_XCNT(b.x)], 1u);
    return b;
}
__device__ __forceinline__ void xcd_barrier_complete(unsigned* bar, unsigned x, unsigned& nloc, unsigned& nx) {
    const unsigned G = gridDim.x * gridDim.y * gridDim.z;
    unsigned sum, cnt, mine, sp = 0u;
    for (;;) {
        sum = 0u; cnt = 0u; mine = 0u;
#pragma unroll
        for (unsigned j = 0; j < 16; ++j) { const unsigned c = xb_ld(&bar[XB_XCNT(j)]); sum += c; cnt += (c > 0u) ? 1u : 0u; mine = (j == x) ? c : mine; }
        if (sum == G) break;
        __builtin_amdgcn_s_sleep(1);
        if ((++sp & 255u) == 0u) { if (xb_ld(&bar[XB_TMO])) break; if (sp > XB_SPIN_CAP) { atomicAdd(&bar[XB_TMO], 1u); break; } }
    }
    nloc = mine > 0u ? mine : 1u; nx = cnt > 0u ? cnt : 1u;
}
__device__ __forceinline__ void xcd_barrier(const XcdBarrier& b) {
    asm volatile("s_waitcnt vmcnt(0)" ::: "memory");
    __syncthreads();
    if (threadIdx.x == 0) {
        unsigned* bar = b.bar;
        __builtin_amdgcn_s_waitcnt(0);
        unsigned nloc = b.st[0], nx = b.st[1];
        if (nloc == 0u) { xcd_barrier_complete(bar, b.x, nloc, nx); b.st[0] = nloc; b.st[1] = nx; }
        const unsigned old = xb_add(&bar[XB_XSUB(b.x)], 1u);
        const unsigned gen = old / nloc;
        if (old + 1u == (gen + 1u) * nloc) {
            __builtin_amdgcn_fence(__ATOMIC_RELEASE, "agent");
            asm volatile("s_waitcnt vmcnt(0)" ::: "memory");
            const unsigned og = xb_add(&bar[XB_TOP], 1u);
            const unsigned tg = og / nx;
            if (og + 1u == (tg + 1u) * nx) xb_add(&bar[XB_TOPGEN], 1u);
            else XB_SPIN(xb_ld(&bar[XB_TOPGEN]) == tg, bar);
            __builtin_amdgcn_fence(__ATOMIC_ACQUIRE, "agent");
            xb_add(&bar[XB_XGEN(b.x)], 1u);
            asm volatile("s_waitcnt vmcnt(0)" ::: "memory");
        } else {
            XB_SPIN(xb_ld(&bar[XB_XGEN(b.x)]) == gen, bar);
            __builtin_amdgcn_fence(__ATOMIC_ACQUIRE, "agent");
            asm volatile("s_waitcnt vmcnt(0)" ::: "memory");
        }
    }
    __syncthreads();
}

__device__ __forceinline__ void run_phase(const P& p, int ph, LAS unsigned char* lds) {
    if (ph == 2 * PPL) { if (EN(34)) phase_final(p); return; }
    const int l = ph / PPL, q = ph % PPL;
    unsigned char* ws = p.ws; bf16_t* W = (bf16_t*)(ws + WS_W);
    const int G = gridDim.x, c = bid_();
    pg8::Order S;
    switch (q) {
        case 0: if (EN(0)) { phase_prep(p, l, lds); if (l == 1) phase_norm(p, l, 1); } break;
        case 1: if (EN(1)) { if (l == 0) phase_norm(p, l, 1); } break;
        case 2: if (EN(2)) { pg8::Gemm g{(const bf16_t*)(ws + WS_R2), W + W_A / 2, TOK, 2816, 1024, 1024, 0, 0, 1}; S.init(TOK, 2816, 1, G, c);
            EpiPartA E{(bf16_t*)(ws + WS_R3), (bf16_t*)(ws + WS_R3) + (size_t)TOK * 512, (bf16_t*)(ws + WS_R4), (bf16_t*)(ws + WS_R5), (float*)(ws + WS_GLR)};
            pg8::gemm_phase(lds, g, S, E); } break;
        case 3: if (EN(3)) { pg8::Gemm g{(const bf16_t*)(ws + WS_R5), (const bf16_t*)(ws + WS_EMAT), 1280, 256, 512, 768, (size_t)1280 * 768, (size_t)256 * 512, 32}; S.init(1280, 256, 32, G, c);
            EpiE E{(float*)(ws + WS_E)}; pg8::gemm_phase(lds, g, S, E); } break;
        case 4: if (EN(4)) phase_s5scan(p, l); break;
        case 5: if (EN(5)) { pg8::Gemm g{(const bf16_t*)(ws + WS_R5), (const bf16_t*)(ws + WS_R1), 1280, 512, 768, 768, (size_t)1280 * 768, (size_t)512 * 768, 32}; S.init(1280, 512, 32, G, c);
            EpiY E{(bf16_t*)(ws + WS_E)}; pg8::gemm_phase(lds, g, S, E); } break;
        case 6: if (EN(6)) { pg8::Gemm g{(const bf16_t*)(ws + WS_E), W + W_GLU / 2, TOK, 512, 512, 512, 0, 0, 1}; S.init(TOK, 512, 1, G, c);
            EpiGLU E{(const bf16_t*)(ws + WS_E), (bf16_t*)(ws + WS_R6), p.in[lnd(24)] + (size_t)l * 512}; pg8::gemm_phase(lds, g, S, E); } break;
        case 7: if (EN(7)) phase_glapre(p, l, lds); break;
        case 8: if (EN(8)) phase_gla(p, l, lds); break;
        case 9: if (EN(9)) { pg8::Gemm g{(const bf16_t*)(ws + WS_R2), W + W_B / 2, TOK, 3072, 1024, 1024, 0, 0, 1}; S.init(TOK, 3072, 1, G, c);
            EpiPartB E{(bf16_t*)(ws + WS_R3), (bf16_t*)(ws + WS_R4), (bf16_t*)(ws + WS_R5)}; pg8::gemm_phase(lds, g, S, E); } break;
        case 10: if (EN(10)) phase_glapost(p, l); break;
        case 11: if (EN(11)) { pg8::Gemm g{(const bf16_t*)(ws + WS_R1), W + W_PG / 2, TOK, 1024, 1024, 1024, 0, 0, 1}; S.init(TOK, 1024, 1, G, c);
              EpiProj1 E{(const bf16_t*)(ws + WS_R4), (bf16_t*)(ws + WS_R2)}; pg8::gemm_phase(lds, g, S, E); } break;
        case 12: if (EN(12)) { pg8::Gemm g{(const bf16_t*)(ws + WS_R6), W + W_PS / 2, TOK, 1024, 512, 512, 0, 0, 1}; S.init(TOK, 1024, 1, G, c);
              EpiProj2 E{(const bf16_t*)(ws + WS_R5), (bf16_t*)(ws + WS_R2)}; pg8::gemm_phase(lds, g, S, E); } break;
        case 13: if (EN(13)) { pg8::Gemm g{(const bf16_t*)(ws + WS_R2), W + W_OUT / 2, TOK, 1024, 1024, 1024, 0, 0, 1}; S.init(TOK, 1024, 1, G, c);
            EpiDelta E{(bf16_t*)(ws + WS_R3), (const float*)(ws + WS_MOD) + (size_t)l * 9 * 6144 + 2048}; pg8::gemm_phase(lds, g, S, E); } break;
        case 14: if (EN(14)) phase_norm(p, l, 2); break;
        case 15: if (EN(15)) { pg8::Gemm g{(const bf16_t*)(ws + WS_R2), W + W_1 / 2, TOK, 4096, 1024, 1024, 0, 0, 1}; S.init(TOK, 4096, 1, G, c);
            EpiFF1 E{(bf16_t*)(ws + WS_HID)}; pg8::gemm_phase(lds, g, S, E); } break;
        case 16: if (EN(16)) { pg8::Gemm g{(const bf16_t*)(ws + WS_HID), W + W_2 / 2, TOK, 1024, 4096, 4096, 0, 0, 1}; S.init(TOK, 1024, 1, G, c);
            EpiDelta E{(bf16_t*)(ws + WS_R2), (const float*)(ws + WS_MOD) + (size_t)l * 9 * 6144 + 5120}; pg8::gemm_phase(lds, g, S, E); } break;
        default: break;
    }
}

__global__ void __launch_bounds__(NTHR, 2) fwd_megakernel(P p) {
    extern __shared__ __attribute__((aligned(16))) unsigned char lds_raw[];
    LAS unsigned char* lds = (LAS unsigned char*)lds_raw;
#if MULTI_LAUNCH
    for (int ph = p.ph_lo; ph < p.ph_hi; ++ph) run_phase(p, ph, lds);
#else
    cg::grid_group grid = cg::this_grid();
    if (p.ph_lo < 0) grid.sync();
    volatile LAS unsigned* stw = (volatile LAS unsigned*)(lds + LDS_BYTES - 16);
    if (threadIdx.x < 4) stw[threadIdx.x] = 0u;
    __syncthreads();
    const XcdBarrier bar = xcd_barrier_post((unsigned*)(p.ws + WS_BAR), stw);
    for (int ph = p.ph_lo; ph < p.ph_hi; ++ph) {
        run_phase(p, ph, lds);
#if REP_MASK
        if (ph < 2 * PPL && ((REP_MASK >> (ph % PPL)) & 1)) {
            xcd_barrier(bar);
            if ((ph % PPL) == 12) { run_phase(p, ph - 1, lds); }
            run_phase(p, ph, lds);
        }
#endif
        if (ph + 1 < p.ph_hi && (ph % PPL) != 11 && ph != PPL) xcd_barrier(bar);
    }
#endif
}

extern "C" void kernel_launch(void* const* d_in, const int* in_sizes, int n_in, void* d_out, int out_size, void* d_ws, size_t ws_size, hipStream_t stream) {
    static int grid = 0;
    if (grid == 0) {
        if (n_in != 31 || ws_size < WS_END) { fprintf(stderr, "kernel_launch: unexpected n_in %d or ws_size %zu (< %zu)\n", n_in, ws_size, (size_t)WS_END); grid = -1; return; }
        int dev = 0, cus = 0, per_cu = 0;
        hipGetDevice(&dev);
        hipDeviceGetAttribute(&cus, hipDeviceAttributeMultiprocessorCount, dev);
        if (hipFuncSetAttribute((const void*)fwd_megakernel, hipFuncAttributeMaxDynamicSharedMemorySize, LDS_BYTES) != hipSuccess) { fprintf(stderr, "kernel_launch: hipFuncSetAttribute failed\n"); grid = -1; return; }
        hipOccupancyMaxActiveBlocksPerMultiprocessor(&per_cu, (const void*)fwd_megakernel, NTHR, LDS_BYTES);
        (void)hipGetLastError();
        if (per_cu < 1) fprintf(stderr, "kernel_launch: occupancy query says %d blocks per CU\n", per_cu);
        grid = cus > 0 ? cus : 256;
    }
    if (grid < 0) return;
    P p{};
    for (int i = 0; i < 31; ++i) p.in[i] = (const float*)d_in[i];
    p.out = (float*)d_out; p.ws = (unsigned char*)d_ws;
#if MULTI_LAUNCH
    for (int ph = 0; ph < NPHASE; ++ph) { p.ph_lo = ph; p.ph_hi = ph + 1; hipLaunchKernelGGL(fwd_megakernel, dim3(grid), dim3(NTHR), LDS_BYTES, stream, p); }
#else
    p.ph_lo = 0; p.ph_hi = NPHASE;
    (void)hipMemsetAsync((char*)d_ws + WS_BAR, 0, XCD_BAR_WORDS * sizeof(unsigned), stream);
    void* args[] = {&p};
    hipError_t e = hipLaunchCooperativeKernel((const void*)fwd_megakernel, dim3(grid), dim3(NTHR), args, LDS_BYTES, stream);
    if (e != hipSuccess) fprintf(stderr, "cooperative launch failed: %s (grid %d)\n", hipGetErrorString(e), grid);
#endif
}
```

```cpp
#include <hip/hip_runtime.h>
#include <hip/hip_cooperative_groups.h>
#include <cstdio>
namespace cg = cooperative_groups;

#ifndef MULTI_LAUNCH
#define MULTI_LAUNCH 0
#endif

#ifndef REP_MASK
#define REP_MASK 0
#endif
#ifndef PHASE_SEL
#define PHASE_SEL -1
#endif
#define EN(q) (PHASE_SEL < 0 || PHASE_SEL == (q))
#define LAS __attribute__((address_space(3)))
typedef unsigned short bf16_t;
typedef short bf16x8 __attribute__((ext_vector_type(8)));
typedef float f32x4 __attribute__((ext_vector_type(4)));
typedef unsigned u32x4 __attribute__((ext_vector_type(4)));
typedef unsigned u32x2 __attribute__((ext_vector_type(2)));

constexpr int NTHR = 512;
constexpr int TOK = 40960, TOKP = 8192;
constexpr int LDS_BYTES = 147456;
constexpr int NPHASE = 35;
constexpr int PPL = 17;

constexpr size_t MiB = (size_t)1 << 20;
constexpr size_t WS_MOD = 0;
constexpr size_t WS_GLR = 1 * MiB;
constexpr size_t WS_TOTF = 7 * MiB;
constexpr size_t WS_TOTB = 9 * MiB;
constexpr size_t WS_BAR = 12 * MiB;
constexpr size_t WS_W = 16 * MiB;
constexpr size_t W_A = 0;
constexpr size_t W_B = W_A + (size_t)2816 * 1024 * 2;
constexpr size_t W_PG = W_B + (size_t)3072 * 1024 * 2;
constexpr size_t W_GLU = W_PG + (size_t)1024 * 1024 * 2;
constexpr size_t W_PS = W_GLU + (size_t)512 * 512 * 2;
constexpr size_t W_OUT = W_PS + (size_t)1024 * 512 * 2;
constexpr size_t W_1 = W_OUT + (size_t)1024 * 1024 * 2;
constexpr size_t W_2 = W_1 + (size_t)4096 * 1024 * 2;
constexpr size_t WS_R2 = 50 * MiB;
constexpr size_t WS_R3 = 130 * MiB;
constexpr size_t WS_R4 = 210 * MiB;
constexpr size_t WS_R5 = 290 * MiB;
constexpr size_t WS_E = 350 * MiB;
constexpr size_t WS_R6 = 390 * MiB;
constexpr size_t WS_R1 = 430 * MiB;
constexpr size_t WS_EMAT = 454 * MiB;
constexpr size_t WS_HID = 130 * MiB;
constexpr size_t WS_END = 510 * MiB;

struct P { const float* in[31]; float* out; unsigned char* ws; int ph_lo, ph_hi; };

__device__ __forceinline__ int tid_() { int t = threadIdx.x; asm volatile("" : "+v"(t)); return t; }
__device__ __forceinline__ int bid_() { int b = blockIdx.x; asm volatile("" : "+s"(b)); return b; }
__device__ __forceinline__ int lnd(int k) { asm volatile("" : "+s"(k)); return k; }
__device__ __forceinline__ unsigned pk_bf16(float lo, float hi) { unsigned r; asm("v_cvt_pk_bf16_f32 %0, %1, %2" : "=v"(r) : "v"(lo), "v"(hi)); return r; }
__device__ __forceinline__ float bf2f(bf16_t b) { return __uint_as_float(((unsigned)b) << 16); }
__device__ __forceinline__ float bflo(unsigned w) { return __uint_as_float(w << 16); }
__device__ __forceinline__ float bfhi(unsigned w) { return __uint_as_float(w & 0xffff0000u); }
__device__ __forceinline__ bf16_t f2bf(float f) { return (bf16_t)(pk_bf16(f, 0.f) & 0xffffu); }
__device__ __forceinline__ float sigmoidf_(float x) { return __builtin_amdgcn_rcpf(1.0f + __expf(-x)); }
__device__ __forceinline__ void store4bf(bf16_t* ptr, f32x4 v) { u32x2 w; w.x = pk_bf16(v[0], v[1]); w.y = pk_bf16(v[2], v[3]); *(u32x2*)ptr = w; }
__device__ __forceinline__ f32x4 load4bf(const bf16_t* ptr) { u32x2 w = *(const u32x2*)ptr; return (f32x4){bflo(w.x), bfhi(w.x), bflo(w.y), bfhi(w.y)}; }
__device__ __forceinline__ int mod_index(int tok) { return tok < TOKP ? 0 : (tok >> 12) - 1; }
__device__ __forceinline__ float wave_sum(float v) {
#pragma unroll
    for (int o = 32; o >= 1; o >>= 1) v += __shfl_xor(v, o);
    return v;
}

namespace pg8 {
constexpr int BM = 256, BK = 64, HALF = 128, HTB = HALF * BK * 2, STAGE_BYTES = 8 * HTB, NXCD = 8, WGM = 8;
__device__ __forceinline__ int lds_byte(int r, int c) { const int st = (r >> 4) * 2 + (c >> 5), rr = r & 15, cc = c & 31, ob = rr * 64 + cc * 2; return st * 1024 + (ob ^ (((ob >> 9) & 1) << 5)); }
__device__ __forceinline__ void stage_rc(int b, int& R, int& C) { const int st = b / 1024, sb = b % 1024, swz = sb ^ (((sb >> 9) & 1) << 5); R = (st >> 1) * 16 + swz / 64; C = (st & 1) * 32 + (swz % 64) / 2; }

struct Unit { int pm, pn, z, hf; };
struct Gemm { const bf16_t* A; const bf16_t* Bt; int M, N, K, lda; size_t sA, sB; int nz; };
struct Order {
    int nM, nN, nwg, G, c, nz, nfull, rem2;
    __device__ __forceinline__ void init(int M, int N, int nz_, int G_, int c_) { nM = M / BM; nN = N / BM; nwg = nM * nN; G = G_; c = c_; nz = nz_;
        nfull = nwg; rem2 = 0;
        if (nz == 1) { const int full = (nwg / G) * G, rem = nwg - full; if (rem > 0 && 2 * rem <= G) { nfull = full; rem2 = 2 * rem; } } }
    __device__ __forceinline__ void map(int wgid, Unit& u) const {
        { const int q = nwg / NXCD, r = nwg % NXCD, xcd = wgid % NXCD, off = wgid / NXCD; wgid = (xcd < r ? xcd * (q + 1) : r * (q + 1) + (xcd - r) * q) + off; }
        const int nig = WGM * nN, gid = wgid / nig, fm = gid * WGM, gsz = (nM - fm) < WGM ? (nM - fm) : WGM;
        u.pm = fm + ((wgid % nig) % gsz); u.pn = (wgid % nig) / gsz; u.z = 0; }
    __device__ __forceinline__ bool next(int i, Unit& u) const {
        const long L = (long)i * G + c;
        if (nz == 1) {
            if (L < nfull) { map((int)L, u); u.hf = 0; return true; }
            const int t = (int)(L - nfull); if (t >= rem2) return false;
            map(nfull + (t >> 1), u); u.hf = 1 + (t & 1); return true;
        }
        if (L >= (long)nwg * nz) return false;
        const int z = (int)(L / nwg), r = (int)(L % nwg); u.z = z; u.pm = r % nM; u.pn = r / nM; u.hf = 0;
        return true;
    }
};

template <class Epi>
__device__ __forceinline__ void gemm_phase(LAS unsigned char* lds, const Gemm g, const Order& S, const Epi& E) {
    const int tid = tid_(), wid = __builtin_amdgcn_readfirstlane(tid >> 6), lane = tid & 63, wr = wid >> 2, wc = wid & 3, fr = lane & 15, fq = lane >> 4;
    const int K = g.K, nt = K / BK;
    unsigned voffA[2], voffB[2];
#pragma unroll
    for (int i = 0; i < 2; ++i) { int R, C; stage_rc(tid * 16 + i * 8192, R, C); voffA[i] = (unsigned)(R * g.lda + C) * 2u; voffB[i] = (unsigned)(R * K + C) * 2u; }
    const size_t kstep = (size_t)(BK * 2);
    const size_t hstepA = (size_t)HALF * g.lda * 2, hstepB = (size_t)HALF * K * 2;
    const unsigned ldsw = (unsigned)wid * 1024u;
    const int aoff = lds_byte(wr * 64 + fr, fq * 8), boff = lds_byte(wc * 32 + fr, fq * 8);
#define PG8_SA(b, h) (((b) * 2 + (h)) * HTB)
#define PG8_SB(b, h) ((4 + (b) * 2 + (h)) * HTB)
#define PG8_STAGE(bufoff, gbase, voff) do { _Pragma("unroll") for (int _i = 0; _i < 2; ++_i) \
        __builtin_amdgcn_global_load_lds((const unsigned*)((const char*)(gbase) + (voff)[_i]), (LAS unsigned*)(lds + (bufoff) + ldsw + _i * 8192), 16, 0, 0); } while (0)
#define PG8_LDA(dst, b, h) do { _Pragma("unroll") for (int m = 0; m < 4; ++m) _Pragma("unroll") for (int k = 0; k < 2; ++k) dst[m][k] = *(const LAS bf16x8*)(lds + PG8_SA(b, h) + aoff + m * 2048 + k * 1024); } while (0)
#define PG8_LDB(dst, b, h) do { _Pragma("unroll") for (int n = 0; n < 2; ++n) _Pragma("unroll") for (int k = 0; k < 2; ++k) dst[n][k] = *(const LAS bf16x8*)(lds + PG8_SB(b, h) + boff + n * 2048 + k * 1024); } while (0)
#define PG8_MMA(ai, bj, At, Bt) do { __builtin_amdgcn_s_setprio(1); _Pragma("unroll") for (int m = 0; m < 4; ++m) _Pragma("unroll") for (int n = 0; n < 2; ++n) _Pragma("unroll") for (int k = 0; k < 2; ++k) \
        acc[ai][bj][m][n] = __builtin_amdgcn_mfma_f32_16x16x32_bf16(Bt[n][k], At[m][k], acc[ai][bj][m][n], 0, 0, 0); __builtin_amdgcn_s_setprio(0); } while (0)
#define PG8_WAIT_V(n) asm volatile("s_waitcnt vmcnt(" #n ")" ::: "memory")
#define PG8_WAIT_L(n) asm volatile("s_waitcnt lgkmcnt(" #n ")" ::: "memory")
#define PG8_BAR __builtin_amdgcn_s_barrier()
#define PG8_SCHED __builtin_amdgcn_sched_barrier(0)
    Unit cur, nxt; int ui = 0;
    if (!S.next(0, cur)) return;
    f32x4 acc[2][2][4][2];
#pragma unroll
    for (int a = 0; a < 2; ++a)
#pragma unroll
        for (int b = 0; b < 2; ++b)
#pragma unroll
            for (int m = 0; m < 4; ++m)
#pragma unroll
                for (int n = 0; n < 2; ++n) acc[a][b][m][n] = (f32x4){0.f, 0.f, 0.f, 0.f};
    bf16x8 At[4][2], B0[2][2], B1[2][2];
    const char* cA = (const char*)g.A + ((size_t)cur.z * g.sA + (size_t)(cur.pm * BM + (cur.hf == 2 ? HALF : 0)) * g.lda) * 2;
    const char* cB = (const char*)g.Bt + ((size_t)cur.z * g.sB + (size_t)cur.pn * BM * K) * 2;
    PG8_STAGE(PG8_SB(0, 0), cB, voffB); PG8_STAGE(PG8_SB(0, 1), cB + hstepB, voffB); PG8_STAGE(PG8_SA(0, 0), cA, voffA); PG8_STAGE(PG8_SA(0, 1), cA + hstepA, voffA);
    if (wr == 1) PG8_BAR;
    PG8_WAIT_V(2); PG8_BAR;
    PG8_STAGE(PG8_SB(1, 0), cB + kstep, voffB); PG8_STAGE(PG8_SA(1, 0), cA + kstep, voffA); PG8_STAGE(PG8_SB(1, 1), cB + hstepB + kstep, voffB);
    PG8_WAIT_V(6); PG8_BAR;
    for (;;) {
        const bool has_next = S.next(ui + 1, nxt);
        const char* nA = has_next ? (const char*)g.A + ((size_t)nxt.z * g.sA + (size_t)(nxt.pm * BM + (nxt.hf == 2 ? HALF : 0)) * g.lda) * 2 : cA;
        const bool fullu = (cur.hf == 0);
        const char* nB = has_next ? (const char*)g.Bt + ((size_t)nxt.z * g.sB + (size_t)nxt.pn * BM * K) * 2 : cB;
        for (int t = 0; t < nt; t += 2) {
            const bool last = (t == nt - 2);
            const char* a1 = cA + (size_t)(t + 1) * kstep;
            const char* a2 = last ? nA : cA + (size_t)(t + 2) * kstep; const char* b2 = last ? nB : cB + (size_t)(t + 2) * kstep;
            const char* a3 = a2 + kstep; const char* b3 = b2 + kstep;
            PG8_LDB(B0, 0, 0); PG8_LDB(B1, 0, 1); PG8_SCHED; PG8_LDA(At, 0, 0); PG8_STAGE(PG8_SA(1, 1), a1 + hstepA, voffA);
            PG8_WAIT_V(8); PG8_WAIT_L(0); PG8_BAR; PG8_MMA(0, 0, At, B0); PG8_MMA(0, 1, At, B1); PG8_BAR; PG8_SCHED;
            if (fullu) PG8_LDA(At, 0, 1); PG8_STAGE(PG8_SB(0, 0), b2, voffB); PG8_STAGE(PG8_SB(0, 1), b2 + hstepB, voffB); PG8_STAGE(PG8_SA(0, 0), a2, voffA);
            PG8_WAIT_V(8); PG8_WAIT_L(0); PG8_BAR; if (fullu) { PG8_MMA(1, 0, At, B0); PG8_MMA(1, 1, At, B1); } PG8_BAR; PG8_SCHED;
            PG8_LDB(B0, 1, 0); PG8_LDB(B1, 1, 1); PG8_SCHED; PG8_LDA(At, 1, 0); PG8_STAGE(PG8_SA(0, 1), a2 + hstepA, voffA);
            PG8_WAIT_V(8); PG8_WAIT_L(0); PG8_BAR; PG8_MMA(0, 0, At, B0); PG8_MMA(0, 1, At, B1); PG8_BAR; PG8_SCHED;
            if (fullu) PG8_LDA(At, 1, 1); PG8_STAGE(PG8_SB(1, 0), b3, voffB); PG8_STAGE(PG8_SB(1, 1), b3 + hstepB, voffB); PG8_STAGE(PG8_SA(1, 0), a3, voffA);
            PG8_WAIT_V(8); PG8_WAIT_L(0); PG8_BAR; if (fullu) { PG8_MMA(1, 0, At, B0); PG8_MMA(1, 1, At, B1); } PG8_BAR; PG8_SCHED;
        }
        if (wr == 0) PG8_BAR;
        if (fullu) E.template tile<2>(acc, cur.z, cur.pm * BM + wr * 64 + fr, cur.pn * BM + wc * 32 + (Epi::PERM ? 8 : 4) * fq);
        else E.template tile<1>(acc, cur.z, cur.pm * BM + (cur.hf == 2 ? HALF : 0) + wr * 64 + fr, cur.pn * BM + wc * 32 + (Epi::PERM ? 8 : 4) * fq);
        if (!has_next) break;
#pragma unroll
        for (int a = 0; a < 2; ++a)
#pragma unroll
            for (int b = 0; b < 2; ++b)
#pragma unroll
                for (int m = 0; m < 4; ++m)
#pragma unroll
                    for (int n = 0; n < 2; ++n) acc[a][b][m][n] = (f32x4){0.f, 0.f, 0.f, 0.f};
        cur = nxt; cA = nA; cB = nB; ++ui;
        if (wr == 1) PG8_BAR;
    }
    PG8_WAIT_V(0);
    PG8_BAR;
#undef PG8_SA
#undef PG8_SB
#undef PG8_STAGE
#undef PG8_LDA
#undef PG8_LDB
#undef PG8_MMA
#undef PG8_WAIT_V
#undef PG8_WAIT_L
#undef PG8_BAR
#undef PG8_SCHED
}
}

#define EPI_SIMPLE_TILE() \
    static constexpr bool PERM = false; \
    template <int NAI> __device__ __forceinline__ void tile(const f32x4 (&acc)[2][2][4][2], int z, int row0, int col0) const { \
        _Pragma("unroll") for (int ai = 0; ai < NAI; ++ai) _Pragma("unroll") for (int m = 0; m < 4; ++m) _Pragma("unroll") for (int bj = 0; bj < 2; ++bj) _Pragma("unroll") for (int n = 0; n < 2; ++n) \
            (*this)(z, row0 + ai * 128 + m * 16, col0 + bj * 128 + n * 16, acc[ai][bj][m][n]); }
#define EPI_PAIR_TILE() \
    static constexpr bool PERM = true; \
    template <int NAI> __device__ __forceinline__ void tile(const f32x4 (&acc)[2][2][4][2], int z, int row0, int col0) const { \
        _Pragma("unroll") for (int ai = 0; ai < NAI; ++ai) _Pragma("unroll") for (int m = 0; m < 4; ++m) _Pragma("unroll") for (int bj = 0; bj < 2; ++bj) \
            pair(row0 + ai * 128 + m * 16, col0 + bj * 128, acc[ai][bj][m][0], acc[ai][bj][m][1]); }
#define EPI_PIPE_TILE() \
    static constexpr bool PERM = true; \
    template <int NAI> __device__ __forceinline__ void tile(const f32x4 (&acc)[2][2][4][2], int z, int row0, int col0) const { \
        Pre pre; begin(row0, col0, pre); L buf[2][8]; \
        _Pragma("unroll") for (int mm = 0; mm < 2; ++mm) _Pragma("unroll") for (int bj = 0; bj < 2; ++bj) _Pragma("unroll") for (int n = 0; n < 2; ++n) load(row0 + mm * 16, col0 + bj * 128 + n * 4, buf[0][mm * 4 + bj * 2 + n]); \
        _Pragma("unroll") for (int b = 0; b < 2 * NAI; ++b) { \
            if (b < 2 * NAI - 1) { _Pragma("unroll") for (int mm = 0; mm < 2; ++mm) _Pragma("unroll") for (int bj = 0; bj < 2; ++bj) _Pragma("unroll") for (int n = 0; n < 2; ++n) \
                load(row0 + ((b + 1) >> 1) * 128 + (((b + 1) & 1) * 2 + mm) * 16, col0 + bj * 128 + n * 4, buf[(b + 1) & 1][mm * 4 + bj * 2 + n]); } \
            _Pragma("unroll") for (int mm = 0; mm < 2; ++mm) _Pragma("unroll") for (int bj = 0; bj < 2; ++bj) _Pragma("unroll") for (int n = 0; n < 2; ++n) \
                apply(row0 + (b >> 1) * 128 + ((b & 1) * 2 + mm) * 16, col0 + bj * 128 + n * 4, acc[b >> 1][bj][(b & 1) * 2 + mm][n], buf[b & 1][mm * 4 + bj * 2 + n], pre, bj * 2 + n); } }
__device__ __forceinline__ void store8bf(bf16_t* ptr, f32x4 a, f32x4 b) { u32x4 w; w.x = pk_bf16(a[0], a[1]); w.y = pk_bf16(a[2], a[3]); w.z = pk_bf16(b[0], b[1]); w.w = pk_bf16(b[2], b[3]); *(u32x4*)ptr = w; }

struct EpiPartA {
    bf16_t* Q; bf16_t* Kk; bf16_t* V; bf16_t* UG; float* GLR;
    __device__ __forceinline__ void pair(int row, int col, f32x4 a, f32x4 b) const {
        if (col < 512) store8bf(Q + (size_t)row * 512 + col, a, b);
        else if (col < 1024) store8bf(Kk + (size_t)row * 512 + (col - 512), a, b);
        else if (col < 2048) store8bf(V + (size_t)row * 1024 + (col - 1024), a, b);
        else if (col < 2304) { const int c = col - 2048; if (c < 32) { *(f32x4*)(GLR + (size_t)row * 32 + c) = a; *(f32x4*)(GLR + (size_t)row * 32 + c + 4) = b; } }
        else { const int c = col - 2304, g = c >> 4, n = c & 15, chunk = row >> 5, j = row & 31; store8bf(UG + ((size_t)(g * 1280 + chunk) * 768 + j * 16 + n), a, b); }
    }
    EPI_PAIR_TILE()
};
struct EpiE { float* E; __device__ __forceinline__ void operator()(int z, int row, int col, f32x4 v) const { *(f32x4*)(E + ((size_t)(z * 1280 + row) * 256 + col)) = v; } EPI_SIMPLE_TILE() };
struct EpiY {
    bf16_t* YB;
    __device__ __forceinline__ void operator()(int z, int row, int col, f32x4 v) const {
        const int tok = row * 32 + (col >> 4), ch = z * 16 + (col & 15);
        f32x4 o;
#pragma unroll
        for (int e = 0; e < 4; ++e) { const float x = v[e]; o[e] = x * sigmoidf_(1.5957691216f * (x + 0.044715f * x * x * x)); }
        store4bf(YB + (size_t)tok * 512 + ch, o);
    }
    EPI_SIMPLE_TILE()
};
struct EpiGLU {
    const bf16_t* YB; bf16_t* OS5; const float* bglu;
    typedef u32x2 L; struct Pre { f32x4 b[4]; };
    __device__ __forceinline__ void begin(int, int col0, Pre& pr) const {
#pragma unroll
        for (int k = 0; k < 4; ++k) pr.b[k] = *(const f32x4*)(bglu + col0 + (k >> 1) * 128 + (k & 1) * 4); }
    __device__ __forceinline__ void load(int row, int col, L& l) const { l = *(const u32x2*)(YB + (size_t)row * 512 + col); }
    __device__ __forceinline__ void apply(int row, int col, f32x4 v, const L& l, const Pre& pr, int k) const {
        const f32x4 y = (f32x4){bflo(l.x), bfhi(l.x), bflo(l.y), bfhi(l.y)}; f32x4 o;
#pragma unroll
        for (int e = 0; e < 4; ++e) o[e] = y[e] * sigmoidf_(v[e] + pr.b[k][e]);
        store4bf(OS5 + (size_t)row * 512 + col, o); }
    EPI_PIPE_TILE()
};
struct EpiPartB {
    bf16_t* R; bf16_t* GA; bf16_t* GB;
    __device__ __forceinline__ void pair(int row, int col, f32x4 a, f32x4 b) const {
        f32x4 sa, sb;
#pragma unroll
        for (int e = 0; e < 4; ++e) { sa[e] = sigmoidf_(a[e]); sb[e] = sigmoidf_(b[e]); }
        if (col < 1024) store8bf(R + (size_t)row * 1024 + col, a * sa, b * sb);
        else if (col < 2048) store8bf(GA + (size_t)row * 1024 + (col - 1024), sa, sb);
        else store8bf(GB + (size_t)row * 1024 + (col - 2048), sa, sb);
    }
    EPI_PAIR_TILE()
};
struct EpiProj1 { const bf16_t* GA; bf16_t* T1;
    typedef u32x2 L; struct Pre { int dummy; };
    __device__ __forceinline__ void begin(int, int, Pre&) const {}
    __device__ __forceinline__ void load(int row, int col, L& l) const { l = *(const u32x2*)(GA + (size_t)row * 1024 + col); }
    __device__ __forceinline__ void apply(int row, int col, f32x4 v, const L& l, const Pre&, int) const {
        const f32x4 g = (f32x4){bflo(l.x), bfhi(l.x), bflo(l.y), bfhi(l.y)}; store4bf(T1 + (size_t)row * 1024 + col, g * v); }
    EPI_PIPE_TILE()
};
struct EpiProj2 { const bf16_t* GB; bf16_t* T1;
    struct L { u32x2 t, g; }; struct Pre { int dummy; };
    __device__ __forceinline__ void begin(int, int, Pre&) const {}
    __device__ __forceinline__ void load(int row, int col, L& l) const { const size_t o = (size_t)row * 1024 + col; l.t = *(const u32x2*)(T1 + o); l.g = *(const u32x2*)(GB + o); }
    __device__ __forceinline__ void apply(int row, int col, f32x4 v, const L& l, const Pre&, int) const {
        const f32x4 g = (f32x4){bflo(l.g.x), bfhi(l.g.x), bflo(l.g.y), bfhi(l.g.y)}, t = (f32x4){bflo(l.t.x), bfhi(l.t.x), bflo(l.t.y), bfhi(l.t.y)};
        store4bf(T1 + (size_t)row * 1024 + col, t + g * v); }
    EPI_PIPE_TILE()
};
struct EpiDelta { bf16_t* Dl; const float* gate;
    static constexpr bool PERM = true;
    template <int NAI> __device__ __forceinline__ void tile(const f32x4 (&acc)[2][2][4][2], int, int row0, int col0) const {
        const float* gp = gate + (size_t)mod_index(row0) * 6144 + col0; f32x4 g[2][2];
#pragma unroll
        for (int bj = 0; bj < 2; ++bj)
#pragma unroll
            for (int n = 0; n < 2; ++n) g[bj][n] = *(const f32x4*)(gp + bj * 128 + n * 4);
#pragma unroll
        for (int ai = 0; ai < NAI; ++ai)
#pragma unroll
            for (int m = 0; m < 4; ++m)
#pragma unroll
                for (int bj = 0; bj < 2; ++bj) store8bf(Dl + (size_t)(row0 + ai * 128 + m * 16) * 1024 + col0 + bj * 128, g[bj][0] * acc[ai][bj][m][0], g[bj][1] * acc[ai][bj][m][1]);
    } };
struct EpiFF1 { bf16_t* H;
    __device__ __forceinline__ void pair(int row, int col, f32x4 a, f32x4 b) const {
        f32x4 oa, ob;
#pragma unroll
        for (int e = 0; e < 4; ++e) { const float ra = fmaxf(a[e], 0.f), rb = fmaxf(b[e], 0.f); oa[e] = ra * ra; ob[e] = rb * rb; }
        store8bf(H + (size_t)row * 4096 + col, oa, ob); }
    EPI_PAIR_TILE()
};

struct ConvJob { const float* src; int ld, K, c0, nvalid, ndst; bf16_t* dst; float scale; };
__device__ __forceinline__ bool conv_job(const P& p, int l, int j, ConvJob& J) {
    bf16_t* W = (bf16_t*)(p.ws + WS_W);
    const float* win = p.in[lnd(10)] + (size_t)l * 1024 * 5664;
    J.scale = 1.0f;
    switch (j) {
        case 0: J = {win, 5664, 1024, 0, 512, 512, W + W_A / 2, 0.08838834764831845f}; break;
        case 1: J = {win, 5664, 1024, 512, 512, 512, W + W_A / 2 + (size_t)512 * 1024, 1.f}; break;
        case 2: J = {win, 5664, 1024, 1024, 1024, 1024, W + W_A / 2 + (size_t)1024 * 1024, 1.f}; break;
        case 3: J = {win, 5664, 1024, 3072, 32, 256, W + W_A / 2 + (size_t)2048 * 1024, 1.f}; break;
        case 4: J = {win, 5664, 1024, 3104, 512, 512, W + W_A / 2 + (size_t)2304 * 1024, 1.f}; break;
        case 5: J = {win, 5664, 1024, 2048, 1024, 1024, W + W_B / 2, 1.f}; break;
        case 6: J = {win, 5664, 1024, 3616, 1024, 1024, W + W_B / 2 + (size_t)1024 * 1024, 1.f}; break;
        case 7: J = {win, 5664, 1024, 4640, 1024, 1024, W + W_B / 2 + (size_t)2048 * 1024, 1.f}; break;
        case 8: J = {p.in[lnd(14)] + (size_t)l * 1024 * 1024, 1024, 1024, 0, 1024, 1024, W + W_PG / 2, 1.f}; break;
        case 9: J = {p.in[lnd(23)] + (size_t)l * 512 * 512, 512, 512, 0, 512, 512, W + W_GLU / 2, 1.f}; break;
        case 10: J = {p.in[lnd(25)] + (size_t)l * 512 * 1024, 1024, 512, 0, 1024, 1024, W + W_PS / 2, 1.f}; break;
        case 11: J = {p.in[lnd(26)] + (size_t)l * 1024 * 1024, 1024, 1024, 0, 1024, 1024, W + W_OUT / 2, 1.f}; break;
        case 12: J = {p.in[lnd(28)] + (size_t)l * 1024 * 4096, 4096, 1024, 0, 4096, 4096, W + W_1 / 2, 1.f}; break;
        case 13: J = {p.in[lnd(29)] + (size_t)l * 4096 * 1024, 1024, 4096, 0, 1024, 1024, W + W_2 / 2, 1.f}; break;
        default: return false;
    }
    return true;
}
constexpr int CONV_TILES = 2112;
__device__ __forceinline__ void conv_tile(const P& p, int l, int tile, LAS float* sT) {
    const int tid = tid_();
    ConvJob J; int j = 0, rem = tile;
    for (; j < 14; ++j) { conv_job(p, l, j, J); const int nt = (J.ndst / 64) * (J.K / 128); if (rem < nt) break; rem -= nt; }
    const int kts = J.K / 128, ntile = rem / kts, ktile = rem % kts, n0 = ntile * 64, k0 = ktile * 128;
    {
        const int kk = tid >> 4, c4 = (tid & 15) * 4; f32x4 v[4];
#pragma unroll
        for (int i = 0; i < 4; ++i) { v[i] = (f32x4){0.f, 0.f, 0.f, 0.f};
            if (n0 + c4 < J.nvalid) v[i] = *(const f32x4*)(J.src + (size_t)(k0 + kk + 32 * i) * J.ld + J.c0 + n0 + c4); }
#pragma unroll
        for (int i = 0; i < 4; ++i)
#pragma unroll
            for (int e = 0; e < 4; ++e) sT[(c4 + e) * 129 + kk + 32 * i] = v[i][e] * J.scale;
    }
    __syncthreads();
    {
        const int n = tid >> 3, ks = (tid & 7) * 16;
        const int rho = n & 31, nsrc = (n & ~31) + 8 * ((rho & 15) >> 2) + 4 * (rho >> 4) + (rho & 3);
        const LAS float* sp = sT + nsrc * 129 + ks;
#pragma unroll
        for (int hh = 0; hh < 2; ++hh) { u32x4 w; const LAS float* q = sp + 8 * hh;
            w.x = pk_bf16(q[0], q[1]); w.y = pk_bf16(q[2], q[3]); w.z = pk_bf16(q[4], q[5]); w.w = pk_bf16(q[6], q[7]);
            *(u32x4*)(J.dst + (size_t)(n0 + n) * J.K + k0 + ks + 8 * hh) = w; }
    }
}

__device__ __forceinline__ void mod_task(const P& p, int m, LAS float* sm) {
    const int tid = tid_(), l = m / 192, colbase = (m % 192) * 32, cl = tid & 31, ks = tid >> 5;
    LAS float* SC = sm; LAS float* RED = sm + 9216;
    for (int i = tid; i < 9216; i += NTHR) { const int j = i >> 10, k = i & 1023; const float c = (j == 0) ? p.in[lnd(6)][k] : p.in[lnd(2)][(j - 1) * 1024 + k]; SC[i] = c * sigmoidf_(c); }
    __syncthreads();
    float acc[9];
#pragma unroll
    for (int j = 0; j < 9; ++j) acc[j] = 0.f;
    const float* w = p.in[lnd(7)] + (size_t)l * 1024 * 6144 + colbase + cl;
    for (int k8 = 0; k8 < 64; k8 += 16) { float wv[16];
#pragma unroll
        for (int u = 0; u < 16; ++u) wv[u] = w[(size_t)(ks * 64 + k8 + u) * 6144];
#pragma unroll
        for (int u = 0; u < 16; ++u)
#pragma unroll
            for (int j = 0; j < 9; ++j) acc[j] += SC[j * 1024 + ks * 64 + k8 + u] * wv[u]; }
#pragma unroll
    for (int j = 0; j < 9; ++j) RED[(ks * 9 + j) * 32 + cl] = acc[j];
    __syncthreads();
    if (tid < 288) { const int j = tid >> 5, c = tid & 31; float s = 0.f;
#pragma unroll
        for (int q = 0; q < 16; ++q) s += RED[(q * 9 + j) * 32 + c];
        float* mod = (float*)(p.ws + WS_MOD);
        mod[((size_t)l * 9 + j) * 6144 + colbase + c] = s + p.in[lnd(8)][(size_t)l * 6144 + colbase + c]; }
}

__device__ __forceinline__ void s5_mats(const P& p, int l, int gq, LAS float* sm) {
    const int tid = tid_(), g = gq >> 2, part = gq & 3;
    LAS float* KF = sm; LAS float* KB = sm + 8192; LAS float* LT = sm + 16384; LAS float* CC = sm + 20608; LAS float* BB = sm + 22656;
    bf16_t* MC = (bf16_t*)(p.ws + WS_R1) + (size_t)g * 512 * 768;
    bf16_t* EM = (bf16_t*)(p.ws + WS_EMAT) + (size_t)g * 256 * 512;
    for (int d = 0; d < 2; ++d) {
        const int pg = (l * 2 + d) * 32 + g;
        const float* lamr = p.in[lnd(15)] + (size_t)pg * 64; const float* lami = p.in[lnd(16)] + (size_t)pg * 64;
        const float dt = expf(p.in[lnd(17)][pg]);
        const float* bre = p.in[lnd(18)] + (size_t)pg * 1024; const float* bim = p.in[lnd(19)] + (size_t)pg * 1024;
        const float* cre = p.in[lnd(20)] + (size_t)pg * 1024; const float* cim = p.in[lnd(21)] + (size_t)pg * 1024;
        for (int i = tid; i < 33 * 64; i += NTHR) { const int tau = i >> 6, pp = i & 63; const float a = expf(lamr[pp] * dt * (float)tau); float s, c; sincosf(lami[pp] * dt * (float)tau, &s, &c); LT[2 * i] = a * c; LT[2 * i + 1] = a * s; }
        for (int i = tid; i < 1024; i += NTHR) { CC[2 * i] = cre[i]; CC[2 * i + 1] = cim[i]; }
        for (int i = tid; i < 1024; i += NTHR) {
            const int pp = i >> 4; const float lr = lamr[pp], li = lami[pp]; float s, c; sincosf(li * dt, &s, &c);
            const float em1 = expm1f(lr * dt); float sh, ch; sincosf(0.5f * li * dt, &sh, &ch);
            const float nr = em1 * c - 2.f * sh * sh, ni = (em1 + 1.f) * s;
            const float inv = 1.f / (lr * lr + li * li);
            const float qr = (nr * lr + ni * li) * inv, qi = (ni * lr - nr * li) * inv;
            const float br = bre[i], bi = bim[i];
            BB[2 * i] = qr * br - qi * bi; BB[2 * i + 1] = qr * bi + qi * br;
        }
        __syncthreads();
        {
            const int tau = tid >> 4, n = tid & 15; float acc[16];
#pragma unroll
            for (int m = 0; m < 16; ++m) acc[m] = 0.f;
            const bool need = d == 0 ? (tau <= 31 - 8 * part) : (tau <= 8 * part + 7);
            if (need) for (int pp = 0; pp < 64; ++pp) {
                const float cr = CC[2 * (n * 64 + pp)], ci = CC[2 * (n * 64 + pp) + 1], lr = LT[2 * (tau * 64 + pp)], li = LT[2 * (tau * 64 + pp) + 1];
                const float xr = cr * lr - ci * li, xi = cr * li + ci * lr;
#pragma unroll
                for (int m = 0; m < 16; ++m) acc[m] += xr * BB[2 * (pp * 16 + m)] - xi * BB[2 * (pp * 16 + m) + 1];
            }
            LAS float* Kd = d ? KB : KF;
#pragma unroll
            for (int m = 0; m < 16; ++m) Kd[(tau * 16 + n) * 16 + m] = acc[m];
        }
        {
            const int pp = tid >> 3, cseg = tid & 7;
            { const int jj = part;
                const int j = cseg * 4 + jj, e = d == 0 ? 31 - j : j; const float lr = LT[2 * (e * 64 + pp)], li = LT[2 * (e * 64 + pp) + 1];
                float re[16], im[16];
#pragma unroll
                for (int m = 0; m < 16; ++m) { const float br = BB[2 * (pp * 16 + m)], bi = BB[2 * (pp * 16 + m) + 1]; re[m] = lr * br - li * bi; im[m] = lr * bi + li * br; }
                bf16_t* er = EM + (size_t)(d * 128 + pp) * 512 + j * 16; bf16_t* ei = EM + (size_t)(d * 128 + 64 + pp) * 512 + j * 16;
#pragma unroll
                for (int h = 0; h < 2; ++h) {
                    u32x4 w; w.x = pk_bf16(re[8 * h], re[8 * h + 1]); w.y = pk_bf16(re[8 * h + 2], re[8 * h + 3]); w.z = pk_bf16(re[8 * h + 4], re[8 * h + 5]); w.w = pk_bf16(re[8 * h + 6], re[8 * h + 7]); *(u32x4*)(er + 8 * h) = w;
                    u32x4 x; x.x = pk_bf16(im[8 * h], im[8 * h + 1]); x.y = pk_bf16(im[8 * h + 2], im[8 * h + 3]); x.z = pk_bf16(im[8 * h + 4], im[8 * h + 5]); x.w = pk_bf16(im[8 * h + 6], im[8 * h + 7]); *(u32x4*)(ei + 8 * h) = x;
                }
            }
        }
        {
            const int t = tid >> 4, n = tid & 15, f = d == 0 ? t + 1 : 32 - t;
            bf16_t* mr = MC + (size_t)tid * 768 + 512 + d * 128;
#pragma unroll 1
            for (int p8 = 2 * part; p8 < 2 * part + 2; ++p8) {
                float re[8], im[8];
#pragma unroll
                for (int q = 0; q < 8; ++q) { const int pp = p8 * 8 + q; const float cr = CC[2 * (n * 64 + pp)], ci = CC[2 * (n * 64 + pp) + 1], lr = LT[2 * (f * 64 + pp)], li = LT[2 * (f * 64 + pp) + 1];
                    re[q] = cr * lr - ci * li; im[q] = -(cr * li + ci * lr); }
                u32x4 w; w.x = pk_bf16(re[0], re[1]); w.y = pk_bf16(re[2], re[3]); w.z = pk_bf16(re[4], re[5]); w.w = pk_bf16(re[6], re[7]); *(u32x4*)(mr + p8 * 8) = w;
                u32x4 x; x.x = pk_bf16(im[0], im[1]); x.y = pk_bf16(im[2], im[3]); x.z = pk_bf16(im[4], im[5]); x.w = pk_bf16(im[6], im[7]); *(u32x4*)(mr + 64 + p8 * 8) = x;
            }
        }
        __syncthreads();
    }
    {
        const int t = tid >> 4, n = tid & 15; const float dsk = p.in[lnd(22)][(size_t)l * 512 + g * 16 + n];
        bf16_t* mr = MC + (size_t)tid * 768;
#pragma unroll 1
        for (int j = 8 * part; j < 8 * part + 8; ++j) {
            float v[16];
#pragma unroll
            for (int m = 0; m < 16; ++m) v[m] = 0.f;
            if (j <= t) { const LAS float* k = KF + ((t - j) * 16 + n) * 16;
#pragma unroll
                for (int m = 0; m < 16; ++m) v[m] += k[m]; }
            if (j >= t) { const LAS float* k = KB + ((j - t) * 16 + n) * 16;
#pragma unroll
                for (int m = 0; m < 16; ++m) v[m] += k[m]; }
            if (j == t) {
#pragma unroll
                for (int m = 0; m < 16; ++m) v[m] += (m == n) ? dsk : 0.f; }
            u32x4 w; w.x = pk_bf16(v[0], v[1]); w.y = pk_bf16(v[2], v[3]); w.z = pk_bf16(v[4], v[5]); w.w = pk_bf16(v[6], v[7]); *(u32x4*)(mr + j * 16) = w;
            u32x4 x; x.x = pk_bf16(v[8], v[9]); x.y = pk_bf16(v[10], v[11]); x.z = pk_bf16(v[12], v[13]); x.w = pk_bf16(v[14], v[15]); *(u32x4*)(mr + j * 16 + 8) = x;
        }
    }
}

__device__ __forceinline__ void phase_prep(const P& p, int l, LAS unsigned char* lds) {
    LAS float* sm = (LAS float*)lds;
    const int b = bid_(), G = gridDim.x, ha = G >> 1;
    if (b < ha) { for (int t = b; t < 128; t += ha) { s5_mats(p, l, t, sm); __syncthreads(); } }
    else { for (int t = b - ha; t < CONV_TILES; t += G - ha) { conv_tile(p, l, t, sm); __syncthreads(); } }
    if (l == 0) for (int t = b; t < 384; t += G) { mod_task(p, t, sm); __syncthreads(); }
}

__device__ __forceinline__ void norm_row_write(const f32x4 (&x)[4], const float* g, const float* mod, int shoff, int scoff, bf16_t* hrow, int lane) {
    float ss = 0.f;
#pragma unroll
    for (int i = 0; i < 4; ++i) ss += x[i][0] * x[i][0] + x[i][1] * x[i][1] + x[i][2] * x[i][2] + x[i][3] * x[i][3];
    ss = wave_sum(ss);
    const float rstd = rsqrtf(ss * (1.0f / 1024.0f) + 1e-6f);
#pragma unroll
    for (int i = 0; i < 4; ++i) { const int d = i * 256 + lane * 4; const f32x4 gg = *(const f32x4*)(g + d), sc = *(const f32x4*)(mod + scoff + d), sh = *(const f32x4*)(mod + shoff + d);
        f32x4 h;
#pragma unroll
        for (int e = 0; e < 4; ++e) h[e] = x[i][e] * rstd * gg[e] * (1.f + sc[e]) + sh[e];
        { u32x2 w; w.x = pk_bf16(h[0], h[1]); w.y = pk_bf16(h[2], h[3]); __builtin_nontemporal_store(w, (u32x2*)(hrow + d)); } }
}
__device__ __forceinline__ void phase_norm(const P& p, int l, int which) {
    const int lane = tid_() & 63, gw = bid_() * 8 + (tid_() >> 6), nw = gridDim.x * 8;
    const float* g = (which == 1 ? p.in[lnd(9)] : p.in[lnd(27)]) + (size_t)l * 1024;
    const float* modl = (const float*)(p.ws + WS_MOD) + (size_t)l * 9 * 6144;
    const int shoff = which == 1 ? 0 : 3072, scoff = which == 1 ? 1024 : 4096;
    bf16_t* H = (bf16_t*)(p.ws + WS_R2); float* X = p.out;
    if (which == 1 && l == 0) {
        for (int item = gw; item < 4096 + 8192; item += nw) {
            if (item < 4096) {
                const int n = item; const float rr = (float)(n >> 6), cc = (float)(n & 63); f32x4 pe[4];
#pragma unroll
                for (int e = 0; e < 4; ++e) { const float om = expf(-(float)(lane * 4 + e) * (9.210340371976184f / 256.0f)); float s, c; sincosf(rr * om, &s, &c); pe[0][e] = s; pe[1][e] = c; sincosf(cc * om, &s, &c); pe[2][e] = s; pe[3][e] = c; }
                for (int b0 = 0; b0 < 8; b0 += 2) { f32x4 x[2][4];
#pragma unroll
                    for (int r = 0; r < 2; ++r) { const float* src = p.in[lnd(1)] + ((size_t)(b0 + r) * 4096 + n) * 1024;
#pragma unroll
                        for (int i = 0; i < 4; ++i) x[r][i] = *(const f32x4*)(src + i * 256 + lane * 4); }
#pragma unroll
                    for (int r = 0; r < 2; ++r) { const int row = TOKP + (b0 + r) * 4096 + n;
#pragma unroll
                        for (int i = 0; i < 4; ++i) { x[r][i] = x[r][i] + pe[i]; *(f32x4*)(X + (size_t)row * 1024 + i * 256 + lane * 4) = x[r][i]; }
                        norm_row_write(x[r], g, modl + (size_t)(1 + b0 + r) * 6144, shoff, scoff, H + (size_t)row * 1024, lane); } }
            } else { const int row = item - 4096; const float* src = p.in[lnd(0)] + (size_t)row * 1024; f32x4 x[4];
#pragma unroll
                for (int i = 0; i < 4; ++i) { x[i] = *(const f32x4*)(src + i * 256 + lane * 4); *(f32x4*)(X + (size_t)row * 1024 + i * 256 + lane * 4) = x[i]; }
                norm_row_write(x, g, modl, shoff, scoff, H + (size_t)row * 1024, lane); }
        }
    } else {
        const bf16_t* DL = (const bf16_t*)(p.ws + (which == 1 ? WS_R2 : WS_R3));
        for (int it = gw; it < TOK / 4; it += nw) {
            const int rowb = it * 4; const float* mod = modl + (size_t)mod_index(rowb) * 6144;
            f32x4 x[4][4]; u32x2 dv[4][4];
#pragma unroll
            for (int r = 0; r < 4; ++r)
#pragma unroll
                for (int i = 0; i < 4; ++i) { x[r][i] = __builtin_nontemporal_load((const f32x4*)(X + (size_t)(rowb + r) * 1024 + i * 256 + lane * 4)); dv[r][i] = __builtin_nontemporal_load((const u32x2*)(DL + (size_t)(rowb + r) * 1024 + i * 256 + lane * 4)); }
            f32x4 gs[4], sh[4];
#pragma unroll
            for (int i = 0; i < 4; ++i) { const int d = i * 256 + lane * 4; const f32x4 gg = *(const f32x4*)(g + d), sc = *(const f32x4*)(mod + scoff + d); sh[i] = *(const f32x4*)(mod + shoff + d); gs[i] = gg * (sc + 1.f); }
#pragma unroll
            for (int r = 0; r < 4; ++r) { float ss = 0.f;
#pragma unroll
                for (int i = 0; i < 4; ++i) { x[r][i] = x[r][i] + (f32x4){bflo(dv[r][i].x), bfhi(dv[r][i].x), bflo(dv[r][i].y), bfhi(dv[r][i].y)}; *(f32x4*)(X + (size_t)(rowb + r) * 1024 + i * 256 + lane * 4) = x[r][i];
                    ss += x[r][i][0] * x[r][i][0] + x[r][i][1] * x[r][i][1] + x[r][i][2] * x[r][i][2] + x[r][i][3] * x[r][i][3]; }
                ss = wave_sum(ss); const float rstd = rsqrtf(ss * (1.0f / 1024.0f) + 1e-6f);
#pragma unroll
                for (int i = 0; i < 4; ++i) { const f32x4 hv = x[r][i] * rstd * gs[i] + sh[i]; u32x2 w; w.x = pk_bf16(hv[0], hv[1]); w.y = pk_bf16(hv[2], hv[3]); __builtin_nontemporal_store(w, (u32x2*)(H + (size_t)(rowb + r) * 1024 + i * 256 + lane * 4)); } }
        }
    }
}
__device__ __forceinline__ void phase_final(const P& p) {
    const int lane = tid_() & 63, gw = bid_() * 8 + (tid_() >> 6), nw = gridDim.x * 8; float* X = p.out; const float* g = p.in[lnd(30)]; const bf16_t* DL = (const bf16_t*)(p.ws + WS_R2);
    for (int row0 = gw; row0 < TOK; row0 += 4 * nw) {
        f32x4 x[4][4]; u32x2 dv[4][4];
#pragma unroll
        for (int r = 0; r < 4; ++r) { const int row = row0 + r * nw;
            if (row < TOK) {
#pragma unroll
                for (int i = 0; i < 4; ++i) { x[r][i] = __builtin_nontemporal_load((const f32x4*)(X + (size_t)row * 1024 + i * 256 + lane * 4)); dv[r][i] = __builtin_nontemporal_load((const u32x2*)(DL + (size_t)row * 1024 + i * 256 + lane * 4)); } } }
#pragma unroll
        for (int r = 0; r < 4; ++r) { const int row = row0 + r * nw;
            if (row < TOK) { float ss = 0.f;
#pragma unroll
                for (int i = 0; i < 4; ++i) { x[r][i] = x[r][i] + (f32x4){bflo(dv[r][i].x), bfhi(dv[r][i].x), bflo(dv[r][i].y), bfhi(dv[r][i].y)}; ss += x[r][i][0] * x[r][i][0] + x[r][i][1] * x[r][i][1] + x[r][i][2] * x[r][i][2] + x[r][i][3] * x[r][i][3]; }
                ss = wave_sum(ss); const float rstd = rsqrtf(ss * (1.0f / 1024.0f) + 1e-6f);
#pragma unroll
                for (int i = 0; i < 4; ++i) { const f32x4 gg = *(const f32x4*)(g + i * 256 + lane * 4); *(f32x4*)(X + (size_t)row * 1024 + i * 256 + lane * 4) = x[r][i] * rstd * gg; } } }
    }
}

__device__ __forceinline__ void phase_s5scan(const P& p, int l) {
    const float* E = (const float*)(p.ws + WS_E); bf16_t* UG = (bf16_t*)(p.ws + WS_R5);
    float* ore = p.out + (size_t)TOK * 1024 + 16777216; float* oim = ore + 262144;
    for (int task = bid_(); task < 320; task += gridDim.x) {
        const int idx = task * NTHR + tid_(), pp = idx & 63, d = (idx >> 6) & 1, g = (idx >> 7) & 31, s = 39 - (idx >> 12);
        const int nch = s < 32 ? 8 : 128, cbase = s < 32 ? s * 8 : 256 + (s - 32) * 128;
        const int pg = (l * 2 + d) * 32 + g; const float dt = expf(p.in[lnd(17)][pg]);
        const float a = expf(p.in[lnd(15)][(size_t)pg * 64 + pp] * dt * 32.f); float sn, cs; sincosf(p.in[lnd(16)][(size_t)pg * 64 + pp] * dt * 32.f, &sn, &cs);
        const float ar = a * cs, ai = a * sn;
        float sr = 0.f, si = 0.f;
        if (s >= 32) { const size_t o = ((((size_t)(s - 32) * 2 + l) * 2 + d) * 32 + g) * 64 + pp; sr = p.in[lnd(4)][o]; si = p.in[lnd(5)][o]; }
        const float* Eb = E + ((size_t)(g * 1280 + cbase) * 256 + d * 128 + pp);
        bf16_t* Ub = UG + ((size_t)(g * 1280 + cbase) * 768 + 512 + d * 128 + pp);
        for (int c0 = 0; c0 < nch; c0 += 8) {
            float er[8], ei[8];
#pragma unroll
            for (int k = 0; k < 8; ++k) { const int c = d == 0 ? c0 + k : nch - 1 - (c0 + k); er[k] = Eb[(size_t)c * 256]; ei[k] = Eb[(size_t)c * 256 + 64]; }
#pragma unroll
            for (int k = 0; k < 8; ++k) { const int c = d == 0 ? c0 + k : nch - 1 - (c0 + k);
                Ub[(size_t)c * 768] = f2bf(sr); Ub[(size_t)c * 768 + 64] = f2bf(si);
                const float nr = ar * sr - ai * si + er[k], ni = ar * si + ai * sr + ei[k]; sr = nr; si = ni; }
        }
        if (s < 32) { const size_t o = ((((size_t)s * 2 + l) * 2 + d) * 32 + g) * 64 + pp; ore[o] = sr; oim[o] = si; }
    }
}

__device__ __forceinline__ void phase_glapre(const P& p, int l, LAS unsigned char* lds) {
    const int tid = tid_(), d = tid & 127, tq = tid >> 7, wv = tid >> 6, lane = tid & 63, fr = lane & 15, fq = lane >> 4;
    LAS float* sG = (LAS float*)lds; LAS float* sT4 = sG + 2048; LAS float* sZ = sG + 2560;
    bf16_t* Q = (bf16_t*)(p.ws + WS_R3); bf16_t* Kk = Q + (size_t)TOK * 512;
    bf16_t* QB = (bf16_t*)(p.ws + WS_R5); bf16_t* KB = QB + (size_t)TOK * 512;
    const float* GLR = (const float*)(p.ws + WS_GLR);
    bf16x8 bw[2]; int hcur = -1;
    for (int task = bid_(); task < 2560; task += gridDim.x) {
        const int c64 = task >> 2, h = task & 3, tb = c64 * 64;
        { const int row = tid >> 3, c4 = (tid & 7) * 4; *(LAS f32x4*)(sG + row * 32 + c4) = *(const f32x4*)(GLR + (size_t)(tb + row) * 32 + c4); }
        float qv[16], kv[16];
#pragma unroll
        for (int i = 0; i < 16; ++i) { const size_t o = (size_t)(tb + tq * 16 + i) * 512 + h * 128 + d; qv[i] = bf2f(Q[o]); kv[i] = bf2f(Kk[o]); }
        if (h != hcur) { hcur = h;
#pragma unroll
        for (int dir = 0; dir < 2; ++dir) { float w8[8];
#pragma unroll
            for (int e = 0; e < 8; ++e) { const int kk = 8 * fq + e - 16 * dir; w8[e] = (kk >= 0 && kk < 16) ? p.in[lnd(11)][((size_t)(l * 2 + dir) * 16 + kk) * 512 + h * 128 + 16 * wv + fr] : 0.f; }
            u32x4 pk; pk.x = pk_bf16(w8[0], w8[1]); pk.y = pk_bf16(w8[2], w8[3]); pk.z = pk_bf16(w8[4], w8[5]); pk.w = pk_bf16(w8[6], w8[7]);
            bw[dir] = __builtin_bit_cast(bf16x8, pk); } }
        __syncthreads();
#pragma unroll
        for (int ti = 0; ti < 4; ++ti) {
            const LAS float* gr = sG + (16 * ti + fr) * 32 + 8 * fq; const f32x4 g0 = *(const LAS f32x4*)gr, g1 = *(const LAS f32x4*)(gr + 4);
            u32x4 pk; pk.x = pk_bf16(g0[0], g0[1]); pk.y = pk_bf16(g0[2], g0[3]); pk.z = pk_bf16(g1[0], g1[1]); pk.w = pk_bf16(g1[2], g1[3]);
            const bf16x8 af = __builtin_bit_cast(bf16x8, pk);
#pragma unroll
            for (int dir = 0; dir < 2; ++dir) { const f32x4 z = __builtin_amdgcn_mfma_f32_16x16x32_bf16(af, bw[dir], (f32x4){0.f, 0.f, 0.f, 0.f}, 0, 0, 0);
#pragma unroll
                for (int e = 0; e < 4; ++e) sZ[(dir * 64 + 16 * ti + 4 * fq + e) * 128 + 16 * wv + fr] = z[e]; }
        }
        __syncthreads();
#pragma unroll 1
        for (int dir = 0; dir < 2; ++dir) {
            const float bg = p.in[lnd(12)][(size_t)(l * 2 + dir) * 512 + h * 128 + d];
            float cum[16];
#pragma unroll
            for (int i = 0; i < 16; ++i) { const float z = sZ[(dir * 64 + tq * 16 + i) * 128 + d] + bg;
                cum[i] = (fminf(z, 0.f) - __logf(1.0f + __expf(-fabsf(z)))) * 0.0625f; }
            if (dir == 0) {
#pragma unroll
                for (int i = 1; i < 16; ++i) cum[i] += cum[i - 1];
            } else {
#pragma unroll
                for (int i = 14; i >= 0; --i) cum[i] += cum[i + 1];
            }
            sT4[tq * 128 + d] = dir == 0 ? cum[15] : cum[0];
            __syncthreads();
            float off = 0.f, total = 0.f;
#pragma unroll
            for (int q = 0; q < 4; ++q) { const float v = sT4[q * 128 + d]; total += v; if (dir == 0 ? (q < tq) : (q > tq)) off += v; }
            bf16_t* QD = dir == 0 ? Q : QB; bf16_t* KI = dir == 0 ? Kk : KB;
#pragma unroll
            for (int i = 0; i < 16; ++i) { const float cm = cum[i] + off; const size_t o = (size_t)(tb + tq * 16 + i) * 512 + h * 128 + d;
                QD[o] = f2bf(qv[i] * __expf(cm)); KI[o] = f2bf(kv[i] * __expf(-cm)); }
            if (tq == 0) ((float*)(p.ws + (dir == 0 ? WS_TOTF : WS_TOTB)))[(size_t)c64 * 512 + h * 128 + d] = total;
            __syncthreads();
        }
    }
}

constexpr int GLA_GRP = 71168;
typedef short s16x4 __attribute__((ext_vector_type(4)));
__device__ __forceinline__ bf16x8 tr_frag(const LAS bf16_t* base, int stride, int krow0, int col0, int fr, int fq) {
    const LAS bf16_t* q = base + (krow0 + 8 * fq + (fr >> 2)) * stride + col0 + 4 * (fr & 3);
    const s16x4 a = __builtin_amdgcn_ds_read_tr16_b64_v4i16((LAS s16x4*)q);
    const s16x4 b = __builtin_amdgcn_ds_read_tr16_b64_v4i16((LAS s16x4*)(q + 4 * stride));
    return __builtin_shufflevector(a, b, 0, 1, 2, 3, 4, 5, 6, 7);
}
__device__ __forceinline__ bf16x8 tr_frag_perm(const LAS bf16_t* base, int stride, int ks, int col0, int fr, int fq) {
    const LAS bf16_t* q = base + (32 * ks + 4 * fq + (fr >> 2)) * stride + col0 + 4 * (fr & 3);
    const s16x4 a = __builtin_amdgcn_ds_read_tr16_b64_v4i16((LAS s16x4*)q);
    const s16x4 b = __builtin_amdgcn_ds_read_tr16_b64_v4i16((LAS s16x4*)(q + 16 * stride));
    return __builtin_shufflevector(a, b, 0, 1, 2, 3, 4, 5, 6, 7);
}
#define LDS_BAR() do { asm volatile("s_waitcnt lgkmcnt(0)" ::: "memory"); __builtin_amdgcn_s_barrier(); asm volatile("" ::: "memory"); } while (0)
__device__ __forceinline__ void phase_gla(const P& p, int l, LAS unsigned char* lds) {
    const int tid = tid_(), grp = __builtin_amdgcn_readfirstlane(tid >> 8), gt = tid & 255, wv = __builtin_amdgcn_readfirstlane((tid >> 6) & 3), lane = tid & 63, fr = lane & 15, fq = lane >> 4;
    LAS unsigned char* gl = lds + grp * GLA_GRP;
    LAS bf16_t* sQ = (LAS bf16_t*)gl; LAS bf16_t* sK = (LAS bf16_t*)(gl + 17408); LAS bf16_t* sV = (LAS bf16_t*)(gl + 34816);
    LAS bf16_t* sP = (LAS bf16_t*)(gl + 44032); LAS bf16_t* sS = (LAS bf16_t*)(gl + 53248); LAS float* sTot = (LAS float*)(gl + 70656);
    const bf16_t* QD = grp == 0 ? (const bf16_t*)(p.ws + WS_R3) : (const bf16_t*)(p.ws + WS_R5);
    const bf16_t* KI = QD + (size_t)TOK * 512;
    const bf16_t* V = (const bf16_t*)(p.ws + WS_R4);
    const float* TOT = (const float*)(p.ws + (grp == 0 ? WS_TOTF : WS_TOTB));
    bf16_t* O = (bf16_t*)(p.ws + WS_R1);
    float* OST = p.out + (size_t)TOK * 1024;
    const int G = gridDim.x, b = bid_();
    const bool custom = (G == 256);
    const int ntask_mine = custom ? (b < 128 ? 1 : 4) : ((640 - b + G - 1) / G);
    for (int ti = 0; ti < ntask_mine; ++ti) {
        const int task = custom ? (b < 128 ? b : b + 128 * ti) : b + G * ti;
        if (task >= 640) break;
        const bool sample = task < 128;
        const int t2 = sample ? task : task - 128, xcd_ = t2 & 7, vs = (t2 >> 3) & 3, sh_ = xcd_ + 8 * (t2 >> 5), sb = sh_ >> 2, h = sh_ & 3;
        const int base = sample ? TOKP + sb * 4096 : sb * 256, nch = sample ? 64 : 4;
        f32x4 accS[2][4];
#pragma unroll
        for (int dt = 0; dt < 2; ++dt)
#pragma unroll
            for (int vt = 0; vt < 4; ++vt) {
                f32x4 a = (f32x4){0.f, 0.f, 0.f, 0.f};
                if (sample) { const float* cp = p.in[lnd(3)] + (((((size_t)sb * 2 + l) * 2 + grp) * 4 + h) * 128 + 16 * (2 * wv + dt) + 4 * fq) * 256 + vs * 64 + 16 * vt + fr;
#pragma unroll
                    for (int e = 0; e < 4; ++e) a[e] = cp[(size_t)e * 256]; }
                accS[dt][vt] = a;
                u32x2 w; w.x = pk_bf16(a[0], a[1]); w.y = pk_bf16(a[2], a[3]);
                *(LAS u32x2*)(sS + (16 * vt + fr) * 136 + 16 * (2 * wv + dt) + 4 * fq) = w;
            }
        u32x4 rq[2][4], rk[2][4], rv[2][2]; float rt[2] = {0.f, 0.f};
        u32x2 oprev[2][4];
#pragma unroll
        for (int u = 0; u < 2; ++u)
#pragma unroll
            for (int vt = 0; vt < 4; ++vt) oprev[u][vt] = (u32x2){0u, 0u};
#define GLA_CHUNK(st) (grp == 0 ? (st) : nch - 1 - (st))
#define GLA_LOAD(U, ci) do { const int tb_ = base + (ci) * 64; \
        _Pragma("unroll") for (int i = 0; i < 4; ++i) { const int idx = gt + 256 * i, row = idx >> 4, c16 = idx & 15; const size_t o = (size_t)(tb_ + row) * 512 + h * 128 + c16 * 8; rq[U][i] = *(const u32x4*)(QD + o); rk[U][i] = *(const u32x4*)(KI + o); } \
        _Pragma("unroll") for (int i = 0; i < 2; ++i) { const int idx = gt + 256 * i, row = idx >> 3, c8 = idx & 7; rv[U][i] = *(const u32x4*)(V + (size_t)(tb_ + row) * 1024 + h * 256 + vs * 64 + c8 * 8); } \
        if (gt < 128) rt[U] = TOT[(size_t)(tb_ >> 6) * 512 + h * 128 + gt]; } while (0)
#define GLA_STORE(U) do { \
        _Pragma("unroll") for (int i = 0; i < 4; ++i) { const int idx = gt + 256 * i, row = idx >> 4, c16 = idx & 15; *(LAS u32x4*)(sQ + row * 136 + c16 * 8) = rq[U][i]; *(LAS u32x4*)(sK + row * 136 + c16 * 8) = rk[U][i]; } \
        _Pragma("unroll") for (int i = 0; i < 2; ++i) { const int idx = gt + 256 * i, row = idx >> 3, c8 = idx & 7; *(LAS u32x4*)(sV + row * 72 + c8 * 8) = rv[U][i]; } \
        if (gt < 128) sTot[gt] = rt[U]; } while (0)
#define GLA_OLOAD(U, st) do { const int tb_ = base + GLA_CHUNK(st) * 64; \
        _Pragma("unroll") for (int vt = 0; vt < 4; ++vt) oprev[U][vt] = *(const u32x2*)(O + (size_t)(tb_ + 16 * wv + fr) * 1024 + h * 256 + vs * 64 + 16 * vt + 4 * fq); } while (0)
        GLA_LOAD(0, GLA_CHUNK(0));
        GLA_STORE(0);
        GLA_LOAD(1, GLA_CHUNK(1));
        __syncthreads();
        const int half = nch >> 1;
        for (int s0 = 0; s0 < nch; s0 += 2) {
#pragma unroll
          for (int u = 0; u < 2; ++u) {
            const int s = s0 + u;
            const int ci = GLA_CHUNK(s), tb = base + ci * 64;
            const bool second = (s >= half);
            if (s == half) GLA_OLOAD(u, s);
            if (s + 1 < nch && s + 1 > half) GLA_OLOAD(u ^ 1, s + 1);
            asm volatile("" ::: "memory");
            if (s + 2 < nch) GLA_LOAD(u, GLA_CHUNK(s + 2));
            bf16x8 pfr[2];
            { bf16x8 qa[4];
#pragma unroll
            for (int ks = 0; ks < 4; ++ks) qa[ks] = *(const LAS bf16x8*)(sQ + (16 * wv + fr) * 136 + 32 * ks + 8 * fq);
            u32x2 pk2[4];
#pragma unroll
            for (int jt = 0; jt < 4; ++jt) {
                bf16x8 kb[4];
#pragma unroll
                for (int ks = 0; ks < 4; ++ks) kb[ks] = *(const LAS bf16x8*)(sK + (16 * jt + fr) * 136 + 32 * ks + 8 * fq);
                f32x4 acc = (f32x4){0.f, 0.f, 0.f, 0.f};
#pragma unroll
                for (int ks = 0; ks < 4; ++ks) acc = __builtin_amdgcn_mfma_f32_16x16x32_bf16(kb[ks], qa[ks], acc, 0, 0, 0);
                const int i = 16 * wv + fr;
#pragma unroll
                for (int e = 0; e < 4; ++e) { const int j = 16 * jt + 4 * fq + e; const bool keep = grp == 0 ? (j <= i) : (j >= i); acc[e] = keep ? acc[e] : 0.f; }
                pk2[jt].x = pk_bf16(acc[0], acc[1]); pk2[jt].y = pk_bf16(acc[2], acc[3]);
            }
#pragma unroll
            for (int ks = 0; ks < 2; ++ks) { u32x4 w; w.x = pk2[2 * ks].x; w.y = pk2[2 * ks].y; w.z = pk2[2 * ks + 1].x; w.w = pk2[2 * ks + 1].y; pfr[ks] = __builtin_bit_cast(bf16x8, w); }
            }
            asm volatile("" ::: "memory");
            bf16x8 vf[4][2];
#pragma unroll
            for (int vt = 0; vt < 4; ++vt)
#pragma unroll
                for (int ks = 0; ks < 2; ++ks) vf[vt][ks] = tr_frag_perm(sV, 72, ks, 16 * vt, fr, fq);
#pragma unroll
            for (int dt = 0; dt < 2; ++dt) {
                bf16x8 kf[2];
#pragma unroll
                for (int ks = 0; ks < 2; ++ks) kf[ks] = tr_frag_perm(sK, 136, ks, 16 * (2 * wv + dt), fr, fq);
                const f32x4 tt = *(const LAS f32x4*)(sTot + 16 * (2 * wv + dt) + 4 * fq);
                const f32x4 sc = (f32x4){__expf(tt[0]), __expf(tt[1]), __expf(tt[2]), __expf(tt[3])};
#pragma unroll
                for (int vt = 0; vt < 4; ++vt) {
#pragma unroll
                    for (int ks = 0; ks < 2; ++ks) accS[dt][vt] = __builtin_amdgcn_mfma_f32_16x16x32_bf16(kf[ks], vf[vt][ks], accS[dt][vt], 0, 0, 0);
                    accS[dt][vt] = accS[dt][vt] * sc;
                }
            }
            {
                bf16x8 qf[4];
#pragma unroll
                for (int ks = 0; ks < 4; ++ks) qf[ks] = *(const LAS bf16x8*)(sQ + (16 * wv + fr) * 136 + 32 * ks + 8 * fq);
#pragma unroll
                for (int vt = 0; vt < 4; ++vt) {
                    f32x4 acc = (f32x4){0.f, 0.f, 0.f, 0.f};
#pragma unroll
                    for (int ks = 0; ks < 2; ++ks) acc = __builtin_amdgcn_mfma_f32_16x16x32_bf16(vf[vt][ks], pfr[ks], acc, 0, 0, 0);
#pragma unroll
                    for (int ks = 0; ks < 4; ++ks) { const bf16x8 sf = *(const LAS bf16x8*)(sS + (16 * vt + fr) * 136 + 32 * ks + 8 * fq);
                        acc = __builtin_amdgcn_mfma_f32_16x16x32_bf16(sf, qf[ks], acc, 0, 0, 0); }
                    { u32x2 pv = oprev[u][vt]; asm volatile("" : "+v"(pv));
                      if (second) acc = acc + (f32x4){bflo(pv.x), bfhi(pv.x), bflo(pv.y), bfhi(pv.y)}; }
                    store4bf(O + (size_t)(tb + 16 * wv + fr) * 1024 + h * 256 + vs * 64 + 16 * vt + 4 * fq, acc);
                }
            }
            LDS_BAR();
#pragma unroll
            for (int dt = 0; dt < 2; ++dt)
#pragma unroll
                for (int vt = 0; vt < 4; ++vt) { u32x2 w; w.x = pk_bf16(accS[dt][vt][0], accS[dt][vt][1]); w.y = pk_bf16(accS[dt][vt][2], accS[dt][vt][3]);
                    *(LAS u32x2*)(sS + (16 * vt + fr) * 136 + 16 * (2 * wv + dt) + 4 * fq) = w; }
            if (s + 1 < nch) GLA_STORE(u ^ 1);
            if (s == half - 1) { asm volatile("s_waitcnt vmcnt(0)" ::: "memory"); __syncthreads(); } else LDS_BAR();
          }
        }
        if (!sample) {
#pragma unroll
            for (int dt = 0; dt < 2; ++dt)
#pragma unroll
                for (int vt = 0; vt < 4; ++vt) { float* op = OST + (((((size_t)sb * 2 + l) * 2 + grp) * 4 + h) * 128 + 16 * (2 * wv + dt) + 4 * fq) * 256 + vs * 64 + 16 * vt + fr;
#pragma unroll
                    for (int e = 0; e < 4; ++e) op[(size_t)e * 256] = accS[dt][vt][e]; }
        }
    }
#undef GLA_LOAD
#undef GLA_STORE
#undef GLA_OLOAD
#undef GLA_CHUNK
}

__device__ __forceinline__ void phase_glapost(const P& p, int l) {
    const int lane = tid_() & 63, gw = bid_() * 8 + (tid_() >> 6), nw = gridDim.x * 8;
    bf16_t* O = (bf16_t*)(p.ws + WS_R1); const bf16_t* R = (const bf16_t*)(p.ws + WS_R3);
    const float* gn = p.in[lnd(13)] + (size_t)l * 256 + (lane & 15) * 16;
    for (int row = gw; row < TOK; row += nw) {
        const size_t o = (size_t)row * 1024 + lane * 16; float x[16], r[16];
#pragma unroll
        for (int hh = 0; hh < 2; ++hh) { const u32x4 a = *(const u32x4*)(O + o + 8 * hh), c = *(const u32x4*)(R + o + 8 * hh);
            x[8 * hh + 0] = bflo(a.x); x[8 * hh + 1] = bfhi(a.x); x[8 * hh + 2] = bflo(a.y); x[8 * hh + 3] = bfhi(a.y); x[8 * hh + 4] = bflo(a.z); x[8 * hh + 5] = bfhi(a.z); x[8 * hh + 6] = bflo(a.w); x[8 * hh + 7] = bfhi(a.w);
            r[8 * hh + 0] = bflo(c.x); r[8 * hh + 1] = bfhi(c.x); r[8 * hh + 2] = bflo(c.y); r[8 * hh + 3] = bfhi(c.y); r[8 * hh + 4] = bflo(c.z); r[8 * hh + 5] = bfhi(c.z); r[8 * hh + 6] = bflo(c.w); r[8 * hh + 7] = bfhi(c.w); }
        float ss = 0.f;
#pragma unroll
        for (int e = 0; e < 16; ++e) ss += x[e] * x[e];
        ss += __shfl_xor(ss, 1); ss += __shfl_xor(ss, 2); ss += __shfl_xor(ss, 4); ss += __shfl_xor(ss, 8);
        const float rstd = rsqrtf(ss * (1.0f / 256.0f) + 1e-6f);
        float y[16];
#pragma unroll
        for (int e = 0; e < 16; ++e) y[e] = x[e] * rstd * gn[e] * r[e];
#pragma unroll
        for (int hh = 0; hh < 2; ++hh) { u32x4 w; w.x = pk_bf16(y[8 * hh], y[8 * hh + 1]); w.y = pk_bf16(y[8 * hh + 2], y[8 * hh + 3]); w.z = pk_bf16(y[8 * hh + 4], y[8 * hh + 5]); w.w = pk_bf16(y[8 * hh + 6], y[8 * hh + 7]); *(u32x4*)(O + o + 8 * hh) = w; }
    }
}


#define XB_TMO      128
#define XB_XCNT(j)  (256  + 64 * (j))
#define XB_XSUB(j)  (1280 + 64 * (j))
#define XB_XGEN(j)  (2304 + 64 * (j))
#define XB_TOP      3328
#define XB_TOPGEN   3392
#define XCD_BAR_WORDS 3456
#define XB_SPIN_CAP (1u << 18)
__device__ __forceinline__ unsigned xb_ld(unsigned* p)              { return __hip_atomic_load(p, __ATOMIC_RELAXED, __HIP_MEMORY_SCOPE_AGENT); }
__device__ __forceinline__ unsigned xb_add(unsigned* p, unsigned v) { return __hip_atomic_fetch_add(p, v, __ATOMIC_RELAXED, __HIP_MEMORY_SCOPE_AGENT); }
__device__ __forceinline__ unsigned xb_xcc_id() { return (unsigned)__builtin_amdgcn_s_getreg((3 << 11) | 20) & 0xFu; }
#define XB_SPIN(cond, bar) do { unsigned _sp = 0; while (cond) { __builtin_amdgcn_s_sleep(1); \
    if ((++_sp & 255u) == 0u) { if (xb_ld(&(bar)[XB_TMO])) break; if (_sp > XB_SPIN_CAP) { atomicAdd(&(bar)[XB_TMO], 1u); break; } } } } while (0)
struct XcdBarrier { unsigned* bar; unsigned x; volatile LAS unsigned* st; };
__device__ __forceinline__ XcdBarrier xcd_barrier_post(unsigned* bar, volatile LAS unsigned* st) {
    XcdBarrier b; b.bar = bar; b.x = xb_xcc_id(); b.st = st;
    if (threadIdx.x == 0) (void)xb_add(&bar[XB_XCNT(b.x)], 1u);
    return b;
}
__device__ __forceinline__ void xcd_barrier_complete(unsigned* bar, unsigned x, unsigned& nloc, unsigned& nx) {
    const unsigned G = gridDim.x * gridDim.y * gridDim.z;
    unsigned sum, cnt, mine, sp = 0u;
    for (;;) {
        sum = 0u; cnt = 0u; mine = 0u;
#pragma unroll
        for (unsigned j = 0; j < 16; ++j) { const unsigned c = xb_ld(&bar[XB_XCNT(j)]); sum += c; cnt += (c > 0u) ? 1u : 0u; mine = (j == x) ? c : mine; }
        if (sum == G) break;
        __builtin_amdgcn_s_sleep(1);
        if ((++sp & 255u) == 0u) { if (xb_ld(&bar[XB_TMO])) break; if (sp > XB_SPIN_CAP) { atomicAdd(&bar[XB_TMO], 1u); break; } }
    }
    nloc = mine > 0u ? mine : 1u; nx = cnt > 0u ? cnt : 1u;
}
__device__ __forceinline__ void xcd_barrier(const XcdBarrier& b) {
    asm volatile("s_waitcnt vmcnt(0)" ::: "memory");
    __syncthreads();
    if (threadIdx.x == 0) {
        unsigned* bar = b.bar;
        __builtin_amdgcn_s_waitcnt(0);
        unsigned nloc = b.st[0], nx = b.st[1];
        if (nloc == 0u) { xcd_barrier_complete(bar, b.x, nloc, nx); b.st[0] = nloc; b.st[1] = nx; }
        const unsigned old = xb_add(&bar[XB_XSUB(b.x)], 1u);
        const unsigned gen = old / nloc;
        if (old + 1u == (gen + 1u) * nloc) {
            __builtin_amdgcn_fence(__ATOMIC_RELEASE, "agent");
            asm volatile("s_waitcnt vmcnt(0)" ::: "memory");
            const unsigned og = xb_add(&bar[XB_TOP], 1u);
            const unsigned tg = og / nx;
            if (og + 1u == (tg + 1u) * nx) xb_add(&bar[XB_TOPGEN], 1u);
            else XB_SPIN(xb_ld(&bar[XB_TOPGEN]) == tg, bar);
            __builtin_amdgcn_fence(__ATOMIC_ACQUIRE, "agent");
            xb_add(&bar[XB_XGEN(b.x)], 1u);
            asm volatile("s_waitcnt vmcnt(0)" ::: "memory");
        } else {
            XB_SPIN(xb_ld(&bar[XB_XGEN(b.x)]) == gen, bar);
            __builtin_amdgcn_fence(__ATOMIC_ACQUIRE, "agent");
            asm volatile("s_waitcnt vmcnt(0)" ::: "memory");
        }
    }
    __syncthreads();
}

__device__ __forceinline__ void run_phase(const P& p, int ph, LAS unsigned char* lds) {
    if (ph == 2 * PPL) { if (EN(34)) phase_final(p); return; }
    const int l = ph / PPL, q = ph % PPL;
    unsigned char* ws = p.ws; bf16_t* W = (bf16_t*)(ws + WS_W);
    const int G = gridDim.x, c = bid_();
    pg8::Order S;
    switch (q) {
        case 0: if (EN(0)) { phase_prep(p, l, lds); if (l == 1) phase_norm(p, l, 1); } break;
        case 1: if (EN(1)) { if (l == 0) phase_norm(p, l, 1); } break;
        case 2: if (EN(2)) { pg8::Gemm g{(const bf16_t*)(ws + WS_R2), W + W_A / 2, TOK, 2816, 1024, 1024, 0, 0, 1}; S.init(TOK, 2816, 1, G, c);
            EpiPartA E{(bf16_t*)(ws + WS_R3), (bf16_t*)(ws + WS_R3) + (size_t)TOK * 512, (bf16_t*)(ws + WS_R4), (bf16_t*)(ws + WS_R5), (float*)(ws + WS_GLR)};
            pg8::gemm_phase(lds, g, S, E); } break;
        case 3: if (EN(3)) { pg8::Gemm g{(const bf16_t*)(ws + WS_R5), (const bf16_t*)(ws + WS_EMAT), 1280, 256, 512, 768, (size_t)1280 * 768, (size_t)256 * 512, 32}; S.init(1280, 256, 32, G, c);
            EpiE E{(float*)(ws + WS_E)}; pg8::gemm_phase(lds, g, S, E); } break;
        case 4: if (EN(4)) phase_s5scan(p, l); break;
        case 5: if (EN(5)) { pg8::Gemm g{(const bf16_t*)(ws + WS_R5), (const bf16_t*)(ws + WS_R1), 1280, 512, 768, 768, (size_t)1280 * 768, (size_t)512 * 768, 32}; S.init(1280, 512, 32, G, c);
            EpiY E{(bf16_t*)(ws + WS_E)}; pg8::gemm_phase(lds, g, S, E); } break;
        case 6: if (EN(6)) { pg8::Gemm g{(const bf16_t*)(ws + WS_E), W + W_GLU / 2, TOK, 512, 512, 512, 0, 0, 1}; S.init(TOK, 512, 1, G, c);
            EpiGLU E{(const bf16_t*)(ws + WS_E), (bf16_t*)(ws + WS_R6), p.in[lnd(24)] + (size_t)l * 512}; pg8::gemm_phase(lds, g, S, E); } break;
        case 7: if (EN(7)) phase_glapre(p, l, lds); break;
        case 8: if (EN(8)) phase_gla(p, l, lds); break;
        case 9: if (EN(9)) { pg8::Gemm g{(const bf16_t*)(ws + WS_R2), W + W_B / 2, TOK, 3072, 1024, 1024, 0, 0, 1}; S.init(TOK, 3072, 1, G, c);
            EpiPartB E{(bf16_t*)(ws + WS_R3), (bf16_t*)(ws + WS_R4), (bf16_t*)(ws + WS_R5)}; pg8::gemm_phase(lds, g, S, E); } break;
        case 10: if (EN(10)) phase_glapost(p, l); break;
        case 11: if (EN(11)) { pg8::Gemm g{(const bf16_t*)(ws + WS_R1), W + W_PG / 2, TOK, 1024, 1024, 1024, 0, 0, 1}; S.init(TOK, 1024, 1, G, c);
              EpiProj1 E{(const bf16_t*)(ws + WS_R4), (bf16_t*)(ws + WS_R2)}; pg8::gemm_phase(lds, g, S, E); } break;
        case 12: if (EN(12)) { pg8::Gemm g{(const bf16_t*)(ws + WS_R6), W + W_PS / 2, TOK, 1024, 512, 512, 0, 0, 1}; S.init(TOK, 1024, 1, G, c);
              EpiProj2 E{(const bf16_t*)(ws + WS_R5), (bf16_t*)(ws + WS_R2)}; pg8::gemm_phase(lds, g, S, E); } break;
        case 13: if (EN(13)) { pg8::Gemm g{(const bf16_t*)(ws + WS_R2), W + W_OUT / 2, TOK, 1024, 1024, 1024, 0, 0, 1}; S.init(TOK, 1024, 1, G, c);
            EpiDelta E{(bf16_t*)(ws + WS_R3), (const float*)(ws + WS_MOD) + (size_t)l * 9 * 6144 + 2048}; pg8::gemm_phase(lds, g, S, E); } break;
        case 14: if (EN(14)) phase_norm(p, l, 2); break;
        case 15: if (EN(15)) { pg8::Gemm g{(const bf16_t*)(ws + WS_R2), W + W_1 / 2, TOK, 4096, 1024, 1024, 0, 0, 1}; S.init(TOK, 4096, 1, G, c);
            EpiFF1 E{(bf16_t*)(ws + WS_HID)}; pg8::gemm_phase(lds, g, S, E); } break;
        case 16: if (EN(16)) { pg8::Gemm g{(const bf16_t*)(ws + WS_HID), W + W_2 / 2, TOK, 1024, 4096, 4096, 0, 0, 1}; S.init(TOK, 1024, 1, G, c);
            EpiDelta E{(bf16_t*)(ws + WS_R2), (const float*)(ws + WS_MOD) + (size_t)l * 9 * 6144 + 5120}; pg8::gemm_phase(lds, g, S, E); } break;
        default: break;
    }
}

__global__ void __launch_bounds__(NTHR, 2) fwd_megakernel(P p) {
    extern __shared__ __attribute__((aligned(16))) unsigned char lds_raw[];
    LAS unsigned char* lds = (LAS unsigned char*)lds_raw;
#if MULTI_LAUNCH
    for (int ph = p.ph_lo; ph < p.ph_hi; ++ph) run_phase(p, ph, lds);
#else
    cg::grid_group grid = cg::this_grid();
    if (p.ph_lo < 0) grid.sync();
    volatile LAS unsigned* stw = (volatile LAS unsigned*)(lds + LDS_BYTES - 16);
    if (threadIdx.x < 4) stw[threadIdx.x] = 0u;
    __syncthreads();
    const XcdBarrier bar = xcd_barrier_post((unsigned*)(p.ws + WS_BAR), stw);
    for (int ph = p.ph_lo; ph < p.ph_hi; ++ph) {
        run_phase(p, ph, lds);
#if REP_MASK
        if (ph < 2 * PPL && ((REP_MASK >> (ph % PPL)) & 1)) {
            xcd_barrier(bar);
            if ((ph % PPL) == 12) { run_phase(p, ph - 1, lds); }
            run_phase(p, ph, lds);
        }
#endif
        if (ph + 1 < p.ph_hi && (ph % PPL) != 11 && ph != PPL) xcd_barrier(bar);
    }
#endif
}

extern "C" void kernel_launch(void* const* d_in, const int* in_sizes, int n_in, void* d_out, int out_size, void* d_ws, size_t ws_size, hipStream_t stream) {
    static int grid = 0;
    if (grid == 0) {
        if (n_in != 31 || ws_size < WS_END) { fprintf(stderr, "kernel_launch: unexpected n_in %d or ws_size %zu (< %zu)\n", n_in, ws_size, (size_t)WS_END); grid = -1; return; }
        int dev = 0, cus = 0, per_cu = 0;
        hipGetDevice(&dev);
        hipDeviceGetAttribute(&cus, hipDeviceAttributeMultiprocessorCount, dev);
        if (hipFuncSetAttribute((const void*)fwd_megakernel, hipFuncAttributeMaxDynamicSharedMemorySize, LDS_BYTES) != hipSuccess) { fprintf(stderr, "kernel_launch: hipFuncSetAttribute failed\n"); grid = -1; return; }
        hipOccupancyMaxActiveBlocksPerMultiprocessor(&per_cu, (const void*)fwd_megakernel, NTHR, LDS_BYTES);
        (void)hipGetLastError();
        if (per_cu < 1) fprintf(stderr, "kernel_launch: occupancy query says %d blocks per CU\n", per_cu);
        grid = cus > 0 ? cus : 256;
    }
    if (grid < 0) return;
    P p{};
    for (int i = 0; i < 31; ++i) p.in[i] = (const float*)d_in[i];
    p.out = (float*)d_out; p.ws = (unsigned char*)d_ws;
#if MULTI_LAUNCH
    for (int ph = 0; ph < NPHASE; ++ph) { p.ph_lo = ph; p.ph_hi = ph + 1; hipLaunchKernelGGL(fwd_megakernel, dim3(grid), dim3(NTHR), LDS_BYTES, stream, p); }
#else
    p.ph_lo = 0; p.ph_hi = NPHASE;
    (void)hipMemsetAsync((char*)d_ws + WS_BAR, 0, XCD_BAR_WORDS * sizeof(unsigned), stream);
    void* args[] = {&p};
    hipError_t e = hipLaunchCooperativeKernel((const void*)fwd_megakernel, dim3(grid), dim3(NTHR), args, LDS_BYTES, stream);
    if (e != hipSuccess) fprintf(stderr, "cooperative launch failed: %s (grid %d)\n", hipGetErrorString(e), grid);
#endif
}
```

```cpp
#include <hip/hip_runtime.h>
#include <hip/hip_cooperative_groups.h>
#include <cstdio>
namespace cg = cooperative_groups;

#ifndef MULTI_LAUNCH
#define MULTI_LAUNCH 0
#endif

#ifndef REP_MASK
#define REP_MASK 0
#endif
#ifndef PHASE_SEL
#define PHASE_SEL -1
#endif
#define EN(q) (PHASE_SEL < 0 || PHASE_SEL == (q))
#define LAS __attribute__((address_space(3)))
typedef unsigned short bf16_t;
typedef short bf16x8 __attribute__((ext_vector_type(8)));
typedef float f32x4 __attribute__((ext_vector_type(4)));
typedef unsigned u32x4 __attribute__((ext_vector_type(4)));
typedef unsigned u32x2 __attribute__((ext_vector_type(2)));

constexpr int NTHR = 512;
constexpr int TOK = 40960, TOKP = 8192;
constexpr int LDS_BYTES = 147456;
constexpr int NPHASE = 35;
constexpr int PPL = 17;

constexpr size_t MiB = (size_t)1 << 20;
constexpr size_t WS_MOD = 0;
constexpr size_t WS_GLR = 1 * MiB;
constexpr size_t WS_TOTF = 7 * MiB;
constexpr size_t WS_TOTB = 9 * MiB;
constexpr size_t WS_BAR = 12 * MiB;
constexpr size_t WS_W = 16 * MiB;
constexpr size_t W_A = 0;
constexpr size_t W_B = W_A + (size_t)2816 * 1024 * 2;
constexpr size_t W_PG = W_B + (size_t)3072 * 1024 * 2;
constexpr size_t W_GLU = W_PG + (size_t)1024 * 1024 * 2;
constexpr size_t W_PS = W_GLU + (size_t)512 * 512 * 2;
constexpr size_t W_OUT = W_PS + (size_t)1024 * 512 * 2;
constexpr size_t W_1 = W_OUT + (size_t)1024 * 1024 * 2;
constexpr size_t W_2 = W_1 + (size_t)4096 * 1024 * 2;
constexpr size_t WS_R2 = 50 * MiB;
constexpr size_t WS_R3 = 130 * MiB;
constexpr size_t WS_R4 = 210 * MiB;
constexpr size_t WS_R5 = 290 * MiB;
constexpr size_t WS_E = 350 * MiB;
constexpr size_t WS_R6 = 390 * MiB;
constexpr size_t WS_R1 = 430 * MiB;
constexpr size_t WS_EMAT = 454 * MiB;
constexpr size_t WS_HID = 130 * MiB;
constexpr size_t WS_END = 510 * MiB;

struct P { const float* in[31]; float* out; unsigned char* ws; int ph_lo, ph_hi; };

__device__ __forceinline__ int tid_() { int t = threadIdx.x; asm volatile("" : "+v"(t)); return t; }
__device__ __forceinline__ int bid_() { int b = blockIdx.x; asm volatile("" : "+s"(b)); return b; }
__device__ __forceinline__ int lnd(int k) { asm volatile("" : "+s"(k)); return k; }
__device__ __forceinline__ unsigned pk_bf16(float lo, float hi) { unsigned r; asm("v_cvt_pk_bf16_f32 %0, %1, %2" : "=v"(r) : "v"(lo), "v"(hi)); return r; }
__device__ __forceinline__ float bf2f(bf16_t b) { return __uint_as_float(((unsigned)b) << 16); }
__device__ __forceinline__ float bflo(unsigned w) { return __uint_as_float(w << 16); }
__device__ __forceinline__ float bfhi(unsigned w) { return __uint_as_float(w & 0xffff0000u); }
__device__ __forceinline__ bf16_t f2bf(float f) { return (bf16_t)(pk_bf16(f, 0.f) & 0xffffu); }
__device__ __forceinline__ float sigmoidf_(float x) { return __builtin_amdgcn_rcpf(1.0f + __expf(-x)); }
__device__ __forceinline__ void store4bf(bf16_t* ptr, f32x4 v) { u32x2 w; w.x = pk_bf16(v[0], v[1]); w.y = pk_bf16(v[2], v[3]); *(u32x2*)ptr = w; }
__device__ __forceinline__ f32x4 load4bf(const bf16_t* ptr) { u32x2 w = *(const u32x2*)ptr; return (f32x4){bflo(w.x), bfhi(w.x), bflo(w.y), bfhi(w.y)}; }
__device__ __forceinline__ int mod_index(int tok) { return tok < TOKP ? 0 : (tok >> 12) - 1; }
__device__ __forceinline__ float wave_sum(float v) {
#pragma unroll
    for (int o = 32; o >= 1; o >>= 1) v += __shfl_xor(v, o);
    return v;
}

namespace pg8 {
constexpr int BM = 256, BK = 64, HALF = 128, HTB = HALF * BK * 2, STAGE_BYTES = 8 * HTB, NXCD = 8, WGM = 8;
__device__ __forceinline__ int lds_byte(int r, int c) { const int st = (r >> 4) * 2 + (c >> 5), rr = r & 15, cc = c & 31, ob = rr * 64 + cc * 2; return st * 1024 + (ob ^ (((ob >> 9) & 1) << 5)); }
__device__ __forceinline__ void stage_rc(int b, int& R, int& C) { const int st = b / 1024, sb = b % 1024, swz = sb ^ (((sb >> 9) & 1) << 5); R = (st >> 1) * 16 + swz / 64; C = (st & 1) * 32 + (swz % 64) / 2; }

struct Unit { int pm, pn, z, hf; };
struct Gemm { const bf16_t* A; const bf16_t* Bt; int M, N, K, lda; size_t sA, sB; int nz; };
struct Order {
    int nM, nN, nwg, G, c, nz, nfull, rem2;
    __device__ __forceinline__ void init(int M, int N, int nz_, int G_, int c_) { nM = M / BM; nN = N / BM; nwg = nM * nN; G = G_; c = c_; nz = nz_;
        nfull = nwg; rem2 = 0;
        if (nz == 1) { const int full = (nwg / G) * G, rem = nwg - full; if (rem > 0 && 2 * rem <= G) { nfull = full; rem2 = 2 * rem; } } }
    __device__ __forceinline__ void map(int wgid, Unit& u) const {
        { const int q = nwg / NXCD, r = nwg % NXCD, xcd = wgid % NXCD, off = wgid / NXCD; wgid = (xcd < r ? xcd * (q + 1) : r * (q + 1) + (xcd - r) * q) + off; }
        const int nig = WGM * nN, gid = wgid / nig, fm = gid * WGM, gsz = (nM - fm) < WGM ? (nM - fm) : WGM;
        u.pm = fm + ((wgid % nig) % gsz); u.pn = (wgid % nig) / gsz; u.z = 0; }
    __device__ __forceinline__ bool next(int i, Unit& u) const {
        const long L = (long)i * G + c;
        if (nz == 1) {
            if (L < nfull) { map((int)L, u); u.hf = 0; return true; }
            const int t = (int)(L - nfull); if (t >= rem2) return false;
            map(nfull + (t >> 1), u); u.hf = 1 + (t & 1); return true;
        }
        if (L >= (long)nwg * nz) return false;
        const int z = (int)(L / nwg), r = (int)(L % nwg); u.z = z; u.pm = r % nM; u.pn = r / nM; u.hf = 0;
        return true;
    }
};

template <class Epi>
__device__ __forceinline__ void gemm_phase(LAS unsigned char* lds, const Gemm g, const Order& S, const Epi& E) {
    const int tid = tid_(), wid = __builtin_amdgcn_readfirstlane(tid >> 6), lane = tid & 63, wr = wid >> 2, wc = wid & 3, fr = lane & 15, fq = lane >> 4;
    const int K = g.K, nt = K / BK;
    unsigned voffA[2], voffB[2];
#pragma unroll
    for (int i = 0; i < 2; ++i) { int R, C; stage_rc(tid * 16 + i * 8192, R, C); voffA[i] = (unsigned)(R * g.lda + C) * 2u; voffB[i] = (unsigned)(R * K + C) * 2u; }
    const size_t kstep = (size_t)(BK * 2);
    const size_t hstepA = (size_t)HALF * g.lda * 2, hstepB = (size_t)HALF * K * 2;
    const unsigned ldsw = (unsigned)wid * 1024u;
    const int aoff = lds_byte(wr * 64 + fr, fq * 8), boff = lds_byte(wc * 32 + fr, fq * 8);
#define PG8_SA(b, h) (((b) * 2 + (h)) * HTB)
#define PG8_SB(b, h) ((4 + (b) * 2 + (h)) * HTB)
#define PG8_STAGE(bufoff, gbase, voff) do { _Pragma("unroll") for (int _i = 0; _i < 2; ++_i) \
        __builtin_amdgcn_global_load_lds((const unsigned*)((const char*)(gbase) + (voff)[_i]), (LAS unsigned*)(lds + (bufoff) + ldsw + _i * 8192), 16, 0, 0); } while (0)
#define PG8_LDA(dst, b, h) do { _Pragma("unroll") for (int m = 0; m < 4; ++m) _Pragma("unroll") for (int k = 0; k < 2; ++k) dst[m][k] = *(const LAS bf16x8*)(lds + PG8_SA(b, h) + aoff + m * 2048 + k * 1024); } while (0)
#define PG8_LDB(dst, b, h) do { _Pragma("unroll") for (int n = 0; n < 2; ++n) _Pragma("unroll") for (int k = 0; k < 2; ++k) dst[n][k] = *(const LAS bf16x8*)(lds + PG8_SB(b, h) + boff + n * 2048 + k * 1024); } while (0)
#define PG8_MMA(ai, bj, At, Bt) do { __builtin_amdgcn_s_setprio(1); _Pragma("unroll") for (int m = 0; m < 4; ++m) _Pragma("unroll") for (int n = 0; n < 2; ++n) _Pragma("unroll") for (int k = 0; k < 2; ++k) \
        acc[ai][bj][m][n] = __builtin_amdgcn_mfma_f32_16x16x32_bf16(Bt[n][k], At[m][k], acc[ai][bj][m][n], 0, 0, 0); __builtin_amdgcn_s_setprio(0); } while (0)
#define PG8_WAIT_V(n) asm volatile("s_waitcnt vmcnt(" #n ")" ::: "memory")
#define PG8_WAIT_L(n) asm volatile("s_waitcnt lgkmcnt(" #n ")" ::: "memory")
#define PG8_BAR __builtin_amdgcn_s_barrier()
#define PG8_SCHED __builtin_amdgcn_sched_barrier(0)
    Unit cur, nxt; int ui = 0;
    if (!S.next(0, cur)) return;
    f32x4 acc[2][2][4][2];
#pragma unroll
    for (int a = 0; a < 2; ++a)
#pragma unroll
        for (int b = 0; b < 2; ++b)
#pragma unroll
            for (int m = 0; m < 4; ++m)
#pragma unroll
                for (int n = 0; n < 2; ++n) acc[a][b][m][n] = (f32x4){0.f, 0.f, 0.f, 0.f};
    bf16x8 At[4][2], B0[2][2], B1[2][2];
    const char* cA = (const char*)g.A + ((size_t)cur.z * g.sA + (size_t)(cur.pm * BM + (cur.hf == 2 ? HALF : 0)) * g.lda) * 2;
    const char* cB = (const char*)g.Bt + ((size_t)cur.z * g.sB + (size_t)cur.pn * BM * K) * 2;
    PG8_STAGE(PG8_SB(0, 0), cB, voffB); PG8_STAGE(PG8_SB(0, 1), cB + hstepB, voffB); PG8_STAGE(PG8_SA(0, 0), cA, voffA); PG8_STAGE(PG8_SA(0, 1), cA + hstepA, voffA);
    if (wr == 1) PG8_BAR;
    PG8_WAIT_V(2); PG8_BAR;
    PG8_STAGE(PG8_SB(1, 0), cB + kstep, voffB); PG8_STAGE(PG8_SA(1, 0), cA + kstep, voffA); PG8_STAGE(PG8_SB(1, 1), cB + hstepB + kstep, voffB);
    PG8_WAIT_V(6); PG8_BAR;
    for (;;) {
        const bool has_next = S.next(ui + 1, nxt);
        const char* nA = has_next ? (const char*)g.A + ((size_t)nxt.z * g.sA + (size_t)(nxt.pm * BM + (nxt.hf == 2 ? HALF : 0)) * g.lda) * 2 : cA;
        const bool fullu = (cur.hf == 0);
        const char* nB = has_next ? (const char*)g.Bt + ((size_t)nxt.z * g.sB + (size_t)nxt.pn * BM * K) * 2 : cB;
        for (int t = 0; t < nt; t += 2) {
            const bool last = (t == nt - 2);
            const char* a1 = cA + (size_t)(t + 1) * kstep;
            const char* a2 = last ? nA : cA + (size_t)(t + 2) * kstep; const char* b2 = last ? nB : cB + (size_t)(t + 2) * kstep;
            const char* a3 = a2 + kstep; const char* b3 = b2 + kstep;
            PG8_LDB(B0, 0, 0); PG8_LDB(B1, 0, 1); PG8_SCHED; PG8_LDA(At, 0, 0); PG8_STAGE(PG8_SA(1, 1), a1 + hstepA, voffA);
            PG8_WAIT_V(8); PG8_WAIT_L(0); PG8_BAR; PG8_MMA(0, 0, At, B0); PG8_MMA(0, 1, At, B1); PG8_BAR; PG8_SCHED;
            if (fullu) PG8_LDA(At, 0, 1); PG8_STAGE(PG8_SB(0, 0), b2, voffB); PG8_STAGE(PG8_SB(0, 1), b2 + hstepB, voffB); PG8_STAGE(PG8_SA(0, 0), a2, voffA);
            PG8_WAIT_V(8); PG8_WAIT_L(0); PG8_BAR; if (fullu) { PG8_MMA(1, 0, At, B0); PG8_MMA(1, 1, At, B1); } PG8_BAR; PG8_SCHED;
            PG8_LDB(B0, 1, 0); PG8_LDB(B1, 1, 1); PG8_SCHED; PG8_LDA(At, 1, 0); PG8_STAGE(PG8_SA(0, 1), a2 + hstepA, voffA);
            PG8_WAIT_V(8); PG8_WAIT_L(0); PG8_BAR; PG8_MMA(0, 0, At, B0); PG8_MMA(0, 1, At, B1); PG8_BAR; PG8_SCHED;
            if (fullu) PG8_LDA(At, 1, 1); PG8_STAGE(PG8_SB(1, 0), b3, voffB); PG8_STAGE(PG8_SB(1, 1), b3 + hstepB, voffB); PG8_STAGE(PG8_SA(1, 0), a3, voffA);
            PG8_WAIT_V(8); PG8_WAIT_L(0); PG8_BAR; if (fullu) { PG8_MMA(1, 0, At, B0); PG8_MMA(1, 1, At, B1); } PG8_BAR; PG8_SCHED;
        }
        if (wr == 0) PG8_BAR;
        if (fullu) E.template tile<2>(acc, cur.z, cur.pm * BM + wr * 64 + fr, cur.pn * BM + wc * 32 + (Epi::PERM ? 8 : 4) * fq);
        else E.template tile<1>(acc, cur.z, cur.pm * BM + (cur.hf == 2 ? HALF : 0) + wr * 64 + fr, cur.pn * BM + wc * 32 + (Epi::PERM ? 8 : 4) * fq);
        if (!has_next) break;
#pragma unroll
        for (int a = 0; a < 2; ++a)
#pragma unroll
            for (int b = 0; b < 2; ++b)
#pragma unroll
                for (int m = 0; m < 4; ++m)
#pragma unroll
                    for (int n = 0; n < 2; ++n) acc[a][b][m][n] = (f32x4){0.f, 0.f, 0.f, 0.f};
        cur = nxt; cA = nA; cB = nB; ++ui;
        if (wr == 1) PG8_BAR;
    }
    PG8_WAIT_V(0);
    PG8_BAR;
#undef PG8_SA
#undef PG8_SB
#undef PG8_STAGE
#undef PG8_LDA
#undef PG8_LDB
#undef PG8_MMA
#undef PG8_WAIT_V
#undef PG8_WAIT_L
#undef PG8_BAR
#undef PG8_SCHED
}
}

#define EPI_SIMPLE_TILE() \
    static constexpr bool PERM = false; \
    template <int NAI> __device__ __forceinline__ void tile(const f32x4 (&acc)[2][2][4][2], int z, int row0, int col0) const { \
        _Pragma("unroll") for (int ai = 0; ai < NAI; ++ai) _Pragma("unroll") for (int m = 0; m < 4; ++m) _Pragma("unroll") for (int bj = 0; bj < 2; ++bj) _Pragma("unroll") for (int n = 0; n < 2; ++n) \
            (*this)(z, row0 + ai * 128 + m * 16, col0 + bj * 128 + n * 16, acc[ai][bj][m][n]); }
#define EPI_PAIR_TILE() \
    static constexpr bool PERM = true; \
    template <int NAI> __device__ __forceinline__ void tile(const f32x4 (&acc)[2][2][4][2], int z, int row0, int col0) const { \
        _Pragma("unroll") for (int ai = 0; ai < NAI; ++ai) _Pragma("unroll") for (int m = 0; m < 4; ++m) _Pragma("unroll") for (int bj = 0; bj < 2; ++bj) \
            pair(row0 + ai * 128 + m * 16, col0 + bj * 128, acc[ai][bj][m][0], acc[ai][bj][m][1]); }
#define EPI_PIPE_TILE() \
    static constexpr bool PERM = true; \
    template <int NAI> __device__ __forceinline__ void tile(const f32x4 (&acc)[2][2][4][2], int z, int row0, int col0) const { \
        Pre pre; begin(row0, col0, pre); L buf[2][8]; \
        _Pragma("unroll") for (int mm = 0; mm < 2; ++mm) _Pragma("unroll") for (int bj = 0; bj < 2; ++bj) _Pragma("unroll") for (int n = 0; n < 2; ++n) load(row0 + mm * 16, col0 + bj * 128 + n * 4, buf[0][mm * 4 + bj * 2 + n]); \
        _Pragma("unroll") for (int b = 0; b < 2 * NAI; ++b) { \
            if (b < 2 * NAI - 1) { _Pragma("unroll") for (int mm = 0; mm < 2; ++mm) _Pragma("unroll") for (int bj = 0; bj < 2; ++bj) _Pragma("unroll") for (int n = 0; n < 2; ++n) \
                load(row0 + ((b + 1) >> 1) * 128 + (((b + 1) & 1) * 2 + mm) * 16, col0 + bj * 128 + n * 4, buf[(b + 1) & 1][mm * 4 + bj * 2 + n]); } \
            _Pragma("unroll") for (int mm = 0; mm < 2; ++mm) _Pragma("unroll") for (int bj = 0; bj < 2; ++bj) _Pragma("unroll") for (int n = 0; n < 2; ++n) \
                apply(row0 + (b >> 1) * 128 + ((b & 1) * 2 + mm) * 16, col0 + bj * 128 + n * 4, acc[b >> 1][bj][(b & 1) * 2 + mm][n], buf[b & 1][mm * 4 + bj * 2 + n], pre, bj * 2 + n); } }
__device__ __forceinline__ void store8bf(bf16_t* ptr, f32x4 a, f32x4 b) { u32x4 w; w.x = pk_bf16(a[0], a[1]); w.y = pk_bf16(a[2], a[3]); w.z = pk_bf16(b[0], b[1]); w.w = pk_bf16(b[2], b[3]); *(u32x4*)ptr = w; }

struct EpiPartA {
    bf16_t* Q; bf16_t* Kk; bf16_t* V; bf16_t* UG; float* GLR;
    __device__ __forceinline__ void pair(int row, int col, f32x4 a, f32x4 b) const {
        if (col < 512) store8bf(Q + (size_t)row * 512 + col, a, b);
        else if (col < 1024) store8bf(Kk + (size_t)row * 512 + (col - 512), a, b);
        else if (col < 2048) store8bf(V + (size_t)row * 1024 + (col - 1024), a, b);
        else if (col < 2304) { const int c = col - 2048; if (c < 32) { *(f32x4*)(GLR + (size_t)row * 32 + c) = a; *(f32x4*)(GLR + (size_t)row * 32 + c + 4) = b; } }
        else { const int c = col - 2304, g = c >> 4, n = c & 15, chunk = row >> 5, j = row & 31; store8bf(UG + ((size_t)(g * 1280 + chunk) * 768 + j * 16 + n), a, b); }
    }
    EPI_PAIR_TILE()
};
struct EpiE { float* E; __device__ __forceinline__ void operator()(int z, int row, int col, f32x4 v) const { *(f32x4*)(E + ((size_t)(z * 1280 + row) * 256 + col)) = v; } EPI_SIMPLE_TILE() };
struct EpiY {
    bf16_t* YB;
    __device__ __forceinline__ void operator()(int z, int row, int col, f32x4 v) const {
        const int tok = row * 32 + (col >> 4), ch = z * 16 + (col & 15);
        f32x4 o;
#pragma unroll
        for (int e = 0; e < 4; ++e) { const float x = v[e]; o[e] = x * sigmoidf_(1.5957691216f * (x + 0.044715f * x * x * x)); }
        store4bf(YB + (size_t)tok * 512 + ch, o);
    }
    EPI_SIMPLE_TILE()
};
struct EpiGLU {
    const bf16_t* YB; bf16_t* OS5; const float* bglu;
    typedef u32x2 L; struct Pre { f32x4 b[4]; };
    __device__ __forceinline__ void begin(int, int col0, Pre& pr) const {
#pragma unroll
        for (int k = 0; k < 4; ++k) pr.b[k] = *(const f32x4*)(bglu + col0 + (k >> 1) * 128 + (k & 1) * 4); }
    __device__ __forceinline__ void load(int row, int col, L& l) const { l = *(const u32x2*)(YB + (size_t)row * 512 + col); }
    __device__ __forceinline__ void apply(int row, int col, f32x4 v, const L& l, const Pre& pr, int k) const {
        const f32x4 y = (f32x4){bflo(l.x), bfhi(l.x), bflo(l.y), bfhi(l.y)}; f32x4 o;
#pragma unroll
        for (int e = 0; e < 4; ++e) o[e] = y[e] * sigmoidf_(v[e] + pr.b[k][e]);
        store4bf(OS5 + (size_t)row * 512 + col, o); }
    EPI_PIPE_TILE()
};
struct EpiPartB {
    bf16_t* R; bf16_t* GA; bf16_t* GB;
    __device__ __forceinline__ void pair(int row, int col, f32x4 a, f32x4 b) const {
        f32x4 sa, sb;
#pragma unroll
        for (int e = 0; e < 4; ++e) { sa[e] = sigmoidf_(a[e]); sb[e] = sigmoidf_(b[e]); }
        if (col < 1024) store8bf(R + (size_t)row * 1024 + col, a * sa, b * sb);
        else if (col < 2048) store8bf(GA + (size_t)row * 1024 + (col - 1024), sa, sb);
        else store8bf(GB + (size_t)row * 1024 + (col - 2048), sa, sb);
    }
    EPI_PAIR_TILE()
};
struct EpiProj1 { const bf16_t* GA; bf16_t* T1;
    typedef u32x2 L; struct Pre { int dummy; };
    __device__ __forceinline__ void begin(int, int, Pre&) const {}
    __device__ __forceinline__ void load(int row, int col, L& l) const { l = *(const u32x2*)(GA + (size_t)row * 1024 + col); }
    __device__ __forceinline__ void apply(int row, int col, f32x4 v, const L& l, const Pre&, int) const {
        const f32x4 g = (f32x4){bflo(l.x), bfhi(l.x), bflo(l.y), bfhi(l.y)}; store4bf(T1 + (size_t)row * 1024 + col, g * v); }
    EPI_PIPE_TILE()
};
struct EpiProj2 { const bf16_t* GB; bf16_t* T1;
    struct L { u32x2 t, g; }; struct Pre { int dummy; };
    __device__ __forceinline__ void begin(int, int, Pre&) const {}
    __device__ __forceinline__ void load(int row, int col, L& l) const { const size_t o = (size_t)row * 1024 + col; l.t = *(const u32x2*)(T1 + o); l.g = *(const u32x2*)(GB + o); }
    __device__ __forceinline__ void apply(int row, int col, f32x4 v, const L& l, const Pre&, int) const {
        const f32x4 g = (f32x4){bflo(l.g.x), bfhi(l.g.x), bflo(l.g.y), bfhi(l.g.y)}, t = (f32x4){bflo(l.t.x), bfhi(l.t.x), bflo(l.t.y), bfhi(l.t.y)};
        store4bf(T1 + (size_t)row * 1024 + col, t + g * v); }
    EPI_PIPE_TILE()
};
struct EpiDelta { bf16_t* Dl; const float* gate;
    static constexpr bool PERM = true;
    template <int NAI> __device__ __forceinline__ void tile(const f32x4 (&acc)[2][2][4][2], int, int row0, int col0) const {
        const float* gp = gate + (size_t)mod_index(row0) * 6144 + col0; f32x4 g[2][2];
#pragma unroll
        for (int bj = 0; bj < 2; ++bj)
#pragma unroll
            for (int n = 0; n < 2; ++n) g[bj][n] = *(const f32x4*)(gp + bj * 128 + n * 4);
#pragma unroll
        for (int ai = 0; ai < NAI; ++ai)
#pragma unroll
            for (int m = 0; m < 4; ++m)
#pragma unroll
                for (int bj = 0; bj < 2; ++bj) store8bf(Dl + (size_t)(row0 + ai * 128 + m * 16) * 1024 + col0 + bj * 128, g[bj][0] * acc[ai][bj][m][0], g[bj][1] * acc[ai][bj][m][1]);
    } };
struct EpiFF1 { bf16_t* H;
    __device__ __forceinline__ void pair(int row, int col, f32x4 a, f32x4 b) const {
        f32x4 oa, ob;
#pragma unroll
        for (int e = 0; e < 4; ++e) { const float ra = fmaxf(a[e], 0.f), rb = fmaxf(b[e], 0.f); oa[e] = ra * ra; ob[e] = rb * rb; }
        store8bf(H + (size_t)row * 4096 + col, oa, ob); }
    EPI_PAIR_TILE()
};

struct ConvJob { const float* src; int ld, K, c0, nvalid, ndst; bf16_t* dst; float scale; };
__device__ __forceinline__ bool conv_job(const P& p, int l, int j, ConvJob& J) {
    bf16_t* W = (bf16_t*)(p.ws + WS_W);
    const float* win = p.in[lnd(10)] + (size_t)l * 1024 * 5664;
    J.scale = 1.0f;
    switch (j) {
        case 0: J = {win, 5664, 1024, 0, 512, 512, W + W_A / 2, 0.08838834764831845f}; break;
        case 1: J = {win, 5664, 1024, 512, 512, 512, W + W_A / 2 + (size_t)512 * 1024, 1.f}; break;
        case 2: J = {win, 5664, 1024, 1024, 1024, 1024, W + W_A / 2 + (size_t)1024 * 1024, 1.f}; break;
        case 3: J = {win, 5664, 1024, 3072, 32, 256, W + W_A / 2 + (size_t)2048 * 1024, 1.f}; break;
        case 4: J = {win, 5664, 1024, 3104, 512, 512, W + W_A / 2 + (size_t)2304 * 1024, 1.f}; break;
        case 5: J = {win, 5664, 1024, 2048, 1024, 1024, W + W_B / 2, 1.f}; break;
        case 6: J = {win, 5664, 1024, 3616, 1024, 1024, W + W_B / 2 + (size_t)1024 * 1024, 1.f}; break;
        case 7: J = {win, 5664, 1024, 4640, 1024, 1024, W + W_B / 2 + (size_t)2048 * 1024, 1.f}; break;
        case 8: J = {p.in[lnd(14)] + (size_t)l * 1024 * 1024, 1024, 1024, 0, 1024, 1024, W + W_PG / 2, 1.f}; break;
        case 9: J = {p.in[lnd(23)] + (size_t)l * 512 * 512, 512, 512, 0, 512, 512, W + W_GLU / 2, 1.f}; break;
        case 10: J = {p.in[lnd(25)] + (size_t)l * 512 * 1024, 1024, 512, 0, 1024, 1024, W + W_PS / 2, 1.f}; break;
        case 11: J = {p.in[lnd(26)] + (size_t)l * 1024 * 1024, 1024, 1024, 0, 1024, 1024, W + W_OUT / 2, 1.f}; break;
        case 12: J = {p.in[lnd(28)] + (size_t)l * 1024 * 4096, 4096, 1024, 0, 4096, 4096, W + W_1 / 2, 1.f}; break;
        case 13: J = {p.in[lnd(29)] + (size_t)l * 4096 * 1024, 1024, 4096, 0, 1024, 1024, W + W_2 / 2, 1.f}; break;
        default: return false;
    }
    return true;
}
constexpr int CONV_TILES = 2112;
__device__ __forceinline__ void conv_tile(const P& p, int l, int tile, LAS float* sT) {
    const int tid = tid_();
    ConvJob J; int j = 0, rem = tile;
    for (; j < 14; ++j) { conv_job(p, l, j, J); const int nt = (J.ndst / 64) * (J.K / 128); if (rem < nt) break; rem -= nt; }
    const int kts = J.K / 128, ntile = rem / kts, ktile = rem % kts, n0 = ntile * 64, k0 = ktile * 128;
    {
        const int kk = tid >> 4, c4 = (tid & 15) * 4; f32x4 v[4];
#pragma unroll
        for (int i = 0; i < 4; ++i) { v[i] = (f32x4){0.f, 0.f, 0.f, 0.f};
            if (n0 + c4 < J.nvalid) v[i] = *(const f32x4*)(J.src + (size_t)(k0 + kk + 32 * i) * J.ld + J.c0 + n0 + c4); }
#pragma unroll
        for (int i = 0; i < 4; ++i)
#pragma unroll
            for (int e = 0; e < 4; ++e) sT[(c4 + e) * 129 + kk + 32 * i] = v[i][e] * J.scale;
    }
    __syncthreads();
    {
        const int n = tid >> 3, ks = (tid & 7) * 16;
        const int rho = n & 31, nsrc = (n & ~31) + 8 * ((rho & 15) >> 2) + 4 * (rho >> 4) + (rho & 3);
        const LAS float* sp = sT + nsrc * 129 + ks;
#pragma unroll
        for (int hh = 0; hh < 2; ++hh) { u32x4 w; const LAS float* q = sp + 8 * hh;
            w.x = pk_bf16(q[0], q[1]); w.y = pk_bf16(q[2], q[3]); w.z = pk_bf16(q[4], q[5]); w.w = pk_bf16(q[6], q[7]);
            *(u32x4*)(J.dst + (size_t)(n0 + n) * J.K + k0 + ks + 8 * hh) = w; }
    }
}

__device__ __forceinline__ void mod_task(const P& p, int m, LAS float* sm) {
    const int tid = tid_(), l = m / 192, colbase = (m % 192) * 32, cl = tid & 31, ks = tid >> 5;
    LAS float* SC = sm; LAS float* RED = sm + 9216;
    for (int i = tid; i < 9216; i += NTHR) { const int j = i >> 10, k = i & 1023; const float c = (j == 0) ? p.in[lnd(6)][k] : p.in[lnd(2)][(j - 1) * 1024 + k]; SC[i] = c * sigmoidf_(c); }
    __syncthreads();
    float acc[9];
#pragma unroll
    for (int j = 0; j < 9; ++j) acc[j] = 0.f;
    const float* w = p.in[lnd(7)] + (size_t)l * 1024 * 6144 + colbase + cl;
    for (int k8 = 0; k8 < 64; k8 += 16) { float wv[16];
#pragma unroll
        for (int u = 0; u < 16; ++u) wv[u] = w[(size_t)(ks * 64 + k8 + u) * 6144];
#pragma unroll
        for (int u = 0; u < 16; ++u)
#pragma unroll
            for (int j = 0; j < 9; ++j) acc[j] += SC[j * 1024 + ks * 64 + k8 + u] * wv[u]; }
#pragma unroll
    for (int j = 0; j < 9; ++j) RED[(ks * 9 + j) * 32 + cl] = acc[j];
    __syncthreads();
    if (tid < 288) { const int j = tid >> 5, c = tid & 31; float s = 0.f;
#pragma unroll
        for (int q = 0; q < 16; ++q) s += RED[(q * 9 + j) * 32 + c];
        float* mod = (float*)(p.ws + WS_MOD);
        mod[((size_t)l * 9 + j) * 6144 + colbase + c] = s + p.in[lnd(8)][(size_t)l * 6144 + colbase + c]; }
}

__device__ __forceinline__ void s5_mats(const P& p, int l, int gq, LAS float* sm) {
    const int tid = tid_(), g = gq >> 2, part = gq & 3;
    LAS float* KF = sm; LAS float* KB = sm + 8192; LAS float* LT = sm + 16384; LAS float* CC = sm + 20608; LAS float* BB = sm + 22656;
    bf16_t* MC = (bf16_t*)(p.ws + WS_R1) + (size_t)g * 512 * 768;
    bf16_t* EM = (bf16_t*)(p.ws + WS_EMAT) + (size_t)g * 256 * 512;
    for (int d = 0; d < 2; ++d) {
        const int pg = (l * 2 + d) * 32 + g;
        const float* lamr = p.in[lnd(15)] + (size_t)pg * 64; const float* lami = p.in[lnd(16)] + (size_t)pg * 64;
        const float dt = expf(p.in[lnd(17)][pg]);
        const float* bre = p.in[lnd(18)] + (size_t)pg * 1024; const float* bim = p.in[lnd(19)] + (size_t)pg * 1024;
        const float* cre = p.in[lnd(20)] + (size_t)pg * 1024; const float* cim = p.in[lnd(21)] + (size_t)pg * 1024;
        for (int i = tid; i < 33 * 64; i += NTHR) { const int tau = i >> 6, pp = i & 63; const float a = expf(lamr[pp] * dt * (float)tau); float s, c; sincosf(lami[pp] * dt * (float)tau, &s, &c); LT[2 * i] = a * c; LT[2 * i + 1] = a * s; }
        for (int i = tid; i < 1024; i += NTHR) { CC[2 * i] = cre[i]; CC[2 * i + 1] = cim[i]; }
        for (int i = tid; i < 1024; i += NTHR) {
            const int pp = i >> 4; const float lr = lamr[pp], li = lami[pp]; float s, c; sincosf(li * dt, &s, &c);
            const float em1 = expm1f(lr * dt); float sh, ch; sincosf(0.5f * li * dt, &sh, &ch);
            const float nr = em1 * c - 2.f * sh * sh, ni = (em1 + 1.f) * s;
            const float inv = 1.f / (lr * lr + li * li);
            const float qr = (nr * lr + ni * li) * inv, qi = (ni * lr - nr * li) * inv;
            const float br = bre[i], bi = bim[i];
            BB[2 * i] = qr * br - qi * bi; BB[2 * i + 1] = qr * bi + qi * br;
        }
        __syncthreads();
        {
            const int tau = tid >> 4, n = tid & 15; float acc[16];
#pragma unroll
            for (int m = 0; m < 16; ++m) acc[m] = 0.f;
            const bool need = d == 0 ? (tau <= 31 - 8 * part) : (tau <= 8 * part + 7);
            if (need) for (int pp = 0; pp < 64; ++pp) {
                const float cr = CC[2 * (n * 64 + pp)], ci = CC[2 * (n * 64 + pp) + 1], lr = LT[2 * (tau * 64 + pp)], li = LT[2 * (tau * 64 + pp) + 1];
                const float xr = cr * lr - ci * li, xi = cr * li + ci * lr;
#pragma unroll
                for (int m = 0; m < 16; ++m) acc[m] += xr * BB[2 * (pp * 16 + m)] - xi * BB[2 * (pp * 16 + m) + 1];
            }
            LAS float* Kd = d ? KB : KF;
#pragma unroll
            for (int m = 0; m < 16; ++m) Kd[(tau * 16 + n) * 16 + m] = acc[m];
        }
        {
            const int pp = tid >> 3, cseg = tid & 7;
            { const int jj = part;
                const int j = cseg * 4 + jj, e = d == 0 ? 31 - j : j; const float lr = LT[2 * (e * 64 + pp)], li = LT[2 * (e * 64 + pp) + 1];
                float re[16], im[16];
#pragma unroll
                for (int m = 0; m < 16; ++m) { const float br = BB[2 * (pp * 16 + m)], bi = BB[2 * (pp * 16 + m) + 1]; re[m] = lr * br - li * bi; im[m] = lr * bi + li * br; }
                bf16_t* er = EM + (size_t)(d * 128 + pp) * 512 + j * 16; bf16_t* ei = EM + (size_t)(d * 128 + 64 + pp) * 512 + j * 16;
#pragma unroll
                for (int h = 0; h < 2; ++h) {
                    u32x4 w; w.x = pk_bf16(re[8 * h], re[8 * h + 1]); w.y = pk_bf16(re[8 * h + 2], re[8 * h + 3]); w.z = pk_bf16(re[8 * h + 4], re[8 * h + 5]); w.w = pk_bf16(re[8 * h + 6], re[8 * h + 7]); *(u32x4*)(er + 8 * h) = w;
                    u32x4 x; x.x = pk_bf16(im[8 * h], im[8 * h + 1]); x.y = pk_bf16(im[8 * h + 2], im[8 * h + 3]); x.z = pk_bf16(im[8 * h + 4], im[8 * h + 5]); x.w = pk_bf16(im[8 * h + 6], im[8 * h + 7]); *(u32x4*)(ei + 8 * h) = x;
                }
            }
        }
        {
            const int t = tid >> 4, n = tid & 15, f = d == 0 ? t + 1 : 32 - t;
            bf16_t* mr = MC + (size_t)tid * 768 + 512 + d * 128;
#pragma unroll 1
            for (int p8 = 2 * part; p8 < 2 * part + 2; ++p8) {
                float re[8], im[8];
#pragma unroll
                for (int q = 0; q < 8; ++q) { const int pp = p8 * 8 + q; const float cr = CC[2 * (n * 64 + pp)], ci = CC[2 * (n * 64 + pp) + 1], lr = LT[2 * (f * 64 + pp)], li = LT[2 * (f * 64 + pp) + 1];
                    re[q] = cr * lr - ci * li; im[q] = -(cr * li + ci * lr); }
                u32x4 w; w.x = pk_bf16(re[0], re[1]); w.y = pk_bf16(re[2], re[3]); w.z = pk_bf16(re[4], re[5]); w.w = pk_bf16(re[6], re[7]); *(u32x4*)(mr + p8 * 8) = w;
                u32x4 x; x.x = pk_bf16(im[0], im[1]); x.y = pk_bf16(im[2], im[3]); x.z = pk_bf16(im[4], im[5]); x.w = pk_bf16(im[6], im[7]); *(u32x4*)(mr + 64 + p8 * 8) = x;
            }
        }
        __syncthreads();
    }
    {
        const int t = tid >> 4, n = tid & 15; const float dsk = p.in[lnd(22)][(size_t)l * 512 + g * 16 + n];
        bf16_t* mr = MC + (size_t)tid * 768;
#pragma unroll 1
        for (int j = 8 * part; j < 8 * part + 8; ++j) {
            float v[16];
#pragma unroll
            for (int m = 0; m < 16; ++m) v[m] = 0.f;
            if (j <= t) { const LAS float* k = KF + ((t - j) * 16 + n) * 16;
#pragma unroll
                for (int m = 0; m < 16; ++m) v[m] += k[m]; }
            if (j >= t) { const LAS float* k = KB + ((j - t) * 16 + n) * 16;
#pragma unroll
                for (int m = 0; m < 16; ++m) v[m] += k[m]; }
            if (j == t) {
#pragma unroll
                for (int m = 0; m < 16; ++m) v[m] += (m == n) ? dsk : 0.f; }
            u32x4 w; w.x = pk_bf16(v[0], v[1]); w.y = pk_bf16(v[2], v[3]); w.z = pk_bf16(v[4], v[5]); w.w = pk_bf16(v[6], v[7]); *(u32x4*)(mr + j * 16) = w;
            u32x4 x; x.x = pk_bf16(v[8], v[9]); x.y = pk_bf16(v[10], v[11]); x.z = pk_bf16(v[12], v[13]); x.w = pk_bf16(v[14], v[15]); *(u32x4*)(mr + j * 16 + 8) = x;
        }
    }
}

__device__ __forceinline__ void phase_prep(const P& p, int l, LAS unsigned char* lds) {
    LAS float* sm = (LAS float*)lds;
    const int b = bid_(), G = gridDim.x, ha = G >> 1;
    if (b < ha) { for (int t = b; t < 128; t += ha) { s5_mats(p, l, t, sm); __syncthreads(); } }
    else { for (int t = b - ha; t < CONV_TILES; t += G - ha) { conv_tile(p, l, t, sm); __syncthreads(); } }
    if (l == 0) for (int t = b; t < 384; t += G) { mod_task(p, t, sm); __syncthreads(); }
}

__device__ __forceinline__ void norm_row_write(const f32x4 (&x)[4], const float* g, const float* mod, int shoff, int scoff, bf16_t* hrow, int lane) {
    float ss = 0.f;
#pragma unroll
    for (int i = 0; i < 4; ++i) ss += x[i][0] * x[i][0] + x[i][1] * x[i][1] + x[i][2] * x[i][2] + x[i][3] * x[i][3];
    ss = wave_sum(ss);
    const float rstd = rsqrtf(ss * (1.0f / 1024.0f) + 1e-6f);
#pragma unroll
    for (int i = 0; i < 4; ++i) { const int d = i * 256 + lane * 4; const f32x4 gg = *(const f32x4*)(g + d), sc = *(const f32x4*)(mod + scoff + d), sh = *(const f32x4*)(mod + shoff + d);
        f32x4 h;
#pragma unroll
        for (int e = 0; e < 4; ++e) h[e] = x[i][e] * rstd * gg[e] * (1.f + sc[e]) + sh[e];
        { u32x2 w; w.x = pk_bf16(h[0], h[1]); w.y = pk_bf16(h[2], h[3]); __builtin_nontemporal_store(w, (u32x2*)(hrow + d)); } }
}
__device__ __forceinline__ void phase_norm(const P& p, int l, int which) {
    const int lane = tid_() & 63, gw = bid_() * 8 + (tid_() >> 6), nw = gridDim.x * 8;
    const float* g = (which == 1 ? p.in[lnd(9)] : p.in[lnd(27)]) + (size_t)l * 1024;
    const float* modl = (const float*)(p.ws + WS_MOD) + (size_t)l * 9 * 6144;
    const int shoff = which == 1 ? 0 : 3072, scoff = which == 1 ? 1024 : 4096;
    bf16_t* H = (bf16_t*)(p.ws + WS_R2); float* X = p.out;
    if (which == 1 && l == 0) {
        for (int item = gw; item < 4096 + 8192; item += nw) {
            if (item < 4096) {
                const int n = item; const float rr = (float)(n >> 6), cc = (float)(n & 63); f32x4 pe[4];
#pragma unroll
                for (int e = 0; e < 4; ++e) { const float om = expf(-(float)(lane * 4 + e) * (9.210340371976184f / 256.0f)); float s, c; sincosf(rr * om, &s, &c); pe[0][e] = s; pe[1][e] = c; sincosf(cc * om, &s, &c); pe[2][e] = s; pe[3][e] = c; }
                for (int b0 = 0; b0 < 8; b0 += 2) { f32x4 x[2][4];
#pragma unroll
                    for (int r = 0; r < 2; ++r) { const float* src = p.in[lnd(1)] + ((size_t)(b0 + r) * 4096 + n) * 1024;
#pragma unroll
                        for (int i = 0; i < 4; ++i) x[r][i] = *(const f32x4*)(src + i * 256 + lane * 4); }
#pragma unroll
                    for (int r = 0; r < 2; ++r) { const int row = TOKP + (b0 + r) * 4096 + n;
#pragma unroll
                        for (int i = 0; i < 4; ++i) { x[r][i] = x[r][i] + pe[i]; *(f32x4*)(X + (size_t)row * 1024 + i * 256 + lane * 4) = x[r][i]; }
                        norm_row_write(x[r], g, modl + (size_t)(1 + b0 + r) * 6144, shoff, scoff, H + (size_t)row * 1024, lane); } }
            } else { const int row = item - 4096; const float* src = p.in[lnd(0)] + (size_t)row * 1024; f32x4 x[4];
#pragma unroll
                for (int i = 0; i < 4; ++i) { x[i] = *(const f32x4*)(src + i * 256 + lane * 4); *(f32x4*)(X + (size_t)row * 1024 + i * 256 + lane * 4) = x[i]; }
                norm_row_write(x, g, modl, shoff, scoff, H + (size_t)row * 1024, lane); }
        }
    } else {
        const bf16_t* DL = (const bf16_t*)(p.ws + (which == 1 ? WS_R2 : WS_R3));
        for (int it = gw; it < TOK / 4; it += nw) {
            const int rowb = it * 4; const float* mod = modl + (size_t)mod_index(rowb) * 6144;
            f32x4 x[4][4]; u32x2 dv[4][4];
#pragma unroll
            for (int r = 0; r < 4; ++r)
#pragma unroll
                for (int i = 0; i < 4; ++i) { x[r][i] = __builtin_nontemporal_load((const f32x4*)(X + (size_t)(rowb + r) * 1024 + i * 256 + lane * 4)); dv[r][i] = __builtin_nontemporal_load((const u32x2*)(DL + (size_t)(rowb + r) * 1024 + i * 256 + lane * 4)); }
            f32x4 gs[4], sh[4];
#pragma unroll
            for (int i = 0; i < 4; ++i) { const int d = i * 256 + lane * 4; const f32x4 gg = *(const f32x4*)(g + d), sc = *(const f32x4*)(mod + scoff + d); sh[i] = *(const f32x4*)(mod + shoff + d); gs[i] = gg * (sc + 1.f); }
#pragma unroll
            for (int r = 0; r < 4; ++r) { float ss = 0.f;
#pragma unroll
                for (int i = 0; i < 4; ++i) { x[r][i] = x[r][i] + (f32x4){bflo(dv[r][i].x), bfhi(dv[r][i].x), bflo(dv[r][i].y), bfhi(dv[r][i].y)}; *(f32x4*)(X + (size_t)(rowb + r) * 1024 + i * 256 + lane * 4) = x[r][i];
                    ss += x[r][i][0] * x[r][i][0] + x[r][i][1] * x[r][i][1] + x[r][i][2] * x[r][i][2] + x[r][i][3] * x[r][i][3]; }
                ss = wave_sum(ss); const float rstd = rsqrtf(ss * (1.0f / 1024.0f) + 1e-6f);
#pragma unroll
                for (int i = 0; i < 4; ++i) { const f32x4 hv = x[r][i] * rstd * gs[i] + sh[i]; u32x2 w; w.x = pk_bf16(hv[0], hv[1]); w.y = pk_bf16(hv[2], hv[3]); __builtin_nontemporal_store(w, (u32x2*)(H + (size_t)(rowb + r) * 1024 + i * 256 + lane * 4)); } }
        }
    }
}
__device__ __forceinline__ void phase_final(const P& p) {
    const int lane = tid_() & 63, gw = bid_() * 8 + (tid_() >> 6), nw = gridDim.x * 8; float* X = p.out; const float* g = p.in[lnd(30)]; const bf16_t* DL = (const bf16_t*)(p.ws + WS_R2);
    for (int row0 = gw; row0 < TOK; row0 += 4 * nw) {
        f32x4 x[4][4]; u32x2 dv[4][4];
#pragma unroll
        for (int r = 0; r < 4; ++r) { const int row = row0 + r * nw;
            if (row < TOK) {
#pragma unroll
                for (int i = 0; i < 4; ++i) { x[r][i] = __builtin_nontemporal_load((const f32x4*)(X + (size_t)row * 1024 + i * 256 + lane * 4)); dv[r][i] = __builtin_nontemporal_load((const u32x2*)(DL + (size_t)row * 1024 + i * 256 + lane * 4)); } } }
#pragma unroll
        for (int r = 0; r < 4; ++r) { const int row = row0 + r * nw;
            if (row < TOK) { float ss = 0.f;
#pragma unroll
                for (int i = 0; i < 4; ++i) { x[r][i] = x[r][i] + (f32x4){bflo(dv[r][i].x), bfhi(dv[r][i].x), bflo(dv[r][i].y), bfhi(dv[r][i].y)}; ss += x[r][i][0] * x[r][i][0] + x[r][i][1] * x[r][i][1] + x[r][i][2] * x[r][i][2] + x[r][i][3] * x[r][i][3]; }
                ss = wave_sum(ss); const float rstd = rsqrtf(ss * (1.0f / 1024.0f) + 1e-6f);
#pragma unroll
                for (int i = 0; i < 4; ++i) { const f32x4 gg = *(const f32x4*)(g + i * 256 + lane * 4); *(f32x4*)(X + (size_t)row * 1024 + i * 256 + lane * 4) = x[r][i] * rstd * gg; } } }
    }
}

__device__ __forceinline__ void phase_s5scan(const P& p, int l) {
    const float* E = (const float*)(p.ws + WS_E); bf16_t* UG = (bf16_t*)(p.ws + WS_R5);
    float* ore = p.out + (size_t)TOK * 1024 + 16777216; float* oim = ore + 262144;
    for (int task = bid_(); task < 320; task += gridDim.x) {
        const int idx = task * NTHR + tid_(), pp = idx & 63, d = (idx >> 6) & 1, g = (idx >> 7) & 31, s = 39 - (idx >> 12);
        const int nch = s < 32 ? 8 : 128, cbase = s < 32 ? s * 8 : 256 + (s - 32) * 128;
        const int pg = (l * 2 + d) * 32 + g; const float dt = expf(p.in[lnd(17)][pg]);
        const float a = expf(p.in[lnd(15)][(size_t)pg * 64 + pp] * dt * 32.f); float sn, cs; sincosf(p.in[lnd(16)][(size_t)pg * 64 + pp] * dt * 32.f, &sn, &cs);
        const float ar = a * cs, ai = a * sn;
        float sr = 0.f, si = 0.f;
        if (s >= 32) { const size_t o = ((((size_t)(s - 32) * 2 + l) * 2 + d) * 32 + g) * 64 + pp; sr = p.in[lnd(4)][o]; si = p.in[lnd(5)][o]; }
        const float* Eb = E + ((size_t)(g * 1280 + cbase) * 256 + d * 128 + pp);
        bf16_t* Ub = UG + ((size_t)(g * 1280 + cbase) * 768 + 512 + d * 128 + pp);
        for (int c0 = 0; c0 < nch; c0 += 8) {
            float er[8], ei[8];
#pragma unroll
            for (int k = 0; k < 8; ++k) { const int c = d == 0 ? c0 + k : nch - 1 - (c0 + k); er[k] = Eb[(size_t)c * 256]; ei[k] = Eb[(size_t)c * 256 + 64]; }
#pragma unroll
            for (int k = 0; k < 8; ++k) { const int c = d == 0 ? c0 + k : nch - 1 - (c0 + k);
                Ub[(size_t)c * 768] = f2bf(sr); Ub[(size_t)c * 768 + 64] = f2bf(si);
                const float nr = ar * sr - ai * si + er[k], ni = ar * si + ai * sr + ei[k]; sr = nr; si = ni; }
        }
        if (s < 32) { const size_t o = ((((size_t)s * 2 + l) * 2 + d) * 32 + g) * 64 + pp; ore[o] = sr; oim[o] = si; }
    }
}

__device__ __forceinline__ void phase_glapre(const P& p, int l, LAS unsigned char* lds) {
    const int tid = tid_(), d = tid & 127, tq = tid >> 7, wv = tid >> 6, lane = tid & 63, fr = lane & 15, fq = lane >> 4;
    LAS float* sG = (LAS float*)lds; LAS float* sT4b = sG + 2048; LAS float* sZ = sG + 3072;
    bf16_t* Q = (bf16_t*)(p.ws + WS_R3); bf16_t* Kk = Q + (size_t)TOK * 512;
    bf16_t* QB = (bf16_t*)(p.ws + WS_R5); bf16_t* KB = QB + (size_t)TOK * 512;
    const float* GLR = (const float*)(p.ws + WS_GLR);
    bf16x8 bw[2]; int hcur = -1;
    for (int task = bid_(); task < 2560; task += gridDim.x) {
        const int c64 = task >> 2, h = task & 3, tb = c64 * 64;
        { const int row = tid >> 3, c4 = (tid & 7) * 4; *(LAS f32x4*)(sG + row * 32 + c4) = *(const f32x4*)(GLR + (size_t)(tb + row) * 32 + c4); }
        float qv[16], kv[16];
#pragma unroll
        for (int i = 0; i < 16; ++i) { const size_t o = (size_t)(tb + tq * 16 + i) * 512 + h * 128 + d; qv[i] = bf2f(Q[o]); kv[i] = bf2f(Kk[o]); }
        if (h != hcur) { hcur = h;
#pragma unroll
        for (int dir = 0; dir < 2; ++dir) { float w8[8];
#pragma unroll
            for (int e = 0; e < 8; ++e) { const int kk = 8 * fq + e - 16 * dir; w8[e] = (kk >= 0 && kk < 16) ? p.in[lnd(11)][((size_t)(l * 2 + dir) * 16 + kk) * 512 + h * 128 + 16 * wv + fr] : 0.f; }
            u32x4 pk; pk.x = pk_bf16(w8[0], w8[1]); pk.y = pk_bf16(w8[2], w8[3]); pk.z = pk_bf16(w8[4], w8[5]); pk.w = pk_bf16(w8[6], w8[7]);
            bw[dir] = __builtin_bit_cast(bf16x8, pk); } }
        __syncthreads();
#pragma unroll
        for (int ti = 0; ti < 4; ++ti) {
            const LAS float* gr = sG + (16 * ti + fr) * 32 + 8 * fq; const f32x4 g0 = *(const LAS f32x4*)gr, g1 = *(const LAS f32x4*)(gr + 4);
            u32x4 pk; pk.x = pk_bf16(g0[0], g0[1]); pk.y = pk_bf16(g0[2], g0[3]); pk.z = pk_bf16(g1[0], g1[1]); pk.w = pk_bf16(g1[2], g1[3]);
            const bf16x8 af = __builtin_bit_cast(bf16x8, pk);
#pragma unroll
            for (int dir = 0; dir < 2; ++dir) { const f32x4 z = __builtin_amdgcn_mfma_f32_16x16x32_bf16(af, bw[dir], (f32x4){0.f, 0.f, 0.f, 0.f}, 0, 0, 0);
#pragma unroll
                for (int e = 0; e < 4; ++e) sZ[(dir * 64 + 16 * ti + 4 * fq + e) * 128 + 16 * wv + fr] = z[e]; }
        }
        __syncthreads();
#pragma unroll 1
        for (int dir = 0; dir < 2; ++dir) {
            LAS float* sT4 = sT4b + dir * 512;
            const float bg = p.in[lnd(12)][(size_t)(l * 2 + dir) * 512 + h * 128 + d];
            float cum[16];
#pragma unroll
            for (int i = 0; i < 16; ++i) { const float z = sZ[(dir * 64 + tq * 16 + i) * 128 + d] + bg;
                cum[i] = (fminf(z, 0.f) - __logf(1.0f + __expf(-fabsf(z)))) * 0.0625f; }
            if (dir == 0) {
#pragma unroll
                for (int i = 1; i < 16; ++i) cum[i] += cum[i - 1];
            } else {
#pragma unroll
                for (int i = 14; i >= 0; --i) cum[i] += cum[i + 1];
            }
            sT4[tq * 128 + d] = dir == 0 ? cum[15] : cum[0];
            __syncthreads();
            float off = 0.f, total = 0.f;
#pragma unroll
            for (int q = 0; q < 4; ++q) { const float v = sT4[q * 128 + d]; total += v; if (dir == 0 ? (q < tq) : (q > tq)) off += v; }
            bf16_t* QD = dir == 0 ? Q : QB; bf16_t* KI = dir == 0 ? Kk : KB;
#pragma unroll
            for (int i = 0; i < 16; ++i) { const float cm = cum[i] + off; const size_t o = (size_t)(tb + tq * 16 + i) * 512 + h * 128 + d;
                QD[o] = f2bf(qv[i] * __expf(cm)); KI[o] = f2bf(kv[i] * __expf(-cm)); }
            if (tq == 0) ((float*)(p.ws + (dir == 0 ? WS_TOTF : WS_TOTB)))[(size_t)c64 * 512 + h * 128 + d] = total;
        }
    }
}

constexpr int GLA_GRP = 71168;
typedef short s16x4 __attribute__((ext_vector_type(4)));
__device__ __forceinline__ bf16x8 tr_frag(const LAS bf16_t* base, int stride, int krow0, int col0, int fr, int fq) {
    const LAS bf16_t* q = base + (krow0 + 8 * fq + (fr >> 2)) * stride + col0 + 4 * (fr & 3);
    const s16x4 a = __builtin_amdgcn_ds_read_tr16_b64_v4i16((LAS s16x4*)q);
    const s16x4 b = __builtin_amdgcn_ds_read_tr16_b64_v4i16((LAS s16x4*)(q + 4 * stride));
    return __builtin_shufflevector(a, b, 0, 1, 2, 3, 4, 5, 6, 7);
}
__device__ __forceinline__ bf16x8 tr_frag_perm(const LAS bf16_t* base, int stride, int ks, int col0, int fr, int fq) {
    const LAS bf16_t* q = base + (32 * ks + 4 * fq + (fr >> 2)) * stride + col0 + 4 * (fr & 3);
    const s16x4 a = __builtin_amdgcn_ds_read_tr16_b64_v4i16((LAS s16x4*)q);
    const s16x4 b = __builtin_amdgcn_ds_read_tr16_b64_v4i16((LAS s16x4*)(q + 16 * stride));
    return __builtin_shufflevector(a, b, 0, 1, 2, 3, 4, 5, 6, 7);
}
#define LDS_BAR() do { asm volatile("s_waitcnt lgkmcnt(0)" ::: "memory"); __builtin_amdgcn_s_barrier(); asm volatile("" ::: "memory"); } while (0)
__device__ __forceinline__ void phase_gla(const P& p, int l, LAS unsigned char* lds) {
    const int tid = tid_(), grp = __builtin_amdgcn_readfirstlane(tid >> 8), gt = tid & 255, wv = __builtin_amdgcn_readfirstlane((tid >> 6) & 3), lane = tid & 63, fr = lane & 15, fq = lane >> 4;
    LAS unsigned char* gl = lds + grp * GLA_GRP;
    LAS bf16_t* sQ = (LAS bf16_t*)gl; LAS bf16_t* sK = (LAS bf16_t*)(gl + 17408); LAS bf16_t* sV = (LAS bf16_t*)(gl + 34816);
    LAS bf16_t* sP = (LAS bf16_t*)(gl + 44032); LAS bf16_t* sS = (LAS bf16_t*)(gl + 53248); LAS float* sTot = (LAS float*)(gl + 70656);
    const bf16_t* QD = grp == 0 ? (const bf16_t*)(p.ws + WS_R3) : (const bf16_t*)(p.ws + WS_R5);
    const bf16_t* KI = QD + (size_t)TOK * 512;
    const bf16_t* V = (const bf16_t*)(p.ws + WS_R4);
    const float* TOT = (const float*)(p.ws + (grp == 0 ? WS_TOTF : WS_TOTB));
    bf16_t* O = (bf16_t*)(p.ws + WS_R1);
    float* OST = p.out + (size_t)TOK * 1024;
    const int G = gridDim.x, b = bid_();
    const bool custom = (G == 256);
    const int ntask_mine = custom ? (b < 128 ? 1 : 4) : ((640 - b + G - 1) / G);
    for (int ti = 0; ti < ntask_mine; ++ti) {
        const int task = custom ? (b < 128 ? b : b + 128 * ti) : b + G * ti;
        if (task >= 640) break;
        const bool sample = task < 128;
        const int t2 = sample ? task : task - 128, xcd_ = t2 & 7, vs = (t2 >> 3) & 3, sh_ = xcd_ + 8 * (t2 >> 5), sb = sh_ >> 2, h = sh_ & 3;
        const int base = sample ? TOKP + sb * 4096 : sb * 256, nch = sample ? 64 : 4;
        f32x4 accS[2][4];
#pragma unroll
        for (int dt = 0; dt < 2; ++dt)
#pragma unroll
            for (int vt = 0; vt < 4; ++vt) {
                f32x4 a = (f32x4){0.f, 0.f, 0.f, 0.f};
                if (sample) { const float* cp = p.in[lnd(3)] + (((((size_t)sb * 2 + l) * 2 + grp) * 4 + h) * 128 + 16 * (2 * wv + dt) + 4 * fq) * 256 + vs * 64 + 16 * vt + fr;
#pragma unroll
                    for (int e = 0; e < 4; ++e) a[e] = cp[(size_t)e * 256]; }
                accS[dt][vt] = a;
                u32x2 w; w.x = pk_bf16(a[0], a[1]); w.y = pk_bf16(a[2], a[3]);
                *(LAS u32x2*)(sS + (16 * vt + fr) * 136 + 16 * (2 * wv + dt) + 4 * fq) = w;
            }
        u32x4 rq[2][4], rk[2][4], rv[2][2]; float rt[2] = {0.f, 0.f};
        u32x2 oprev[2][4];
#pragma unroll
        for (int u = 0; u < 2; ++u)
#pragma unroll
            for (int vt = 0; vt < 4; ++vt) oprev[u][vt] = (u32x2){0u, 0u};
#define GLA_CHUNK(st) (grp == 0 ? (st) : nch - 1 - (st))
#define GLA_LOAD(U, ci) do { const int tb_ = base + (ci) * 64; \
        _Pragma("unroll") for (int i = 0; i < 4; ++i) { const int idx = gt + 256 * i, row = idx >> 4, c16 = idx & 15; const size_t o = (size_t)(tb_ + row) * 512 + h * 128 + c16 * 8; rq[U][i] = *(const u32x4*)(QD + o); rk[U][i] = *(const u32x4*)(KI + o); } \
        _Pragma("unroll") for (int i = 0; i < 2; ++i) { const int idx = gt + 256 * i, row = idx >> 3, c8 = idx & 7; rv[U][i] = *(const u32x4*)(V + (size_t)(tb_ + row) * 1024 + h * 256 + vs * 64 + c8 * 8); } \
        if (gt < 128) rt[U] = TOT[(size_t)(tb_ >> 6) * 512 + h * 128 + gt]; } while (0)
#define GLA_STORE(U) do { \
        _Pragma("unroll") for (int i = 0; i < 4; ++i) { const int idx = gt + 256 * i, row = idx >> 4, c16 = idx & 15; *(LAS u32x4*)(sQ + row * 136 + c16 * 8) = rq[U][i]; *(LAS u32x4*)(sK + row * 136 + c16 * 8) = rk[U][i]; } \
        _Pragma("unroll") for (int i = 0; i < 2; ++i) { const int idx = gt + 256 * i, row = idx >> 3, c8 = idx & 7; *(LAS u32x4*)(sV + row * 72 + c8 * 8) = rv[U][i]; } \
        if (gt < 128) sTot[gt] = rt[U]; } while (0)
#define GLA_OLOAD(U, st) do { const int tb_ = base + GLA_CHUNK(st) * 64; \
        _Pragma("unroll") for (int vt = 0; vt < 4; ++vt) oprev[U][vt] = *(const u32x2*)(O + (size_t)(tb_ + 16 * wv + fr) * 1024 + h * 256 + vs * 64 + 16 * vt + 4 * fq); } while (0)
        GLA_LOAD(0, GLA_CHUNK(0));
        GLA_STORE(0);
        GLA_LOAD(1, GLA_CHUNK(1));
        __syncthreads();
        const int half = nch >> 1;
        for (int s0 = 0; s0 < nch; s0 += 2) {
#pragma unroll
          for (int u = 0; u < 2; ++u) {
            const int s = s0 + u;
            const int ci = GLA_CHUNK(s), tb = base + ci * 64;
            const bool second = (s >= half);
            if (s == half) GLA_OLOAD(u, s);
            if (s + 1 < nch && s + 1 > half) GLA_OLOAD(u ^ 1, s + 1);
            asm volatile("" ::: "memory");
            if (s + 2 < nch) GLA_LOAD(u, GLA_CHUNK(s + 2));
            bf16x8 pfr[2];
            { bf16x8 qa[4];
#pragma unroll
            for (int ks = 0; ks < 4; ++ks) qa[ks] = *(const LAS bf16x8*)(sQ + (16 * wv + fr) * 136 + 32 * ks + 8 * fq);
            u32x2 pk2[4];
#pragma unroll
            for (int jt = 0; jt < 4; ++jt) {
                bf16x8 kb[4];
#pragma unroll
                for (int ks = 0; ks < 4; ++ks) kb[ks] = *(const LAS bf16x8*)(sK + (16 * jt + fr) * 136 + 32 * ks + 8 * fq);
                f32x4 acc = (f32x4){0.f, 0.f, 0.f, 0.f};
#pragma unroll
                for (int ks = 0; ks < 4; ++ks) acc = __builtin_amdgcn_mfma_f32_16x16x32_bf16(kb[ks], qa[ks], acc, 0, 0, 0);
                const int i = 16 * wv + fr;
#pragma unroll
                for (int e = 0; e < 4; ++e) { const int j = 16 * jt + 4 * fq + e; const bool keep = grp == 0 ? (j <= i) : (j >= i); acc[e] = keep ? acc[e] : 0.f; }
                pk2[jt].x = pk_bf16(acc[0], acc[1]); pk2[jt].y = pk_bf16(acc[2], acc[3]);
            }
#pragma unroll
            for (int ks = 0; ks < 2; ++ks) { u32x4 w; w.x = pk2[2 * ks].x; w.y = pk2[2 * ks].y; w.z = pk2[2 * ks + 1].x; w.w = pk2[2 * ks + 1].y; pfr[ks] = __builtin_bit_cast(bf16x8, w); }
            }
            asm volatile("" ::: "memory");
            bf16x8 vf[4][2];
#pragma unroll
            for (int vt = 0; vt < 4; ++vt)
#pragma unroll
                for (int ks = 0; ks < 2; ++ks) vf[vt][ks] = tr_frag_perm(sV, 72, ks, 16 * vt, fr, fq);
#pragma unroll
            for (int dt = 0; dt < 2; ++dt) {
                bf16x8 kf[2];
#pragma unroll
                for (int ks = 0; ks < 2; ++ks) kf[ks] = tr_frag_perm(sK, 136, ks, 16 * (2 * wv + dt), fr, fq);
                const f32x4 tt = *(const LAS f32x4*)(sTot + 16 * (2 * wv + dt) + 4 * fq);
                const f32x4 sc = (f32x4){__expf(tt[0]), __expf(tt[1]), __expf(tt[2]), __expf(tt[3])};
#pragma unroll
                for (int vt = 0; vt < 4; ++vt) {
#pragma unroll
                    for (int ks = 0; ks < 2; ++ks) accS[dt][vt] = __builtin_amdgcn_mfma_f32_16x16x32_bf16(kf[ks], vf[vt][ks], accS[dt][vt], 0, 0, 0);
                    accS[dt][vt] = accS[dt][vt] * sc;
                }
            }
            {
                bf16x8 qf[4];
#pragma unroll
                for (int ks = 0; ks < 4; ++ks) qf[ks] = *(const LAS bf16x8*)(sQ + (16 * wv + fr) * 136 + 32 * ks + 8 * fq);
#pragma unroll
                for (int vt = 0; vt < 4; ++vt) {
                    f32x4 acc = (f32x4){0.f, 0.f, 0.f, 0.f};
#pragma unroll
                    for (int ks = 0; ks < 2; ++ks) acc = __builtin_amdgcn_mfma_f32_16x16x32_bf16(vf[vt][ks], pfr[ks], acc, 0, 0, 0);
#pragma unroll
                    for (int ks = 0; ks < 4; ++ks) { const bf16x8 sf = *(const LAS bf16x8*)(sS + (16 * vt + fr) * 136 + 32 * ks + 8 * fq);
                        acc = __builtin_amdgcn_mfma_f32_16x16x32_bf16(sf, qf[ks], acc, 0, 0, 0); }
                    { u32x2 pv = oprev[u][vt]; asm volatile("" : "+v"(pv));
                      if (second) acc = acc + (f32x4){bflo(pv.x), bfhi(pv.x), bflo(pv.y), bfhi(pv.y)}; }
                    store4bf(O + (size_t)(tb + 16 * wv + fr) * 1024 + h * 256 + vs * 64 + 16 * vt + 4 * fq, acc);
                }
            }
            LDS_BAR();
#pragma unroll
            for (int dt = 0; dt < 2; ++dt)
#pragma unroll
                for (int vt = 0; vt < 4; ++vt) { u32x2 w; w.x = pk_bf16(accS[dt][vt][0], accS[dt][vt][1]); w.y = pk_bf16(accS[dt][vt][2], accS[dt][vt][3]);
                    *(LAS u32x2*)(sS + (16 * vt + fr) * 136 + 16 * (2 * wv + dt) + 4 * fq) = w; }
            if (s + 1 < nch) GLA_STORE(u ^ 1);
            if (s == half - 1) { asm volatile("s_waitcnt vmcnt(0)" ::: "memory"); __syncthreads(); } else LDS_BAR();
          }
        }
        if (!sample) {
#pragma unroll
            for (int dt = 0; dt < 2; ++dt)
#pragma unroll
                for (int vt = 0; vt < 4; ++vt) { float* op = OST + (((((size_t)sb * 2 + l) * 2 + grp) * 4 + h) * 128 + 16 * (2 * wv + dt) + 4 * fq) * 256 + vs * 64 + 16 * vt + fr;
#pragma unroll
                    for (int e = 0; e < 4; ++e) op[(size_t)e * 256] = accS[dt][vt][e]; }
        }
    }
#undef GLA_LOAD
#undef GLA_STORE
#undef GLA_OLOAD
#undef GLA_CHUNK
}

__device__ __forceinline__ void phase_glapost(const P& p, int l) {
    const int lane = tid_() & 63, gw = bid_() * 8 + (tid_() >> 6), nw = gridDim.x * 8;
    bf16_t* O = (bf16_t*)(p.ws + WS_R1); const bf16_t* R = (const bf16_t*)(p.ws + WS_R3);
    const float* gn = p.in[lnd(13)] + (size_t)l * 256 + (lane & 15) * 16;
    for (int row = gw; row < TOK; row += nw) {
        const size_t o = (size_t)row * 1024 + lane * 16; float x[16], r[16];
#pragma unroll
        for (int hh = 0; hh < 2; ++hh) { const u32x4 a = *(const u32x4*)(O + o + 8 * hh), c = *(const u32x4*)(R + o + 8 * hh);
            x[8 * hh + 0] = bflo(a.x); x[8 * hh + 1] = bfhi(a.x); x[8 * hh + 2] = bflo(a.y); x[8 * hh + 3] = bfhi(a.y); x[8 * hh + 4] = bflo(a.z); x[8 * hh + 5] = bfhi(a.z); x[8 * hh + 6] = bflo(a.w); x[8 * hh + 7] = bfhi(a.w);
            r[8 * hh + 0] = bflo(c.x); r[8 * hh + 1] = bfhi(c.x); r[8 * hh + 2] = bflo(c.y); r[8 * hh + 3] = bfhi(c.y); r[8 * hh + 4] = bflo(c.z); r[8 * hh + 5] = bfhi(c.z); r[8 * hh + 6] = bflo(c.w); r[8 * hh + 7] = bfhi(c.w); }
        float ss = 0.f;
#pragma unroll
        for (int e = 0; e < 16; ++e) ss += x[e] * x[e];
        ss += __shfl_xor(ss, 1); ss += __shfl_xor(ss, 2); ss += __shfl_xor(ss, 4); ss += __shfl_xor(ss, 8);
        const float rstd = rsqrtf(ss * (1.0f / 256.0f) + 1e-6f);
        float y[16];
#pragma unroll
        for (int e = 0; e < 16; ++e) y[e] = x[e] * rstd * gn[e] * r[e];
#pragma unroll
        for (int hh = 0; hh < 2; ++hh) { u32x4 w; w.x = pk_bf16(y[8 * hh], y[8 * hh + 1]); w.y = pk_bf16(y[8 * hh + 2], y[8 * hh + 3]); w.z = pk_bf16(y[8 * hh + 4], y[8 * hh + 5]); w.w = pk_bf16(y[8 * hh + 6], y[8 * hh + 7]); *(u32x4*)(O + o + 8 * hh) = w; }
    }
}


#define XB_TMO      128
#define XB_XCNT(j)  (256  + 64 * (j))
#define XB_XSUB(j)  (1280 + 64 * (j))
#define XB_XGEN(j)  (2304 + 64 * (j))
#define XB_TOP      3328
#define XB_TOPGEN   3392
#define XCD_BAR_WORDS 3456
#define XB_SPIN_CAP (1u << 18)
__device__ __forceinline__ unsigned xb_ld(unsigned* p)              { return __hip_atomic_load(p, __ATOMIC_RELAXED, __HIP_MEMORY_SCOPE_AGENT); }
__device__ __forceinline__ unsigned xb_add(unsigned* p, unsigned v) { return __hip_atomic_fetch_add(p, v, __ATOMIC_RELAXED, __HIP_MEMORY_SCOPE_AGENT); }
__device__ __forceinline__ unsigned xb_xcc_id() { return (unsigned)__builtin_amdgcn_s_getreg((3 << 11) | 20) & 0xFu; }
#define XB_SPIN(cond, bar) do { unsigned _sp = 0; while (cond) { __builtin_amdgcn_s_sleep(1); \
    if ((++_sp & 255u) == 0u) { if (xb_ld(&(bar)[XB_TMO])) break; if (_sp > XB_SPIN_CAP) { atomicAdd(&(bar)[XB_TMO], 1u); break; } } } } while (0)
struct XcdBarrier { unsigned* bar; unsigned x; volatile LAS unsigned* st; };
__device__ __forceinline__ XcdBarrier xcd_barrier_post(unsigned* bar, volatile LAS unsigned* st) {
    XcdBarrier b; b.bar = bar; b.x = xb_xcc_id(); b.st = st;
    if (threadIdx.x == 0) (void)xb_add(&bar[XB_XCNT(b.x)], 1u);
    return b;
}
__device__ __forceinline__ void xcd_barrier_complete(unsigned* bar, unsigned x, unsigned& nloc, unsigned& nx) {
    const unsigned G = gridDim.x * gridDim.y * gridDim.z;
    unsigned sum, cnt, mine, sp = 0u;
    for (;;) {
        sum = 0u; cnt = 0u; mine = 0u;
#pragma unroll
        for (unsigned j = 0; j < 16; ++j) { const unsigned c = xb_ld(&bar[XB_XCNT(j)]); sum += c; cnt += (c > 0u) ? 1u : 0u; mine = (j == x) ? c : mine; }
        if (sum == G) break;
        __builtin_amdgcn_s_sleep(1);
        if ((++sp & 255u) == 0u) { if (xb_ld(&bar[XB_TMO])) break; if (sp > XB_SPIN_CAP) { atomicAdd(&bar[XB_TMO], 1u); break; } }
    }
    nloc = mine > 0u ? mine : 1u; nx = cnt > 0u ? cnt : 1u;
}
__device__ __forceinline__ void xcd_barrier(const XcdBarrier& b) {
    asm volatile("s_waitcnt vmcnt(0)" ::: "memory");
    __syncthreads();
    if (threadIdx.x == 0) {
        unsigned* bar = b.bar;
        __builtin_amdgcn_s_waitcnt(0);
        unsigned nloc = b.st[0], nx = b.st[1];
        if (nloc == 0u) { xcd_barrier_complete(bar, b.x, nloc, nx); b.st[0] = nloc; b.st[1] = nx; }
        const unsigned old = xb_add(&bar[XB_XSUB(b.x)], 1u);
        const unsigned gen = old / nloc;
        if (old + 1u == (gen + 1u) * nloc) {
            __builtin_amdgcn_fence(__ATOMIC_RELEASE, "agent");
            asm volatile("s_waitcnt vmcnt(0)" ::: "memory");
            const unsigned og = xb_add(&bar[XB_TOP], 1u);
            const unsigned tg = og / nx;
            if (og + 1u == (tg + 1u) * nx) xb_add(&bar[XB_TOPGEN], 1u);
            else XB_SPIN(xb_ld(&bar[XB_TOPGEN]) == tg, bar);
            __builtin_amdgcn_fence(__ATOMIC_ACQUIRE, "agent");
            xb_add(&bar[XB_XGEN(b.x)], 1u);
            asm volatile("s_waitcnt vmcnt(0)" ::: "memory");
        } else {
            XB_SPIN(xb_ld(&bar[XB_XGEN(b.x)]) == gen, bar);
            __builtin_amdgcn_fence(__ATOMIC_ACQUIRE, "agent");
            asm volatile("s_waitcnt vmcnt(0)" ::: "memory");
        }
    }
    __syncthreads();
}

__device__ __forceinline__ void run_phase(const P& p, int ph, LAS unsigned char* lds) {
    if (ph == 2 * PPL) { if (EN(34)) phase_final(p); return; }
    const int l = ph / PPL, q = ph % PPL;
    unsigned char* ws = p.ws; bf16_t* W = (bf16_t*)(ws + WS_W);
    const int G = gridDim.x, c = bid_();
    pg8::Order S;
    switch (q) {
        case 0: if (EN(0)) { phase_prep(p, l, lds); if (l == 1) phase_norm(p, l, 1); } break;
        case 1: if (EN(1)) { if (l == 0) phase_norm(p, l, 1); } break;
        case 2: if (EN(2)) { pg8::Gemm g{(const bf16_t*)(ws + WS_R2), W + W_A / 2, TOK, 2816, 1024, 1024, 0, 0, 1}; S.init(TOK, 2816, 1, G, c);
            EpiPartA E{(bf16_t*)(ws + WS_R3), (bf16_t*)(ws + WS_R3) + (size_t)TOK * 512, (bf16_t*)(ws + WS_R4), (bf16_t*)(ws + WS_R5), (float*)(ws + WS_GLR)};
            pg8::gemm_phase(lds, g, S, E); } break;
        case 3: if (EN(3)) { pg8::Gemm g{(const bf16_t*)(ws + WS_R5), (const bf16_t*)(ws + WS_EMAT), 1280, 256, 512, 768, (size_t)1280 * 768, (size_t)256 * 512, 32}; S.init(1280, 256, 32, G, c);
            EpiE E{(float*)(ws + WS_E)}; pg8::gemm_phase(lds, g, S, E); } break;
        case 4: if (EN(4)) phase_s5scan(p, l); break;
        case 5: if (EN(5)) { pg8::Gemm g{(const bf16_t*)(ws + WS_R5), (const bf16_t*)(ws + WS_R1), 1280, 512, 768, 768, (size_t)1280 * 768, (size_t)512 * 768, 32}; S.init(1280, 512, 32, G, c);
            EpiY E{(bf16_t*)(ws + WS_E)}; pg8::gemm_phase(lds, g, S, E); } break;
        case 6: if (EN(6)) { pg8::Gemm g{(const bf16_t*)(ws + WS_E), W + W_GLU / 2, TOK, 512, 512, 512, 0, 0, 1}; S.init(TOK, 512, 1, G, c);
            EpiGLU E{(const bf16_t*)(ws + WS_E), (bf16_t*)(ws + WS_R6), p.in[lnd(24)] + (size_t)l * 512}; pg8::gemm_phase(lds, g, S, E); } break;
        case 7: if (EN(7)) phase_glapre(p, l, lds); break;
        case 8: if (EN(8)) phase_gla(p, l, lds); break;
        case 9: if (EN(9)) { pg8::Gemm g{(const bf16_t*)(ws + WS_R2), W + W_B / 2, TOK, 3072, 1024, 1024, 0, 0, 1}; S.init(TOK, 3072, 1, G, c);
            EpiPartB E{(bf16_t*)(ws + WS_R3), (bf16_t*)(ws + WS_R4), (bf16_t*)(ws + WS_R5)}; pg8::gemm_phase(lds, g, S, E); } break;
        case 10: if (EN(10)) phase_glapost(p, l); break;
        case 11: if (EN(11)) { pg8::Gemm g{(const bf16_t*)(ws + WS_R1), W + W_PG / 2, TOK, 1024, 1024, 1024, 0, 0, 1}; S.init(TOK, 1024, 1, G, c);
              EpiProj1 E{(const bf16_t*)(ws + WS_R4), (bf16_t*)(ws + WS_R2)}; pg8::gemm_phase(lds, g, S, E); } break;
        case 12: if (EN(12)) { pg8::Gemm g{(const bf16_t*)(ws + WS_R6), W + W_PS / 2, TOK, 1024, 512, 512, 0, 0, 1}; S.init(TOK, 1024, 1, G, c);
              EpiProj2 E{(const bf16_t*)(ws + WS_R5), (bf16_t*)(ws + WS_R2)}; pg8::gemm_phase(lds, g, S, E); } break;
        case 13: if (EN(13)) { pg8::Gemm g{(const bf16_t*)(ws + WS_R2), W + W_OUT / 2, TOK, 1024, 1024, 1024, 0, 0, 1}; S.init(TOK, 1024, 1, G, c);
            EpiDelta E{(bf16_t*)(ws + WS_R3), (const float*)(ws + WS_MOD) + (size_t)l * 9 * 6144 + 2048}; pg8::gemm_phase(lds, g, S, E); } break;
        case 14: if (EN(14)) phase_norm(p, l, 2); break;
        case 15: if (EN(15)) { pg8::Gemm g{(const bf16_t*)(ws + WS_R2), W + W_1 / 2, TOK, 4096, 1024, 1024, 0, 0, 1}; S.init(TOK, 4096, 1, G, c);
            EpiFF1 E{(bf16_t*)(ws + WS_HID)}; pg8::gemm_phase(lds, g, S, E); } break;
        case 16: if (EN(16)) { pg8::Gemm g{(const bf16_t*)(ws + WS_HID), W + W_2 / 2, TOK, 1024, 4096, 4096, 0, 0, 1}; S.init(TOK, 1024, 1, G, c);
            EpiDelta E{(bf16_t*)(ws + WS_R2), (const float*)(ws + WS_MOD) + (size_t)l * 9 * 6144 + 5120}; pg8::gemm_phase(lds, g, S, E); } break;
        default: break;
    }
}

__global__ void __launch_bounds__(NTHR, 2) fwd_megakernel(P p) {
    extern __shared__ __attribute__((aligned(16))) unsigned char lds_raw[];
    LAS unsigned char* lds = (LAS unsigned char*)lds_raw;
#if MULTI_LAUNCH
    for (int ph = p.ph_lo; ph < p.ph_hi; ++ph) run_phase(p, ph, lds);
#else
    cg::grid_group grid = cg::this_grid();
    if (p.ph_lo < 0) grid.sync();
    volatile LAS unsigned* stw = (volatile LAS unsigned*)(lds + LDS_BYTES - 16);
    if (threadIdx.x < 4) stw[threadIdx.x] = 0u;
    __syncthreads();
    const XcdBarrier bar = xcd_barrier_post((unsigned*)(p.ws + WS_BAR), stw);
    for (int ph = p.ph_lo; ph < p.ph_hi; ++ph) {
        run_phase(p, ph, lds);
#if REP_MASK
        if (ph < 2 * PPL && ((REP_MASK >> (ph % PPL)) & 1)) {
            xcd_barrier(bar);
            if ((ph % PPL) == 12) { run_phase(p, ph - 1, lds); }
            run_phase(p, ph, lds);
        }
#endif
        if (ph + 1 < p.ph_hi && (ph % PPL) != 11 && ph != PPL) xcd_barrier(bar);
    }
#endif
}

extern "C" void kernel_launch(void* const* d_in, const int* in_sizes, int n_in, void* d_out, int out_size, void* d_ws, size_t ws_size, hipStream_t stream) {
    static int grid = 0;
    if (grid == 0) {
        if (n_in != 31 || ws_size < WS_END) { fprintf(stderr, "kernel_launch: unexpected n_in %d or ws_size %zu (< %zu)\n", n_in, ws_size, (size_t)WS_END); grid = -1; return; }
        int dev = 0, cus = 0, per_cu = 0;
        hipGetDevice(&dev);
        hipDeviceGetAttribute(&cus, hipDeviceAttributeMultiprocessorCount, dev);
        if (hipFuncSetAttribute((const void*)fwd_megakernel, hipFuncAttributeMaxDynamicSharedMemorySize, LDS_BYTES) != hipSuccess) { fprintf(stderr, "kernel_launch: hipFuncSetAttribute failed\n"); grid = -1; return; }
        hipOccupancyMaxActiveBlocksPerMultiprocessor(&per_cu, (const void*)fwd_megakernel, NTHR, LDS_BYTES);
        (void)hipGetLastError();
        if (per_cu < 1) fprintf(stderr, "kernel_launch: occupancy query says %d blocks per CU\n", per_cu);
        grid = cus > 0 ? cus : 256;
    }
    if (grid < 0) return;
    P p{};
    for (int i = 0; i < 31; ++i) p.in[i] = (const float*)d_in[i];
    p.out = (float*)d_out; p.ws = (unsigned char*)d_ws;
#if MULTI_LAUNCH
    for (int ph = 0; ph < NPHASE; ++ph) { p.ph_lo = ph; p.ph_hi = ph + 1; hipLaunchKernelGGL(fwd_megakernel, dim3(grid), dim3(NTHR), LDS_BYTES, stream, p); }
#else
    p.ph_lo = 0; p.ph_hi = NPHASE;
    (void)hipMemsetAsync((char*)d_ws + WS_BAR, 0, XCD_BAR_WORDS * sizeof(unsigned), stream);
    void* args[] = {&p};
    hipError_t e = hipLaunchCooperativeKernel((const void*)fwd_megakernel, dim3(grid), dim3(NTHR), args, LDS_BYTES, stream);
    if (e != hipSuccess) fprintf(stderr, "cooperative launch failed: %s (grid %d)\n", hipGetErrorString(e), grid);
#endif
}
```
